# Optimizing an MI355X kernel written in HIP

```python
import math
import jax, jax.numpy as jnp
from jax import lax
import numpy as np

D_MODEL = 1024
BATCH = 8
SEQ = 2048
DEPTH = 2
DEC_BATCH = 128
DEC_SEQ = 1
PAST_LEN = 16384
PAGE_SIZE = 128

HG_HEADS = 8
HG_DK = 128
HG_DV = 128
HG_WIDTH = HG_HEADS * HG_DK
CHUNK = 64
LB_FLOOR = 1e-30
LRU_WIDTH = D_MODEL
LRU_BLOCKS = 8
LRU_BS = LRU_WIDTH // LRU_BLOCKS
LRU_C = 8.0
CONV_W = 4
D_FF = 4 * D_MODEL
EPS = 1e-6
COL_SIZES = [HG_WIDTH, HG_WIDTH, HG_HEADS * HG_DV, HG_HEADS * HG_DV,
             LRU_WIDTH, LRU_WIDTH, D_MODEL, D_MODEL]
N_IN = sum(COL_SIZES)

kernel_name = "hgrn2_rglru_gated_parallel_decoder_step"

F32 = jnp.float32


def _rmsnorm(x, g):
    xf = x.astype(F32)
    return xf * lax.rsqrt(jnp.mean(xf * xf, axis=-1, keepdims=True) + EPS) * g.astype(F32)


def _split_cols(u):
    idx = [int(v) for v in np.cumsum(COL_SIZES)[:-1]]
    return jnp.split(u, idx, axis=-1)


def _hgrn2(q, k, v, logf, S0):
    B, L, H, DK = q.shape
    DV = v.shape[-1]
    C = math.gcd(L, CHUNK)
    N = L // C

    def to_chunks(t):
        return t.reshape(B, N, C, H, t.shape[-1]).transpose(1, 0, 3, 2, 4)

    xs = tuple(to_chunks(t.astype(F32)) for t in (q, k, v, logf))
    mask = jnp.tril(jnp.ones((C, C), dtype=bool))[None, None, :, :, None]

    def step(S, inp):
        qc, kc, vc, gc = inp
        G = jnp.cumsum(gc, axis=2)
        o_inter = jnp.einsum('bhtk,bhkv->bhtv', qc * jnp.exp(G), S)
        diff = G[:, :, :, None, :] - G[:, :, None, :, :]
        decay = jnp.where(mask, jnp.exp(jnp.where(mask, diff, 0.0)), 0.0)
        A = jnp.einsum('bhtk,bhsk,bhtsk->bhts', qc, kc, decay)
        o = o_inter + jnp.einsum('bhts,bhsv->bhtv', A, vc)
        G_last = G[:, :, -1:, :]
        S_new = (jnp.exp(G_last[:, :, 0, :])[..., None] * S
                 + jnp.einsum('bhsk,bhsv->bhkv', kc * jnp.exp(G_last - G), vc))
        return S_new, o

    S_fin, o = lax.scan(step, S0, xs)
    o = o.transpose(1, 0, 3, 2, 4).reshape(B, L, H, DV)
    return o, S_fin


def _causal_conv(x, buf, w, b):
    L = x.shape[1]
    full = jnp.concatenate([buf.astype(F32), x.astype(F32)], axis=1)
    out = b.astype(F32) + sum(full[:, j:j + L] * w[j].astype(F32) for j in range(CONV_W))
    return out, full[:, -(CONV_W - 1):]


def _blockdiag(x, w):
    B, L, _ = x.shape
    xb = x.reshape(B, L, LRU_BLOCKS, LRU_BS)
    return jnp.einsum('blnd,nde->blne', xb, w.astype(F32)).reshape(B, L, LRU_WIDTH)


def _rglru(xc, r, i, lam, h0):
    log_a = -LRU_C * r * jax.nn.softplus(-lam.astype(F32))
    a = jnp.exp(log_a)
    b = jnp.sqrt(-jnp.expm1(2.0 * log_a)) * (i * xc)
    b = b.at[:, 0].add(a[:, 0] * h0)

    def comb(left, right):
        a1, b1 = left
        a2, b2 = right
        return a1 * a2, a2 * b1 + b2

    _, h = lax.associative_scan(comb, (a, b), axis=1)
    return h, h[:, -1]


def _trunk(x, c, st_hg, st_lru, st_conv, lb, weights):
    (w_mod, b_mod, norm1_g, norm2_g, w_in, hg_onorm_g, lru_conv_w, lru_conv_b,
     lru_wa, lru_ba, lru_wx, lru_bx, lru_lambda, w_branch_a, w_branch_b, w_out,
     w_ff1, w_ff2, final_norm_g) = weights
    dt = x.dtype
    B, L, _ = x.shape
    cs = jax.nn.silu(c.astype(F32))
    new_hg, new_lru, new_conv = [], [], []
    for l in range(DEPTH):
        mod = cs @ w_mod[l].astype(F32) + b_mod[l].astype(F32)
        sh1, sc1, g1, sh2, sc2, g2 = [m[:, None, :] for m in jnp.split(mod, 6, axis=-1)]

        h = _rmsnorm(x, norm1_g[l]) * (1.0 + sc1) + sh1
        u = h @ w_in[l].astype(F32)
        qa, fa, ia, oga, xb, yb, ga, gb = _split_cols(u)

        lbl = lb[l]
        q = jax.nn.silu(qa).reshape(B, L, HG_HEADS, HG_DK)
        logf = jnp.logaddexp(jnp.log(jnp.maximum(lbl, LB_FLOOR)),
                             jnp.log1p(-lbl) + jax.nn.log_sigmoid(fa))
        k = (1.0 - lbl) * jax.nn.sigmoid(-fa)
        o, S_new = _hgrn2(q, k.reshape(B, L, HG_HEADS, HG_DK), ia.reshape(B, L, HG_HEADS, HG_DV),
                          logf.reshape(B, L, HG_HEADS, HG_DK), st_hg[l].astype(F32))
        o = _rmsnorm(o, hg_onorm_g[l]) * jax.nn.silu(oga.reshape(B, L, HG_HEADS, HG_DV))
        o_a = o.reshape(B, L, HG_HEADS * HG_DV)

        xc, buf = _causal_conv(xb, st_conv[l], lru_conv_w[l], lru_conv_b[l])
        r = jax.nn.sigmoid(_blockdiag(xc, lru_wa[l]) + lru_ba[l].astype(F32))
        ig = jax.nn.sigmoid(_blockdiag(xc, lru_wx[l]) + lru_bx[l].astype(F32))
        hseq, h_last = _rglru(xc, r, ig, lru_lambda[l], st_lru[l].astype(F32))
        o_b = hseq * jax.nn.gelu(yb)

        merged = (jax.nn.sigmoid(ga) * (o_a @ w_branch_a[l].astype(F32))
                  + jax.nn.sigmoid(gb) * (o_b @ w_branch_b[l].astype(F32)))
        x = (x.astype(F32) + g1 * (merged @ w_out[l].astype(F32))).astype(dt)

        h2 = _rmsnorm(x, norm2_g[l]) * (1.0 + sc2) + sh2
        ff = jnp.square(jax.nn.relu(h2 @ w_ff1[l].astype(F32))) @ w_ff2[l].astype(F32)
        x = (x.astype(F32) + g2 * ff).astype(dt)

        new_hg.append(S_new)
        new_lru.append(h_last)
        new_conv.append(buf)
    y = _rmsnorm(x, final_norm_g).astype(dt)
    return (y, jnp.stack(new_hg).astype(st_hg.dtype), jnp.stack(new_lru).astype(st_lru.dtype),
            jnp.stack(new_conv).astype(st_conv.dtype))


def setup_inputs(seed: int = 0) -> dict:
    key = jax.random.key(seed)
    ks = jax.random.split(key, 32)
    nrm = jax.random.normal
    D = D_MODEL
    u = jax.random.uniform(ks[20], (DEPTH, LRU_WIDTH), minval=0.9, maxval=0.999)
    a0 = u ** (1.0 / LRU_C)
    lam = jnp.log(a0) - jnp.log1p(-a0)
    return {
        "x_prompt": nrm(ks[0], (BATCH, SEQ, D), F32),
        "x_sample": nrm(ks[1], (DEC_BATCH, DEC_SEQ, D), F32),
        "state_hgrn": 0.5 * nrm(ks[2], (DEPTH, DEC_BATCH, HG_HEADS, HG_DK, HG_DV), F32),
        "state_rglru": nrm(ks[3], (DEPTH, DEC_BATCH, LRU_WIDTH), F32),
        "state_conv": nrm(ks[4], (DEPTH, DEC_BATCH, CONV_W - 1, LRU_WIDTH), F32),
        "c_prompt": nrm(ks[5], (BATCH, D), F32),
        "c_sample": nrm(ks[6], (DEC_BATCH, D), F32),
        "w_mod": 0.5 * D ** -0.5 * nrm(ks[7], (DEPTH, D, 6 * D), F32),
        "b_mod": 0.02 * nrm(ks[8], (DEPTH, 6 * D), F32),
        "norm1_g": 1.0 + 0.02 * nrm(ks[9], (DEPTH, D), F32),
        "norm2_g": 1.0 + 0.02 * nrm(ks[10], (DEPTH, D), F32),
        "w_in": D ** -0.5 * nrm(ks[11], (DEPTH, D, N_IN), F32),
        "hg_lower": nrm(ks[12], (DEPTH, HG_WIDTH), F32),
        "hg_onorm_g": 1.0 + 0.02 * nrm(ks[13], (DEPTH, HG_DV), F32),
        "lru_conv_w": CONV_W ** -0.5 * nrm(ks[14], (DEPTH, CONV_W, LRU_WIDTH), F32),
        "lru_conv_b": 0.02 * nrm(ks[15], (DEPTH, LRU_WIDTH), F32),
        "lru_wa": LRU_BS ** -0.5 * nrm(ks[16], (DEPTH, LRU_BLOCKS, LRU_BS, LRU_BS), F32),
        "lru_ba": 0.02 * nrm(ks[17], (DEPTH, LRU_WIDTH), F32),
        "lru_wx": LRU_BS ** -0.5 * nrm(ks[18], (DEPTH, LRU_BLOCKS, LRU_BS, LRU_BS), F32),
        "lru_bx": 0.02 * nrm(ks[19], (DEPTH, LRU_WIDTH), F32),
        "lru_lambda": lam,
        "w_branch_a": HG_WIDTH ** -0.5 * nrm(ks[21], (DEPTH, HG_HEADS * HG_DV, D), F32),
        "w_branch_b": LRU_WIDTH ** -0.5 * nrm(ks[22], (DEPTH, LRU_WIDTH, D), F32),
        "w_out": D ** -0.5 * nrm(ks[23], (DEPTH, D, D), F32),
        "w_ff1": D ** -0.5 * nrm(ks[24], (DEPTH, D, D_FF), F32),
        "w_ff2": D_FF ** -0.5 * nrm(ks[25], (DEPTH, D_FF, D), F32),
        "final_norm_g": 1.0 + 0.02 * nrm(ks[26], (D,), F32),
    }


def reference(x_prompt, x_sample, state_hgrn, state_rglru, state_conv, c_prompt, c_sample,
              w_mod, b_mod, norm1_g, norm2_g, w_in, hg_lower, hg_onorm_g, lru_conv_w, lru_conv_b,
              lru_wa, lru_ba, lru_wx, lru_bx, lru_lambda, w_branch_a, w_branch_b, w_out,
              w_ff1, w_ff2, final_norm_g):
    p = jax.nn.softmax(hg_lower.astype(F32), axis=0)
    lb = jnp.cumsum(p, axis=0) - p[0:1]
    weights = (w_mod, b_mod, norm1_g, norm2_g, w_in, hg_onorm_g, lru_conv_w, lru_conv_b,
               lru_wa, lru_ba, lru_wx, lru_bx, lru_lambda, w_branch_a, w_branch_b, w_out,
               w_ff1, w_ff2, final_norm_g)
    Bp = x_prompt.shape[0]
    zero_hg = jnp.zeros((DEPTH, Bp, HG_HEADS, HG_DK, HG_DV), state_hgrn.dtype)
    zero_lru = jnp.zeros((DEPTH, Bp, LRU_WIDTH), state_rglru.dtype)
    zero_conv = jnp.zeros((DEPTH, Bp, CONV_W - 1, LRU_WIDTH), state_conv.dtype)
    y_prompt, hg_p, lru_p, conv_p = _trunk(x_prompt, c_prompt, zero_hg, zero_lru, zero_conv, lb, weights)
    y_sample, hg_s, lru_s, conv_s = _trunk(x_sample, c_sample, state_hgrn, state_rglru, state_conv, lb, weights)
    return (y_prompt, y_sample, hg_p, lru_p, conv_p, hg_s, lru_s, conv_s)
```

```cpp
#include <hip/hip_runtime.h>
#include <cstdio>
#include <cstdint>

#ifndef FAST_GEMM
#define FAST_GEMM 0
#endif
#ifndef FAST_HGRN
#define FAST_HGRN 0
#endif
#ifndef FAST_GATES
#define FAST_GATES 0
#endif
#ifndef ONE_LAUNCH
#define ONE_LAUNCH 0
#endif

#define LAS __attribute__((address_space(3)))
#define GAS __attribute__((address_space(1)))
typedef unsigned short bf16;
typedef float f32x4 __attribute__((ext_vector_type(4)));
typedef float f32x2 __attribute__((ext_vector_type(2)));
typedef short bf16x8 __attribute__((ext_vector_type(8)));
typedef unsigned u32x4 __attribute__((ext_vector_type(4)));
typedef unsigned u32x2 __attribute__((ext_vector_type(2)));

constexpr int D = 1024, NBATCH = 8, SEQ = 2048, MP = NBATCH * SEQ, NS = 128, MR = MP + NS, MT = 16640;
constexpr int NMOD = NBATCH + NS;
constexpr int NIN = 8192, FF = 4096, NH = 8, DKV = 128;
constexpr float EPS = 1e-6f;
constexpr int NPHASE = 18;

constexpr size_t MiB = (size_t)1 << 20;
constexpr size_t WS_CTL = 0, CTL_BYTES = 64 * 1024;
constexpr size_t WS_TAB = 1 * MiB;
constexpr size_t WS_MOD = 2 * MiB;
constexpr size_t WS_W = 9 * MiB, WL_STRIDE = 77 * MiB / 2;
constexpr size_t OFF_WIN = 0, OFF_WA = 16 * MiB, OFF_WB = 18 * MiB, OFF_WO = 20 * MiB, OFF_W1 = 22 * MiB, OFF_W2 = 30 * MiB, OFF_LWA = 38 * MiB, OFF_LWX = 38 * MiB + 256 * 1024;
constexpr size_t WS_H = 86 * MiB;
constexpr size_t WS_Q = 119 * MiB, WS_K = 152 * MiB, WS_V = 185 * MiB, WS_OG = 218 * MiB, WS_XB = 251 * MiB, WS_YG = 284 * MiB, WS_SGA = 317 * MiB, WS_SGB = 350 * MiB;
constexpr size_t WS_LOGF = 383 * MiB;
constexpr size_t WS_T = WS_LOGF;
constexpr size_t WS_MG = WS_K;
constexpr size_t WS_HM = WS_OG;
constexpr size_t WS_END = 448 * MiB;
static_assert(WS_W + 2 * WL_STRIDE <= WS_H && WS_H + (size_t)MT * D * 2 <= WS_Q && WS_LOGF + (size_t)MT * D * 4 <= WS_END && WS_HM + (size_t)MT * FF * 2 <= WS_SGB, "ws map");

constexpr size_t O_YP = 0, O_YS = (size_t)MP * D, O_HGP = O_YS + (size_t)NS * D, O_LRP = O_HGP + (size_t)2 * NBATCH * NH * DKV * DKV, O_CVP = O_LRP + (size_t)2 * NBATCH * D,
                 O_HGS = O_CVP + (size_t)2 * NBATCH * 3 * D, O_LRS = O_HGS + (size_t)2 * NS * NH * DKV * DKV, O_CVS = O_LRS + (size_t)2 * NS * D, O_END = O_CVS + (size_t)2 * NS * 3 * D;
static_assert(O_END == 53673984, "out map");

constexpr int LDS_BYTES = 147456;
constexpr int MISC_OFF = 140 * 1024;

__device__ __forceinline__ unsigned f2bf(float f) { unsigned u = __builtin_bit_cast(unsigned, f); return (u + 0x7fffu + ((u >> 16) & 1u)) >> 16; }
__device__ __forceinline__ unsigned pk2(float lo, float hi) { return f2bf(lo) | (f2bf(hi) << 16); }
__device__ __forceinline__ float bf2f(unsigned b) { return __builtin_bit_cast(float, b << 16); }
__device__ __forceinline__ f32x4 ld_bf4(const bf16* p) { const u32x2 w = *(const u32x2*)p; return (f32x4){bf2f(w.x & 0xffffu), bf2f(w.x >> 16), bf2f(w.y & 0xffffu), bf2f(w.y >> 16)}; }
__device__ __forceinline__ void st_bf4(bf16* p, f32x4 v) { u32x2 w; w.x = pk2(v[0], v[1]); w.y = pk2(v[2], v[3]); *(u32x2*)p = w; }
__device__ __forceinline__ float sigmoidf_(float x) { return 1.0f / (1.0f + __expf(-x)); }
__device__ __forceinline__ float siluf_(float x) { return x * sigmoidf_(x); }
__device__ __forceinline__ float gelu_tanh_(float x) { const float u = 0.7978845608028654f * (x + 0.044715f * x * x * x); return x * sigmoidf_(2.0f * u); }
__device__ __forceinline__ float softplusf_(float x) { return fmaxf(x, 0.f) + log1pf(expf(-fabsf(x))); }
__device__ __forceinline__ float wave_sum(float v) {
#pragma unroll
    for (int o = 1; o < 64; o <<= 1) v += __shfl_xor(v, o);
    return v;
}
__device__ __forceinline__ int mod_row(int row) { return row < MP ? (row >> 11) : (NBATCH + row - MP); }

struct Args { const float* in[27]; float* out; unsigned char* ws; int ph_lo, ph_hi; };
struct Ctx { LAS unsigned char* lds; int tid, lane, wave, G, wg; };
namespace pg8 {
#define PG8_LAS __attribute__((address_space(3)))
typedef unsigned short bf16_t;
typedef short bf16x8 __attribute__((ext_vector_type(8)));
typedef float f32x4 __attribute__((ext_vector_type(4)));
typedef unsigned u32x4 __attribute__((ext_vector_type(4)));
constexpr int BM = 256, BK = 64, HALF = 128, HTB = HALF * BK * 2  , STAGE_BYTES = 8 * HTB, NXCD = 8, WGM = 8;

__host__ __device__ __forceinline__ int lds_byte(int r, int c) { const int st = (r >> 4) * 2 + (c >> 5), rr = r & 15, cc = c & 31, ob = rr * 64 + cc * 2; return st * 1024 + (ob ^ (((ob >> 9) & 1) << 5)); }
__host__ __device__ __forceinline__ void stage_rc(int b, int& R, int& C) { const int st = b / 1024, sb = b % 1024, swz = sb ^ (((sb >> 9) & 1) << 5); R = (st >> 1) * 16 + swz / 64; C = (st & 1) * 32 + (swz % 64) / 2; }
__host__ __device__ __forceinline__ int perm32(int rho) { const int n = rho >> 4, i = rho & 15; return 8 * (i >> 2) + 4 * n + (i & 3); }

struct Unit { int pm, pn; };
struct Gemm { const bf16_t* A; const bf16_t* Bt; int M, N, K; };

struct StaticOrder {
    int nM, nN, nwg, G, c;
    __host__ __device__ void init(int M, int N, int G_, int c_) { nM = M / BM; nN = N / BM; nwg = nM * nN; G = G_; c = c_; }
    __host__ __device__ bool next(int i, Unit& u) const {
        const long L = (long)i * G + c; if (L >= nwg) return false;
        int wgid = (int)L; { const int q = nwg / NXCD, r = nwg % NXCD, xcd = wgid % NXCD, off = wgid / NXCD; wgid = (xcd < r ? xcd * (q + 1) : r * (q + 1) + (xcd - r) * q) + off; }
        const int nig = WGM * nN, gid = wgid / nig, fm = gid * WGM, gsz = (nM - fm) < WGM ? (nM - fm) : WGM;
        u.pm = fm + ((wgid % nig) % gsz); u.pn = (wgid % nig) / gsz; return true;
    }
    __device__ __forceinline__ void a_ready(const Unit&) const {}
    __device__ __forceinline__ void done(const Unit&) const {}
};
template <class Epi, class Sched, bool ALIGN_EPI = false, bool SP2 = false>
__device__ __forceinline__ void gemm_phase(PG8_LAS unsigned char* lds, const Gemm g, const Sched& S, const Epi& E) {
    const int tid = threadIdx.x, wid = __builtin_amdgcn_readfirstlane(tid >> 6), lane = tid & 63, wr = wid >> 2, wc = wid & 3, fr = lane & 15, fq = lane >> 4;
    const int K = g.K, nt = K / BK;
    unsigned voffA[2], voffB[2];
#pragma unroll
    for (int i = 0; i < 2; ++i) { int R, C; stage_rc(tid * 16 + i * 8192, R, C); const int Rb = Epi::PERM ? ((R & ~31) + perm32(R & 31)) : R;
        voffA[i] = (unsigned)(R * K + C) * 2u; voffB[i] = (unsigned)(Rb * K + C) * 2u; }
    const size_t kstep = (size_t)(BK * 2);
    const size_t hstep = (size_t)HALF * K * 2;
    const size_t tstep = 2 * hstep;
    const unsigned ldsw = (unsigned)wid * 1024u;
    const int aoff = lds_byte(wr * 64 + fr, fq * 8), boff = lds_byte(wc * 32 + fr, fq * 8);
#define PG8_SA(b, h) (((b) * 2 + (h)) * HTB)
#define PG8_SB(b, h) ((4 + (b) * 2 + (h)) * HTB)
#define PG8_STAGE(bufoff, gbase, voff) do { _Pragma("unroll") for (int _i = 0; _i < 2; ++_i) \
        __builtin_amdgcn_global_load_lds((const unsigned*)((const char*)(gbase) + (voff)[_i]), (PG8_LAS unsigned*)(lds + (bufoff) + ldsw + _i * 8192), 16, 0, 0); } while (0)
#define PG8_LDA(dst, b, h) do { _Pragma("unroll") for (int m = 0; m < 4; ++m) _Pragma("unroll") for (int k = 0; k < 2; ++k) dst[m][k] = *(const PG8_LAS bf16x8*)(lds + PG8_SA(b, h) + aoff + m * 2048 + k * 1024); } while (0)
#define PG8_LDB(dst, b, h) do { _Pragma("unroll") for (int n = 0; n < 2; ++n) _Pragma("unroll") for (int k = 0; k < 2; ++k) dst[n][k] = *(const PG8_LAS bf16x8*)(lds + PG8_SB(b, h) + boff + n * 2048 + k * 1024); } while (0)
#define PG8_MMA(ai, bj, At, Bt) do { __builtin_amdgcn_s_setprio(1); _Pragma("unroll") for (int m = 0; m < 4; ++m) _Pragma("unroll") for (int n = 0; n < 2; ++n) _Pragma("unroll") for (int k = 0; k < 2; ++k) \
        acc[ai][bj][m][n] = __builtin_amdgcn_mfma_f32_16x16x32_bf16(Bt[n][k], At[m][k], acc[ai][bj][m][n], 0, 0, 0); __builtin_amdgcn_s_setprio(0); } while (0)
#define PG8_WAIT_V(n) asm volatile("s_waitcnt vmcnt(" #n ")" ::: "memory")
#define PG8_WAIT_L(n) asm volatile("s_waitcnt lgkmcnt(" #n ")" ::: "memory")
#define PG8_BAR __builtin_amdgcn_s_barrier()
#define PG8_SCHED __builtin_amdgcn_sched_barrier(0)
    Unit cur, nxt; int ui = 0;
    if (!S.next(0, cur)) return;
    f32x4 acc[2][2][4][2];
#pragma unroll
    for (int a = 0; a < 2; ++a)
#pragma unroll
        for (int b = 0; b < 2; ++b)
#pragma unroll
            for (int m = 0; m < 4; ++m)
#pragma unroll
                for (int n = 0; n < 2; ++n) acc[a][b][m][n] = (f32x4){0.f, 0.f, 0.f, 0.f};
    bf16x8 At[4][2], B0[2][2], B1[2][2];
    const char* cA = (const char*)g.A + (size_t)cur.pm * tstep; const char* cB = (const char*)g.Bt + (size_t)cur.pn * tstep;
    S.a_ready(cur);
    if constexpr (SP2) {
        PG8_STAGE(PG8_SB(0, 0), cB, voffB); PG8_STAGE(PG8_SB(0, 1), cB + hstep, voffB); PG8_STAGE(PG8_SA(0, 0), cA, voffA); PG8_STAGE(PG8_SA(0, 1), cA + hstep, voffA);
        if (wr == 1) PG8_BAR;
        PG8_WAIT_V(2); PG8_BAR;
        PG8_STAGE(PG8_SB(1, 0), cB + kstep, voffB); PG8_STAGE(PG8_SA(1, 0), cA + kstep, voffA); PG8_STAGE(PG8_SB(1, 1), cB + hstep + kstep, voffB);
        PG8_WAIT_V(6); PG8_BAR;
    } else {
        PG8_STAGE(PG8_SB(0, 0), cB, voffB); PG8_STAGE(PG8_SA(0, 0), cA, voffA); PG8_STAGE(PG8_SB(0, 1), cB + hstep, voffB); PG8_STAGE(PG8_SA(0, 1), cA + hstep, voffA);
        if (wr == 1) PG8_BAR;
        PG8_WAIT_V(4); PG8_BAR;
        PG8_STAGE(PG8_SB(1, 0), cB + kstep, voffB); PG8_STAGE(PG8_SA(1, 0), cA + kstep, voffA); PG8_STAGE(PG8_SB(1, 1), cB + hstep + kstep, voffB);
        PG8_WAIT_V(6); PG8_BAR;
    }
    for (;;) {
        const bool has_next = S.next(ui + 1, nxt);
        const char* nA = has_next ? (const char*)g.A + (size_t)nxt.pm * tstep : cA; const char* nB = has_next ? (const char*)g.Bt + (size_t)nxt.pn * tstep : cB;
        for (int t = 0; t < nt; t += 2) {
            const bool last = (t == nt - 2);
            const char* a1 = cA + (size_t)(t + 1) * kstep;
            const char* a2 = last ? nA : cA + (size_t)(t + 2) * kstep; const char* b2 = last ? nB : cB + (size_t)(t + 2) * kstep;
            const char* a3 = a2 + kstep; const char* b3 = b2 + kstep;
            if (last && has_next) S.a_ready(nxt);
            if constexpr (SP2) {
            PG8_LDB(B0, 0, 0); PG8_LDB(B1, 0, 1); PG8_SCHED; PG8_LDA(At, 0, 0); PG8_STAGE(PG8_SA(1, 1), a1 + hstep, voffA);
            PG8_WAIT_V(8); PG8_WAIT_L(0); PG8_BAR; PG8_MMA(0, 0, At, B0); PG8_MMA(0, 1, At, B1); PG8_BAR; PG8_SCHED;
            PG8_LDA(At, 0, 1); PG8_STAGE(PG8_SB(0, 0), b2, voffB); PG8_STAGE(PG8_SB(0, 1), b2 + hstep, voffB); PG8_STAGE(PG8_SA(0, 0), a2, voffA);
            PG8_WAIT_V(8); PG8_WAIT_L(0); PG8_BAR; PG8_MMA(1, 0, At, B0); PG8_MMA(1, 1, At, B1); PG8_BAR; PG8_SCHED;
            PG8_LDB(B0, 1, 0); PG8_LDB(B1, 1, 1); PG8_SCHED; PG8_LDA(At, 1, 0); PG8_STAGE(PG8_SA(0, 1), a2 + hstep, voffA);
            PG8_WAIT_V(8); PG8_WAIT_L(0); PG8_BAR; PG8_MMA(0, 0, At, B0); PG8_MMA(0, 1, At, B1); PG8_BAR; PG8_SCHED;
            PG8_LDA(At, 1, 1); PG8_STAGE(PG8_SB(1, 0), b3, voffB); PG8_STAGE(PG8_SB(1, 1), b3 + hstep, voffB); PG8_STAGE(PG8_SA(1, 0), a3, voffA);
            PG8_WAIT_V(8); PG8_WAIT_L(0); PG8_BAR; PG8_MMA(1, 0, At, B0); PG8_MMA(1, 1, At, B1); PG8_BAR; PG8_SCHED;
            } else {
            PG8_LDB(B0, 0, 0); PG8_SCHED; PG8_LDA(At, 0, 0); PG8_STAGE(PG8_SA(1, 1), a1 + hstep, voffA);
            PG8_WAIT_L(8); PG8_BAR; PG8_WAIT_L(0); PG8_MMA(0, 0, At, B0); PG8_BAR; PG8_SCHED;
            PG8_LDB(B1, 0, 1); PG8_STAGE(PG8_SB(0, 0), b2, voffB);
            PG8_BAR; PG8_WAIT_L(0); PG8_MMA(0, 1, At, B1); PG8_BAR;
            PG8_LDA(At, 0, 1); PG8_STAGE(PG8_SA(0, 0), a2, voffA);
            PG8_BAR; PG8_WAIT_L(0); PG8_MMA(1, 0, At, B0); PG8_BAR; PG8_SCHED;
            PG8_STAGE(PG8_SB(0, 1), b2 + hstep, voffB);
            PG8_WAIT_V(6); PG8_BAR; PG8_MMA(1, 1, At, B1); PG8_BAR;
            PG8_LDB(B0, 1, 0); PG8_SCHED; PG8_LDA(At, 1, 0); PG8_STAGE(PG8_SA(0, 1), a2 + hstep, voffA);
            PG8_WAIT_L(8); PG8_BAR; PG8_WAIT_L(0); PG8_MMA(0, 0, At, B0); PG8_BAR; PG8_SCHED;
            PG8_LDB(B1, 1, 1); PG8_STAGE(PG8_SB(1, 0), b3, voffB);
            PG8_BAR; PG8_WAIT_L(0); PG8_MMA(0, 1, At, B1); PG8_BAR;
            PG8_LDA(At, 1, 1); PG8_STAGE(PG8_SA(1, 0), a3, voffA);
            PG8_BAR; PG8_WAIT_L(0); PG8_MMA(1, 0, At, B0); PG8_BAR; PG8_SCHED;
            PG8_STAGE(PG8_SB(1, 1), b3 + hstep, voffB);
            PG8_WAIT_V(6); PG8_BAR; PG8_MMA(1, 1, At, B1); PG8_BAR;
            }
        }
        if constexpr (ALIGN_EPI) { if (wr == 0) PG8_BAR; }
        if constexpr (!Epi::AFTER_DRAIN) { E(acc, cur, wr, wc, fr, fq); S.done(cur); }
        if (!has_next) break;
#pragma unroll
        for (int a = 0; a < 2; ++a)
#pragma unroll
            for (int b = 0; b < 2; ++b)
#pragma unroll
                for (int m = 0; m < 4; ++m)
#pragma unroll
                    for (int n = 0; n < 2; ++n) acc[a][b][m][n] = (f32x4){0.f, 0.f, 0.f, 0.f};
        cur = nxt; cA = nA; cB = nB; ++ui;
        if constexpr (ALIGN_EPI) { if (wr == 1) PG8_BAR; }
    }
    PG8_WAIT_V(0);
    if constexpr (!ALIGN_EPI) { if (wr == 0) PG8_BAR; }
    PG8_BAR;
    if constexpr (Epi::AFTER_DRAIN) { E.fused(acc, cur, wr, wc, fr, fq, lds, wid, lane); S.done(cur); }
#undef PG8_SA
#undef PG8_SB
#undef PG8_STAGE
#undef PG8_LDA
#undef PG8_LDB
#undef PG8_MMA
#undef PG8_WAIT_V
#undef PG8_WAIT_L
#undef PG8_BAR
#undef PG8_SCHED
}
}

template <class E> struct QuadEpi {
    static constexpr bool PERM = false, AFTER_DRAIN = false;
    E e;
    __device__ __forceinline__ void operator()(const f32x4 (&acc)[2][2][4][2], const pg8::Unit& u, int wr, int wc, int fr, int fq) const {
        const int row0 = u.pm * 256 + wr * 64 + fr, col0 = u.pn * 256 + wc * 32 + 4 * fq;
#pragma unroll
        for (int ai = 0; ai < 2; ++ai)
#pragma unroll
            for (int m = 0; m < 4; ++m)
#pragma unroll
                for (int bj = 0; bj < 2; ++bj)
#pragma unroll
                    for (int n = 0; n < 2; ++n) e.quad(row0 + ai * 128 + m * 16, col0 + bj * 128 + n * 16, acc[ai][bj][m][n]);
    }
};

struct EpiIn {
    bf16 *Q, *Kb, *V, *OG, *XB, *YG, *SGA, *SGB; float* LOGF; const float* lbt;
    __device__ __forceinline__ void quad(int row, int col, f32x4 v) const {
        const int reg = col >> 10, cc = col & 1023; const size_t o = (size_t)row * D + cc;
        f32x4 r;
        if (reg == 0) {
#pragma unroll
            for (int j = 0; j < 4; ++j) r[j] = siluf_(v[j]);
            st_bf4(Q + o, r);
        } else if (reg == 1) {
            const f32x4 lb = *(const f32x4*)(lbt + cc), llb = *(const f32x4*)(lbt + 1024 + cc), l1m = *(const f32x4*)(lbt + 2048 + cc);
            f32x4 lf;
#pragma unroll
            for (int j = 0; j < 4; ++j) {
                const float fa = v[j];
                const float t = __expf(-fabsf(fa));
                const float ls = fminf(fa, 0.f) - log1pf(t);
                const float b = l1m[j] + ls, a_ = llb[j], mx = fmaxf(a_, b);
                lf[j] = mx + log1pf(__expf(-fabsf(a_ - b)));
                const float sneg = (fa >= 0.f ? t : 1.0f) / (1.0f + t);
                r[j] = (1.0f - lb[j]) * sneg;
            }
            *(f32x4*)(LOGF + o) = lf; st_bf4(Kb + o, r);
        } else if (reg == 2) { st_bf4(V + o, v);
        } else if (reg == 3) {
#pragma unroll
            for (int j = 0; j < 4; ++j) r[j] = siluf_(v[j]);
            st_bf4(OG + o, r);
        } else if (reg == 4) { st_bf4(XB + o, v);
        } else if (reg == 5) {
#pragma unroll
            for (int j = 0; j < 4; ++j) r[j] = gelu_tanh_(v[j]);
            st_bf4(YG + o, r);
        } else {
#pragma unroll
            for (int j = 0; j < 4; ++j) r[j] = sigmoidf_(v[j]);
            st_bf4((reg == 6 ? SGA : SGB) + o, r);
        }
    }
};
struct EpiBrA { const bf16* SGA; float* T;
    __device__ __forceinline__ void quad(int row, int col, f32x4 v) const { const size_t o = (size_t)row * D + col; *(f32x4*)(T + o) = ld_bf4(SGA + o) * v; } };
struct EpiBrB { const bf16* SGB; const float* T; bf16* MG;
    __device__ __forceinline__ void quad(int row, int col, f32x4 v) const { const size_t o = (size_t)row * D + col; st_bf4(MG + o, *(const f32x4*)(T + o) + ld_bf4(SGB + o) * v); } };
struct EpiRes { const float* xp; const float* xs; float* X; const float* modl; int gi;
    __device__ __forceinline__ void quad(int row, int col, f32x4 v) const {
        if (row >= MR) return;
        const float* src = row < MP ? xp + (size_t)row * D : xs + (size_t)(row - MP) * D;
        const f32x4 g = *(const f32x4*)(modl + (size_t)mod_row(row) * 6144 + gi * 1024 + col);
        *(f32x4*)(X + (size_t)row * D + col) = *(const f32x4*)(src + col) + g * v;
    } };
struct EpiFF1 { bf16* HM;
    __device__ __forceinline__ void quad(int row, int col, f32x4 v) const {
        f32x4 r;
#pragma unroll
        for (int j = 0; j < 4; ++j) { const float t = fmaxf(v[j], 0.f); r[j] = t * t; }
        st_bf4(HM + (size_t)row * FF + col, r);
    } };

template <class E>
__device__ __forceinline__ void naive_gemm_phase(Ctx& c, const bf16* A, const bf16* Bt, int M, int N, int K, const E& e) {
    LAS float* As = (LAS float*)c.lds;
    LAS float* Bs = As + 32 * 132;
    const int ntm = M / 128, ntn = N / 128, tx = c.tid & 31, ty = c.tid >> 5;
    const int lr = c.tid >> 2, lk = (c.tid & 3) * 8;
    for (int tile = c.wg; tile < ntm * ntn; tile += c.G) {
        const int tm = tile % ntm, tn = tile / ntm;
        f32x4 acc[8];
#pragma unroll
        for (int i = 0; i < 8; ++i) acc[i] = (f32x4){0.f, 0.f, 0.f, 0.f};
        for (int k0 = 0; k0 < K; k0 += 32) {
            const u32x4 av = *(const u32x4*)(A + (size_t)(tm * 128 + lr) * K + k0 + lk);
            const u32x4 bv = *(const u32x4*)(Bt + (size_t)(tn * 128 + lr) * K + k0 + lk);
            __syncthreads();
#pragma unroll
            for (int j = 0; j < 4; ++j) {
                As[(lk + 2 * j) * 132 + lr] = bf2f(av[j] & 0xffffu); As[(lk + 2 * j + 1) * 132 + lr] = bf2f(av[j] >> 16);
                Bs[(lk + 2 * j) * 132 + lr] = bf2f(bv[j] & 0xffffu); Bs[(lk + 2 * j + 1) * 132 + lr] = bf2f(bv[j] >> 16);
            }
            __syncthreads();
#pragma unroll 8
            for (int k = 0; k < 32; ++k) {
                const f32x4 a0 = *(const LAS f32x4*)(As + k * 132 + ty * 8), a1 = *(const LAS f32x4*)(As + k * 132 + ty * 8 + 4);
                const f32x4 b = *(const LAS f32x4*)(Bs + k * 132 + tx * 4);
                acc[0] += a0[0] * b; acc[1] += a0[1] * b; acc[2] += a0[2] * b; acc[3] += a0[3] * b;
                acc[4] += a1[0] * b; acc[5] += a1[1] * b; acc[6] += a1[2] * b; acc[7] += a1[3] * b;
            }
        }
#pragma unroll
        for (int i = 0; i < 8; ++i) e.quad(tm * 128 + ty * 8 + i, tn * 128 + tx * 4, acc[i]);
    }
    __syncthreads();
}

template <class E>
__device__ __forceinline__ void gemm_phase_sel(Ctx& c, const bf16* A, const bf16* Bt, int M, int N, int K, const E& e) {
#if FAST_GEMM
    pg8::Gemm g{A, Bt, M, N, K}; pg8::StaticOrder S; S.init(M, N, c.G, c.wg);
    QuadEpi<E> qe{e};
    pg8::gemm_phase<QuadEpi<E>, pg8::StaticOrder, true, true>(c.lds, g, S, qe);
#else
    naive_gemm_phase(c, A, Bt, M, N, K, e);
#endif
}

#define XB_TMO      128
#define XB_XCNT(j)  (256  + 64 * (j))
#define XB_XSUB(j)  (1280 + 64 * (j))
#define XB_XGEN(j)  (2304 + 64 * (j))
#define XB_TOP      3328
#define XB_TOPGEN   3392
#define XCD_BAR_WORDS 3456
#define XB_SPIN_CAP (1u << 18)
__device__ __forceinline__ unsigned xb_ld(unsigned* p)              { return __hip_atomic_load(p, __ATOMIC_RELAXED, __HIP_MEMORY_SCOPE_AGENT); }
__device__ __forceinline__ unsigned xb_add(unsigned* p, unsigned v) { return __hip_atomic_fetch_add(p, v, __ATOMIC_RELAXED, __HIP_MEMORY_SCOPE_AGENT); }
__device__ __forceinline__ unsigned xb_xcc_id() { return (unsigned)__builtin_amdgcn_s_getreg((3 << 11) | 20) & 0xFu; }
#define XB_SPIN(cond, bar) do { unsigned _sp = 0; while (cond) { __builtin_amdgcn_s_sleep(1); \
    if ((++_sp & 255u) == 0u) { if (xb_ld(&(bar)[XB_TMO])) break; if (_sp > XB_SPIN_CAP) { atomicAdd(&(bar)[XB_TMO], 1u); break; } } } } while (0)
struct XcdBarrier { unsigned* bar; unsigned x; volatile LAS unsigned* st; };
__device__ __forceinline__ XcdBarrier xcd_barrier_post(unsigned* bar, volatile LAS unsigned* st) {
    XcdBarrier b; b.bar = bar; b.x = xb_xcc_id(); b.st = st;
    if (threadIdx.x == 0) (void)xb_add(&bar[XB_XCNT(b.x)], 1u);
    return b;
}
__device__ __forceinline__ void xcd_barrier_complete(unsigned* bar, unsigned x, unsigned& nloc, unsigned& nx) {
    const unsigned G = gridDim.x * gridDim.y * gridDim.z;
    unsigned sum, cnt, mine, sp = 0u;
    for (;;) {
        sum = 0u; cnt = 0u; mine = 0u;
#pragma unroll
        for (unsigned j = 0; j < 16; ++j) { const unsigned c = xb_ld(&bar[XB_XCNT(j)]); sum += c; cnt += (c > 0u) ? 1u : 0u; mine = (j == x) ? c : mine; }
        if (sum == G) break;
        __builtin_amdgcn_s_sleep(1);
        if ((++sp & 255u) == 0u) { if (xb_ld(&bar[XB_TMO])) break; if (sp > XB_SPIN_CAP) { atomicAdd(&bar[XB_TMO], 1u); break; } }
    }
    nloc = mine > 0u ? mine : 1u; nx = cnt > 0u ? cnt : 1u;
}
__device__ __forceinline__ void xcd_barrier(const XcdBarrier& b) {
    asm volatile("s_waitcnt vmcnt(0)" ::: "memory");
    __syncthreads();
    if (threadIdx.x == 0) {
        unsigned* bar = b.bar;
        __builtin_amdgcn_s_waitcnt(0);
        unsigned nloc = b.st[0], nx = b.st[1];
        if (nloc == 0u) { xcd_barrier_complete(bar, b.x, nloc, nx); b.st[0] = nloc; b.st[1] = nx; }
        const unsigned old = xb_add(&bar[XB_XSUB(b.x)], 1u);
        const unsigned gen = old / nloc;
        if (old + 1u == (gen + 1u) * nloc) {
            __builtin_amdgcn_fence(__ATOMIC_RELEASE, "agent");
            asm volatile("s_waitcnt vmcnt(0)" ::: "memory");
            const unsigned og = xb_add(&bar[XB_TOP], 1u);
            const unsigned tg = og / nx;
            if (og + 1u == (tg + 1u) * nx) xb_add(&bar[XB_TOPGEN], 1u);
            else XB_SPIN(xb_ld(&bar[XB_TOPGEN]) == tg, bar);
            __builtin_amdgcn_fence(__ATOMIC_ACQUIRE, "agent");
            xb_add(&bar[XB_XGEN(b.x)], 1u);
            asm volatile("s_waitcnt vmcnt(0)" ::: "memory");
        } else {
            XB_SPIN(xb_ld(&bar[XB_XGEN(b.x)]) == gen, bar);
            __builtin_amdgcn_fence(__ATOMIC_ACQUIRE, "agent");
            asm volatile("s_waitcnt vmcnt(0)" ::: "memory");
        }
    }
    __syncthreads();
}

__device__ __forceinline__ void p0_transpose_item(const float* W, int K, int N, bf16* WT, LAS float* scr, int item, int lane) {
    const int nblk = N / 32, kb = item / nblk, nb = item % nblk, k0 = 64 * kb, n0 = 32 * nb;
#pragma unroll 8
    for (int i = 0; i < 32; ++i) { const int kk = 2 * i + (lane >> 5); scr[kk * 33 + (lane & 31)] = W[(size_t)(k0 + kk) * N + n0 + (lane & 31)]; }
    asm volatile("s_waitcnt lgkmcnt(0)" ::: "memory");
    const int ch = lane & 7;
#pragma unroll
    for (int j = 0; j < 4; ++j) { const int n = (lane >> 3) + 8 * j; const LAS float* s = scr + (8 * ch) * 33 + n;
        u32x4 o; o.x = pk2(s[0 * 33], s[1 * 33]); o.y = pk2(s[2 * 33], s[3 * 33]); o.z = pk2(s[4 * 33], s[5 * 33]); o.w = pk2(s[6 * 33], s[7 * 33]);
        *(u32x4*)(WT + (size_t)(n0 + n) * K + k0 + 8 * ch) = o; }
    asm volatile("s_waitcnt lgkmcnt(0)" ::: "memory");
}
__device__ __forceinline__ void p0_prologue(const Args& a, Ctx& c) {
    {
        LAS float* scr = (LAS float*)(c.lds + c.wave * 16384);
        const int gw = c.wg * 8 + c.wave, NGW = c.G * 8;
        constexpr int I_IN = 16 * 256, I_SQ = 16 * 32, I_1 = 16 * 128, I_2 = 64 * 32, I_L = 8 * 8, PER_L = I_IN + 3 * I_SQ + I_1 + I_2 + 2 * I_L;
        for (int it = gw; it < 2 * PER_L; it += NGW) {
            const int l = it / PER_L; int r = it % PER_L; bf16* wl = (bf16*)(a.ws + WS_W + (size_t)l * WL_STRIDE);
            if (r < I_IN) { p0_transpose_item(a.in[11] + (size_t)l * D * NIN, D, NIN, wl + OFF_WIN / 2, scr, r, c.lane); continue; } r -= I_IN;
            if (r < I_SQ) { p0_transpose_item(a.in[21] + (size_t)l * D * D, D, D, wl + OFF_WA / 2, scr, r, c.lane); continue; } r -= I_SQ;
            if (r < I_SQ) { p0_transpose_item(a.in[22] + (size_t)l * D * D, D, D, wl + OFF_WB / 2, scr, r, c.lane); continue; } r -= I_SQ;
            if (r < I_SQ) { p0_transpose_item(a.in[23] + (size_t)l * D * D, D, D, wl + OFF_WO / 2, scr, r, c.lane); continue; } r -= I_SQ;
            if (r < I_1) { p0_transpose_item(a.in[24] + (size_t)l * D * FF, D, FF, wl + OFF_W1 / 2, scr, r, c.lane); continue; } r -= I_1;
            if (r < I_2) { p0_transpose_item(a.in[25] + (size_t)l * FF * D, FF, D, wl + OFF_W2 / 2, scr, r, c.lane); continue; } r -= I_2;
            if (r < I_L) { const int n = r >> 3; p0_transpose_item(a.in[16] + ((size_t)l * 8 + n) * 16384, 128, 128, wl + OFF_LWA / 2 + n * 16384, scr, r & 7, c.lane); continue; } r -= I_L;
            { const int n = r >> 3; p0_transpose_item(a.in[18] + ((size_t)l * 8 + n) * 16384, 128, 128, wl + OFF_LWX / 2 + n * 16384, scr, r & 7, c.lane); }
        }
    }
    {
        float* lbt = (float*)(a.ws + WS_TAB); float* sp = (float*)(a.ws + WS_TAB + 32768);
        const int gid = c.wg * 512 + c.tid;
        if (gid < 2 * D) {
            const int l = gid >> 10, col = gid & 1023;
            const float h0 = a.in[12][col], h1 = a.in[12][D + col];
            const float p1 = 1.0f / (1.0f + expf(h0 - h1));
            const float lb = l == 0 ? 0.f : p1;
            lbt[(l * 3 + 0) * D + col] = lb; lbt[(l * 3 + 1) * D + col] = logf(fmaxf(lb, 1e-30f)); lbt[(l * 3 + 2) * D + col] = log1pf(-lb);
            sp[l * D + col] = softplusf_(-a.in[20][l * D + col]);
        }
    }
    __syncthreads();
    {
        LAS float* cs = (LAS float*)c.lds;
        float* MOD = (float*)(a.ws + WS_MOD);
        const int col = c.tid & 63, rg = c.tid >> 6;
        for (int item = c.wg; item < 2 * 96; item += c.G) {
            const int l = item / 96, cg = item % 96;
            const float* W = a.in[7] + (size_t)l * D * 6144 + cg * 64 + col;
            float acc[17];
#pragma unroll
            for (int i = 0; i < 17; ++i) acc[i] = 0.f;
            for (int k0 = 0; k0 < D; k0 += 64) {
                __syncthreads();
                for (int e = c.tid; e < NMOD * 64; e += 512) { const int r = e >> 6, kk = e & 63;
                    const float cv = r < NBATCH ? a.in[5][(size_t)r * D + k0 + kk] : a.in[6][(size_t)(r - NBATCH) * D + k0 + kk];
                    cs[e] = siluf_(cv); }
                __syncthreads();
#pragma unroll 4
                for (int kk = 0; kk < 64; ++kk) {
                    const float w = W[(size_t)(k0 + kk) * 6144];
#pragma unroll
                    for (int i = 0; i < 17; ++i) acc[i] += cs[(rg * 17 + i) * 64 + kk] * w;
                }
            }
            const float bm = a.in[8][(size_t)l * 6144 + cg * 64 + col];
#pragma unroll
            for (int i = 0; i < 17; ++i) MOD[((size_t)l * NMOD + rg * 17 + i) * 6144 + cg * 64 + col] = acc[i] + bm;
        }
    }
    __syncthreads();
}

__device__ __forceinline__ void norm_phase(const Args& a, Ctx& c, int l, int which, const float* xp, const float* xs) {
    const int gw = c.wg * 8 + c.wave, NGW = c.G * 8;
    bf16* H = (bf16*)(a.ws + WS_H);
    const float* MODL = (const float*)(a.ws + WS_MOD) + (size_t)l * NMOD * 6144;
    const float* g = a.in[which ? 10 : 9] + (size_t)l * D;
    for (int row = gw; row < MR; row += NGW) {
        const float* xr = row < MP ? xp + (size_t)row * D : xs + (size_t)(row - MP) * D;
        const float* md = MODL + (size_t)mod_row(row) * 6144 + (which ? 3 : 0) * 1024;
        f32x4 v[4]; float ss = 0.f;
#pragma unroll
        for (int j = 0; j < 4; ++j) { v[j] = *(const f32x4*)(xr + 4 * c.lane + 256 * j); ss += (v[j][0] * v[j][0] + v[j][1] * v[j][1]) + (v[j][2] * v[j][2] + v[j][3] * v[j][3]); }
        const float rstd = 1.0f / sqrtf(wave_sum(ss) * (1.0f / D) + EPS);
#pragma unroll
        for (int j = 0; j < 4; ++j) { const int cc = 4 * c.lane + 256 * j;
            const f32x4 gg = *(const f32x4*)(g + cc), sh = *(const f32x4*)(md + cc), sc = *(const f32x4*)(md + 1024 + cc);
            st_bf4(H + (size_t)row * D + cc, v[j] * rstd * gg * (1.0f + sc) + sh); }
    }
}
__device__ __forceinline__ void final_norm_phase(const Args& a, Ctx& c) {
    const int gw = c.wg * 8 + c.wave, NGW = c.G * 8;
    const float* g = a.in[26];
    for (int row = gw; row < MR; row += NGW) {
        float* xr = a.out + (size_t)row * D;
        f32x4 v[4]; float ss = 0.f;
#pragma unroll
        for (int j = 0; j < 4; ++j) { v[j] = *(const f32x4*)(xr + 4 * c.lane + 256 * j); ss += (v[j][0] * v[j][0] + v[j][1] * v[j][1]) + (v[j][2] * v[j][2] + v[j][3] * v[j][3]); }
        const float rstd = 1.0f / sqrtf(wave_sum(ss) * (1.0f / D) + EPS);
#pragma unroll
        for (int j = 0; j < 4; ++j) { const int cc = 4 * c.lane + 256 * j; *(f32x4*)(xr + cc) = v[j] * rstd * *(const f32x4*)(g + cc); }
    }
}

__device__ __forceinline__ void hgrn_naive(const Args& a, Ctx& c, int l, int row0, int ntok, int h, const float* S0, float* Sout) {
    LAS float* fs = (LAS float*)c.lds;
    LAS float* ks = fs + 2048;
    LAS float* qs = ks + 2048;
    LAS float* vs = qs + 2048;
    LAS float* part = vs + 2048;
    bf16* Q = (bf16*)(a.ws + WS_Q); const bf16* Kb = (const bf16*)(a.ws + WS_K); const bf16* V = (const bf16*)(a.ws + WS_V); const bf16* OG = (const bf16*)(a.ws + WS_OG);
    const float* LOGF = (const float*)(a.ws + WS_LOGF);
    const float* hg = a.in[13] + (size_t)l * DKV;
    const int v = c.tid & 127, kg = c.tid >> 7;
    float S[32];
#pragma unroll
    for (int i = 0; i < 32; ++i) S[i] = S0 ? S0[(size_t)(32 * kg + i) * DKV + v] : 0.f;
    for (int t0 = 0; t0 < ntok; t0 += 16) {
        const int nt = (ntok - t0) < 16 ? (ntok - t0) : 16;
        __syncthreads();
        { const int tt = c.tid >> 5, k4 = (c.tid & 31) * 4;
          if (tt < nt) { const size_t off = (size_t)(row0 + t0 + tt) * D + h * DKV + k4;
              const f32x4 lf = *(const f32x4*)(LOGF + off);
              *(LAS f32x4*)(fs + tt * 128 + k4) = (f32x4){expf(lf[0]), expf(lf[1]), expf(lf[2]), expf(lf[3])};
              *(LAS f32x4*)(ks + tt * 128 + k4) = ld_bf4(Kb + off);
              *(LAS f32x4*)(qs + tt * 128 + k4) = ld_bf4(Q + off);
              *(LAS f32x4*)(vs + tt * 128 + k4) = ld_bf4(V + off); } }
        __syncthreads();
        for (int tt = 0; tt < nt; ++tt) {
            const float vv = vs[tt * 128 + v]; float acc = 0.f;
#pragma unroll
            for (int i4 = 0; i4 < 8; ++i4) {
                const f32x4 f = *(const LAS f32x4*)(fs + tt * 128 + 32 * kg + 4 * i4), kk = *(const LAS f32x4*)(ks + tt * 128 + 32 * kg + 4 * i4), qq = *(const LAS f32x4*)(qs + tt * 128 + 32 * kg + 4 * i4);
#pragma unroll
                for (int j = 0; j < 4; ++j) { S[4 * i4 + j] = f[j] * S[4 * i4 + j] + kk[j] * vv; acc += S[4 * i4 + j] * qq[j]; }
            }
            part[(tt * 4 + kg) * 128 + v] = acc;
        }
        __syncthreads();
        { const int tt = c.tid >> 5, v4 = (c.tid & 31) * 4; const int tc = tt < nt ? tt : 0;
          const f32x4 o = *(const LAS f32x4*)(part + (tc * 4 + 0) * 128 + v4) + *(const LAS f32x4*)(part + (tc * 4 + 1) * 128 + v4)
                        + *(const LAS f32x4*)(part + (tc * 4 + 2) * 128 + v4) + *(const LAS f32x4*)(part + (tc * 4 + 3) * 128 + v4);
          float ss = (o[0] * o[0] + o[1] * o[1]) + (o[2] * o[2] + o[3] * o[3]);
#pragma unroll
          for (int m = 1; m < 32; m <<= 1) ss += __shfl_xor(ss, m);
          const float rstd = 1.0f / sqrtf(ss * (1.0f / DKV) + EPS);
          if (tt < nt) { const size_t off = (size_t)(row0 + t0 + tt) * D + h * DKV + v4;
              st_bf4(Q + off, o * rstd * *(const f32x4*)(hg + v4) * ld_bf4(OG + off)); } }
    }
#pragma unroll
    for (int i = 0; i < 32; ++i) Sout[(size_t)(32 * kg + i) * DKV + v] = S[i];
    __syncthreads();
}

constexpr int L_XBS = 0, L_XC = 67 * 128, L_AS = L_XC + 8192, L_BS = L_AS + 8192, L_SEG = L_BS + 8192, L_CARRY = L_SEG + 1024;
static_assert((L_CARRY + 128) * 4 <= MISC_OFF, "lru lds");
__device__ __forceinline__ void lru_gates_naive(const Args& a, Ctx& c, int l, int n) {
    LAS float* XC = (LAS float*)c.lds + L_XC; LAS float* As = (LAS float*)c.lds + L_AS; LAS float* Bs = (LAS float*)c.lds + L_BS;
    const bf16* wl = (const bf16*)(a.ws + WS_W + (size_t)l * WL_STRIDE);
    const int e = c.tid & 127, tg = c.tid >> 7;
    const bf16* wa = wl + OFF_LWA / 2 + (size_t)(n * 128 + e) * 128; const bf16* wx = wl + OFF_LWX / 2 + (size_t)(n * 128 + e) * 128;
    const int ch = n * 128 + e;
    const float ba = a.in[17][(size_t)l * D + ch], bx = a.in[19][(size_t)l * D + ch], sp = ((const float*)(a.ws + WS_TAB + 32768))[l * D + ch];
#pragma unroll 1
    for (int tq = 0; tq < 4; ++tq) {
        float ra[4], ia[4];
#pragma unroll
        for (int i = 0; i < 4; ++i) { ra[i] = 0.f; ia[i] = 0.f; }
        const LAS float* xc = XC + (tg * 16 + tq * 4) * 128;
#pragma unroll 1
        for (int d0 = 0; d0 < 128; d0 += 8) {
            const f32x4 wa0 = ld_bf4(wa + d0), wa1 = ld_bf4(wa + d0 + 4), wx0 = ld_bf4(wx + d0), wx1 = ld_bf4(wx + d0 + 4);
#pragma unroll
            for (int tt = 0; tt < 4; ++tt) {
                const f32x4 x0 = *(const LAS f32x4*)(xc + tt * 128 + d0), x1 = *(const LAS f32x4*)(xc + tt * 128 + d0 + 4);
                ra[tt] += (x0[0] * wa0[0] + x0[1] * wa0[1]) + (x0[2] * wa0[2] + x0[3] * wa0[3]) + (x1[0] * wa1[0] + x1[1] * wa1[1]) + (x1[2] * wa1[2] + x1[3] * wa1[3]);
                ia[tt] += (x0[0] * wx0[0] + x0[1] * wx0[1]) + (x0[2] * wx0[2] + x0[3] * wx0[3]) + (x1[0] * wx1[0] + x1[1] * wx1[1]) + (x1[2] * wx1[2] + x1[3] * wx1[3]);
            }
        }
#pragma unroll
        for (int tt = 0; tt < 4; ++tt) {
            const int t = tg * 16 + tq * 4 + tt;
            const float r = sigmoidf_(ra[tt] + ba), ig = sigmoidf_(ia[tt] + bx);
            const float la = -8.0f * r * sp, aa = expf(la), mult = sqrtf(-expm1f(2.0f * la));
            As[t * 128 + e] = aa; Bs[t * 128 + e] = mult * ig * XC[t * 128 + e];
        }
    }
}
#define lru_gates lru_gates_naive

__device__ __forceinline__ void lru_prompt_item(const Args& a, Ctx& c, int l, int b, int n) {
    LAS float* L = (LAS float*)c.lds;
    bf16* XB = (bf16*)(a.ws + WS_XB); const bf16* YG = (const bf16*)(a.ws + WS_YG);
    const int t_ld = c.tid >> 3, c0 = (c.tid & 7) * 16;
    const int cch = c.tid & 127, sg = c.tid >> 7;
    const float* cw = a.in[14] + (size_t)l * 4 * D + n * 128; const float* cb = a.in[15] + (size_t)l * D + n * 128;
    __syncthreads();
    if (c.tid < 128) L[L_CARRY + c.tid] = 0.f;
    if (c.tid < 384) L[L_XBS + c.tid] = 0.f;
    for (int t0 = 0; t0 < SEQ; t0 += 64) {
        __syncthreads();
        { const bf16* src = XB + (size_t)(b * SEQ + t0 + t_ld) * D + n * 128 + c0;
          const f32x4 x0 = ld_bf4(src), x1 = ld_bf4(src + 4), x2 = ld_bf4(src + 8), x3 = ld_bf4(src + 12);
          LAS float* dst = L + L_XBS + (3 + t_ld) * 128 + c0;
          *(LAS f32x4*)dst = x0; *(LAS f32x4*)(dst + 4) = x1; *(LAS f32x4*)(dst + 8) = x2; *(LAS f32x4*)(dst + 12) = x3; }
        __syncthreads();
#pragma unroll
        for (int j4 = 0; j4 < 4; ++j4) { const int cc = c0 + 4 * j4;
            f32x4 acc = *(const f32x4*)(cb + cc);
#pragma unroll
            for (int j = 0; j < 4; ++j) acc += *(const f32x4*)(cw + j * D + cc) * *(const LAS f32x4*)(L + L_XBS + (t_ld + j) * 128 + cc);
            *(LAS f32x4*)(L + L_XC + t_ld * 128 + cc) = acc; }
        __syncthreads();
        lru_gates(a, c, l, n);
        __syncthreads();
        float P = 1.f, Bv = 0.f;
#pragma unroll 4
        for (int tt = 0; tt < 16; ++tt) { const float aa = L[L_AS + (sg * 16 + tt) * 128 + cch], bb = L[L_BS + (sg * 16 + tt) * 128 + cch]; Bv = aa * Bv + bb; P *= aa; }
        L[L_SEG + (sg * 128 + cch) * 2] = P; L[L_SEG + (sg * 128 + cch) * 2 + 1] = Bv;
        __syncthreads();
        float h = L[L_CARRY + cch];
        for (int s = 0; s < sg; ++s) h = L[L_SEG + (s * 128 + cch) * 2] * h + L[L_SEG + (s * 128 + cch) * 2 + 1];
#pragma unroll 4
        for (int tt = 0; tt < 16; ++tt) { const int t = sg * 16 + tt; const size_t off = (size_t)(b * SEQ + t0 + t) * D + n * 128 + cch;
            h = L[L_AS + t * 128 + cch] * h + L[L_BS + t * 128 + cch];
            XB[off] = (bf16)f2bf(h * bf2f(YG[off])); }
        __syncthreads();
        if (sg == 3) L[L_CARRY + cch] = h;
        if (c.tid < 384) L[L_XBS + c.tid] = L[L_XBS + 64 * 128 + c.tid];
    }
    __syncthreads();
    if (c.tid < 128) a.out[O_LRP + ((size_t)l * NBATCH + b) * D + n * 128 + c.tid] = L[L_CARRY + c.tid];
    if (c.tid < 384) a.out[O_CVP + (((size_t)l * NBATCH + b) * 3 + (c.tid >> 7)) * D + n * 128 + (c.tid & 127)] = L[L_XBS + c.tid];
    __syncthreads();
}
__device__ __forceinline__ void lru_sample_item(const Args& a, Ctx& c, int l, int n, int hf) {
    LAS float* L = (LAS float*)c.lds;
    bf16* XB = (bf16*)(a.ws + WS_XB); const bf16* YG = (const bf16*)(a.ws + WS_YG);
    const int t_ld = c.tid >> 3, c0 = (c.tid & 7) * 16;
    const float* cw = a.in[14] + (size_t)l * 4 * D + n * 128; const float* cb = a.in[15] + (size_t)l * D + n * 128;
    const int bs = hf * 64 + t_ld, row = MP + bs;
    const float* sc = a.in[4] + ((size_t)l * NS + bs) * 3 * D + n * 128;
    float* nc = a.out + O_CVS + ((size_t)l * NS + bs) * 3 * D + n * 128;
    __syncthreads();
#pragma unroll
    for (int j4 = 0; j4 < 4; ++j4) { const int cc = c0 + 4 * j4;
        const f32x4 x = ld_bf4(XB + (size_t)row * D + n * 128 + cc);
        const f32x4 s0 = *(const f32x4*)(sc + cc), s1 = *(const f32x4*)(sc + D + cc), s2 = *(const f32x4*)(sc + 2 * D + cc);
        const f32x4 acc = *(const f32x4*)(cb + cc) + *(const f32x4*)(cw + cc) * s0 + *(const f32x4*)(cw + D + cc) * s1 + *(const f32x4*)(cw + 2 * D + cc) * s2 + *(const f32x4*)(cw + 3 * D + cc) * x;
        *(LAS f32x4*)(L + L_XC + t_ld * 128 + cc) = acc;
        *(f32x4*)(nc + cc) = s1; *(f32x4*)(nc + D + cc) = s2; *(f32x4*)(nc + 2 * D + cc) = x; }
    __syncthreads();
    lru_gates(a, c, l, n);
    __syncthreads();
    { const int cch = c.tid & 127, tg = c.tid >> 7;
#pragma unroll 4
      for (int tt = 0; tt < 16; ++tt) { const int t = tg * 16 + tt, b2 = hf * 64 + t; const size_t off = (size_t)(MP + b2) * D + n * 128 + cch;
          const float h0 = a.in[3][((size_t)l * NS + b2) * D + n * 128 + cch];
          const float h = L[L_AS + t * 128 + cch] * h0 + L[L_BS + t * 128 + cch];
          a.out[O_LRS + ((size_t)l * NS + b2) * D + n * 128 + cch] = h;
          XB[off] = (bf16)f2bf(h * bf2f(YG[off])); } }
    __syncthreads();
}

__device__ __forceinline__ void mixer_phase(const Args& a, Ctx& c, int l) {
    if (c.wg < 64) {
        const int b = c.wg >> 3, h = c.wg & 7;
        hgrn_naive(a, c, l, b * SEQ, SEQ, h, nullptr, a.out + O_HGP + (((size_t)l * NBATCH + b) * NH + h) * DKV * DKV);
    } else if (c.wg < 128) {
        const int i = c.wg - 64;
        lru_prompt_item(a, c, l, i >> 3, i & 7);
        if (i < 16) lru_sample_item(a, c, l, i >> 1, i & 1);
    } else {
        for (int it = c.wg - 128; it < NS * NH; it += c.G - 128) {
            const int bs = it >> 3, h = it & 7; const size_t so = (((size_t)l * NS + bs) * NH + h) * DKV * DKV;
            hgrn_naive(a, c, l, MP + bs, 1, h, a.in[2] + so, a.out + O_HGS + so);
        }
    }
}

__global__ void __launch_bounds__(512, 2) mega_fwd(Args a0) {
    extern __shared__ __attribute__((aligned(16))) unsigned char lds_raw[];
    Ctx c; c.lds = (LAS unsigned char*)lds_raw; c.tid = threadIdx.x; c.lane = c.tid & 63; c.wave = __builtin_amdgcn_readfirstlane(c.tid >> 6); c.G = gridDim.x; c.wg = blockIdx.x;
    volatile LAS unsigned* MISC = (volatile LAS unsigned*)(c.lds + MISC_OFF);
    if (c.tid < 32) MISC[c.tid] = 0u;
    __syncthreads();
    XcdBarrier bar; bar.bar = (unsigned*)(a0.ws + WS_CTL) + 1024; bar.x = 0; bar.st = nullptr;
    if (a0.ph_hi - a0.ph_lo > 1) bar = xcd_barrier_post((unsigned*)(a0.ws + WS_CTL) + 1024, MISC + 8);

    for (int ph = a0.ph_lo; ph < a0.ph_hi; ++ph) {
        Args a = a0; asm volatile("" : "+s"(a.ws), "+s"(a.out));
        float* X = a.out;
        if (ph == 0) p0_prologue(a, c);
        else if (ph == NPHASE - 1) final_norm_phase(a, c);
        else {
            const int l = (ph - 1) >> 3, j = (ph - 1) & 7;
            const bf16* wl = (const bf16*)(a.ws + WS_W + (size_t)l * WL_STRIDE);
            const float* xp = l == 0 ? a.in[0] : X; const float* xs = l == 0 ? a.in[1] : X + (size_t)MP * D;
            const float* modl = (const float*)(a.ws + WS_MOD) + (size_t)l * NMOD * 6144;
            bf16* H = (bf16*)(a.ws + WS_H);
            if (j == 0) norm_phase(a, c, l, 0, xp, xs);
            else if (j == 1) {
                EpiIn e{(bf16*)(a.ws + WS_Q), (bf16*)(a.ws + WS_K), (bf16*)(a.ws + WS_V), (bf16*)(a.ws + WS_OG), (bf16*)(a.ws + WS_XB), (bf16*)(a.ws + WS_YG), (bf16*)(a.ws + WS_SGA), (bf16*)(a.ws + WS_SGB),
                        (float*)(a.ws + WS_LOGF), (const float*)(a.ws + WS_TAB) + (size_t)l * 3 * D};
                gemm_phase_sel(c, H, wl + OFF_WIN / 2, MT, NIN, D, e);
            } else if (j == 2) mixer_phase(a, c, l);
            else if (j == 3) {
                EpiBrA ea{(const bf16*)(a.ws + WS_SGA), (float*)(a.ws + WS_T)};
                gemm_phase_sel(c, (const bf16*)(a.ws + WS_Q), wl + OFF_WA / 2, MT, D, D, ea);
                asm volatile("s_waitcnt vmcnt(0)" ::: "memory"); __syncthreads();
                EpiBrB eb{(const bf16*)(a.ws + WS_SGB), (const float*)(a.ws + WS_T), (bf16*)(a.ws + WS_MG)};
                gemm_phase_sel(c, (const bf16*)(a.ws + WS_XB), wl + OFF_WB / 2, MT, D, D, eb);
            } else if (j == 4) {
                EpiRes e{xp, xs, X, modl, 2};
                gemm_phase_sel(c, (const bf16*)(a.ws + WS_MG), wl + OFF_WO / 2, MT, D, D, e);
            } else if (j == 5) norm_phase(a, c, l, 1, X, X + (size_t)MP * D);
            else if (j == 6) { EpiFF1 e{(bf16*)(a.ws + WS_HM)}; gemm_phase_sel(c, H, wl + OFF_W1 / 2, MT, FF, D, e); }
            else { EpiRes e{X, X + (size_t)MP * D, X, modl, 5}; gemm_phase_sel(c, (const bf16*)(a.ws + WS_HM), wl + OFF_W2 / 2, MT, D, FF, e); }
        }
        if (ph + 1 < a0.ph_hi) xcd_barrier(bar);
    }
}

extern "C" void kernel_launch(void* const* d_in, const int* in_sizes, int n_in, void* d_out, int out_size, void* d_ws, size_t ws_size, hipStream_t stream) {
    static int grid = 0;
    if (grid == 0) {
        if (n_in != 27 || out_size != (int)O_END || ws_size < WS_END) { fprintf(stderr, "kernel_launch: unexpected shapes (n_in %d out %d ws %zu)\n", n_in, out_size, ws_size); grid = -1; return; }
        int dev = 0, cus = 0, per_cu = 0;
        if (hipGetDevice(&dev) != hipSuccess || hipDeviceGetAttribute(&cus, hipDeviceAttributeMultiprocessorCount, dev) != hipSuccess) { grid = -1; return; }
        if (hipFuncSetAttribute((const void*)mega_fwd, hipFuncAttributeMaxDynamicSharedMemorySize, LDS_BYTES) != hipSuccess) { fprintf(stderr, "kernel_launch: hipFuncSetAttribute failed\n"); grid = -1; return; }
        if (hipOccupancyMaxActiveBlocksPerMultiprocessor(&per_cu, (const void*)mega_fwd, 512, LDS_BYTES) != hipSuccess || per_cu < 1) { fprintf(stderr, "kernel_launch: occupancy query failed (%d)\n", per_cu); (void)hipGetLastError(); per_cu = 1; }
        grid = cus * (per_cu < 1 ? 1 : 1);
        fprintf(stderr, "kernel_launch: cus %d per_cu %d grid %d\n", cus, per_cu, grid);
    }
    if (grid < 0) return;
    (void)hipMemsetAsync((char*)d_ws + WS_CTL, 0, CTL_BYTES, stream);
    Args a{};
    for (int i = 0; i < 27; ++i) a.in[i] = (const float*)d_in[i];
    a.out = (float*)d_out; a.ws = (unsigned char*)d_ws;
#if ONE_LAUNCH
    a.ph_lo = 0; a.ph_hi = NPHASE;
    void* kargs[] = {&a};
    hipError_t e = hipLaunchCooperativeKernel((const void*)mega_fwd, dim3(grid), dim3(512), kargs, LDS_BYTES, stream);
    if (e != hipSuccess) fprintf(stderr, "kernel_launch: cooperative launch failed: %s (grid %d)\n", hipGetErrorString(e), grid);
#else
    for (int ph = 0; ph < NPHASE; ++ph) { a.ph_lo = ph; a.ph_hi = ph + 1; hipLaunchKernelGGL(mega_fwd, dim3(grid), dim3(512), LDS_BYTES, stream, a); }
#endif
}
```

```cpp
#include <hip/hip_runtime.h>
#include <cstdio>
#include <cstdint>

#ifndef FAST_GEMM
#define FAST_GEMM 63
#endif
#ifndef FAST_HGRN
#define FAST_HGRN 0
#endif
#ifndef FAST_GATES
#define FAST_GATES 0
#endif
#ifndef DBG_SHFL
#define DBG_SHFL 1
#endif
#ifndef ONE_LAUNCH
#define ONE_LAUNCH 1
#endif

#define LAS __attribute__((address_space(3)))
#define GAS __attribute__((address_space(1)))
typedef unsigned short bf16;
typedef float f32x4 __attribute__((ext_vector_type(4)));
typedef float f32x2 __attribute__((ext_vector_type(2)));
typedef short bf16x8 __attribute__((ext_vector_type(8)));
typedef unsigned u32x4 __attribute__((ext_vector_type(4)));
typedef unsigned u32x2 __attribute__((ext_vector_type(2)));

constexpr int D = 1024, NBATCH = 8, SEQ = 2048, MP = NBATCH * SEQ, NS = 128, MR = MP + NS, MT = 16640;
constexpr int NMOD = NBATCH + NS;
constexpr int NIN = 8192, FF = 4096, NH = 8, DKV = 128;
constexpr float EPS = 1e-6f;
constexpr int NPHASE = 18;

constexpr size_t MiB = (size_t)1 << 20;
constexpr size_t WS_CTL = 0, CTL_BYTES = 64 * 1024;
constexpr size_t WS_TAB = 1 * MiB;
constexpr size_t WS_MOD = 2 * MiB;
constexpr size_t WS_W = 9 * MiB, WL_STRIDE = 77 * MiB / 2;
constexpr size_t OFF_WIN = 0, OFF_WA = 16 * MiB, OFF_WB = 18 * MiB, OFF_WO = 20 * MiB, OFF_W1 = 22 * MiB, OFF_W2 = 30 * MiB, OFF_LWA = 38 * MiB, OFF_LWX = 38 * MiB + 256 * 1024;
constexpr size_t WS_H = 86 * MiB;
constexpr size_t WS_Q = 119 * MiB, WS_K = 152 * MiB, WS_V = 185 * MiB, WS_OG = 218 * MiB, WS_XB = 251 * MiB, WS_YG = 284 * MiB, WS_SGA = 317 * MiB, WS_SGB = 350 * MiB;
constexpr size_t WS_LOGF = 383 * MiB;
constexpr size_t WS_T = WS_LOGF;
constexpr size_t WS_MG = WS_K;
constexpr size_t WS_HM = WS_OG;
constexpr size_t WS_END = 448 * MiB;
static_assert(WS_W + 2 * WL_STRIDE <= WS_H && WS_H + (size_t)MT * D * 2 <= WS_Q && WS_LOGF + (size_t)MT * D * 4 <= WS_END && WS_HM + (size_t)MT * FF * 2 <= WS_SGB, "ws map");

constexpr size_t O_YP = 0, O_YS = (size_t)MP * D, O_HGP = O_YS + (size_t)NS * D, O_LRP = O_HGP + (size_t)2 * NBATCH * NH * DKV * DKV, O_CVP = O_LRP + (size_t)2 * NBATCH * D,
                 O_HGS = O_CVP + (size_t)2 * NBATCH * 3 * D, O_LRS = O_HGS + (size_t)2 * NS * NH * DKV * DKV, O_CVS = O_LRS + (size_t)2 * NS * D, O_END = O_CVS + (size_t)2 * NS * 3 * D;
static_assert(O_END == 53673984, "out map");

constexpr int LDS_BYTES = 147456;
constexpr int MISC_OFF = 140 * 1024;

__device__ __forceinline__ unsigned f2bf(float f) { unsigned u = __builtin_bit_cast(unsigned, f); return (u + 0x7fffu + ((u >> 16) & 1u)) >> 16; }
__device__ __forceinline__ unsigned pk2(float lo, float hi) { return f2bf(lo) | (f2bf(hi) << 16); }
__device__ __forceinline__ float bf2f(unsigned b) { return __builtin_bit_cast(float, b << 16); }
__device__ __forceinline__ f32x4 ld_bf4(const bf16* p) { const u32x2 w = *(const u32x2*)p; return (f32x4){bf2f(w.x & 0xffffu), bf2f(w.x >> 16), bf2f(w.y & 0xffffu), bf2f(w.y >> 16)}; }
__device__ __forceinline__ void st_bf4(bf16* p, f32x4 v) { u32x2 w; w.x = pk2(v[0], v[1]); w.y = pk2(v[2], v[3]); *(u32x2*)p = w; }
__device__ __forceinline__ float sigmoidf_(float x) { return 1.0f / (1.0f + __expf(-x)); }
__device__ __forceinline__ float siluf_(float x) { return x * sigmoidf_(x); }
__device__ __forceinline__ float gelu_tanh_(float x) { const float u = 0.7978845608028654f * (x + 0.044715f * x * x * x); return x * sigmoidf_(2.0f * u); }
__device__ __forceinline__ float softplusf_(float x) { return fmaxf(x, 0.f) + log1pf(expf(-fabsf(x))); }
template <int XM> __device__ __forceinline__ float swz_xor(float v) { return __builtin_bit_cast(float, __builtin_amdgcn_ds_swizzle(__builtin_bit_cast(int, v), (XM << 10) | 0x1f)); }
#if DBG_SHFL
__device__ __forceinline__ float half_sum(float v) {
#pragma unroll
    for (int o = 1; o < 32; o <<= 1) v += __shfl_xor(v, o);
    return v; }
__device__ __forceinline__ float wave_sum(float v) {
#pragma unroll
    for (int o = 1; o < 64; o <<= 1) v += __shfl_xor(v, o);
    return v; }
#else
__device__ __forceinline__ float half_sum(float v) { v += swz_xor<1>(v); v += swz_xor<2>(v); v += swz_xor<4>(v); v += swz_xor<8>(v); v += swz_xor<16>(v); return v; }
__device__ __forceinline__ float wave_sum(float v) {
    v = half_sum(v);
    unsigned v1 = __builtin_bit_cast(unsigned, v), v2 = v1; asm volatile("" : "+v"(v2));
    const auto r = __builtin_amdgcn_permlane32_swap(v1, v2, false, false);
    return __builtin_bit_cast(float, r[0]) + __builtin_bit_cast(float, r[1]);
}
#endif
__device__ __forceinline__ int mod_row(int row) { return row < MP ? (row >> 11) : (NBATCH + row - MP); }

struct Args { const float* in[27]; float* out; unsigned char* ws; int ph_lo, ph_hi; };
typedef const __attribute__((address_space(4))) Args CArgs;
struct Ctx { LAS unsigned char* lds; int tid, G, wg; };
namespace pg8 {
#define PG8_LAS __attribute__((address_space(3)))
typedef unsigned short bf16_t;
typedef short bf16x8 __attribute__((ext_vector_type(8)));
typedef float f32x4 __attribute__((ext_vector_type(4)));
typedef unsigned u32x4 __attribute__((ext_vector_type(4)));
constexpr int BM = 256, BK = 64, HALF = 128, HTB = HALF * BK * 2  , STAGE_BYTES = 8 * HTB, NXCD = 8, WGM = 8;

__host__ __device__ __forceinline__ int lds_byte(int r, int c) { const int st = (r >> 4) * 2 + (c >> 5), rr = r & 15, cc = c & 31, ob = rr * 64 + cc * 2; return st * 1024 + (ob ^ (((ob >> 9) & 1) << 5)); }
__host__ __device__ __forceinline__ void stage_rc(int b, int& R, int& C) { const int st = b / 1024, sb = b % 1024, swz = sb ^ (((sb >> 9) & 1) << 5); R = (st >> 1) * 16 + swz / 64; C = (st & 1) * 32 + (swz % 64) / 2; }
__host__ __device__ __forceinline__ int perm32(int rho) { const int n = rho >> 4, i = rho & 15; return 8 * (i >> 2) + 4 * n + (i & 3); }

struct Unit { int pm, pn; };
struct Gemm { const bf16_t* A; const bf16_t* Bt; int M, N, K; };

struct StaticOrder {
    int nM, nN, nwg, G, c;
    __host__ __device__ void init(int M, int N, int G_, int c_) { nM = M / BM; nN = N / BM; nwg = nM * nN; G = G_; c = c_; }
    __host__ __device__ bool next(int i, Unit& u) const {
        const long L = (long)i * G + c; if (L >= nwg) return false;
        int wgid = (int)L; { const int q = nwg / NXCD, r = nwg % NXCD, xcd = wgid % NXCD, off = wgid / NXCD; wgid = (xcd < r ? xcd * (q + 1) : r * (q + 1) + (xcd - r) * q) + off; }
        const int nig = WGM * nN, gid = wgid / nig, fm = gid * WGM, gsz = (nM - fm) < WGM ? (nM - fm) : WGM;
        u.pm = fm + ((wgid % nig) % gsz); u.pn = (wgid % nig) / gsz; return true;
    }
    __device__ __forceinline__ void a_ready(const Unit&) const {}
    __device__ __forceinline__ void done(const Unit&) const {}
};
template <class Epi, class Sched, bool ALIGN_EPI = false, bool SP2 = false>
__device__ __forceinline__ void gemm_phase(PG8_LAS unsigned char* lds, const Gemm g, const Sched& S, const Epi& E, const int tid_in) {
    const int tid = tid_in, wid = __builtin_amdgcn_readfirstlane(tid >> 6), lane = tid & 63, wr = wid >> 2, wc = wid & 3, fr = lane & 15, fq = lane >> 4;
    const int K = g.K, nt = K / BK;
    unsigned voffA[2], voffB[2];
#pragma unroll
    for (int i = 0; i < 2; ++i) { int R, C; stage_rc(tid * 16 + i * 8192, R, C); const int Rb = Epi::PERM ? ((R & ~31) + perm32(R & 31)) : R;
        voffA[i] = (unsigned)(R * K + C) * 2u; voffB[i] = (unsigned)(Rb * K + C) * 2u; }
    const size_t kstep = (size_t)(BK * 2);
    const size_t hstep = (size_t)HALF * K * 2;
    const size_t tstep = 2 * hstep;
    const unsigned ldsw = (unsigned)wid * 1024u;
    const int aoff = lds_byte(wr * 64 + fr, fq * 8), boff = lds_byte(wc * 32 + fr, fq * 8);
#define PG8_SA(b, h) (((b) * 2 + (h)) * HTB)
#define PG8_SB(b, h) ((4 + (b) * 2 + (h)) * HTB)
#define PG8_STAGE(bufoff, gbase, voff) do { _Pragma("unroll") for (int _i = 0; _i < 2; ++_i) \
        __builtin_amdgcn_global_load_lds((const unsigned*)((const char*)(gbase) + (voff)[_i]), (PG8_LAS unsigned*)(lds + (bufoff) + ldsw + _i * 8192), 16, 0, 0); } while (0)
#define PG8_LDA(dst, b, h) do { _Pragma("unroll") for (int m = 0; m < 4; ++m) _Pragma("unroll") for (int k = 0; k < 2; ++k) dst[m][k] = *(const PG8_LAS bf16x8*)(lds + PG8_SA(b, h) + aoff + m * 2048 + k * 1024); } while (0)
#define PG8_LDB(dst, b, h) do { _Pragma("unroll") for (int n = 0; n < 2; ++n) _Pragma("unroll") for (int k = 0; k < 2; ++k) dst[n][k] = *(const PG8_LAS bf16x8*)(lds + PG8_SB(b, h) + boff + n * 2048 + k * 1024); } while (0)
#define PG8_MMA(ai, bj, At, Bt) do { __builtin_amdgcn_s_setprio(1); _Pragma("unroll") for (int m = 0; m < 4; ++m) _Pragma("unroll") for (int n = 0; n < 2; ++n) _Pragma("unroll") for (int k = 0; k < 2; ++k) \
        acc[ai][bj][m][n] = __builtin_amdgcn_mfma_f32_16x16x32_bf16(Bt[n][k], At[m][k], acc[ai][bj][m][n], 0, 0, 0); __builtin_amdgcn_s_setprio(0); } while (0)
#define PG8_WAIT_V(n) asm volatile("s_waitcnt vmcnt(" #n ")" ::: "memory")
#define PG8_WAIT_L(n) asm volatile("s_waitcnt lgkmcnt(" #n ")" ::: "memory")
#define PG8_BAR __builtin_amdgcn_s_barrier()
#define PG8_SCHED __builtin_amdgcn_sched_barrier(0)
    Unit cur, nxt; int ui = 0;
    if (!S.next(0, cur)) return;
    f32x4 acc[2][2][4][2];
#pragma unroll
    for (int a = 0; a < 2; ++a)
#pragma unroll
        for (int b = 0; b < 2; ++b)
#pragma unroll
            for (int m = 0; m < 4; ++m)
#pragma unroll
                for (int n = 0; n < 2; ++n) acc[a][b][m][n] = (f32x4){0.f, 0.f, 0.f, 0.f};
    bf16x8 At[4][2], B0[2][2], B1[2][2];
    const char* cA = (const char*)g.A + (size_t)cur.pm * tstep; const char* cB = (const char*)g.Bt + (size_t)cur.pn * tstep;
    S.a_ready(cur);
    if constexpr (SP2) {
        PG8_STAGE(PG8_SB(0, 0), cB, voffB); PG8_STAGE(PG8_SB(0, 1), cB + hstep, voffB); PG8_STAGE(PG8_SA(0, 0), cA, voffA); PG8_STAGE(PG8_SA(0, 1), cA + hstep, voffA);
        if (wr == 1) PG8_BAR;
        PG8_WAIT_V(2); PG8_BAR;
        PG8_STAGE(PG8_SB(1, 0), cB + kstep, voffB); PG8_STAGE(PG8_SA(1, 0), cA + kstep, voffA); PG8_STAGE(PG8_SB(1, 1), cB + hstep + kstep, voffB);
        PG8_WAIT_V(6); PG8_BAR;
    } else {
        PG8_STAGE(PG8_SB(0, 0), cB, voffB); PG8_STAGE(PG8_SA(0, 0), cA, voffA); PG8_STAGE(PG8_SB(0, 1), cB + hstep, voffB); PG8_STAGE(PG8_SA(0, 1), cA + hstep, voffA);
        if (wr == 1) PG8_BAR;
        PG8_WAIT_V(4); PG8_BAR;
        PG8_STAGE(PG8_SB(1, 0), cB + kstep, voffB); PG8_STAGE(PG8_SA(1, 0), cA + kstep, voffA); PG8_STAGE(PG8_SB(1, 1), cB + hstep + kstep, voffB);
        PG8_WAIT_V(6); PG8_BAR;
    }
    for (;;) {
        const bool has_next = S.next(ui + 1, nxt);
        const char* nA = has_next ? (const char*)g.A + (size_t)nxt.pm * tstep : cA; const char* nB = has_next ? (const char*)g.Bt + (size_t)nxt.pn * tstep : cB;
        for (int t = 0; t < nt; t += 2) {
            const bool last = (t == nt - 2);
            const char* a1 = cA + (size_t)(t + 1) * kstep;
            const char* a2 = last ? nA : cA + (size_t)(t + 2) * kstep; const char* b2 = last ? nB : cB + (size_t)(t + 2) * kstep;
            const char* a3 = a2 + kstep; const char* b3 = b2 + kstep;
            if (last && has_next) S.a_ready(nxt);
            if constexpr (SP2) {
            PG8_LDB(B0, 0, 0); PG8_LDB(B1, 0, 1); PG8_SCHED; PG8_LDA(At, 0, 0); PG8_STAGE(PG8_SA(1, 1), a1 + hstep, voffA);
            PG8_WAIT_V(8); PG8_WAIT_L(0); PG8_BAR; PG8_MMA(0, 0, At, B0); PG8_MMA(0, 1, At, B1); PG8_BAR; PG8_SCHED;
            PG8_LDA(At, 0, 1); PG8_STAGE(PG8_SB(0, 0), b2, voffB); PG8_STAGE(PG8_SB(0, 1), b2 + hstep, voffB); PG8_STAGE(PG8_SA(0, 0), a2, voffA);
            PG8_WAIT_V(8); PG8_WAIT_L(0); PG8_BAR; PG8_MMA(1, 0, At, B0); PG8_MMA(1, 1, At, B1); PG8_BAR; PG8_SCHED;
            PG8_LDB(B0, 1, 0); PG8_LDB(B1, 1, 1); PG8_SCHED; PG8_LDA(At, 1, 0); PG8_STAGE(PG8_SA(0, 1), a2 + hstep, voffA);
            PG8_WAIT_V(8); PG8_WAIT_L(0); PG8_BAR; PG8_MMA(0, 0, At, B0); PG8_MMA(0, 1, At, B1); PG8_BAR; PG8_SCHED;
            PG8_LDA(At, 1, 1); PG8_STAGE(PG8_SB(1, 0), b3, voffB); PG8_STAGE(PG8_SB(1, 1), b3 + hstep, voffB); PG8_STAGE(PG8_SA(1, 0), a3, voffA);
            PG8_WAIT_V(8); PG8_WAIT_L(0); PG8_BAR; PG8_MMA(1, 0, At, B0); PG8_MMA(1, 1, At, B1); PG8_BAR; PG8_SCHED;
            } else {
            PG8_LDB(B0, 0, 0); PG8_SCHED; PG8_LDA(At, 0, 0); PG8_STAGE(PG8_SA(1, 1), a1 + hstep, voffA);
            PG8_WAIT_L(8); PG8_BAR; PG8_WAIT_L(0); PG8_MMA(0, 0, At, B0); PG8_BAR; PG8_SCHED;
            PG8_LDB(B1, 0, 1); PG8_STAGE(PG8_SB(0, 0), b2, voffB);
            PG8_BAR; PG8_WAIT_L(0); PG8_MMA(0, 1, At, B1); PG8_BAR;
            PG8_LDA(At, 0, 1); PG8_STAGE(PG8_SA(0, 0), a2, voffA);
            PG8_BAR; PG8_WAIT_L(0); PG8_MMA(1, 0, At, B0); PG8_BAR; PG8_SCHED;
            PG8_STAGE(PG8_SB(0, 1), b2 + hstep, voffB);
            PG8_WAIT_V(6); PG8_BAR; PG8_MMA(1, 1, At, B1); PG8_BAR;
            PG8_LDB(B0, 1, 0); PG8_SCHED; PG8_LDA(At, 1, 0); PG8_STAGE(PG8_SA(0, 1), a2 + hstep, voffA);
            PG8_WAIT_L(8); PG8_BAR; PG8_WAIT_L(0); PG8_MMA(0, 0, At, B0); PG8_BAR; PG8_SCHED;
            PG8_LDB(B1, 1, 1); PG8_STAGE(PG8_SB(1, 0), b3, voffB);
            PG8_BAR; PG8_WAIT_L(0); PG8_MMA(0, 1, At, B1); PG8_BAR;
            PG8_LDA(At, 1, 1); PG8_STAGE(PG8_SA(1, 0), a3, voffA);
            PG8_BAR; PG8_WAIT_L(0); PG8_MMA(1, 0, At, B0); PG8_BAR; PG8_SCHED;
            PG8_STAGE(PG8_SB(1, 1), b3 + hstep, voffB);
            PG8_WAIT_V(6); PG8_BAR; PG8_MMA(1, 1, At, B1); PG8_BAR;
            }
        }
        if constexpr (ALIGN_EPI) { if (wr == 0) PG8_BAR; }
        if constexpr (!Epi::AFTER_DRAIN) { int l2 = (int)__builtin_amdgcn_mbcnt_hi(~0u, __builtin_amdgcn_mbcnt_lo(~0u, 0u)); asm volatile("" : "+v"(l2));
            E(acc, cur, wr, wc, l2 & 15, l2 >> 4); S.done(cur); }
        if (!has_next) break;
#pragma unroll
        for (int a = 0; a < 2; ++a)
#pragma unroll
            for (int b = 0; b < 2; ++b)
#pragma unroll
                for (int m = 0; m < 4; ++m)
#pragma unroll
                    for (int n = 0; n < 2; ++n) acc[a][b][m][n] = (f32x4){0.f, 0.f, 0.f, 0.f};
        cur = nxt; cA = nA; cB = nB; ++ui;
        if constexpr (ALIGN_EPI) { if (wr == 1) PG8_BAR; }
    }
    PG8_WAIT_V(0);
    if constexpr (!ALIGN_EPI) { if (wr == 0) PG8_BAR; }
    PG8_BAR;
    if constexpr (Epi::AFTER_DRAIN) { E.fused(acc, cur, wr, wc, fr, fq, lds, wid, lane); S.done(cur); }
#undef PG8_SA
#undef PG8_SB
#undef PG8_STAGE
#undef PG8_LDA
#undef PG8_LDB
#undef PG8_MMA
#undef PG8_WAIT_V
#undef PG8_WAIT_L
#undef PG8_BAR
#undef PG8_SCHED
}
}

template <class E> struct QuadEpi {
    static constexpr bool PERM = false, AFTER_DRAIN = false;
    E e;
    __device__ __forceinline__ void operator()(const f32x4 (&acc)[2][2][4][2], const pg8::Unit& u, int wr, int wc, int fr, int fq) const {
        const int row0 = u.pm * 256 + wr * 64 + fr, col0 = u.pn * 256 + wc * 32 + 4 * fq;
#pragma unroll
        for (int ai = 0; ai < 2; ++ai)
#pragma unroll
            for (int m = 0; m < 4; ++m)
#pragma unroll
                for (int bj = 0; bj < 2; ++bj)
#pragma unroll
                    for (int n = 0; n < 2; ++n) e.quad(row0 + ai * 128 + m * 16, col0 + bj * 128 + n * 16, acc[ai][bj][m][n]);
    }
};

struct EpiIn {
    bf16 *Q, *Kb, *V, *OG, *XB, *YG, *SGA, *SGB; float* LOGF; const float* lbt;
    static constexpr bool BY_REGION = true;
    template <int R> __device__ __forceinline__ void quadR(int row, int cc, f32x4 v) const {
        const size_t o = (size_t)row * D + cc;
        f32x4 r;
        if constexpr (R == 0 || R == 3) {
#pragma unroll
            for (int j = 0; j < 4; ++j) r[j] = siluf_(v[j]);
            st_bf4((R == 0 ? Q : OG) + o, r);
        } else if constexpr (R == 1) {
            const f32x4 lb = *(const f32x4*)(lbt + cc), llb = *(const f32x4*)(lbt + 1024 + cc), l1m = *(const f32x4*)(lbt + 2048 + cc);
            f32x4 lf;
#pragma unroll
            for (int j = 0; j < 4; ++j) {
                const float fa = v[j];
                const float t = __expf(-fabsf(fa));
                const float ls = fminf(fa, 0.f) - __logf(1.0f + t);
                const float b = l1m[j] + ls, a_ = llb[j], mx = fmaxf(a_, b);
                lf[j] = mx + __logf(1.0f + __expf(-fabsf(a_ - b)));
                const float sneg = (fa >= 0.f ? t : 1.0f) / (1.0f + t);
                r[j] = (1.0f - lb[j]) * sneg;
            }
            *(f32x4*)(LOGF + o) = lf; st_bf4(Kb + o, r);
        } else if constexpr (R == 2 || R == 4) { st_bf4((R == 2 ? V : XB) + o, v);
        } else if constexpr (R == 5) {
#pragma unroll
            for (int j = 0; j < 4; ++j) r[j] = gelu_tanh_(v[j]);
            st_bf4(YG + o, r);
        } else {
#pragma unroll
            for (int j = 0; j < 4; ++j) r[j] = sigmoidf_(v[j]);
            st_bf4((R == 6 ? SGA : SGB) + o, r);
        }
    }
    __device__ __forceinline__ void quad(int row, int col, f32x4 v) const {
        const int reg = col >> 10, cc = col & 1023;
        switch (reg) { case 0: quadR<0>(row, cc, v); break; case 1: quadR<1>(row, cc, v); break; case 2: quadR<2>(row, cc, v); break; case 3: quadR<3>(row, cc, v); break;
                       case 4: quadR<4>(row, cc, v); break; case 5: quadR<5>(row, cc, v); break; case 6: quadR<6>(row, cc, v); break; default: quadR<7>(row, cc, v); break; }
    }
};
struct EpiInUnit {
    static constexpr bool PERM = false, AFTER_DRAIN = false;
    EpiIn e;
    template <int R> __device__ __forceinline__ void run(const f32x4 (&acc)[2][2][4][2], int row0, int cc0) const {
#pragma unroll
        for (int ai = 0; ai < 2; ++ai)
#pragma unroll
            for (int m = 0; m < 4; ++m) {
#pragma unroll
                for (int bj = 0; bj < 2; ++bj)
#pragma unroll
                    for (int n = 0; n < 2; ++n) e.quadR<R>(row0 + ai * 128 + m * 16, cc0 + bj * 128 + n * 16, acc[ai][bj][m][n]);
                asm volatile("" ::: "memory"); }
    }
    __device__ __forceinline__ void operator()(const f32x4 (&acc)[2][2][4][2], const pg8::Unit& u, int wr, int wc, int fr, int fq) const {
        const int row0 = u.pm * 256 + wr * 64 + fr, cc0 = (u.pn & 3) * 256 + wc * 32 + 4 * fq;
        switch (u.pn >> 2) { case 0: run<0>(acc, row0, cc0); break; case 1: run<1>(acc, row0, cc0); break; case 2: run<2>(acc, row0, cc0); break; case 3: run<3>(acc, row0, cc0); break;
                             case 4: run<4>(acc, row0, cc0); break; case 5: run<5>(acc, row0, cc0); break; case 6: run<6>(acc, row0, cc0); break; default: run<7>(acc, row0, cc0); break; }
    }
};
struct EpiBrA { static constexpr bool BY_REGION = false; const bf16* SGA; float* T;
    __device__ __forceinline__ void quad(int row, int col, f32x4 v) const { const size_t o = (size_t)row * D + col; *(f32x4*)(T + o) = ld_bf4(SGA + o) * v; } };
struct EpiBrB { static constexpr bool BY_REGION = false; const bf16* SGB; const float* T; bf16* MG;
    __device__ __forceinline__ void quad(int row, int col, f32x4 v) const { const size_t o = (size_t)row * D + col; st_bf4(MG + o, *(const f32x4*)(T + o) + ld_bf4(SGB + o) * v); } };
struct EpiRes { static constexpr bool BY_REGION = false; const float* xp; const float* xs; float* X; const float* modl; int gi;
    __device__ __forceinline__ void quad(int row, int col, f32x4 v) const {
        if (row >= MR) return;
        const float* src = row < MP ? xp + (size_t)row * D : xs + (size_t)(row - MP) * D;
        const f32x4 g = *(const f32x4*)(modl + (size_t)mod_row(row) * 6144 + gi * 1024 + col);
        *(f32x4*)(X + (size_t)row * D + col) = *(const f32x4*)(src + col) + g * v;
    } };
struct EpiFF1 { static constexpr bool BY_REGION = false; bf16* HM;
    __device__ __forceinline__ void quad(int row, int col, f32x4 v) const {
        f32x4 r;
#pragma unroll
        for (int j = 0; j < 4; ++j) { const float t = fmaxf(v[j], 0.f); r[j] = t * t; }
        st_bf4(HM + (size_t)row * FF + col, r);
    } };

template <class E>
__device__ __forceinline__ void naive_gemm_phase(Ctx& c, const bf16* A, const bf16* Bt, int M, int N, int K, const E& e) {
    LAS float* As = (LAS float*)c.lds;
    LAS float* Bs = As + 32 * 132;
    const int ntm = M / 128, ntn = N / 128, tx = c.tid & 31, ty = c.tid >> 5;
    const int lr = c.tid >> 2, lk = (c.tid & 3) * 8;
    for (int tile = c.wg; tile < ntm * ntn; tile += c.G) {
        const int tm = tile % ntm, tn = tile / ntm;
        f32x4 acc[8];
#pragma unroll
        for (int i = 0; i < 8; ++i) acc[i] = (f32x4){0.f, 0.f, 0.f, 0.f};
        for (int k0 = 0; k0 < K; k0 += 32) {
            const u32x4 av = *(const u32x4*)(A + (size_t)(tm * 128 + lr) * K + k0 + lk);
            const u32x4 bv = *(const u32x4*)(Bt + (size_t)(tn * 128 + lr) * K + k0 + lk);
            __syncthreads();
#pragma unroll
            for (int j = 0; j < 4; ++j) {
                As[(lk + 2 * j) * 132 + lr] = bf2f(av[j] & 0xffffu); As[(lk + 2 * j + 1) * 132 + lr] = bf2f(av[j] >> 16);
                Bs[(lk + 2 * j) * 132 + lr] = bf2f(bv[j] & 0xffffu); Bs[(lk + 2 * j + 1) * 132 + lr] = bf2f(bv[j] >> 16);
            }
            __syncthreads();
#pragma unroll 8
            for (int k = 0; k < 32; ++k) {
                const f32x4 a0 = *(const LAS f32x4*)(As + k * 132 + ty * 8), a1 = *(const LAS f32x4*)(As + k * 132 + ty * 8 + 4);
                const f32x4 b = *(const LAS f32x4*)(Bs + k * 132 + tx * 4);
                acc[0] += a0[0] * b; acc[1] += a0[1] * b; acc[2] += a0[2] * b; acc[3] += a0[3] * b;
                acc[4] += a1[0] * b; acc[5] += a1[1] * b; acc[6] += a1[2] * b; acc[7] += a1[3] * b;
            }
        }
#pragma unroll
        for (int i = 0; i < 8; ++i) e.quad(tm * 128 + ty * 8 + i, tn * 128 + tx * 4, acc[i]);
    }
    __syncthreads();
}

template <int SITE, class E>
__device__ __forceinline__ void gemm_phase_sel(Ctx& c, const bf16* A, const bf16* Bt, int M, int N, int K, const E& e) {
    if constexpr ((FAST_GEMM >> SITE) & 1) {
        pg8::Gemm g{A, Bt, M, N, K}; pg8::StaticOrder S; S.init(M, N, c.G, c.wg);
        if constexpr (E::BY_REGION) { EpiInUnit qe{e}; pg8::gemm_phase<EpiInUnit, pg8::StaticOrder, true, true>(c.lds, g, S, qe, c.tid); }
        else { QuadEpi<E> qe{e}; pg8::gemm_phase<QuadEpi<E>, pg8::StaticOrder, true, true>(c.lds, g, S, qe, c.tid); }
    } else naive_gemm_phase(c, A, Bt, M, N, K, e);
}

#define XB_TMO      128
#define XB_XCNT(j)  (256  + 64 * (j))
#define XB_XSUB(j)  (1280 + 64 * (j))
#define XB_XGEN(j)  (2304 + 64 * (j))
#define XB_TOP      3328
#define XB_TOPGEN   3392
#define XCD_BAR_WORDS 3456
#define XB_SPIN_CAP (1u << 18)
__device__ __forceinline__ unsigned xb_ld(unsigned* p)              { return __hip_atomic_load(p, __ATOMIC_RELAXED, __HIP_MEMORY_SCOPE_AGENT); }
__device__ __forceinline__ unsigned xb_add(unsigned* p, unsigned v) { return __hip_atomic_fetch_add(p, v, __ATOMIC_RELAXED, __HIP_MEMORY_SCOPE_AGENT); }
__device__ __forceinline__ unsigned xb_xcc_id() { return (unsigned)__builtin_amdgcn_s_getreg((3 << 11) | 20) & 0xFu; }
#define XB_SPIN(cond, bar) do { unsigned _sp = 0; while (cond) { __builtin_amdgcn_s_sleep(1); \
    if ((++_sp & 255u) == 0u) { if (xb_ld(&(bar)[XB_TMO])) break; if (_sp > XB_SPIN_CAP) { atomicAdd(&(bar)[XB_TMO], 1u); break; } } } } while (0)
struct XcdBarrier { unsigned* bar; unsigned x; volatile LAS unsigned* st; };
__device__ __forceinline__ XcdBarrier xcd_barrier_post(unsigned* bar, volatile LAS unsigned* st) {
    XcdBarrier b; b.bar = bar; b.x = xb_xcc_id(); b.st = st;
    if (threadIdx.x == 0) (void)xb_add(&bar[XB_XCNT(b.x)], 1u);
    return b;
}
__device__ __forceinline__ void xcd_barrier_complete(unsigned* bar, unsigned x, unsigned& nloc, unsigned& nx) {
    const unsigned G = gridDim.x * gridDim.y * gridDim.z;
    unsigned sum, cnt, mine, sp = 0u;
    for (;;) {
        sum = 0u; cnt = 0u; mine = 0u;
#pragma unroll
        for (unsigned j = 0; j < 16; ++j) { const unsigned c = xb_ld(&bar[XB_XCNT(j)]); sum += c; cnt += (c > 0u) ? 1u : 0u; mine = (j == x) ? c : mine; }
        if (sum == G) break;
        __builtin_amdgcn_s_sleep(1);
        if ((++sp & 255u) == 0u) { if (xb_ld(&bar[XB_TMO])) break; if (sp > XB_SPIN_CAP) { atomicAdd(&bar[XB_TMO], 1u); break; } }
    }
    nloc = mine > 0u ? mine : 1u; nx = cnt > 0u ? cnt : 1u;
}
__device__ __forceinline__ void xcd_barrier(const XcdBarrier& b) {
    asm volatile("s_waitcnt vmcnt(0)" ::: "memory");
    __syncthreads();
    if (threadIdx.x == 0) {
        unsigned* bar = b.bar; asm volatile("" : "+s"(bar));
        __builtin_amdgcn_s_waitcnt(0);
        unsigned nloc = b.st[0], nx = b.st[1];
        if (nloc == 0u) { xcd_barrier_complete(bar, b.x, nloc, nx); b.st[0] = nloc; b.st[1] = nx; }
        const unsigned old = xb_add(&bar[XB_XSUB(b.x)], 1u);
        const unsigned gen = old / nloc;
        if (old + 1u == (gen + 1u) * nloc) {
            __builtin_amdgcn_fence(__ATOMIC_RELEASE, "agent");
            asm volatile("s_waitcnt vmcnt(0)" ::: "memory");
            const unsigned og = xb_add(&bar[XB_TOP], 1u);
            const unsigned tg = og / nx;
            if (og + 1u == (tg + 1u) * nx) xb_add(&bar[XB_TOPGEN], 1u);
            else XB_SPIN(xb_ld(&bar[XB_TOPGEN]) == tg, bar);
            __builtin_amdgcn_fence(__ATOMIC_ACQUIRE, "agent");
            xb_add(&bar[XB_XGEN(b.x)], 1u);
            asm volatile("s_waitcnt vmcnt(0)" ::: "memory");
        } else {
            XB_SPIN(xb_ld(&bar[XB_XGEN(b.x)]) == gen, bar);
            __builtin_amdgcn_fence(__ATOMIC_ACQUIRE, "agent");
            asm volatile("s_waitcnt vmcnt(0)" ::: "memory");
        }
    }
    __syncthreads();
}

__device__ __forceinline__ void p0_transpose_item(const float* W, int K, int N, bf16* WT, LAS float* scr, int item, int lane) {
    const int nblk = N / 32, kb = item / nblk, nb = item % nblk, k0 = 64 * kb, n0 = 32 * nb;
#pragma unroll 8
    for (int i = 0; i < 32; ++i) { const int kk = 2 * i + (lane >> 5); scr[kk * 33 + (lane & 31)] = W[(size_t)(k0 + kk) * N + n0 + (lane & 31)]; }
    asm volatile("s_waitcnt lgkmcnt(0)" ::: "memory");
    const int ch = lane & 7;
#pragma unroll
    for (int j = 0; j < 4; ++j) { const int n = (lane >> 3) + 8 * j; const LAS float* s = scr + (8 * ch) * 33 + n;
        u32x4 o; o.x = pk2(s[0 * 33], s[1 * 33]); o.y = pk2(s[2 * 33], s[3 * 33]); o.z = pk2(s[4 * 33], s[5 * 33]); o.w = pk2(s[6 * 33], s[7 * 33]);
        *(u32x4*)(WT + (size_t)(n0 + n) * K + k0 + 8 * ch) = o; }
    asm volatile("s_waitcnt lgkmcnt(0)" ::: "memory");
}
__device__ __forceinline__ void p0_prologue(CArgs& a, Ctx& c) {
    {
        LAS float* scr = (LAS float*)(c.lds + __builtin_amdgcn_readfirstlane(c.tid >> 6) * 16384);
        const int gw = c.wg * 8 + __builtin_amdgcn_readfirstlane(c.tid >> 6), NGW = c.G * 8;
        constexpr int I_IN = 16 * 256, I_SQ = 16 * 32, I_1 = 16 * 128, I_2 = 64 * 32, I_L = 8 * 8, PER_L = I_IN + 3 * I_SQ + I_1 + I_2 + 2 * I_L;
        for (int it = gw; it < 2 * PER_L; it += NGW) {
            const int l = it / PER_L; int r = it % PER_L; bf16* wl = (bf16*)(a.ws + WS_W + (size_t)l * WL_STRIDE);
            if (r < I_IN) { p0_transpose_item(a.in[11] + (size_t)l * D * NIN, D, NIN, wl + OFF_WIN / 2, scr, r, (c.tid & 63)); continue; } r -= I_IN;
            if (r < I_SQ) { p0_transpose_item(a.in[21] + (size_t)l * D * D, D, D, wl + OFF_WA / 2, scr, r, (c.tid & 63)); continue; } r -= I_SQ;
            if (r < I_SQ) { p0_transpose_item(a.in[22] + (size_t)l * D * D, D, D, wl + OFF_WB / 2, scr, r, (c.tid & 63)); continue; } r -= I_SQ;
            if (r < I_SQ) { p0_transpose_item(a.in[23] + (size_t)l * D * D, D, D, wl + OFF_WO / 2, scr, r, (c.tid & 63)); continue; } r -= I_SQ;
            if (r < I_1) { p0_transpose_item(a.in[24] + (size_t)l * D * FF, D, FF, wl + OFF_W1 / 2, scr, r, (c.tid & 63)); continue; } r -= I_1;
            if (r < I_2) { p0_transpose_item(a.in[25] + (size_t)l * FF * D, FF, D, wl + OFF_W2 / 2, scr, r, (c.tid & 63)); continue; } r -= I_2;
            if (r < I_L) { const int n = r >> 3; p0_transpose_item(a.in[16] + ((size_t)l * 8 + n) * 16384, 128, 128, wl + OFF_LWA / 2 + n * 16384, scr, r & 7, (c.tid & 63)); continue; } r -= I_L;
            { const int n = r >> 3; p0_transpose_item(a.in[18] + ((size_t)l * 8 + n) * 16384, 128, 128, wl + OFF_LWX / 2 + n * 16384, scr, r & 7, (c.tid & 63)); }
        }
    }
    {
        float* lbt = (float*)(a.ws + WS_TAB); float* sp = (float*)(a.ws + WS_TAB + 32768);
        const int gid = c.wg * 512 + c.tid;
        if (gid < 2 * D) {
            const int l = gid >> 10, col = gid & 1023;
            const float h0 = a.in[12][col], h1 = a.in[12][D + col];
            const float p1 = 1.0f / (1.0f + expf(h0 - h1));
            const float lb = l == 0 ? 0.f : p1;
            lbt[(l * 3 + 0) * D + col] = lb; lbt[(l * 3 + 1) * D + col] = logf(fmaxf(lb, 1e-30f)); lbt[(l * 3 + 2) * D + col] = log1pf(-lb);
            sp[l * D + col] = softplusf_(-a.in[20][l * D + col]);
        }
    }
    __syncthreads();
    {
        LAS float* cs = (LAS float*)c.lds;
        float* MOD = (float*)(a.ws + WS_MOD);
        const int col = c.tid & 63, rg = c.tid >> 6;
        for (int item = c.wg; item < 2 * 96; item += c.G) {
            const int l = item / 96, cg = item % 96;
            const float* W = a.in[7] + (size_t)l * D * 6144 + cg * 64 + col;
            float acc[17];
#pragma unroll
            for (int i = 0; i < 17; ++i) acc[i] = 0.f;
            for (int k0 = 0; k0 < D; k0 += 64) {
                __syncthreads();
                for (int e = c.tid; e < NMOD * 64; e += 512) { const int r = e >> 6, kk = e & 63;
                    const float cv = r < NBATCH ? a.in[5][(size_t)r * D + k0 + kk] : a.in[6][(size_t)(r - NBATCH) * D + k0 + kk];
                    cs[e] = siluf_(cv); }
                __syncthreads();
#pragma unroll 4
                for (int kk = 0; kk < 64; ++kk) {
                    const float w = W[(size_t)(k0 + kk) * 6144];
#pragma unroll
                    for (int i = 0; i < 17; ++i) acc[i] += cs[(rg * 17 + i) * 64 + kk] * w;
                }
            }
            const float bm = a.in[8][(size_t)l * 6144 + cg * 64 + col];
#pragma unroll
            for (int i = 0; i < 17; ++i) MOD[((size_t)l * NMOD + rg * 17 + i) * 6144 + cg * 64 + col] = acc[i] + bm;
        }
    }
    __syncthreads();
}

__device__ __forceinline__ void norm_phase(CArgs& a, Ctx& c, int l, int which, const float* xp, const float* xs) {
    const int gw = c.wg * 8 + __builtin_amdgcn_readfirstlane(c.tid >> 6), NGW = c.G * 8;
    bf16* H = (bf16*)(a.ws + WS_H);
    const float* MODL = (const float*)(a.ws + WS_MOD) + (size_t)l * NMOD * 6144;
    const float* g = a.in[which ? 10 : 9] + (size_t)l * D;
    for (int row = gw; row < MR; row += NGW) {
        const float* xr = row < MP ? xp + (size_t)row * D : xs + (size_t)(row - MP) * D;
        const float* md = MODL + (size_t)mod_row(row) * 6144 + (which ? 3 : 0) * 1024;
        f32x4 v[4]; float ss = 0.f;
#pragma unroll
        for (int j = 0; j < 4; ++j) { v[j] = *(const f32x4*)(xr + 4 * (c.tid & 63) + 256 * j); ss += (v[j][0] * v[j][0] + v[j][1] * v[j][1]) + (v[j][2] * v[j][2] + v[j][3] * v[j][3]); }
        const float rstd = 1.0f / sqrtf(wave_sum(ss) * (1.0f / D) + EPS);
#pragma unroll
        for (int j = 0; j < 4; ++j) { const int cc = 4 * (c.tid & 63) + 256 * j;
            const f32x4 gg = *(const f32x4*)(g + cc), sh = *(const f32x4*)(md + cc), sc = *(const f32x4*)(md + 1024 + cc);
            st_bf4(H + (size_t)row * D + cc, v[j] * rstd * gg * (1.0f + sc) + sh); }
    }
}
__device__ __forceinline__ void final_norm_phase(CArgs& a, Ctx& c) {
    const int gw = c.wg * 8 + __builtin_amdgcn_readfirstlane(c.tid >> 6), NGW = c.G * 8;
    const float* g = a.in[26];
    for (int row = gw; row < MR; row += NGW) {
        float* xr = a.out + (size_t)row * D;
        f32x4 v[4]; float ss = 0.f;
#pragma unroll
        for (int j = 0; j < 4; ++j) { v[j] = *(const f32x4*)(xr + 4 * (c.tid & 63) + 256 * j); ss += (v[j][0] * v[j][0] + v[j][1] * v[j][1]) + (v[j][2] * v[j][2] + v[j][3] * v[j][3]); }
        const float rstd = 1.0f / sqrtf(wave_sum(ss) * (1.0f / D) + EPS);
#pragma unroll
        for (int j = 0; j < 4; ++j) { const int cc = 4 * (c.tid & 63) + 256 * j; *(f32x4*)(xr + cc) = v[j] * rstd * *(const f32x4*)(g + cc); }
    }
}

__device__ __forceinline__ void hgrn_naive(CArgs& a, Ctx& c, int l, int row0, int ntok, int h, const float* S0, float* Sout) {
    LAS float* fs = (LAS float*)c.lds;
    LAS float* ks = fs + 2048;
    LAS float* qs = ks + 2048;
    LAS float* vs = qs + 2048;
    LAS float* part = vs + 2048;
    bf16* Q = (bf16*)(a.ws + WS_Q); const bf16* Kb = (const bf16*)(a.ws + WS_K); const bf16* V = (const bf16*)(a.ws + WS_V); const bf16* OG = (const bf16*)(a.ws + WS_OG);
    const float* LOGF = (const float*)(a.ws + WS_LOGF);
    const float* hg = a.in[13] + (size_t)l * DKV;
    const int v = c.tid & 127, kg = c.tid >> 7;
    float S[32];
#pragma unroll
    for (int i = 0; i < 32; ++i) S[i] = S0 ? S0[(size_t)(32 * kg + i) * DKV + v] : 0.f;
    for (int t0 = 0; t0 < ntok; t0 += 16) {
        const int nt = (ntok - t0) < 16 ? (ntok - t0) : 16;
        __syncthreads();
        { const int tt = c.tid >> 5, k4 = (c.tid & 31) * 4;
          if (tt < nt) { const size_t off = (size_t)(row0 + t0 + tt) * D + h * DKV + k4;
              const f32x4 lf = *(const f32x4*)(LOGF + off);
              *(LAS f32x4*)(fs + tt * 128 + k4) = (f32x4){expf(lf[0]), expf(lf[1]), expf(lf[2]), expf(lf[3])};
              *(LAS f32x4*)(ks + tt * 128 + k4) = ld_bf4(Kb + off);
              *(LAS f32x4*)(qs + tt * 128 + k4) = ld_bf4(Q + off);
              *(LAS f32x4*)(vs + tt * 128 + k4) = ld_bf4(V + off); } }
        __syncthreads();
        for (int tt = 0; tt < nt; ++tt) {
            const float vv = vs[tt * 128 + v]; float acc = 0.f;
#pragma unroll
            for (int i4 = 0; i4 < 8; ++i4) {
                const f32x4 f = *(const LAS f32x4*)(fs + tt * 128 + 32 * kg + 4 * i4), kk = *(const LAS f32x4*)(ks + tt * 128 + 32 * kg + 4 * i4), qq = *(const LAS f32x4*)(qs + tt * 128 + 32 * kg + 4 * i4);
#pragma unroll
                for (int j = 0; j < 4; ++j) { S[4 * i4 + j] = f[j] * S[4 * i4 + j] + kk[j] * vv; acc += S[4 * i4 + j] * qq[j]; }
            }
            part[(tt * 4 + kg) * 128 + v] = acc;
        }
        __syncthreads();
        { const int tt = c.tid >> 5, v4 = (c.tid & 31) * 4; const int tc = tt < nt ? tt : 0;
          const f32x4 o = *(const LAS f32x4*)(part + (tc * 4 + 0) * 128 + v4) + *(const LAS f32x4*)(part + (tc * 4 + 1) * 128 + v4)
                        + *(const LAS f32x4*)(part + (tc * 4 + 2) * 128 + v4) + *(const LAS f32x4*)(part + (tc * 4 + 3) * 128 + v4);
          float ss = (o[0] * o[0] + o[1] * o[1]) + (o[2] * o[2] + o[3] * o[3]);
          ss = half_sum(ss);
          const float rstd = 1.0f / sqrtf(ss * (1.0f / DKV) + EPS);
          if (tt < nt) { const size_t off = (size_t)(row0 + t0 + tt) * D + h * DKV + v4;
              st_bf4(Q + off, o * rstd * *(const f32x4*)(hg + v4) * ld_bf4(OG + off)); } }
    }
#pragma unroll
    for (int i = 0; i < 32; ++i) Sout[(size_t)(32 * kg + i) * DKV + v] = S[i];
    __syncthreads();
}

constexpr int L_XBS = 0, L_XC = 67 * 128, L_AS = L_XC + 8192, L_BS = L_AS + 8192, L_SEG = L_BS + 8192, L_CARRY = L_SEG + 1024;
static_assert((L_CARRY + 128) * 4 <= MISC_OFF, "lru lds");
__device__ __forceinline__ void lru_gates_naive(CArgs& a, Ctx& c, int l, int n) {
    LAS float* XC = (LAS float*)c.lds + L_XC; LAS float* As = (LAS float*)c.lds + L_AS; LAS float* Bs = (LAS float*)c.lds + L_BS;
    const bf16* wl = (const bf16*)(a.ws + WS_W + (size_t)l * WL_STRIDE);
    const int e = c.tid & 127, tg = c.tid >> 7;
    const bf16* wa = wl + OFF_LWA / 2 + (size_t)(n * 128 + e) * 128; const bf16* wx = wl + OFF_LWX / 2 + (size_t)(n * 128 + e) * 128;
    const int ch = n * 128 + e;
    const float ba = a.in[17][(size_t)l * D + ch], bx = a.in[19][(size_t)l * D + ch], sp = ((const float*)(a.ws + WS_TAB + 32768))[l * D + ch];
#pragma unroll 1
    for (int tq = 0; tq < 4; ++tq) {
        float ra[4], ia[4];
#pragma unroll
        for (int i = 0; i < 4; ++i) { ra[i] = 0.f; ia[i] = 0.f; }
        const LAS float* xc = XC + (tg * 16 + tq * 4) * 128;
#pragma unroll 1
        for (int d0 = 0; d0 < 128; d0 += 8) {
            const f32x4 wa0 = ld_bf4(wa + d0), wa1 = ld_bf4(wa + d0 + 4), wx0 = ld_bf4(wx + d0), wx1 = ld_bf4(wx + d0 + 4);
#pragma unroll
            for (int tt = 0; tt < 4; ++tt) {
                const f32x4 x0 = *(const LAS f32x4*)(xc + tt * 128 + d0), x1 = *(const LAS f32x4*)(xc + tt * 128 + d0 + 4);
                ra[tt] += (x0[0] * wa0[0] + x0[1] * wa0[1]) + (x0[2] * wa0[2] + x0[3] * wa0[3]) + (x1[0] * wa1[0] + x1[1] * wa1[1]) + (x1[2] * wa1[2] + x1[3] * wa1[3]);
                ia[tt] += (x0[0] * wx0[0] + x0[1] * wx0[1]) + (x0[2] * wx0[2] + x0[3] * wx0[3]) + (x1[0] * wx1[0] + x1[1] * wx1[1]) + (x1[2] * wx1[2] + x1[3] * wx1[3]);
            }
        }
#pragma unroll
        for (int tt = 0; tt < 4; ++tt) {
            const int t = tg * 16 + tq * 4 + tt;
            const float r = sigmoidf_(ra[tt] + ba), ig = sigmoidf_(ia[tt] + bx);
            const float la = -8.0f * r * sp, aa = expf(la), mult = sqrtf(-expm1f(2.0f * la));
            As[t * 128 + e] = aa; Bs[t * 128 + e] = mult * ig * XC[t * 128 + e];
        }
    }
}
#define lru_gates lru_gates_naive

__device__ __forceinline__ void lru_prompt_item(CArgs& a, Ctx& c, int l, int b, int n) {
    LAS float* L = (LAS float*)c.lds;
    bf16* XB = (bf16*)(a.ws + WS_XB); const bf16* YG = (const bf16*)(a.ws + WS_YG);
    const int t_ld = c.tid >> 3, c0 = (c.tid & 7) * 16;
    const int cch = c.tid & 127, sg = c.tid >> 7;
    const float* cw = a.in[14] + (size_t)l * 4 * D + n * 128; const float* cb = a.in[15] + (size_t)l * D + n * 128;
    __syncthreads();
    if (c.tid < 128) L[L_CARRY + c.tid] = 0.f;
    if (c.tid < 384) L[L_XBS + c.tid] = 0.f;
    for (int t0 = 0; t0 < SEQ; t0 += 64) {
        __syncthreads();
        { const bf16* src = XB + (size_t)(b * SEQ + t0 + t_ld) * D + n * 128 + c0;
          const f32x4 x0 = ld_bf4(src), x1 = ld_bf4(src + 4), x2 = ld_bf4(src + 8), x3 = ld_bf4(src + 12);
          LAS float* dst = L + L_XBS + (3 + t_ld) * 128 + c0;
          *(LAS f32x4*)dst = x0; *(LAS f32x4*)(dst + 4) = x1; *(LAS f32x4*)(dst + 8) = x2; *(LAS f32x4*)(dst + 12) = x3; }
        __syncthreads();
#pragma unroll
        for (int j4 = 0; j4 < 4; ++j4) { const int cc = c0 + 4 * j4;
            f32x4 acc = *(const f32x4*)(cb + cc);
#pragma unroll
            for (int j = 0; j < 4; ++j) acc += *(const f32x4*)(cw + j * D + cc) * *(const LAS f32x4*)(L + L_XBS + (t_ld + j) * 128 + cc);
            *(LAS f32x4*)(L + L_XC + t_ld * 128 + cc) = acc; }
        __syncthreads();
        lru_gates(a, c, l, n);
        __syncthreads();
        float P = 1.f, Bv = 0.f;
#pragma unroll 4
        for (int tt = 0; tt < 16; ++tt) { const float aa = L[L_AS + (sg * 16 + tt) * 128 + cch], bb = L[L_BS + (sg * 16 + tt) * 128 + cch]; Bv = aa * Bv + bb; P *= aa; }
        L[L_SEG + (sg * 128 + cch) * 2] = P; L[L_SEG + (sg * 128 + cch) * 2 + 1] = Bv;
        __syncthreads();
        float h = L[L_CARRY + cch];
        for (int s = 0; s < sg; ++s) h = L[L_SEG + (s * 128 + cch) * 2] * h + L[L_SEG + (s * 128 + cch) * 2 + 1];
#pragma unroll 4
        for (int tt = 0; tt < 16; ++tt) { const int t = sg * 16 + tt; const size_t off = (size_t)(b * SEQ + t0 + t) * D + n * 128 + cch;
            h = L[L_AS + t * 128 + cch] * h + L[L_BS + t * 128 + cch];
            XB[off] = (bf16)f2bf(h * bf2f(YG[off])); }
        __syncthreads();
        if (sg == 3) L[L_CARRY + cch] = h;
        if (c.tid < 384) L[L_XBS + c.tid] = L[L_XBS + 64 * 128 + c.tid];
    }
    __syncthreads();
    if (c.tid < 128) a.out[O_LRP + ((size_t)l * NBATCH + b) * D + n * 128 + c.tid] = L[L_CARRY + c.tid];
    if (c.tid < 384) a.out[O_CVP + (((size_t)l * NBATCH + b) * 3 + (c.tid >> 7)) * D + n * 128 + (c.tid & 127)] = L[L_XBS + c.tid];
    __syncthreads();
}
__device__ __forceinline__ void lru_sample_item(CArgs& a, Ctx& c, int l, int n, int hf) {
    LAS float* L = (LAS float*)c.lds;
    bf16* XB = (bf16*)(a.ws + WS_XB); const bf16* YG = (const bf16*)(a.ws + WS_YG);
    const int t_ld = c.tid >> 3, c0 = (c.tid & 7) * 16;
    const float* cw = a.in[14] + (size_t)l * 4 * D + n * 128; const float* cb = a.in[15] + (size_t)l * D + n * 128;
    const int bs = hf * 64 + t_ld, row = MP + bs;
    const float* sc = a.in[4] + ((size_t)l * NS + bs) * 3 * D + n * 128;
    float* nc = a.out + O_CVS + ((size_t)l * NS + bs) * 3 * D + n * 128;
    __syncthreads();
#pragma unroll
    for (int j4 = 0; j4 < 4; ++j4) { const int cc = c0 + 4 * j4;
        const f32x4 x = ld_bf4(XB + (size_t)row * D + n * 128 + cc);
        const f32x4 s0 = *(const f32x4*)(sc + cc), s1 = *(const f32x4*)(sc + D + cc), s2 = *(const f32x4*)(sc + 2 * D + cc);
        const f32x4 acc = *(const f32x4*)(cb + cc) + *(const f32x4*)(cw + cc) * s0 + *(const f32x4*)(cw + D + cc) * s1 + *(const f32x4*)(cw + 2 * D + cc) * s2 + *(const f32x4*)(cw + 3 * D + cc) * x;
        *(LAS f32x4*)(L + L_XC + t_ld * 128 + cc) = acc;
        *(f32x4*)(nc + cc) = s1; *(f32x4*)(nc + D + cc) = s2; *(f32x4*)(nc + 2 * D + cc) = x; }
    __syncthreads();
    lru_gates(a, c, l, n);
    __syncthreads();
    { const int cch = c.tid & 127, tg = c.tid >> 7;
#pragma unroll 4
      for (int tt = 0; tt < 16; ++tt) { const int t = tg * 16 + tt, b2 = hf * 64 + t; const size_t off = (size_t)(MP + b2) * D + n * 128 + cch;
          const float h0 = a.in[3][((size_t)l * NS + b2) * D + n * 128 + cch];
          const float h = L[L_AS + t * 128 + cch] * h0 + L[L_BS + t * 128 + cch];
          a.out[O_LRS + ((size_t)l * NS + b2) * D + n * 128 + cch] = h;
          XB[off] = (bf16)f2bf(h * bf2f(YG[off])); } }
    __syncthreads();
}

__device__ __forceinline__ void mixer_phase(CArgs& a, Ctx& c, int l) {
    if (c.wg < 64) {
        const int b = c.wg >> 3, h = c.wg & 7;
        hgrn_naive(a, c, l, b * SEQ, SEQ, h, nullptr, a.out + O_HGP + (((size_t)l * NBATCH + b) * NH + h) * DKV * DKV);
    } else if (c.wg < 128) {
        const int i = c.wg - 64;
        lru_prompt_item(a, c, l, i >> 3, i & 7);
        if (i < 16) lru_sample_item(a, c, l, i >> 1, i & 1);
    } else {
        for (int it = c.wg - 128; it < NS * NH; it += c.G - 128) {
            const int bs = it >> 3, h = it & 7; const size_t so = (((size_t)l * NS + bs) * NH + h) * DKV * DKV;
            hgrn_naive(a, c, l, MP + bs, 1, h, a.in[2] + so, a.out + O_HGS + so);
        }
    }
}

__global__ void __launch_bounds__(512, 2) mega_fwd(Args a0) {
    extern __shared__ __attribute__((aligned(16))) unsigned char lds_raw[];
    Ctx c; c.lds = (LAS unsigned char*)lds_raw; c.tid = threadIdx.x; c.G = gridDim.x; c.wg = blockIdx.x;
    volatile LAS unsigned* MISC = (volatile LAS unsigned*)(c.lds + MISC_OFF);
    if (c.tid < 32) MISC[c.tid] = 0u;
    __syncthreads();
    XcdBarrier bar; bar.bar = (unsigned*)(a0.ws + WS_CTL) + 1024; bar.x = 0; bar.st = nullptr;
    if (a0.ph_hi - a0.ph_lo > 1) bar = xcd_barrier_post((unsigned*)(a0.ws + WS_CTL) + 1024, MISC + 8);

    for (int ph = a0.ph_lo; ph < a0.ph_hi; ++ph) {
        CArgs* ap = (CArgs*)__builtin_amdgcn_kernarg_segment_ptr(); asm volatile("" : "+s"(ap));
        CArgs& a = *ap;
        { int t_ = threadIdx.x, w_ = blockIdx.x, g_ = gridDim.x; asm volatile("" : "+v"(t_), "+s"(w_), "+s"(g_)); c.tid = t_; c.wg = w_; c.G = g_; }
        float* X = a.out;
        if (ph == 0) p0_prologue(a, c);
        else if (ph == NPHASE - 1) final_norm_phase(a, c);
        else {
            const int l = (ph - 1) >> 3, j = (ph - 1) & 7;
            const bf16* wl = (const bf16*)(a.ws + WS_W + (size_t)l * WL_STRIDE);
            const float* xp = l == 0 ? a.in[0] : X; const float* xs = l == 0 ? a.in[1] : X + (size_t)MP * D;
            const float* modl = (const float*)(a.ws + WS_MOD) + (size_t)l * NMOD * 6144;
            bf16* H = (bf16*)(a.ws + WS_H);
            if (j == 0) norm_phase(a, c, l, 0, xp, xs);
            else if (j == 1) {
                EpiIn e{(bf16*)(a.ws + WS_Q), (bf16*)(a.ws + WS_K), (bf16*)(a.ws + WS_V), (bf16*)(a.ws + WS_OG), (bf16*)(a.ws + WS_XB), (bf16*)(a.ws + WS_YG), (bf16*)(a.ws + WS_SGA), (bf16*)(a.ws + WS_SGB),
                        (float*)(a.ws + WS_LOGF), (const float*)(a.ws + WS_TAB) + (size_t)l * 3 * D};
                gemm_phase_sel<0>(c, H, wl + OFF_WIN / 2, MT, NIN, D, e);
            } else if (j == 2) mixer_phase(a, c, l);
            else if (j == 3) {
                EpiBrA ea{(const bf16*)(a.ws + WS_SGA), (float*)(a.ws + WS_T)};
                gemm_phase_sel<1>(c, (const bf16*)(a.ws + WS_Q), wl + OFF_WA / 2, MT, D, D, ea);
                asm volatile("s_waitcnt vmcnt(0)" ::: "memory"); __syncthreads();
                { int t_ = threadIdx.x; asm volatile("" : "+v"(t_)); c.tid = t_; }
                EpiBrB eb{(const bf16*)(a.ws + WS_SGB), (const float*)(a.ws + WS_T), (bf16*)(a.ws + WS_MG)};
                gemm_phase_sel<2>(c, (const bf16*)(a.ws + WS_XB), wl + OFF_WB / 2, MT, D, D, eb);
            } else if (j == 4) {
                EpiRes e{xp, xs, X, modl, 2};
                gemm_phase_sel<3>(c, (const bf16*)(a.ws + WS_MG), wl + OFF_WO / 2, MT, D, D, e);
            } else if (j == 5) norm_phase(a, c, l, 1, X, X + (size_t)MP * D);
            else if (j == 6) { EpiFF1 e{(bf16*)(a.ws + WS_HM)}; gemm_phase_sel<4>(c, H, wl + OFF_W1 / 2, MT, FF, D, e); }
            else { EpiRes e{X, X + (size_t)MP * D, X, modl, 5}; gemm_phase_sel<5>(c, (const bf16*)(a.ws + WS_HM), wl + OFF_W2 / 2, MT, D, FF, e); }
        }
        if (ph + 1 < a0.ph_hi) xcd_barrier(bar);
    }
}

extern "C" void kernel_launch(void* const* d_in, const int* in_sizes, int n_in, void* d_out, int out_size, void* d_ws, size_t ws_size, hipStream_t stream) {
    static int grid = 0;
    if (grid == 0) {
        if (n_in != 27 || out_size != (int)O_END || ws_size < WS_END) { fprintf(stderr, "kernel_launch: unexpected shapes (n_in %d out %d ws %zu)\n", n_in, out_size, ws_size); grid = -1; return; }
        int dev = 0, cus = 0, per_cu = 0;
        if (hipGetDevice(&dev) != hipSuccess || hipDeviceGetAttribute(&cus, hipDeviceAttributeMultiprocessorCount, dev) != hipSuccess) { grid = -1; return; }
        if (hipFuncSetAttribute((const void*)mega_fwd, hipFuncAttributeMaxDynamicSharedMemorySize, LDS_BYTES) != hipSuccess) { fprintf(stderr, "kernel_launch: hipFuncSetAttribute failed\n"); grid = -1; return; }
        if (hipOccupancyMaxActiveBlocksPerMultiprocessor(&per_cu, (const void*)mega_fwd, 512, LDS_BYTES) != hipSuccess || per_cu < 1) { fprintf(stderr, "kernel_launch: occupancy query failed (%d)\n", per_cu); (void)hipGetLastError(); per_cu = 1; }
        grid = cus * (per_cu < 1 ? 1 : 1);
        fprintf(stderr, "kernel_launch: cus %d per_cu %d grid %d\n", cus, per_cu, grid);
    }
    if (grid < 0) return;
    (void)hipMemsetAsync((char*)d_ws + WS_CTL, 0, CTL_BYTES, stream);
    Args a{};
    for (int i = 0; i < 27; ++i) a.in[i] = (const float*)d_in[i];
    a.out = (float*)d_out; a.ws = (unsigned char*)d_ws;
#if ONE_LAUNCH
    a.ph_lo = 0; a.ph_hi = NPHASE;
    void* kargs[] = {&a};
    hipError_t e = hipLaunchCooperativeKernel((const void*)mega_fwd, dim3(grid), dim3(512), kargs, LDS_BYTES, stream);
    if (e != hipSuccess) fprintf(stderr, "kernel_launch: cooperative launch failed: %s (grid %d)\n", hipGetErrorString(e), grid);
#else
    for (int ph = 0; ph < NPHASE; ++ph) { a.ph_lo = ph; a.ph_hi = ph + 1; hipLaunchKernelGGL(mega_fwd, dim3(grid), dim3(512), LDS_BYTES, stream, a); }
#endif
}
```

```cpp
#include <hip/hip_runtime.h>
#include <cstdio>
#include <cstdint>

#ifndef FAST_GEMM
#define FAST_GEMM 63
#endif
#ifndef FAST_HGRN
#define FAST_HGRN 0
#endif
#ifndef FAST_GATES
#define FAST_GATES 1
#endif
#ifndef DBG_SHFL
#define DBG_SHFL 1
#endif
#ifndef PROBE_REPEAT
#define PROBE_REPEAT 0
#endif
#ifndef ONE_LAUNCH
#define ONE_LAUNCH 1
#endif

#define LAS __attribute__((address_space(3)))
#define GAS __attribute__((address_space(1)))
typedef unsigned short bf16;
typedef float f32x4 __attribute__((ext_vector_type(4)));
typedef float f32x2 __attribute__((ext_vector_type(2)));
typedef short bf16x8 __attribute__((ext_vector_type(8)));
typedef unsigned u32x4 __attribute__((ext_vector_type(4)));
typedef unsigned u32x2 __attribute__((ext_vector_type(2)));

constexpr int D = 1024, NBATCH = 8, SEQ = 2048, MP = NBATCH * SEQ, NS = 128, MR = MP + NS, MT = 16640;
constexpr int NMOD = NBATCH + NS;
constexpr int NIN = 8192, FF = 4096, NH = 8, DKV = 128;
constexpr float EPS = 1e-6f;
constexpr int NPHASE = 18;

constexpr size_t MiB = (size_t)1 << 20;
constexpr size_t WS_CTL = 0, CTL_BYTES = 64 * 1024;
constexpr size_t WS_TAB = 1 * MiB;
constexpr size_t WS_MOD = 2 * MiB;
constexpr size_t WS_W = 9 * MiB, WL_STRIDE = 77 * MiB / 2;
constexpr size_t OFF_WIN = 0, OFF_WA = 16 * MiB, OFF_WB = 18 * MiB, OFF_WO = 20 * MiB, OFF_W1 = 22 * MiB, OFF_W2 = 30 * MiB, OFF_LWA = 38 * MiB, OFF_LWX = 38 * MiB + 256 * 1024;
constexpr size_t WS_H = 86 * MiB;
constexpr size_t WS_Q = 119 * MiB, WS_K = 152 * MiB, WS_V = 185 * MiB, WS_OG = 218 * MiB, WS_XB = 251 * MiB, WS_YG = 284 * MiB, WS_SGA = 317 * MiB, WS_SGB = 350 * MiB;
constexpr size_t WS_LOGF = 383 * MiB;
constexpr size_t WS_T = WS_LOGF;
constexpr size_t WS_MG = WS_K;
constexpr size_t WS_HM = WS_OG;
constexpr size_t WS_OA = 448 * MiB;
constexpr size_t WS_OB = WS_H;
constexpr size_t WS_END = 481 * MiB;
static_assert(WS_W + 2 * WL_STRIDE <= WS_H && WS_H + (size_t)MT * D * 2 <= WS_Q && WS_LOGF + (size_t)MT * D * 4 <= WS_OA && WS_OA + (size_t)MT * D * 2 <= WS_END && WS_HM + (size_t)MT * FF * 2 <= WS_SGB, "ws map");

constexpr size_t O_YP = 0, O_YS = (size_t)MP * D, O_HGP = O_YS + (size_t)NS * D, O_LRP = O_HGP + (size_t)2 * NBATCH * NH * DKV * DKV, O_CVP = O_LRP + (size_t)2 * NBATCH * D,
                 O_HGS = O_CVP + (size_t)2 * NBATCH * 3 * D, O_LRS = O_HGS + (size_t)2 * NS * NH * DKV * DKV, O_CVS = O_LRS + (size_t)2 * NS * D, O_END = O_CVS + (size_t)2 * NS * 3 * D;
static_assert(O_END == 53673984, "out map");

constexpr int LDS_BYTES = 163840;
constexpr int MISC_OFF = 158 * 1024;

__device__ __forceinline__ unsigned f2bf(float f) { unsigned u = __builtin_bit_cast(unsigned, f); return (u + 0x7fffu + ((u >> 16) & 1u)) >> 16; }
__device__ __forceinline__ unsigned pk2(float lo, float hi) { return f2bf(lo) | (f2bf(hi) << 16); }
__device__ __forceinline__ float bf2f(unsigned b) { return __builtin_bit_cast(float, b << 16); }
__device__ __forceinline__ f32x4 ld_bf4(const bf16* p) { const u32x2 w = *(const u32x2*)p; return (f32x4){bf2f(w.x & 0xffffu), bf2f(w.x >> 16), bf2f(w.y & 0xffffu), bf2f(w.y >> 16)}; }
__device__ __forceinline__ void st_bf4(bf16* p, f32x4 v) { u32x2 w; w.x = pk2(v[0], v[1]); w.y = pk2(v[2], v[3]); *(u32x2*)p = w; }
__device__ __forceinline__ float sigmoidf_(float x) { return 1.0f / (1.0f + __expf(-x)); }
__device__ __forceinline__ float siluf_(float x) { return x * sigmoidf_(x); }
__device__ __forceinline__ float gelu_tanh_(float x) { const float u = 0.7978845608028654f * (x + 0.044715f * x * x * x); return x * sigmoidf_(2.0f * u); }
__device__ __forceinline__ float softplusf_(float x) { return fmaxf(x, 0.f) + log1pf(expf(-fabsf(x))); }
template <int XM> __device__ __forceinline__ float swz_xor(float v) { return __builtin_bit_cast(float, __builtin_amdgcn_ds_swizzle(__builtin_bit_cast(int, v), (XM << 10) | 0x1f)); }
#if DBG_SHFL
__device__ __forceinline__ float half_sum(float v) {
#pragma unroll
    for (int o = 1; o < 32; o <<= 1) v += __shfl_xor(v, o);
    return v; }
__device__ __forceinline__ float wave_sum(float v) {
#pragma unroll
    for (int o = 1; o < 64; o <<= 1) v += __shfl_xor(v, o);
    return v; }
#else
__device__ __forceinline__ float half_sum(float v) { v += swz_xor<1>(v); v += swz_xor<2>(v); v += swz_xor<4>(v); v += swz_xor<8>(v); v += swz_xor<16>(v); return v; }
__device__ __forceinline__ float wave_sum(float v) {
    v = half_sum(v);
    unsigned v1 = __builtin_bit_cast(unsigned, v), v2 = v1; asm volatile("" : "+v"(v2));
    const auto r = __builtin_amdgcn_permlane32_swap(v1, v2, false, false);
    return __builtin_bit_cast(float, r[0]) + __builtin_bit_cast(float, r[1]);
}
#endif
__device__ __forceinline__ int mod_row(int row) { return row < MP ? (row >> 11) : (NBATCH + row - MP); }

struct Args { const float* in[27]; float* out; unsigned char* ws; int ph_lo, ph_hi; };
typedef const __attribute__((address_space(4))) Args CArgs;
struct Ctx { LAS unsigned char* lds; int tid, G, wg; };
namespace pg8 {
#define PG8_LAS __attribute__((address_space(3)))
typedef unsigned short bf16_t;
typedef short bf16x8 __attribute__((ext_vector_type(8)));
typedef float f32x4 __attribute__((ext_vector_type(4)));
typedef unsigned u32x4 __attribute__((ext_vector_type(4)));
constexpr int BM = 256, BK = 64, HALF = 128, HTB = HALF * BK * 2  , STAGE_BYTES = 8 * HTB, NXCD = 8, WGM = 8;

__host__ __device__ __forceinline__ int lds_byte(int r, int c) { const int st = (r >> 4) * 2 + (c >> 5), rr = r & 15, cc = c & 31, ob = rr * 64 + cc * 2; return st * 1024 + (ob ^ (((ob >> 9) & 1) << 5)); }
__host__ __device__ __forceinline__ void stage_rc(int b, int& R, int& C) { const int st = b / 1024, sb = b % 1024, swz = sb ^ (((sb >> 9) & 1) << 5); R = (st >> 1) * 16 + swz / 64; C = (st & 1) * 32 + (swz % 64) / 2; }
__host__ __device__ __forceinline__ int perm32(int rho) { const int n = rho >> 4, i = rho & 15; return 8 * (i >> 2) + 4 * n + (i & 3); }

struct Unit { int pm, pn; };
struct Gemm { const bf16_t* A; const bf16_t* Bt; int M, N, K; };

struct StaticOrder {
    int nM, nN, nwg, G, c;
    __host__ __device__ void init(int M, int N, int G_, int c_) { nM = M / BM; nN = N / BM; nwg = nM * nN; G = G_; c = c_; }
    __host__ __device__ bool next(int i, Unit& u) const {
        const long L = (long)i * G + c; if (L >= nwg) return false;
        int wgid = (int)L; { const int q = nwg / NXCD, r = nwg % NXCD, xcd = wgid % NXCD, off = wgid / NXCD; wgid = (xcd < r ? xcd * (q + 1) : r * (q + 1) + (xcd - r) * q) + off; }
        const int nig = WGM * nN, gid = wgid / nig, fm = gid * WGM, gsz = (nM - fm) < WGM ? (nM - fm) : WGM;
        u.pm = fm + ((wgid % nig) % gsz); u.pn = (wgid % nig) / gsz; return true;
    }
    __device__ __forceinline__ void a_ready(const Unit&) const {}
    __device__ __forceinline__ void done(const Unit&) const {}
};
template <class Epi, class Sched, bool ALIGN_EPI = false, bool SP2 = false>
__device__ __forceinline__ void gemm_phase(PG8_LAS unsigned char* lds, const Gemm g, const Sched& S, const Epi& E, const int tid_in) {
    const int tid = tid_in, wid = __builtin_amdgcn_readfirstlane(tid >> 6), lane = tid & 63, wr = wid >> 2, wc = wid & 3, fr = lane & 15, fq = lane >> 4;
    const int K = g.K, nt = K / BK;
    unsigned voffA[2], voffB[2];
#pragma unroll
    for (int i = 0; i < 2; ++i) { int R, C; stage_rc(tid * 16 + i * 8192, R, C); const int Rb = Epi::PERM ? ((R & ~31) + perm32(R & 31)) : R;
        voffA[i] = (unsigned)(R * K + C) * 2u; voffB[i] = (unsigned)(Rb * K + C) * 2u; }
    const size_t kstep = (size_t)(BK * 2);
    const size_t hstep = (size_t)HALF * K * 2;
    const size_t tstep = 2 * hstep;
    const unsigned ldsw = (unsigned)wid * 1024u;
    const int aoff = lds_byte(wr * 64 + fr, fq * 8), boff = lds_byte(wc * 32 + fr, fq * 8);
#define PG8_SA(b, h) (((b) * 2 + (h)) * HTB)
#define PG8_SB(b, h) ((4 + (b) * 2 + (h)) * HTB)
#define PG8_STAGE(bufoff, gbase, voff) do { _Pragma("unroll") for (int _i = 0; _i < 2; ++_i) \
        __builtin_amdgcn_global_load_lds((const unsigned*)((const char*)(gbase) + (voff)[_i]), (PG8_LAS unsigned*)(lds + (bufoff) + ldsw + _i * 8192), 16, 0, 0); } while (0)
#define PG8_LDA(dst, b, h) do { _Pragma("unroll") for (int m = 0; m < 4; ++m) _Pragma("unroll") for (int k = 0; k < 2; ++k) dst[m][k] = *(const PG8_LAS bf16x8*)(lds + PG8_SA(b, h) + aoff + m * 2048 + k * 1024); } while (0)
#define PG8_LDB(dst, b, h) do { _Pragma("unroll") for (int n = 0; n < 2; ++n) _Pragma("unroll") for (int k = 0; k < 2; ++k) dst[n][k] = *(const PG8_LAS bf16x8*)(lds + PG8_SB(b, h) + boff + n * 2048 + k * 1024); } while (0)
#define PG8_MMA(ai, bj, At, Bt) do { __builtin_amdgcn_s_setprio(1); _Pragma("unroll") for (int m = 0; m < 4; ++m) _Pragma("unroll") for (int n = 0; n < 2; ++n) _Pragma("unroll") for (int k = 0; k < 2; ++k) \
        acc[ai][bj][m][n] = __builtin_amdgcn_mfma_f32_16x16x32_bf16(Bt[n][k], At[m][k], acc[ai][bj][m][n], 0, 0, 0); __builtin_amdgcn_s_setprio(0); } while (0)
#define PG8_WAIT_V(n) asm volatile("s_waitcnt vmcnt(" #n ")" ::: "memory")
#define PG8_WAIT_L(n) asm volatile("s_waitcnt lgkmcnt(" #n ")" ::: "memory")
#define PG8_BAR __builtin_amdgcn_s_barrier()
#define PG8_SCHED __builtin_amdgcn_sched_barrier(0)
    Unit cur, nxt; int ui = 0;
    if (!S.next(0, cur)) return;
    f32x4 acc[2][2][4][2];
#pragma unroll
    for (int a = 0; a < 2; ++a)
#pragma unroll
        for (int b = 0; b < 2; ++b)
#pragma unroll
            for (int m = 0; m < 4; ++m)
#pragma unroll
                for (int n = 0; n < 2; ++n) acc[a][b][m][n] = (f32x4){0.f, 0.f, 0.f, 0.f};
    bf16x8 At[4][2], B0[2][2], B1[2][2];
    const char* cA = (const char*)g.A + (size_t)cur.pm * tstep; const char* cB = (const char*)g.Bt + (size_t)cur.pn * tstep;
    S.a_ready(cur);
    if constexpr (SP2) {
        PG8_STAGE(PG8_SB(0, 0), cB, voffB); PG8_STAGE(PG8_SB(0, 1), cB + hstep, voffB); PG8_STAGE(PG8_SA(0, 0), cA, voffA); PG8_STAGE(PG8_SA(0, 1), cA + hstep, voffA);
        if (wr == 1) PG8_BAR;
        PG8_WAIT_V(2); PG8_BAR;
        PG8_STAGE(PG8_SB(1, 0), cB + kstep, voffB); PG8_STAGE(PG8_SA(1, 0), cA + kstep, voffA); PG8_STAGE(PG8_SB(1, 1), cB + hstep + kstep, voffB);
        PG8_WAIT_V(6); PG8_BAR;
    } else {
        PG8_STAGE(PG8_SB(0, 0), cB, voffB); PG8_STAGE(PG8_SA(0, 0), cA, voffA); PG8_STAGE(PG8_SB(0, 1), cB + hstep, voffB); PG8_STAGE(PG8_SA(0, 1), cA + hstep, voffA);
        if (wr == 1) PG8_BAR;
        PG8_WAIT_V(4); PG8_BAR;
        PG8_STAGE(PG8_SB(1, 0), cB + kstep, voffB); PG8_STAGE(PG8_SA(1, 0), cA + kstep, voffA); PG8_STAGE(PG8_SB(1, 1), cB + hstep + kstep, voffB);
        PG8_WAIT_V(6); PG8_BAR;
    }
    for (;;) {
        const bool has_next = S.next(ui + 1, nxt);
        const char* nA = has_next ? (const char*)g.A + (size_t)nxt.pm * tstep : cA; const char* nB = has_next ? (const char*)g.Bt + (size_t)nxt.pn * tstep : cB;
        for (int t = 0; t < nt; t += 2) {
            const bool last = (t == nt - 2);
            const char* a1 = cA + (size_t)(t + 1) * kstep;
            const char* a2 = last ? nA : cA + (size_t)(t + 2) * kstep; const char* b2 = last ? nB : cB + (size_t)(t + 2) * kstep;
            const char* a3 = a2 + kstep; const char* b3 = b2 + kstep;
            if (last && has_next) S.a_ready(nxt);
            if constexpr (SP2) {
            PG8_LDB(B0, 0, 0); PG8_LDB(B1, 0, 1); PG8_SCHED; PG8_LDA(At, 0, 0); PG8_STAGE(PG8_SA(1, 1), a1 + hstep, voffA);
            PG8_WAIT_V(8); PG8_WAIT_L(0); PG8_BAR; PG8_MMA(0, 0, At, B0); PG8_MMA(0, 1, At, B1); PG8_BAR; PG8_SCHED;
            PG8_LDA(At, 0, 1); PG8_STAGE(PG8_SB(0, 0), b2, voffB); PG8_STAGE(PG8_SB(0, 1), b2 + hstep, voffB); PG8_STAGE(PG8_SA(0, 0), a2, voffA);
            PG8_WAIT_V(8); PG8_WAIT_L(0); PG8_BAR; PG8_MMA(1, 0, At, B0); PG8_MMA(1, 1, At, B1); PG8_BAR; PG8_SCHED;
            PG8_LDB(B0, 1, 0); PG8_LDB(B1, 1, 1); PG8_SCHED; PG8_LDA(At, 1, 0); PG8_STAGE(PG8_SA(0, 1), a2 + hstep, voffA);
            PG8_WAIT_V(8); PG8_WAIT_L(0); PG8_BAR; PG8_MMA(0, 0, At, B0); PG8_MMA(0, 1, At, B1); PG8_BAR; PG8_SCHED;
            PG8_LDA(At, 1, 1); PG8_STAGE(PG8_SB(1, 0), b3, voffB); PG8_STAGE(PG8_SB(1, 1), b3 + hstep, voffB); PG8_STAGE(PG8_SA(1, 0), a3, voffA);
            PG8_WAIT_V(8); PG8_WAIT_L(0); PG8_BAR; PG8_MMA(1, 0, At, B0); PG8_MMA(1, 1, At, B1); PG8_BAR; PG8_SCHED;
            } else {
            PG8_LDB(B0, 0, 0); PG8_SCHED; PG8_LDA(At, 0, 0); PG8_STAGE(PG8_SA(1, 1), a1 + hstep, voffA);
            PG8_WAIT_L(8); PG8_BAR; PG8_WAIT_L(0); PG8_MMA(0, 0, At, B0); PG8_BAR; PG8_SCHED;
            PG8_LDB(B1, 0, 1); PG8_STAGE(PG8_SB(0, 0), b2, voffB);
            PG8_BAR; PG8_WAIT_L(0); PG8_MMA(0, 1, At, B1); PG8_BAR;
            PG8_LDA(At, 0, 1); PG8_STAGE(PG8_SA(0, 0), a2, voffA);
            PG8_BAR; PG8_WAIT_L(0); PG8_MMA(1, 0, At, B0); PG8_BAR; PG8_SCHED;
            PG8_STAGE(PG8_SB(0, 1), b2 + hstep, voffB);
            PG8_WAIT_V(6); PG8_BAR; PG8_MMA(1, 1, At, B1); PG8_BAR;
            PG8_LDB(B0, 1, 0); PG8_SCHED; PG8_LDA(At, 1, 0); PG8_STAGE(PG8_SA(0, 1), a2 + hstep, voffA);
            PG8_WAIT_L(8); PG8_BAR; PG8_WAIT_L(0); PG8_MMA(0, 0, At, B0); PG8_BAR; PG8_SCHED;
            PG8_LDB(B1, 1, 1); PG8_STAGE(PG8_SB(1, 0), b3, voffB);
            PG8_BAR; PG8_WAIT_L(0); PG8_MMA(0, 1, At, B1); PG8_BAR;
            PG8_LDA(At, 1, 1); PG8_STAGE(PG8_SA(1, 0), a3, voffA);
            PG8_BAR; PG8_WAIT_L(0); PG8_MMA(1, 0, At, B0); PG8_BAR; PG8_SCHED;
            PG8_STAGE(PG8_SB(1, 1), b3 + hstep, voffB);
            PG8_WAIT_V(6); PG8_BAR; PG8_MMA(1, 1, At, B1); PG8_BAR;
            }
        }
        if constexpr (ALIGN_EPI) { if (wr == 0) PG8_BAR; }
        if constexpr (!Epi::AFTER_DRAIN) { int l2 = (int)__builtin_amdgcn_mbcnt_hi(~0u, __builtin_amdgcn_mbcnt_lo(~0u, 0u)); asm volatile("" : "+v"(l2));
            E(acc, cur, wr, wc, l2 & 15, l2 >> 4); S.done(cur); }
        if (!has_next) break;
#pragma unroll
        for (int a = 0; a < 2; ++a)
#pragma unroll
            for (int b = 0; b < 2; ++b)
#pragma unroll
                for (int m = 0; m < 4; ++m)
#pragma unroll
                    for (int n = 0; n < 2; ++n) acc[a][b][m][n] = (f32x4){0.f, 0.f, 0.f, 0.f};
        cur = nxt; cA = nA; cB = nB; ++ui;
        if constexpr (ALIGN_EPI) { if (wr == 1) PG8_BAR; }
    }
    PG8_WAIT_V(0);
    if constexpr (!ALIGN_EPI) { if (wr == 0) PG8_BAR; }
    PG8_BAR;
    if constexpr (Epi::AFTER_DRAIN) { E.fused(acc, cur, wr, wc, fr, fq, lds, wid, lane); S.done(cur); }
#undef PG8_SA
#undef PG8_SB
#undef PG8_STAGE
#undef PG8_LDA
#undef PG8_LDB
#undef PG8_MMA
#undef PG8_WAIT_V
#undef PG8_WAIT_L
#undef PG8_BAR
#undef PG8_SCHED
}
}

template <class E> struct QuadEpi {
    static constexpr bool PERM = false, AFTER_DRAIN = false;
    E e;
    __device__ __forceinline__ void operator()(const f32x4 (&acc)[2][2][4][2], const pg8::Unit& u, int wr, int wc, int fr, int fq) const {
        const int row0 = u.pm * 256 + wr * 64 + fr, col0 = u.pn * 256 + wc * 32 + 4 * fq;
#pragma unroll
        for (int ai = 0; ai < 2; ++ai)
#pragma unroll
            for (int m = 0; m < 4; ++m)
#pragma unroll
                for (int bj = 0; bj < 2; ++bj)
#pragma unroll
                    for (int n = 0; n < 2; ++n) e.quad(row0 + ai * 128 + m * 16, col0 + bj * 128 + n * 16, acc[ai][bj][m][n]);
    }
};

struct EpiIn {
    bf16 *Q, *Kb, *V, *OG, *XB, *YG, *SGA, *SGB; float* LOGF; const float* lbt;
    static constexpr bool BY_REGION = true;
    template <int R> __device__ __forceinline__ void quadR(int row, int cc, f32x4 v) const {
        const size_t o = (size_t)row * D + cc;
        f32x4 r;
        if constexpr (R == 0 || R == 3) {
#pragma unroll
            for (int j = 0; j < 4; ++j) r[j] = siluf_(v[j]);
            st_bf4((R == 0 ? Q : OG) + o, r);
        } else if constexpr (R == 1) {
            const f32x4 lb = *(const f32x4*)(lbt + cc), llb = *(const f32x4*)(lbt + 1024 + cc), l1m = *(const f32x4*)(lbt + 2048 + cc);
            f32x4 lf;
#pragma unroll
            for (int j = 0; j < 4; ++j) {
                const float fa = v[j];
                const float t = __expf(-fabsf(fa));
                const float ls = fminf(fa, 0.f) - __logf(1.0f + t);
                const float b = l1m[j] + ls, a_ = llb[j], mx = fmaxf(a_, b);
                lf[j] = mx + __logf(1.0f + __expf(-fabsf(a_ - b)));
                const float sneg = (fa >= 0.f ? t : 1.0f) / (1.0f + t);
                r[j] = (1.0f - lb[j]) * sneg;
            }
            *(f32x4*)(LOGF + o) = lf; st_bf4(Kb + o, r);
        } else if constexpr (R == 2 || R == 4) { st_bf4((R == 2 ? V : XB) + o, v);
        } else if constexpr (R == 5) {
#pragma unroll
            for (int j = 0; j < 4; ++j) r[j] = gelu_tanh_(v[j]);
            st_bf4(YG + o, r);
        } else {
#pragma unroll
            for (int j = 0; j < 4; ++j) r[j] = sigmoidf_(v[j]);
            st_bf4((R == 6 ? SGA : SGB) + o, r);
        }
    }
    __device__ __forceinline__ void quad(int row, int col, f32x4 v) const {
        const int reg = col >> 10, cc = col & 1023;
        switch (reg) { case 0: quadR<0>(row, cc, v); break; case 1: quadR<1>(row, cc, v); break; case 2: quadR<2>(row, cc, v); break; case 3: quadR<3>(row, cc, v); break;
                       case 4: quadR<4>(row, cc, v); break; case 5: quadR<5>(row, cc, v); break; case 6: quadR<6>(row, cc, v); break; default: quadR<7>(row, cc, v); break; }
    }
};
struct EpiInUnit {
    static constexpr bool PERM = false, AFTER_DRAIN = false;
    EpiIn e;
    template <int R> __device__ __forceinline__ void run(const f32x4 (&acc)[2][2][4][2], int row0, int cc0) const {
#pragma unroll
        for (int ai = 0; ai < 2; ++ai)
#pragma unroll
            for (int m = 0; m < 4; ++m) {
#pragma unroll
                for (int bj = 0; bj < 2; ++bj)
#pragma unroll
                    for (int n = 0; n < 2; ++n) e.quadR<R>(row0 + ai * 128 + m * 16, cc0 + bj * 128 + n * 16, acc[ai][bj][m][n]);
                asm volatile("" ::: "memory"); }
    }
    __device__ __forceinline__ void operator()(const f32x4 (&acc)[2][2][4][2], const pg8::Unit& u, int wr, int wc, int fr, int fq) const {
        const int row0 = u.pm * 256 + wr * 64 + fr, cc0 = (u.pn & 3) * 256 + wc * 32 + 4 * fq;
        switch (u.pn >> 2) { case 0: run<0>(acc, row0, cc0); break; case 1: run<1>(acc, row0, cc0); break; case 2: run<2>(acc, row0, cc0); break; case 3: run<3>(acc, row0, cc0); break;
                             case 4: run<4>(acc, row0, cc0); break; case 5: run<5>(acc, row0, cc0); break; case 6: run<6>(acc, row0, cc0); break; default: run<7>(acc, row0, cc0); break; }
    }
};
struct EpiBrA { static constexpr bool BY_REGION = false; const bf16* SGA; float* T;
    __device__ __forceinline__ void quad(int row, int col, f32x4 v) const { const size_t o = (size_t)row * D + col; *(f32x4*)(T + o) = ld_bf4(SGA + o) * v; } };
struct EpiBrB { static constexpr bool BY_REGION = false; const bf16* SGB; const float* T; bf16* MG;
    __device__ __forceinline__ void quad(int row, int col, f32x4 v) const { const size_t o = (size_t)row * D + col; st_bf4(MG + o, *(const f32x4*)(T + o) + ld_bf4(SGB + o) * v); } };
struct EpiRes { static constexpr bool BY_REGION = false; const float* xp; const float* xs; float* X; const float* modl; int gi;
    __device__ __forceinline__ void quad(int row, int col, f32x4 v) const {
        if (row >= MR) return;
        const float* src = row < MP ? xp + (size_t)row * D : xs + (size_t)(row - MP) * D;
        const f32x4 g = *(const f32x4*)(modl + (size_t)mod_row(row) * 6144 + gi * 1024 + col);
        *(f32x4*)(X + (size_t)row * D + col) = *(const f32x4*)(src + col) + g * v;
    } };
struct EpiFF1 { static constexpr bool BY_REGION = false; bf16* HM;
    __device__ __forceinline__ void quad(int row, int col, f32x4 v) const {
        f32x4 r;
#pragma unroll
        for (int j = 0; j < 4; ++j) { const float t = fmaxf(v[j], 0.f); r[j] = t * t; }
        st_bf4(HM + (size_t)row * FF + col, r);
    } };

template <class E>
__device__ __forceinline__ void naive_gemm_phase(Ctx& c, const bf16* A, const bf16* Bt, int M, int N, int K, const E& e) {
    LAS float* As = (LAS float*)c.lds;
    LAS float* Bs = As + 32 * 132;
    const int ntm = M / 128, ntn = N / 128, tx = c.tid & 31, ty = c.tid >> 5;
    const int lr = c.tid >> 2, lk = (c.tid & 3) * 8;
    for (int tile = c.wg; tile < ntm * ntn; tile += c.G) {
        const int tm = tile % ntm, tn = tile / ntm;
        f32x4 acc[8];
#pragma unroll
        for (int i = 0; i < 8; ++i) acc[i] = (f32x4){0.f, 0.f, 0.f, 0.f};
        for (int k0 = 0; k0 < K; k0 += 32) {
            const u32x4 av = *(const u32x4*)(A + (size_t)(tm * 128 + lr) * K + k0 + lk);
            const u32x4 bv = *(const u32x4*)(Bt + (size_t)(tn * 128 + lr) * K + k0 + lk);
            __syncthreads();
#pragma unroll
            for (int j = 0; j < 4; ++j) {
                As[(lk + 2 * j) * 132 + lr] = bf2f(av[j] & 0xffffu); As[(lk + 2 * j + 1) * 132 + lr] = bf2f(av[j] >> 16);
                Bs[(lk + 2 * j) * 132 + lr] = bf2f(bv[j] & 0xffffu); Bs[(lk + 2 * j + 1) * 132 + lr] = bf2f(bv[j] >> 16);
            }
            __syncthreads();
#pragma unroll 8
            for (int k = 0; k < 32; ++k) {
                const f32x4 a0 = *(const LAS f32x4*)(As + k * 132 + ty * 8), a1 = *(const LAS f32x4*)(As + k * 132 + ty * 8 + 4);
                const f32x4 b = *(const LAS f32x4*)(Bs + k * 132 + tx * 4);
                acc[0] += a0[0] * b; acc[1] += a0[1] * b; acc[2] += a0[2] * b; acc[3] += a0[3] * b;
                acc[4] += a1[0] * b; acc[5] += a1[1] * b; acc[6] += a1[2] * b; acc[7] += a1[3] * b;
            }
        }
#pragma unroll
        for (int i = 0; i < 8; ++i) e.quad(tm * 128 + ty * 8 + i, tn * 128 + tx * 4, acc[i]);
    }
    __syncthreads();
}

template <int SITE, class E>
__device__ __forceinline__ void gemm_phase_sel(Ctx& c, const bf16* A, const bf16* Bt, int M, int N, int K, const E& e) {
    if constexpr ((FAST_GEMM >> SITE) & 1) {
        pg8::Gemm g{A, Bt, M, N, K}; pg8::StaticOrder S; S.init(M, N, c.G, c.wg);
        if constexpr (E::BY_REGION) { EpiInUnit qe{e}; pg8::gemm_phase<EpiInUnit, pg8::StaticOrder, true, true>(c.lds, g, S, qe, c.tid); }
        else { QuadEpi<E> qe{e}; pg8::gemm_phase<QuadEpi<E>, pg8::StaticOrder, true, true>(c.lds, g, S, qe, c.tid); }
    } else naive_gemm_phase(c, A, Bt, M, N, K, e);
}

#define XB_TMO      128
#define XB_XCNT(j)  (256  + 64 * (j))
#define XB_XSUB(j)  (1280 + 64 * (j))
#define XB_XGEN(j)  (2304 + 64 * (j))
#define XB_TOP      3328
#define XB_TOPGEN   3392
#define XCD_BAR_WORDS 3456
#define XB_SPIN_CAP (1u << 18)
__device__ __forceinline__ unsigned xb_ld(unsigned* p)              { return __hip_atomic_load(p, __ATOMIC_RELAXED, __HIP_MEMORY_SCOPE_AGENT); }
__device__ __forceinline__ unsigned xb_add(unsigned* p, unsigned v) { return __hip_atomic_fetch_add(p, v, __ATOMIC_RELAXED, __HIP_MEMORY_SCOPE_AGENT); }
__device__ __forceinline__ unsigned xb_xcc_id() { return (unsigned)__builtin_amdgcn_s_getreg((3 << 11) | 20) & 0xFu; }
#define XB_SPIN(cond, bar) do { unsigned _sp = 0; while (cond) { __builtin_amdgcn_s_sleep(1); \
    if ((++_sp & 255u) == 0u) { if (xb_ld(&(bar)[XB_TMO])) break; if (_sp > XB_SPIN_CAP) { atomicAdd(&(bar)[XB_TMO], 1u); break; } } } } while (0)
struct XcdBarrier { unsigned* bar; unsigned x; volatile LAS unsigned* st; };
__device__ __forceinline__ XcdBarrier xcd_barrier_post(unsigned* bar, volatile LAS unsigned* st) {
    XcdBarrier b; b.bar = bar; b.x = xb_xcc_id(); b.st = st;
    if (threadIdx.x == 0) (void)xb_add(&bar[XB_XCNT(b.x)], 1u);
    return b;
}
__device__ __forceinline__ void xcd_barrier_complete(unsigned* bar, unsigned x, unsigned& nloc, unsigned& nx) {
    const unsigned G = gridDim.x * gridDim.y * gridDim.z;
    unsigned sum, cnt, mine, sp = 0u;
    for (;;) {
        sum = 0u; cnt = 0u; mine = 0u;
#pragma unroll
        for (unsigned j = 0; j < 16; ++j) { const unsigned c = xb_ld(&bar[XB_XCNT(j)]); sum += c; cnt += (c > 0u) ? 1u : 0u; mine = (j == x) ? c : mine; }
        if (sum == G) break;
        __builtin_amdgcn_s_sleep(1);
        if ((++sp & 255u) == 0u) { if (xb_ld(&bar[XB_TMO])) break; if (sp > XB_SPIN_CAP) { atomicAdd(&bar[XB_TMO], 1u); break; } }
    }
    nloc = mine > 0u ? mine : 1u; nx = cnt > 0u ? cnt : 1u;
}
__device__ __forceinline__ void xcd_barrier(const XcdBarrier& b) {
    asm volatile("s_waitcnt vmcnt(0)" ::: "memory");
    __syncthreads();
    if (threadIdx.x == 0) {
        unsigned* bar = b.bar; asm volatile("" : "+s"(bar));
        __builtin_amdgcn_s_waitcnt(0);
        unsigned nloc = b.st[0], nx = b.st[1];
        if (nloc == 0u) { xcd_barrier_complete(bar, b.x, nloc, nx); b.st[0] = nloc; b.st[1] = nx; }
        const unsigned old = xb_add(&bar[XB_XSUB(b.x)], 1u);
        const unsigned gen = old / nloc;
        if (old + 1u == (gen + 1u) * nloc) {
            __builtin_amdgcn_fence(__ATOMIC_RELEASE, "agent");
            asm volatile("s_waitcnt vmcnt(0)" ::: "memory");
            const unsigned og = xb_add(&bar[XB_TOP], 1u);
            const unsigned tg = og / nx;
            if (og + 1u == (tg + 1u) * nx) xb_add(&bar[XB_TOPGEN], 1u);
            else XB_SPIN(xb_ld(&bar[XB_TOPGEN]) == tg, bar);
            __builtin_amdgcn_fence(__ATOMIC_ACQUIRE, "agent");
            xb_add(&bar[XB_XGEN(b.x)], 1u);
            asm volatile("s_waitcnt vmcnt(0)" ::: "memory");
        } else {
            XB_SPIN(xb_ld(&bar[XB_XGEN(b.x)]) == gen, bar);
            __builtin_amdgcn_fence(__ATOMIC_ACQUIRE, "agent");
            asm volatile("s_waitcnt vmcnt(0)" ::: "memory");
        }
    }
    __syncthreads();
}

__device__ __forceinline__ void p0_transpose_item(const float* W, int K, int N, bf16* WT, LAS float* scr, int item, int lane) {
    const int nblk = N / 32, kb = item / nblk, nb = item % nblk, k0 = 64 * kb, n0 = 32 * nb;
#pragma unroll 8
    for (int i = 0; i < 32; ++i) { const int kk = 2 * i + (lane >> 5); scr[kk * 33 + (lane & 31)] = W[(size_t)(k0 + kk) * N + n0 + (lane & 31)]; }
    asm volatile("s_waitcnt lgkmcnt(0)" ::: "memory");
    const int ch = lane & 7;
#pragma unroll
    for (int j = 0; j < 4; ++j) { const int n = (lane >> 3) + 8 * j; const LAS float* s = scr + (8 * ch) * 33 + n;
        u32x4 o; o.x = pk2(s[0 * 33], s[1 * 33]); o.y = pk2(s[2 * 33], s[3 * 33]); o.z = pk2(s[4 * 33], s[5 * 33]); o.w = pk2(s[6 * 33], s[7 * 33]);
        *(u32x4*)(WT + (size_t)(n0 + n) * K + k0 + 8 * ch) = o; }
    asm volatile("s_waitcnt lgkmcnt(0)" ::: "memory");
}
__device__ __forceinline__ void p0_prologue(CArgs& a, Ctx& c) {
    {
        LAS float* scr = (LAS float*)(c.lds + __builtin_amdgcn_readfirstlane(c.tid >> 6) * 16384);
        const int gw = c.wg * 8 + __builtin_amdgcn_readfirstlane(c.tid >> 6), NGW = c.G * 8;
        constexpr int I_IN = 16 * 256, I_SQ = 16 * 32, I_1 = 16 * 128, I_2 = 64 * 32, I_L = 8 * 8, PER_L = I_IN + 3 * I_SQ + I_1 + I_2 + 2 * I_L;
        for (int it = gw; it < 2 * PER_L; it += NGW) {
            const int l = it / PER_L; int r = it % PER_L; bf16* wl = (bf16*)(a.ws + WS_W + (size_t)l * WL_STRIDE);
            if (r < I_IN) { p0_transpose_item(a.in[11] + (size_t)l * D * NIN, D, NIN, wl + OFF_WIN / 2, scr, r, (c.tid & 63)); continue; } r -= I_IN;
            if (r < I_SQ) { p0_transpose_item(a.in[21] + (size_t)l * D * D, D, D, wl + OFF_WA / 2, scr, r, (c.tid & 63)); continue; } r -= I_SQ;
            if (r < I_SQ) { p0_transpose_item(a.in[22] + (size_t)l * D * D, D, D, wl + OFF_WB / 2, scr, r, (c.tid & 63)); continue; } r -= I_SQ;
            if (r < I_SQ) { p0_transpose_item(a.in[23] + (size_t)l * D * D, D, D, wl + OFF_WO / 2, scr, r, (c.tid & 63)); continue; } r -= I_SQ;
            if (r < I_1) { p0_transpose_item(a.in[24] + (size_t)l * D * FF, D, FF, wl + OFF_W1 / 2, scr, r, (c.tid & 63)); continue; } r -= I_1;
            if (r < I_2) { p0_transpose_item(a.in[25] + (size_t)l * FF * D, FF, D, wl + OFF_W2 / 2, scr, r, (c.tid & 63)); continue; } r -= I_2;
            if (r < I_L) { const int n = r >> 3; p0_transpose_item(a.in[16] + ((size_t)l * 8 + n) * 16384, 128, 128, wl + OFF_LWA / 2 + n * 16384, scr, r & 7, (c.tid & 63)); continue; } r -= I_L;
            { const int n = r >> 3; p0_transpose_item(a.in[18] + ((size_t)l * 8 + n) * 16384, 128, 128, wl + OFF_LWX / 2 + n * 16384, scr, r & 7, (c.tid & 63)); }
        }
    }
    {
        float* lbt = (float*)(a.ws + WS_TAB); float* sp = (float*)(a.ws + WS_TAB + 32768);
        const int gid = c.wg * 512 + c.tid;
        if (gid < 2 * D) {
            const int l = gid >> 10, col = gid & 1023;
            const float h0 = a.in[12][col], h1 = a.in[12][D + col];
            const float p1 = 1.0f / (1.0f + expf(h0 - h1));
            const float lb = l == 0 ? 0.f : p1;
            lbt[(l * 3 + 0) * D + col] = lb; lbt[(l * 3 + 1) * D + col] = logf(fmaxf(lb, 1e-30f)); lbt[(l * 3 + 2) * D + col] = log1pf(-lb);
            sp[l * D + col] = softplusf_(-a.in[20][l * D + col]);
        }
    }
    __syncthreads();
    {
        LAS float* cs = (LAS float*)c.lds;
        float* MOD = (float*)(a.ws + WS_MOD);
        const int cq = c.tid & 15, rq = c.tid >> 4;
        for (int item = c.wg; item < 2 * 96; item += c.G) {
            const int l = item / 96, cg = item % 96;
            const float* W = a.in[7] + (size_t)l * D * 6144 + cg * 64 + 4 * cq;
            f32x4 acc[5];
#pragma unroll
            for (int i = 0; i < 5; ++i) acc[i] = (f32x4){0.f, 0.f, 0.f, 0.f};
            for (int k0 = 0; k0 < D; k0 += 128) {
                __syncthreads();
                for (int e = c.tid; e < 160 * 128; e += 512) { const int r = e >> 7, kk = e & 127;
                    float cv = 0.f;
                    if (r < NBATCH) cv = a.in[5][(size_t)r * D + k0 + kk]; else if (r < NMOD) cv = a.in[6][(size_t)(r - NBATCH) * D + k0 + kk];
                    cs[r * 132 + kk] = siluf_(cv); }
                __syncthreads();
#pragma unroll 2
                for (int kk = 0; kk < 128; kk += 4) {
                    const float* wp = W + (size_t)(k0 + kk) * 6144;
                    const f32x4 w0 = *(const f32x4*)wp, w1 = *(const f32x4*)(wp + 6144), w2 = *(const f32x4*)(wp + 2 * 6144), w3 = *(const f32x4*)(wp + 3 * 6144);
#pragma unroll
                    for (int i = 0; i < 5; ++i) { const f32x4 x = *(const LAS f32x4*)(cs + (5 * rq + i) * 132 + kk);
                        acc[i] += x[0] * w0 + x[1] * w1 + x[2] * w2 + x[3] * w3; }
                }
            }
            const f32x4 bm = *(const f32x4*)(a.in[8] + (size_t)l * 6144 + cg * 64 + 4 * cq);
#pragma unroll
            for (int i = 0; i < 5; ++i) { const int row = 5 * rq + i; if (row < NMOD) *(f32x4*)(MOD + ((size_t)l * NMOD + row) * 6144 + cg * 64 + 4 * cq) = acc[i] + bm; }
        }
    }
    __syncthreads();
}

__device__ __forceinline__ void norm_phase(CArgs& a, Ctx& c, int l, int which, const float* xp, const float* xs) {
    const int gw = c.wg * 8 + __builtin_amdgcn_readfirstlane(c.tid >> 6), NGW = c.G * 8;
    bf16* H = (bf16*)(a.ws + WS_H);
    const float* MODL = (const float*)(a.ws + WS_MOD) + (size_t)l * NMOD * 6144;
    const float* g = a.in[which ? 10 : 9] + (size_t)l * D;
    for (int row = gw; row < MR; row += NGW) {
        const float* xr = row < MP ? xp + (size_t)row * D : xs + (size_t)(row - MP) * D;
        const float* md = MODL + (size_t)mod_row(row) * 6144 + (which ? 3 : 0) * 1024;
        f32x4 v[4]; float ss = 0.f;
#pragma unroll
        for (int j = 0; j < 4; ++j) { v[j] = *(const f32x4*)(xr + 4 * (c.tid & 63) + 256 * j); ss += (v[j][0] * v[j][0] + v[j][1] * v[j][1]) + (v[j][2] * v[j][2] + v[j][3] * v[j][3]); }
        const float rstd = 1.0f / sqrtf(wave_sum(ss) * (1.0f / D) + EPS);
#pragma unroll
        for (int j = 0; j < 4; ++j) { const int cc = 4 * (c.tid & 63) + 256 * j;
            const f32x4 gg = *(const f32x4*)(g + cc), sh = *(const f32x4*)(md + cc), sc = *(const f32x4*)(md + 1024 + cc);
            st_bf4(H + (size_t)row * D + cc, v[j] * rstd * gg * (1.0f + sc) + sh); }
    }
}
__device__ __forceinline__ void final_norm_phase(CArgs& a, Ctx& c) {
    const int gw = c.wg * 8 + __builtin_amdgcn_readfirstlane(c.tid >> 6), NGW = c.G * 8;
    const float* g = a.in[26];
    for (int row = gw; row < MR; row += NGW) {
        float* xr = a.out + (size_t)row * D;
        f32x4 v[4]; float ss = 0.f;
#pragma unroll
        for (int j = 0; j < 4; ++j) { v[j] = *(const f32x4*)(xr + 4 * (c.tid & 63) + 256 * j); ss += (v[j][0] * v[j][0] + v[j][1] * v[j][1]) + (v[j][2] * v[j][2] + v[j][3] * v[j][3]); }
        const float rstd = 1.0f / sqrtf(wave_sum(ss) * (1.0f / D) + EPS);
#pragma unroll
        for (int j = 0; j < 4; ++j) { const int cc = 4 * (c.tid & 63) + 256 * j; *(f32x4*)(xr + cc) = v[j] * rstd * *(const f32x4*)(g + cc); }
    }
}

__device__ __forceinline__ void hgrn_naive(CArgs& a, Ctx& c, int l, int row0, int ntok, int h, const float* S0, float* Sout) {
    LAS float* fs = (LAS float*)c.lds;
    LAS float* ks = fs + 2048;
    LAS float* qs = ks + 2048;
    LAS float* vs = qs + 2048;
    LAS float* part = vs + 2048;
    const bf16* Q = (const bf16*)(a.ws + WS_Q); const bf16* Kb = (const bf16*)(a.ws + WS_K); const bf16* V = (const bf16*)(a.ws + WS_V); const bf16* OG = (const bf16*)(a.ws + WS_OG); bf16* OA = (bf16*)(a.ws + WS_OA);
    const float* LOGF = (const float*)(a.ws + WS_LOGF);
    const float* hg = a.in[13] + (size_t)l * DKV;
    const int v = c.tid & 127, kg = c.tid >> 7;
    float S[32];
#pragma unroll
    for (int i = 0; i < 32; ++i) S[i] = S0 ? S0[(size_t)(32 * kg + i) * DKV + v] : 0.f;
    for (int t0 = 0; t0 < ntok; t0 += 16) {
        const int nt = (ntok - t0) < 16 ? (ntok - t0) : 16;
        __syncthreads();
        { const int tt = c.tid >> 5, k4 = (c.tid & 31) * 4;
          if (tt < nt) { const size_t off = (size_t)(row0 + t0 + tt) * D + h * DKV + k4;
              const f32x4 lf = *(const f32x4*)(LOGF + off);
              *(LAS f32x4*)(fs + tt * 128 + k4) = (f32x4){expf(lf[0]), expf(lf[1]), expf(lf[2]), expf(lf[3])};
              *(LAS f32x4*)(ks + tt * 128 + k4) = ld_bf4(Kb + off);
              *(LAS f32x4*)(qs + tt * 128 + k4) = ld_bf4(Q + off);
              *(LAS f32x4*)(vs + tt * 128 + k4) = ld_bf4(V + off); } }
        __syncthreads();
        for (int tt = 0; tt < nt; ++tt) {
            const float vv = vs[tt * 128 + v]; float acc = 0.f;
#pragma unroll
            for (int i4 = 0; i4 < 8; ++i4) {
                const f32x4 f = *(const LAS f32x4*)(fs + tt * 128 + 32 * kg + 4 * i4), kk = *(const LAS f32x4*)(ks + tt * 128 + 32 * kg + 4 * i4), qq = *(const LAS f32x4*)(qs + tt * 128 + 32 * kg + 4 * i4);
#pragma unroll
                for (int j = 0; j < 4; ++j) { S[4 * i4 + j] = f[j] * S[4 * i4 + j] + kk[j] * vv; acc += S[4 * i4 + j] * qq[j]; }
            }
            part[(tt * 4 + kg) * 128 + v] = acc;
        }
        __syncthreads();
        { const int tt = c.tid >> 5, v4 = (c.tid & 31) * 4; const int tc = tt < nt ? tt : 0;
          const f32x4 o = *(const LAS f32x4*)(part + (tc * 4 + 0) * 128 + v4) + *(const LAS f32x4*)(part + (tc * 4 + 1) * 128 + v4)
                        + *(const LAS f32x4*)(part + (tc * 4 + 2) * 128 + v4) + *(const LAS f32x4*)(part + (tc * 4 + 3) * 128 + v4);
          float ss = (o[0] * o[0] + o[1] * o[1]) + (o[2] * o[2] + o[3] * o[3]);
          ss = half_sum(ss);
          const float rstd = 1.0f / sqrtf(ss * (1.0f / DKV) + EPS);
          if (tt < nt) { const size_t off = (size_t)(row0 + t0 + tt) * D + h * DKV + v4;
              st_bf4(OA + off, o * rstd * *(const f32x4*)(hg + v4) * ld_bf4(OG + off)); } }
    }
#pragma unroll
    for (int i = 0; i < 32; ++i) Sout[(size_t)(32 * kg + i) * DKV + v] = S[i];
    __syncthreads();
}

constexpr int L_XBS = 0, L_XC = 67 * 128, L_AS = L_XC + 8192, L_BS = L_AS + 8192, L_SEG = L_BS + 8192, L_CARRY = L_SEG + 1024;
constexpr int LB_XCB = (L_CARRY + 128) * 4, XCB_STRIDE = 272;
static_assert(LB_XCB + 64 * XCB_STRIDE <= MISC_OFF && LB_XCB % 16 == 0, "lru lds");
__device__ __forceinline__ void lru_gates_naive(CArgs& a, Ctx& c, int l, int n) {
    LAS float* XC = (LAS float*)c.lds + L_XC; LAS float* As = (LAS float*)c.lds + L_AS; LAS float* Bs = (LAS float*)c.lds + L_BS;
    const bf16* wl = (const bf16*)(a.ws + WS_W + (size_t)l * WL_STRIDE);
    const int e = c.tid & 127, tg = c.tid >> 7;
    const bf16* wa = wl + OFF_LWA / 2 + (size_t)(n * 128 + e) * 128; const bf16* wx = wl + OFF_LWX / 2 + (size_t)(n * 128 + e) * 128;
    const int ch = n * 128 + e;
    const float ba = a.in[17][(size_t)l * D + ch], bx = a.in[19][(size_t)l * D + ch], sp = ((const float*)(a.ws + WS_TAB + 32768))[l * D + ch];
#pragma unroll 1
    for (int tq = 0; tq < 4; ++tq) {
        float ra[4], ia[4];
#pragma unroll
        for (int i = 0; i < 4; ++i) { ra[i] = 0.f; ia[i] = 0.f; }
        const LAS float* xc = XC + (tg * 16 + tq * 4) * 128;
#pragma unroll 1
        for (int d0 = 0; d0 < 128; d0 += 8) {
            const f32x4 wa0 = ld_bf4(wa + d0), wa1 = ld_bf4(wa + d0 + 4), wx0 = ld_bf4(wx + d0), wx1 = ld_bf4(wx + d0 + 4);
#pragma unroll
            for (int tt = 0; tt < 4; ++tt) {
                const f32x4 x0 = *(const LAS f32x4*)(xc + tt * 128 + d0), x1 = *(const LAS f32x4*)(xc + tt * 128 + d0 + 4);
                ra[tt] += (x0[0] * wa0[0] + x0[1] * wa0[1]) + (x0[2] * wa0[2] + x0[3] * wa0[3]) + (x1[0] * wa1[0] + x1[1] * wa1[1]) + (x1[2] * wa1[2] + x1[3] * wa1[3]);
                ia[tt] += (x0[0] * wx0[0] + x0[1] * wx0[1]) + (x0[2] * wx0[2] + x0[3] * wx0[3]) + (x1[0] * wx1[0] + x1[1] * wx1[1]) + (x1[2] * wx1[2] + x1[3] * wx1[3]);
            }
        }
#pragma unroll
        for (int tt = 0; tt < 4; ++tt) {
            const int t = tg * 16 + tq * 4 + tt;
            const float r = sigmoidf_(ra[tt] + ba), ig = sigmoidf_(ia[tt] + bx);
            const float la = -8.0f * r * sp, aa = expf(la), mult = sqrtf(-expm1f(2.0f * la));
            As[t * 128 + e] = aa; Bs[t * 128 + e] = mult * ig * XC[t * 128 + e];
        }
    }
}
__device__ __forceinline__ void lru_gates_mfma(CArgs& a, Ctx& c, int l, int n) {
    LAS float* XC = (LAS float*)c.lds + L_XC; LAS float* As = (LAS float*)c.lds + L_AS; LAS float* Bs = (LAS float*)c.lds + L_BS;
    const bf16* wl = (const bf16*)(a.ws + WS_W + (size_t)l * WL_STRIDE);
    const int lane = c.tid & 63, w = __builtin_amdgcn_readfirstlane(c.tid >> 6), fr = lane & 15, fq = lane >> 4;
    const int e = 16 * w + fr, ch = n * 128 + e;
    const bf16* wa = wl + OFF_LWA / 2 + (size_t)(n * 128 + e) * 128 + 8 * fq; const bf16* wx = wl + OFF_LWX / 2 + (size_t)(n * 128 + e) * 128 + 8 * fq;
    bf16x8 Ba[4], Bx[4];
#pragma unroll
    for (int ks = 0; ks < 4; ++ks) { Ba[ks] = *(const bf16x8*)(wa + 32 * ks); Bx[ks] = *(const bf16x8*)(wx + 32 * ks); }
    const float ba = a.in[17][(size_t)l * D + ch], bx = a.in[19][(size_t)l * D + ch], sp = ((const float*)(a.ws + WS_TAB + 32768))[l * D + ch];
#pragma unroll
    for (int m = 0; m < 4; ++m) {
        f32x4 ar = (f32x4){0.f, 0.f, 0.f, 0.f}, ai = (f32x4){0.f, 0.f, 0.f, 0.f};
#pragma unroll
        for (int ks = 0; ks < 4; ++ks) {
            const bf16x8 af = *(const LAS bf16x8*)(c.lds + LB_XCB + (16 * m + fr) * XCB_STRIDE + (32 * ks + 8 * fq) * 2);
            ar = __builtin_amdgcn_mfma_f32_16x16x32_bf16(af, Ba[ks], ar, 0, 0, 0);
            ai = __builtin_amdgcn_mfma_f32_16x16x32_bf16(af, Bx[ks], ai, 0, 0, 0);
        }
#pragma unroll
        for (int j = 0; j < 4; ++j) {
            const int t = 16 * m + 4 * fq + j;
            const float r = sigmoidf_(ar[j] + ba), ig = sigmoidf_(ai[j] + bx);
            const float la = -8.0f * r * sp, aa = expf(la), mult = sqrtf(-expm1f(2.0f * la));
            As[t * 128 + e] = aa; Bs[t * 128 + e] = mult * ig * XC[t * 128 + e];
        }
    }
}
#if FAST_GATES
#define lru_gates lru_gates_mfma
#else
#define lru_gates lru_gates_naive
#endif

__device__ __forceinline__ void lru_prompt_item(CArgs& a, Ctx& c, int l, int b, int n) {
    LAS float* L = (LAS float*)c.lds;
    const bf16* XB = (const bf16*)(a.ws + WS_XB); const bf16* YG = (const bf16*)(a.ws + WS_YG); bf16* OB = (bf16*)(a.ws + WS_OB);
    const int t_ld = c.tid >> 3, c0 = (c.tid & 7) * 16;
    const int cch = c.tid & 127, sg = c.tid >> 7;
    const float* cw = a.in[14] + (size_t)l * 4 * D + n * 128; const float* cb = a.in[15] + (size_t)l * D + n * 128;
    __syncthreads();
    if (c.tid < 128) L[L_CARRY + c.tid] = 0.f;
    if (c.tid < 384) L[L_XBS + c.tid] = 0.f;
    for (int t0 = 0; t0 < SEQ; t0 += 64) {
        __syncthreads();
        { const bf16* src = XB + (size_t)(b * SEQ + t0 + t_ld) * D + n * 128 + c0;
          const f32x4 x0 = ld_bf4(src), x1 = ld_bf4(src + 4), x2 = ld_bf4(src + 8), x3 = ld_bf4(src + 12);
          LAS float* dst = L + L_XBS + (3 + t_ld) * 128 + c0;
          *(LAS f32x4*)dst = x0; *(LAS f32x4*)(dst + 4) = x1; *(LAS f32x4*)(dst + 8) = x2; *(LAS f32x4*)(dst + 12) = x3; }
        __syncthreads();
#pragma unroll
        for (int j4 = 0; j4 < 4; ++j4) { const int cc = c0 + 4 * j4;
            f32x4 acc = *(const f32x4*)(cb + cc);
#pragma unroll
            for (int j = 0; j < 4; ++j) acc += *(const f32x4*)(cw + j * D + cc) * *(const LAS f32x4*)(L + L_XBS + (t_ld + j) * 128 + cc);
            *(LAS f32x4*)(L + L_XC + t_ld * 128 + cc) = acc;
            { u32x2 w; w.x = pk2(acc[0], acc[1]); w.y = pk2(acc[2], acc[3]); *(LAS u32x2*)(c.lds + LB_XCB + t_ld * XCB_STRIDE + cc * 2) = w; } }
        __syncthreads();
        lru_gates(a, c, l, n);
        __syncthreads();
        float P = 1.f, Bv = 0.f;
#pragma unroll 4
        for (int tt = 0; tt < 16; ++tt) { const float aa = L[L_AS + (sg * 16 + tt) * 128 + cch], bb = L[L_BS + (sg * 16 + tt) * 128 + cch]; Bv = aa * Bv + bb; P *= aa; }
        L[L_SEG + (sg * 128 + cch) * 2] = P; L[L_SEG + (sg * 128 + cch) * 2 + 1] = Bv;
        __syncthreads();
        float h = L[L_CARRY + cch];
        for (int s = 0; s < sg; ++s) h = L[L_SEG + (s * 128 + cch) * 2] * h + L[L_SEG + (s * 128 + cch) * 2 + 1];
#pragma unroll 4
        for (int tt = 0; tt < 16; ++tt) { const int t = sg * 16 + tt; const size_t off = (size_t)(b * SEQ + t0 + t) * D + n * 128 + cch;
            h = L[L_AS + t * 128 + cch] * h + L[L_BS + t * 128 + cch];
            OB[off] = (bf16)f2bf(h * bf2f(YG[off])); }
        __syncthreads();
        if (sg == 3) L[L_CARRY + cch] = h;
        if (c.tid < 384) L[L_XBS + c.tid] = L[L_XBS + 64 * 128 + c.tid];
    }
    __syncthreads();
    if (c.tid < 128) a.out[O_LRP + ((size_t)l * NBATCH + b) * D + n * 128 + c.tid] = L[L_CARRY + c.tid];
    if (c.tid < 384) a.out[O_CVP + (((size_t)l * NBATCH + b) * 3 + (c.tid >> 7)) * D + n * 128 + (c.tid & 127)] = L[L_XBS + c.tid];
    __syncthreads();
}
__device__ __forceinline__ void lru_sample_item(CArgs& a, Ctx& c, int l, int n, int hf) {
    LAS float* L = (LAS float*)c.lds;
    const bf16* XB = (const bf16*)(a.ws + WS_XB); const bf16* YG = (const bf16*)(a.ws + WS_YG); bf16* OB = (bf16*)(a.ws + WS_OB);
    const int t_ld = c.tid >> 3, c0 = (c.tid & 7) * 16;
    const float* cw = a.in[14] + (size_t)l * 4 * D + n * 128; const float* cb = a.in[15] + (size_t)l * D + n * 128;
    const int bs = hf * 64 + t_ld, row = MP + bs;
    const float* sc = a.in[4] + ((size_t)l * NS + bs) * 3 * D + n * 128;
    float* nc = a.out + O_CVS + ((size_t)l * NS + bs) * 3 * D + n * 128;
    __syncthreads();
#pragma unroll
    for (int j4 = 0; j4 < 4; ++j4) { const int cc = c0 + 4 * j4;
        const f32x4 x = ld_bf4(XB + (size_t)row * D + n * 128 + cc);
        const f32x4 s0 = *(const f32x4*)(sc + cc), s1 = *(const f32x4*)(sc + D + cc), s2 = *(const f32x4*)(sc + 2 * D + cc);
        const f32x4 acc = *(const f32x4*)(cb + cc) + *(const f32x4*)(cw + cc) * s0 + *(const f32x4*)(cw + D + cc) * s1 + *(const f32x4*)(cw + 2 * D + cc) * s2 + *(const f32x4*)(cw + 3 * D + cc) * x;
        *(LAS f32x4*)(L + L_XC + t_ld * 128 + cc) = acc;
        { u32x2 w; w.x = pk2(acc[0], acc[1]); w.y = pk2(acc[2], acc[3]); *(LAS u32x2*)(c.lds + LB_XCB + t_ld * XCB_STRIDE + cc * 2) = w; }
        *(f32x4*)(nc + cc) = s1; *(f32x4*)(nc + D + cc) = s2; *(f32x4*)(nc + 2 * D + cc) = x; }
    __syncthreads();
    lru_gates(a, c, l, n);
    __syncthreads();
    { const int cch = c.tid & 127, tg = c.tid >> 7;
#pragma unroll 4
      for (int tt = 0; tt < 16; ++tt) { const int t = tg * 16 + tt, b2 = hf * 64 + t; const size_t off = (size_t)(MP + b2) * D + n * 128 + cch;
          const float h0 = a.in[3][((size_t)l * NS + b2) * D + n * 128 + cch];
          const float h = L[L_AS + t * 128 + cch] * h0 + L[L_BS + t * 128 + cch];
          a.out[O_LRS + ((size_t)l * NS + b2) * D + n * 128 + cch] = h;
          OB[off] = (bf16)f2bf(h * bf2f(YG[off])); } }
    __syncthreads();
}

__device__ __forceinline__ void mixer_phase(CArgs& a, Ctx& c, int l) {
    if (c.wg < 64) {
        const int b = c.wg >> 3, h = c.wg & 7;
        hgrn_naive(a, c, l, b * SEQ, SEQ, h, nullptr, a.out + O_HGP + (((size_t)l * NBATCH + b) * NH + h) * DKV * DKV);
    } else if (c.wg < 128) {
        const int i = c.wg - 64;
        lru_prompt_item(a, c, l, i >> 3, i & 7);
        if (i < 16) lru_sample_item(a, c, l, i >> 1, i & 1);
    } else {
        for (int it = c.wg - 128; it < NS * NH; it += c.G - 128) {
            const int bs = it >> 3, h = it & 7; const size_t so = (((size_t)l * NS + bs) * NH + h) * DKV * DKV;
            hgrn_naive(a, c, l, MP + bs, 1, h, a.in[2] + so, a.out + O_HGS + so);
        }
    }
}

__global__ void __launch_bounds__(512, 2) mega_fwd(Args a0) {
    extern __shared__ __attribute__((aligned(16))) unsigned char lds_raw[];
    Ctx c; c.lds = (LAS unsigned char*)lds_raw; c.tid = threadIdx.x; c.G = gridDim.x; c.wg = blockIdx.x;
    volatile LAS unsigned* MISC = (volatile LAS unsigned*)(c.lds + MISC_OFF);
    if (c.tid < 32) MISC[c.tid] = 0u;
    __syncthreads();
    XcdBarrier bar; bar.bar = (unsigned*)(a0.ws + WS_CTL) + 1024; bar.x = 0; bar.st = nullptr;
    if (a0.ph_hi - a0.ph_lo > 1) bar = xcd_barrier_post((unsigned*)(a0.ws + WS_CTL) + 1024, MISC + 8);

    for (int ph = a0.ph_lo; ph < a0.ph_hi; ++ph) {
        CArgs* ap = (CArgs*)__builtin_amdgcn_kernarg_segment_ptr(); asm volatile("" : "+s"(ap));
        CArgs& a = *ap;
        { int t_ = threadIdx.x, w_ = blockIdx.x, g_ = gridDim.x; asm volatile("" : "+v"(t_), "+s"(w_), "+s"(g_)); c.tid = t_; c.wg = w_; c.G = g_; }
        float* X = a.out;
        if (ph == 0) p0_prologue(a, c);
        else if (ph == NPHASE - 1) final_norm_phase(a, c);
        else {
            const int l = (ph - 1) >> 3, j = (ph - 1) & 7;
            const bf16* wl = (const bf16*)(a.ws + WS_W + (size_t)l * WL_STRIDE);
            const float* xp = l == 0 ? a.in[0] : X; const float* xs = l == 0 ? a.in[1] : X + (size_t)MP * D;
            const float* modl = (const float*)(a.ws + WS_MOD) + (size_t)l * NMOD * 6144;
            bf16* H = (bf16*)(a.ws + WS_H);
            if (j == 0) norm_phase(a, c, l, 0, xp, xs);
            else if (j == 1) {
                EpiIn e{(bf16*)(a.ws + WS_Q), (bf16*)(a.ws + WS_K), (bf16*)(a.ws + WS_V), (bf16*)(a.ws + WS_OG), (bf16*)(a.ws + WS_XB), (bf16*)(a.ws + WS_YG), (bf16*)(a.ws + WS_SGA), (bf16*)(a.ws + WS_SGB),
                        (float*)(a.ws + WS_LOGF), (const float*)(a.ws + WS_TAB) + (size_t)l * 3 * D};
                gemm_phase_sel<0>(c, H, wl + OFF_WIN / 2, MT, NIN, D, e);
            } else if (j == 2) mixer_phase(a, c, l);
            else if (j == 3) {
                EpiBrA ea{(const bf16*)(a.ws + WS_SGA), (float*)(a.ws + WS_T)};
                gemm_phase_sel<1>(c, (const bf16*)(a.ws + WS_OA), wl + OFF_WA / 2, MT, D, D, ea);
                asm volatile("s_waitcnt vmcnt(0)" ::: "memory"); __syncthreads();
                { int t_ = threadIdx.x; asm volatile("" : "+v"(t_)); c.tid = t_; }
                EpiBrB eb{(const bf16*)(a.ws + WS_SGB), (const float*)(a.ws + WS_T), (bf16*)(a.ws + WS_MG)};
                gemm_phase_sel<2>(c, (const bf16*)(a.ws + WS_OB), wl + OFF_WB / 2, MT, D, D, eb);
            } else if (j == 4) {
                EpiRes e{xp, xs, X, modl, 2};
                gemm_phase_sel<3>(c, (const bf16*)(a.ws + WS_MG), wl + OFF_WO / 2, MT, D, D, e);
            } else if (j == 5) norm_phase(a, c, l, 1, X, X + (size_t)MP * D);
            else if (j == 6) { EpiFF1 e{(bf16*)(a.ws + WS_HM)}; gemm_phase_sel<4>(c, H, wl + OFF_W1 / 2, MT, FF, D, e); }
            else { EpiRes e{X, X + (size_t)MP * D, X, modl, 5}; gemm_phase_sel<5>(c, (const bf16*)(a.ws + WS_HM), wl + OFF_W2 / 2, MT, D, FF, e); }
        }
        if (ph + 1 < a0.ph_hi) xcd_barrier(bar);
    }
}

extern "C" void kernel_launch(void* const* d_in, const int* in_sizes, int n_in, void* d_out, int out_size, void* d_ws, size_t ws_size, hipStream_t stream) {
    static int grid = 0;
    if (grid == 0) {
        if (n_in != 27 || out_size != (int)O_END || ws_size < WS_END) { fprintf(stderr, "kernel_launch: unexpected shapes (n_in %d out %d ws %zu)\n", n_in, out_size, ws_size); grid = -1; return; }
        int dev = 0, cus = 0, per_cu = 0;
        if (hipGetDevice(&dev) != hipSuccess || hipDeviceGetAttribute(&cus, hipDeviceAttributeMultiprocessorCount, dev) != hipSuccess) { grid = -1; return; }
        if (hipFuncSetAttribute((const void*)mega_fwd, hipFuncAttributeMaxDynamicSharedMemorySize, LDS_BYTES) != hipSuccess) { fprintf(stderr, "kernel_launch: hipFuncSetAttribute failed\n"); grid = -1; return; }
        if (hipOccupancyMaxActiveBlocksPerMultiprocessor(&per_cu, (const void*)mega_fwd, 512, LDS_BYTES) != hipSuccess || per_cu < 1) { fprintf(stderr, "kernel_launch: occupancy query failed (%d)\n", per_cu); (void)hipGetLastError(); per_cu = 1; }
        grid = cus * (per_cu < 1 ? 1 : 1);
        fprintf(stderr, "kernel_launch: cus %d per_cu %d grid %d\n", cus, per_cu, grid);
    }
    if (grid < 0) return;
    (void)hipMemsetAsync((char*)d_ws + WS_CTL, 0, CTL_BYTES, stream);
    Args a{};
    for (int i = 0; i < 27; ++i) a.in[i] = (const float*)d_in[i];
    a.out = (float*)d_out; a.ws = (unsigned char*)d_ws;
#if ONE_LAUNCH
    a.ph_lo = 0; a.ph_hi = NPHASE;
    void* kargs[] = {&a};
    hipError_t e = hipLaunchCooperativeKernel((const void*)mega_fwd, dim3(grid), dim3(512), kargs, LDS_BYTES, stream);
    if (e != hipSuccess) fprintf(stderr, "kernel_launch: cooperative launch failed: %s (grid %d)\n", hipGetErrorString(e), grid);
#else
    for (int ph = 0; ph < NPHASE; ++ph) { a.ph_lo = ph; a.ph_hi = ph + 1;
        for (int rep = 0; rep < 1 + (int)((PROBE_REPEAT >> ph) & 1); ++rep) hipLaunchKernelGGL(mega_fwd, dim3(grid), dim3(512), LDS_BYTES, stream, a); }
#endif
}
```

```cpp
#include <hip/hip_runtime.h>
#include <cstdio>
#include <cstdint>

#ifndef FAST_GEMM
#define FAST_GEMM 63
#endif
#ifndef FAST_HGRN
#define FAST_HGRN 1
#endif
#ifndef FAST_GATES
#define FAST_GATES 1
#endif
#ifndef DBG_SHFL
#define DBG_SHFL 1
#endif
#ifndef PROBE_REPEAT
#define PROBE_REPEAT 0
#endif
#ifndef ONE_LAUNCH
#define ONE_LAUNCH 1
#endif

#define LAS __attribute__((address_space(3)))
#define GAS __attribute__((address_space(1)))
typedef unsigned short bf16;
typedef float f32x4 __attribute__((ext_vector_type(4)));
typedef float f32x2 __attribute__((ext_vector_type(2)));
typedef short bf16x8 __attribute__((ext_vector_type(8)));
typedef unsigned u32x4 __attribute__((ext_vector_type(4)));
typedef unsigned u32x2 __attribute__((ext_vector_type(2)));

constexpr int D = 1024, NBATCH = 8, SEQ = 2048, MP = NBATCH * SEQ, NS = 128, MR = MP + NS, MT = 16640;
constexpr int NMOD = NBATCH + NS;
constexpr int NIN = 8192, FF = 4096, NH = 8, DKV = 128;
constexpr float EPS = 1e-6f;
constexpr int NPHASE = 18;

constexpr size_t MiB = (size_t)1 << 20;
constexpr size_t WS_CTL = 0, CTL_BYTES = 64 * 1024;
constexpr size_t WS_TAB = 1 * MiB;
constexpr size_t WS_MOD = 2 * MiB;
constexpr size_t WS_W = 9 * MiB, WL_STRIDE = 77 * MiB / 2;
constexpr size_t OFF_WIN = 0, OFF_WA = 16 * MiB, OFF_WB = 18 * MiB, OFF_WO = 20 * MiB, OFF_W1 = 22 * MiB, OFF_W2 = 30 * MiB, OFF_LWA = 38 * MiB, OFF_LWX = 38 * MiB + 256 * 1024;
constexpr size_t WS_H = 86 * MiB;
constexpr size_t WS_Q = 119 * MiB, WS_K = 152 * MiB, WS_V = 185 * MiB, WS_OG = 218 * MiB, WS_XB = 251 * MiB, WS_YG = 284 * MiB, WS_SGA = 317 * MiB, WS_SGB = 350 * MiB;
constexpr size_t WS_LOGF = 383 * MiB;
constexpr size_t WS_T = WS_LOGF;
constexpr size_t WS_MG = WS_K;
constexpr size_t WS_HM = WS_OG;
constexpr size_t WS_OA = 448 * MiB;
constexpr size_t WS_OB = WS_H;
constexpr size_t WS_END = 481 * MiB;
static_assert(WS_W + 2 * WL_STRIDE <= WS_H && WS_H + (size_t)MT * D * 2 <= WS_Q && WS_LOGF + (size_t)MT * D * 4 <= WS_OA && WS_OA + (size_t)MT * D * 2 <= WS_END && WS_HM + (size_t)MT * FF * 2 <= WS_SGB, "ws map");

constexpr size_t O_YP = 0, O_YS = (size_t)MP * D, O_HGP = O_YS + (size_t)NS * D, O_LRP = O_HGP + (size_t)2 * NBATCH * NH * DKV * DKV, O_CVP = O_LRP + (size_t)2 * NBATCH * D,
                 O_HGS = O_CVP + (size_t)2 * NBATCH * 3 * D, O_LRS = O_HGS + (size_t)2 * NS * NH * DKV * DKV, O_CVS = O_LRS + (size_t)2 * NS * D, O_END = O_CVS + (size_t)2 * NS * 3 * D;
static_assert(O_END == 53673984, "out map");

constexpr int LDS_BYTES = 163840;
constexpr int MISC_OFF = 158 * 1024;

__device__ __forceinline__ unsigned f2bf(float f) { unsigned u = __builtin_bit_cast(unsigned, f); return (u + 0x7fffu + ((u >> 16) & 1u)) >> 16; }
__device__ __forceinline__ unsigned pk2(float lo, float hi) { return f2bf(lo) | (f2bf(hi) << 16); }
__device__ __forceinline__ float bf2f(unsigned b) { return __builtin_bit_cast(float, b << 16); }
__device__ __forceinline__ f32x4 ld_bf4(const bf16* p) { const u32x2 w = *(const u32x2*)p; return (f32x4){bf2f(w.x & 0xffffu), bf2f(w.x >> 16), bf2f(w.y & 0xffffu), bf2f(w.y >> 16)}; }
__device__ __forceinline__ void st_bf4(bf16* p, f32x4 v) { u32x2 w; w.x = pk2(v[0], v[1]); w.y = pk2(v[2], v[3]); *(u32x2*)p = w; }
__device__ __forceinline__ float sigmoidf_(float x) { return 1.0f / (1.0f + __expf(-x)); }
__device__ __forceinline__ float siluf_(float x) { return x * sigmoidf_(x); }
__device__ __forceinline__ float gelu_tanh_(float x) { const float u = 0.7978845608028654f * (x + 0.044715f * x * x * x); return x * sigmoidf_(2.0f * u); }
__device__ __forceinline__ float softplusf_(float x) { return fmaxf(x, 0.f) + log1pf(expf(-fabsf(x))); }
template <int XM> __device__ __forceinline__ float swz_xor(float v) { return __builtin_bit_cast(float, __builtin_amdgcn_ds_swizzle(__builtin_bit_cast(int, v), (XM << 10) | 0x1f)); }
#if DBG_SHFL
__device__ __forceinline__ float half_sum(float v) {
#pragma unroll
    for (int o = 1; o < 32; o <<= 1) v += __shfl_xor(v, o);
    return v; }
__device__ __forceinline__ float wave_sum(float v) {
#pragma unroll
    for (int o = 1; o < 64; o <<= 1) v += __shfl_xor(v, o);
    return v; }
#else
__device__ __forceinline__ float half_sum(float v) { v += swz_xor<1>(v); v += swz_xor<2>(v); v += swz_xor<4>(v); v += swz_xor<8>(v); v += swz_xor<16>(v); return v; }
__device__ __forceinline__ float wave_sum(float v) {
    v = half_sum(v);
    unsigned v1 = __builtin_bit_cast(unsigned, v), v2 = v1; asm volatile("" : "+v"(v2));
    const auto r = __builtin_amdgcn_permlane32_swap(v1, v2, false, false);
    return __builtin_bit_cast(float, r[0]) + __builtin_bit_cast(float, r[1]);
}
#endif
__device__ __forceinline__ int mod_row(int row) { return row < MP ? (row >> 11) : (NBATCH + row - MP); }

struct Args { const float* in[27]; float* out; unsigned char* ws; int ph_lo, ph_hi; };
typedef const __attribute__((address_space(4))) Args CArgs;
struct Ctx { LAS unsigned char* lds; int tid, G, wg; };
namespace pg8 {
#define PG8_LAS __attribute__((address_space(3)))
typedef unsigned short bf16_t;
typedef short bf16x8 __attribute__((ext_vector_type(8)));
typedef float f32x4 __attribute__((ext_vector_type(4)));
typedef unsigned u32x4 __attribute__((ext_vector_type(4)));
constexpr int BM = 256, BK = 64, HALF = 128, HTB = HALF * BK * 2  , STAGE_BYTES = 8 * HTB, NXCD = 8, WGM = 8;

__host__ __device__ __forceinline__ int lds_byte(int r, int c) { const int st = (r >> 4) * 2 + (c >> 5), rr = r & 15, cc = c & 31, ob = rr * 64 + cc * 2; return st * 1024 + (ob ^ (((ob >> 9) & 1) << 5)); }
__host__ __device__ __forceinline__ void stage_rc(int b, int& R, int& C) { const int st = b / 1024, sb = b % 1024, swz = sb ^ (((sb >> 9) & 1) << 5); R = (st >> 1) * 16 + swz / 64; C = (st & 1) * 32 + (swz % 64) / 2; }
__host__ __device__ __forceinline__ int perm32(int rho) { const int n = rho >> 4, i = rho & 15; return 8 * (i >> 2) + 4 * n + (i & 3); }

struct Unit { int pm, pn; };
struct Gemm { const bf16_t* A; const bf16_t* Bt; int M, N, K; };

struct StaticOrder {
    int nM, nN, nwg, G, c;
    __host__ __device__ void init(int M, int N, int G_, int c_) { nM = M / BM; nN = N / BM; nwg = nM * nN; G = G_; c = c_; }
    __host__ __device__ bool next(int i, Unit& u) const {
        const long L = (long)i * G + c; if (L >= nwg) return false;
        int wgid = (int)L; { const int q = nwg / NXCD, r = nwg % NXCD, xcd = wgid % NXCD, off = wgid / NXCD; wgid = (xcd < r ? xcd * (q + 1) : r * (q + 1) + (xcd - r) * q) + off; }
        const int nig = WGM * nN, gid = wgid / nig, fm = gid * WGM, gsz = (nM - fm) < WGM ? (nM - fm) : WGM;
        u.pm = fm + ((wgid % nig) % gsz); u.pn = (wgid % nig) / gsz; return true;
    }
    __device__ __forceinline__ void a_ready(const Unit&) const {}
    __device__ __forceinline__ void done(const Unit&) const {}
};
template <class Epi, class Sched, bool ALIGN_EPI = false, bool SP2 = false>
__device__ __forceinline__ void gemm_phase(PG8_LAS unsigned char* lds, const Gemm g, const Sched& S, const Epi& E, const int tid_in) {
    const int tid = tid_in, wid = __builtin_amdgcn_readfirstlane(tid >> 6), lane = tid & 63, wr = wid >> 2, wc = wid & 3, fr = lane & 15, fq = lane >> 4;
    const int K = g.K, nt = K / BK;
    unsigned voffA[2], voffB[2];
#pragma unroll
    for (int i = 0; i < 2; ++i) { int R, C; stage_rc(tid * 16 + i * 8192, R, C); const int Rb = Epi::PERM ? ((R & ~31) + perm32(R & 31)) : R;
        voffA[i] = (unsigned)(R * K + C) * 2u; voffB[i] = (unsigned)(Rb * K + C) * 2u; }
    const size_t kstep = (size_t)(BK * 2);
    const size_t hstep = (size_t)HALF * K * 2;
    const size_t tstep = 2 * hstep;
    const unsigned ldsw = (unsigned)wid * 1024u;
    const int aoff = lds_byte(wr * 64 + fr, fq * 8), boff = lds_byte(wc * 32 + fr, fq * 8);
#define PG8_SA(b, h) (((b) * 2 + (h)) * HTB)
#define PG8_SB(b, h) ((4 + (b) * 2 + (h)) * HTB)
#define PG8_STAGE(bufoff, gbase, voff) do { _Pragma("unroll") for (int _i = 0; _i < 2; ++_i) \
        __builtin_amdgcn_global_load_lds((const unsigned*)((const char*)(gbase) + (voff)[_i]), (PG8_LAS unsigned*)(lds + (bufoff) + ldsw + _i * 8192), 16, 0, 0); } while (0)
#define PG8_LDA(dst, b, h) do { _Pragma("unroll") for (int m = 0; m < 4; ++m) _Pragma("unroll") for (int k = 0; k < 2; ++k) dst[m][k] = *(const PG8_LAS bf16x8*)(lds + PG8_SA(b, h) + aoff + m * 2048 + k * 1024); } while (0)
#define PG8_LDB(dst, b, h) do { _Pragma("unroll") for (int n = 0; n < 2; ++n) _Pragma("unroll") for (int k = 0; k < 2; ++k) dst[n][k] = *(const PG8_LAS bf16x8*)(lds + PG8_SB(b, h) + boff + n * 2048 + k * 1024); } while (0)
#define PG8_MMA(ai, bj, At, Bt) do { __builtin_amdgcn_s_setprio(1); _Pragma("unroll") for (int m = 0; m < 4; ++m) _Pragma("unroll") for (int n = 0; n < 2; ++n) _Pragma("unroll") for (int k = 0; k < 2; ++k) \
        acc[ai][bj][m][n] = __builtin_amdgcn_mfma_f32_16x16x32_bf16(Bt[n][k], At[m][k], acc[ai][bj][m][n], 0, 0, 0); __builtin_amdgcn_s_setprio(0); } while (0)
#define PG8_WAIT_V(n) asm volatile("s_waitcnt vmcnt(" #n ")" ::: "memory")
#define PG8_WAIT_L(n) asm volatile("s_waitcnt lgkmcnt(" #n ")" ::: "memory")
#define PG8_BAR __builtin_amdgcn_s_barrier()
#define PG8_SCHED __builtin_amdgcn_sched_barrier(0)
    Unit cur, nxt; int ui = 0;
    if (!S.next(0, cur)) return;
    f32x4 acc[2][2][4][2];
#pragma unroll
    for (int a = 0; a < 2; ++a)
#pragma unroll
        for (int b = 0; b < 2; ++b)
#pragma unroll
            for (int m = 0; m < 4; ++m)
#pragma unroll
                for (int n = 0; n < 2; ++n) acc[a][b][m][n] = (f32x4){0.f, 0.f, 0.f, 0.f};
    bf16x8 At[4][2], B0[2][2], B1[2][2];
    const char* cA = (const char*)g.A + (size_t)cur.pm * tstep; const char* cB = (const char*)g.Bt + (size_t)cur.pn * tstep;
    S.a_ready(cur);
    if constexpr (SP2) {
        PG8_STAGE(PG8_SB(0, 0), cB, voffB); PG8_STAGE(PG8_SB(0, 1), cB + hstep, voffB); PG8_STAGE(PG8_SA(0, 0), cA, voffA); PG8_STAGE(PG8_SA(0, 1), cA + hstep, voffA);
        if (wr == 1) PG8_BAR;
        PG8_WAIT_V(2); PG8_BAR;
        PG8_STAGE(PG8_SB(1, 0), cB + kstep, voffB); PG8_STAGE(PG8_SA(1, 0), cA + kstep, voffA); PG8_STAGE(PG8_SB(1, 1), cB + hstep + kstep, voffB);
        PG8_WAIT_V(6); PG8_BAR;
    } else {
        PG8_STAGE(PG8_SB(0, 0), cB, voffB); PG8_STAGE(PG8_SA(0, 0), cA, voffA); PG8_STAGE(PG8_SB(0, 1), cB + hstep, voffB); PG8_STAGE(PG8_SA(0, 1), cA + hstep, voffA);
        if (wr == 1) PG8_BAR;
        PG8_WAIT_V(4); PG8_BAR;
        PG8_STAGE(PG8_SB(1, 0), cB + kstep, voffB); PG8_STAGE(PG8_SA(1, 0), cA + kstep, voffA); PG8_STAGE(PG8_SB(1, 1), cB + hstep + kstep, voffB);
        PG8_WAIT_V(6); PG8_BAR;
    }
    for (;;) {
        const bool has_next = S.next(ui + 1, nxt);
        const char* nA = has_next ? (const char*)g.A + (size_t)nxt.pm * tstep : cA; const char* nB = has_next ? (const char*)g.Bt + (size_t)nxt.pn * tstep : cB;
        for (int t = 0; t < nt; t += 2) {
            const bool last = (t == nt - 2);
            const char* a1 = cA + (size_t)(t + 1) * kstep;
            const char* a2 = last ? nA : cA + (size_t)(t + 2) * kstep; const char* b2 = last ? nB : cB + (size_t)(t + 2) * kstep;
            const char* a3 = a2 + kstep; const char* b3 = b2 + kstep;
            if (last && has_next) S.a_ready(nxt);
            if constexpr (SP2) {
            PG8_LDB(B0, 0, 0); PG8_LDB(B1, 0, 1); PG8_SCHED; PG8_LDA(At, 0, 0); PG8_STAGE(PG8_SA(1, 1), a1 + hstep, voffA);
            PG8_WAIT_V(8); PG8_WAIT_L(0); PG8_BAR; PG8_MMA(0, 0, At, B0); PG8_MMA(0, 1, At, B1); PG8_BAR; PG8_SCHED;
            PG8_LDA(At, 0, 1); PG8_STAGE(PG8_SB(0, 0), b2, voffB); PG8_STAGE(PG8_SB(0, 1), b2 + hstep, voffB); PG8_STAGE(PG8_SA(0, 0), a2, voffA);
            PG8_WAIT_V(8); PG8_WAIT_L(0); PG8_BAR; PG8_MMA(1, 0, At, B0); PG8_MMA(1, 1, At, B1); PG8_BAR; PG8_SCHED;
            PG8_LDB(B0, 1, 0); PG8_LDB(B1, 1, 1); PG8_SCHED; PG8_LDA(At, 1, 0); PG8_STAGE(PG8_SA(0, 1), a2 + hstep, voffA);
            PG8_WAIT_V(8); PG8_WAIT_L(0); PG8_BAR; PG8_MMA(0, 0, At, B0); PG8_MMA(0, 1, At, B1); PG8_BAR; PG8_SCHED;
            PG8_LDA(At, 1, 1); PG8_STAGE(PG8_SB(1, 0), b3, voffB); PG8_STAGE(PG8_SB(1, 1), b3 + hstep, voffB); PG8_STAGE(PG8_SA(1, 0), a3, voffA);
            PG8_WAIT_V(8); PG8_WAIT_L(0); PG8_BAR; PG8_MMA(1, 0, At, B0); PG8_MMA(1, 1, At, B1); PG8_BAR; PG8_SCHED;
            } else {
            PG8_LDB(B0, 0, 0); PG8_SCHED; PG8_LDA(At, 0, 0); PG8_STAGE(PG8_SA(1, 1), a1 + hstep, voffA);
            PG8_WAIT_L(8); PG8_BAR; PG8_WAIT_L(0); PG8_MMA(0, 0, At, B0); PG8_BAR; PG8_SCHED;
            PG8_LDB(B1, 0, 1); PG8_STAGE(PG8_SB(0, 0), b2, voffB);
            PG8_BAR; PG8_WAIT_L(0); PG8_MMA(0, 1, At, B1); PG8_BAR;
            PG8_LDA(At, 0, 1); PG8_STAGE(PG8_SA(0, 0), a2, voffA);
            PG8_BAR; PG8_WAIT_L(0); PG8_MMA(1, 0, At, B0); PG8_BAR; PG8_SCHED;
            PG8_STAGE(PG8_SB(0, 1), b2 + hstep, voffB);
            PG8_WAIT_V(6); PG8_BAR; PG8_MMA(1, 1, At, B1); PG8_BAR;
            PG8_LDB(B0, 1, 0); PG8_SCHED; PG8_LDA(At, 1, 0); PG8_STAGE(PG8_SA(0, 1), a2 + hstep, voffA);
            PG8_WAIT_L(8); PG8_BAR; PG8_WAIT_L(0); PG8_MMA(0, 0, At, B0); PG8_BAR; PG8_SCHED;
            PG8_LDB(B1, 1, 1); PG8_STAGE(PG8_SB(1, 0), b3, voffB);
            PG8_BAR; PG8_WAIT_L(0); PG8_MMA(0, 1, At, B1); PG8_BAR;
            PG8_LDA(At, 1, 1); PG8_STAGE(PG8_SA(1, 0), a3, voffA);
            PG8_BAR; PG8_WAIT_L(0); PG8_MMA(1, 0, At, B0); PG8_BAR; PG8_SCHED;
            PG8_STAGE(PG8_SB(1, 1), b3 + hstep, voffB);
            PG8_WAIT_V(6); PG8_BAR; PG8_MMA(1, 1, At, B1); PG8_BAR;
            }
        }
        if constexpr (ALIGN_EPI) { if (wr == 0) PG8_BAR; }
        if constexpr (!Epi::AFTER_DRAIN) { int l2 = (int)__builtin_amdgcn_mbcnt_hi(~0u, __builtin_amdgcn_mbcnt_lo(~0u, 0u)); asm volatile("" : "+v"(l2));
            E(acc, cur, wr, wc, l2 & 15, l2 >> 4); S.done(cur); }
        if (!has_next) break;
#pragma unroll
        for (int a = 0; a < 2; ++a)
#pragma unroll
            for (int b = 0; b < 2; ++b)
#pragma unroll
                for (int m = 0; m < 4; ++m)
#pragma unroll
                    for (int n = 0; n < 2; ++n) acc[a][b][m][n] = (f32x4){0.f, 0.f, 0.f, 0.f};
        cur = nxt; cA = nA; cB = nB; ++ui;
        if constexpr (ALIGN_EPI) { if (wr == 1) PG8_BAR; }
    }
    PG8_WAIT_V(0);
    if constexpr (!ALIGN_EPI) { if (wr == 0) PG8_BAR; }
    PG8_BAR;
    if constexpr (Epi::AFTER_DRAIN) { E.fused(acc, cur, wr, wc, fr, fq, lds, wid, lane); S.done(cur); }
#undef PG8_SA
#undef PG8_SB
#undef PG8_STAGE
#undef PG8_LDA
#undef PG8_LDB
#undef PG8_MMA
#undef PG8_WAIT_V
#undef PG8_WAIT_L
#undef PG8_BAR
#undef PG8_SCHED
}
}

template <class E> struct QuadEpi {
    static constexpr bool PERM = false, AFTER_DRAIN = false;
    E e;
    __device__ __forceinline__ void operator()(const f32x4 (&acc)[2][2][4][2], const pg8::Unit& u, int wr, int wc, int fr, int fq) const {
        const int row0 = u.pm * 256 + wr * 64 + fr, col0 = u.pn * 256 + wc * 32 + 4 * fq;
#pragma unroll
        for (int ai = 0; ai < 2; ++ai)
#pragma unroll
            for (int m = 0; m < 4; ++m)
#pragma unroll
                for (int bj = 0; bj < 2; ++bj)
#pragma unroll
                    for (int n = 0; n < 2; ++n) e.quad(row0 + ai * 128 + m * 16, col0 + bj * 128 + n * 16, acc[ai][bj][m][n]);
    }
};

struct EpiIn {
    bf16 *Q, *Kb, *V, *OG, *XB, *YG, *SGA, *SGB; float* LOGF; const float* lbt;
    static constexpr bool BY_REGION = true;
    template <int R> __device__ __forceinline__ void quadR(int row, int cc, f32x4 v) const {
        const size_t o = (size_t)row * D + cc;
        f32x4 r;
        if constexpr (R == 0 || R == 3) {
#pragma unroll
            for (int j = 0; j < 4; ++j) r[j] = siluf_(v[j]);
            st_bf4((R == 0 ? Q : OG) + o, r);
        } else if constexpr (R == 1) {
            const f32x4 lb = *(const f32x4*)(lbt + cc), llb = *(const f32x4*)(lbt + 1024 + cc), l1m = *(const f32x4*)(lbt + 2048 + cc);
            f32x4 lf;
#pragma unroll
            for (int j = 0; j < 4; ++j) {
                const float fa = v[j];
                const float t = __expf(-fabsf(fa));
                const float ls = fminf(fa, 0.f) - __logf(1.0f + t);
                const float b = l1m[j] + ls, a_ = llb[j], mx = fmaxf(a_, b);
                lf[j] = mx + __logf(1.0f + __expf(-fabsf(a_ - b)));
                const float sneg = (fa >= 0.f ? t : 1.0f) / (1.0f + t);
                r[j] = (1.0f - lb[j]) * sneg;
            }
            *(f32x4*)(LOGF + o) = lf; st_bf4(Kb + o, r);
        } else if constexpr (R == 2 || R == 4) { st_bf4((R == 2 ? V : XB) + o, v);
        } else if constexpr (R == 5) {
#pragma unroll
            for (int j = 0; j < 4; ++j) r[j] = gelu_tanh_(v[j]);
            st_bf4(YG + o, r);
        } else {
#pragma unroll
            for (int j = 0; j < 4; ++j) r[j] = sigmoidf_(v[j]);
            st_bf4((R == 6 ? SGA : SGB) + o, r);
        }
    }
    __device__ __forceinline__ void quad(int row, int col, f32x4 v) const {
        const int reg = col >> 10, cc = col & 1023;
        switch (reg) { case 0: quadR<0>(row, cc, v); break; case 1: quadR<1>(row, cc, v); break; case 2: quadR<2>(row, cc, v); break; case 3: quadR<3>(row, cc, v); break;
                       case 4: quadR<4>(row, cc, v); break; case 5: quadR<5>(row, cc, v); break; case 6: quadR<6>(row, cc, v); break; default: quadR<7>(row, cc, v); break; }
    }
};
struct EpiInUnit {
    static constexpr bool PERM = false, AFTER_DRAIN = false;
    EpiIn e;
    template <int R> __device__ __forceinline__ void run(const f32x4 (&acc)[2][2][4][2], int row0, int cc0) const {
#pragma unroll
        for (int ai = 0; ai < 2; ++ai)
#pragma unroll
            for (int m = 0; m < 4; ++m) {
#pragma unroll
                for (int bj = 0; bj < 2; ++bj)
#pragma unroll
                    for (int n = 0; n < 2; ++n) e.quadR<R>(row0 + ai * 128 + m * 16, cc0 + bj * 128 + n * 16, acc[ai][bj][m][n]);
                asm volatile("" ::: "memory"); }
    }
    __device__ __forceinline__ void operator()(const f32x4 (&acc)[2][2][4][2], const pg8::Unit& u, int wr, int wc, int fr, int fq) const {
        const int row0 = u.pm * 256 + wr * 64 + fr, cc0 = (u.pn & 3) * 256 + wc * 32 + 4 * fq;
        switch (u.pn >> 2) { case 0: run<0>(acc, row0, cc0); break; case 1: run<1>(acc, row0, cc0); break; case 2: run<2>(acc, row0, cc0); break; case 3: run<3>(acc, row0, cc0); break;
                             case 4: run<4>(acc, row0, cc0); break; case 5: run<5>(acc, row0, cc0); break; case 6: run<6>(acc, row0, cc0); break; default: run<7>(acc, row0, cc0); break; }
    }
};
struct EpiBrA { static constexpr bool BY_REGION = false; const bf16* SGA; float* T;
    __device__ __forceinline__ void quad(int row, int col, f32x4 v) const { const size_t o = (size_t)row * D + col; *(f32x4*)(T + o) = ld_bf4(SGA + o) * v; } };
struct EpiBrB { static constexpr bool BY_REGION = false; const bf16* SGB; const float* T; bf16* MG;
    __device__ __forceinline__ void quad(int row, int col, f32x4 v) const { const size_t o = (size_t)row * D + col; st_bf4(MG + o, *(const f32x4*)(T + o) + ld_bf4(SGB + o) * v); } };
struct EpiRes { static constexpr bool BY_REGION = false; const float* xp; const float* xs; float* X; const float* modl; int gi;
    __device__ __forceinline__ void quad(int row, int col, f32x4 v) const {
        if (row >= MR) return;
        const float* src = row < MP ? xp + (size_t)row * D : xs + (size_t)(row - MP) * D;
        const f32x4 g = *(const f32x4*)(modl + (size_t)mod_row(row) * 6144 + gi * 1024 + col);
        *(f32x4*)(X + (size_t)row * D + col) = *(const f32x4*)(src + col) + g * v;
    } };
struct EpiFF1 { static constexpr bool BY_REGION = false; bf16* HM;
    __device__ __forceinline__ void quad(int row, int col, f32x4 v) const {
        f32x4 r;
#pragma unroll
        for (int j = 0; j < 4; ++j) { const float t = fmaxf(v[j], 0.f); r[j] = t * t; }
        st_bf4(HM + (size_t)row * FF + col, r);
    } };

template <class E>
__device__ __forceinline__ void naive_gemm_phase(Ctx& c, const bf16* A, const bf16* Bt, int M, int N, int K, const E& e) {
    LAS float* As = (LAS float*)c.lds;
    LAS float* Bs = As + 32 * 132;
    const int ntm = M / 128, ntn = N / 128, tx = c.tid & 31, ty = c.tid >> 5;
    const int lr = c.tid >> 2, lk = (c.tid & 3) * 8;
    for (int tile = c.wg; tile < ntm * ntn; tile += c.G) {
        const int tm = tile % ntm, tn = tile / ntm;
        f32x4 acc[8];
#pragma unroll
        for (int i = 0; i < 8; ++i) acc[i] = (f32x4){0.f, 0.f, 0.f, 0.f};
        for (int k0 = 0; k0 < K; k0 += 32) {
            const u32x4 av = *(const u32x4*)(A + (size_t)(tm * 128 + lr) * K + k0 + lk);
            const u32x4 bv = *(const u32x4*)(Bt + (size_t)(tn * 128 + lr) * K + k0 + lk);
            __syncthreads();
#pragma unroll
            for (int j = 0; j < 4; ++j) {
                As[(lk + 2 * j) * 132 + lr] = bf2f(av[j] & 0xffffu); As[(lk + 2 * j + 1) * 132 + lr] = bf2f(av[j] >> 16);
                Bs[(lk + 2 * j) * 132 + lr] = bf2f(bv[j] & 0xffffu); Bs[(lk + 2 * j + 1) * 132 + lr] = bf2f(bv[j] >> 16);
            }
            __syncthreads();
#pragma unroll 8
            for (int k = 0; k < 32; ++k) {
                const f32x4 a0 = *(const LAS f32x4*)(As + k * 132 + ty * 8), a1 = *(const LAS f32x4*)(As + k * 132 + ty * 8 + 4);
                const f32x4 b = *(const LAS f32x4*)(Bs + k * 132 + tx * 4);
                acc[0] += a0[0] * b; acc[1] += a0[1] * b; acc[2] += a0[2] * b; acc[3] += a0[3] * b;
                acc[4] += a1[0] * b; acc[5] += a1[1] * b; acc[6] += a1[2] * b; acc[7] += a1[3] * b;
            }
        }
#pragma unroll
        for (int i = 0; i < 8; ++i) e.quad(tm * 128 + ty * 8 + i, tn * 128 + tx * 4, acc[i]);
    }
    __syncthreads();
}

template <int SITE, class E>
__device__ __forceinline__ void gemm_phase_sel(Ctx& c, const bf16* A, const bf16* Bt, int M, int N, int K, const E& e) {
    if constexpr ((FAST_GEMM >> SITE) & 1) {
        pg8::Gemm g{A, Bt, M, N, K}; pg8::StaticOrder S; S.init(M, N, c.G, c.wg);
        if constexpr (E::BY_REGION) { EpiInUnit qe{e}; pg8::gemm_phase<EpiInUnit, pg8::StaticOrder, true, true>(c.lds, g, S, qe, c.tid); }
        else { QuadEpi<E> qe{e}; pg8::gemm_phase<QuadEpi<E>, pg8::StaticOrder, true, true>(c.lds, g, S, qe, c.tid); }
    } else naive_gemm_phase(c, A, Bt, M, N, K, e);
}

#define XB_TMO      128
#define XB_XCNT(j)  (256  + 64 * (j))
#define XB_XSUB(j)  (1280 + 64 * (j))
#define XB_XGEN(j)  (2304 + 64 * (j))
#define XB_TOP      3328
#define XB_TOPGEN   3392
#define XCD_BAR_WORDS 3456
#define XB_SPIN_CAP (1u << 18)
__device__ __forceinline__ unsigned xb_ld(unsigned* p)              { return __hip_atomic_load(p, __ATOMIC_RELAXED, __HIP_MEMORY_SCOPE_AGENT); }
__device__ __forceinline__ unsigned xb_add(unsigned* p, unsigned v) { return __hip_atomic_fetch_add(p, v, __ATOMIC_RELAXED, __HIP_MEMORY_SCOPE_AGENT); }
__device__ __forceinline__ unsigned xb_xcc_id() { return (unsigned)__builtin_amdgcn_s_getreg((3 << 11) | 20) & 0xFu; }
#define XB_SPIN(cond, bar) do { unsigned _sp = 0; while (cond) { __builtin_amdgcn_s_sleep(1); \
    if ((++_sp & 255u) == 0u) { if (xb_ld(&(bar)[XB_TMO])) break; if (_sp > XB_SPIN_CAP) { atomicAdd(&(bar)[XB_TMO], 1u); break; } } } } while (0)
struct XcdBarrier { unsigned* bar; unsigned x; volatile LAS unsigned* st; };
__device__ __forceinline__ XcdBarrier xcd_barrier_post(unsigned* bar, volatile LAS unsigned* st) {
    XcdBarrier b; b.bar = bar; b.x = xb_xcc_id(); b.st = st;
    if (threadIdx.x == 0) (void)xb_add(&bar[XB_XCNT(b.x)], 1u);
    return b;
}
__device__ __forceinline__ void xcd_barrier_complete(unsigned* bar, unsigned x, unsigned& nloc, unsigned& nx) {
    const unsigned G = gridDim.x * gridDim.y * gridDim.z;
    unsigned sum, cnt, mine, sp = 0u;
    for (;;) {
        sum = 0u; cnt = 0u; mine = 0u;
#pragma unroll
        for (unsigned j = 0; j < 16; ++j) { const unsigned c = xb_ld(&bar[XB_XCNT(j)]); sum += c; cnt += (c > 0u) ? 1u : 0u; mine = (j == x) ? c : mine; }
        if (sum == G) break;
        __builtin_amdgcn_s_sleep(1);
        if ((++sp & 255u) == 0u) { if (xb_ld(&bar[XB_TMO])) break; if (sp > XB_SPIN_CAP) { atomicAdd(&bar[XB_TMO], 1u); break; } }
    }
    nloc = mine > 0u ? mine : 1u; nx = cnt > 0u ? cnt : 1u;
}
__device__ __forceinline__ void xcd_barrier(const XcdBarrier& b) {
    asm volatile("s_waitcnt vmcnt(0)" ::: "memory");
    __syncthreads();
    if (threadIdx.x == 0) {
        unsigned* bar = b.bar; asm volatile("" : "+s"(bar));
        __builtin_amdgcn_s_waitcnt(0);
        unsigned nloc = b.st[0], nx = b.st[1];
        if (nloc == 0u) { xcd_barrier_complete(bar, b.x, nloc, nx); b.st[0] = nloc; b.st[1] = nx; }
        const unsigned old = xb_add(&bar[XB_XSUB(b.x)], 1u);
        const unsigned gen = old / nloc;
        if (old + 1u == (gen + 1u) * nloc) {
            __builtin_amdgcn_fence(__ATOMIC_RELEASE, "agent");
            asm volatile("s_waitcnt vmcnt(0)" ::: "memory");
            const unsigned og = xb_add(&bar[XB_TOP], 1u);
            const unsigned tg = og / nx;
            if (og + 1u == (tg + 1u) * nx) xb_add(&bar[XB_TOPGEN], 1u);
            else XB_SPIN(xb_ld(&bar[XB_TOPGEN]) == tg, bar);
            __builtin_amdgcn_fence(__ATOMIC_ACQUIRE, "agent");
            xb_add(&bar[XB_XGEN(b.x)], 1u);
            asm volatile("s_waitcnt vmcnt(0)" ::: "memory");
        } else {
            XB_SPIN(xb_ld(&bar[XB_XGEN(b.x)]) == gen, bar);
            __builtin_amdgcn_fence(__ATOMIC_ACQUIRE, "agent");
            asm volatile("s_waitcnt vmcnt(0)" ::: "memory");
        }
    }
    __syncthreads();
}

__device__ __forceinline__ void p0_transpose_item(const float* W, int K, int N, bf16* WT, LAS float* scr, int item, int lane) {
    const int nblk = N / 32, kb = item / nblk, nb = item % nblk, k0 = 64 * kb, n0 = 32 * nb;
#pragma unroll 8
    for (int i = 0; i < 32; ++i) { const int kk = 2 * i + (lane >> 5); scr[kk * 33 + (lane & 31)] = W[(size_t)(k0 + kk) * N + n0 + (lane & 31)]; }
    asm volatile("s_waitcnt lgkmcnt(0)" ::: "memory");
    const int ch = lane & 7;
#pragma unroll
    for (int j = 0; j < 4; ++j) { const int n = (lane >> 3) + 8 * j; const LAS float* s = scr + (8 * ch) * 33 + n;
        u32x4 o; o.x = pk2(s[0 * 33], s[1 * 33]); o.y = pk2(s[2 * 33], s[3 * 33]); o.z = pk2(s[4 * 33], s[5 * 33]); o.w = pk2(s[6 * 33], s[7 * 33]);
        *(u32x4*)(WT + (size_t)(n0 + n) * K + k0 + 8 * ch) = o; }
    asm volatile("s_waitcnt lgkmcnt(0)" ::: "memory");
}
__device__ __forceinline__ void p0_prologue(CArgs& a, Ctx& c) {
    {
        LAS float* scr = (LAS float*)(c.lds + __builtin_amdgcn_readfirstlane(c.tid >> 6) * 16384);
        const int gw = c.wg * 8 + __builtin_amdgcn_readfirstlane(c.tid >> 6), NGW = c.G * 8;
        constexpr int I_IN = 16 * 256, I_SQ = 16 * 32, I_1 = 16 * 128, I_2 = 64 * 32, I_L = 8 * 8, PER_L = I_IN + 3 * I_SQ + I_1 + I_2 + 2 * I_L;
        for (int it = gw; it < 2 * PER_L; it += NGW) {
            const int l = it / PER_L; int r = it % PER_L; bf16* wl = (bf16*)(a.ws + WS_W + (size_t)l * WL_STRIDE);
            if (r < I_IN) { p0_transpose_item(a.in[11] + (size_t)l * D * NIN, D, NIN, wl + OFF_WIN / 2, scr, r, (c.tid & 63)); continue; } r -= I_IN;
            if (r < I_SQ) { p0_transpose_item(a.in[21] + (size_t)l * D * D, D, D, wl + OFF_WA / 2, scr, r, (c.tid & 63)); continue; } r -= I_SQ;
            if (r < I_SQ) { p0_transpose_item(a.in[22] + (size_t)l * D * D, D, D, wl + OFF_WB / 2, scr, r, (c.tid & 63)); continue; } r -= I_SQ;
            if (r < I_SQ) { p0_transpose_item(a.in[23] + (size_t)l * D * D, D, D, wl + OFF_WO / 2, scr, r, (c.tid & 63)); continue; } r -= I_SQ;
            if (r < I_1) { p0_transpose_item(a.in[24] + (size_t)l * D * FF, D, FF, wl + OFF_W1 / 2, scr, r, (c.tid & 63)); continue; } r -= I_1;
            if (r < I_2) { p0_transpose_item(a.in[25] + (size_t)l * FF * D, FF, D, wl + OFF_W2 / 2, scr, r, (c.tid & 63)); continue; } r -= I_2;
            if (r < I_L) { const int n = r >> 3; p0_transpose_item(a.in[16] + ((size_t)l * 8 + n) * 16384, 128, 128, wl + OFF_LWA / 2 + n * 16384, scr, r & 7, (c.tid & 63)); continue; } r -= I_L;
            { const int n = r >> 3; p0_transpose_item(a.in[18] + ((size_t)l * 8 + n) * 16384, 128, 128, wl + OFF_LWX / 2 + n * 16384, scr, r & 7, (c.tid & 63)); }
        }
    }
    {
        float* lbt = (float*)(a.ws + WS_TAB); float* sp = (float*)(a.ws + WS_TAB + 32768);
        const int gid = c.wg * 512 + c.tid;
        if (gid < 2 * D) {
            const int l = gid >> 10, col = gid & 1023;
            const float h0 = a.in[12][col], h1 = a.in[12][D + col];
            const float p1 = 1.0f / (1.0f + expf(h0 - h1));
            const float lb = l == 0 ? 0.f : p1;
            lbt[(l * 3 + 0) * D + col] = lb; lbt[(l * 3 + 1) * D + col] = logf(fmaxf(lb, 1e-30f)); lbt[(l * 3 + 2) * D + col] = log1pf(-lb);
            sp[l * D + col] = softplusf_(-a.in[20][l * D + col]);
        }
    }
    __syncthreads();
    {
        LAS float* cs = (LAS float*)c.lds;
        float* MOD = (float*)(a.ws + WS_MOD);
        const int cq = c.tid & 15, rq = c.tid >> 4;
        for (int item = c.wg; item < 2 * 96; item += c.G) {
            const int l = item / 96, cg = item % 96;
            const float* W = a.in[7] + (size_t)l * D * 6144 + cg * 64 + 4 * cq;
            f32x4 acc[5];
#pragma unroll
            for (int i = 0; i < 5; ++i) acc[i] = (f32x4){0.f, 0.f, 0.f, 0.f};
            for (int k0 = 0; k0 < D; k0 += 128) {
                __syncthreads();
                for (int e = c.tid; e < 160 * 128; e += 512) { const int r = e >> 7, kk = e & 127;
                    float cv = 0.f;
                    if (r < NBATCH) cv = a.in[5][(size_t)r * D + k0 + kk]; else if (r < NMOD) cv = a.in[6][(size_t)(r - NBATCH) * D + k0 + kk];
                    cs[r * 132 + kk] = siluf_(cv); }
                __syncthreads();
#pragma unroll 2
                for (int kk = 0; kk < 128; kk += 4) {
                    const float* wp = W + (size_t)(k0 + kk) * 6144;
                    const f32x4 w0 = *(const f32x4*)wp, w1 = *(const f32x4*)(wp + 6144), w2 = *(const f32x4*)(wp + 2 * 6144), w3 = *(const f32x4*)(wp + 3 * 6144);
#pragma unroll
                    for (int i = 0; i < 5; ++i) { const f32x4 x = *(const LAS f32x4*)(cs + (5 * rq + i) * 132 + kk);
                        acc[i] += x[0] * w0 + x[1] * w1 + x[2] * w2 + x[3] * w3; }
                }
            }
            const f32x4 bm = *(const f32x4*)(a.in[8] + (size_t)l * 6144 + cg * 64 + 4 * cq);
#pragma unroll
            for (int i = 0; i < 5; ++i) { const int row = 5 * rq + i; if (row < NMOD) *(f32x4*)(MOD + ((size_t)l * NMOD + row) * 6144 + cg * 64 + 4 * cq) = acc[i] + bm; }
        }
    }
    __syncthreads();
}

__device__ __forceinline__ void norm_phase(CArgs& a, Ctx& c, int l, int which, const float* xp, const float* xs) {
    const int gw = c.wg * 8 + __builtin_amdgcn_readfirstlane(c.tid >> 6), NGW = c.G * 8;
    bf16* H = (bf16*)(a.ws + WS_H);
    const float* MODL = (const float*)(a.ws + WS_MOD) + (size_t)l * NMOD * 6144;
    const float* g = a.in[which ? 10 : 9] + (size_t)l * D;
    for (int row = gw; row < MR; row += NGW) {
        const float* xr = row < MP ? xp + (size_t)row * D : xs + (size_t)(row - MP) * D;
        const float* md = MODL + (size_t)mod_row(row) * 6144 + (which ? 3 : 0) * 1024;
        f32x4 v[4]; float ss = 0.f;
#pragma unroll
        for (int j = 0; j < 4; ++j) { v[j] = *(const f32x4*)(xr + 4 * (c.tid & 63) + 256 * j); ss += (v[j][0] * v[j][0] + v[j][1] * v[j][1]) + (v[j][2] * v[j][2] + v[j][3] * v[j][3]); }
        const float rstd = 1.0f / sqrtf(wave_sum(ss) * (1.0f / D) + EPS);
#pragma unroll
        for (int j = 0; j < 4; ++j) { const int cc = 4 * (c.tid & 63) + 256 * j;
            const f32x4 gg = *(const f32x4*)(g + cc), sh = *(const f32x4*)(md + cc), sc = *(const f32x4*)(md + 1024 + cc);
            st_bf4(H + (size_t)row * D + cc, v[j] * rstd * gg * (1.0f + sc) + sh); }
    }
}
__device__ __forceinline__ void final_norm_phase(CArgs& a, Ctx& c) {
    const int gw = c.wg * 8 + __builtin_amdgcn_readfirstlane(c.tid >> 6), NGW = c.G * 8;
    const float* g = a.in[26];
    for (int row = gw; row < MR; row += NGW) {
        float* xr = a.out + (size_t)row * D;
        f32x4 v[4]; float ss = 0.f;
#pragma unroll
        for (int j = 0; j < 4; ++j) { v[j] = *(const f32x4*)(xr + 4 * (c.tid & 63) + 256 * j); ss += (v[j][0] * v[j][0] + v[j][1] * v[j][1]) + (v[j][2] * v[j][2] + v[j][3] * v[j][3]); }
        const float rstd = 1.0f / sqrtf(wave_sum(ss) * (1.0f / D) + EPS);
#pragma unroll
        for (int j = 0; j < 4; ++j) { const int cc = 4 * (c.tid & 63) + 256 * j; *(f32x4*)(xr + cc) = v[j] * rstd * *(const f32x4*)(g + cc); }
    }
}

__device__ __forceinline__ void hgrn_naive(CArgs& a, Ctx& c, int l, int row0, int ntok, int h, const float* S0, float* Sout) {
    LAS float* fs = (LAS float*)c.lds;
    LAS float* ks = fs + 2048;
    LAS float* qs = ks + 2048;
    LAS float* vs = qs + 2048;
    LAS float* part = vs + 2048;
    const bf16* Q = (const bf16*)(a.ws + WS_Q); const bf16* Kb = (const bf16*)(a.ws + WS_K); const bf16* V = (const bf16*)(a.ws + WS_V); const bf16* OG = (const bf16*)(a.ws + WS_OG); bf16* OA = (bf16*)(a.ws + WS_OA);
    const float* LOGF = (const float*)(a.ws + WS_LOGF);
    const float* hg = a.in[13] + (size_t)l * DKV;
    const int v = c.tid & 127, kg = c.tid >> 7;
    float S[32];
#pragma unroll
    for (int i = 0; i < 32; ++i) S[i] = S0 ? S0[(size_t)(32 * kg + i) * DKV + v] : 0.f;
    for (int t0 = 0; t0 < ntok; t0 += 16) {
        const int nt = (ntok - t0) < 16 ? (ntok - t0) : 16;
        __syncthreads();
        { const int tt = c.tid >> 5, k4 = (c.tid & 31) * 4;
          if (tt < nt) { const size_t off = (size_t)(row0 + t0 + tt) * D + h * DKV + k4;
              const f32x4 lf = *(const f32x4*)(LOGF + off);
              *(LAS f32x4*)(fs + tt * 128 + k4) = (f32x4){expf(lf[0]), expf(lf[1]), expf(lf[2]), expf(lf[3])};
              *(LAS f32x4*)(ks + tt * 128 + k4) = ld_bf4(Kb + off);
              *(LAS f32x4*)(qs + tt * 128 + k4) = ld_bf4(Q + off);
              *(LAS f32x4*)(vs + tt * 128 + k4) = ld_bf4(V + off); } }
        __syncthreads();
        for (int tt = 0; tt < nt; ++tt) {
            const float vv = vs[tt * 128 + v]; float acc = 0.f;
#pragma unroll
            for (int i4 = 0; i4 < 8; ++i4) {
                const f32x4 f = *(const LAS f32x4*)(fs + tt * 128 + 32 * kg + 4 * i4), kk = *(const LAS f32x4*)(ks + tt * 128 + 32 * kg + 4 * i4), qq = *(const LAS f32x4*)(qs + tt * 128 + 32 * kg + 4 * i4);
#pragma unroll
                for (int j = 0; j < 4; ++j) { S[4 * i4 + j] = f[j] * S[4 * i4 + j] + kk[j] * vv; acc += S[4 * i4 + j] * qq[j]; }
            }
            part[(tt * 4 + kg) * 128 + v] = acc;
        }
        __syncthreads();
        { const int tt = c.tid >> 5, v4 = (c.tid & 31) * 4; const int tc = tt < nt ? tt : 0;
          const f32x4 o = *(const LAS f32x4*)(part + (tc * 4 + 0) * 128 + v4) + *(const LAS f32x4*)(part + (tc * 4 + 1) * 128 + v4)
                        + *(const LAS f32x4*)(part + (tc * 4 + 2) * 128 + v4) + *(const LAS f32x4*)(part + (tc * 4 + 3) * 128 + v4);
          float ss = (o[0] * o[0] + o[1] * o[1]) + (o[2] * o[2] + o[3] * o[3]);
          ss = half_sum(ss);
          const float rstd = 1.0f / sqrtf(ss * (1.0f / DKV) + EPS);
          if (tt < nt) { const size_t off = (size_t)(row0 + t0 + tt) * D + h * DKV + v4;
              st_bf4(OA + off, o * rstd * *(const f32x4*)(hg + v4) * ld_bf4(OG + off)); } }
    }
#pragma unroll
    for (int i = 0; i < 32; ++i) Sout[(size_t)(32 * kg + i) * DKV + v] = S[i];
    __syncthreads();
}


constexpr int HB_Q0 = 0, HB_K0 = 17408, HB_Q1 = 26112, HB_K1 = 34816, HB_KT0 = 43520, HB_KT1 = 53760, HB_VT = 64000, HB_AS = 82432, HB_ST = 91648, HB_VEC = 126464, HB_TOT = 128512, HB_SSQ = 130560;
constexpr int HS_Q = 272, HS_KT = 80, HS_VT = 144, HS_AS = 144;
static_assert(HB_SSQ + 2048 <= MISC_OFF, "hgrn lds");
__device__ __forceinline__ float exp_c(float x) { return __expf(fminf(x, 80.f)); }
__device__ __forceinline__ void hgrn_fast_prompt(CArgs& a, Ctx& c, int l, int b, int h) {
    LAS unsigned char* lds = c.lds;
    const int tid = c.tid, lane = tid & 63, w = __builtin_amdgcn_readfirstlane(tid >> 6), fr = lane & 15, fq = lane >> 4;
    const int col = tid & 127, sg = tid >> 7;
    const bf16* Q = (const bf16*)(a.ws + WS_Q); const bf16* Kb = (const bf16*)(a.ws + WS_K); const bf16* V = (const bf16*)(a.ws + WS_V); const bf16* OG = (const bf16*)(a.ws + WS_OG); bf16* OA = (bf16*)(a.ws + WS_OA);
    const float* LOGF = (const float*)(a.ws + WS_LOGF);
    const size_t base = (size_t)b * SEQ * D + (size_t)h * DKV;
    LAS float* VEC = (LAS float*)(lds + HB_VEC); LAS float* TOT = (LAS float*)(lds + HB_TOT); LAS float* SSQ = (LAS float*)(lds + HB_SSQ);
    LAS unsigned char* STw = lds + HB_ST + w * 4352;
    const float gv = a.in[13][(size_t)l * DKV + 16 * w + fr];
    f32x4 S[8];
#pragma unroll
    for (int i = 0; i < 8; ++i) S[i] = (f32x4){0.f, 0.f, 0.f, 0.f};
    __syncthreads();
    for (int e = tid; e < 2 * 16 * 16; e += 512) { const int which = e >> 8, r = (e >> 4) & 15, cc = e & 15;
        *(LAS bf16*)(lds + HB_AS + ((which ? 32 : 0) + r) * HS_AS + ((which ? 48 : 16) + cc) * 2) = 0; }
    float lf[16]; unsigned qr[16], kr[16], vr[16];
    { const size_t o0 = base + (size_t)(16 * sg) * D + col;
#pragma unroll
      for (int i = 0; i < 16; ++i) { lf[i] = LOGF[o0 + (size_t)i * D]; qr[i] = Q[o0 + (size_t)i * D]; kr[i] = Kb[o0 + (size_t)i * D]; vr[i] = V[o0 + (size_t)i * D]; } }
    for (int n = 0; n < SEQ / 64; ++n) {
        float g[16]; g[0] = lf[0];
#pragma unroll
        for (int i = 1; i < 16; ++i) g[i] = g[i - 1] + lf[i];
        TOT[sg * 128 + col] = g[15];
        __syncthreads();
        {
            const float t0 = TOT[col], t1 = TOT[128 + col], t2 = TOT[256 + col], t3 = TOT[384 + col];
            const float off = (sg > 0 ? t0 : 0.f) + (sg > 1 ? t1 : 0.f) + (sg > 2 ? t2 : 0.f);
            const float r0 = t0, r1 = t0 + t1 + t2, last = r1 + t3;
            unsigned kt[8], vt[8];
#pragma unroll
            for (int i = 0; i < 16; ++i) {
                const float G = g[i] + off, qv = bf2f(qr[i]), kv = bf2f(kr[i]);
                const int t = 16 * sg + i;
                *(LAS bf16*)(lds + HB_Q0 + t * HS_Q + col * 2) = (bf16)f2bf(qv * exp_c(G - r0));
                unsigned kb;
                if (sg < 2) { kb = f2bf(kv * exp_c(r0 - G)); *(LAS bf16*)(lds + HB_K0 + t * HS_Q + col * 2) = (bf16)kb; }
                else { kb = f2bf(kv * exp_c(r1 - G)); *(LAS bf16*)(lds + HB_K1 + (t - 32) * HS_Q + col * 2) = (bf16)kb;
                       *(LAS bf16*)(lds + HB_Q1 + (t - 32) * HS_Q + col * 2) = (bf16)f2bf(qv * exp_c(G - r1)); }
                if (i & 1) { kt[i >> 1] |= kb << 16; vt[i >> 1] |= vr[i] << 16; } else { kt[i >> 1] = kb; vt[i >> 1] = vr[i]; }
            }
            { LAS unsigned char* p = lds + (sg < 2 ? HB_KT0 : HB_KT1) + col * HS_KT + (sg & 1) * 32;
              *(LAS u32x4*)p = (u32x4){kt[0], kt[1], kt[2], kt[3]}; *(LAS u32x4*)(p + 16) = (u32x4){kt[4], kt[5], kt[6], kt[7]}; }
            { LAS unsigned char* p = lds + HB_VT + col * HS_VT + sg * 32;
              *(LAS u32x4*)p = (u32x4){vt[0], vt[1], vt[2], vt[3]}; *(LAS u32x4*)(p + 16) = (u32x4){vt[4], vt[5], vt[6], vt[7]}; }
            VEC[sg * 128 + col] = exp_c(sg == 0 ? r0 : (sg == 1 ? last : (sg == 2 ? last - r0 : last - r1)));
        }
        unsigned ogr[16];
        { const size_t oo = base + (size_t)(64 * n + 4 * fq) * D + 16 * w + fr;
#pragma unroll
          for (int tt = 0; tt < 4; ++tt)
#pragma unroll
              for (int j = 0; j < 4; ++j) ogr[tt * 4 + j] = OG[oo + (size_t)(16 * tt + j) * D]; }
        if (n + 1 < SEQ / 64) { const size_t o0 = base + (size_t)(64 * (n + 1) + 16 * sg) * D + col;
#pragma unroll
            for (int i = 0; i < 16; ++i) { lf[i] = LOGF[o0 + (size_t)i * D]; qr[i] = Q[o0 + (size_t)i * D]; kr[i] = Kb[o0 + (size_t)i * D]; vr[i] = V[o0 + (size_t)i * D]; } }
        __syncthreads();
#pragma unroll
        for (int kt8 = 0; kt8 < 8; ++kt8) { const f32x4 er = *(const LAS f32x4*)(VEC + 16 * kt8 + 4 * fq);
            u32x2 pw; pw.x = pk2(S[kt8][0] * er[0], S[kt8][1] * er[1]); pw.y = pk2(S[kt8][2] * er[2], S[kt8][3] * er[3]);
            *(LAS u32x2*)(STw + fr * HS_Q + (16 * kt8 + 4 * fq) * 2) = pw; }
#pragma unroll
        for (int rep = 0; rep < 2; ++rep) {
            const int id = w + 8 * rep;
            if (id < 10) {
                int tt, st;
                if (id == 0) { tt = 0; st = 0; } else if (id < 7) { tt = (id + 1) >> 1; st = (id + 1) & 1; } else if (id == 7) { tt = 2; st = 2; } else { tt = 3; st = id - 6; }
                const LAS unsigned char* ap = (st < 2) ? lds + HB_Q0 + (16 * tt + fr) * HS_Q : lds + HB_Q1 + (16 * (tt - 2) + fr) * HS_Q;
                const LAS unsigned char* bp = (st < 2) ? lds + HB_K0 + (16 * st + fr) * HS_Q : lds + HB_K1 + (16 * (st - 2) + fr) * HS_Q;
                f32x4 acc = (f32x4){0.f, 0.f, 0.f, 0.f};
#pragma unroll
                for (int ks = 0; ks < 4; ++ks) acc = __builtin_amdgcn_mfma_f32_16x16x32_bf16(*(const LAS bf16x8*)(ap + (32 * ks + 8 * fq) * 2), *(const LAS bf16x8*)(bp + (32 * ks + 8 * fq) * 2), acc, 0, 0, 0);
#pragma unroll
                for (int j = 0; j < 4; ++j) { const float v_ = (tt == st && fr > 4 * fq + j) ? 0.f : acc[j];
                    *(LAS bf16*)(lds + HB_AS + (16 * tt + 4 * fq + j) * HS_AS + (16 * st + fr) * 2) = (bf16)f2bf(v_); }
            }
        }
        f32x4 o[4];
#pragma unroll
        for (int tt = 0; tt < 4; ++tt) o[tt] = (f32x4){0.f, 0.f, 0.f, 0.f};
#pragma unroll
        for (int ks = 0; ks < 4; ++ks) { const bf16x8 bfr = *(const LAS bf16x8*)(STw + fr * HS_Q + (32 * ks + 8 * fq) * 2);
#pragma unroll
            for (int tt = 0; tt < 4; ++tt) o[tt] = __builtin_amdgcn_mfma_f32_16x16x32_bf16(*(const LAS bf16x8*)(lds + HB_Q0 + (16 * tt + fr) * HS_Q + (32 * ks + 8 * fq) * 2), bfr, o[tt], 0, 0, 0); }
        __syncthreads();
#pragma unroll
        for (int tt = 0; tt < 4; ++tt)
#pragma unroll
            for (int ks = 0; ks < 2; ++ks) if (ks == 0 || tt >= 2)
                o[tt] = __builtin_amdgcn_mfma_f32_16x16x32_bf16(*(const LAS bf16x8*)(lds + HB_AS + (16 * tt + fr) * HS_AS + (32 * ks + 8 * fq) * 2), *(const LAS bf16x8*)(lds + HB_VT + (16 * w + fr) * HS_VT + (32 * ks + 8 * fq) * 2), o[tt], 0, 0, 0);
#pragma unroll
        for (int tt = 0; tt < 4; ++tt)
#pragma unroll
            for (int j = 0; j < 4; ++j) { float p = o[tt][j] * o[tt][j];
                p += __shfl_xor(p, 1); p += __shfl_xor(p, 2); p += __shfl_xor(p, 4); p += __shfl_xor(p, 8);
                if (fr == 0) SSQ[w * 64 + 16 * tt + 4 * fq + j] = p; }
#pragma unroll
        for (int kt8 = 0; kt8 < 8; ++kt8) {
            const f32x4 z = (f32x4){0.f, 0.f, 0.f, 0.f};
            const f32x4 U0 = __builtin_amdgcn_mfma_f32_16x16x32_bf16(*(const LAS bf16x8*)(lds + HB_KT0 + (16 * kt8 + fr) * HS_KT + 8 * fq * 2), *(const LAS bf16x8*)(lds + HB_VT + (16 * w + fr) * HS_VT + 8 * fq * 2), z, 0, 0, 0);
            const f32x4 U1 = __builtin_amdgcn_mfma_f32_16x16x32_bf16(*(const LAS bf16x8*)(lds + HB_KT1 + (16 * kt8 + fr) * HS_KT + 8 * fq * 2), *(const LAS bf16x8*)(lds + HB_VT + (16 * w + fr) * HS_VT + (32 + 8 * fq) * 2), z, 0, 0, 0);
            const f32x4 eL = *(const LAS f32x4*)(VEC + 128 + 16 * kt8 + 4 * fq), eL0 = *(const LAS f32x4*)(VEC + 256 + 16 * kt8 + 4 * fq), eL1 = *(const LAS f32x4*)(VEC + 384 + 16 * kt8 + 4 * fq);
            S[kt8] = eL * S[kt8] + eL0 * U0 + eL1 * U1;
        }
        __syncthreads();
#pragma unroll
        for (int tt = 0; tt < 4; ++tt)
#pragma unroll
            for (int j = 0; j < 4; ++j) { const int t = 16 * tt + 4 * fq + j;
                float ss = 0.f;
#pragma unroll
                for (int ww = 0; ww < 8; ++ww) ss += SSQ[ww * 64 + t];
                const float rstd = 1.0f / sqrtf(ss * (1.0f / DKV) + EPS);
                OA[base + (size_t)(64 * n + t) * D + 16 * w + fr] = (bf16)f2bf(o[tt][j] * rstd * gv * bf2f(ogr[tt * 4 + j])); }
    }
    { float* Sout = a.out + O_HGP + (((size_t)l * NBATCH + b) * NH + h) * DKV * DKV;
#pragma unroll
      for (int kt8 = 0; kt8 < 8; ++kt8)
#pragma unroll
          for (int j = 0; j < 4; ++j) Sout[(size_t)(16 * kt8 + 4 * fq + j) * DKV + 16 * w + fr] = S[kt8][j]; }
    __syncthreads();
}

constexpr int L_XBS = 0, L_XC = 67 * 128, L_AS = L_XC + 8192, L_BS = L_AS + 8192, L_SEG = L_BS + 8192, L_CARRY = L_SEG + 1024;
constexpr int LB_XCB = (L_CARRY + 128) * 4, XCB_STRIDE = 272;
static_assert(LB_XCB + 64 * XCB_STRIDE <= MISC_OFF && LB_XCB % 16 == 0, "lru lds");
__device__ __forceinline__ void lru_gates_naive(CArgs& a, Ctx& c, int l, int n) {
    LAS float* XC = (LAS float*)c.lds + L_XC; LAS float* As = (LAS float*)c.lds + L_AS; LAS float* Bs = (LAS float*)c.lds + L_BS;
    const bf16* wl = (const bf16*)(a.ws + WS_W + (size_t)l * WL_STRIDE);
    const int e = c.tid & 127, tg = c.tid >> 7;
    const bf16* wa = wl + OFF_LWA / 2 + (size_t)(n * 128 + e) * 128; const bf16* wx = wl + OFF_LWX / 2 + (size_t)(n * 128 + e) * 128;
    const int ch = n * 128 + e;
    const float ba = a.in[17][(size_t)l * D + ch], bx = a.in[19][(size_t)l * D + ch], sp = ((const float*)(a.ws + WS_TAB + 32768))[l * D + ch];
#pragma unroll 1
    for (int tq = 0; tq < 4; ++tq) {
        float ra[4], ia[4];
#pragma unroll
        for (int i = 0; i < 4; ++i) { ra[i] = 0.f; ia[i] = 0.f; }
        const LAS float* xc = XC + (tg * 16 + tq * 4) * 128;
#pragma unroll 1
        for (int d0 = 0; d0 < 128; d0 += 8) {
            const f32x4 wa0 = ld_bf4(wa + d0), wa1 = ld_bf4(wa + d0 + 4), wx0 = ld_bf4(wx + d0), wx1 = ld_bf4(wx + d0 + 4);
#pragma unroll
            for (int tt = 0; tt < 4; ++tt) {
                const f32x4 x0 = *(const LAS f32x4*)(xc + tt * 128 + d0), x1 = *(const LAS f32x4*)(xc + tt * 128 + d0 + 4);
                ra[tt] += (x0[0] * wa0[0] + x0[1] * wa0[1]) + (x0[2] * wa0[2] + x0[3] * wa0[3]) + (x1[0] * wa1[0] + x1[1] * wa1[1]) + (x1[2] * wa1[2] + x1[3] * wa1[3]);
                ia[tt] += (x0[0] * wx0[0] + x0[1] * wx0[1]) + (x0[2] * wx0[2] + x0[3] * wx0[3]) + (x1[0] * wx1[0] + x1[1] * wx1[1]) + (x1[2] * wx1[2] + x1[3] * wx1[3]);
            }
        }
#pragma unroll
        for (int tt = 0; tt < 4; ++tt) {
            const int t = tg * 16 + tq * 4 + tt;
            const float r = sigmoidf_(ra[tt] + ba), ig = sigmoidf_(ia[tt] + bx);
            const float la = -8.0f * r * sp, aa = expf(la), mult = sqrtf(-expm1f(2.0f * la));
            As[t * 128 + e] = aa; Bs[t * 128 + e] = mult * ig * XC[t * 128 + e];
        }
    }
}
__device__ __forceinline__ void lru_gates_mfma(CArgs& a, Ctx& c, int l, int n) {
    LAS float* XC = (LAS float*)c.lds + L_XC; LAS float* As = (LAS float*)c.lds + L_AS; LAS float* Bs = (LAS float*)c.lds + L_BS;
    const bf16* wl = (const bf16*)(a.ws + WS_W + (size_t)l * WL_STRIDE);
    const int lane = c.tid & 63, w = __builtin_amdgcn_readfirstlane(c.tid >> 6), fr = lane & 15, fq = lane >> 4;
    const int e = 16 * w + fr, ch = n * 128 + e;
    const bf16* wa = wl + OFF_LWA / 2 + (size_t)(n * 128 + e) * 128 + 8 * fq; const bf16* wx = wl + OFF_LWX / 2 + (size_t)(n * 128 + e) * 128 + 8 * fq;
    bf16x8 Ba[4], Bx[4];
#pragma unroll
    for (int ks = 0; ks < 4; ++ks) { Ba[ks] = *(const bf16x8*)(wa + 32 * ks); Bx[ks] = *(const bf16x8*)(wx + 32 * ks); }
    const float ba = a.in[17][(size_t)l * D + ch], bx = a.in[19][(size_t)l * D + ch], sp = ((const float*)(a.ws + WS_TAB + 32768))[l * D + ch];
#pragma unroll
    for (int m = 0; m < 4; ++m) {
        f32x4 ar = (f32x4){0.f, 0.f, 0.f, 0.f}, ai = (f32x4){0.f, 0.f, 0.f, 0.f};
#pragma unroll
        for (int ks = 0; ks < 4; ++ks) {
            const bf16x8 af = *(const LAS bf16x8*)(c.lds + LB_XCB + (16 * m + fr) * XCB_STRIDE + (32 * ks + 8 * fq) * 2);
            ar = __builtin_amdgcn_mfma_f32_16x16x32_bf16(af, Ba[ks], ar, 0, 0, 0);
            ai = __builtin_amdgcn_mfma_f32_16x16x32_bf16(af, Bx[ks], ai, 0, 0, 0);
        }
#pragma unroll
        for (int j = 0; j < 4; ++j) {
            const int t = 16 * m + 4 * fq + j;
            const float r = sigmoidf_(ar[j] + ba), ig = sigmoidf_(ai[j] + bx);
            const float la = -8.0f * r * sp, aa = expf(la), mult = sqrtf(-expm1f(2.0f * la));
            As[t * 128 + e] = aa; Bs[t * 128 + e] = mult * ig * XC[t * 128 + e];
        }
    }
}
#if FAST_GATES
#define lru_gates lru_gates_mfma
#else
#define lru_gates lru_gates_naive
#endif

__device__ __forceinline__ void lru_prompt_item(CArgs& a, Ctx& c, int l, int b, int n) {
    LAS float* L = (LAS float*)c.lds;
    const bf16* XB = (const bf16*)(a.ws + WS_XB); const bf16* YG = (const bf16*)(a.ws + WS_YG); bf16* OB = (bf16*)(a.ws + WS_OB);
    const int t_ld = c.tid >> 3, c0 = (c.tid & 7) * 16;
    const int cch = c.tid & 127, sg = c.tid >> 7;
    const float* cw = a.in[14] + (size_t)l * 4 * D + n * 128; const float* cb = a.in[15] + (size_t)l * D + n * 128;
    __syncthreads();
    if (c.tid < 128) L[L_CARRY + c.tid] = 0.f;
    if (c.tid < 384) L[L_XBS + c.tid] = 0.f;
    for (int t0 = 0; t0 < SEQ; t0 += 64) {
        __syncthreads();
        { const bf16* src = XB + (size_t)(b * SEQ + t0 + t_ld) * D + n * 128 + c0;
          const f32x4 x0 = ld_bf4(src), x1 = ld_bf4(src + 4), x2 = ld_bf4(src + 8), x3 = ld_bf4(src + 12);
          LAS float* dst = L + L_XBS + (3 + t_ld) * 128 + c0;
          *(LAS f32x4*)dst = x0; *(LAS f32x4*)(dst + 4) = x1; *(LAS f32x4*)(dst + 8) = x2; *(LAS f32x4*)(dst + 12) = x3; }
        __syncthreads();
#pragma unroll
        for (int j4 = 0; j4 < 4; ++j4) { const int cc = c0 + 4 * j4;
            f32x4 acc = *(const f32x4*)(cb + cc);
#pragma unroll
            for (int j = 0; j < 4; ++j) acc += *(const f32x4*)(cw + j * D + cc) * *(const LAS f32x4*)(L + L_XBS + (t_ld + j) * 128 + cc);
            *(LAS f32x4*)(L + L_XC + t_ld * 128 + cc) = acc;
            { u32x2 w; w.x = pk2(acc[0], acc[1]); w.y = pk2(acc[2], acc[3]); *(LAS u32x2*)(c.lds + LB_XCB + t_ld * XCB_STRIDE + cc * 2) = w; } }
        __syncthreads();
        lru_gates(a, c, l, n);
        __syncthreads();
        float P = 1.f, Bv = 0.f;
#pragma unroll 4
        for (int tt = 0; tt < 16; ++tt) { const float aa = L[L_AS + (sg * 16 + tt) * 128 + cch], bb = L[L_BS + (sg * 16 + tt) * 128 + cch]; Bv = aa * Bv + bb; P *= aa; }
        L[L_SEG + (sg * 128 + cch) * 2] = P; L[L_SEG + (sg * 128 + cch) * 2 + 1] = Bv;
        __syncthreads();
        float h = L[L_CARRY + cch];
        for (int s = 0; s < sg; ++s) h = L[L_SEG + (s * 128 + cch) * 2] * h + L[L_SEG + (s * 128 + cch) * 2 + 1];
#pragma unroll 4
        for (int tt = 0; tt < 16; ++tt) { const int t = sg * 16 + tt; const size_t off = (size_t)(b * SEQ + t0 + t) * D + n * 128 + cch;
            h = L[L_AS + t * 128 + cch] * h + L[L_BS + t * 128 + cch];
            OB[off] = (bf16)f2bf(h * bf2f(YG[off])); }
        __syncthreads();
        if (sg == 3) L[L_CARRY + cch] = h;
        if (c.tid < 384) L[L_XBS + c.tid] = L[L_XBS + 64 * 128 + c.tid];
    }
    __syncthreads();
    if (c.tid < 128) a.out[O_LRP + ((size_t)l * NBATCH + b) * D + n * 128 + c.tid] = L[L_CARRY + c.tid];
    if (c.tid < 384) a.out[O_CVP + (((size_t)l * NBATCH + b) * 3 + (c.tid >> 7)) * D + n * 128 + (c.tid & 127)] = L[L_XBS + c.tid];
    __syncthreads();
}
__device__ __forceinline__ void lru_sample_item(CArgs& a, Ctx& c, int l, int n, int hf) {
    LAS float* L = (LAS float*)c.lds;
    const bf16* XB = (const bf16*)(a.ws + WS_XB); const bf16* YG = (const bf16*)(a.ws + WS_YG); bf16* OB = (bf16*)(a.ws + WS_OB);
    const int t_ld = c.tid >> 3, c0 = (c.tid & 7) * 16;
    const float* cw = a.in[14] + (size_t)l * 4 * D + n * 128; const float* cb = a.in[15] + (size_t)l * D + n * 128;
    const int bs = hf * 64 + t_ld, row = MP + bs;
    const float* sc = a.in[4] + ((size_t)l * NS + bs) * 3 * D + n * 128;
    float* nc = a.out + O_CVS + ((size_t)l * NS + bs) * 3 * D + n * 128;
    __syncthreads();
#pragma unroll
    for (int j4 = 0; j4 < 4; ++j4) { const int cc = c0 + 4 * j4;
        const f32x4 x = ld_bf4(XB + (size_t)row * D + n * 128 + cc);
        const f32x4 s0 = *(const f32x4*)(sc + cc), s1 = *(const f32x4*)(sc + D + cc), s2 = *(const f32x4*)(sc + 2 * D + cc);
        const f32x4 acc = *(const f32x4*)(cb + cc) + *(const f32x4*)(cw + cc) * s0 + *(const f32x4*)(cw + D + cc) * s1 + *(const f32x4*)(cw + 2 * D + cc) * s2 + *(const f32x4*)(cw + 3 * D + cc) * x;
        *(LAS f32x4*)(L + L_XC + t_ld * 128 + cc) = acc;
        { u32x2 w; w.x = pk2(acc[0], acc[1]); w.y = pk2(acc[2], acc[3]); *(LAS u32x2*)(c.lds + LB_XCB + t_ld * XCB_STRIDE + cc * 2) = w; }
        *(f32x4*)(nc + cc) = s1; *(f32x4*)(nc + D + cc) = s2; *(f32x4*)(nc + 2 * D + cc) = x; }
    __syncthreads();
    lru_gates(a, c, l, n);
    __syncthreads();
    { const int cch = c.tid & 127, tg = c.tid >> 7;
#pragma unroll 4
      for (int tt = 0; tt < 16; ++tt) { const int t = tg * 16 + tt, b2 = hf * 64 + t; const size_t off = (size_t)(MP + b2) * D + n * 128 + cch;
          const float h0 = a.in[3][((size_t)l * NS + b2) * D + n * 128 + cch];
          const float h = L[L_AS + t * 128 + cch] * h0 + L[L_BS + t * 128 + cch];
          a.out[O_LRS + ((size_t)l * NS + b2) * D + n * 128 + cch] = h;
          OB[off] = (bf16)f2bf(h * bf2f(YG[off])); } }
    __syncthreads();
}

__device__ __forceinline__ void mixer_phase(CArgs& a, Ctx& c, int l) {
    if (c.wg < 64) {
        const int b = c.wg >> 3, h = c.wg & 7;
#if FAST_HGRN
        hgrn_fast_prompt(a, c, l, b, h);
#else
        hgrn_naive(a, c, l, b * SEQ, SEQ, h, nullptr, a.out + O_HGP + (((size_t)l * NBATCH + b) * NH + h) * DKV * DKV);
#endif
    } else if (c.wg < 128) {
        const int i = c.wg - 64;
        lru_prompt_item(a, c, l, i >> 3, i & 7);
        if (i < 16) lru_sample_item(a, c, l, i >> 1, i & 1);
    } else {
        for (int it = c.wg - 128; it < NS * NH; it += c.G - 128) {
            const int bs = it >> 3, h = it & 7; const size_t so = (((size_t)l * NS + bs) * NH + h) * DKV * DKV;
            hgrn_naive(a, c, l, MP + bs, 1, h, a.in[2] + so, a.out + O_HGS + so);
        }
    }
}

__global__ void __launch_bounds__(512, 2) mega_fwd(Args a0) {
    extern __shared__ __attribute__((aligned(16))) unsigned char lds_raw[];
    Ctx c; c.lds = (LAS unsigned char*)lds_raw; c.tid = threadIdx.x; c.G = gridDim.x; c.wg = blockIdx.x;
    volatile LAS unsigned* MISC = (volatile LAS unsigned*)(c.lds + MISC_OFF);
    if (c.tid < 32) MISC[c.tid] = 0u;
    __syncthreads();
    XcdBarrier bar; bar.bar = (unsigned*)(a0.ws + WS_CTL) + 1024; bar.x = 0; bar.st = nullptr;
    if (a0.ph_hi - a0.ph_lo > 1) bar = xcd_barrier_post((unsigned*)(a0.ws + WS_CTL) + 1024, MISC + 8);

    for (int ph = a0.ph_lo; ph < a0.ph_hi; ++ph) {
        CArgs* ap = (CArgs*)__builtin_amdgcn_kernarg_segment_ptr(); asm volatile("" : "+s"(ap));
        CArgs& a = *ap;
        { int t_ = threadIdx.x, w_ = blockIdx.x, g_ = gridDim.x; asm volatile("" : "+v"(t_), "+s"(w_), "+s"(g_)); c.tid = t_; c.wg = w_; c.G = g_; }
        float* X = a.out;
        if (ph == 0) p0_prologue(a, c);
        else if (ph == NPHASE - 1) final_norm_phase(a, c);
        else {
            const int l = (ph - 1) >> 3, j = (ph - 1) & 7;
            const bf16* wl = (const bf16*)(a.ws + WS_W + (size_t)l * WL_STRIDE);
            const float* xp = l == 0 ? a.in[0] : X; const float* xs = l == 0 ? a.in[1] : X + (size_t)MP * D;
            const float* modl = (const float*)(a.ws + WS_MOD) + (size_t)l * NMOD * 6144;
            bf16* H = (bf16*)(a.ws + WS_H);
            if (j == 0) norm_phase(a, c, l, 0, xp, xs);
            else if (j == 1) {
                EpiIn e{(bf16*)(a.ws + WS_Q), (bf16*)(a.ws + WS_K), (bf16*)(a.ws + WS_V), (bf16*)(a.ws + WS_OG), (bf16*)(a.ws + WS_XB), (bf16*)(a.ws + WS_YG), (bf16*)(a.ws + WS_SGA), (bf16*)(a.ws + WS_SGB),
                        (float*)(a.ws + WS_LOGF), (const float*)(a.ws + WS_TAB) + (size_t)l * 3 * D};
                gemm_phase_sel<0>(c, H, wl + OFF_WIN / 2, MT, NIN, D, e);
            } else if (j == 2) mixer_phase(a, c, l);
            else if (j == 3) {
                EpiBrA ea{(const bf16*)(a.ws + WS_SGA), (float*)(a.ws + WS_T)};
                gemm_phase_sel<1>(c, (const bf16*)(a.ws + WS_OA), wl + OFF_WA / 2, MT, D, D, ea);
                asm volatile("s_waitcnt vmcnt(0)" ::: "memory"); __syncthreads();
                { int t_ = threadIdx.x; asm volatile("" : "+v"(t_)); c.tid = t_; }
                EpiBrB eb{(const bf16*)(a.ws + WS_SGB), (const float*)(a.ws + WS_T), (bf16*)(a.ws + WS_MG)};
                gemm_phase_sel<2>(c, (const bf16*)(a.ws + WS_OB), wl + OFF_WB / 2, MT, D, D, eb);
            } else if (j == 4) {
                EpiRes e{xp, xs, X, modl, 2};
                gemm_phase_sel<3>(c, (const bf16*)(a.ws + WS_MG), wl + OFF_WO / 2, MT, D, D, e);
            } else if (j == 5) norm_phase(a, c, l, 1, X, X + (size_t)MP * D);
            else if (j == 6) { EpiFF1 e{(bf16*)(a.ws + WS_HM)}; gemm_phase_sel<4>(c, H, wl + OFF_W1 / 2, MT, FF, D, e); }
            else { EpiRes e{X, X + (size_t)MP * D, X, modl, 5}; gemm_phase_sel<5>(c, (const bf16*)(a.ws + WS_HM), wl + OFF_W2 / 2, MT, D, FF, e); }
        }
        if (ph + 1 < a0.ph_hi) xcd_barrier(bar);
    }
}

extern "C" void kernel_launch(void* const* d_in, const int* in_sizes, int n_in, void* d_out, int out_size, void* d_ws, size_t ws_size, hipStream_t stream) {
    static int grid = 0;
    if (grid == 0) {
        if (n_in != 27 || out_size != (int)O_END || ws_size < WS_END) { fprintf(stderr, "kernel_launch: unexpected shapes (n_in %d out %d ws %zu)\n", n_in, out_size, ws_size); grid = -1; return; }
        int dev = 0, cus = 0, per_cu = 0;
        if (hipGetDevice(&dev) != hipSuccess || hipDeviceGetAttribute(&cus, hipDeviceAttributeMultiprocessorCount, dev) != hipSuccess) { grid = -1; return; }
        if (hipFuncSetAttribute((const void*)mega_fwd, hipFuncAttributeMaxDynamicSharedMemorySize, LDS_BYTES) != hipSuccess) { fprintf(stderr, "kernel_launch: hipFuncSetAttribute failed\n"); grid = -1; return; }
        if (hipOccupancyMaxActiveBlocksPerMultiprocessor(&per_cu, (const void*)mega_fwd, 512, LDS_BYTES) != hipSuccess || per_cu < 1) { fprintf(stderr, "kernel_launch: occupancy query failed (%d)\n", per_cu); (void)hipGetLastError(); per_cu = 1; }
        grid = cus * (per_cu < 1 ? 1 : 1);
        fprintf(stderr, "kernel_launch: cus %d per_cu %d grid %d\n", cus, per_cu, grid);
    }
    if (grid < 0) return;
    (void)hipMemsetAsync((char*)d_ws + WS_CTL, 0, CTL_BYTES, stream);
    Args a{};
    for (int i = 0; i < 27; ++i) a.in[i] = (const float*)d_in[i];
    a.out = (float*)d_out; a.ws = (unsigned char*)d_ws;
#if ONE_LAUNCH
    a.ph_lo = 0; a.ph_hi = NPHASE;
    void* kargs[] = {&a};
    hipError_t e = hipLaunchCooperativeKernel((const void*)mega_fwd, dim3(grid), dim3(512), kargs, LDS_BYTES, stream);
    if (e != hipSuccess) fprintf(stderr, "kernel_launch: cooperative launch failed: %s (grid %d)\n", hipGetErrorString(e), grid);
#else
    for (int ph = 0; ph < NPHASE; ++ph) { a.ph_lo = ph; a.ph_hi = ph + 1;
        for (int rep = 0; rep < 1 + (int)((PROBE_REPEAT >> ph) & 1); ++rep) hipLaunchKernelGGL(mega_fwd, dim3(grid), dim3(512), LDS_BYTES, stream, a); }
#endif
}
```

```cpp
#include <hip/hip_runtime.h>
#include <cstdio>
#include <cstdint>

#ifndef FAST_GEMM
#define FAST_GEMM 63
#endif
#ifndef FAST_HGRN
#define FAST_HGRN 1
#endif
#ifndef FAST_GATES
#define FAST_GATES 1
#endif
#ifndef DBG_SHFL
#define DBG_SHFL 1
#endif
#ifndef PROBE_REPEAT
#define PROBE_REPEAT 0
#endif
#ifndef PROBE_MIX
#define PROBE_MIX 0
#endif
#ifndef ONE_LAUNCH
#define ONE_LAUNCH 1
#endif

#define LAS __attribute__((address_space(3)))
#define GAS __attribute__((address_space(1)))
typedef unsigned short bf16;
typedef float f32x4 __attribute__((ext_vector_type(4)));
typedef float f32x2 __attribute__((ext_vector_type(2)));
typedef short bf16x8 __attribute__((ext_vector_type(8)));
typedef unsigned u32x4 __attribute__((ext_vector_type(4)));
typedef unsigned u32x2 __attribute__((ext_vector_type(2)));

constexpr int D = 1024, NBATCH = 8, SEQ = 2048, MP = NBATCH * SEQ, NS = 128, MR = MP + NS, MT = 16640;
constexpr int NMOD = NBATCH + NS;
constexpr int NIN = 8192, FF = 4096, NH = 8, DKV = 128;
constexpr float EPS = 1e-6f;
constexpr int NPHASE = 18;

constexpr size_t MiB = (size_t)1 << 20;
constexpr size_t WS_CTL = 0, CTL_BYTES = 64 * 1024;
constexpr size_t WS_TAB = 1 * MiB;
constexpr size_t WS_MOD = 2 * MiB;
constexpr size_t WS_W = 9 * MiB, WL_STRIDE = 77 * MiB / 2;
constexpr size_t OFF_WIN = 0, OFF_WA = 16 * MiB, OFF_WB = 18 * MiB, OFF_WO = 20 * MiB, OFF_W1 = 22 * MiB, OFF_W2 = 30 * MiB, OFF_LWA = 38 * MiB, OFF_LWX = 38 * MiB + 256 * 1024;
constexpr size_t WS_H = 86 * MiB;
constexpr size_t WS_Q = 119 * MiB, WS_K = 152 * MiB, WS_V = 185 * MiB, WS_OG = 218 * MiB, WS_XB = 251 * MiB, WS_YG = 284 * MiB, WS_SGA = 317 * MiB, WS_SGB = 350 * MiB;
constexpr size_t WS_LOGF = 383 * MiB;
constexpr size_t WS_T = WS_LOGF;
constexpr size_t WS_MG = WS_K;
constexpr size_t WS_HM = WS_OG;
constexpr size_t WS_OA = 448 * MiB;
constexpr size_t WS_OB = WS_H;
constexpr size_t WS_END = 481 * MiB;
static_assert(WS_W + 2 * WL_STRIDE <= WS_H && WS_H + (size_t)MT * D * 2 <= WS_Q && WS_LOGF + (size_t)MT * D * 4 <= WS_OA && WS_OA + (size_t)MT * D * 2 <= WS_END && WS_HM + (size_t)MT * FF * 2 <= WS_SGB, "ws map");

constexpr size_t O_YP = 0, O_YS = (size_t)MP * D, O_HGP = O_YS + (size_t)NS * D, O_LRP = O_HGP + (size_t)2 * NBATCH * NH * DKV * DKV, O_CVP = O_LRP + (size_t)2 * NBATCH * D,
                 O_HGS = O_CVP + (size_t)2 * NBATCH * 3 * D, O_LRS = O_HGS + (size_t)2 * NS * NH * DKV * DKV, O_CVS = O_LRS + (size_t)2 * NS * D, O_END = O_CVS + (size_t)2 * NS * 3 * D;
static_assert(O_END == 53673984, "out map");

constexpr int LDS_BYTES = 163840;
constexpr int MISC_OFF = 158 * 1024;

typedef __bf16 bf16x2_t __attribute__((ext_vector_type(2)));
__device__ __forceinline__ unsigned f2bf(float f) { return (unsigned)__builtin_bit_cast(unsigned short, (__bf16)f); }
__device__ __forceinline__ unsigned pk2(float lo, float hi) { return __builtin_bit_cast(unsigned, __builtin_convertvector((f32x2){lo, hi}, bf16x2_t)); }
__device__ __forceinline__ float bf2f(unsigned b) { return __builtin_bit_cast(float, b << 16); }
__device__ __forceinline__ f32x4 ld_bf4(const bf16* p) { const u32x2 w = *(const u32x2*)p; return (f32x4){bf2f(w.x & 0xffffu), bf2f(w.x >> 16), bf2f(w.y & 0xffffu), bf2f(w.y >> 16)}; }
__device__ __forceinline__ void st_bf4(bf16* p, f32x4 v) { u32x2 w; w.x = pk2(v[0], v[1]); w.y = pk2(v[2], v[3]); *(u32x2*)p = w; }
#define WG_BAR() do { asm volatile("s_waitcnt lgkmcnt(0)" ::: "memory"); __builtin_amdgcn_s_barrier(); asm volatile("" ::: "memory"); } while (0)
__device__ __forceinline__ float sig_fast(float x) { return __builtin_amdgcn_rcpf(1.0f + __expf(-x)); }
__device__ __forceinline__ float sigmoidf_(float x) { return 1.0f / (1.0f + __expf(-x)); }
__device__ __forceinline__ float siluf_(float x) { return x * sigmoidf_(x); }
__device__ __forceinline__ float gelu_tanh_(float x) { const float u = 0.7978845608028654f * (x + 0.044715f * x * x * x); return x * sigmoidf_(2.0f * u); }
__device__ __forceinline__ float softplusf_(float x) { return fmaxf(x, 0.f) + log1pf(expf(-fabsf(x))); }
template <int XM> __device__ __forceinline__ float swz_xor(float v) { return __builtin_bit_cast(float, __builtin_amdgcn_ds_swizzle(__builtin_bit_cast(int, v), (XM << 10) | 0x1f)); }
#if DBG_SHFL
__device__ __forceinline__ float half_sum(float v) {
#pragma unroll
    for (int o = 1; o < 32; o <<= 1) v += __shfl_xor(v, o);
    return v; }
__device__ __forceinline__ float wave_sum(float v) {
#pragma unroll
    for (int o = 1; o < 64; o <<= 1) v += __shfl_xor(v, o);
    return v; }
#else
__device__ __forceinline__ float half_sum(float v) { v += swz_xor<1>(v); v += swz_xor<2>(v); v += swz_xor<4>(v); v += swz_xor<8>(v); v += swz_xor<16>(v); return v; }
__device__ __forceinline__ float wave_sum(float v) {
    v = half_sum(v);
    unsigned v1 = __builtin_bit_cast(unsigned, v), v2 = v1; asm volatile("" : "+v"(v2));
    const auto r = __builtin_amdgcn_permlane32_swap(v1, v2, false, false);
    return __builtin_bit_cast(float, r[0]) + __builtin_bit_cast(float, r[1]);
}
#endif
__device__ __forceinline__ int mod_row(int row) { return row < MP ? (row >> 11) : (NBATCH + row - MP); }

struct Args { const float* in[27]; float* out; unsigned char* ws; int ph_lo, ph_hi; };
typedef const __attribute__((address_space(4))) Args CArgs;
struct Ctx { LAS unsigned char* lds; int tid, G, wg; };
namespace pg8 {
#define PG8_LAS __attribute__((address_space(3)))
typedef unsigned short bf16_t;
typedef short bf16x8 __attribute__((ext_vector_type(8)));
typedef float f32x4 __attribute__((ext_vector_type(4)));
typedef unsigned u32x4 __attribute__((ext_vector_type(4)));
constexpr int BM = 256, BK = 64, HALF = 128, HTB = HALF * BK * 2  , STAGE_BYTES = 8 * HTB, NXCD = 8, WGM = 8;

__host__ __device__ __forceinline__ int lds_byte(int r, int c) { const int st = (r >> 4) * 2 + (c >> 5), rr = r & 15, cc = c & 31, ob = rr * 64 + cc * 2; return st * 1024 + (ob ^ (((ob >> 9) & 1) << 5)); }
__host__ __device__ __forceinline__ void stage_rc(int b, int& R, int& C) { const int st = b / 1024, sb = b % 1024, swz = sb ^ (((sb >> 9) & 1) << 5); R = (st >> 1) * 16 + swz / 64; C = (st & 1) * 32 + (swz % 64) / 2; }
__host__ __device__ __forceinline__ int perm32(int rho) { const int n = rho >> 4, i = rho & 15; return 8 * (i >> 2) + 4 * n + (i & 3); }

struct Unit { int pm, pn; };
struct Gemm { const bf16_t* A; const bf16_t* Bt; int M, N, K; };

struct StaticOrder {
    int nM, nN, nwg, G, c;
    __host__ __device__ void init(int M, int N, int G_, int c_) { nM = M / BM; nN = N / BM; nwg = nM * nN; G = G_; c = c_; }
    __host__ __device__ bool next(int i, Unit& u) const {
        const long L = (long)i * G + c; if (L >= nwg) return false;
        int wgid = (int)L; { const int q = nwg / NXCD, r = nwg % NXCD, xcd = wgid % NXCD, off = wgid / NXCD; wgid = (xcd < r ? xcd * (q + 1) : r * (q + 1) + (xcd - r) * q) + off; }
        const int nig = WGM * nN, gid = wgid / nig, fm = gid * WGM, gsz = (nM - fm) < WGM ? (nM - fm) : WGM;
        u.pm = fm + ((wgid % nig) % gsz); u.pn = (wgid % nig) / gsz; return true;
    }
    __device__ __forceinline__ void a_ready(const Unit&) const {}
    __device__ __forceinline__ void done(const Unit&) const {}
};
template <class Epi, class Sched, bool ALIGN_EPI = false, bool SP2 = false>
__device__ __forceinline__ void gemm_phase(PG8_LAS unsigned char* lds, const Gemm g, const Sched& S, const Epi& E, const int tid_in) {
    const int tid = tid_in, wid = __builtin_amdgcn_readfirstlane(tid >> 6), lane = tid & 63, wr = wid >> 2, wc = wid & 3, fr = lane & 15, fq = lane >> 4;
    const int K = g.K, nt = K / BK;
    unsigned voffA[2], voffB[2];
#pragma unroll
    for (int i = 0; i < 2; ++i) { int R, C; stage_rc(tid * 16 + i * 8192, R, C); const int Rb = Epi::PERM ? ((R & ~31) + perm32(R & 31)) : R;
        voffA[i] = (unsigned)(R * K + C) * 2u; voffB[i] = (unsigned)(Rb * K + C) * 2u; }
    const size_t kstep = (size_t)(BK * 2);
    const size_t hstep = (size_t)HALF * K * 2;
    const size_t tstep = 2 * hstep;
    const unsigned ldsw = (unsigned)wid * 1024u;
    const int aoff = lds_byte(wr * 64 + fr, fq * 8), boff = lds_byte(wc * 32 + fr, fq * 8);
#define PG8_SA(b, h) (((b) * 2 + (h)) * HTB)
#define PG8_SB(b, h) ((4 + (b) * 2 + (h)) * HTB)
#define PG8_STAGE(bufoff, gbase, voff) do { _Pragma("unroll") for (int _i = 0; _i < 2; ++_i) \
        __builtin_amdgcn_global_load_lds((const unsigned*)((const char*)(gbase) + (voff)[_i]), (PG8_LAS unsigned*)(lds + (bufoff) + ldsw + _i * 8192), 16, 0, 0); } while (0)
#define PG8_LDA(dst, b, h) do { _Pragma("unroll") for (int m = 0; m < 4; ++m) _Pragma("unroll") for (int k = 0; k < 2; ++k) dst[m][k] = *(const PG8_LAS bf16x8*)(lds + PG8_SA(b, h) + aoff + m * 2048 + k * 1024); } while (0)
#define PG8_LDB(dst, b, h) do { _Pragma("unroll") for (int n = 0; n < 2; ++n) _Pragma("unroll") for (int k = 0; k < 2; ++k) dst[n][k] = *(const PG8_LAS bf16x8*)(lds + PG8_SB(b, h) + boff + n * 2048 + k * 1024); } while (0)
#define PG8_MMA(ai, bj, At, Bt) do { __builtin_amdgcn_s_setprio(1); _Pragma("unroll") for (int m = 0; m < 4; ++m) _Pragma("unroll") for (int n = 0; n < 2; ++n) _Pragma("unroll") for (int k = 0; k < 2; ++k) \
        acc[ai][bj][m][n] = __builtin_amdgcn_mfma_f32_16x16x32_bf16(Bt[n][k], At[m][k], acc[ai][bj][m][n], 0, 0, 0); __builtin_amdgcn_s_setprio(0); } while (0)
#define PG8_WAIT_V(n) asm volatile("s_waitcnt vmcnt(" #n ")" ::: "memory")
#define PG8_WAIT_L(n) asm volatile("s_waitcnt lgkmcnt(" #n ")" ::: "memory")
#define PG8_BAR __builtin_amdgcn_s_barrier()
#define PG8_SCHED __builtin_amdgcn_sched_barrier(0)
    Unit cur, nxt; int ui = 0;
    if (!S.next(0, cur)) return;
    f32x4 acc[2][2][4][2];
#pragma unroll
    for (int a = 0; a < 2; ++a)
#pragma unroll
        for (int b = 0; b < 2; ++b)
#pragma unroll
            for (int m = 0; m < 4; ++m)
#pragma unroll
                for (int n = 0; n < 2; ++n) acc[a][b][m][n] = (f32x4){0.f, 0.f, 0.f, 0.f};
    bf16x8 At[4][2], B0[2][2], B1[2][2];
    const char* cA = (const char*)g.A + (size_t)cur.pm * tstep; const char* cB = (const char*)g.Bt + (size_t)cur.pn * tstep;
    S.a_ready(cur);
    if constexpr (SP2) {
        PG8_STAGE(PG8_SB(0, 0), cB, voffB); PG8_STAGE(PG8_SB(0, 1), cB + hstep, voffB); PG8_STAGE(PG8_SA(0, 0), cA, voffA); PG8_STAGE(PG8_SA(0, 1), cA + hstep, voffA);
        if (wr == 1) PG8_BAR;
        PG8_WAIT_V(2); PG8_BAR;
        PG8_STAGE(PG8_SB(1, 0), cB + kstep, voffB); PG8_STAGE(PG8_SA(1, 0), cA + kstep, voffA); PG8_STAGE(PG8_SB(1, 1), cB + hstep + kstep, voffB);
        PG8_WAIT_V(6); PG8_BAR;
    } else {
        PG8_STAGE(PG8_SB(0, 0), cB, voffB); PG8_STAGE(PG8_SA(0, 0), cA, voffA); PG8_STAGE(PG8_SB(0, 1), cB + hstep, voffB); PG8_STAGE(PG8_SA(0, 1), cA + hstep, voffA);
        if (wr == 1) PG8_BAR;
        PG8_WAIT_V(4); PG8_BAR;
        PG8_STAGE(PG8_SB(1, 0), cB + kstep, voffB); PG8_STAGE(PG8_SA(1, 0), cA + kstep, voffA); PG8_STAGE(PG8_SB(1, 1), cB + hstep + kstep, voffB);
        PG8_WAIT_V(6); PG8_BAR;
    }
    for (;;) {
        const bool has_next = S.next(ui + 1, nxt);
        const char* nA = has_next ? (const char*)g.A + (size_t)nxt.pm * tstep : cA; const char* nB = has_next ? (const char*)g.Bt + (size_t)nxt.pn * tstep : cB;
        for (int t = 0; t < nt; t += 2) {
            const bool last = (t == nt - 2);
            const char* a1 = cA + (size_t)(t + 1) * kstep;
            const char* a2 = last ? nA : cA + (size_t)(t + 2) * kstep; const char* b2 = last ? nB : cB + (size_t)(t + 2) * kstep;
            const char* a3 = a2 + kstep; const char* b3 = b2 + kstep;
            if (last && has_next) S.a_ready(nxt);
            if constexpr (SP2) {
            PG8_LDB(B0, 0, 0); PG8_LDB(B1, 0, 1); PG8_SCHED; PG8_LDA(At, 0, 0); PG8_STAGE(PG8_SA(1, 1), a1 + hstep, voffA);
            PG8_WAIT_V(8); PG8_WAIT_L(0); PG8_BAR; PG8_MMA(0, 0, At, B0); PG8_MMA(0, 1, At, B1); PG8_BAR; PG8_SCHED;
            PG8_LDA(At, 0, 1); PG8_STAGE(PG8_SB(0, 0), b2, voffB); PG8_STAGE(PG8_SB(0, 1), b2 + hstep, voffB); PG8_STAGE(PG8_SA(0, 0), a2, voffA);
            PG8_WAIT_V(8); PG8_WAIT_L(0); PG8_BAR; PG8_MMA(1, 0, At, B0); PG8_MMA(1, 1, At, B1); PG8_BAR; PG8_SCHED;
            PG8_LDB(B0, 1, 0); PG8_LDB(B1, 1, 1); PG8_SCHED; PG8_LDA(At, 1, 0); PG8_STAGE(PG8_SA(0, 1), a2 + hstep, voffA);
            PG8_WAIT_V(8); PG8_WAIT_L(0); PG8_BAR; PG8_MMA(0, 0, At, B0); PG8_MMA(0, 1, At, B1); PG8_BAR; PG8_SCHED;
            PG8_LDA(At, 1, 1); PG8_STAGE(PG8_SB(1, 0), b3, voffB); PG8_STAGE(PG8_SB(1, 1), b3 + hstep, voffB); PG8_STAGE(PG8_SA(1, 0), a3, voffA);
            PG8_WAIT_V(8); PG8_WAIT_L(0); PG8_BAR; PG8_MMA(1, 0, At, B0); PG8_MMA(1, 1, At, B1); PG8_BAR; PG8_SCHED;
            } else {
            PG8_LDB(B0, 0, 0); PG8_SCHED; PG8_LDA(At, 0, 0); PG8_STAGE(PG8_SA(1, 1), a1 + hstep, voffA);
            PG8_WAIT_L(8); PG8_BAR; PG8_WAIT_L(0); PG8_MMA(0, 0, At, B0); PG8_BAR; PG8_SCHED;
            PG8_LDB(B1, 0, 1); PG8_STAGE(PG8_SB(0, 0), b2, voffB);
            PG8_BAR; PG8_WAIT_L(0); PG8_MMA(0, 1, At, B1); PG8_BAR;
            PG8_LDA(At, 0, 1); PG8_STAGE(PG8_SA(0, 0), a2, voffA);
            PG8_BAR; PG8_WAIT_L(0); PG8_MMA(1, 0, At, B0); PG8_BAR; PG8_SCHED;
            PG8_STAGE(PG8_SB(0, 1), b2 + hstep, voffB);
            PG8_WAIT_V(6); PG8_BAR; PG8_MMA(1, 1, At, B1); PG8_BAR;
            PG8_LDB(B0, 1, 0); PG8_SCHED; PG8_LDA(At, 1, 0); PG8_STAGE(PG8_SA(0, 1), a2 + hstep, voffA);
            PG8_WAIT_L(8); PG8_BAR; PG8_WAIT_L(0); PG8_MMA(0, 0, At, B0); PG8_BAR; PG8_SCHED;
            PG8_LDB(B1, 1, 1); PG8_STAGE(PG8_SB(1, 0), b3, voffB);
            PG8_BAR; PG8_WAIT_L(0); PG8_MMA(0, 1, At, B1); PG8_BAR;
            PG8_LDA(At, 1, 1); PG8_STAGE(PG8_SA(1, 0), a3, voffA);
            PG8_BAR; PG8_WAIT_L(0); PG8_MMA(1, 0, At, B0); PG8_BAR; PG8_SCHED;
            PG8_STAGE(PG8_SB(1, 1), b3 + hstep, voffB);
            PG8_WAIT_V(6); PG8_BAR; PG8_MMA(1, 1, At, B1); PG8_BAR;
            }
        }
        if constexpr (ALIGN_EPI) { if (wr == 0) PG8_BAR; }
        if constexpr (!Epi::AFTER_DRAIN) { int l2 = (int)__builtin_amdgcn_mbcnt_hi(~0u, __builtin_amdgcn_mbcnt_lo(~0u, 0u)); asm volatile("" : "+v"(l2));
            E(acc, cur, wr, wc, l2 & 15, l2 >> 4); S.done(cur); }
        if (!has_next) break;
#pragma unroll
        for (int a = 0; a < 2; ++a)
#pragma unroll
            for (int b = 0; b < 2; ++b)
#pragma unroll
                for (int m = 0; m < 4; ++m)
#pragma unroll
                    for (int n = 0; n < 2; ++n) acc[a][b][m][n] = (f32x4){0.f, 0.f, 0.f, 0.f};
        cur = nxt; cA = nA; cB = nB; ++ui;
        if constexpr (ALIGN_EPI) { if (wr == 1) PG8_BAR; }
    }
    PG8_WAIT_V(0);
    if constexpr (!ALIGN_EPI) { if (wr == 0) PG8_BAR; }
    PG8_BAR;
    if constexpr (Epi::AFTER_DRAIN) { E.fused(acc, cur, wr, wc, fr, fq, lds, wid, lane); S.done(cur); }
#undef PG8_SA
#undef PG8_SB
#undef PG8_STAGE
#undef PG8_LDA
#undef PG8_LDB
#undef PG8_MMA
#undef PG8_WAIT_V
#undef PG8_WAIT_L
#undef PG8_BAR
#undef PG8_SCHED
}
}

template <class E> struct QuadEpi {
    static constexpr bool PERM = false, AFTER_DRAIN = false;
    E e;
    __device__ __forceinline__ void operator()(const f32x4 (&acc)[2][2][4][2], const pg8::Unit& u, int wr, int wc, int fr, int fq) const {
        const int row0 = u.pm * 256 + wr * 64 + fr, col0 = u.pn * 256 + wc * 32 + 4 * fq;
#pragma unroll
        for (int ai = 0; ai < 2; ++ai)
#pragma unroll
            for (int m = 0; m < 4; ++m)
#pragma unroll
                for (int bj = 0; bj < 2; ++bj)
#pragma unroll
                    for (int n = 0; n < 2; ++n) e.quad(row0 + ai * 128 + m * 16, col0 + bj * 128 + n * 16, acc[ai][bj][m][n]);
    }
};

struct EpiIn {
    bf16 *Q, *Kb, *V, *OG, *XB, *YG, *SGA, *SGB; float* LOGF; const float* lbt;
    static constexpr bool BY_REGION = true;
    template <int R> __device__ __forceinline__ void quadR(int row, int cc, f32x4 v) const {
        const size_t o = (size_t)row * D + cc;
        f32x4 r;
        if constexpr (R == 0 || R == 3) {
#pragma unroll
            for (int j = 0; j < 4; ++j) r[j] = siluf_(v[j]);
            st_bf4((R == 0 ? Q : OG) + o, r);
        } else if constexpr (R == 1) {
            const f32x4 lb = *(const f32x4*)(lbt + cc), llb = *(const f32x4*)(lbt + 1024 + cc), l1m = *(const f32x4*)(lbt + 2048 + cc);
            f32x4 lf;
#pragma unroll
            for (int j = 0; j < 4; ++j) {
                const float fa = v[j];
                const float t = __expf(-fabsf(fa));
                const float ls = fminf(fa, 0.f) - __logf(1.0f + t);
                const float b = l1m[j] + ls, a_ = llb[j], mx = fmaxf(a_, b);
                lf[j] = mx + __logf(1.0f + __expf(-fabsf(a_ - b)));
                const float sneg = (fa >= 0.f ? t : 1.0f) / (1.0f + t);
                r[j] = (1.0f - lb[j]) * sneg;
            }
            *(f32x4*)(LOGF + o) = lf; st_bf4(Kb + o, r);
        } else if constexpr (R == 2 || R == 4) { st_bf4((R == 2 ? V : XB) + o, v);
        } else if constexpr (R == 5) {
#pragma unroll
            for (int j = 0; j < 4; ++j) r[j] = gelu_tanh_(v[j]);
            st_bf4(YG + o, r);
        } else {
#pragma unroll
            for (int j = 0; j < 4; ++j) r[j] = sigmoidf_(v[j]);
            st_bf4((R == 6 ? SGA : SGB) + o, r);
        }
    }
    __device__ __forceinline__ void quad(int row, int col, f32x4 v) const {
        const int reg = col >> 10, cc = col & 1023;
        switch (reg) { case 0: quadR<0>(row, cc, v); break; case 1: quadR<1>(row, cc, v); break; case 2: quadR<2>(row, cc, v); break; case 3: quadR<3>(row, cc, v); break;
                       case 4: quadR<4>(row, cc, v); break; case 5: quadR<5>(row, cc, v); break; case 6: quadR<6>(row, cc, v); break; default: quadR<7>(row, cc, v); break; }
    }
};
struct EpiInUnit {
    static constexpr bool PERM = false, AFTER_DRAIN = false;
    EpiIn e;
    template <int R> __device__ __forceinline__ void run(const f32x4 (&acc)[2][2][4][2], int row0, int cc0) const {
#pragma unroll
        for (int ai = 0; ai < 2; ++ai)
#pragma unroll
            for (int m = 0; m < 4; ++m) {
#pragma unroll
                for (int bj = 0; bj < 2; ++bj)
#pragma unroll
                    for (int n = 0; n < 2; ++n) e.quadR<R>(row0 + ai * 128 + m * 16, cc0 + bj * 128 + n * 16, acc[ai][bj][m][n]);
                asm volatile("" ::: "memory"); }
    }
    __device__ __forceinline__ void operator()(const f32x4 (&acc)[2][2][4][2], const pg8::Unit& u, int wr, int wc, int fr, int fq) const {
        const int row0 = u.pm * 256 + wr * 64 + fr, cc0 = (u.pn & 3) * 256 + wc * 32 + 4 * fq;
        switch (u.pn >> 2) { case 0: run<0>(acc, row0, cc0); break; case 1: run<1>(acc, row0, cc0); break; case 2: run<2>(acc, row0, cc0); break; case 3: run<3>(acc, row0, cc0); break;
                             case 4: run<4>(acc, row0, cc0); break; case 5: run<5>(acc, row0, cc0); break; case 6: run<6>(acc, row0, cc0); break; default: run<7>(acc, row0, cc0); break; }
    }
};
struct EpiBrA { static constexpr bool BY_REGION = false; const bf16* SGA; float* T;
    __device__ __forceinline__ void quad(int row, int col, f32x4 v) const { const size_t o = (size_t)row * D + col; *(f32x4*)(T + o) = ld_bf4(SGA + o) * v; } };
struct EpiBrB { static constexpr bool BY_REGION = false; const bf16* SGB; const float* T; bf16* MG;
    __device__ __forceinline__ void quad(int row, int col, f32x4 v) const { const size_t o = (size_t)row * D + col; st_bf4(MG + o, *(const f32x4*)(T + o) + ld_bf4(SGB + o) * v); } };
struct EpiRes { static constexpr bool BY_REGION = false; const float* xp; const float* xs; float* X; const float* modl; int gi;
    __device__ __forceinline__ void quad(int row, int col, f32x4 v) const {
        if (row >= MR) return;
        const float* src = row < MP ? xp + (size_t)row * D : xs + (size_t)(row - MP) * D;
        const f32x4 g = *(const f32x4*)(modl + (size_t)mod_row(row) * 6144 + gi * 1024 + col);
        *(f32x4*)(X + (size_t)row * D + col) = *(const f32x4*)(src + col) + g * v;
    } };
struct EpiFF1 { static constexpr bool BY_REGION = false; bf16* HM;
    __device__ __forceinline__ void quad(int row, int col, f32x4 v) const {
        f32x4 r;
#pragma unroll
        for (int j = 0; j < 4; ++j) { const float t = fmaxf(v[j], 0.f); r[j] = t * t; }
        st_bf4(HM + (size_t)row * FF + col, r);
    } };

template <class E>
__device__ __forceinline__ void naive_gemm_phase(Ctx& c, const bf16* A, const bf16* Bt, int M, int N, int K, const E& e) {
    LAS float* As = (LAS float*)c.lds;
    LAS float* Bs = As + 32 * 132;
    const int ntm = M / 128, ntn = N / 128, tx = c.tid & 31, ty = c.tid >> 5;
    const int lr = c.tid >> 2, lk = (c.tid & 3) * 8;
    for (int tile = c.wg; tile < ntm * ntn; tile += c.G) {
        const int tm = tile % ntm, tn = tile / ntm;
        f32x4 acc[8];
#pragma unroll
        for (int i = 0; i < 8; ++i) acc[i] = (f32x4){0.f, 0.f, 0.f, 0.f};
        for (int k0 = 0; k0 < K; k0 += 32) {
            const u32x4 av = *(const u32x4*)(A + (size_t)(tm * 128 + lr) * K + k0 + lk);
            const u32x4 bv = *(const u32x4*)(Bt + (size_t)(tn * 128 + lr) * K + k0 + lk);
            __syncthreads();
#pragma unroll
            for (int j = 0; j < 4; ++j) {
                As[(lk + 2 * j) * 132 + lr] = bf2f(av[j] & 0xffffu); As[(lk + 2 * j + 1) * 132 + lr] = bf2f(av[j] >> 16);
                Bs[(lk + 2 * j) * 132 + lr] = bf2f(bv[j] & 0xffffu); Bs[(lk + 2 * j + 1) * 132 + lr] = bf2f(bv[j] >> 16);
            }
            __syncthreads();
#pragma unroll 8
            for (int k = 0; k < 32; ++k) {
                const f32x4 a0 = *(const LAS f32x4*)(As + k * 132 + ty * 8), a1 = *(const LAS f32x4*)(As + k * 132 + ty * 8 + 4);
                const f32x4 b = *(const LAS f32x4*)(Bs + k * 132 + tx * 4);
                acc[0] += a0[0] * b; acc[1] += a0[1] * b; acc[2] += a0[2] * b; acc[3] += a0[3] * b;
                acc[4] += a1[0] * b; acc[5] += a1[1] * b; acc[6] += a1[2] * b; acc[7] += a1[3] * b;
            }
        }
#pragma unroll
        for (int i = 0; i < 8; ++i) e.quad(tm * 128 + ty * 8 + i, tn * 128 + tx * 4, acc[i]);
    }
    __syncthreads();
}

template <int SITE, class E>
__device__ __forceinline__ void gemm_phase_sel(Ctx& c, const bf16* A, const bf16* Bt, int M, int N, int K, const E& e) {
    if constexpr ((FAST_GEMM >> SITE) & 1) {
        pg8::Gemm g{A, Bt, M, N, K}; pg8::StaticOrder S; S.init(M, N, c.G, c.wg);
        if constexpr (E::BY_REGION) { EpiInUnit qe{e}; pg8::gemm_phase<EpiInUnit, pg8::StaticOrder, true, true>(c.lds, g, S, qe, c.tid); }
        else { QuadEpi<E> qe{e}; pg8::gemm_phase<QuadEpi<E>, pg8::StaticOrder, true, true>(c.lds, g, S, qe, c.tid); }
    } else naive_gemm_phase(c, A, Bt, M, N, K, e);
}

#define XB_TMO      128
#define XB_XCNT(j)  (256  + 64 * (j))
#define XB_XSUB(j)  (1280 + 64 * (j))
#define XB_XGEN(j)  (2304 + 64 * (j))
#define XB_TOP      3328
#define XB_TOPGEN   3392
#define XCD_BAR_WORDS 3456
#define XB_SPIN_CAP (1u << 18)
__device__ __forceinline__ unsigned xb_ld(unsigned* p)              { return __hip_atomic_load(p, __ATOMIC_RELAXED, __HIP_MEMORY_SCOPE_AGENT); }
__device__ __forceinline__ unsigned xb_add(unsigned* p, unsigned v) { return __hip_atomic_fetch_add(p, v, __ATOMIC_RELAXED, __HIP_MEMORY_SCOPE_AGENT); }
__device__ __forceinline__ unsigned xb_xcc_id() { return (unsigned)__builtin_amdgcn_s_getreg((3 << 11) | 20) & 0xFu; }
#define XB_SPIN(cond, bar) do { unsigned _sp = 0; while (cond) { __builtin_amdgcn_s_sleep(1); \
    if ((++_sp & 255u) == 0u) { if (xb_ld(&(bar)[XB_TMO])) break; if (_sp > XB_SPIN_CAP) { atomicAdd(&(bar)[XB_TMO], 1u); break; } } } } while (0)
struct XcdBarrier { unsigned* bar; unsigned x; volatile LAS unsigned* st; };
__device__ __forceinline__ XcdBarrier xcd_barrier_post(unsigned* bar, volatile LAS unsigned* st) {
    XcdBarrier b; b.bar = bar; b.x = xb_xcc_id(); b.st = st;
    if (threadIdx.x == 0) (void)xb_add(&bar[XB_XCNT(b.x)], 1u);
    return b;
}
__device__ __forceinline__ void xcd_barrier_complete(unsigned* bar, unsigned x, unsigned& nloc, unsigned& nx) {
    const unsigned G = gridDim.x * gridDim.y * gridDim.z;
    unsigned sum, cnt, mine, sp = 0u;
    for (;;) {
        sum = 0u; cnt = 0u; mine = 0u;
#pragma unroll
        for (unsigned j = 0; j < 16; ++j) { const unsigned c = xb_ld(&bar[XB_XCNT(j)]); sum += c; cnt += (c > 0u) ? 1u : 0u; mine = (j == x) ? c : mine; }
        if (sum == G) break;
        __builtin_amdgcn_s_sleep(1);
        if ((++sp & 255u) == 0u) { if (xb_ld(&bar[XB_TMO])) break; if (sp > XB_SPIN_CAP) { atomicAdd(&bar[XB_TMO], 1u); break; } }
    }
    nloc = mine > 0u ? mine : 1u; nx = cnt > 0u ? cnt : 1u;
}
__device__ __forceinline__ void xcd_barrier(const XcdBarrier& b) {
    asm volatile("s_waitcnt vmcnt(0)" ::: "memory");
    __syncthreads();
    if (threadIdx.x == 0) {
        unsigned* bar = b.bar; asm volatile("" : "+s"(bar));
        __builtin_amdgcn_s_waitcnt(0);
        unsigned nloc = b.st[0], nx = b.st[1];
        if (nloc == 0u) { xcd_barrier_complete(bar, b.x, nloc, nx); b.st[0] = nloc; b.st[1] = nx; }
        const unsigned old = xb_add(&bar[XB_XSUB(b.x)], 1u);
        const unsigned gen = old / nloc;
        if (old + 1u == (gen + 1u) * nloc) {
            __builtin_amdgcn_fence(__ATOMIC_RELEASE, "agent");
            asm volatile("s_waitcnt vmcnt(0)" ::: "memory");
            const unsigned og = xb_add(&bar[XB_TOP], 1u);
            const unsigned tg = og / nx;
            if (og + 1u == (tg + 1u) * nx) xb_add(&bar[XB_TOPGEN], 1u);
            else XB_SPIN(xb_ld(&bar[XB_TOPGEN]) == tg, bar);
            __builtin_amdgcn_fence(__ATOMIC_ACQUIRE, "agent");
            xb_add(&bar[XB_XGEN(b.x)], 1u);
            asm volatile("s_waitcnt vmcnt(0)" ::: "memory");
        } else {
            XB_SPIN(xb_ld(&bar[XB_XGEN(b.x)]) == gen, bar);
            __builtin_amdgcn_fence(__ATOMIC_ACQUIRE, "agent");
            asm volatile("s_waitcnt vmcnt(0)" ::: "memory");
        }
    }
    __syncthreads();
}

__device__ __forceinline__ void p0_transpose_item(const float* W, int K, int N, bf16* WT, LAS float* scr, int item, int lane) {
    const int nblk = N / 32, kb = item / nblk, nb = item % nblk, k0 = 64 * kb, n0 = 32 * nb;
#pragma unroll 8
    for (int i = 0; i < 32; ++i) { const int kk = 2 * i + (lane >> 5); scr[kk * 33 + (lane & 31)] = W[(size_t)(k0 + kk) * N + n0 + (lane & 31)]; }
    asm volatile("s_waitcnt lgkmcnt(0)" ::: "memory");
    const int ch = lane & 7;
#pragma unroll
    for (int j = 0; j < 4; ++j) { const int n = (lane >> 3) + 8 * j; const LAS float* s = scr + (8 * ch) * 33 + n;
        u32x4 o; o.x = pk2(s[0 * 33], s[1 * 33]); o.y = pk2(s[2 * 33], s[3 * 33]); o.z = pk2(s[4 * 33], s[5 * 33]); o.w = pk2(s[6 * 33], s[7 * 33]);
        *(u32x4*)(WT + (size_t)(n0 + n) * K + k0 + 8 * ch) = o; }
    asm volatile("s_waitcnt lgkmcnt(0)" ::: "memory");
}
__device__ __forceinline__ void p0_prologue(CArgs& a, Ctx& c) {
    {
        LAS float* scr = (LAS float*)(c.lds + __builtin_amdgcn_readfirstlane(c.tid >> 6) * 16384);
        const int gw = c.wg * 8 + __builtin_amdgcn_readfirstlane(c.tid >> 6), NGW = c.G * 8;
        constexpr int I_IN = 16 * 256, I_SQ = 16 * 32, I_1 = 16 * 128, I_2 = 64 * 32, I_L = 8 * 8, PER_L = I_IN + 3 * I_SQ + I_1 + I_2 + 2 * I_L;
        for (int it = gw; it < 2 * PER_L; it += NGW) {
            const int l = it / PER_L; int r = it % PER_L; bf16* wl = (bf16*)(a.ws + WS_W + (size_t)l * WL_STRIDE);
            if (r < I_IN) { p0_transpose_item(a.in[11] + (size_t)l * D * NIN, D, NIN, wl + OFF_WIN / 2, scr, r, (c.tid & 63)); continue; } r -= I_IN;
            if (r < I_SQ) { p0_transpose_item(a.in[21] + (size_t)l * D * D, D, D, wl + OFF_WA / 2, scr, r, (c.tid & 63)); continue; } r -= I_SQ;
            if (r < I_SQ) { p0_transpose_item(a.in[22] + (size_t)l * D * D, D, D, wl + OFF_WB / 2, scr, r, (c.tid & 63)); continue; } r -= I_SQ;
            if (r < I_SQ) { p0_transpose_item(a.in[23] + (size_t)l * D * D, D, D, wl + OFF_WO / 2, scr, r, (c.tid & 63)); continue; } r -= I_SQ;
            if (r < I_1) { p0_transpose_item(a.in[24] + (size_t)l * D * FF, D, FF, wl + OFF_W1 / 2, scr, r, (c.tid & 63)); continue; } r -= I_1;
            if (r < I_2) { p0_transpose_item(a.in[25] + (size_t)l * FF * D, FF, D, wl + OFF_W2 / 2, scr, r, (c.tid & 63)); continue; } r -= I_2;
            if (r < I_L) { const int n = r >> 3; p0_transpose_item(a.in[16] + ((size_t)l * 8 + n) * 16384, 128, 128, wl + OFF_LWA / 2 + n * 16384, scr, r & 7, (c.tid & 63)); continue; } r -= I_L;
            { const int n = r >> 3; p0_transpose_item(a.in[18] + ((size_t)l * 8 + n) * 16384, 128, 128, wl + OFF_LWX / 2 + n * 16384, scr, r & 7, (c.tid & 63)); }
        }
    }
    {
        float* lbt = (float*)(a.ws + WS_TAB); float* sp = (float*)(a.ws + WS_TAB + 32768);
        const int gid = c.wg * 512 + c.tid;
        if (gid < 2 * D) {
            const int l = gid >> 10, col = gid & 1023;
            const float h0 = a.in[12][col], h1 = a.in[12][D + col];
            const float p1 = 1.0f / (1.0f + expf(h0 - h1));
            const float lb = l == 0 ? 0.f : p1;
            lbt[(l * 3 + 0) * D + col] = lb; lbt[(l * 3 + 1) * D + col] = logf(fmaxf(lb, 1e-30f)); lbt[(l * 3 + 2) * D + col] = log1pf(-lb);
            sp[l * D + col] = softplusf_(-a.in[20][l * D + col]);
        }
    }
    __syncthreads();
    {
        LAS float* cs = (LAS float*)c.lds;
        float* MOD = (float*)(a.ws + WS_MOD);
        const int cq = c.tid & 15, rq = c.tid >> 4;
        for (int item = c.wg; item < 2 * 96; item += c.G) {
            const int l = item / 96, cg = item % 96;
            const float* W = a.in[7] + (size_t)l * D * 6144 + cg * 64 + 4 * cq;
            f32x4 acc[5];
#pragma unroll
            for (int i = 0; i < 5; ++i) acc[i] = (f32x4){0.f, 0.f, 0.f, 0.f};
            for (int k0 = 0; k0 < D; k0 += 128) {
                __syncthreads();
                for (int e = c.tid; e < 160 * 128; e += 512) { const int r = e >> 7, kk = e & 127;
                    float cv = 0.f;
                    if (r < NBATCH) cv = a.in[5][(size_t)r * D + k0 + kk]; else if (r < NMOD) cv = a.in[6][(size_t)(r - NBATCH) * D + k0 + kk];
                    cs[r * 132 + kk] = siluf_(cv); }
                __syncthreads();
#pragma unroll 2
                for (int kk = 0; kk < 128; kk += 4) {
                    const float* wp = W + (size_t)(k0 + kk) * 6144;
                    const f32x4 w0 = *(const f32x4*)wp, w1 = *(const f32x4*)(wp + 6144), w2 = *(const f32x4*)(wp + 2 * 6144), w3 = *(const f32x4*)(wp + 3 * 6144);
#pragma unroll
                    for (int i = 0; i < 5; ++i) { const f32x4 x = *(const LAS f32x4*)(cs + (5 * rq + i) * 132 + kk);
                        acc[i] += x[0] * w0 + x[1] * w1 + x[2] * w2 + x[3] * w3; }
                }
            }
            const f32x4 bm = *(const f32x4*)(a.in[8] + (size_t)l * 6144 + cg * 64 + 4 * cq);
#pragma unroll
            for (int i = 0; i < 5; ++i) { const int row = 5 * rq + i; if (row < NMOD) *(f32x4*)(MOD + ((size_t)l * NMOD + row) * 6144 + cg * 64 + 4 * cq) = acc[i] + bm; }
        }
    }
    __syncthreads();
}

__device__ __forceinline__ void norm_phase(CArgs& a, Ctx& c, int l, int which, const float* xp, const float* xs) {
    const int gw = c.wg * 8 + __builtin_amdgcn_readfirstlane(c.tid >> 6), NGW = c.G * 8;
    bf16* H = (bf16*)(a.ws + WS_H);
    const float* MODL = (const float*)(a.ws + WS_MOD) + (size_t)l * NMOD * 6144;
    const float* g = a.in[which ? 10 : 9] + (size_t)l * D;
    for (int row = gw; row < MR; row += NGW) {
        const float* xr = row < MP ? xp + (size_t)row * D : xs + (size_t)(row - MP) * D;
        const float* md = MODL + (size_t)mod_row(row) * 6144 + (which ? 3 : 0) * 1024;
        f32x4 v[4]; float ss = 0.f;
#pragma unroll
        for (int j = 0; j < 4; ++j) { v[j] = *(const f32x4*)(xr + 4 * (c.tid & 63) + 256 * j); ss += (v[j][0] * v[j][0] + v[j][1] * v[j][1]) + (v[j][2] * v[j][2] + v[j][3] * v[j][3]); }
        const float rstd = 1.0f / sqrtf(wave_sum(ss) * (1.0f / D) + EPS);
#pragma unroll
        for (int j = 0; j < 4; ++j) { const int cc = 4 * (c.tid & 63) + 256 * j;
            const f32x4 gg = *(const f32x4*)(g + cc), sh = *(const f32x4*)(md + cc), sc = *(const f32x4*)(md + 1024 + cc);
            st_bf4(H + (size_t)row * D + cc, v[j] * rstd * gg * (1.0f + sc) + sh); }
    }
}
__device__ __forceinline__ void final_norm_phase(CArgs& a, Ctx& c) {
    const int gw = c.wg * 8 + __builtin_amdgcn_readfirstlane(c.tid >> 6), NGW = c.G * 8;
    const float* g = a.in[26];
    for (int row = gw; row < MR; row += NGW) {
        float* xr = a.out + (size_t)row * D;
        f32x4 v[4]; float ss = 0.f;
#pragma unroll
        for (int j = 0; j < 4; ++j) { v[j] = *(const f32x4*)(xr + 4 * (c.tid & 63) + 256 * j); ss += (v[j][0] * v[j][0] + v[j][1] * v[j][1]) + (v[j][2] * v[j][2] + v[j][3] * v[j][3]); }
        const float rstd = 1.0f / sqrtf(wave_sum(ss) * (1.0f / D) + EPS);
#pragma unroll
        for (int j = 0; j < 4; ++j) { const int cc = 4 * (c.tid & 63) + 256 * j; *(f32x4*)(xr + cc) = v[j] * rstd * *(const f32x4*)(g + cc); }
    }
}

__device__ __forceinline__ void hgrn_naive(CArgs& a, Ctx& c, int l, int row0, int ntok, int h, const float* S0, float* Sout) {
    LAS float* fs = (LAS float*)c.lds;
    LAS float* ks = fs + 2048;
    LAS float* qs = ks + 2048;
    LAS float* vs = qs + 2048;
    LAS float* part = vs + 2048;
    const bf16* Q = (const bf16*)(a.ws + WS_Q); const bf16* Kb = (const bf16*)(a.ws + WS_K); const bf16* V = (const bf16*)(a.ws + WS_V); const bf16* OG = (const bf16*)(a.ws + WS_OG); bf16* OA = (bf16*)(a.ws + WS_OA);
    const float* LOGF = (const float*)(a.ws + WS_LOGF);
    const float* hg = a.in[13] + (size_t)l * DKV;
    const int v = c.tid & 127, kg = c.tid >> 7;
    float S[32];
#pragma unroll
    for (int i = 0; i < 32; ++i) S[i] = S0 ? S0[(size_t)(32 * kg + i) * DKV + v] : 0.f;
    for (int t0 = 0; t0 < ntok; t0 += 16) {
        const int nt = (ntok - t0) < 16 ? (ntok - t0) : 16;
        __syncthreads();
        { const int tt = c.tid >> 5, k4 = (c.tid & 31) * 4;
          if (tt < nt) { const size_t off = (size_t)(row0 + t0 + tt) * D + h * DKV + k4;
              const f32x4 lf = *(const f32x4*)(LOGF + off);
              *(LAS f32x4*)(fs + tt * 128 + k4) = (f32x4){expf(lf[0]), expf(lf[1]), expf(lf[2]), expf(lf[3])};
              *(LAS f32x4*)(ks + tt * 128 + k4) = ld_bf4(Kb + off);
              *(LAS f32x4*)(qs + tt * 128 + k4) = ld_bf4(Q + off);
              *(LAS f32x4*)(vs + tt * 128 + k4) = ld_bf4(V + off); } }
        __syncthreads();
        for (int tt = 0; tt < nt; ++tt) {
            const float vv = vs[tt * 128 + v]; float acc = 0.f;
#pragma unroll
            for (int i4 = 0; i4 < 8; ++i4) {
                const f32x4 f = *(const LAS f32x4*)(fs + tt * 128 + 32 * kg + 4 * i4), kk = *(const LAS f32x4*)(ks + tt * 128 + 32 * kg + 4 * i4), qq = *(const LAS f32x4*)(qs + tt * 128 + 32 * kg + 4 * i4);
#pragma unroll
                for (int j = 0; j < 4; ++j) { S[4 * i4 + j] = f[j] * S[4 * i4 + j] + kk[j] * vv; acc += S[4 * i4 + j] * qq[j]; }
            }
            part[(tt * 4 + kg) * 128 + v] = acc;
        }
        __syncthreads();
        { const int tt = c.tid >> 5, v4 = (c.tid & 31) * 4; const int tc = tt < nt ? tt : 0;
          const f32x4 o = *(const LAS f32x4*)(part + (tc * 4 + 0) * 128 + v4) + *(const LAS f32x4*)(part + (tc * 4 + 1) * 128 + v4)
                        + *(const LAS f32x4*)(part + (tc * 4 + 2) * 128 + v4) + *(const LAS f32x4*)(part + (tc * 4 + 3) * 128 + v4);
          float ss = (o[0] * o[0] + o[1] * o[1]) + (o[2] * o[2] + o[3] * o[3]);
          ss = half_sum(ss);
          const float rstd = 1.0f / sqrtf(ss * (1.0f / DKV) + EPS);
          if (tt < nt) { const size_t off = (size_t)(row0 + t0 + tt) * D + h * DKV + v4;
              st_bf4(OA + off, o * rstd * *(const f32x4*)(hg + v4) * ld_bf4(OG + off)); } }
    }
#pragma unroll
    for (int i = 0; i < 32; ++i) Sout[(size_t)(32 * kg + i) * DKV + v] = S[i];
    __syncthreads();
}


constexpr int HB_Q0 = 0, HB_K0 = 17408, HB_Q1 = 26112, HB_K1 = 34816, HB_KT0 = 43520, HB_KT1 = 53760, HB_VT = 64000, HB_AS = 82432, HB_ST = 91648, HB_VEC = 126464, HB_TOT = 128512, HB_SSQ = 130560;
constexpr int HS_Q = 272, HS_KT = 80, HS_VT = 144, HS_AS = 144;
static_assert(HB_SSQ + 2048 <= MISC_OFF, "hgrn lds");
__device__ __forceinline__ float exp_c(float x) { return __expf(fminf(x, 80.f)); }
__device__ __forceinline__ void hgrn_fast_prompt(CArgs& a, Ctx& c, int l, int b, int h) {
    LAS unsigned char* lds = c.lds;
    const int tid = c.tid, lane = tid & 63, w = __builtin_amdgcn_readfirstlane(tid >> 6), fr = lane & 15, fq = lane >> 4;
    const int col = tid & 127, sg = tid >> 7;
    const bf16* Q = (const bf16*)(a.ws + WS_Q); const bf16* Kb = (const bf16*)(a.ws + WS_K); const bf16* V = (const bf16*)(a.ws + WS_V); const bf16* OG = (const bf16*)(a.ws + WS_OG); bf16* OA = (bf16*)(a.ws + WS_OA);
    const float* LOGF = (const float*)(a.ws + WS_LOGF);
    const size_t base = (size_t)b * SEQ * D + (size_t)h * DKV;
    LAS float* VEC = (LAS float*)(lds + HB_VEC); LAS float* TOT = (LAS float*)(lds + HB_TOT); LAS float* SSQ = (LAS float*)(lds + HB_SSQ);
    LAS unsigned char* STw = lds + HB_ST + w * 4352;
    const float gv = a.in[13][(size_t)l * DKV + 16 * w + fr];
    f32x4 S[8];
#pragma unroll
    for (int i = 0; i < 8; ++i) S[i] = (f32x4){0.f, 0.f, 0.f, 0.f};
    __syncthreads();
    for (int e = tid; e < 2 * 16 * 16; e += 512) { const int which = e >> 8, r = (e >> 4) & 15, cc = e & 15;
        *(LAS bf16*)(lds + HB_AS + ((which ? 32 : 0) + r) * HS_AS + ((which ? 48 : 16) + cc) * 2) = 0; }
    float lf[16]; unsigned qr[16], kr[16], vr[16];
    { const size_t o0 = base + (size_t)(16 * sg) * D + col;
#pragma unroll
      for (int i = 0; i < 16; ++i) { lf[i] = LOGF[o0 + (size_t)i * D]; qr[i] = Q[o0 + (size_t)i * D]; kr[i] = Kb[o0 + (size_t)i * D]; vr[i] = V[o0 + (size_t)i * D]; } }
    for (int nn = 0; nn < (SEQ / 64) * (1 + (PROBE_MIX & 1)); ++nn) {
        const int n = nn & (SEQ / 64 - 1);
        if (PROBE_MIX & 1) { if (nn == SEQ / 64) {
#pragma unroll
            for (int i = 0; i < 8; ++i) S[i] = (f32x4){0.f, 0.f, 0.f, 0.f}; } }
        float g[16]; g[0] = lf[0];
#pragma unroll
        for (int i = 1; i < 16; ++i) g[i] = g[i - 1] + lf[i];
        TOT[sg * 128 + col] = g[15];
        WG_BAR();
        {
            const float t0 = TOT[col], t1 = TOT[128 + col], t2 = TOT[256 + col], t3 = TOT[384 + col];
            const float off = (sg > 0 ? t0 : 0.f) + (sg > 1 ? t1 : 0.f) + (sg > 2 ? t2 : 0.f);
            const float r0 = t0, r1 = t0 + t1 + t2, last = r1 + t3;
            unsigned kt[8], vt[8];
#pragma unroll
            for (int i = 0; i < 16; ++i) {
                const float G = g[i] + off, qv = bf2f(qr[i]), kv = bf2f(kr[i]);
                const int t = 16 * sg + i;
                *(LAS bf16*)(lds + HB_Q0 + t * HS_Q + col * 2) = (bf16)f2bf(qv * exp_c(G - r0));
                unsigned kb;
                if (sg < 2) { kb = f2bf(kv * exp_c(r0 - G)); *(LAS bf16*)(lds + HB_K0 + t * HS_Q + col * 2) = (bf16)kb; }
                else { kb = f2bf(kv * exp_c(r1 - G)); *(LAS bf16*)(lds + HB_K1 + (t - 32) * HS_Q + col * 2) = (bf16)kb;
                       *(LAS bf16*)(lds + HB_Q1 + (t - 32) * HS_Q + col * 2) = (bf16)f2bf(qv * exp_c(G - r1)); }
                if (i & 1) { kt[i >> 1] |= kb << 16; vt[i >> 1] |= vr[i] << 16; } else { kt[i >> 1] = kb; vt[i >> 1] = vr[i]; }
            }
            { LAS unsigned char* p = lds + (sg < 2 ? HB_KT0 : HB_KT1) + col * HS_KT + (sg & 1) * 32;
              *(LAS u32x4*)p = (u32x4){kt[0], kt[1], kt[2], kt[3]}; *(LAS u32x4*)(p + 16) = (u32x4){kt[4], kt[5], kt[6], kt[7]}; }
            { LAS unsigned char* p = lds + HB_VT + col * HS_VT + sg * 32;
              *(LAS u32x4*)p = (u32x4){vt[0], vt[1], vt[2], vt[3]}; *(LAS u32x4*)(p + 16) = (u32x4){vt[4], vt[5], vt[6], vt[7]}; }
            VEC[sg * 128 + col] = exp_c(sg == 0 ? r0 : (sg == 1 ? last : (sg == 2 ? last - r0 : last - r1)));
        }
        unsigned ogr[16];
        { const size_t oo = base + (size_t)(64 * n + 4 * fq) * D + 16 * w + fr;
#pragma unroll
          for (int tt = 0; tt < 4; ++tt)
#pragma unroll
              for (int j = 0; j < 4; ++j) ogr[tt * 4 + j] = OG[oo + (size_t)(16 * tt + j) * D]; }
        if ((PROBE_MIX & 1) || n + 1 < SEQ / 64) { const size_t o0 = base + (size_t)(64 * ((n + 1) & (SEQ / 64 - 1)) + 16 * sg) * D + col;
#pragma unroll
            for (int i = 0; i < 16; ++i) { lf[i] = LOGF[o0 + (size_t)i * D]; qr[i] = Q[o0 + (size_t)i * D]; kr[i] = Kb[o0 + (size_t)i * D]; vr[i] = V[o0 + (size_t)i * D]; } }
        WG_BAR();
#pragma unroll
        for (int kt8 = 0; kt8 < 8; ++kt8) { const f32x4 er = *(const LAS f32x4*)(VEC + 16 * kt8 + 4 * fq);
            u32x2 pw; pw.x = pk2(S[kt8][0] * er[0], S[kt8][1] * er[1]); pw.y = pk2(S[kt8][2] * er[2], S[kt8][3] * er[3]);
            *(LAS u32x2*)(STw + fr * HS_Q + (16 * kt8 + 4 * fq) * 2) = pw; }
#pragma unroll
        for (int rep = 0; rep < 2; ++rep) {
            const int id = w + 8 * rep;
            if (id < 10) {
                int tt, st;
                if (id == 0) { tt = 0; st = 0; } else if (id < 7) { tt = (id + 1) >> 1; st = (id + 1) & 1; } else if (id == 7) { tt = 2; st = 2; } else { tt = 3; st = id - 6; }
                const LAS unsigned char* ap = (st < 2) ? lds + HB_Q0 + (16 * tt + fr) * HS_Q : lds + HB_Q1 + (16 * (tt - 2) + fr) * HS_Q;
                const LAS unsigned char* bp = (st < 2) ? lds + HB_K0 + (16 * st + fr) * HS_Q : lds + HB_K1 + (16 * (st - 2) + fr) * HS_Q;
                f32x4 acc = (f32x4){0.f, 0.f, 0.f, 0.f};
#pragma unroll
                for (int ks = 0; ks < 4; ++ks) acc = __builtin_amdgcn_mfma_f32_16x16x32_bf16(*(const LAS bf16x8*)(ap + (32 * ks + 8 * fq) * 2), *(const LAS bf16x8*)(bp + (32 * ks + 8 * fq) * 2), acc, 0, 0, 0);
#pragma unroll
                for (int j = 0; j < 4; ++j) { const float v_ = (tt == st && fr > 4 * fq + j) ? 0.f : acc[j];
                    *(LAS bf16*)(lds + HB_AS + (16 * tt + 4 * fq + j) * HS_AS + (16 * st + fr) * 2) = (bf16)f2bf(v_); }
            }
        }
        f32x4 o[4];
#pragma unroll
        for (int tt = 0; tt < 4; ++tt) o[tt] = (f32x4){0.f, 0.f, 0.f, 0.f};
#pragma unroll
        for (int ks = 0; ks < 4; ++ks) { const bf16x8 bfr = *(const LAS bf16x8*)(STw + fr * HS_Q + (32 * ks + 8 * fq) * 2);
#pragma unroll
            for (int tt = 0; tt < 4; ++tt) o[tt] = __builtin_amdgcn_mfma_f32_16x16x32_bf16(*(const LAS bf16x8*)(lds + HB_Q0 + (16 * tt + fr) * HS_Q + (32 * ks + 8 * fq) * 2), bfr, o[tt], 0, 0, 0); }
        WG_BAR();
#pragma unroll
        for (int tt = 0; tt < 4; ++tt)
#pragma unroll
            for (int ks = 0; ks < 2; ++ks) if (ks == 0 || tt >= 2)
                o[tt] = __builtin_amdgcn_mfma_f32_16x16x32_bf16(*(const LAS bf16x8*)(lds + HB_AS + (16 * tt + fr) * HS_AS + (32 * ks + 8 * fq) * 2), *(const LAS bf16x8*)(lds + HB_VT + (16 * w + fr) * HS_VT + (32 * ks + 8 * fq) * 2), o[tt], 0, 0, 0);
#pragma unroll
        for (int tt = 0; tt < 4; ++tt)
#pragma unroll
            for (int j = 0; j < 4; ++j) { float p = o[tt][j] * o[tt][j];
                p += __shfl_xor(p, 1); p += __shfl_xor(p, 2); p += __shfl_xor(p, 4); p += __shfl_xor(p, 8);
                if (fr == 0) SSQ[w * 64 + 16 * tt + 4 * fq + j] = p; }
#pragma unroll
        for (int kt8 = 0; kt8 < 8; ++kt8) {
            const f32x4 z = (f32x4){0.f, 0.f, 0.f, 0.f};
            const f32x4 U0 = __builtin_amdgcn_mfma_f32_16x16x32_bf16(*(const LAS bf16x8*)(lds + HB_KT0 + (16 * kt8 + fr) * HS_KT + 8 * fq * 2), *(const LAS bf16x8*)(lds + HB_VT + (16 * w + fr) * HS_VT + 8 * fq * 2), z, 0, 0, 0);
            const f32x4 U1 = __builtin_amdgcn_mfma_f32_16x16x32_bf16(*(const LAS bf16x8*)(lds + HB_KT1 + (16 * kt8 + fr) * HS_KT + 8 * fq * 2), *(const LAS bf16x8*)(lds + HB_VT + (16 * w + fr) * HS_VT + (32 + 8 * fq) * 2), z, 0, 0, 0);
            const f32x4 eL = *(const LAS f32x4*)(VEC + 128 + 16 * kt8 + 4 * fq), eL0 = *(const LAS f32x4*)(VEC + 256 + 16 * kt8 + 4 * fq), eL1 = *(const LAS f32x4*)(VEC + 384 + 16 * kt8 + 4 * fq);
            S[kt8] = eL * S[kt8] + eL0 * U0 + eL1 * U1;
        }
        WG_BAR();
#pragma unroll
        for (int tt = 0; tt < 4; ++tt) {
            f32x4 ss = *(const LAS f32x4*)(SSQ + 16 * tt + 4 * fq);
#pragma unroll
            for (int ww = 1; ww < 8; ++ww) ss += *(const LAS f32x4*)(SSQ + ww * 64 + 16 * tt + 4 * fq);
#pragma unroll
            for (int j = 0; j < 4; ++j) { const int t = 16 * tt + 4 * fq + j;
                const float rstd = __builtin_amdgcn_rsqf(ss[j] * (1.0f / DKV) + EPS);
                OA[base + (size_t)(64 * n + t) * D + 16 * w + fr] = (bf16)f2bf(o[tt][j] * rstd * gv * bf2f(ogr[tt * 4 + j])); } }
    }
    { float* Sout = a.out + O_HGP + (((size_t)l * NBATCH + b) * NH + h) * DKV * DKV;
#pragma unroll
      for (int kt8 = 0; kt8 < 8; ++kt8)
#pragma unroll
          for (int j = 0; j < 4; ++j) Sout[(size_t)(16 * kt8 + 4 * fq + j) * DKV + 16 * w + fr] = S[kt8][j]; }
    __syncthreads();
}

constexpr int L_XBS = 0, L_XC = 67 * 128, L_AS = L_XC + 8192, L_BS = L_AS + 8192, L_SEG = L_BS + 8192, L_CARRY = L_SEG + 1024;
constexpr int LB_XCB = (L_CARRY + 256) * 4, XCB_STRIDE = 272;
static_assert(LB_XCB + 64 * XCB_STRIDE <= MISC_OFF && LB_XCB % 16 == 0, "lru lds");
__device__ __forceinline__ void lru_gates_naive(CArgs& a, Ctx& c, int l, int n) {
    LAS float* XC = (LAS float*)c.lds + L_XC; LAS float* As = (LAS float*)c.lds + L_AS; LAS float* Bs = (LAS float*)c.lds + L_BS;
    const bf16* wl = (const bf16*)(a.ws + WS_W + (size_t)l * WL_STRIDE);
    const int e = c.tid & 127, tg = c.tid >> 7;
    const bf16* wa = wl + OFF_LWA / 2 + (size_t)(n * 128 + e) * 128; const bf16* wx = wl + OFF_LWX / 2 + (size_t)(n * 128 + e) * 128;
    const int ch = n * 128 + e;
    const float ba = a.in[17][(size_t)l * D + ch], bx = a.in[19][(size_t)l * D + ch], sp = ((const float*)(a.ws + WS_TAB + 32768))[l * D + ch];
#pragma unroll 1
    for (int tq = 0; tq < 4; ++tq) {
        float ra[4], ia[4];
#pragma unroll
        for (int i = 0; i < 4; ++i) { ra[i] = 0.f; ia[i] = 0.f; }
        const LAS float* xc = XC + (tg * 16 + tq * 4) * 128;
#pragma unroll 1
        for (int d0 = 0; d0 < 128; d0 += 8) {
            const f32x4 wa0 = ld_bf4(wa + d0), wa1 = ld_bf4(wa + d0 + 4), wx0 = ld_bf4(wx + d0), wx1 = ld_bf4(wx + d0 + 4);
#pragma unroll
            for (int tt = 0; tt < 4; ++tt) {
                const f32x4 x0 = *(const LAS f32x4*)(xc + tt * 128 + d0), x1 = *(const LAS f32x4*)(xc + tt * 128 + d0 + 4);
                ra[tt] += (x0[0] * wa0[0] + x0[1] * wa0[1]) + (x0[2] * wa0[2] + x0[3] * wa0[3]) + (x1[0] * wa1[0] + x1[1] * wa1[1]) + (x1[2] * wa1[2] + x1[3] * wa1[3]);
                ia[tt] += (x0[0] * wx0[0] + x0[1] * wx0[1]) + (x0[2] * wx0[2] + x0[3] * wx0[3]) + (x1[0] * wx1[0] + x1[1] * wx1[1]) + (x1[2] * wx1[2] + x1[3] * wx1[3]);
            }
        }
#pragma unroll
        for (int tt = 0; tt < 4; ++tt) {
            const int t = tg * 16 + tq * 4 + tt;
            const float r = sigmoidf_(ra[tt] + ba), ig = sigmoidf_(ia[tt] + bx);
            const float la = -8.0f * r * sp, aa = expf(la), mult = sqrtf(-expm1f(2.0f * la));
            As[t * 128 + e] = aa; Bs[t * 128 + e] = mult * ig * XC[t * 128 + e];
        }
    }
}
__device__ __forceinline__ void lru_gates_mfma(CArgs& a, Ctx& c, int l, int n) {
    LAS float* XC = (LAS float*)c.lds + L_XC; LAS float* As = (LAS float*)c.lds + L_AS; LAS float* Bs = (LAS float*)c.lds + L_BS;
    const bf16* wl = (const bf16*)(a.ws + WS_W + (size_t)l * WL_STRIDE);
    const int lane = c.tid & 63, w = __builtin_amdgcn_readfirstlane(c.tid >> 6), fr = lane & 15, fq = lane >> 4;
    const int e = 16 * w + fr, ch = n * 128 + e;
    const bf16* wa = wl + OFF_LWA / 2 + (size_t)(n * 128 + e) * 128 + 8 * fq; const bf16* wx = wl + OFF_LWX / 2 + (size_t)(n * 128 + e) * 128 + 8 * fq;
    bf16x8 Ba[4], Bx[4];
#pragma unroll
    for (int ks = 0; ks < 4; ++ks) { Ba[ks] = *(const bf16x8*)(wa + 32 * ks); Bx[ks] = *(const bf16x8*)(wx + 32 * ks); }
    const float ba = a.in[17][(size_t)l * D + ch], bx = a.in[19][(size_t)l * D + ch], sp = ((const float*)(a.ws + WS_TAB + 32768))[l * D + ch];
#pragma unroll
    for (int m = 0; m < 4; ++m) {
        f32x4 ar = (f32x4){0.f, 0.f, 0.f, 0.f}, ai = (f32x4){0.f, 0.f, 0.f, 0.f};
#pragma unroll
        for (int ks = 0; ks < 4; ++ks) {
            const bf16x8 af = *(const LAS bf16x8*)(c.lds + LB_XCB + (16 * m + fr) * XCB_STRIDE + (32 * ks + 8 * fq) * 2);
            ar = __builtin_amdgcn_mfma_f32_16x16x32_bf16(af, Ba[ks], ar, 0, 0, 0);
            ai = __builtin_amdgcn_mfma_f32_16x16x32_bf16(af, Bx[ks], ai, 0, 0, 0);
        }
#pragma unroll
        for (int j = 0; j < 4; ++j) {
            const int t = 16 * m + 4 * fq + j;
            const float r = sigmoidf_(ar[j] + ba), ig = sigmoidf_(ai[j] + bx);
            const float la = -8.0f * r * sp, aa = expf(la), mult = sqrtf(-expm1f(2.0f * la));
            As[t * 128 + e] = aa; Bs[t * 128 + e] = mult * ig * XC[t * 128 + e];
        }
    }
}
#if FAST_GATES
#define lru_gates lru_gates_mfma
#else
#define lru_gates lru_gates_naive
#endif

constexpr int LB_CW = LB_XCB + 64 * XCB_STRIDE;
static_assert(LB_CW + 2560 <= MISC_OFF, "lru lds");
__device__ __forceinline__ void lru_prompt_item(CArgs& a, Ctx& c, int l, int b, int n) {
    LAS float* L = (LAS float*)c.lds; LAS float* CW = (LAS float*)(c.lds + LB_CW);
    const bf16* XB = (const bf16*)(a.ws + WS_XB); const bf16* YG = (const bf16*)(a.ws + WS_YG); bf16* OB = (bf16*)(a.ws + WS_OB);
    const int t_ld = c.tid >> 3, c0 = (c.tid & 7) * 16;
    const int cch = c.tid & 127, sg = c.tid >> 7;
    const int lane = c.tid & 63, w = __builtin_amdgcn_readfirstlane(c.tid >> 6), fr = lane & 15, fq = lane >> 4;
    const int e = 16 * w + fr, ch = n * 128 + e;
    __syncthreads();
    if (c.tid < 256) L[L_CARRY + c.tid] = 0.f;
    if (c.tid < 384) L[L_XBS + c.tid] = 0.f;
    for (int i = c.tid; i < 640; i += 512) CW[i] = i < 512 ? a.in[14][(size_t)l * 4 * D + (i >> 7) * D + n * 128 + (i & 127)] : a.in[15][(size_t)l * D + n * 128 + (i - 512)];
    bf16x8 Ba[4], Bx[4];
    { const bf16* wl = (const bf16*)(a.ws + WS_W + (size_t)l * WL_STRIDE);
      const bf16* wa = wl + OFF_LWA / 2 + (size_t)(n * 128 + e) * 128 + 8 * fq; const bf16* wx = wl + OFF_LWX / 2 + (size_t)(n * 128 + e) * 128 + 8 * fq;
#pragma unroll
      for (int ks = 0; ks < 4; ++ks) { Ba[ks] = *(const bf16x8*)(wa + 32 * ks); Bx[ks] = *(const bf16x8*)(wx + 32 * ks); } }
    const float ba = a.in[17][(size_t)l * D + ch], bx = a.in[19][(size_t)l * D + ch], sp8 = -8.0f * ((const float*)(a.ws + WS_TAB + 32768))[l * D + ch];
    const bf16* xsrc = XB + (size_t)(b * SEQ + t_ld) * D + n * 128 + c0;
    u32x4 xr0 = *(const u32x4*)xsrc, xr1 = *(const u32x4*)(xsrc + 8);
    for (int t0 = 0; t0 < SEQ; t0 += 64) {
        const int par = (t0 >> 6) & 1;
        unsigned ygr[16];
        { const bf16* yp = YG + (size_t)(b * SEQ + t0 + sg * 16) * D + n * 128 + cch;
#pragma unroll
          for (int tt = 0; tt < 16; ++tt) ygr[tt] = yp[(size_t)tt * D]; }
        WG_BAR();
        { LAS float* dst = L + L_XBS + (3 + t_ld) * 128 + c0;
          *(LAS f32x4*)dst        = (f32x4){bf2f(xr0.x & 0xffffu), bf2f(xr0.x >> 16), bf2f(xr0.y & 0xffffu), bf2f(xr0.y >> 16)};
          *(LAS f32x4*)(dst + 4)  = (f32x4){bf2f(xr0.z & 0xffffu), bf2f(xr0.z >> 16), bf2f(xr0.w & 0xffffu), bf2f(xr0.w >> 16)};
          *(LAS f32x4*)(dst + 8)  = (f32x4){bf2f(xr1.x & 0xffffu), bf2f(xr1.x >> 16), bf2f(xr1.y & 0xffffu), bf2f(xr1.y >> 16)};
          *(LAS f32x4*)(dst + 12) = (f32x4){bf2f(xr1.z & 0xffffu), bf2f(xr1.z >> 16), bf2f(xr1.w & 0xffffu), bf2f(xr1.w >> 16)}; }
        if (t0 + 64 < SEQ) { xr0 = *(const u32x4*)(xsrc + (size_t)(t0 + 64) * D); xr1 = *(const u32x4*)(xsrc + (size_t)(t0 + 64) * D + 8); }
        WG_BAR();
#pragma unroll
        for (int j4 = 0; j4 < 4; ++j4) { const int cc = c0 + 4 * j4;
            f32x4 acc = *(const LAS f32x4*)(CW + 512 + cc);
#pragma unroll
            for (int j = 0; j < 4; ++j) acc += *(const LAS f32x4*)(CW + j * 128 + cc) * *(const LAS f32x4*)(L + L_XBS + (t_ld + j) * 128 + cc);
            *(LAS f32x4*)(L + L_XC + t_ld * 128 + cc) = acc;
            { u32x2 pw; pw.x = pk2(acc[0], acc[1]); pw.y = pk2(acc[2], acc[3]); *(LAS u32x2*)(c.lds + LB_XCB + t_ld * XCB_STRIDE + cc * 2) = pw; } }
        WG_BAR();
#pragma unroll
        for (int m = 0; m < 4; ++m) {
            f32x4 ar = (f32x4){0.f, 0.f, 0.f, 0.f}, ai = (f32x4){0.f, 0.f, 0.f, 0.f};
#pragma unroll
            for (int ks = 0; ks < 4; ++ks) {
                const bf16x8 af = *(const LAS bf16x8*)(c.lds + LB_XCB + (16 * m + fr) * XCB_STRIDE + (32 * ks + 8 * fq) * 2);
                ar = __builtin_amdgcn_mfma_f32_16x16x32_bf16(af, Ba[ks], ar, 0, 0, 0);
                ai = __builtin_amdgcn_mfma_f32_16x16x32_bf16(af, Bx[ks], ai, 0, 0, 0);
            }
#pragma unroll
            for (int j = 0; j < 4; ++j) {
                const int t = 16 * m + 4 * fq + j;
                const float r = sig_fast(ar[j] + ba), ig = sig_fast(ai[j] + bx);
                const float la = sp8 * r, x2 = 2.0f * la;
                const float em = x2 > -0.5f ? x2 * (1.0f + x2 * (0.5f + x2 * (0.16666667f + x2 * (0.041666668f + x2 * 0.0083333338f)))) : __expf(x2) - 1.0f;
                L[L_AS + t * 128 + e] = __expf(la); L[L_BS + t * 128 + e] = __builtin_amdgcn_sqrtf(-em) * ig * L[L_XC + t * 128 + e];
            }
        }
        WG_BAR();
        float P = 1.f, Bv = 0.f;
#pragma unroll
        for (int tt = 0; tt < 16; ++tt) { const float aa = L[L_AS + (sg * 16 + tt) * 128 + cch], bb = L[L_BS + (sg * 16 + tt) * 128 + cch]; Bv = aa * Bv + bb; P *= aa; }
        L[L_SEG + (sg * 128 + cch) * 2] = P; L[L_SEG + (sg * 128 + cch) * 2 + 1] = Bv;
        WG_BAR();
        float h = L[L_CARRY + par * 128 + cch];
        for (int s2 = 0; s2 < sg; ++s2) h = L[L_SEG + (s2 * 128 + cch) * 2] * h + L[L_SEG + (s2 * 128 + cch) * 2 + 1];
        { bf16* op = OB + (size_t)(b * SEQ + t0 + sg * 16) * D + n * 128 + cch;
#pragma unroll
          for (int tt = 0; tt < 16; ++tt) { const int t = sg * 16 + tt;
              h = L[L_AS + t * 128 + cch] * h + L[L_BS + t * 128 + cch];
              op[(size_t)tt * D] = (bf16)f2bf(h * bf2f(ygr[tt])); } }
        if (sg == 3) L[L_CARRY + (par ^ 1) * 128 + cch] = h;
        if (c.tid < 384) L[L_XBS + c.tid] = L[L_XBS + 64 * 128 + c.tid];
    }
    __syncthreads();
    if (c.tid < 128) a.out[O_LRP + ((size_t)l * NBATCH + b) * D + n * 128 + c.tid] = L[L_CARRY + c.tid];
    if (c.tid < 384) a.out[O_CVP + (((size_t)l * NBATCH + b) * 3 + (c.tid >> 7)) * D + n * 128 + (c.tid & 127)] = L[L_XBS + c.tid];
    __syncthreads();
}
__device__ __forceinline__ void lru_sample_item(CArgs& a, Ctx& c, int l, int n, int hf) {
    LAS float* L = (LAS float*)c.lds;
    const bf16* XB = (const bf16*)(a.ws + WS_XB); const bf16* YG = (const bf16*)(a.ws + WS_YG); bf16* OB = (bf16*)(a.ws + WS_OB);
    const int t_ld = c.tid >> 3, c0 = (c.tid & 7) * 16;
    const float* cw = a.in[14] + (size_t)l * 4 * D + n * 128; const float* cb = a.in[15] + (size_t)l * D + n * 128;
    const int bs = hf * 64 + t_ld, row = MP + bs;
    const float* sc = a.in[4] + ((size_t)l * NS + bs) * 3 * D + n * 128;
    float* nc = a.out + O_CVS + ((size_t)l * NS + bs) * 3 * D + n * 128;
    __syncthreads();
#pragma unroll
    for (int j4 = 0; j4 < 4; ++j4) { const int cc = c0 + 4 * j4;
        const f32x4 x = ld_bf4(XB + (size_t)row * D + n * 128 + cc);
        const f32x4 s0 = *(const f32x4*)(sc + cc), s1 = *(const f32x4*)(sc + D + cc), s2 = *(const f32x4*)(sc + 2 * D + cc);
        const f32x4 acc = *(const f32x4*)(cb + cc) + *(const f32x4*)(cw + cc) * s0 + *(const f32x4*)(cw + D + cc) * s1 + *(const f32x4*)(cw + 2 * D + cc) * s2 + *(const f32x4*)(cw + 3 * D + cc) * x;
        *(LAS f32x4*)(L + L_XC + t_ld * 128 + cc) = acc;
        { u32x2 w; w.x = pk2(acc[0], acc[1]); w.y = pk2(acc[2], acc[3]); *(LAS u32x2*)(c.lds + LB_XCB + t_ld * XCB_STRIDE + cc * 2) = w; }
        *(f32x4*)(nc + cc) = s1; *(f32x4*)(nc + D + cc) = s2; *(f32x4*)(nc + 2 * D + cc) = x; }
    __syncthreads();
    lru_gates(a, c, l, n);
    __syncthreads();
    { const int cch = c.tid & 127, tg = c.tid >> 7;
#pragma unroll 4
      for (int tt = 0; tt < 16; ++tt) { const int t = tg * 16 + tt, b2 = hf * 64 + t; const size_t off = (size_t)(MP + b2) * D + n * 128 + cch;
          const float h0 = a.in[3][((size_t)l * NS + b2) * D + n * 128 + cch];
          const float h = L[L_AS + t * 128 + cch] * h0 + L[L_BS + t * 128 + cch];
          a.out[O_LRS + ((size_t)l * NS + b2) * D + n * 128 + cch] = h;
          OB[off] = (bf16)f2bf(h * bf2f(YG[off])); } }
    __syncthreads();
}

__device__ __forceinline__ void mixer_phase(CArgs& a, Ctx& c, int l) {
    if (c.wg < 64) {
        const int b = c.wg >> 3, h = c.wg & 7;
        {
#if FAST_HGRN
        hgrn_fast_prompt(a, c, l, b, h);
#else
        hgrn_naive(a, c, l, b * SEQ, SEQ, h, nullptr, a.out + O_HGP + (((size_t)l * NBATCH + b) * NH + h) * DKV * DKV);
#endif
        }
    } else if (c.wg < 128) {
        const int i = c.wg - 64;
        for (int rep = 0; rep < 1 + ((PROBE_MIX >> 1) & 1); ++rep) lru_prompt_item(a, c, l, i >> 3, i & 7);
        if (i < 16) for (int rep = 0; rep < 1 + ((PROBE_MIX >> 3) & 1); ++rep) lru_sample_item(a, c, l, i >> 1, i & 1);
    } else {
        for (int rep = 0; rep < 1 + ((PROBE_MIX >> 2) & 1); ++rep)
        for (int it = c.wg - 128; it < NS * NH; it += c.G - 128) {
            const int bs = it >> 3, h = it & 7; const size_t so = (((size_t)l * NS + bs) * NH + h) * DKV * DKV;
            hgrn_naive(a, c, l, MP + bs, 1, h, a.in[2] + so, a.out + O_HGS + so);
        }
    }
}

__global__ void __launch_bounds__(512, 2) mega_fwd(Args a0) {
    extern __shared__ __attribute__((aligned(16))) unsigned char lds_raw[];
    Ctx c; c.lds = (LAS unsigned char*)lds_raw; c.tid = threadIdx.x; c.G = gridDim.x; c.wg = blockIdx.x;
    volatile LAS unsigned* MISC = (volatile LAS unsigned*)(c.lds + MISC_OFF);
    if (c.tid < 32) MISC[c.tid] = 0u;
    __syncthreads();
    XcdBarrier bar; bar.bar = (unsigned*)(a0.ws + WS_CTL) + 1024; bar.x = 0; bar.st = nullptr;
    if (a0.ph_hi - a0.ph_lo > 1) bar = xcd_barrier_post((unsigned*)(a0.ws + WS_CTL) + 1024, MISC + 8);

    for (int ph = a0.ph_lo; ph < a0.ph_hi; ++ph) {
        CArgs* ap = (CArgs*)__builtin_amdgcn_kernarg_segment_ptr(); asm volatile("" : "+s"(ap));
        CArgs& a = *ap;
        { int t_ = threadIdx.x, w_ = blockIdx.x, g_ = gridDim.x; asm volatile("" : "+v"(t_), "+s"(w_), "+s"(g_)); c.tid = t_; c.wg = w_; c.G = g_; }
        float* X = a.out;
        if (ph == 0) p0_prologue(a, c);
        else if (ph == NPHASE - 1) final_norm_phase(a, c);
        else {
            const int l = (ph - 1) >> 3, j = (ph - 1) & 7;
            const bf16* wl = (const bf16*)(a.ws + WS_W + (size_t)l * WL_STRIDE);
            const float* xp = l == 0 ? a.in[0] : X; const float* xs = l == 0 ? a.in[1] : X + (size_t)MP * D;
            const float* modl = (const float*)(a.ws + WS_MOD) + (size_t)l * NMOD * 6144;
            bf16* H = (bf16*)(a.ws + WS_H);
            if (j == 0) norm_phase(a, c, l, 0, xp, xs);
            else if (j == 1) {
                EpiIn e{(bf16*)(a.ws + WS_Q), (bf16*)(a.ws + WS_K), (bf16*)(a.ws + WS_V), (bf16*)(a.ws + WS_OG), (bf16*)(a.ws + WS_XB), (bf16*)(a.ws + WS_YG), (bf16*)(a.ws + WS_SGA), (bf16*)(a.ws + WS_SGB),
                        (float*)(a.ws + WS_LOGF), (const float*)(a.ws + WS_TAB) + (size_t)l * 3 * D};
                gemm_phase_sel<0>(c, H, wl + OFF_WIN / 2, MT, NIN, D, e);
            } else if (j == 2) mixer_phase(a, c, l);
            else if (j == 3) {
                EpiBrA ea{(const bf16*)(a.ws + WS_SGA), (float*)(a.ws + WS_T)};
                gemm_phase_sel<1>(c, (const bf16*)(a.ws + WS_OA), wl + OFF_WA / 2, MT, D, D, ea);
                asm volatile("s_waitcnt vmcnt(0)" ::: "memory"); __syncthreads();
                { int t_ = threadIdx.x; asm volatile("" : "+v"(t_)); c.tid = t_; }
                EpiBrB eb{(const bf16*)(a.ws + WS_SGB), (const float*)(a.ws + WS_T), (bf16*)(a.ws + WS_MG)};
                gemm_phase_sel<2>(c, (const bf16*)(a.ws + WS_OB), wl + OFF_WB / 2, MT, D, D, eb);
            } else if (j == 4) {
                EpiRes e{xp, xs, X, modl, 2};
                gemm_phase_sel<3>(c, (const bf16*)(a.ws + WS_MG), wl + OFF_WO / 2, MT, D, D, e);
            } else if (j == 5) norm_phase(a, c, l, 1, X, X + (size_t)MP * D);
            else if (j == 6) { EpiFF1 e{(bf16*)(a.ws + WS_HM)}; gemm_phase_sel<4>(c, H, wl + OFF_W1 / 2, MT, FF, D, e); }
            else { EpiRes e{X, X + (size_t)MP * D, X, modl, 5}; gemm_phase_sel<5>(c, (const bf16*)(a.ws + WS_HM), wl + OFF_W2 / 2, MT, D, FF, e); }
        }
        if (ph + 1 < a0.ph_hi) xcd_barrier(bar);
    }
}

extern "C" void kernel_launch(void* const* d_in, const int* in_sizes, int n_in, void* d_out, int out_size, void* d_ws, size_t ws_size, hipStream_t stream) {
    static int grid = 0;
    if (grid == 0) {
        if (n_in != 27 || out_size != (int)O_END || ws_size < WS_END) { fprintf(stderr, "kernel_launch: unexpected shapes (n_in %d out %d ws %zu)\n", n_in, out_size, ws_size); grid = -1; return; }
        int dev = 0, cus = 0, per_cu = 0;
        if (hipGetDevice(&dev) != hipSuccess || hipDeviceGetAttribute(&cus, hipDeviceAttributeMultiprocessorCount, dev) != hipSuccess) { grid = -1; return; }
        if (hipFuncSetAttribute((const void*)mega_fwd, hipFuncAttributeMaxDynamicSharedMemorySize, LDS_BYTES) != hipSuccess) { fprintf(stderr, "kernel_launch: hipFuncSetAttribute failed\n"); grid = -1; return; }
        if (hipOccupancyMaxActiveBlocksPerMultiprocessor(&per_cu, (const void*)mega_fwd, 512, LDS_BYTES) != hipSuccess || per_cu < 1) { fprintf(stderr, "kernel_launch: occupancy query failed (%d)\n", per_cu); (void)hipGetLastError(); per_cu = 1; }
        grid = cus * (per_cu < 1 ? 1 : 1);
        fprintf(stderr, "kernel_launch: cus %d per_cu %d grid %d\n", cus, per_cu, grid);
    }
    if (grid < 0) return;
    (void)hipMemsetAsync((char*)d_ws + WS_CTL, 0, CTL_BYTES, stream);
    Args a{};
    for (int i = 0; i < 27; ++i) a.in[i] = (const float*)d_in[i];
    a.out = (float*)d_out; a.ws = (unsigned char*)d_ws;
#if ONE_LAUNCH
    a.ph_lo = 0; a.ph_hi = NPHASE;
    void* kargs[] = {&a};
    hipError_t e = hipLaunchCooperativeKernel((const void*)mega_fwd, dim3(grid), dim3(512), kargs, LDS_BYTES, stream);
    if (e != hipSuccess) fprintf(stderr, "kernel_launch: cooperative launch failed: %s (grid %d)\n", hipGetErrorString(e), grid);
#else
    for (int ph = 0; ph < NPHASE; ++ph) { a.ph_lo = ph; a.ph_hi = ph + 1;
        for (int rep = 0; rep < 1 + (int)((PROBE_REPEAT >> ph) & 1); ++rep) hipLaunchKernelGGL(mega_fwd, dim3(grid), dim3(512), LDS_BYTES, stream, a); }
#endif
}
```

```cpp
#include <hip/hip_runtime.h>
#include <cstdio>
#include <cstdint>

#ifndef FAST_GEMM
#define FAST_GEMM 63
#endif
#ifndef FAST_HGRN
#define FAST_HGRN 1
#endif
#ifndef FAST_GATES
#define FAST_GATES 1
#endif
#ifndef DBG_SHFL
#define DBG_SHFL 1
#endif
#ifndef PROBE_REPEAT
#define PROBE_REPEAT 0
#endif
#ifndef PROBE_MIX
#define PROBE_MIX 0
#endif
#ifndef PROBE_P0
#define PROBE_P0 0
#endif
#ifndef ONE_LAUNCH
#define ONE_LAUNCH 1
#endif

#define LAS __attribute__((address_space(3)))
#define GAS __attribute__((address_space(1)))
typedef unsigned short bf16;
typedef float f32x4 __attribute__((ext_vector_type(4)));
typedef float f32x2 __attribute__((ext_vector_type(2)));
typedef short bf16x8 __attribute__((ext_vector_type(8)));
typedef unsigned u32x4 __attribute__((ext_vector_type(4)));
typedef unsigned u32x2 __attribute__((ext_vector_type(2)));

constexpr int D = 1024, NBATCH = 8, SEQ = 2048, MP = NBATCH * SEQ, NS = 128, MR = MP + NS, MT = 16640;
constexpr int NMOD = NBATCH + NS;
constexpr int NIN = 8192, FF = 4096, NH = 8, DKV = 128;
constexpr float EPS = 1e-6f;
constexpr int NPHASE = 18;

constexpr size_t MiB = (size_t)1 << 20;
constexpr size_t WS_CTL = 0, CTL_BYTES = 64 * 1024;
constexpr size_t WS_TAB = 1 * MiB;
constexpr size_t WS_MOD = 2 * MiB;
constexpr size_t WS_W = 9 * MiB, WL_STRIDE = 77 * MiB / 2;
constexpr size_t OFF_WIN = 0, OFF_WA = 16 * MiB, OFF_WB = 18 * MiB, OFF_WO = 20 * MiB, OFF_W1 = 22 * MiB, OFF_W2 = 30 * MiB, OFF_LWA = 38 * MiB, OFF_LWX = 38 * MiB + 256 * 1024;
constexpr size_t WS_H = 86 * MiB;
constexpr size_t WS_Q = 119 * MiB, WS_K = 152 * MiB, WS_V = 185 * MiB, WS_OG = 218 * MiB, WS_XB = 251 * MiB, WS_YG = 284 * MiB, WS_SGA = 317 * MiB, WS_SGB = 350 * MiB;
constexpr size_t WS_LOGF = 383 * MiB;
constexpr size_t WS_T = WS_LOGF;
constexpr size_t WS_MG = WS_K;
constexpr size_t WS_HM = WS_OG;
constexpr size_t WS_OA = 448 * MiB;
constexpr size_t WS_OB = WS_H;
constexpr size_t WS_END = 481 * MiB;
static_assert(WS_W + 2 * WL_STRIDE <= WS_H && WS_H + (size_t)MT * D * 2 <= WS_Q && WS_LOGF + (size_t)MT * D * 4 <= WS_OA && WS_OA + (size_t)MT * D * 2 <= WS_END && WS_HM + (size_t)MT * FF * 2 <= WS_SGB, "ws map");

constexpr size_t O_YP = 0, O_YS = (size_t)MP * D, O_HGP = O_YS + (size_t)NS * D, O_LRP = O_HGP + (size_t)2 * NBATCH * NH * DKV * DKV, O_CVP = O_LRP + (size_t)2 * NBATCH * D,
                 O_HGS = O_CVP + (size_t)2 * NBATCH * 3 * D, O_LRS = O_HGS + (size_t)2 * NS * NH * DKV * DKV, O_CVS = O_LRS + (size_t)2 * NS * D, O_END = O_CVS + (size_t)2 * NS * 3 * D;
static_assert(O_END == 53673984, "out map");

constexpr int LDS_BYTES = 163840;
constexpr int MISC_OFF = 158 * 1024;

typedef __bf16 bf16x2_t __attribute__((ext_vector_type(2)));
__device__ __forceinline__ unsigned f2bf(float f) { return (unsigned)__builtin_bit_cast(unsigned short, (__bf16)f); }
__device__ __forceinline__ unsigned pk2(float lo, float hi) { return __builtin_bit_cast(unsigned, __builtin_convertvector((f32x2){lo, hi}, bf16x2_t)); }
__device__ __forceinline__ float bf2f(unsigned b) { return __builtin_bit_cast(float, b << 16); }
__device__ __forceinline__ f32x4 ld_bf4(const bf16* p) { const u32x2 w = *(const u32x2*)p; return (f32x4){bf2f(w.x & 0xffffu), bf2f(w.x >> 16), bf2f(w.y & 0xffffu), bf2f(w.y >> 16)}; }
__device__ __forceinline__ void st_bf4(bf16* p, f32x4 v) { u32x2 w; w.x = pk2(v[0], v[1]); w.y = pk2(v[2], v[3]); *(u32x2*)p = w; }
#define WG_BAR() do { asm volatile("s_waitcnt lgkmcnt(0)" ::: "memory"); __builtin_amdgcn_s_barrier(); asm volatile("" ::: "memory"); } while (0)
__device__ __forceinline__ float sig_fast(float x) { return __builtin_amdgcn_rcpf(1.0f + __expf(-x)); }
__device__ __forceinline__ void st_bf8(bf16* p, f32x4 v0, f32x4 v1) { u32x4 w; w.x = pk2(v0[0], v0[1]); w.y = pk2(v0[2], v0[3]); w.z = pk2(v1[0], v1[1]); w.w = pk2(v1[2], v1[3]); *(u32x4*)p = w; }
__device__ __forceinline__ void ld_bf8(const bf16* p, f32x4& v0, f32x4& v1) { const u32x4 w = *(const u32x4*)p; v0 = (f32x4){bf2f(w.x & 0xffffu), bf2f(w.x >> 16), bf2f(w.y & 0xffffu), bf2f(w.y >> 16)}; v1 = (f32x4){bf2f(w.z & 0xffffu), bf2f(w.z >> 16), bf2f(w.w & 0xffffu), bf2f(w.w >> 16)}; }
__device__ __forceinline__ float sigmoidf_(float x) { return 1.0f / (1.0f + __expf(-x)); }
__device__ __forceinline__ float siluf_(float x) { return x * sigmoidf_(x); }
__device__ __forceinline__ float gelu_tanh_(float x) { const float u = 0.7978845608028654f * (x + 0.044715f * x * x * x); return x * sigmoidf_(2.0f * u); }
__device__ __forceinline__ float softplusf_(float x) { return fmaxf(x, 0.f) + log1pf(expf(-fabsf(x))); }
template <int XM> __device__ __forceinline__ float swz_xor(float v) { return __builtin_bit_cast(float, __builtin_amdgcn_ds_swizzle(__builtin_bit_cast(int, v), (XM << 10) | 0x1f)); }
__device__ __forceinline__ int lane_id_fresh() { int l = (int)__builtin_amdgcn_mbcnt_hi(~0u, __builtin_amdgcn_mbcnt_lo(~0u, 0u)); asm volatile("" : "+v"(l)); return l; }
__device__ __forceinline__ float xchg(float v, int l, int m) { return __builtin_bit_cast(float, __builtin_amdgcn_ds_bpermute((l ^ m) << 2, __builtin_bit_cast(int, v))); }
__device__ __forceinline__ float row16_sum(float v) { const int l = lane_id_fresh(); v += xchg(v, l, 1); v += xchg(v, l, 2); v += xchg(v, l, 4); v += xchg(v, l, 8); return v; }
__device__ __forceinline__ float half_sum(float v) { const int l = lane_id_fresh(); v += xchg(v, l, 1); v += xchg(v, l, 2); v += xchg(v, l, 4); v += xchg(v, l, 8); v += xchg(v, l, 16); return v; }
__device__ __forceinline__ float wave_sum(float v) { const int l = lane_id_fresh(); v += xchg(v, l, 1); v += xchg(v, l, 2); v += xchg(v, l, 4); v += xchg(v, l, 8); v += xchg(v, l, 16); v += xchg(v, l, 32); return v; }
__device__ __forceinline__ int mod_row(int row) { return row < MP ? (row >> 11) : (NBATCH + row - MP); }

struct Args { const float* in[27]; float* out; unsigned char* ws; int ph_lo, ph_hi; };
typedef const __attribute__((address_space(4))) Args CArgs;
struct Ctx { LAS unsigned char* lds; int tid, G, wg; };
namespace pg8 {
#define PG8_LAS __attribute__((address_space(3)))
typedef unsigned short bf16_t;
typedef short bf16x8 __attribute__((ext_vector_type(8)));
typedef float f32x4 __attribute__((ext_vector_type(4)));
typedef unsigned u32x4 __attribute__((ext_vector_type(4)));
constexpr int BM = 256, BK = 64, HALF = 128, HTB = HALF * BK * 2  , STAGE_BYTES = 8 * HTB, NXCD = 8, WGM = 8;

__host__ __device__ __forceinline__ int lds_byte(int r, int c) { const int st = (r >> 4) * 2 + (c >> 5), rr = r & 15, cc = c & 31, ob = rr * 64 + cc * 2; return st * 1024 + (ob ^ (((ob >> 9) & 1) << 5)); }
__host__ __device__ __forceinline__ void stage_rc(int b, int& R, int& C) { const int st = b / 1024, sb = b % 1024, swz = sb ^ (((sb >> 9) & 1) << 5); R = (st >> 1) * 16 + swz / 64; C = (st & 1) * 32 + (swz % 64) / 2; }
__host__ __device__ __forceinline__ int perm32(int rho) { const int n = rho >> 4, i = rho & 15; return 8 * (i >> 2) + 4 * n + (i & 3); }

struct Unit { int pm, pn; };
struct Gemm { const bf16_t* A; const bf16_t* Bt; int M, N, K; };

struct StaticOrder {
    int nM, nN, nwg, G, c;
    __host__ __device__ void init(int M, int N, int G_, int c_) { nM = M / BM; nN = N / BM; nwg = nM * nN; G = G_; c = c_; }
    __host__ __device__ bool next(int i, Unit& u) const {
        const long L = (long)i * G + c; if (L >= nwg) return false;
        int wgid = (int)L; { const int q = nwg / NXCD, r = nwg % NXCD, xcd = wgid % NXCD, off = wgid / NXCD; wgid = (xcd < r ? xcd * (q + 1) : r * (q + 1) + (xcd - r) * q) + off; }
        const int nig = WGM * nN, gid = wgid / nig, fm = gid * WGM, gsz = (nM - fm) < WGM ? (nM - fm) : WGM;
        u.pm = fm + ((wgid % nig) % gsz); u.pn = (wgid % nig) / gsz; return true;
    }
    __device__ __forceinline__ void a_ready(const Unit&) const {}
    __device__ __forceinline__ void done(const Unit&) const {}
};
template <class Epi, class Sched, bool ALIGN_EPI = false, bool SP2 = false>
__device__ __forceinline__ void gemm_phase(PG8_LAS unsigned char* lds, const Gemm g, const Sched& S, const Epi& E, const int tid_in) {
    const int tid = tid_in, wid = __builtin_amdgcn_readfirstlane(tid >> 6), lane = tid & 63, wr = wid >> 2, wc = wid & 3, fr = lane & 15, fq = lane >> 4;
    const int K = g.K, nt = K / BK;
    unsigned voffA[2], voffB[2];
#pragma unroll
    for (int i = 0; i < 2; ++i) { int R, C; stage_rc(tid * 16 + i * 8192, R, C); const int Rb = Epi::PERM ? ((R & ~31) + perm32(R & 31)) : R;
        voffA[i] = (unsigned)(R * K + C) * 2u; voffB[i] = (unsigned)(Rb * K + C) * 2u; }
    const size_t kstep = (size_t)(BK * 2);
    const size_t hstep = (size_t)HALF * K * 2;
    const size_t tstep = 2 * hstep;
    const unsigned ldsw = (unsigned)wid * 1024u;
    const int aoff = lds_byte(wr * 64 + fr, fq * 8), boff = lds_byte(wc * 32 + fr, fq * 8);
#define PG8_SA(b, h) (((b) * 2 + (h)) * HTB)
#define PG8_SB(b, h) ((4 + (b) * 2 + (h)) * HTB)
#define PG8_STAGE(bufoff, gbase, voff) do { _Pragma("unroll") for (int _i = 0; _i < 2; ++_i) \
        __builtin_amdgcn_global_load_lds((const unsigned*)((const char*)(gbase) + (voff)[_i]), (PG8_LAS unsigned*)(lds + (bufoff) + ldsw + _i * 8192), 16, 0, 0); } while (0)
#define PG8_LDA(dst, b, h) do { _Pragma("unroll") for (int m = 0; m < 4; ++m) _Pragma("unroll") for (int k = 0; k < 2; ++k) dst[m][k] = *(const PG8_LAS bf16x8*)(lds + PG8_SA(b, h) + aoff + m * 2048 + k * 1024); } while (0)
#define PG8_LDB(dst, b, h) do { _Pragma("unroll") for (int n = 0; n < 2; ++n) _Pragma("unroll") for (int k = 0; k < 2; ++k) dst[n][k] = *(const PG8_LAS bf16x8*)(lds + PG8_SB(b, h) + boff + n * 2048 + k * 1024); } while (0)
#define PG8_MMA(ai, bj, At, Bt) do { __builtin_amdgcn_s_setprio(1); _Pragma("unroll") for (int m = 0; m < 4; ++m) _Pragma("unroll") for (int n = 0; n < 2; ++n) _Pragma("unroll") for (int k = 0; k < 2; ++k) \
        acc[ai][bj][m][n] = __builtin_amdgcn_mfma_f32_16x16x32_bf16(Bt[n][k], At[m][k], acc[ai][bj][m][n], 0, 0, 0); __builtin_amdgcn_s_setprio(0); } while (0)
#define PG8_WAIT_V(n) asm volatile("s_waitcnt vmcnt(" #n ")" ::: "memory")
#define PG8_WAIT_L(n) asm volatile("s_waitcnt lgkmcnt(" #n ")" ::: "memory")
#define PG8_BAR __builtin_amdgcn_s_barrier()
#define PG8_SCHED __builtin_amdgcn_sched_barrier(0)
    Unit cur, nxt; int ui = 0;
    if (!S.next(0, cur)) return;
    f32x4 acc[2][2][4][2];
#pragma unroll
    for (int a = 0; a < 2; ++a)
#pragma unroll
        for (int b = 0; b < 2; ++b)
#pragma unroll
            for (int m = 0; m < 4; ++m)
#pragma unroll
                for (int n = 0; n < 2; ++n) acc[a][b][m][n] = (f32x4){0.f, 0.f, 0.f, 0.f};
    bf16x8 At[4][2], B0[2][2], B1[2][2];
    const char* cA = (const char*)g.A + (size_t)cur.pm * tstep; const char* cB = (const char*)g.Bt + (size_t)cur.pn * tstep;
    S.a_ready(cur);
    if constexpr (SP2) {
        PG8_STAGE(PG8_SB(0, 0), cB, voffB); PG8_STAGE(PG8_SB(0, 1), cB + hstep, voffB); PG8_STAGE(PG8_SA(0, 0), cA, voffA); PG8_STAGE(PG8_SA(0, 1), cA + hstep, voffA);
        if (wr == 1) PG8_BAR;
        PG8_WAIT_V(2); PG8_BAR;
        PG8_STAGE(PG8_SB(1, 0), cB + kstep, voffB); PG8_STAGE(PG8_SA(1, 0), cA + kstep, voffA); PG8_STAGE(PG8_SB(1, 1), cB + hstep + kstep, voffB);
        PG8_WAIT_V(6); PG8_BAR;
    } else {
        PG8_STAGE(PG8_SB(0, 0), cB, voffB); PG8_STAGE(PG8_SA(0, 0), cA, voffA); PG8_STAGE(PG8_SB(0, 1), cB + hstep, voffB); PG8_STAGE(PG8_SA(0, 1), cA + hstep, voffA);
        if (wr == 1) PG8_BAR;
        PG8_WAIT_V(4); PG8_BAR;
        PG8_STAGE(PG8_SB(1, 0), cB + kstep, voffB); PG8_STAGE(PG8_SA(1, 0), cA + kstep, voffA); PG8_STAGE(PG8_SB(1, 1), cB + hstep + kstep, voffB);
        PG8_WAIT_V(6); PG8_BAR;
    }
    for (;;) {
        const bool has_next = S.next(ui + 1, nxt);
        const char* nA = has_next ? (const char*)g.A + (size_t)nxt.pm * tstep : cA; const char* nB = has_next ? (const char*)g.Bt + (size_t)nxt.pn * tstep : cB;
        for (int t = 0; t < nt; t += 2) {
            const bool last = (t == nt - 2);
            const char* a1 = cA + (size_t)(t + 1) * kstep;
            const char* a2 = last ? nA : cA + (size_t)(t + 2) * kstep; const char* b2 = last ? nB : cB + (size_t)(t + 2) * kstep;
            const char* a3 = a2 + kstep; const char* b3 = b2 + kstep;
            if (last && has_next) S.a_ready(nxt);
            if constexpr (SP2) {
            PG8_LDB(B0, 0, 0); PG8_LDB(B1, 0, 1); PG8_SCHED; PG8_LDA(At, 0, 0); PG8_STAGE(PG8_SA(1, 1), a1 + hstep, voffA);
            PG8_WAIT_V(8); PG8_WAIT_L(0); PG8_BAR; PG8_MMA(0, 0, At, B0); PG8_MMA(0, 1, At, B1); PG8_BAR; PG8_SCHED;
            PG8_LDA(At, 0, 1); PG8_STAGE(PG8_SB(0, 0), b2, voffB); PG8_STAGE(PG8_SB(0, 1), b2 + hstep, voffB); PG8_STAGE(PG8_SA(0, 0), a2, voffA);
            PG8_WAIT_V(8); PG8_WAIT_L(0); PG8_BAR; PG8_MMA(1, 0, At, B0); PG8_MMA(1, 1, At, B1); PG8_BAR; PG8_SCHED;
            PG8_LDB(B0, 1, 0); PG8_LDB(B1, 1, 1); PG8_SCHED; PG8_LDA(At, 1, 0); PG8_STAGE(PG8_SA(0, 1), a2 + hstep, voffA);
            PG8_WAIT_V(8); PG8_WAIT_L(0); PG8_BAR; PG8_MMA(0, 0, At, B0); PG8_MMA(0, 1, At, B1); PG8_BAR; PG8_SCHED;
            PG8_LDA(At, 1, 1); PG8_STAGE(PG8_SB(1, 0), b3, voffB); PG8_STAGE(PG8_SB(1, 1), b3 + hstep, voffB); PG8_STAGE(PG8_SA(1, 0), a3, voffA);
            PG8_WAIT_V(8); PG8_WAIT_L(0); PG8_BAR; PG8_MMA(1, 0, At, B0); PG8_MMA(1, 1, At, B1); PG8_BAR; PG8_SCHED;
            } else {
            PG8_LDB(B0, 0, 0); PG8_SCHED; PG8_LDA(At, 0, 0); PG8_STAGE(PG8_SA(1, 1), a1 + hstep, voffA);
            PG8_WAIT_L(8); PG8_BAR; PG8_WAIT_L(0); PG8_MMA(0, 0, At, B0); PG8_BAR; PG8_SCHED;
            PG8_LDB(B1, 0, 1); PG8_STAGE(PG8_SB(0, 0), b2, voffB);
            PG8_BAR; PG8_WAIT_L(0); PG8_MMA(0, 1, At, B1); PG8_BAR;
            PG8_LDA(At, 0, 1); PG8_STAGE(PG8_SA(0, 0), a2, voffA);
            PG8_BAR; PG8_WAIT_L(0); PG8_MMA(1, 0, At, B0); PG8_BAR; PG8_SCHED;
            PG8_STAGE(PG8_SB(0, 1), b2 + hstep, voffB);
            PG8_WAIT_V(6); PG8_BAR; PG8_MMA(1, 1, At, B1); PG8_BAR;
            PG8_LDB(B0, 1, 0); PG8_SCHED; PG8_LDA(At, 1, 0); PG8_STAGE(PG8_SA(0, 1), a2 + hstep, voffA);
            PG8_WAIT_L(8); PG8_BAR; PG8_WAIT_L(0); PG8_MMA(0, 0, At, B0); PG8_BAR; PG8_SCHED;
            PG8_LDB(B1, 1, 1); PG8_STAGE(PG8_SB(1, 0), b3, voffB);
            PG8_BAR; PG8_WAIT_L(0); PG8_MMA(0, 1, At, B1); PG8_BAR;
            PG8_LDA(At, 1, 1); PG8_STAGE(PG8_SA(1, 0), a3, voffA);
            PG8_BAR; PG8_WAIT_L(0); PG8_MMA(1, 0, At, B0); PG8_BAR; PG8_SCHED;
            PG8_STAGE(PG8_SB(1, 1), b3 + hstep, voffB);
            PG8_WAIT_V(6); PG8_BAR; PG8_MMA(1, 1, At, B1); PG8_BAR;
            }
        }
        if constexpr (ALIGN_EPI) { if (wr == 0) PG8_BAR; }
        if constexpr (!Epi::AFTER_DRAIN) { int l2 = (int)__builtin_amdgcn_mbcnt_hi(~0u, __builtin_amdgcn_mbcnt_lo(~0u, 0u)); asm volatile("" : "+v"(l2));
            E(acc, cur, wr, wc, l2 & 15, l2 >> 4); S.done(cur); }
        if (!has_next) break;
#pragma unroll
        for (int a = 0; a < 2; ++a)
#pragma unroll
            for (int b = 0; b < 2; ++b)
#pragma unroll
                for (int m = 0; m < 4; ++m)
#pragma unroll
                    for (int n = 0; n < 2; ++n) acc[a][b][m][n] = (f32x4){0.f, 0.f, 0.f, 0.f};
        cur = nxt; cA = nA; cB = nB; ++ui;
        if constexpr (ALIGN_EPI) { if (wr == 1) PG8_BAR; }
    }
    PG8_WAIT_V(0);
    if constexpr (!ALIGN_EPI) { if (wr == 0) PG8_BAR; }
    PG8_BAR;
    if constexpr (Epi::AFTER_DRAIN) { E.fused(acc, cur, wr, wc, fr, fq, lds, wid, lane); S.done(cur); }
#undef PG8_SA
#undef PG8_SB
#undef PG8_STAGE
#undef PG8_LDA
#undef PG8_LDB
#undef PG8_MMA
#undef PG8_WAIT_V
#undef PG8_WAIT_L
#undef PG8_BAR
#undef PG8_SCHED
}
}

template <class E> struct QuadEpi {
    static constexpr bool PERM = false, AFTER_DRAIN = false;
    E e;
    __device__ __forceinline__ void operator()(const f32x4 (&acc)[2][2][4][2], const pg8::Unit& u, int wr, int wc, int fr, int fq) const {
        const int row0 = u.pm * 256 + wr * 64 + fr, col0 = u.pn * 256 + wc * 32 + 4 * fq;
#pragma unroll
        for (int ai = 0; ai < 2; ++ai)
#pragma unroll
            for (int m = 0; m < 4; ++m)
#pragma unroll
                for (int bj = 0; bj < 2; ++bj)
#pragma unroll
                    for (int n = 0; n < 2; ++n) e.quad(row0 + ai * 128 + m * 16, col0 + bj * 128 + n * 16, acc[ai][bj][m][n]);
    }
};

struct EpiIn {
    bf16 *Q, *Kb, *V, *OG, *XB, *YG, *SGA, *SGB; float* LOGF; const float* lbt; int lb0;
    static constexpr bool BY_REGION = true;
    __device__ __forceinline__ f32x2 fgate(float fa, float lb, float llb, float l1m) const {
        float lf, kk;
        const float t = __expf(-fabsf(fa));
        const float ls = fminf(fa, 0.f) - __logf(1.0f + t);
        const float sneg = (fa >= 0.f ? t : 1.0f) * __builtin_amdgcn_rcpf(1.0f + t);
        if (lb0) { lf = ls; kk = sneg; }
        else { const float b = l1m + ls, mx = fmaxf(llb, b); lf = mx + __logf(1.0f + __expf(-fabsf(llb - b))); kk = (1.0f - lb) * sneg; }
        return (f32x2){lf, kk};
    }
    template <int R> __device__ __forceinline__ f32x4 act(f32x4 v) const {
        f32x4 r;
#pragma unroll
        for (int j = 0; j < 4; ++j) {
            if constexpr (R == 0 || R == 3) r[j] = v[j] * sig_fast(v[j]);
            else if constexpr (R == 5) { const float x = v[j], u = 0.7978845608028654f * (x + 0.044715f * x * x * x); r[j] = x * sig_fast(2.0f * u); }
            else if constexpr (R >= 6) r[j] = sig_fast(v[j]);
            else r[j] = v[j];
        }
        return r;
    }
    template <int R> __device__ __forceinline__ bf16* dst() const { return R == 0 ? Q : R == 2 ? V : R == 3 ? OG : R == 4 ? XB : R == 5 ? YG : R == 6 ? SGA : SGB; }
    template <int R> __device__ __forceinline__ void quadR(int row, int cc, f32x4 v) const {
        const size_t o = (size_t)row * D + cc;
        if constexpr (R == 1) {
            const f32x4 lb = *(const f32x4*)(lbt + cc), llb = *(const f32x4*)(lbt + 1024 + cc), l1m = *(const f32x4*)(lbt + 2048 + cc);
            f32x4 lf, r;
#pragma unroll
            for (int j = 0; j < 4; ++j) { const f32x2 g = fgate(v[j], lb[j], llb[j], l1m[j]); lf[j] = g.x; r[j] = g.y; }
            *(f32x4*)(LOGF + o) = lf; st_bf4(Kb + o, r);
        } else st_bf4(dst<R>() + o, act<R>(v));
    }
    template <int R> __device__ __forceinline__ void octR(int row, int cc, f32x4 v0, f32x4 v1) const {
        const size_t o = (size_t)row * D + cc;
        if constexpr (R == 1) {
            f32x4 lf0, lf1, r0, r1;
            if (lb0) {
#pragma unroll
                for (int j = 0; j < 4; ++j) { const f32x2 g0 = fgate(v0[j], 0.f, 0.f, 0.f), g1 = fgate(v1[j], 0.f, 0.f, 0.f); lf0[j] = g0.x; r0[j] = g0.y; lf1[j] = g1.x; r1[j] = g1.y; }
            } else {
                const f32x4 lba = *(const f32x4*)(lbt + cc), lbb = *(const f32x4*)(lbt + cc + 4), lla = *(const f32x4*)(lbt + 1024 + cc), llb_ = *(const f32x4*)(lbt + 1024 + cc + 4), l1a = *(const f32x4*)(lbt + 2048 + cc), l1b = *(const f32x4*)(lbt + 2048 + cc + 4);
#pragma unroll
                for (int j = 0; j < 4; ++j) { const f32x2 g0 = fgate(v0[j], lba[j], lla[j], l1a[j]), g1 = fgate(v1[j], lbb[j], llb_[j], l1b[j]); lf0[j] = g0.x; r0[j] = g0.y; lf1[j] = g1.x; r1[j] = g1.y; }
            }
            *(f32x4*)(LOGF + o) = lf0; *(f32x4*)(LOGF + o + 4) = lf1; st_bf8(Kb + o, r0, r1);
        } else st_bf8(dst<R>() + o, act<R>(v0), act<R>(v1));
    }
    __device__ __forceinline__ void quad(int row, int col, f32x4 v) const {
        const int reg = col >> 10, cc = col & 1023;
        switch (reg) { case 0: quadR<0>(row, cc, v); break; case 1: quadR<1>(row, cc, v); break; case 2: quadR<2>(row, cc, v); break; case 3: quadR<3>(row, cc, v); break;
                       case 4: quadR<4>(row, cc, v); break; case 5: quadR<5>(row, cc, v); break; case 6: quadR<6>(row, cc, v); break; default: quadR<7>(row, cc, v); break; }
    }
};
struct EpiInUnit {
    static constexpr bool PERM = true, AFTER_DRAIN = false;
    EpiIn e;
    template <int KIND> __device__ __forceinline__ void run(const f32x4 (&acc)[2][2][4][2], int row0, int cc0, bf16* dstp, int mode) const {
#pragma unroll
        for (int ai = 0; ai < 2; ++ai)
#pragma unroll
            for (int m = 0; m < 4; ++m) {
#pragma unroll
                for (int bj = 0; bj < 2; ++bj) {
                    const int row = row0 + ai * 128 + m * 16, cc = cc0 + bj * 128;
                    const f32x4 v0 = acc[ai][bj][m][0], v1 = acc[ai][bj][m][1];
                    if constexpr (KIND == 0) e.octR<1>(row, cc, v0, v1);
                    else if constexpr (KIND == 1) st_bf8(dstp + (size_t)row * D + cc, v0, v1);
                    else { f32x4 r0, r1;
#pragma unroll
                        for (int j = 0; j < 4; ++j) {
                            const float x0 = v0[j], x1 = v1[j];
                            const float a0 = mode == 1 ? 1.5957691216057308f * (x0 + 0.044715f * x0 * x0 * x0) : x0, a1 = mode == 1 ? 1.5957691216057308f * (x1 + 0.044715f * x1 * x1 * x1) : x1;
                            const float s0 = sig_fast(a0), s1 = sig_fast(a1);
                            r0[j] = mode == 2 ? s0 : x0 * s0; r1[j] = mode == 2 ? s1 : x1 * s1; }
                        st_bf8(dstp + (size_t)row * D + cc, r0, r1); }
                }
                asm volatile("" ::: "memory"); __builtin_amdgcn_sched_barrier(0); }
    }
    __device__ __forceinline__ void operator()(const f32x4 (&acc)[2][2][4][2], const pg8::Unit& u, int wr, int wc, int fr, int fq) const {
        const int row0 = u.pm * 256 + wr * 64 + fr, cc0 = (u.pn & 3) * 256 + wc * 32 + 8 * fq, reg = u.pn >> 2;
        if (reg == 1) run<0>(acc, row0, cc0, nullptr, 0);
        else if (reg == 2 || reg == 4) run<1>(acc, row0, cc0, reg == 2 ? e.V : e.XB, 0);
        else { bf16* dp = reg == 0 ? e.Q : reg == 3 ? e.OG : reg == 5 ? e.YG : reg == 6 ? e.SGA : e.SGB;
               run<2>(acc, row0, cc0, dp, reg == 5 ? 1 : (reg >= 6 ? 2 : 0)); }
    }
};
template <class E> struct OctEpi {
    static constexpr bool PERM = true, AFTER_DRAIN = false;
    E e;
    __device__ __forceinline__ void operator()(const f32x4 (&acc)[2][2][4][2], const pg8::Unit& u, int wr, int wc, int fr, int fq) const {
        const int row0 = u.pm * 256 + wr * 64 + fr, col0 = u.pn * 256 + wc * 32 + 8 * fq;
#pragma unroll
        for (int ai = 0; ai < 2; ++ai)
#pragma unroll
            for (int m = 0; m < 4; ++m) {
#pragma unroll
                for (int bj = 0; bj < 2; ++bj) e.oct(row0 + ai * 128 + m * 16, col0 + bj * 128, acc[ai][bj][m][0], acc[ai][bj][m][1]);
                asm volatile("" ::: "memory"); __builtin_amdgcn_sched_barrier(0); }
    }
};
struct EpiBrA { static constexpr bool BY_REGION = false; const bf16* SGA; float* T;
    __device__ __forceinline__ void quad(int row, int col, f32x4 v) const { const size_t o = (size_t)row * D + col; *(f32x4*)(T + o) = ld_bf4(SGA + o) * v; }
    __device__ __forceinline__ void oct(int row, int col, f32x4 v0, f32x4 v1) const { const size_t o = (size_t)row * D + col; f32x4 g0, g1; ld_bf8(SGA + o, g0, g1); *(f32x4*)(T + o) = g0 * v0; *(f32x4*)(T + o + 4) = g1 * v1; } };
struct EpiBrB { static constexpr bool BY_REGION = false; const bf16* SGB; const float* T; bf16* MG;
    __device__ __forceinline__ void quad(int row, int col, f32x4 v) const { const size_t o = (size_t)row * D + col; st_bf4(MG + o, *(const f32x4*)(T + o) + ld_bf4(SGB + o) * v); }
    __device__ __forceinline__ void oct(int row, int col, f32x4 v0, f32x4 v1) const { const size_t o = (size_t)row * D + col; f32x4 g0, g1; ld_bf8(SGB + o, g0, g1);
        st_bf8(MG + o, *(const f32x4*)(T + o) + g0 * v0, *(const f32x4*)(T + o + 4) + g1 * v1); } };
struct EpiRes { static constexpr bool BY_REGION = false; const float* xp; const float* xs; float* X; const float* modl; int gi;
    __device__ __forceinline__ void quad(int row, int col, f32x4 v) const {
        if (row >= MR) return;
        const float* src = row < MP ? xp + (size_t)row * D : xs + (size_t)(row - MP) * D;
        const f32x4 g = *(const f32x4*)(modl + (size_t)mod_row(row) * 6144 + gi * 1024 + col);
        *(f32x4*)(X + (size_t)row * D + col) = *(const f32x4*)(src + col) + g * v;
    }
    __device__ __forceinline__ void oct(int row, int col, f32x4 v0, f32x4 v1) const { quad(row, col, v0); quad(row, col + 4, v1); } };
struct EpiFF1 { static constexpr bool BY_REGION = false; bf16* HM;
    __device__ __forceinline__ void quad(int row, int col, f32x4 v) const {
        f32x4 r;
#pragma unroll
        for (int j = 0; j < 4; ++j) { const float t = fmaxf(v[j], 0.f); r[j] = t * t; }
        st_bf4(HM + (size_t)row * FF + col, r);
    }
    __device__ __forceinline__ void oct(int row, int col, f32x4 v0, f32x4 v1) const {
        f32x4 r0, r1;
#pragma unroll
        for (int j = 0; j < 4; ++j) { const float t0 = fmaxf(v0[j], 0.f), t1 = fmaxf(v1[j], 0.f); r0[j] = t0 * t0; r1[j] = t1 * t1; }
        st_bf8(HM + (size_t)row * FF + col, r0, r1);
    } };

template <class E>
__device__ __forceinline__ void naive_gemm_phase(Ctx& c, const bf16* A, const bf16* Bt, int M, int N, int K, const E& e) {
    LAS float* As = (LAS float*)c.lds;
    LAS float* Bs = As + 32 * 132;
    const int ntm = M / 128, ntn = N / 128, tx = c.tid & 31, ty = c.tid >> 5;
    const int lr = c.tid >> 2, lk = (c.tid & 3) * 8;
    for (int tile = c.wg; tile < ntm * ntn; tile += c.G) {
        const int tm = tile % ntm, tn = tile / ntm;
        f32x4 acc[8];
#pragma unroll
        for (int i = 0; i < 8; ++i) acc[i] = (f32x4){0.f, 0.f, 0.f, 0.f};
        for (int k0 = 0; k0 < K; k0 += 32) {
            const u32x4 av = *(const u32x4*)(A + (size_t)(tm * 128 + lr) * K + k0 + lk);
            const u32x4 bv = *(const u32x4*)(Bt + (size_t)(tn * 128 + lr) * K + k0 + lk);
            __syncthreads();
#pragma unroll
            for (int j = 0; j < 4; ++j) {
                As[(lk + 2 * j) * 132 + lr] = bf2f(av[j] & 0xffffu); As[(lk + 2 * j + 1) * 132 + lr] = bf2f(av[j] >> 16);
                Bs[(lk + 2 * j) * 132 + lr] = bf2f(bv[j] & 0xffffu); Bs[(lk + 2 * j + 1) * 132 + lr] = bf2f(bv[j] >> 16);
            }
            __syncthreads();
#pragma unroll 8
            for (int k = 0; k < 32; ++k) {
                const f32x4 a0 = *(const LAS f32x4*)(As + k * 132 + ty * 8), a1 = *(const LAS f32x4*)(As + k * 132 + ty * 8 + 4);
                const f32x4 b = *(const LAS f32x4*)(Bs + k * 132 + tx * 4);
                acc[0] += a0[0] * b; acc[1] += a0[1] * b; acc[2] += a0[2] * b; acc[3] += a0[3] * b;
                acc[4] += a1[0] * b; acc[5] += a1[1] * b; acc[6] += a1[2] * b; acc[7] += a1[3] * b;
            }
        }
#pragma unroll
        for (int i = 0; i < 8; ++i) e.quad(tm * 128 + ty * 8 + i, tn * 128 + tx * 4, acc[i]);
    }
    __syncthreads();
}

struct PowOrder {
    int lgN, nwg, G, c;
    __device__ __forceinline__ void init(int lgN_, int G_, int c_) { lgN = lgN_; nwg = 64 << lgN_; G = G_; c = c_; }
    __device__ __forceinline__ bool next(int i, pg8::Unit& u) const {
        const int L = i * G + c; if (L >= nwg) return false;
        const int w = (L & 7) * (nwg >> 3) + (L >> 3), j = w & ((8 << lgN) - 1), gid = w >> (3 + lgN);
        u.pm = __builtin_amdgcn_readfirstlane(gid * 8 + (j & 7)); u.pn = __builtin_amdgcn_readfirstlane(j >> 3); return true;
    }
    __device__ __forceinline__ void a_ready(const pg8::Unit&) const {}
    __device__ __forceinline__ void done(const pg8::Unit&) const {}
};
template <class E>
__device__ __forceinline__ void sample_gemm_phase(Ctx& c, const bf16* A, const bf16* Bt, int N, int K, const E& e) {
    LAS float* red = (LAS float*)c.lds;
    const int lane = c.tid & 63, w = __builtin_amdgcn_readfirstlane(c.tid >> 6), fr = lane & 15, fq = lane >> 4, chh = w & 1, kq = w >> 1;
    const bf16* As = A + (size_t)MP * K;
    const int kspan = K >> 2;
    for (int mu = c.G - 1 - c.wg; mu < (N >> 5); mu += c.G) {
        const int n0 = 32 * mu;
        f32x4 acc[8];
#pragma unroll
        for (int m = 0; m < 8; ++m) acc[m] = (f32x4){0.f, 0.f, 0.f, 0.f};
        const bf16* bp = Bt + (size_t)(n0 + 16 * chh + fr) * K + kq * kspan + 8 * fq;
        const bf16* ap = As + (size_t)fr * K + kq * kspan + 8 * fq;
#pragma unroll 2
        for (int k = 0; k < kspan; k += 32) {
            const bf16x8 bfr = *(const bf16x8*)(bp + k);
#pragma unroll
            for (int m = 0; m < 8; ++m) acc[m] = __builtin_amdgcn_mfma_f32_16x16x32_bf16(*(const bf16x8*)(ap + (size_t)(16 * m) * K + k), bfr, acc[m], 0, 0, 0);
        }
        __syncthreads();
#pragma unroll
        for (int m = 0; m < 8; ++m)
#pragma unroll
            for (int j = 0; j < 4; ++j) red[(kq * 128 + 16 * m + 4 * fq + j) * 32 + 16 * chh + fr] = acc[m][j];
        __syncthreads();
#pragma unroll
        for (int i = 0; i < 2; ++i) { const int q = c.tid + 512 * i, row = q >> 3, cq = (q & 7) * 4;
            const f32x4 v = *(const LAS f32x4*)(red + row * 32 + cq) + *(const LAS f32x4*)(red + (128 + row) * 32 + cq) + *(const LAS f32x4*)(red + (256 + row) * 32 + cq) + *(const LAS f32x4*)(red + (384 + row) * 32 + cq);
            e.quad(MP + row, n0 + cq, v); }
    }
    __syncthreads();
}

template <int SITE, class E>
__device__ __forceinline__ void gemm_phase_sel(Ctx& c, const bf16* A, const bf16* Bt, int M, int N, int K, const E& e) {
    if constexpr ((FAST_GEMM >> SITE) & 1) {
        pg8::Gemm g{A, Bt, MP, N, K}; PowOrder S; S.init(N == 1024 ? 2 : (N == 4096 ? 4 : 5), c.G, c.wg);
        if constexpr (E::BY_REGION) { EpiInUnit qe{e}; pg8::gemm_phase<EpiInUnit, PowOrder, true, true>(c.lds, g, S, qe, c.tid); }
        else { OctEpi<E> qe{e}; pg8::gemm_phase<OctEpi<E>, PowOrder, true, true>(c.lds, g, S, qe, c.tid); }
        { int t_ = threadIdx.x; asm volatile("" : "+v"(t_)); c.tid = t_; }
        sample_gemm_phase(c, A, Bt, N, K, e);
    } else naive_gemm_phase(c, A, Bt, M, N, K, e);
}

#define XB_TMO      128
#define XB_XCNT(j)  (256  + 64 * (j))
#define XB_XSUB(j)  (1280 + 64 * (j))
#define XB_XGEN(j)  (2304 + 64 * (j))
#define XB_TOP      3328
#define XB_TOPGEN   3392
#define XCD_BAR_WORDS 3456
#define XB_SPIN_CAP (1u << 18)
__device__ __forceinline__ unsigned xb_ld(unsigned* p)              { return __hip_atomic_load(p, __ATOMIC_RELAXED, __HIP_MEMORY_SCOPE_AGENT); }
__device__ __forceinline__ unsigned xb_add(unsigned* p, unsigned v) { return __hip_atomic_fetch_add(p, v, __ATOMIC_RELAXED, __HIP_MEMORY_SCOPE_AGENT); }
__device__ __forceinline__ unsigned xb_xcc_id() { return (unsigned)__builtin_amdgcn_s_getreg((3 << 11) | 20) & 0xFu; }
#define XB_SPIN(cond, bar) do { unsigned _sp = 0; while (cond) { __builtin_amdgcn_s_sleep(1); \
    if ((++_sp & 255u) == 0u) { if (xb_ld(&(bar)[XB_TMO])) break; if (_sp > XB_SPIN_CAP) { atomicAdd(&(bar)[XB_TMO], 1u); break; } } } } while (0)
struct XcdBarrier { unsigned* bar; unsigned x; volatile LAS unsigned* st; };
__device__ __forceinline__ XcdBarrier xcd_barrier_post(unsigned* bar, volatile LAS unsigned* st) {
    XcdBarrier b; b.bar = bar; b.x = xb_xcc_id(); b.st = st;
    if (threadIdx.x == 0) (void)xb_add(&bar[XB_XCNT(b.x)], 1u);
    return b;
}
__device__ __forceinline__ void xcd_barrier_complete(unsigned* bar, unsigned x, unsigned& nloc, unsigned& nx) {
    const unsigned G = gridDim.x * gridDim.y * gridDim.z;
    unsigned sum, cnt, mine, sp = 0u;
    for (;;) {
        sum = 0u; cnt = 0u; mine = 0u;
#pragma unroll
        for (unsigned j = 0; j < 16; ++j) { const unsigned c = xb_ld(&bar[XB_XCNT(j)]); sum += c; cnt += (c > 0u) ? 1u : 0u; mine = (j == x) ? c : mine; }
        if (sum == G) break;
        __builtin_amdgcn_s_sleep(1);
        if ((++sp & 255u) == 0u) { if (xb_ld(&bar[XB_TMO])) break; if (sp > XB_SPIN_CAP) { atomicAdd(&bar[XB_TMO], 1u); break; } }
    }
    nloc = mine > 0u ? mine : 1u; nx = cnt > 0u ? cnt : 1u;
}
__device__ __forceinline__ void xcd_barrier(const XcdBarrier& b) {
    asm volatile("s_waitcnt vmcnt(0)" ::: "memory");
    __syncthreads();
    if (threadIdx.x == 0) {
        unsigned* bar = b.bar; asm volatile("" : "+s"(bar));
        __builtin_amdgcn_s_waitcnt(0);
        unsigned nloc = b.st[0], nx = b.st[1];
        if (nloc == 0u) { xcd_barrier_complete(bar, b.x, nloc, nx); b.st[0] = nloc; b.st[1] = nx; }
        const unsigned old = xb_add(&bar[XB_XSUB(b.x)], 1u);
        const unsigned gen = old / nloc;
        if (old + 1u == (gen + 1u) * nloc) {
            __builtin_amdgcn_fence(__ATOMIC_RELEASE, "agent");
            asm volatile("s_waitcnt vmcnt(0)" ::: "memory");
            const unsigned og = xb_add(&bar[XB_TOP], 1u);
            const unsigned tg = og / nx;
            if (og + 1u == (tg + 1u) * nx) xb_add(&bar[XB_TOPGEN], 1u);
            else XB_SPIN(xb_ld(&bar[XB_TOPGEN]) == tg, bar);
            __builtin_amdgcn_fence(__ATOMIC_ACQUIRE, "agent");
            xb_add(&bar[XB_XGEN(b.x)], 1u);
            asm volatile("s_waitcnt vmcnt(0)" ::: "memory");
        } else {
            XB_SPIN(xb_ld(&bar[XB_XGEN(b.x)]) == gen, bar);
            __builtin_amdgcn_fence(__ATOMIC_ACQUIRE, "agent");
            asm volatile("s_waitcnt vmcnt(0)" ::: "memory");
        }
    }
    __syncthreads();
}

__device__ __forceinline__ void p0_transpose_item(const float* W, int K, int N, bf16* WT, LAS float* scr, int item, int lane) {
    const int nblk = N / 32, kb = item / nblk, nb = item % nblk, k0 = 64 * kb, n0 = 32 * nb;
#pragma unroll 8
    for (int i = 0; i < 32; ++i) { const int kk = 2 * i + (lane >> 5); scr[kk * 33 + (lane & 31)] = W[(size_t)(k0 + kk) * N + n0 + (lane & 31)]; }
    asm volatile("s_waitcnt lgkmcnt(0)" ::: "memory");
    const int ch = lane & 7;
#pragma unroll
    for (int j = 0; j < 4; ++j) { const int n = (lane >> 3) + 8 * j; const LAS float* s = scr + (8 * ch) * 33 + n;
        u32x4 o; o.x = pk2(s[0 * 33], s[1 * 33]); o.y = pk2(s[2 * 33], s[3 * 33]); o.z = pk2(s[4 * 33], s[5 * 33]); o.w = pk2(s[6 * 33], s[7 * 33]);
        *(u32x4*)(WT + (size_t)(n0 + n) * K + k0 + 8 * ch) = o; }
    asm volatile("s_waitcnt lgkmcnt(0)" ::: "memory");
}
__device__ __forceinline__ void p0_prologue(CArgs& a, Ctx& c) {
    for (int rep = 0; rep < 1 + (PROBE_P0 & 1); ++rep) {
        LAS float* scr = (LAS float*)(c.lds + __builtin_amdgcn_readfirstlane(c.tid >> 6) * 16384);
        const int gw = c.wg * 8 + __builtin_amdgcn_readfirstlane(c.tid >> 6), NGW = c.G * 8;
        constexpr int I_IN = 16 * 256, I_SQ = 16 * 32, I_1 = 16 * 128, I_2 = 64 * 32, I_L = 8 * 8, PER_L = I_IN + 3 * I_SQ + I_1 + I_2 + 2 * I_L;
        for (int it = gw; it < 2 * PER_L; it += NGW) {
            const int l = it / PER_L; int r = it % PER_L; bf16* wl = (bf16*)(a.ws + WS_W + (size_t)l * WL_STRIDE);
            if (r < I_IN) { p0_transpose_item(a.in[11] + (size_t)l * D * NIN, D, NIN, wl + OFF_WIN / 2, scr, r, (c.tid & 63)); continue; } r -= I_IN;
            if (r < I_SQ) { p0_transpose_item(a.in[21] + (size_t)l * D * D, D, D, wl + OFF_WA / 2, scr, r, (c.tid & 63)); continue; } r -= I_SQ;
            if (r < I_SQ) { p0_transpose_item(a.in[22] + (size_t)l * D * D, D, D, wl + OFF_WB / 2, scr, r, (c.tid & 63)); continue; } r -= I_SQ;
            if (r < I_SQ) { p0_transpose_item(a.in[23] + (size_t)l * D * D, D, D, wl + OFF_WO / 2, scr, r, (c.tid & 63)); continue; } r -= I_SQ;
            if (r < I_1) { p0_transpose_item(a.in[24] + (size_t)l * D * FF, D, FF, wl + OFF_W1 / 2, scr, r, (c.tid & 63)); continue; } r -= I_1;
            if (r < I_2) { p0_transpose_item(a.in[25] + (size_t)l * FF * D, FF, D, wl + OFF_W2 / 2, scr, r, (c.tid & 63)); continue; } r -= I_2;
            if (r < I_L) { const int n = r >> 3; p0_transpose_item(a.in[16] + ((size_t)l * 8 + n) * 16384, 128, 128, wl + OFF_LWA / 2 + n * 16384, scr, r & 7, (c.tid & 63)); continue; } r -= I_L;
            { const int n = r >> 3; p0_transpose_item(a.in[18] + ((size_t)l * 8 + n) * 16384, 128, 128, wl + OFF_LWX / 2 + n * 16384, scr, r & 7, (c.tid & 63)); }
        }
    }
    {
        float* lbt = (float*)(a.ws + WS_TAB); float* sp = (float*)(a.ws + WS_TAB + 32768);
        const int gid = c.wg * 512 + c.tid;
        if (gid < 2 * D) {
            const int l = gid >> 10, col = gid & 1023;
            const float h0 = a.in[12][col], h1 = a.in[12][D + col];
            const float p1 = 1.0f / (1.0f + expf(h0 - h1));
            const float lb = l == 0 ? 0.f : p1;
            lbt[(l * 3 + 0) * D + col] = lb; lbt[(l * 3 + 1) * D + col] = logf(fmaxf(lb, 1e-30f)); lbt[(l * 3 + 2) * D + col] = log1pf(-lb);
            sp[l * D + col] = softplusf_(-a.in[20][l * D + col]);
        }
    }
    __syncthreads();
    {
        LAS float* cs = (LAS float*)c.lds;
        LAS float* ws = cs + 160 * 132;
        float* MOD = (float*)(a.ws + WS_MOD);
        const int cq = c.tid & 15, rq = c.tid >> 4;
        for (int rep = 0; rep < 1 + ((PROBE_P0 >> 1) & 1); ++rep)
        for (int item = c.wg; item < 2 * 96; item += c.G) {
            const int l = item / 96, cg = item % 96;
            const float* W = a.in[7] + (size_t)l * D * 6144 + cg * 64;
            f32x4 acc[5];
#pragma unroll
            for (int i = 0; i < 5; ++i) acc[i] = (f32x4){0.f, 0.f, 0.f, 0.f};
            f32x4 cv[10], wv[4];
#define MOD_LOAD(k0_) do { _Pragma("unroll") for (int i = 0; i < 10; ++i) { const int e4 = c.tid + 512 * i, r = e4 >> 5, kq = (e4 & 31) * 4; const int rr = r < NMOD ? r : 0; \
                const float* src = rr < NBATCH ? a.in[5] + (size_t)rr * D : a.in[6] + (size_t)(rr - NBATCH) * D; cv[i] = *(const f32x4*)(src + (k0_) + kq); } \
              _Pragma("unroll") for (int i = 0; i < 4; ++i) { const int e4 = c.tid + 512 * i, kk = e4 >> 4, c4 = (e4 & 15) * 4; wv[i] = *(const f32x4*)(W + (size_t)((k0_) + kk) * 6144 + c4); } } while (0)
            MOD_LOAD(0);
            for (int k0 = 0; k0 < D; k0 += 128) {
                __syncthreads();
#pragma unroll
                for (int i = 0; i < 10; ++i) { const int e4 = c.tid + 512 * i, r = e4 >> 5, kq = (e4 & 31) * 4;
                    f32x4 sv = (f32x4){siluf_(cv[i][0]), siluf_(cv[i][1]), siluf_(cv[i][2]), siluf_(cv[i][3])};
                    if (r >= NMOD) sv = (f32x4){0.f, 0.f, 0.f, 0.f};
                    *(LAS f32x4*)(cs + r * 132 + kq) = sv; }
#pragma unroll
                for (int i = 0; i < 4; ++i) { const int e4 = c.tid + 512 * i, kk = e4 >> 4, c4 = (e4 & 15) * 4; *(LAS f32x4*)(ws + kk * 68 + c4) = wv[i]; }
                if (k0 + 128 < D) MOD_LOAD(k0 + 128);
                WG_BAR();
#pragma unroll 4
                for (int kk = 0; kk < 128; kk += 4) {
                    const f32x4 w0 = *(const LAS f32x4*)(ws + kk * 68 + 4 * cq), w1 = *(const LAS f32x4*)(ws + (kk + 1) * 68 + 4 * cq), w2 = *(const LAS f32x4*)(ws + (kk + 2) * 68 + 4 * cq), w3 = *(const LAS f32x4*)(ws + (kk + 3) * 68 + 4 * cq);
#pragma unroll
                    for (int i = 0; i < 5; ++i) { const f32x4 x = *(const LAS f32x4*)(cs + (5 * rq + i) * 132 + kk);
                        acc[i] += x[0] * w0 + x[1] * w1 + x[2] * w2 + x[3] * w3; }
                }
            }
#undef MOD_LOAD
            const f32x4 bm = *(const f32x4*)(a.in[8] + (size_t)l * 6144 + cg * 64 + 4 * cq);
#pragma unroll
            for (int i = 0; i < 5; ++i) { const int row = 5 * rq + i; if (row < NMOD) *(f32x4*)(MOD + ((size_t)l * NMOD + row) * 6144 + cg * 64 + 4 * cq) = acc[i] + bm; }
        }
    }
    __syncthreads();
}

__device__ __forceinline__ void norm_phase(CArgs& a, Ctx& c, int l, int which, const float* xp, const float* xs) {
    const int gw = c.wg * 8 + __builtin_amdgcn_readfirstlane(c.tid >> 6), NGW = c.G * 8;
    bf16* H = (bf16*)(a.ws + WS_H);
    const float* MODL = (const float*)(a.ws + WS_MOD) + (size_t)l * NMOD * 6144;
    const float* g = a.in[which ? 10 : 9] + (size_t)l * D;
    for (int row = gw; row < MR; row += NGW) {
        const float* xr = row < MP ? xp + (size_t)row * D : xs + (size_t)(row - MP) * D;
        const float* md = MODL + (size_t)mod_row(row) * 6144 + (which ? 3 : 0) * 1024;
        f32x4 v[4]; float ss = 0.f;
#pragma unroll
        for (int j = 0; j < 4; ++j) { v[j] = *(const f32x4*)(xr + 4 * (c.tid & 63) + 256 * j); ss += (v[j][0] * v[j][0] + v[j][1] * v[j][1]) + (v[j][2] * v[j][2] + v[j][3] * v[j][3]); }
        const float rstd = 1.0f / sqrtf(wave_sum(ss) * (1.0f / D) + EPS);
#pragma unroll
        for (int j = 0; j < 4; ++j) { const int cc = 4 * (c.tid & 63) + 256 * j;
            const f32x4 gg = *(const f32x4*)(g + cc), sh = *(const f32x4*)(md + cc), sc = *(const f32x4*)(md + 1024 + cc);
            st_bf4(H + (size_t)row * D + cc, v[j] * rstd * gg * (1.0f + sc) + sh); }
    }
}
__device__ __forceinline__ void final_norm_phase(CArgs& a, Ctx& c) {
    const int gw = c.wg * 8 + __builtin_amdgcn_readfirstlane(c.tid >> 6), NGW = c.G * 8;
    const float* g = a.in[26];
    for (int row = gw; row < MR; row += NGW) {
        float* xr = a.out + (size_t)row * D;
        f32x4 v[4]; float ss = 0.f;
#pragma unroll
        for (int j = 0; j < 4; ++j) { v[j] = *(const f32x4*)(xr + 4 * (c.tid & 63) + 256 * j); ss += (v[j][0] * v[j][0] + v[j][1] * v[j][1]) + (v[j][2] * v[j][2] + v[j][3] * v[j][3]); }
        const float rstd = 1.0f / sqrtf(wave_sum(ss) * (1.0f / D) + EPS);
#pragma unroll
        for (int j = 0; j < 4; ++j) { const int cc = 4 * (c.tid & 63) + 256 * j; *(f32x4*)(xr + cc) = v[j] * rstd * *(const f32x4*)(g + cc); }
    }
}

__device__ __forceinline__ void hgrn_naive(CArgs& a, Ctx& c, int l, int row0, int ntok, int h, const float* S0, float* Sout) {
    LAS float* fs = (LAS float*)c.lds;
    LAS float* ks = fs + 2048;
    LAS float* qs = ks + 2048;
    LAS float* vs = qs + 2048;
    LAS float* part = vs + 2048;
    const bf16* Q = (const bf16*)(a.ws + WS_Q); const bf16* Kb = (const bf16*)(a.ws + WS_K); const bf16* V = (const bf16*)(a.ws + WS_V); const bf16* OG = (const bf16*)(a.ws + WS_OG); bf16* OA = (bf16*)(a.ws + WS_OA);
    const float* LOGF = (const float*)(a.ws + WS_LOGF);
    const float* hg = a.in[13] + (size_t)l * DKV;
    const int v = c.tid & 127, kg = c.tid >> 7;
    float S[32];
#pragma unroll
    for (int i = 0; i < 32; ++i) S[i] = S0 ? S0[(size_t)(32 * kg + i) * DKV + v] : 0.f;
    for (int t0 = 0; t0 < ntok; t0 += 16) {
        const int nt = (ntok - t0) < 16 ? (ntok - t0) : 16;
        __syncthreads();
        { const int tt = c.tid >> 5, k4 = (c.tid & 31) * 4;
          if (tt < nt) { const size_t off = (size_t)(row0 + t0 + tt) * D + h * DKV + k4;
              const f32x4 lf = *(const f32x4*)(LOGF + off);
              *(LAS f32x4*)(fs + tt * 128 + k4) = (f32x4){expf(lf[0]), expf(lf[1]), expf(lf[2]), expf(lf[3])};
              *(LAS f32x4*)(ks + tt * 128 + k4) = ld_bf4(Kb + off);
              *(LAS f32x4*)(qs + tt * 128 + k4) = ld_bf4(Q + off);
              *(LAS f32x4*)(vs + tt * 128 + k4) = ld_bf4(V + off); } }
        __syncthreads();
        for (int tt = 0; tt < nt; ++tt) {
            const float vv = vs[tt * 128 + v]; float acc = 0.f;
#pragma unroll
            for (int i4 = 0; i4 < 8; ++i4) {
                const f32x4 f = *(const LAS f32x4*)(fs + tt * 128 + 32 * kg + 4 * i4), kk = *(const LAS f32x4*)(ks + tt * 128 + 32 * kg + 4 * i4), qq = *(const LAS f32x4*)(qs + tt * 128 + 32 * kg + 4 * i4);
#pragma unroll
                for (int j = 0; j < 4; ++j) { S[4 * i4 + j] = f[j] * S[4 * i4 + j] + kk[j] * vv; acc += S[4 * i4 + j] * qq[j]; }
            }
            part[(tt * 4 + kg) * 128 + v] = acc;
        }
        __syncthreads();
        { const int tt = c.tid >> 5, v4 = (c.tid & 31) * 4; const int tc = tt < nt ? tt : 0;
          const f32x4 o = *(const LAS f32x4*)(part + (tc * 4 + 0) * 128 + v4) + *(const LAS f32x4*)(part + (tc * 4 + 1) * 128 + v4)
                        + *(const LAS f32x4*)(part + (tc * 4 + 2) * 128 + v4) + *(const LAS f32x4*)(part + (tc * 4 + 3) * 128 + v4);
          float ss = (o[0] * o[0] + o[1] * o[1]) + (o[2] * o[2] + o[3] * o[3]);
          ss = half_sum(ss);
          const float rstd = 1.0f / sqrtf(ss * (1.0f / DKV) + EPS);
          if (tt < nt) { const size_t off = (size_t)(row0 + t0 + tt) * D + h * DKV + v4;
              st_bf4(OA + off, o * rstd * *(const f32x4*)(hg + v4) * ld_bf4(OG + off)); } }
    }
#pragma unroll
    for (int i = 0; i < 32; ++i) Sout[(size_t)(32 * kg + i) * DKV + v] = S[i];
    __syncthreads();
}


constexpr int HB_Q0 = 0, HB_K0 = 17408, HB_Q1 = 26112, HB_K1 = 34816, HB_KT0 = 43520, HB_KT1 = 53760, HB_VT = 64000, HB_AS = 82432, HB_ST = 91648, HB_VEC = 126464, HB_TOT = 128512, HB_SSQ = 130560;
constexpr int HS_Q = 272, HS_KT = 80, HS_VT = 144, HS_AS = 144;
static_assert(HB_SSQ + 2048 <= MISC_OFF, "hgrn lds");
__device__ __forceinline__ float exp_c(float x) { return __expf(fminf(x, 80.f)); }
__device__ __forceinline__ void hgrn_fast_prompt(CArgs& a, Ctx& c, int l, int b, int h) {
    LAS unsigned char* lds = c.lds;
    const int tid = c.tid, lane = tid & 63, w = __builtin_amdgcn_readfirstlane(tid >> 6), fr = lane & 15, fq = lane >> 4;
    const int col = tid & 127, sg = tid >> 7;
    const bf16* Q = (const bf16*)(a.ws + WS_Q); const bf16* Kb = (const bf16*)(a.ws + WS_K); const bf16* V = (const bf16*)(a.ws + WS_V); const bf16* OG = (const bf16*)(a.ws + WS_OG); bf16* OA = (bf16*)(a.ws + WS_OA);
    const float* LOGF = (const float*)(a.ws + WS_LOGF);
    const size_t base = (size_t)b * SEQ * D + (size_t)h * DKV;
    LAS float* VEC = (LAS float*)(lds + HB_VEC); LAS float* TOT = (LAS float*)(lds + HB_TOT); LAS float* SSQ = (LAS float*)(lds + HB_SSQ);
    LAS unsigned char* STw = lds + HB_ST + w * 4352;
    const float gv = a.in[13][(size_t)l * DKV + 16 * w + fr];
    f32x4 S[8];
#pragma unroll
    for (int i = 0; i < 8; ++i) S[i] = (f32x4){0.f, 0.f, 0.f, 0.f};
    __syncthreads();
    for (int e = tid; e < 2 * 16 * 16; e += 512) { const int which = e >> 8, r = (e >> 4) & 15, cc = e & 15;
        *(LAS bf16*)(lds + HB_AS + ((which ? 32 : 0) + r) * HS_AS + ((which ? 48 : 16) + cc) * 2) = 0; }
    float lf[16]; unsigned qr[16], kr[16], vr[16];
    { const size_t o0 = base + (size_t)(16 * sg) * D + col;
#pragma unroll
      for (int i = 0; i < 16; ++i) { lf[i] = LOGF[o0 + (size_t)i * D]; qr[i] = Q[o0 + (size_t)i * D]; kr[i] = Kb[o0 + (size_t)i * D]; vr[i] = V[o0 + (size_t)i * D]; } }
    for (int nn = 0; nn < (SEQ / 64) * (1 + (PROBE_MIX & 1)); ++nn) {
        const int n = nn & (SEQ / 64 - 1);
        if (PROBE_MIX & 1) { if (nn == SEQ / 64) {
#pragma unroll
            for (int i = 0; i < 8; ++i) S[i] = (f32x4){0.f, 0.f, 0.f, 0.f}; } }
        float g[16]; g[0] = lf[0];
#pragma unroll
        for (int i = 1; i < 16; ++i) g[i] = g[i - 1] + lf[i];
        TOT[sg * 128 + col] = g[15];
        WG_BAR();
        {
            const float t0 = TOT[col], t1 = TOT[128 + col], t2 = TOT[256 + col], t3 = TOT[384 + col];
            const float off = (sg > 0 ? t0 : 0.f) + (sg > 1 ? t1 : 0.f) + (sg > 2 ? t2 : 0.f);
            const float r0 = t0, r1 = t0 + t1 + t2, last = r1 + t3;
            unsigned kt[8], vt[8];
#pragma unroll
            for (int i = 0; i < 16; ++i) {
                const float G = g[i] + off, qv = bf2f(qr[i]), kv = bf2f(kr[i]);
                const int t = 16 * sg + i;
                *(LAS bf16*)(lds + HB_Q0 + t * HS_Q + col * 2) = (bf16)f2bf(qv * exp_c(G - r0));
                unsigned kb;
                if (sg < 2) { kb = f2bf(kv * exp_c(r0 - G)); *(LAS bf16*)(lds + HB_K0 + t * HS_Q + col * 2) = (bf16)kb; }
                else { kb = f2bf(kv * exp_c(r1 - G)); *(LAS bf16*)(lds + HB_K1 + (t - 32) * HS_Q + col * 2) = (bf16)kb;
                       *(LAS bf16*)(lds + HB_Q1 + (t - 32) * HS_Q + col * 2) = (bf16)f2bf(qv * exp_c(G - r1)); }
                if (i & 1) { kt[i >> 1] |= kb << 16; vt[i >> 1] |= vr[i] << 16; } else { kt[i >> 1] = kb; vt[i >> 1] = vr[i]; }
            }
            { LAS unsigned char* p = lds + (sg < 2 ? HB_KT0 : HB_KT1) + col * HS_KT + (sg & 1) * 32;
              *(LAS u32x4*)p = (u32x4){kt[0], kt[1], kt[2], kt[3]}; *(LAS u32x4*)(p + 16) = (u32x4){kt[4], kt[5], kt[6], kt[7]}; }
            { LAS unsigned char* p = lds + HB_VT + col * HS_VT + sg * 32;
              *(LAS u32x4*)p = (u32x4){vt[0], vt[1], vt[2], vt[3]}; *(LAS u32x4*)(p + 16) = (u32x4){vt[4], vt[5], vt[6], vt[7]}; }
            VEC[sg * 128 + col] = exp_c(sg == 0 ? r0 : (sg == 1 ? last : (sg == 2 ? last - r0 : last - r1)));
        }
        unsigned ogr[16];
        { const size_t oo = base + (size_t)(64 * n + 4 * fq) * D + 16 * w + fr;
#pragma unroll
          for (int tt = 0; tt < 4; ++tt)
#pragma unroll
              for (int j = 0; j < 4; ++j) ogr[tt * 4 + j] = OG[oo + (size_t)(16 * tt + j) * D]; }
        if ((PROBE_MIX & 1) || n + 1 < SEQ / 64) { const size_t o0 = base + (size_t)(64 * ((n + 1) & (SEQ / 64 - 1)) + 16 * sg) * D + col;
#pragma unroll
            for (int i = 0; i < 16; ++i) { lf[i] = LOGF[o0 + (size_t)i * D]; qr[i] = Q[o0 + (size_t)i * D]; kr[i] = Kb[o0 + (size_t)i * D]; vr[i] = V[o0 + (size_t)i * D]; } }
        WG_BAR();
#pragma unroll
        for (int kt8 = 0; kt8 < 8; ++kt8) { const f32x4 er = *(const LAS f32x4*)(VEC + 16 * kt8 + 4 * fq);
            u32x2 pw; pw.x = pk2(S[kt8][0] * er[0], S[kt8][1] * er[1]); pw.y = pk2(S[kt8][2] * er[2], S[kt8][3] * er[3]);
            *(LAS u32x2*)(STw + fr * HS_Q + (16 * kt8 + 4 * fq) * 2) = pw; }
#pragma unroll
        for (int rep = 0; rep < 2; ++rep) {
            const int id = w + 8 * rep;
            if (id < 10) {
                int tt, st;
                if (id == 0) { tt = 0; st = 0; } else if (id < 7) { tt = (id + 1) >> 1; st = (id + 1) & 1; } else if (id == 7) { tt = 2; st = 2; } else { tt = 3; st = id - 6; }
                const LAS unsigned char* ap = (st < 2) ? lds + HB_Q0 + (16 * tt + fr) * HS_Q : lds + HB_Q1 + (16 * (tt - 2) + fr) * HS_Q;
                const LAS unsigned char* bp = (st < 2) ? lds + HB_K0 + (16 * st + fr) * HS_Q : lds + HB_K1 + (16 * (st - 2) + fr) * HS_Q;
                f32x4 acc = (f32x4){0.f, 0.f, 0.f, 0.f};
#pragma unroll
                for (int ks = 0; ks < 4; ++ks) acc = __builtin_amdgcn_mfma_f32_16x16x32_bf16(*(const LAS bf16x8*)(ap + (32 * ks + 8 * fq) * 2), *(const LAS bf16x8*)(bp + (32 * ks + 8 * fq) * 2), acc, 0, 0, 0);
#pragma unroll
                for (int j = 0; j < 4; ++j) { const float v_ = (tt == st && fr > 4 * fq + j) ? 0.f : acc[j];
                    *(LAS bf16*)(lds + HB_AS + (16 * tt + 4 * fq + j) * HS_AS + (16 * st + fr) * 2) = (bf16)f2bf(v_); }
            }
        }
        f32x4 o[4];
#pragma unroll
        for (int tt = 0; tt < 4; ++tt) o[tt] = (f32x4){0.f, 0.f, 0.f, 0.f};
#pragma unroll
        for (int ks = 0; ks < 4; ++ks) { const bf16x8 bfr = *(const LAS bf16x8*)(STw + fr * HS_Q + (32 * ks + 8 * fq) * 2);
#pragma unroll
            for (int tt = 0; tt < 4; ++tt) o[tt] = __builtin_amdgcn_mfma_f32_16x16x32_bf16(*(const LAS bf16x8*)(lds + HB_Q0 + (16 * tt + fr) * HS_Q + (32 * ks + 8 * fq) * 2), bfr, o[tt], 0, 0, 0); }
        WG_BAR();
#pragma unroll
        for (int tt = 0; tt < 4; ++tt)
#pragma unroll
            for (int ks = 0; ks < 2; ++ks) if (ks == 0 || tt >= 2)
                o[tt] = __builtin_amdgcn_mfma_f32_16x16x32_bf16(*(const LAS bf16x8*)(lds + HB_AS + (16 * tt + fr) * HS_AS + (32 * ks + 8 * fq) * 2), *(const LAS bf16x8*)(lds + HB_VT + (16 * w + fr) * HS_VT + (32 * ks + 8 * fq) * 2), o[tt], 0, 0, 0);
#pragma unroll
        for (int tt = 0; tt < 4; ++tt)
#pragma unroll
            for (int j = 0; j < 4; ++j) { float p = o[tt][j] * o[tt][j];
                p = row16_sum(p);
                if (fr == 0) SSQ[w * 64 + 16 * tt + 4 * fq + j] = p; }
#pragma unroll
        for (int kt8 = 0; kt8 < 8; ++kt8) {
            const f32x4 z = (f32x4){0.f, 0.f, 0.f, 0.f};
            const f32x4 U0 = __builtin_amdgcn_mfma_f32_16x16x32_bf16(*(const LAS bf16x8*)(lds + HB_KT0 + (16 * kt8 + fr) * HS_KT + 8 * fq * 2), *(const LAS bf16x8*)(lds + HB_VT + (16 * w + fr) * HS_VT + 8 * fq * 2), z, 0, 0, 0);
            const f32x4 U1 = __builtin_amdgcn_mfma_f32_16x16x32_bf16(*(const LAS bf16x8*)(lds + HB_KT1 + (16 * kt8 + fr) * HS_KT + 8 * fq * 2), *(const LAS bf16x8*)(lds + HB_VT + (16 * w + fr) * HS_VT + (32 + 8 * fq) * 2), z, 0, 0, 0);
            const f32x4 eL = *(const LAS f32x4*)(VEC + 128 + 16 * kt8 + 4 * fq), eL0 = *(const LAS f32x4*)(VEC + 256 + 16 * kt8 + 4 * fq), eL1 = *(const LAS f32x4*)(VEC + 384 + 16 * kt8 + 4 * fq);
            S[kt8] = eL * S[kt8] + eL0 * U0 + eL1 * U1;
        }
        WG_BAR();
#pragma unroll
        for (int tt = 0; tt < 4; ++tt) {
            f32x4 ss = *(const LAS f32x4*)(SSQ + 16 * tt + 4 * fq);
#pragma unroll
            for (int ww = 1; ww < 8; ++ww) ss += *(const LAS f32x4*)(SSQ + ww * 64 + 16 * tt + 4 * fq);
#pragma unroll
            for (int j = 0; j < 4; ++j) { const int t = 16 * tt + 4 * fq + j;
                const float rstd = __builtin_amdgcn_rsqf(ss[j] * (1.0f / DKV) + EPS);
                OA[base + (size_t)(64 * n + t) * D + 16 * w + fr] = (bf16)f2bf(o[tt][j] * rstd * gv * bf2f(ogr[tt * 4 + j])); } }
    }
    { float* Sout = a.out + O_HGP + (((size_t)l * NBATCH + b) * NH + h) * DKV * DKV;
#pragma unroll
      for (int kt8 = 0; kt8 < 8; ++kt8)
#pragma unroll
          for (int j = 0; j < 4; ++j) Sout[(size_t)(16 * kt8 + 4 * fq + j) * DKV + 16 * w + fr] = S[kt8][j]; }
    __syncthreads();
}

constexpr int L_XBS = 0, L_XC = 67 * 128, L_AS = L_XC + 8192, L_BS = L_AS + 8192, L_SEG = L_BS + 8192, L_CARRY = L_SEG + 1024;
constexpr int LB_XCB = (L_CARRY + 256) * 4, XCB_STRIDE = 272;
static_assert(LB_XCB + 64 * XCB_STRIDE <= MISC_OFF && LB_XCB % 16 == 0, "lru lds");
__device__ __forceinline__ void lru_gates_naive(CArgs& a, Ctx& c, int l, int n) {
    LAS float* XC = (LAS float*)c.lds + L_XC; LAS float* As = (LAS float*)c.lds + L_AS; LAS float* Bs = (LAS float*)c.lds + L_BS;
    const bf16* wl = (const bf16*)(a.ws + WS_W + (size_t)l * WL_STRIDE);
    const int e = c.tid & 127, tg = c.tid >> 7;
    const bf16* wa = wl + OFF_LWA / 2 + (size_t)(n * 128 + e) * 128; const bf16* wx = wl + OFF_LWX / 2 + (size_t)(n * 128 + e) * 128;
    const int ch = n * 128 + e;
    const float ba = a.in[17][(size_t)l * D + ch], bx = a.in[19][(size_t)l * D + ch], sp = ((const float*)(a.ws + WS_TAB + 32768))[l * D + ch];
#pragma unroll 1
    for (int tq = 0; tq < 4; ++tq) {
        float ra[4], ia[4];
#pragma unroll
        for (int i = 0; i < 4; ++i) { ra[i] = 0.f; ia[i] = 0.f; }
        const LAS float* xc = XC + (tg * 16 + tq * 4) * 128;
#pragma unroll 1
        for (int d0 = 0; d0 < 128; d0 += 8) {
            const f32x4 wa0 = ld_bf4(wa + d0), wa1 = ld_bf4(wa + d0 + 4), wx0 = ld_bf4(wx + d0), wx1 = ld_bf4(wx + d0 + 4);
#pragma unroll
            for (int tt = 0; tt < 4; ++tt) {
                const f32x4 x0 = *(const LAS f32x4*)(xc + tt * 128 + d0), x1 = *(const LAS f32x4*)(xc + tt * 128 + d0 + 4);
                ra[tt] += (x0[0] * wa0[0] + x0[1] * wa0[1]) + (x0[2] * wa0[2] + x0[3] * wa0[3]) + (x1[0] * wa1[0] + x1[1] * wa1[1]) + (x1[2] * wa1[2] + x1[3] * wa1[3]);
                ia[tt] += (x0[0] * wx0[0] + x0[1] * wx0[1]) + (x0[2] * wx0[2] + x0[3] * wx0[3]) + (x1[0] * wx1[0] + x1[1] * wx1[1]) + (x1[2] * wx1[2] + x1[3] * wx1[3]);
            }
        }
#pragma unroll
        for (int tt = 0; tt < 4; ++tt) {
            const int t = tg * 16 + tq * 4 + tt;
            const float r = sigmoidf_(ra[tt] + ba), ig = sigmoidf_(ia[tt] + bx);
            const float la = -8.0f * r * sp, aa = expf(la), mult = sqrtf(-expm1f(2.0f * la));
            As[t * 128 + e] = aa; Bs[t * 128 + e] = mult * ig * XC[t * 128 + e];
        }
    }
}
__device__ __forceinline__ void lru_gates_mfma(CArgs& a, Ctx& c, int l, int n) {
    LAS float* XC = (LAS float*)c.lds + L_XC; LAS float* As = (LAS float*)c.lds + L_AS; LAS float* Bs = (LAS float*)c.lds + L_BS;
    const bf16* wl = (const bf16*)(a.ws + WS_W + (size_t)l * WL_STRIDE);
    const int lane = c.tid & 63, w = __builtin_amdgcn_readfirstlane(c.tid >> 6), fr = lane & 15, fq = lane >> 4;
    const int e = 16 * w + fr, ch = n * 128 + e;
    const bf16* wa = wl + OFF_LWA / 2 + (size_t)(n * 128 + e) * 128 + 8 * fq; const bf16* wx = wl + OFF_LWX / 2 + (size_t)(n * 128 + e) * 128 + 8 * fq;
    bf16x8 Ba[4], Bx[4];
#pragma unroll
    for (int ks = 0; ks < 4; ++ks) { Ba[ks] = *(const bf16x8*)(wa + 32 * ks); Bx[ks] = *(const bf16x8*)(wx + 32 * ks); }
    const float ba = a.in[17][(size_t)l * D + ch], bx = a.in[19][(size_t)l * D + ch], sp = ((const float*)(a.ws + WS_TAB + 32768))[l * D + ch];
#pragma unroll
    for (int m = 0; m < 4; ++m) {
        f32x4 ar = (f32x4){0.f, 0.f, 0.f, 0.f}, ai = (f32x4){0.f, 0.f, 0.f, 0.f};
#pragma unroll
        for (int ks = 0; ks < 4; ++ks) {
            const bf16x8 af = *(const LAS bf16x8*)(c.lds + LB_XCB + (16 * m + fr) * XCB_STRIDE + (32 * ks + 8 * fq) * 2);
            ar = __builtin_amdgcn_mfma_f32_16x16x32_bf16(af, Ba[ks], ar, 0, 0, 0);
            ai = __builtin_amdgcn_mfma_f32_16x16x32_bf16(af, Bx[ks], ai, 0, 0, 0);
        }
#pragma unroll
        for (int j = 0; j < 4; ++j) {
            const int t = 16 * m + 4 * fq + j;
            const float r = sigmoidf_(ar[j] + ba), ig = sigmoidf_(ai[j] + bx);
            const float la = -8.0f * r * sp, aa = expf(la), mult = sqrtf(-expm1f(2.0f * la));
            As[t * 128 + e] = aa; Bs[t * 128 + e] = mult * ig * XC[t * 128 + e];
        }
    }
}
#if FAST_GATES
#define lru_gates lru_gates_mfma
#else
#define lru_gates lru_gates_naive
#endif

constexpr int LB_CW = LB_XCB + 64 * XCB_STRIDE;
static_assert(LB_CW + 2560 <= MISC_OFF, "lru lds");
__device__ __forceinline__ void lru_prompt_item(CArgs& a, Ctx& c, int l, int b, int n) {
    LAS float* L = (LAS float*)c.lds; LAS float* CW = (LAS float*)(c.lds + LB_CW);
    const bf16* XB = (const bf16*)(a.ws + WS_XB); const bf16* YG = (const bf16*)(a.ws + WS_YG); bf16* OB = (bf16*)(a.ws + WS_OB);
    const int t_ld = c.tid >> 3, c0 = (c.tid & 7) * 16;
    const int cch = c.tid & 127, sg = c.tid >> 7;
    const int lane = c.tid & 63, w = __builtin_amdgcn_readfirstlane(c.tid >> 6), fr = lane & 15, fq = lane >> 4;
    const int e = 16 * w + fr, ch = n * 128 + e;
    __syncthreads();
    if (c.tid < 256) L[L_CARRY + c.tid] = 0.f;
    if (c.tid < 384) L[L_XBS + c.tid] = 0.f;
    for (int i = c.tid; i < 640; i += 512) CW[i] = i < 512 ? a.in[14][(size_t)l * 4 * D + (i >> 7) * D + n * 128 + (i & 127)] : a.in[15][(size_t)l * D + n * 128 + (i - 512)];
    bf16x8 Ba[4], Bx[4];
    { const bf16* wl = (const bf16*)(a.ws + WS_W + (size_t)l * WL_STRIDE);
      const bf16* wa = wl + OFF_LWA / 2 + (size_t)(n * 128 + e) * 128 + 8 * fq; const bf16* wx = wl + OFF_LWX / 2 + (size_t)(n * 128 + e) * 128 + 8 * fq;
#pragma unroll
      for (int ks = 0; ks < 4; ++ks) { Ba[ks] = *(const bf16x8*)(wa + 32 * ks); Bx[ks] = *(const bf16x8*)(wx + 32 * ks); } }
    const float ba = a.in[17][(size_t)l * D + ch], bx = a.in[19][(size_t)l * D + ch], sp8 = -8.0f * ((const float*)(a.ws + WS_TAB + 32768))[l * D + ch];
    const bf16* xsrc = XB + (size_t)(b * SEQ + t_ld) * D + n * 128 + c0;
    u32x4 xr0 = *(const u32x4*)xsrc, xr1 = *(const u32x4*)(xsrc + 8);
    for (int t0 = 0; t0 < SEQ; t0 += 64) {
        const int par = (t0 >> 6) & 1;
        unsigned ygr[16];
        { const bf16* yp = YG + (size_t)(b * SEQ + t0 + sg * 16) * D + n * 128 + cch;
#pragma unroll
          for (int tt = 0; tt < 16; ++tt) ygr[tt] = yp[(size_t)tt * D]; }
        WG_BAR();
        { LAS float* dst = L + L_XBS + (3 + t_ld) * 128 + c0;
          *(LAS f32x4*)dst        = (f32x4){bf2f(xr0.x & 0xffffu), bf2f(xr0.x >> 16), bf2f(xr0.y & 0xffffu), bf2f(xr0.y >> 16)};
          *(LAS f32x4*)(dst + 4)  = (f32x4){bf2f(xr0.z & 0xffffu), bf2f(xr0.z >> 16), bf2f(xr0.w & 0xffffu), bf2f(xr0.w >> 16)};
          *(LAS f32x4*)(dst + 8)  = (f32x4){bf2f(xr1.x & 0xffffu), bf2f(xr1.x >> 16), bf2f(xr1.y & 0xffffu), bf2f(xr1.y >> 16)};
          *(LAS f32x4*)(dst + 12) = (f32x4){bf2f(xr1.z & 0xffffu), bf2f(xr1.z >> 16), bf2f(xr1.w & 0xffffu), bf2f(xr1.w >> 16)}; }
        if (t0 + 64 < SEQ) { xr0 = *(const u32x4*)(xsrc + (size_t)(t0 + 64) * D); xr1 = *(const u32x4*)(xsrc + (size_t)(t0 + 64) * D + 8); }
        WG_BAR();
#pragma unroll
        for (int j4 = 0; j4 < 4; ++j4) { const int cc = c0 + 4 * j4;
            f32x4 acc = *(const LAS f32x4*)(CW + 512 + cc);
#pragma unroll
            for (int j = 0; j < 4; ++j) acc += *(const LAS f32x4*)(CW + j * 128 + cc) * *(const LAS f32x4*)(L + L_XBS + (t_ld + j) * 128 + cc);
            *(LAS f32x4*)(L + L_XC + t_ld * 128 + cc) = acc;
            { u32x2 pw; pw.x = pk2(acc[0], acc[1]); pw.y = pk2(acc[2], acc[3]); *(LAS u32x2*)(c.lds + LB_XCB + t_ld * XCB_STRIDE + cc * 2) = pw; } }
        WG_BAR();
#pragma unroll
        for (int m = 0; m < 4; ++m) {
            f32x4 ar = (f32x4){0.f, 0.f, 0.f, 0.f}, ai = (f32x4){0.f, 0.f, 0.f, 0.f};
#pragma unroll
            for (int ks = 0; ks < 4; ++ks) {
                const bf16x8 af = *(const LAS bf16x8*)(c.lds + LB_XCB + (16 * m + fr) * XCB_STRIDE + (32 * ks + 8 * fq) * 2);
                ar = __builtin_amdgcn_mfma_f32_16x16x32_bf16(af, Ba[ks], ar, 0, 0, 0);
                ai = __builtin_amdgcn_mfma_f32_16x16x32_bf16(af, Bx[ks], ai, 0, 0, 0);
            }
#pragma unroll
            for (int j = 0; j < 4; ++j) {
                const int t = 16 * m + 4 * fq + j;
                const float r = sig_fast(ar[j] + ba), ig = sig_fast(ai[j] + bx);
                const float la = sp8 * r, x2 = 2.0f * la;
                const float em = x2 > -0.5f ? x2 * (1.0f + x2 * (0.5f + x2 * (0.16666667f + x2 * (0.041666668f + x2 * 0.0083333338f)))) : __expf(x2) - 1.0f;
                L[L_AS + t * 128 + e] = __expf(la); L[L_BS + t * 128 + e] = __builtin_amdgcn_sqrtf(-em) * ig * L[L_XC + t * 128 + e];
            }
        }
        WG_BAR();
        float P = 1.f, Bv = 0.f;
#pragma unroll
        for (int tt = 0; tt < 16; ++tt) { const float aa = L[L_AS + (sg * 16 + tt) * 128 + cch], bb = L[L_BS + (sg * 16 + tt) * 128 + cch]; Bv = aa * Bv + bb; P *= aa; }
        L[L_SEG + (sg * 128 + cch) * 2] = P; L[L_SEG + (sg * 128 + cch) * 2 + 1] = Bv;
        WG_BAR();
        float h = L[L_CARRY + par * 128 + cch];
        for (int s2 = 0; s2 < sg; ++s2) h = L[L_SEG + (s2 * 128 + cch) * 2] * h + L[L_SEG + (s2 * 128 + cch) * 2 + 1];
        { bf16* op = OB + (size_t)(b * SEQ + t0 + sg * 16) * D + n * 128 + cch;
#pragma unroll
          for (int tt = 0; tt < 16; ++tt) { const int t = sg * 16 + tt;
              h = L[L_AS + t * 128 + cch] * h + L[L_BS + t * 128 + cch];
              op[(size_t)tt * D] = (bf16)f2bf(h * bf2f(ygr[tt])); } }
        if (sg == 3) L[L_CARRY + (par ^ 1) * 128 + cch] = h;
        if (c.tid < 384) L[L_XBS + c.tid] = L[L_XBS + 64 * 128 + c.tid];
    }
    __syncthreads();
    if (c.tid < 128) a.out[O_LRP + ((size_t)l * NBATCH + b) * D + n * 128 + c.tid] = L[L_CARRY + c.tid];
    if (c.tid < 384) a.out[O_CVP + (((size_t)l * NBATCH + b) * 3 + (c.tid >> 7)) * D + n * 128 + (c.tid & 127)] = L[L_XBS + c.tid];
    __syncthreads();
}
__device__ __forceinline__ void lru_sample_item(CArgs& a, Ctx& c, int l, int n, int hf) {
    LAS float* L = (LAS float*)c.lds;
    const bf16* XB = (const bf16*)(a.ws + WS_XB); const bf16* YG = (const bf16*)(a.ws + WS_YG); bf16* OB = (bf16*)(a.ws + WS_OB);
    const int t_ld = c.tid >> 3, c0 = (c.tid & 7) * 16;
    const float* cw = a.in[14] + (size_t)l * 4 * D + n * 128; const float* cb = a.in[15] + (size_t)l * D + n * 128;
    const int bs = hf * 64 + t_ld, row = MP + bs;
    const float* sc = a.in[4] + ((size_t)l * NS + bs) * 3 * D + n * 128;
    float* nc = a.out + O_CVS + ((size_t)l * NS + bs) * 3 * D + n * 128;
    __syncthreads();
#pragma unroll
    for (int j4 = 0; j4 < 4; ++j4) { const int cc = c0 + 4 * j4;
        const f32x4 x = ld_bf4(XB + (size_t)row * D + n * 128 + cc);
        const f32x4 s0 = *(const f32x4*)(sc + cc), s1 = *(const f32x4*)(sc + D + cc), s2 = *(const f32x4*)(sc + 2 * D + cc);
        const f32x4 acc = *(const f32x4*)(cb + cc) + *(const f32x4*)(cw + cc) * s0 + *(const f32x4*)(cw + D + cc) * s1 + *(const f32x4*)(cw + 2 * D + cc) * s2 + *(const f32x4*)(cw + 3 * D + cc) * x;
        *(LAS f32x4*)(L + L_XC + t_ld * 128 + cc) = acc;
        { u32x2 w; w.x = pk2(acc[0], acc[1]); w.y = pk2(acc[2], acc[3]); *(LAS u32x2*)(c.lds + LB_XCB + t_ld * XCB_STRIDE + cc * 2) = w; }
        *(f32x4*)(nc + cc) = s1; *(f32x4*)(nc + D + cc) = s2; *(f32x4*)(nc + 2 * D + cc) = x; }
    __syncthreads();
    lru_gates(a, c, l, n);
    __syncthreads();
    { const int cch = c.tid & 127, tg = c.tid >> 7;
#pragma unroll 4
      for (int tt = 0; tt < 16; ++tt) { const int t = tg * 16 + tt, b2 = hf * 64 + t; const size_t off = (size_t)(MP + b2) * D + n * 128 + cch;
          const float h0 = a.in[3][((size_t)l * NS + b2) * D + n * 128 + cch];
          const float h = L[L_AS + t * 128 + cch] * h0 + L[L_BS + t * 128 + cch];
          a.out[O_LRS + ((size_t)l * NS + b2) * D + n * 128 + cch] = h;
          OB[off] = (bf16)f2bf(h * bf2f(YG[off])); } }
    __syncthreads();
}

__device__ __forceinline__ void mixer_phase(CArgs& a, Ctx& c, int l) {
    if (c.wg < 64) {
        const int b = c.wg >> 3, h = c.wg & 7;
        {
#if FAST_HGRN
        hgrn_fast_prompt(a, c, l, b, h);
#else
        hgrn_naive(a, c, l, b * SEQ, SEQ, h, nullptr, a.out + O_HGP + (((size_t)l * NBATCH + b) * NH + h) * DKV * DKV);
#endif
        }
    } else if (c.wg < 128) {
        const int i = c.wg - 64;
        for (int rep = 0; rep < 1 + ((PROBE_MIX >> 1) & 1); ++rep) lru_prompt_item(a, c, l, i >> 3, i & 7);
        if (i < 16) for (int rep = 0; rep < 1 + ((PROBE_MIX >> 3) & 1); ++rep) lru_sample_item(a, c, l, i >> 1, i & 1);
    } else {
        for (int rep = 0; rep < 1 + ((PROBE_MIX >> 2) & 1); ++rep)
        for (int it = c.wg - 128; it < NS * NH; it += c.G - 128) {
            const int bs = it >> 3, h = it & 7; const size_t so = (((size_t)l * NS + bs) * NH + h) * DKV * DKV;
            hgrn_naive(a, c, l, MP + bs, 1, h, a.in[2] + so, a.out + O_HGS + so);
        }
    }
}

__global__ void __launch_bounds__(512, 2) mega_fwd(Args a0) {
    extern __shared__ __attribute__((aligned(16))) unsigned char lds_raw[];
    Ctx c; c.lds = (LAS unsigned char*)lds_raw; c.tid = threadIdx.x; c.G = gridDim.x; c.wg = blockIdx.x;
    volatile LAS unsigned* MISC = (volatile LAS unsigned*)(c.lds + MISC_OFF);
    if (c.tid < 32) MISC[c.tid] = 0u;
    __syncthreads();
    XcdBarrier bar; bar.bar = (unsigned*)(a0.ws + WS_CTL) + 1024; bar.x = 0; bar.st = nullptr;
    if (a0.ph_hi - a0.ph_lo > 1) bar = xcd_barrier_post((unsigned*)(a0.ws + WS_CTL) + 1024, MISC + 8);

    for (int ph = a0.ph_lo; ph < a0.ph_hi; ++ph) {
        CArgs* ap = (CArgs*)__builtin_amdgcn_kernarg_segment_ptr(); asm volatile("" : "+s"(ap));
        CArgs& a = *ap;
        { int t_ = threadIdx.x, w_ = blockIdx.x, g_ = gridDim.x; asm volatile("" : "+v"(t_), "+s"(w_), "+s"(g_)); c.tid = t_; c.wg = w_; c.G = g_; }
        float* X = a.out;
        if (ph == 0) p0_prologue(a, c);
        else if (ph == NPHASE - 1) final_norm_phase(a, c);
        else {
            const int l = (ph - 1) >> 3, j = (ph - 1) & 7;
            const bf16* wl = (const bf16*)(a.ws + WS_W + (size_t)l * WL_STRIDE);
            const float* xp = l == 0 ? a.in[0] : X; const float* xs = l == 0 ? a.in[1] : X + (size_t)MP * D;
            const float* modl = (const float*)(a.ws + WS_MOD) + (size_t)l * NMOD * 6144;
            bf16* H = (bf16*)(a.ws + WS_H);
            if (j == 0) norm_phase(a, c, l, 0, xp, xs);
            else if (j == 1) {
                EpiIn e{(bf16*)(a.ws + WS_Q), (bf16*)(a.ws + WS_K), (bf16*)(a.ws + WS_V), (bf16*)(a.ws + WS_OG), (bf16*)(a.ws + WS_XB), (bf16*)(a.ws + WS_YG), (bf16*)(a.ws + WS_SGA), (bf16*)(a.ws + WS_SGB),
                        (float*)(a.ws + WS_LOGF), (const float*)(a.ws + WS_TAB) + (size_t)l * 3 * D, l == 0 ? 1 : 0};
                gemm_phase_sel<0>(c, H, wl + OFF_WIN / 2, MT, NIN, D, e);
            } else if (j == 2) mixer_phase(a, c, l);
            else if (j == 3) {
                EpiBrA ea{(const bf16*)(a.ws + WS_SGA), (float*)(a.ws + WS_T)};
                gemm_phase_sel<1>(c, (const bf16*)(a.ws + WS_OA), wl + OFF_WA / 2, MT, D, D, ea);
                asm volatile("s_waitcnt vmcnt(0)" ::: "memory"); __syncthreads();
                { int t_ = threadIdx.x; asm volatile("" : "+v"(t_)); c.tid = t_; }
                EpiBrB eb{(const bf16*)(a.ws + WS_SGB), (const float*)(a.ws + WS_T), (bf16*)(a.ws + WS_MG)};
                gemm_phase_sel<2>(c, (const bf16*)(a.ws + WS_OB), wl + OFF_WB / 2, MT, D, D, eb);
            } else if (j == 4) {
                EpiRes e{xp, xs, X, modl, 2};
                gemm_phase_sel<3>(c, (const bf16*)(a.ws + WS_MG), wl + OFF_WO / 2, MT, D, D, e);
            } else if (j == 5) norm_phase(a, c, l, 1, X, X + (size_t)MP * D);
            else if (j == 6) { EpiFF1 e{(bf16*)(a.ws + WS_HM)}; gemm_phase_sel<4>(c, H, wl + OFF_W1 / 2, MT, FF, D, e); }
            else { EpiRes e{X, X + (size_t)MP * D, X, modl, 5}; gemm_phase_sel<5>(c, (const bf16*)(a.ws + WS_HM), wl + OFF_W2 / 2, MT, D, FF, e); }
        }
        if (ph + 1 < a0.ph_hi) xcd_barrier(bar);
    }
}

extern "C" void kernel_launch(void* const* d_in, const int* in_sizes, int n_in, void* d_out, int out_size, void* d_ws, size_t ws_size, hipStream_t stream) {
    static int grid = 0;
    if (grid == 0) {
        if (n_in != 27 || out_size != (int)O_END || ws_size < WS_END) { fprintf(stderr, "kernel_launch: unexpected shapes (n_in %d out %d ws %zu)\n", n_in, out_size, ws_size); grid = -1; return; }
        int dev = 0, cus = 0, per_cu = 0;
        if (hipGetDevice(&dev) != hipSuccess || hipDeviceGetAttribute(&cus, hipDeviceAttributeMultiprocessorCount, dev) != hipSuccess) { grid = -1; return; }
        if (hipFuncSetAttribute((const void*)mega_fwd, hipFuncAttributeMaxDynamicSharedMemorySize, LDS_BYTES) != hipSuccess) { fprintf(stderr, "kernel_launch: hipFuncSetAttribute failed\n"); grid = -1; return; }
        if (hipOccupancyMaxActiveBlocksPerMultiprocessor(&per_cu, (const void*)mega_fwd, 512, LDS_BYTES) != hipSuccess || per_cu < 1) { fprintf(stderr, "kernel_launch: occupancy query failed (%d)\n", per_cu); (void)hipGetLastError(); per_cu = 1; }
        grid = cus * (per_cu < 1 ? 1 : 1);
        fprintf(stderr, "kernel_launch: cus %d per_cu %d grid %d\n", cus, per_cu, grid);
    }
    if (grid < 0) return;
    (void)hipMemsetAsync((char*)d_ws + WS_CTL, 0, CTL_BYTES, stream);
    Args a{};
    for (int i = 0; i < 27; ++i) a.in[i] = (const float*)d_in[i];
    a.out = (float*)d_out; a.ws = (unsigned char*)d_ws;
#if ONE_LAUNCH
    a.ph_lo = 0; a.ph_hi = NPHASE;
    void* kargs[] = {&a};
    hipError_t e = hipLaunchCooperativeKernel((const void*)mega_fwd, dim3(grid), dim3(512), kargs, LDS_BYTES, stream);
    if (e != hipSuccess) fprintf(stderr, "kernel_launch: cooperative launch failed: %s (grid %d)\n", hipGetErrorString(e), grid);
#else
    for (int ph = 0; ph < NPHASE; ++ph) { a.ph_lo = ph; a.ph_hi = ph + 1;
        for (int rep = 0; rep < 1 + (int)((PROBE_REPEAT >> ph) & 1); ++rep) hipLaunchKernelGGL(mega_fwd, dim3(grid), dim3(512), LDS_BYTES, stream, a); }
#endif
}
```

```cpp
#include <hip/hip_runtime.h>
#include <cstdio>
#include <cstdint>

#ifndef FAST_GEMM
#define FAST_GEMM 63
#endif
#ifndef FAST_HGRN
#define FAST_HGRN 1
#endif
#ifndef FAST_GATES
#define FAST_GATES 1
#endif
#ifndef DBG_SHFL
#define DBG_SHFL 1
#endif
#ifndef PROBE_REPEAT
#define PROBE_REPEAT 0
#endif
#ifndef PROBE_MIX
#define PROBE_MIX 0
#endif
#ifndef PROBE_P0
#define PROBE_P0 0
#endif
#ifndef XOUT_SCRATCH
#define XOUT_SCRATCH 0
#endif
#ifndef ONE_LAUNCH
#define ONE_LAUNCH 1
#endif

#define LAS __attribute__((address_space(3)))
#define GAS __attribute__((address_space(1)))
typedef unsigned short bf16;
typedef float f32x4 __attribute__((ext_vector_type(4)));
typedef float f32x2 __attribute__((ext_vector_type(2)));
typedef short bf16x8 __attribute__((ext_vector_type(8)));
typedef unsigned u32x4 __attribute__((ext_vector_type(4)));
typedef unsigned u32x2 __attribute__((ext_vector_type(2)));

constexpr int D = 1024, NBATCH = 8, SEQ = 2048, MP = NBATCH * SEQ, NS = 128, MR = MP + NS, MT = 16640;
constexpr int NMOD = NBATCH + NS;
constexpr int NIN = 8192, FF = 4096, NH = 8, DKV = 128;
constexpr float EPS = 1e-6f;
constexpr int NPHASE = 18;

constexpr size_t MiB = (size_t)1 << 20;
constexpr size_t WS_CTL = 0, CTL_BYTES = 64 * 1024;
constexpr size_t WS_TAB = 1 * MiB;
constexpr size_t WS_MOD = 2 * MiB;
constexpr size_t WS_W = 9 * MiB, WL_STRIDE = 77 * MiB / 2;
constexpr size_t OFF_WIN = 0, OFF_WA = 16 * MiB, OFF_WB = 18 * MiB, OFF_WO = 20 * MiB, OFF_W1 = 22 * MiB, OFF_W2 = 30 * MiB, OFF_LWA = 38 * MiB, OFF_LWX = 38 * MiB + 256 * 1024;
constexpr size_t WS_H = 86 * MiB;
constexpr size_t WS_Q = 119 * MiB, WS_K = 152 * MiB, WS_V = 185 * MiB, WS_OG = 218 * MiB, WS_XB = 251 * MiB, WS_YG = 284 * MiB, WS_SGA = 317 * MiB, WS_SGB = 350 * MiB;
constexpr size_t WS_LOGF = 383 * MiB;
constexpr size_t WS_T = WS_LOGF;
constexpr size_t WS_MG = WS_K;
constexpr size_t WS_HM = WS_OG;
constexpr size_t WS_OA = 448 * MiB;
constexpr size_t WS_OB = WS_H;
constexpr size_t WS_END = 481 * MiB;
static_assert(WS_W + 2 * WL_STRIDE <= WS_H && WS_H + (size_t)MT * D * 2 <= WS_Q && WS_LOGF + (size_t)MT * D * 4 <= WS_OA && WS_OA + (size_t)MT * D * 2 <= WS_END && WS_HM + (size_t)MT * FF * 2 <= WS_SGB, "ws map");

constexpr size_t O_YP = 0, O_YS = (size_t)MP * D, O_HGP = O_YS + (size_t)NS * D, O_LRP = O_HGP + (size_t)2 * NBATCH * NH * DKV * DKV, O_CVP = O_LRP + (size_t)2 * NBATCH * D,
                 O_HGS = O_CVP + (size_t)2 * NBATCH * 3 * D, O_LRS = O_HGS + (size_t)2 * NS * NH * DKV * DKV, O_CVS = O_LRS + (size_t)2 * NS * D, O_END = O_CVS + (size_t)2 * NS * 3 * D;
static_assert(O_END == 53673984, "out map");

constexpr int LDS_BYTES = 163840;
constexpr int MISC_OFF = 158 * 1024;

typedef __bf16 bf16x2_t __attribute__((ext_vector_type(2)));
__device__ __forceinline__ unsigned f2bf(float f) { return (unsigned)__builtin_bit_cast(unsigned short, (__bf16)f); }
__device__ __forceinline__ unsigned pk2(float lo, float hi) { return __builtin_bit_cast(unsigned, __builtin_convertvector((f32x2){lo, hi}, bf16x2_t)); }
__device__ __forceinline__ float bf2f(unsigned b) { return __builtin_bit_cast(float, b << 16); }
__device__ __forceinline__ f32x4 ld_bf4(const bf16* p) { const u32x2 w = *(const u32x2*)p; return (f32x4){bf2f(w.x & 0xffffu), bf2f(w.x >> 16), bf2f(w.y & 0xffffu), bf2f(w.y >> 16)}; }
__device__ __forceinline__ void st_bf4(bf16* p, f32x4 v) { u32x2 w; w.x = pk2(v[0], v[1]); w.y = pk2(v[2], v[3]); *(u32x2*)p = w; }
#define WG_BAR() do { asm volatile("s_waitcnt lgkmcnt(0)" ::: "memory"); __builtin_amdgcn_s_barrier(); asm volatile("" ::: "memory"); } while (0)
__device__ __forceinline__ float sig_fast(float x) { return __builtin_amdgcn_rcpf(1.0f + __expf(-x)); }
__device__ __forceinline__ void st_bf8(bf16* p, f32x4 v0, f32x4 v1) { u32x4 w; w.x = pk2(v0[0], v0[1]); w.y = pk2(v0[2], v0[3]); w.z = pk2(v1[0], v1[1]); w.w = pk2(v1[2], v1[3]); *(u32x4*)p = w; }
__device__ __forceinline__ void ld_bf8(const bf16* p, f32x4& v0, f32x4& v1) { const u32x4 w = *(const u32x4*)p; v0 = (f32x4){bf2f(w.x & 0xffffu), bf2f(w.x >> 16), bf2f(w.y & 0xffffu), bf2f(w.y >> 16)}; v1 = (f32x4){bf2f(w.z & 0xffffu), bf2f(w.z >> 16), bf2f(w.w & 0xffffu), bf2f(w.w >> 16)}; }
__device__ __forceinline__ float sigmoidf_(float x) { return 1.0f / (1.0f + __expf(-x)); }
__device__ __forceinline__ float siluf_(float x) { return x * sigmoidf_(x); }
__device__ __forceinline__ float gelu_tanh_(float x) { const float u = 0.7978845608028654f * (x + 0.044715f * x * x * x); return x * sigmoidf_(2.0f * u); }
__device__ __forceinline__ float softplusf_(float x) { return fmaxf(x, 0.f) + log1pf(expf(-fabsf(x))); }
template <int XM> __device__ __forceinline__ float swz_xor(float v) { return __builtin_bit_cast(float, __builtin_amdgcn_ds_swizzle(__builtin_bit_cast(int, v), (XM << 10) | 0x1f)); }
__device__ __forceinline__ int lane_id_fresh() { int l = (int)__builtin_amdgcn_mbcnt_hi(~0u, __builtin_amdgcn_mbcnt_lo(~0u, 0u)); asm volatile("" : "+v"(l)); return l; }
__device__ __forceinline__ float xchg(float v, int l, int m) { return __builtin_bit_cast(float, __builtin_amdgcn_ds_bpermute((l ^ m) << 2, __builtin_bit_cast(int, v))); }
__device__ __forceinline__ float row16_sum(float v) { const int l = lane_id_fresh(); v += xchg(v, l, 1); v += xchg(v, l, 2); v += xchg(v, l, 4); v += xchg(v, l, 8); return v; }
__device__ __forceinline__ float half_sum(float v) { const int l = lane_id_fresh(); v += xchg(v, l, 1); v += xchg(v, l, 2); v += xchg(v, l, 4); v += xchg(v, l, 8); v += xchg(v, l, 16); return v; }
__device__ __forceinline__ float wave_sum(float v) { const int l = lane_id_fresh(); v += xchg(v, l, 1); v += xchg(v, l, 2); v += xchg(v, l, 4); v += xchg(v, l, 8); v += xchg(v, l, 16); v += xchg(v, l, 32); return v; }
__device__ __forceinline__ int mod_row(int row) { return row < MP ? (row >> 11) : (NBATCH + row - MP); }

struct Args { const float* in[27]; float* out; unsigned char* ws; int nprog; unsigned char prog[60]; };
typedef const __attribute__((address_space(4))) Args CArgs;
struct Ctx { LAS unsigned char* lds; int tid, G, wg; };
namespace pg8 {
#define PG8_LAS __attribute__((address_space(3)))
typedef unsigned short bf16_t;
typedef short bf16x8 __attribute__((ext_vector_type(8)));
typedef float f32x4 __attribute__((ext_vector_type(4)));
typedef unsigned u32x4 __attribute__((ext_vector_type(4)));
constexpr int BM = 256, BK = 64, HALF = 128, HTB = HALF * BK * 2  , STAGE_BYTES = 8 * HTB, NXCD = 8, WGM = 8;

__host__ __device__ __forceinline__ int lds_byte(int r, int c) { const int st = (r >> 4) * 2 + (c >> 5), rr = r & 15, cc = c & 31, ob = rr * 64 + cc * 2; return st * 1024 + (ob ^ (((ob >> 9) & 1) << 5)); }
__host__ __device__ __forceinline__ void stage_rc(int b, int& R, int& C) { const int st = b / 1024, sb = b % 1024, swz = sb ^ (((sb >> 9) & 1) << 5); R = (st >> 1) * 16 + swz / 64; C = (st & 1) * 32 + (swz % 64) / 2; }
__host__ __device__ __forceinline__ int perm32(int rho) { const int n = rho >> 4, i = rho & 15; return 8 * (i >> 2) + 4 * n + (i & 3); }

struct Unit { int pm, pn; };
struct Gemm { const bf16_t* A; const bf16_t* Bt; int M, N, K; };

struct StaticOrder {
    int nM, nN, nwg, G, c;
    __host__ __device__ void init(int M, int N, int G_, int c_) { nM = M / BM; nN = N / BM; nwg = nM * nN; G = G_; c = c_; }
    __host__ __device__ bool next(int i, Unit& u) const {
        const long L = (long)i * G + c; if (L >= nwg) return false;
        int wgid = (int)L; { const int q = nwg / NXCD, r = nwg % NXCD, xcd = wgid % NXCD, off = wgid / NXCD; wgid = (xcd < r ? xcd * (q + 1) : r * (q + 1) + (xcd - r) * q) + off; }
        const int nig = WGM * nN, gid = wgid / nig, fm = gid * WGM, gsz = (nM - fm) < WGM ? (nM - fm) : WGM;
        u.pm = fm + ((wgid % nig) % gsz); u.pn = (wgid % nig) / gsz; return true;
    }
    __device__ __forceinline__ void a_ready(const Unit&) const {}
    __device__ __forceinline__ void done(const Unit&) const {}
};
template <class Epi, class Sched, bool ALIGN_EPI = false, bool SP2 = false>
__device__ __forceinline__ void gemm_phase(PG8_LAS unsigned char* lds, const Gemm g, const Sched& S, const Epi& E, const int tid_in) {
    const int tid = tid_in, wid = __builtin_amdgcn_readfirstlane(tid >> 6), lane = tid & 63, wr = wid >> 2, wc = wid & 3, fr = lane & 15, fq = lane >> 4;
    const int K = g.K, nt = K / BK;
    unsigned voffA[2], voffB[2];
#pragma unroll
    for (int i = 0; i < 2; ++i) { int R, C; stage_rc(tid * 16 + i * 8192, R, C); const int Rb = Epi::PERM ? ((R & ~31) + perm32(R & 31)) : R;
        voffA[i] = (unsigned)(R * K + C) * 2u; voffB[i] = (unsigned)(Rb * K + C) * 2u; }
    const size_t kstep = (size_t)(BK * 2);
    const size_t hstep = (size_t)HALF * K * 2;
    const size_t tstep = 2 * hstep;
    const unsigned ldsw = (unsigned)wid * 1024u;
    const int aoff = lds_byte(wr * 64 + fr, fq * 8), boff = lds_byte(wc * 32 + fr, fq * 8);
#define PG8_SA(b, h) (((b) * 2 + (h)) * HTB)
#define PG8_SB(b, h) ((4 + (b) * 2 + (h)) * HTB)
#define PG8_STAGE(bufoff, gbase, voff) do { _Pragma("unroll") for (int _i = 0; _i < 2; ++_i) \
        __builtin_amdgcn_global_load_lds((const unsigned*)((const char*)(gbase) + (voff)[_i]), (PG8_LAS unsigned*)(lds + (bufoff) + ldsw + _i * 8192), 16, 0, 0); } while (0)
#define PG8_LDA(dst, b, h) do { _Pragma("unroll") for (int m = 0; m < 4; ++m) _Pragma("unroll") for (int k = 0; k < 2; ++k) dst[m][k] = *(const PG8_LAS bf16x8*)(lds + PG8_SA(b, h) + aoff + m * 2048 + k * 1024); } while (0)
#define PG8_LDB(dst, b, h) do { _Pragma("unroll") for (int n = 0; n < 2; ++n) _Pragma("unroll") for (int k = 0; k < 2; ++k) dst[n][k] = *(const PG8_LAS bf16x8*)(lds + PG8_SB(b, h) + boff + n * 2048 + k * 1024); } while (0)
#define PG8_MMA(ai, bj, At, Bt) do { __builtin_amdgcn_s_setprio(1); _Pragma("unroll") for (int m = 0; m < 4; ++m) _Pragma("unroll") for (int n = 0; n < 2; ++n) _Pragma("unroll") for (int k = 0; k < 2; ++k) \
        acc[ai][bj][m][n] = __builtin_amdgcn_mfma_f32_16x16x32_bf16(Bt[n][k], At[m][k], acc[ai][bj][m][n], 0, 0, 0); __builtin_amdgcn_s_setprio(0); } while (0)
#define PG8_WAIT_V(n) asm volatile("s_waitcnt vmcnt(" #n ")" ::: "memory")
#define PG8_WAIT_L(n) asm volatile("s_waitcnt lgkmcnt(" #n ")" ::: "memory")
#define PG8_BAR __builtin_amdgcn_s_barrier()
#define PG8_SCHED __builtin_amdgcn_sched_barrier(0)
    Unit cur, nxt; int ui = 0;
    if (!S.next(0, cur)) return;
    f32x4 acc[2][2][4][2];
#pragma unroll
    for (int a = 0; a < 2; ++a)
#pragma unroll
        for (int b = 0; b < 2; ++b)
#pragma unroll
            for (int m = 0; m < 4; ++m)
#pragma unroll
                for (int n = 0; n < 2; ++n) acc[a][b][m][n] = (f32x4){0.f, 0.f, 0.f, 0.f};
    bf16x8 At[4][2], B0[2][2], B1[2][2];
    const char* cA = (const char*)g.A + (size_t)cur.pm * tstep; const char* cB = (const char*)g.Bt + (size_t)cur.pn * tstep;
    S.a_ready(cur);
    if constexpr (SP2) {
        PG8_STAGE(PG8_SB(0, 0), cB, voffB); PG8_STAGE(PG8_SB(0, 1), cB + hstep, voffB); PG8_STAGE(PG8_SA(0, 0), cA, voffA); PG8_STAGE(PG8_SA(0, 1), cA + hstep, voffA);
        if (wr == 1) PG8_BAR;
        PG8_WAIT_V(2); PG8_BAR;
        PG8_STAGE(PG8_SB(1, 0), cB + kstep, voffB); PG8_STAGE(PG8_SA(1, 0), cA + kstep, voffA); PG8_STAGE(PG8_SB(1, 1), cB + hstep + kstep, voffB);
        PG8_WAIT_V(6); PG8_BAR;
    } else {
        PG8_STAGE(PG8_SB(0, 0), cB, voffB); PG8_STAGE(PG8_SA(0, 0), cA, voffA); PG8_STAGE(PG8_SB(0, 1), cB + hstep, voffB); PG8_STAGE(PG8_SA(0, 1), cA + hstep, voffA);
        if (wr == 1) PG8_BAR;
        PG8_WAIT_V(4); PG8_BAR;
        PG8_STAGE(PG8_SB(1, 0), cB + kstep, voffB); PG8_STAGE(PG8_SA(1, 0), cA + kstep, voffA); PG8_STAGE(PG8_SB(1, 1), cB + hstep + kstep, voffB);
        PG8_WAIT_V(6); PG8_BAR;
    }
    for (;;) {
        const bool has_next = S.next(ui + 1, nxt);
        const char* nA = has_next ? (const char*)g.A + (size_t)nxt.pm * tstep : cA; const char* nB = has_next ? (const char*)g.Bt + (size_t)nxt.pn * tstep : cB;
        for (int t = 0; t < nt; t += 2) {
            const bool last = (t == nt - 2);
            const char* a1 = cA + (size_t)(t + 1) * kstep;
            const char* a2 = last ? nA : cA + (size_t)(t + 2) * kstep; const char* b2 = last ? nB : cB + (size_t)(t + 2) * kstep;
            const char* a3 = a2 + kstep; const char* b3 = b2 + kstep;
            if (last && has_next) S.a_ready(nxt);
            if constexpr (SP2) {
            PG8_LDB(B0, 0, 0); PG8_LDB(B1, 0, 1); PG8_SCHED; PG8_LDA(At, 0, 0); PG8_STAGE(PG8_SA(1, 1), a1 + hstep, voffA);
            PG8_WAIT_V(8); PG8_WAIT_L(0); PG8_BAR; PG8_MMA(0, 0, At, B0); PG8_MMA(0, 1, At, B1); PG8_BAR; PG8_SCHED;
            PG8_LDA(At, 0, 1); PG8_STAGE(PG8_SB(0, 0), b2, voffB); PG8_STAGE(PG8_SB(0, 1), b2 + hstep, voffB); PG8_STAGE(PG8_SA(0, 0), a2, voffA);
            PG8_WAIT_V(8); PG8_WAIT_L(0); PG8_BAR; PG8_MMA(1, 0, At, B0); PG8_MMA(1, 1, At, B1); PG8_BAR; PG8_SCHED;
            PG8_LDB(B0, 1, 0); PG8_LDB(B1, 1, 1); PG8_SCHED; PG8_LDA(At, 1, 0); PG8_STAGE(PG8_SA(0, 1), a2 + hstep, voffA);
            PG8_WAIT_V(8); PG8_WAIT_L(0); PG8_BAR; PG8_MMA(0, 0, At, B0); PG8_MMA(0, 1, At, B1); PG8_BAR; PG8_SCHED;
            PG8_LDA(At, 1, 1); PG8_STAGE(PG8_SB(1, 0), b3, voffB); PG8_STAGE(PG8_SB(1, 1), b3 + hstep, voffB); PG8_STAGE(PG8_SA(1, 0), a3, voffA);
            PG8_WAIT_V(8); PG8_WAIT_L(0); PG8_BAR; PG8_MMA(1, 0, At, B0); PG8_MMA(1, 1, At, B1); PG8_BAR; PG8_SCHED;
            } else {
            PG8_LDB(B0, 0, 0); PG8_SCHED; PG8_LDA(At, 0, 0); PG8_STAGE(PG8_SA(1, 1), a1 + hstep, voffA);
            PG8_WAIT_L(8); PG8_BAR; PG8_WAIT_L(0); PG8_MMA(0, 0, At, B0); PG8_BAR; PG8_SCHED;
            PG8_LDB(B1, 0, 1); PG8_STAGE(PG8_SB(0, 0), b2, voffB);
            PG8_BAR; PG8_WAIT_L(0); PG8_MMA(0, 1, At, B1); PG8_BAR;
            PG8_LDA(At, 0, 1); PG8_STAGE(PG8_SA(0, 0), a2, voffA);
            PG8_BAR; PG8_WAIT_L(0); PG8_MMA(1, 0, At, B0); PG8_BAR; PG8_SCHED;
            PG8_STAGE(PG8_SB(0, 1), b2 + hstep, voffB);
            PG8_WAIT_V(6); PG8_BAR; PG8_MMA(1, 1, At, B1); PG8_BAR;
            PG8_LDB(B0, 1, 0); PG8_SCHED; PG8_LDA(At, 1, 0); PG8_STAGE(PG8_SA(0, 1), a2 + hstep, voffA);
            PG8_WAIT_L(8); PG8_BAR; PG8_WAIT_L(0); PG8_MMA(0, 0, At, B0); PG8_BAR; PG8_SCHED;
            PG8_LDB(B1, 1, 1); PG8_STAGE(PG8_SB(1, 0), b3, voffB);
            PG8_BAR; PG8_WAIT_L(0); PG8_MMA(0, 1, At, B1); PG8_BAR;
            PG8_LDA(At, 1, 1); PG8_STAGE(PG8_SA(1, 0), a3, voffA);
            PG8_BAR; PG8_WAIT_L(0); PG8_MMA(1, 0, At, B0); PG8_BAR; PG8_SCHED;
            PG8_STAGE(PG8_SB(1, 1), b3 + hstep, voffB);
            PG8_WAIT_V(6); PG8_BAR; PG8_MMA(1, 1, At, B1); PG8_BAR;
            }
        }
        if constexpr (ALIGN_EPI) { if (wr == 0) PG8_BAR; }
        if constexpr (!Epi::AFTER_DRAIN) { int l2 = (int)__builtin_amdgcn_mbcnt_hi(~0u, __builtin_amdgcn_mbcnt_lo(~0u, 0u)); asm volatile("" : "+v"(l2));
            E(acc, cur, wr, wc, l2 & 15, l2 >> 4); S.done(cur); }
        if (!has_next) break;
#pragma unroll
        for (int a = 0; a < 2; ++a)
#pragma unroll
            for (int b = 0; b < 2; ++b)
#pragma unroll
                for (int m = 0; m < 4; ++m)
#pragma unroll
                    for (int n = 0; n < 2; ++n) acc[a][b][m][n] = (f32x4){0.f, 0.f, 0.f, 0.f};
        cur = nxt; cA = nA; cB = nB; ++ui;
        if constexpr (ALIGN_EPI) { if (wr == 1) PG8_BAR; }
    }
    PG8_WAIT_V(0);
    if constexpr (!ALIGN_EPI) { if (wr == 0) PG8_BAR; }
    PG8_BAR;
    if constexpr (Epi::AFTER_DRAIN) { E.fused(acc, cur, wr, wc, fr, fq, lds, wid, lane); S.done(cur); }
#undef PG8_SA
#undef PG8_SB
#undef PG8_STAGE
#undef PG8_LDA
#undef PG8_LDB
#undef PG8_MMA
#undef PG8_WAIT_V
#undef PG8_WAIT_L
#undef PG8_BAR
#undef PG8_SCHED
}
}

template <class E> struct QuadEpi {
    static constexpr bool PERM = false, AFTER_DRAIN = false;
    E e;
    __device__ __forceinline__ void operator()(const f32x4 (&acc)[2][2][4][2], const pg8::Unit& u, int wr, int wc, int fr, int fq) const {
        const int row0 = u.pm * 256 + wr * 64 + fr, col0 = u.pn * 256 + wc * 32 + 4 * fq;
#pragma unroll
        for (int ai = 0; ai < 2; ++ai)
#pragma unroll
            for (int m = 0; m < 4; ++m)
#pragma unroll
                for (int bj = 0; bj < 2; ++bj)
#pragma unroll
                    for (int n = 0; n < 2; ++n) e.quad(row0 + ai * 128 + m * 16, col0 + bj * 128 + n * 16, acc[ai][bj][m][n]);
    }
};

struct EpiIn {
    bf16 *Q, *Kb, *V, *OG, *XB, *YG, *SGA, *SGB; float* LOGF; const float* lbt; int lb0;
    static constexpr bool BY_REGION = true;
    __device__ __forceinline__ f32x2 fgate(float fa, float lb, float llb, float l1m) const {
        float lf, kk;
        const float t = __expf(-fabsf(fa));
        const float ls = fminf(fa, 0.f) - __logf(1.0f + t);
        const float sneg = (fa >= 0.f ? t : 1.0f) * __builtin_amdgcn_rcpf(1.0f + t);
        if (lb0) { lf = ls; kk = sneg; }
        else { const float b = l1m + ls, mx = fmaxf(llb, b); lf = mx + __logf(1.0f + __expf(-fabsf(llb - b))); kk = (1.0f - lb) * sneg; }
        return (f32x2){lf, kk};
    }
    template <int R> __device__ __forceinline__ f32x4 act(f32x4 v) const {
        f32x4 r;
#pragma unroll
        for (int j = 0; j < 4; ++j) {
            if constexpr (R == 0 || R == 3) r[j] = v[j] * sig_fast(v[j]);
            else if constexpr (R == 5) { const float x = v[j], u = 0.7978845608028654f * (x + 0.044715f * x * x * x); r[j] = x * sig_fast(2.0f * u); }
            else if constexpr (R >= 6) r[j] = sig_fast(v[j]);
            else r[j] = v[j];
        }
        return r;
    }
    template <int R> __device__ __forceinline__ bf16* dst() const { return R == 0 ? Q : R == 2 ? V : R == 3 ? OG : R == 4 ? XB : R == 5 ? YG : R == 6 ? SGA : SGB; }
    template <int R> __device__ __forceinline__ void quadR(int row, int cc, f32x4 v) const {
        const size_t o = (size_t)row * D + cc;
        if constexpr (R == 1) {
            const f32x4 lb = *(const f32x4*)(lbt + cc), llb = *(const f32x4*)(lbt + 1024 + cc), l1m = *(const f32x4*)(lbt + 2048 + cc);
            f32x4 lf, r;
#pragma unroll
            for (int j = 0; j < 4; ++j) { const f32x2 g = fgate(v[j], lb[j], llb[j], l1m[j]); lf[j] = g.x; r[j] = g.y; }
            *(f32x4*)(LOGF + o) = lf; st_bf4(Kb + o, r);
        } else st_bf4(dst<R>() + o, act<R>(v));
    }
    template <int R> __device__ __forceinline__ void octR(int row, int cc, f32x4 v0, f32x4 v1) const {
        const size_t o = (size_t)row * D + cc;
        if constexpr (R == 1) {
            f32x4 lf0, lf1, r0, r1;
            if (lb0) {
#pragma unroll
                for (int j = 0; j < 4; ++j) { const f32x2 g0 = fgate(v0[j], 0.f, 0.f, 0.f), g1 = fgate(v1[j], 0.f, 0.f, 0.f); lf0[j] = g0.x; r0[j] = g0.y; lf1[j] = g1.x; r1[j] = g1.y; }
            } else {
                const f32x4 lba = *(const f32x4*)(lbt + cc), lbb = *(const f32x4*)(lbt + cc + 4), lla = *(const f32x4*)(lbt + 1024 + cc), llb_ = *(const f32x4*)(lbt + 1024 + cc + 4), l1a = *(const f32x4*)(lbt + 2048 + cc), l1b = *(const f32x4*)(lbt + 2048 + cc + 4);
#pragma unroll
                for (int j = 0; j < 4; ++j) { const f32x2 g0 = fgate(v0[j], lba[j], lla[j], l1a[j]), g1 = fgate(v1[j], lbb[j], llb_[j], l1b[j]); lf0[j] = g0.x; r0[j] = g0.y; lf1[j] = g1.x; r1[j] = g1.y; }
            }
            *(f32x4*)(LOGF + o) = lf0; *(f32x4*)(LOGF + o + 4) = lf1; st_bf8(Kb + o, r0, r1);
        } else st_bf8(dst<R>() + o, act<R>(v0), act<R>(v1));
    }
    __device__ __forceinline__ void quad(int row, int col, f32x4 v) const {
        const int reg = col >> 10, cc = col & 1023;
        switch (reg) { case 0: quadR<0>(row, cc, v); break; case 1: quadR<1>(row, cc, v); break; case 2: quadR<2>(row, cc, v); break; case 3: quadR<3>(row, cc, v); break;
                       case 4: quadR<4>(row, cc, v); break; case 5: quadR<5>(row, cc, v); break; case 6: quadR<6>(row, cc, v); break; default: quadR<7>(row, cc, v); break; }
    }
};
struct EpiInUnit {
    static constexpr bool PERM = true, AFTER_DRAIN = false;
    EpiIn e;
    template <int KIND> __device__ __forceinline__ void run(const f32x4 (&acc)[2][2][4][2], int row0, int cc0, bf16* dstp, int mode) const {
#pragma unroll
        for (int ai = 0; ai < 2; ++ai)
#pragma unroll
            for (int m = 0; m < 4; ++m) {
#pragma unroll
                for (int bj = 0; bj < 2; ++bj) {
                    const int row = row0 + ai * 128 + m * 16, cc = cc0 + bj * 128;
                    const f32x4 v0 = acc[ai][bj][m][0], v1 = acc[ai][bj][m][1];
                    if constexpr (KIND == 0) e.octR<1>(row, cc, v0, v1);
                    else if constexpr (KIND == 1) st_bf8(dstp + (size_t)row * D + cc, v0, v1);
                    else { f32x4 r0, r1;
#pragma unroll
                        for (int j = 0; j < 4; ++j) {
                            const float x0 = v0[j], x1 = v1[j];
                            const float a0 = mode == 1 ? 1.5957691216057308f * (x0 + 0.044715f * x0 * x0 * x0) : x0, a1 = mode == 1 ? 1.5957691216057308f * (x1 + 0.044715f * x1 * x1 * x1) : x1;
                            const float s0 = sig_fast(a0), s1 = sig_fast(a1);
                            r0[j] = mode == 2 ? s0 : x0 * s0; r1[j] = mode == 2 ? s1 : x1 * s1; }
                        st_bf8(dstp + (size_t)row * D + cc, r0, r1); }
                }
                asm volatile("" ::: "memory"); __builtin_amdgcn_sched_barrier(0); }
    }
    __device__ __forceinline__ void operator()(const f32x4 (&acc)[2][2][4][2], const pg8::Unit& u, int wr, int wc, int fr, int fq) const {
        const int row0 = u.pm * 256 + wr * 64 + fr, cc0 = (u.pn & 3) * 256 + wc * 32 + 8 * fq, reg = u.pn >> 2;
        if (reg == 1) run<0>(acc, row0, cc0, nullptr, 0);
        else if (reg == 2 || reg == 4) run<1>(acc, row0, cc0, reg == 2 ? e.V : e.XB, 0);
        else { bf16* dp = reg == 0 ? e.Q : reg == 3 ? e.OG : reg == 5 ? e.YG : reg == 6 ? e.SGA : e.SGB;
               run<2>(acc, row0, cc0, dp, reg == 5 ? 1 : (reg >= 6 ? 2 : 0)); }
    }
};
template <class E> struct OctEpi {
    static constexpr bool PERM = true, AFTER_DRAIN = false;
    E e;
    __device__ __forceinline__ void operator()(const f32x4 (&acc)[2][2][4][2], const pg8::Unit& u, int wr, int wc, int fr, int fq) const {
        const int row0 = u.pm * 256 + wr * 64 + fr, col0 = u.pn * 256 + wc * 32 + 8 * fq;
#pragma unroll
        for (int ai = 0; ai < 2; ++ai)
#pragma unroll
            for (int m = 0; m < 4; ++m) {
#pragma unroll
                for (int bj = 0; bj < 2; ++bj) e.oct(row0 + ai * 128 + m * 16, col0 + bj * 128, acc[ai][bj][m][0], acc[ai][bj][m][1]);
                asm volatile("" ::: "memory"); __builtin_amdgcn_sched_barrier(0); }
    }
};
struct EpiBrA { static constexpr bool BY_REGION = false; const bf16* SGA; float* T;
    __device__ __forceinline__ void quad(int row, int col, f32x4 v) const { const size_t o = (size_t)row * D + col; *(f32x4*)(T + o) = ld_bf4(SGA + o) * v; }
    __device__ __forceinline__ void oct(int row, int col, f32x4 v0, f32x4 v1) const { const size_t o = (size_t)row * D + col; f32x4 g0, g1; ld_bf8(SGA + o, g0, g1); *(f32x4*)(T + o) = g0 * v0; *(f32x4*)(T + o + 4) = g1 * v1; } };
struct EpiBrB { static constexpr bool BY_REGION = false; const bf16* SGB; const float* T; bf16* MG;
    __device__ __forceinline__ void quad(int row, int col, f32x4 v) const { const size_t o = (size_t)row * D + col; st_bf4(MG + o, *(const f32x4*)(T + o) + ld_bf4(SGB + o) * v); }
    __device__ __forceinline__ void oct(int row, int col, f32x4 v0, f32x4 v1) const { const size_t o = (size_t)row * D + col; f32x4 g0, g1; ld_bf8(SGB + o, g0, g1);
        st_bf8(MG + o, *(const f32x4*)(T + o) + g0 * v0, *(const f32x4*)(T + o + 4) + g1 * v1); } };
struct EpiRes { static constexpr bool BY_REGION = false; const float* xp; const float* xs; float* X; const float* modl; int gi;
    __device__ __forceinline__ void quad(int row, int col, f32x4 v) const {
        if (row >= MR) return;
        const float* src = row < MP ? xp + (size_t)row * D : xs + (size_t)(row - MP) * D;
        const f32x4 g = *(const f32x4*)(modl + (size_t)mod_row(row) * 6144 + gi * 1024 + col);
        *(f32x4*)(X + (size_t)row * D + col) = *(const f32x4*)(src + col) + g * v;
    }
    __device__ __forceinline__ void oct(int row, int col, f32x4 v0, f32x4 v1) const { quad(row, col, v0); quad(row, col + 4, v1); } };
struct EpiFF1 { static constexpr bool BY_REGION = false; bf16* HM;
    __device__ __forceinline__ void quad(int row, int col, f32x4 v) const {
        f32x4 r;
#pragma unroll
        for (int j = 0; j < 4; ++j) { const float t = fmaxf(v[j], 0.f); r[j] = t * t; }
        st_bf4(HM + (size_t)row * FF + col, r);
    }
    __device__ __forceinline__ void oct(int row, int col, f32x4 v0, f32x4 v1) const {
        f32x4 r0, r1;
#pragma unroll
        for (int j = 0; j < 4; ++j) { const float t0 = fmaxf(v0[j], 0.f), t1 = fmaxf(v1[j], 0.f); r0[j] = t0 * t0; r1[j] = t1 * t1; }
        st_bf8(HM + (size_t)row * FF + col, r0, r1);
    } };

template <class E>
__device__ __forceinline__ void naive_gemm_phase(Ctx& c, const bf16* A, const bf16* Bt, int M, int N, int K, const E& e) {
    LAS float* As = (LAS float*)c.lds;
    LAS float* Bs = As + 32 * 132;
    const int ntm = M / 128, ntn = N / 128, tx = c.tid & 31, ty = c.tid >> 5;
    const int lr = c.tid >> 2, lk = (c.tid & 3) * 8;
    for (int tile = c.wg; tile < ntm * ntn; tile += c.G) {
        const int tm = tile % ntm, tn = tile / ntm;
        f32x4 acc[8];
#pragma unroll
        for (int i = 0; i < 8; ++i) acc[i] = (f32x4){0.f, 0.f, 0.f, 0.f};
        for (int k0 = 0; k0 < K; k0 += 32) {
            const u32x4 av = *(const u32x4*)(A + (size_t)(tm * 128 + lr) * K + k0 + lk);
            const u32x4 bv = *(const u32x4*)(Bt + (size_t)(tn * 128 + lr) * K + k0 + lk);
            __syncthreads();
#pragma unroll
            for (int j = 0; j < 4; ++j) {
                As[(lk + 2 * j) * 132 + lr] = bf2f(av[j] & 0xffffu); As[(lk + 2 * j + 1) * 132 + lr] = bf2f(av[j] >> 16);
                Bs[(lk + 2 * j) * 132 + lr] = bf2f(bv[j] & 0xffffu); Bs[(lk + 2 * j + 1) * 132 + lr] = bf2f(bv[j] >> 16);
            }
            __syncthreads();
#pragma unroll 8
            for (int k = 0; k < 32; ++k) {
                const f32x4 a0 = *(const LAS f32x4*)(As + k * 132 + ty * 8), a1 = *(const LAS f32x4*)(As + k * 132 + ty * 8 + 4);
                const f32x4 b = *(const LAS f32x4*)(Bs + k * 132 + tx * 4);
                acc[0] += a0[0] * b; acc[1] += a0[1] * b; acc[2] += a0[2] * b; acc[3] += a0[3] * b;
                acc[4] += a1[0] * b; acc[5] += a1[1] * b; acc[6] += a1[2] * b; acc[7] += a1[3] * b;
            }
        }
#pragma unroll
        for (int i = 0; i < 8; ++i) e.quad(tm * 128 + ty * 8 + i, tn * 128 + tx * 4, acc[i]);
    }
    __syncthreads();
}

struct PowOrder {
    int lgN, nwg, G, c;
    __device__ __forceinline__ void init(int lgN_, int G_, int c_) { lgN = lgN_; nwg = 64 << lgN_; G = G_; c = c_; }
    __device__ __forceinline__ bool next(int i, pg8::Unit& u) const {
        const int L = i * G + c; if (L >= nwg) return false;
        const int w = (L & 7) * (nwg >> 3) + (L >> 3), j = w & ((8 << lgN) - 1), gid = w >> (3 + lgN);
        u.pm = __builtin_amdgcn_readfirstlane(gid * 8 + (j & 7)); u.pn = __builtin_amdgcn_readfirstlane(j >> 3); return true;
    }
    __device__ __forceinline__ void a_ready(const pg8::Unit&) const {}
    __device__ __forceinline__ void done(const pg8::Unit&) const {}
};
template <class E>
__device__ __forceinline__ void sample_gemm_phase(Ctx& c, const bf16* A, const bf16* Bt, int N, int K, const E& e) {
    LAS float* red = (LAS float*)c.lds;
    const int lane = c.tid & 63, w = __builtin_amdgcn_readfirstlane(c.tid >> 6), fr = lane & 15, fq = lane >> 4, chh = w & 1, kq = w >> 1;
    const bf16* As = A + (size_t)MP * K;
    const int kspan = K >> 2;
    for (int mu = c.G - 1 - c.wg; mu < (N >> 5); mu += c.G) {
        const int n0 = 32 * mu;
        f32x4 acc[8];
#pragma unroll
        for (int m = 0; m < 8; ++m) acc[m] = (f32x4){0.f, 0.f, 0.f, 0.f};
        const bf16* bp = Bt + (size_t)(n0 + 16 * chh + fr) * K + kq * kspan + 8 * fq;
        const bf16* ap = As + (size_t)fr * K + kq * kspan + 8 * fq;
#pragma unroll 2
        for (int k = 0; k < kspan; k += 32) {
            const bf16x8 bfr = *(const bf16x8*)(bp + k);
#pragma unroll
            for (int m = 0; m < 8; ++m) acc[m] = __builtin_amdgcn_mfma_f32_16x16x32_bf16(*(const bf16x8*)(ap + (size_t)(16 * m) * K + k), bfr, acc[m], 0, 0, 0);
        }
        __syncthreads();
#pragma unroll
        for (int m = 0; m < 8; ++m)
#pragma unroll
            for (int j = 0; j < 4; ++j) red[(kq * 128 + 16 * m + 4 * fq + j) * 32 + 16 * chh + fr] = acc[m][j];
        __syncthreads();
#pragma unroll
        for (int i = 0; i < 2; ++i) { const int q = c.tid + 512 * i, row = q >> 3, cq = (q & 7) * 4;
            const f32x4 v = *(const LAS f32x4*)(red + row * 32 + cq) + *(const LAS f32x4*)(red + (128 + row) * 32 + cq) + *(const LAS f32x4*)(red + (256 + row) * 32 + cq) + *(const LAS f32x4*)(red + (384 + row) * 32 + cq);
            e.quad(MP + row, n0 + cq, v); }
    }
    __syncthreads();
}

template <int SITE, class E>
__device__ __forceinline__ void gemm_phase_sel(Ctx& c, const bf16* A, const bf16* Bt, int M, int N, int K, const E& e) {
    if constexpr ((FAST_GEMM >> SITE) & 1) {
        pg8::Gemm g{A, Bt, MP, N, K}; PowOrder S; S.init(N == 1024 ? 2 : (N == 4096 ? 4 : 5), c.G, c.wg);
        if constexpr (E::BY_REGION) { EpiInUnit qe{e}; pg8::gemm_phase<EpiInUnit, PowOrder, true, true>(c.lds, g, S, qe, c.tid); }
        else { OctEpi<E> qe{e}; pg8::gemm_phase<OctEpi<E>, PowOrder, true, true>(c.lds, g, S, qe, c.tid); }
        { int t_ = threadIdx.x; asm volatile("" : "+v"(t_)); c.tid = t_; }
        sample_gemm_phase(c, A, Bt, N, K, e);
    } else naive_gemm_phase(c, A, Bt, M, N, K, e);
}

#define XB_TMO      128
#define XB_XCNT(j)  (256  + 64 * (j))
#define XB_XSUB(j)  (1280 + 64 * (j))
#define XB_XGEN(j)  (2304 + 64 * (j))
#define XB_TOP      3328
#define XB_TOPGEN   3392
#define XCD_BAR_WORDS 3456
#define XB_SPIN_CAP (1u << 18)
__device__ __forceinline__ unsigned xb_ld(unsigned* p)              { return __hip_atomic_load(p, __ATOMIC_RELAXED, __HIP_MEMORY_SCOPE_AGENT); }
__device__ __forceinline__ unsigned xb_add(unsigned* p, unsigned v) { return __hip_atomic_fetch_add(p, v, __ATOMIC_RELAXED, __HIP_MEMORY_SCOPE_AGENT); }
__device__ __forceinline__ unsigned xb_xcc_id() { return (unsigned)__builtin_amdgcn_s_getreg((3 << 11) | 20) & 0xFu; }
#define XB_SPIN(cond, bar) do { unsigned _sp = 0; while (cond) { __builtin_amdgcn_s_sleep(1); \
    if ((++_sp & 255u) == 0u) { if (xb_ld(&(bar)[XB_TMO])) break; if (_sp > XB_SPIN_CAP) { atomicAdd(&(bar)[XB_TMO], 1u); break; } } } } while (0)
struct XcdBarrier { unsigned* bar; unsigned x; volatile LAS unsigned* st; };
__device__ __forceinline__ XcdBarrier xcd_barrier_post(unsigned* bar, volatile LAS unsigned* st) {
    XcdBarrier b; b.bar = bar; b.x = xb_xcc_id(); b.st = st;
    if (threadIdx.x == 0) (void)xb_add(&bar[XB_XCNT(b.x)], 1u);
    return b;
}
__device__ __forceinline__ void xcd_barrier_complete(unsigned* bar, unsigned x, unsigned& nloc, unsigned& nx) {
    const unsigned G = gridDim.x * gridDim.y * gridDim.z;
    unsigned sum, cnt, mine, sp = 0u;
    for (;;) {
        sum = 0u; cnt = 0u; mine = 0u;
#pragma unroll
        for (unsigned j = 0; j < 16; ++j) { const unsigned c = xb_ld(&bar[XB_XCNT(j)]); sum += c; cnt += (c > 0u) ? 1u : 0u; mine = (j == x) ? c : mine; }
        if (sum == G) break;
        __builtin_amdgcn_s_sleep(1);
        if ((++sp & 255u) == 0u) { if (xb_ld(&bar[XB_TMO])) break; if (sp > XB_SPIN_CAP) { atomicAdd(&bar[XB_TMO], 1u); break; } }
    }
    nloc = mine > 0u ? mine : 1u; nx = cnt > 0u ? cnt : 1u;
}
__device__ __forceinline__ void xcd_barrier(const XcdBarrier& b) {
    asm volatile("s_waitcnt vmcnt(0)" ::: "memory");
    __syncthreads();
    if (threadIdx.x == 0) {
        unsigned* bar = b.bar; asm volatile("" : "+s"(bar));
        __builtin_amdgcn_s_waitcnt(0);
        unsigned nloc = b.st[0], nx = b.st[1];
        if (nloc == 0u) { xcd_barrier_complete(bar, b.x, nloc, nx); b.st[0] = nloc; b.st[1] = nx; }
        const unsigned old = xb_add(&bar[XB_XSUB(b.x)], 1u);
        const unsigned gen = old / nloc;
        if (old + 1u == (gen + 1u) * nloc) {
            __builtin_amdgcn_fence(__ATOMIC_RELEASE, "agent");
            asm volatile("s_waitcnt vmcnt(0)" ::: "memory");
            const unsigned og = xb_add(&bar[XB_TOP], 1u);
            const unsigned tg = og / nx;
            if (og + 1u == (tg + 1u) * nx) xb_add(&bar[XB_TOPGEN], 1u);
            else XB_SPIN(xb_ld(&bar[XB_TOPGEN]) == tg, bar);
            __builtin_amdgcn_fence(__ATOMIC_ACQUIRE, "agent");
            xb_add(&bar[XB_XGEN(b.x)], 1u);
            asm volatile("s_waitcnt vmcnt(0)" ::: "memory");
        } else {
            XB_SPIN(xb_ld(&bar[XB_XGEN(b.x)]) == gen, bar);
            __builtin_amdgcn_fence(__ATOMIC_ACQUIRE, "agent");
            asm volatile("s_waitcnt vmcnt(0)" ::: "memory");
        }
    }
    __syncthreads();
}

__device__ __forceinline__ void p0_transpose_item(const float* W, int K, int N, bf16* WT, LAS float* scr, int item, int lane) {
    const int nblk = N / 32, kb = item / nblk, nb = item % nblk, k0 = 64 * kb, n0 = 32 * nb;
#pragma unroll 8
    for (int i = 0; i < 32; ++i) { const int kk = 2 * i + (lane >> 5); scr[kk * 33 + (lane & 31)] = W[(size_t)(k0 + kk) * N + n0 + (lane & 31)]; }
    asm volatile("s_waitcnt lgkmcnt(0)" ::: "memory");
    const int ch = lane & 7;
#pragma unroll
    for (int j = 0; j < 4; ++j) { const int n = (lane >> 3) + 8 * j; const LAS float* s = scr + (8 * ch) * 33 + n;
        u32x4 o; o.x = pk2(s[0 * 33], s[1 * 33]); o.y = pk2(s[2 * 33], s[3 * 33]); o.z = pk2(s[4 * 33], s[5 * 33]); o.w = pk2(s[6 * 33], s[7 * 33]);
        *(u32x4*)(WT + (size_t)(n0 + n) * K + k0 + 8 * ch) = o; }
    asm volatile("s_waitcnt lgkmcnt(0)" ::: "memory");
}
__device__ __forceinline__ void p0_work(CArgs& a, Ctx& c, int l, int vw, int nvw, bool with_tables) {
    {
        LAS float* scr = (LAS float*)(c.lds + __builtin_amdgcn_readfirstlane(c.tid >> 6) * 16384);
        const int gw = vw * 8 + __builtin_amdgcn_readfirstlane(c.tid >> 6), NGW = nvw * 8;
        constexpr int I_IN = 16 * 256, I_SQ = 16 * 32, I_1 = 16 * 128, I_2 = 64 * 32, I_L = 8 * 8, PER_L = I_IN + 3 * I_SQ + I_1 + I_2 + 2 * I_L;
        bf16* wl = (bf16*)(a.ws + WS_W + (size_t)l * WL_STRIDE);
        for (int it = gw; it < PER_L; it += NGW) {
            int r = it;
            if (r < I_IN) { p0_transpose_item(a.in[11] + (size_t)l * D * NIN, D, NIN, wl + OFF_WIN / 2, scr, r, (c.tid & 63)); continue; } r -= I_IN;
            if (r < I_SQ) { p0_transpose_item(a.in[21] + (size_t)l * D * D, D, D, wl + OFF_WA / 2, scr, r, (c.tid & 63)); continue; } r -= I_SQ;
            if (r < I_SQ) { p0_transpose_item(a.in[22] + (size_t)l * D * D, D, D, wl + OFF_WB / 2, scr, r, (c.tid & 63)); continue; } r -= I_SQ;
            if (r < I_SQ) { p0_transpose_item(a.in[23] + (size_t)l * D * D, D, D, wl + OFF_WO / 2, scr, r, (c.tid & 63)); continue; } r -= I_SQ;
            if (r < I_1) { p0_transpose_item(a.in[24] + (size_t)l * D * FF, D, FF, wl + OFF_W1 / 2, scr, r, (c.tid & 63)); continue; } r -= I_1;
            if (r < I_2) { p0_transpose_item(a.in[25] + (size_t)l * FF * D, FF, D, wl + OFF_W2 / 2, scr, r, (c.tid & 63)); continue; } r -= I_2;
            if (r < I_L) { const int n = r >> 3; p0_transpose_item(a.in[16] + ((size_t)l * 8 + n) * 16384, 128, 128, wl + OFF_LWA / 2 + n * 16384, scr, r & 7, (c.tid & 63)); continue; } r -= I_L;
            { const int n = r >> 3; p0_transpose_item(a.in[18] + ((size_t)l * 8 + n) * 16384, 128, 128, wl + OFF_LWX / 2 + n * 16384, scr, r & 7, (c.tid & 63)); }
        }
    }
    if (with_tables) {
        float* lbt = (float*)(a.ws + WS_TAB); float* sp = (float*)(a.ws + WS_TAB + 32768);
        const int gid = vw * 512 + c.tid;
        if (gid < 2 * D) {
            const int ll = gid >> 10, col = gid & 1023;
            const float h0 = a.in[12][col], h1 = a.in[12][D + col];
            const float p1 = 1.0f / (1.0f + expf(h0 - h1));
            const float lb = ll == 0 ? 0.f : p1;
            lbt[(ll * 3 + 0) * D + col] = lb; lbt[(ll * 3 + 1) * D + col] = logf(fmaxf(lb, 1e-30f)); lbt[(ll * 3 + 2) * D + col] = log1pf(-lb);
            sp[ll * D + col] = softplusf_(-a.in[20][ll * D + col]);
        }
    }
    __syncthreads();
    {
        LAS float* cs = (LAS float*)c.lds;
        LAS float* ws = cs + 160 * 132;
        LAS float* red = ws + 128 * 36;
        float* MOD = (float*)(a.ws + WS_MOD);
        const int cq = c.tid & 7, rq = (c.tid >> 3) & 31, kh = c.tid >> 8;
        for (int item = vw; item < 192; item += nvw) {
            const float* W = a.in[7] + (size_t)l * D * 6144 + item * 32;
            f32x4 acc[5];
#pragma unroll
            for (int i = 0; i < 5; ++i) acc[i] = (f32x4){0.f, 0.f, 0.f, 0.f};
            f32x4 cv[10], wv[2];
#define MOD_LOAD(k0_) do { _Pragma("unroll") for (int i = 0; i < 10; ++i) { const int e4 = c.tid + 512 * i, r = e4 >> 5, kq = (e4 & 31) * 4; const int rr = r < NMOD ? r : 0; \
                const float* src = rr < NBATCH ? a.in[5] + (size_t)rr * D : a.in[6] + (size_t)(rr - NBATCH) * D; cv[i] = *(const f32x4*)(src + (k0_) + kq); } \
              _Pragma("unroll") for (int i = 0; i < 2; ++i) { const int e4 = c.tid + 512 * i, kk = e4 >> 3, c4 = (e4 & 7) * 4; wv[i] = *(const f32x4*)(W + (size_t)((k0_) + kk) * 6144 + c4); } } while (0)
            MOD_LOAD(0);
            for (int k0 = 0; k0 < D; k0 += 128) {
                __syncthreads();
#pragma unroll
                for (int i = 0; i < 10; ++i) { const int e4 = c.tid + 512 * i, r = e4 >> 5, kq = (e4 & 31) * 4;
                    f32x4 sv = (f32x4){siluf_(cv[i][0]), siluf_(cv[i][1]), siluf_(cv[i][2]), siluf_(cv[i][3])};
                    if (r >= NMOD) sv = (f32x4){0.f, 0.f, 0.f, 0.f};
                    *(LAS f32x4*)(cs + r * 132 + kq) = sv; }
#pragma unroll
                for (int i = 0; i < 2; ++i) { const int e4 = c.tid + 512 * i, kk = e4 >> 3, c4 = (e4 & 7) * 4; *(LAS f32x4*)(ws + kk * 36 + c4) = wv[i]; }
                if (k0 + 128 < D) MOD_LOAD(k0 + 128);
                WG_BAR();
#pragma unroll 4
                for (int kk = 64 * kh; kk < 64 * kh + 64; kk += 4) {
                    const f32x4 w0 = *(const LAS f32x4*)(ws + kk * 36 + 4 * cq), w1 = *(const LAS f32x4*)(ws + (kk + 1) * 36 + 4 * cq), w2 = *(const LAS f32x4*)(ws + (kk + 2) * 36 + 4 * cq), w3 = *(const LAS f32x4*)(ws + (kk + 3) * 36 + 4 * cq);
#pragma unroll
                    for (int i = 0; i < 5; ++i) { const f32x4 x = *(const LAS f32x4*)(cs + (5 * rq + i) * 132 + kk);
                        acc[i] += x[0] * w0 + x[1] * w1 + x[2] * w2 + x[3] * w3; }
                }
            }
#undef MOD_LOAD
            if (kh == 1) {
#pragma unroll
                for (int i = 0; i < 5; ++i) *(LAS f32x4*)(red + (5 * rq + i) * 36 + 4 * cq) = acc[i]; }
            __syncthreads();
            if (kh == 0) {
                const f32x4 bm = *(const f32x4*)(a.in[8] + (size_t)l * 6144 + item * 32 + 4 * cq);
#pragma unroll
                for (int i = 0; i < 5; ++i) { const int row = 5 * rq + i; if (row < NMOD) *(f32x4*)(MOD + ((size_t)l * NMOD + row) * 6144 + item * 32 + 4 * cq) = acc[i] + *(const LAS f32x4*)(red + row * 36 + 4 * cq) + bm; } }
        }
    }
    __syncthreads();
}

__device__ __forceinline__ void norm_phase(CArgs& a, Ctx& c, int l, int which, const float* xp, const float* xs) {
    const int gw = c.wg * 8 + __builtin_amdgcn_readfirstlane(c.tid >> 6), NGW = c.G * 8;
    bf16* H = (bf16*)(a.ws + WS_H);
    const float* MODL = (const float*)(a.ws + WS_MOD) + (size_t)l * NMOD * 6144;
    const float* g = a.in[which ? 10 : 9] + (size_t)l * D;
    for (int row = gw; row < MR; row += NGW) {
        const float* xr = row < MP ? xp + (size_t)row * D : xs + (size_t)(row - MP) * D;
        const float* md = MODL + (size_t)mod_row(row) * 6144 + (which ? 3 : 0) * 1024;
        f32x4 v[4]; float ss = 0.f;
#pragma unroll
        for (int j = 0; j < 4; ++j) { v[j] = *(const f32x4*)(xr + 4 * (c.tid & 63) + 256 * j); ss += (v[j][0] * v[j][0] + v[j][1] * v[j][1]) + (v[j][2] * v[j][2] + v[j][3] * v[j][3]); }
        const float rstd = 1.0f / sqrtf(wave_sum(ss) * (1.0f / D) + EPS);
#pragma unroll
        for (int j = 0; j < 4; ++j) { const int cc = 4 * (c.tid & 63) + 256 * j;
            const f32x4 gg = *(const f32x4*)(g + cc), sh = *(const f32x4*)(md + cc), sc = *(const f32x4*)(md + 1024 + cc);
            st_bf4(H + (size_t)row * D + cc, v[j] * rstd * gg * (1.0f + sc) + sh); }
    }
}
__device__ __forceinline__ void final_norm_phase(CArgs& a, Ctx& c) {
    const int gw = c.wg * 8 + __builtin_amdgcn_readfirstlane(c.tid >> 6), NGW = c.G * 8;
    const float* g = a.in[26];
    for (int row = gw; row < MR; row += NGW) {
        const float* xr = (XOUT_SCRATCH ? (const float*)(a.ws + WS_T) : (const float*)a.out) + (size_t)row * D; float* yr = a.out + (size_t)row * D;
        f32x4 v[4]; float ss = 0.f;
#pragma unroll
        for (int j = 0; j < 4; ++j) { v[j] = *(const f32x4*)(xr + 4 * (c.tid & 63) + 256 * j); ss += (v[j][0] * v[j][0] + v[j][1] * v[j][1]) + (v[j][2] * v[j][2] + v[j][3] * v[j][3]); }
        const float rstd = 1.0f / sqrtf(wave_sum(ss) * (1.0f / D) + EPS);
#pragma unroll
        for (int j = 0; j < 4; ++j) { const int cc = 4 * (c.tid & 63) + 256 * j; *(f32x4*)(yr + cc) = v[j] * rstd * *(const f32x4*)(g + cc); }
    }
}

__device__ __forceinline__ void hgrn_naive(CArgs& a, Ctx& c, int l, int row0, int ntok, int h, const float* S0, float* Sout) {
    LAS float* fs = (LAS float*)c.lds;
    LAS float* ks = fs + 2048;
    LAS float* qs = ks + 2048;
    LAS float* vs = qs + 2048;
    LAS float* part = vs + 2048;
    const bf16* Q = (const bf16*)(a.ws + WS_Q); const bf16* Kb = (const bf16*)(a.ws + WS_K); const bf16* V = (const bf16*)(a.ws + WS_V); const bf16* OG = (const bf16*)(a.ws + WS_OG); bf16* OA = (bf16*)(a.ws + WS_OA);
    const float* LOGF = (const float*)(a.ws + WS_LOGF);
    const float* hg = a.in[13] + (size_t)l * DKV;
    const int v = c.tid & 127, kg = c.tid >> 7;
    float S[32];
#pragma unroll
    for (int i = 0; i < 32; ++i) S[i] = S0 ? S0[(size_t)(32 * kg + i) * DKV + v] : 0.f;
    for (int t0 = 0; t0 < ntok; t0 += 16) {
        const int nt = (ntok - t0) < 16 ? (ntok - t0) : 16;
        __syncthreads();
        { const int tt = c.tid >> 5, k4 = (c.tid & 31) * 4;
          if (tt < nt) { const size_t off = (size_t)(row0 + t0 + tt) * D + h * DKV + k4;
              const f32x4 lf = *(const f32x4*)(LOGF + off);
              *(LAS f32x4*)(fs + tt * 128 + k4) = (f32x4){expf(lf[0]), expf(lf[1]), expf(lf[2]), expf(lf[3])};
              *(LAS f32x4*)(ks + tt * 128 + k4) = ld_bf4(Kb + off);
              *(LAS f32x4*)(qs + tt * 128 + k4) = ld_bf4(Q + off);
              *(LAS f32x4*)(vs + tt * 128 + k4) = ld_bf4(V + off); } }
        __syncthreads();
        for (int tt = 0; tt < nt; ++tt) {
            const float vv = vs[tt * 128 + v]; float acc = 0.f;
#pragma unroll
            for (int i4 = 0; i4 < 8; ++i4) {
                const f32x4 f = *(const LAS f32x4*)(fs + tt * 128 + 32 * kg + 4 * i4), kk = *(const LAS f32x4*)(ks + tt * 128 + 32 * kg + 4 * i4), qq = *(const LAS f32x4*)(qs + tt * 128 + 32 * kg + 4 * i4);
#pragma unroll
                for (int j = 0; j < 4; ++j) { S[4 * i4 + j] = f[j] * S[4 * i4 + j] + kk[j] * vv; acc += S[4 * i4 + j] * qq[j]; }
            }
            part[(tt * 4 + kg) * 128 + v] = acc;
        }
        __syncthreads();
        { const int tt = c.tid >> 5, v4 = (c.tid & 31) * 4; const int tc = tt < nt ? tt : 0;
          const f32x4 o = *(const LAS f32x4*)(part + (tc * 4 + 0) * 128 + v4) + *(const LAS f32x4*)(part + (tc * 4 + 1) * 128 + v4)
                        + *(const LAS f32x4*)(part + (tc * 4 + 2) * 128 + v4) + *(const LAS f32x4*)(part + (tc * 4 + 3) * 128 + v4);
          float ss = (o[0] * o[0] + o[1] * o[1]) + (o[2] * o[2] + o[3] * o[3]);
          ss = half_sum(ss);
          const float rstd = 1.0f / sqrtf(ss * (1.0f / DKV) + EPS);
          if (tt < nt) { const size_t off = (size_t)(row0 + t0 + tt) * D + h * DKV + v4;
              st_bf4(OA + off, o * rstd * *(const f32x4*)(hg + v4) * ld_bf4(OG + off)); } }
    }
#pragma unroll
    for (int i = 0; i < 32; ++i) Sout[(size_t)(32 * kg + i) * DKV + v] = S[i];
    __syncthreads();
}


constexpr int HB_Q0 = 0, HB_K0 = 17408, HB_Q1 = 26112, HB_K1 = 34816, HB_KT0 = 43520, HB_KT1 = 53760, HB_VT = 64000, HB_AS = 82432, HB_ST = 91648, HB_VEC = 126464, HB_TOT = 128512, HB_SSQ = 130560;
constexpr int HS_Q = 272, HS_KT = 80, HS_VT = 144, HS_AS = 144;
static_assert(HB_SSQ + 2048 <= MISC_OFF, "hgrn lds");
__device__ __forceinline__ float exp_c(float x) { return __expf(fminf(x, 80.f)); }
__device__ __forceinline__ void hgrn_fast_prompt(CArgs& a, Ctx& c, int l, int b, int h) {
    LAS unsigned char* lds = c.lds;
    const int tid = c.tid, lane = tid & 63, w = __builtin_amdgcn_readfirstlane(tid >> 6), fr = lane & 15, fq = lane >> 4;
    const int col = tid & 127, sg = tid >> 7;
    const bf16* Q = (const bf16*)(a.ws + WS_Q); const bf16* Kb = (const bf16*)(a.ws + WS_K); const bf16* V = (const bf16*)(a.ws + WS_V); const bf16* OG = (const bf16*)(a.ws + WS_OG); bf16* OA = (bf16*)(a.ws + WS_OA);
    const float* LOGF = (const float*)(a.ws + WS_LOGF);
    const size_t base = (size_t)b * SEQ * D + (size_t)h * DKV;
    LAS float* VEC = (LAS float*)(lds + HB_VEC); LAS float* TOT = (LAS float*)(lds + HB_TOT); LAS float* SSQ = (LAS float*)(lds + HB_SSQ);
    LAS unsigned char* STw = lds + HB_ST + w * 4352;
    const float gv = a.in[13][(size_t)l * DKV + 16 * w + fr];
    f32x4 S[8];
#pragma unroll
    for (int i = 0; i < 8; ++i) S[i] = (f32x4){0.f, 0.f, 0.f, 0.f};
    __syncthreads();
    for (int e = tid; e < 2 * 16 * 16; e += 512) { const int which = e >> 8, r = (e >> 4) & 15, cc = e & 15;
        *(LAS bf16*)(lds + HB_AS + ((which ? 32 : 0) + r) * HS_AS + ((which ? 48 : 16) + cc) * 2) = 0; }
    float lf[16]; unsigned qr[16], kr[16], vr[16];
    { const size_t o0 = base + (size_t)(16 * sg) * D + col;
#pragma unroll
      for (int i = 0; i < 16; ++i) { lf[i] = LOGF[o0 + (size_t)i * D]; qr[i] = Q[o0 + (size_t)i * D]; kr[i] = Kb[o0 + (size_t)i * D]; vr[i] = V[o0 + (size_t)i * D]; } }
    for (int nn = 0; nn < (SEQ / 64) * (1 + (PROBE_MIX & 1)); ++nn) {
        const int n = nn & (SEQ / 64 - 1);
        if (PROBE_MIX & 1) { if (nn == SEQ / 64) {
#pragma unroll
            for (int i = 0; i < 8; ++i) S[i] = (f32x4){0.f, 0.f, 0.f, 0.f}; } }
        float g[16]; g[0] = lf[0];
#pragma unroll
        for (int i = 1; i < 16; ++i) g[i] = g[i - 1] + lf[i];
        TOT[sg * 128 + col] = g[15];
        WG_BAR();
        {
            const float t0 = TOT[col], t1 = TOT[128 + col], t2 = TOT[256 + col], t3 = TOT[384 + col];
            const float off = (sg > 0 ? t0 : 0.f) + (sg > 1 ? t1 : 0.f) + (sg > 2 ? t2 : 0.f);
            const float r0 = t0, r1 = t0 + t1 + t2, last = r1 + t3;
            unsigned kt[8], vt[8];
#pragma unroll
            for (int i = 0; i < 16; ++i) {
                const float G = g[i] + off, qv = bf2f(qr[i]), kv = bf2f(kr[i]);
                const int t = 16 * sg + i;
                *(LAS bf16*)(lds + HB_Q0 + t * HS_Q + col * 2) = (bf16)f2bf(qv * exp_c(G - r0));
                unsigned kb;
                if (sg < 2) { kb = f2bf(kv * exp_c(r0 - G)); *(LAS bf16*)(lds + HB_K0 + t * HS_Q + col * 2) = (bf16)kb; }
                else { kb = f2bf(kv * exp_c(r1 - G)); *(LAS bf16*)(lds + HB_K1 + (t - 32) * HS_Q + col * 2) = (bf16)kb;
                       *(LAS bf16*)(lds + HB_Q1 + (t - 32) * HS_Q + col * 2) = (bf16)f2bf(qv * exp_c(G - r1)); }
                if (i & 1) { kt[i >> 1] |= kb << 16; vt[i >> 1] |= vr[i] << 16; } else { kt[i >> 1] = kb; vt[i >> 1] = vr[i]; }
            }
            { LAS unsigned char* p = lds + (sg < 2 ? HB_KT0 : HB_KT1) + col * HS_KT + (sg & 1) * 32;
              *(LAS u32x4*)p = (u32x4){kt[0], kt[1], kt[2], kt[3]}; *(LAS u32x4*)(p + 16) = (u32x4){kt[4], kt[5], kt[6], kt[7]}; }
            { LAS unsigned char* p = lds + HB_VT + col * HS_VT + sg * 32;
              *(LAS u32x4*)p = (u32x4){vt[0], vt[1], vt[2], vt[3]}; *(LAS u32x4*)(p + 16) = (u32x4){vt[4], vt[5], vt[6], vt[7]}; }
            VEC[sg * 128 + col] = exp_c(sg == 0 ? r0 : (sg == 1 ? last : (sg == 2 ? last - r0 : last - r1)));
        }
        unsigned ogr[16];
        { const size_t oo = base + (size_t)(64 * n + 4 * fq) * D + 16 * w + fr;
#pragma unroll
          for (int tt = 0; tt < 4; ++tt)
#pragma unroll
              for (int j = 0; j < 4; ++j) ogr[tt * 4 + j] = OG[oo + (size_t)(16 * tt + j) * D]; }
        if ((PROBE_MIX & 1) || n + 1 < SEQ / 64) { const size_t o0 = base + (size_t)(64 * ((n + 1) & (SEQ / 64 - 1)) + 16 * sg) * D + col;
#pragma unroll
            for (int i = 0; i < 16; ++i) { lf[i] = LOGF[o0 + (size_t)i * D]; qr[i] = Q[o0 + (size_t)i * D]; kr[i] = Kb[o0 + (size_t)i * D]; vr[i] = V[o0 + (size_t)i * D]; } }
        WG_BAR();
#pragma unroll
        for (int kt8 = 0; kt8 < 8; ++kt8) { const f32x4 er = *(const LAS f32x4*)(VEC + 16 * kt8 + 4 * fq);
            u32x2 pw; pw.x = pk2(S[kt8][0] * er[0], S[kt8][1] * er[1]); pw.y = pk2(S[kt8][2] * er[2], S[kt8][3] * er[3]);
            *(LAS u32x2*)(STw + fr * HS_Q + (16 * kt8 + 4 * fq) * 2) = pw; }
#pragma unroll
        for (int rep = 0; rep < 2; ++rep) {
            const int id = w + 8 * rep;
            if (id < 10) {
                int tt, st;
                if (id == 0) { tt = 0; st = 0; } else if (id < 7) { tt = (id + 1) >> 1; st = (id + 1) & 1; } else if (id == 7) { tt = 2; st = 2; } else { tt = 3; st = id - 6; }
                const LAS unsigned char* ap = (st < 2) ? lds + HB_Q0 + (16 * tt + fr) * HS_Q : lds + HB_Q1 + (16 * (tt - 2) + fr) * HS_Q;
                const LAS unsigned char* bp = (st < 2) ? lds + HB_K0 + (16 * st + fr) * HS_Q : lds + HB_K1 + (16 * (st - 2) + fr) * HS_Q;
                f32x4 acc = (f32x4){0.f, 0.f, 0.f, 0.f};
#pragma unroll
                for (int ks = 0; ks < 4; ++ks) acc = __builtin_amdgcn_mfma_f32_16x16x32_bf16(*(const LAS bf16x8*)(ap + (32 * ks + 8 * fq) * 2), *(const LAS bf16x8*)(bp + (32 * ks + 8 * fq) * 2), acc, 0, 0, 0);
#pragma unroll
                for (int j = 0; j < 4; ++j) { const float v_ = (tt == st && fr > 4 * fq + j) ? 0.f : acc[j];
                    *(LAS bf16*)(lds + HB_AS + (16 * tt + 4 * fq + j) * HS_AS + (16 * st + fr) * 2) = (bf16)f2bf(v_); }
            }
        }
        f32x4 o[4];
#pragma unroll
        for (int tt = 0; tt < 4; ++tt) o[tt] = (f32x4){0.f, 0.f, 0.f, 0.f};
#pragma unroll
        for (int ks = 0; ks < 4; ++ks) { const bf16x8 bfr = *(const LAS bf16x8*)(STw + fr * HS_Q + (32 * ks + 8 * fq) * 2);
#pragma unroll
            for (int tt = 0; tt < 4; ++tt) o[tt] = __builtin_amdgcn_mfma_f32_16x16x32_bf16(*(const LAS bf16x8*)(lds + HB_Q0 + (16 * tt + fr) * HS_Q + (32 * ks + 8 * fq) * 2), bfr, o[tt], 0, 0, 0); }
        WG_BAR();
#pragma unroll
        for (int tt = 0; tt < 4; ++tt)
#pragma unroll
            for (int ks = 0; ks < 2; ++ks) if (ks == 0 || tt >= 2)
                o[tt] = __builtin_amdgcn_mfma_f32_16x16x32_bf16(*(const LAS bf16x8*)(lds + HB_AS + (16 * tt + fr) * HS_AS + (32 * ks + 8 * fq) * 2), *(const LAS bf16x8*)(lds + HB_VT + (16 * w + fr) * HS_VT + (32 * ks + 8 * fq) * 2), o[tt], 0, 0, 0);
#pragma unroll
        for (int tt = 0; tt < 4; ++tt)
#pragma unroll
            for (int j = 0; j < 4; ++j) { float p = o[tt][j] * o[tt][j];
                p = row16_sum(p);
                if (fr == 0) SSQ[w * 64 + 16 * tt + 4 * fq + j] = p; }
#pragma unroll
        for (int kt8 = 0; kt8 < 8; ++kt8) {
            const f32x4 z = (f32x4){0.f, 0.f, 0.f, 0.f};
            const f32x4 U0 = __builtin_amdgcn_mfma_f32_16x16x32_bf16(*(const LAS bf16x8*)(lds + HB_KT0 + (16 * kt8 + fr) * HS_KT + 8 * fq * 2), *(const LAS bf16x8*)(lds + HB_VT + (16 * w + fr) * HS_VT + 8 * fq * 2), z, 0, 0, 0);
            const f32x4 U1 = __builtin_amdgcn_mfma_f32_16x16x32_bf16(*(const LAS bf16x8*)(lds + HB_KT1 + (16 * kt8 + fr) * HS_KT + 8 * fq * 2), *(const LAS bf16x8*)(lds + HB_VT + (16 * w + fr) * HS_VT + (32 + 8 * fq) * 2), z, 0, 0, 0);
            const f32x4 eL = *(const LAS f32x4*)(VEC + 128 + 16 * kt8 + 4 * fq), eL0 = *(const LAS f32x4*)(VEC + 256 + 16 * kt8 + 4 * fq), eL1 = *(const LAS f32x4*)(VEC + 384 + 16 * kt8 + 4 * fq);
            S[kt8] = eL * S[kt8] + eL0 * U0 + eL1 * U1;
        }
        WG_BAR();
#pragma unroll
        for (int tt = 0; tt < 4; ++tt) {
            f32x4 ss = *(const LAS f32x4*)(SSQ + 16 * tt + 4 * fq);
#pragma unroll
            for (int ww = 1; ww < 8; ++ww) ss += *(const LAS f32x4*)(SSQ + ww * 64 + 16 * tt + 4 * fq);
#pragma unroll
            for (int j = 0; j < 4; ++j) { const int t = 16 * tt + 4 * fq + j;
                const float rstd = __builtin_amdgcn_rsqf(ss[j] * (1.0f / DKV) + EPS);
                OA[base + (size_t)(64 * n + t) * D + 16 * w + fr] = (bf16)f2bf(o[tt][j] * rstd * gv * bf2f(ogr[tt * 4 + j])); } }
    }
    { float* Sout = a.out + O_HGP + (((size_t)l * NBATCH + b) * NH + h) * DKV * DKV;
#pragma unroll
      for (int kt8 = 0; kt8 < 8; ++kt8)
#pragma unroll
          for (int j = 0; j < 4; ++j) Sout[(size_t)(16 * kt8 + 4 * fq + j) * DKV + 16 * w + fr] = S[kt8][j]; }
    __syncthreads();
}

constexpr int L_XBS = 0, L_XC = 67 * 128, L_AS = L_XC + 8192, L_BS = L_AS + 8192, L_SEG = L_BS + 8192, L_CARRY = L_SEG + 1024;
constexpr int LB_XCB = (L_CARRY + 256) * 4, XCB_STRIDE = 272;
static_assert(LB_XCB + 64 * XCB_STRIDE <= MISC_OFF && LB_XCB % 16 == 0, "lru lds");
__device__ __forceinline__ void lru_gates_naive(CArgs& a, Ctx& c, int l, int n) {
    LAS float* XC = (LAS float*)c.lds + L_XC; LAS float* As = (LAS float*)c.lds + L_AS; LAS float* Bs = (LAS float*)c.lds + L_BS;
    const bf16* wl = (const bf16*)(a.ws + WS_W + (size_t)l * WL_STRIDE);
    const int e = c.tid & 127, tg = c.tid >> 7;
    const bf16* wa = wl + OFF_LWA / 2 + (size_t)(n * 128 + e) * 128; const bf16* wx = wl + OFF_LWX / 2 + (size_t)(n * 128 + e) * 128;
    const int ch = n * 128 + e;
    const float ba = a.in[17][(size_t)l * D + ch], bx = a.in[19][(size_t)l * D + ch], sp = ((const float*)(a.ws + WS_TAB + 32768))[l * D + ch];
#pragma unroll 1
    for (int tq = 0; tq < 4; ++tq) {
        float ra[4], ia[4];
#pragma unroll
        for (int i = 0; i < 4; ++i) { ra[i] = 0.f; ia[i] = 0.f; }
        const LAS float* xc = XC + (tg * 16 + tq * 4) * 128;
#pragma unroll 1
        for (int d0 = 0; d0 < 128; d0 += 8) {
            const f32x4 wa0 = ld_bf4(wa + d0), wa1 = ld_bf4(wa + d0 + 4), wx0 = ld_bf4(wx + d0), wx1 = ld_bf4(wx + d0 + 4);
#pragma unroll
            for (int tt = 0; tt < 4; ++tt) {
                const f32x4 x0 = *(const LAS f32x4*)(xc + tt * 128 + d0), x1 = *(const LAS f32x4*)(xc + tt * 128 + d0 + 4);
                ra[tt] += (x0[0] * wa0[0] + x0[1] * wa0[1]) + (x0[2] * wa0[2] + x0[3] * wa0[3]) + (x1[0] * wa1[0] + x1[1] * wa1[1]) + (x1[2] * wa1[2] + x1[3] * wa1[3]);
                ia[tt] += (x0[0] * wx0[0] + x0[1] * wx0[1]) + (x0[2] * wx0[2] + x0[3] * wx0[3]) + (x1[0] * wx1[0] + x1[1] * wx1[1]) + (x1[2] * wx1[2] + x1[3] * wx1[3]);
            }
        }
#pragma unroll
        for (int tt = 0; tt < 4; ++tt) {
            const int t = tg * 16 + tq * 4 + tt;
            const float r = sigmoidf_(ra[tt] + ba), ig = sigmoidf_(ia[tt] + bx);
            const float la = -8.0f * r * sp, aa = expf(la), mult = sqrtf(-expm1f(2.0f * la));
            As[t * 128 + e] = aa; Bs[t * 128 + e] = mult * ig * XC[t * 128 + e];
        }
    }
}
__device__ __forceinline__ void lru_gates_mfma(CArgs& a, Ctx& c, int l, int n) {
    LAS float* XC = (LAS float*)c.lds + L_XC; LAS float* As = (LAS float*)c.lds + L_AS; LAS float* Bs = (LAS float*)c.lds + L_BS;
    const bf16* wl = (const bf16*)(a.ws + WS_W + (size_t)l * WL_STRIDE);
    const int lane = c.tid & 63, w = __builtin_amdgcn_readfirstlane(c.tid >> 6), fr = lane & 15, fq = lane >> 4;
    const int e = 16 * w + fr, ch = n * 128 + e;
    const bf16* wa = wl + OFF_LWA / 2 + (size_t)(n * 128 + e) * 128 + 8 * fq; const bf16* wx = wl + OFF_LWX / 2 + (size_t)(n * 128 + e) * 128 + 8 * fq;
    bf16x8 Ba[4], Bx[4];
#pragma unroll
    for (int ks = 0; ks < 4; ++ks) { Ba[ks] = *(const bf16x8*)(wa + 32 * ks); Bx[ks] = *(const bf16x8*)(wx + 32 * ks); }
    const float ba = a.in[17][(size_t)l * D + ch], bx = a.in[19][(size_t)l * D + ch], sp = ((const float*)(a.ws + WS_TAB + 32768))[l * D + ch];
#pragma unroll
    for (int m = 0; m < 4; ++m) {
        f32x4 ar = (f32x4){0.f, 0.f, 0.f, 0.f}, ai = (f32x4){0.f, 0.f, 0.f, 0.f};
#pragma unroll
        for (int ks = 0; ks < 4; ++ks) {
            const bf16x8 af = *(const LAS bf16x8*)(c.lds + LB_XCB + (16 * m + fr) * XCB_STRIDE + (32 * ks + 8 * fq) * 2);
            ar = __builtin_amdgcn_mfma_f32_16x16x32_bf16(af, Ba[ks], ar, 0, 0, 0);
            ai = __builtin_amdgcn_mfma_f32_16x16x32_bf16(af, Bx[ks], ai, 0, 0, 0);
        }
#pragma unroll
        for (int j = 0; j < 4; ++j) {
            const int t = 16 * m + 4 * fq + j;
            const float r = sigmoidf_(ar[j] + ba), ig = sigmoidf_(ai[j] + bx);
            const float la = -8.0f * r * sp, aa = expf(la), mult = sqrtf(-expm1f(2.0f * la));
            As[t * 128 + e] = aa; Bs[t * 128 + e] = mult * ig * XC[t * 128 + e];
        }
    }
}
#if FAST_GATES
#define lru_gates lru_gates_mfma
#else
#define lru_gates lru_gates_naive
#endif

constexpr int LB_CW = LB_XCB + 64 * XCB_STRIDE;
static_assert(LB_CW + 2560 <= MISC_OFF, "lru lds");
__device__ __forceinline__ void lru_prompt_item(CArgs& a, Ctx& c, int l, int b, int n) {
    LAS float* L = (LAS float*)c.lds; LAS float* CW = (LAS float*)(c.lds + LB_CW);
    const bf16* XB = (const bf16*)(a.ws + WS_XB); const bf16* YG = (const bf16*)(a.ws + WS_YG); bf16* OB = (bf16*)(a.ws + WS_OB);
    const int t_ld = c.tid >> 3, c0 = (c.tid & 7) * 16;
    const int cch = c.tid & 127, sg = c.tid >> 7;
    const int lane = c.tid & 63, w = __builtin_amdgcn_readfirstlane(c.tid >> 6), fr = lane & 15, fq = lane >> 4;
    const int e = 16 * w + fr, ch = n * 128 + e;
    __syncthreads();
    if (c.tid < 256) L[L_CARRY + c.tid] = 0.f;
    if (c.tid < 384) L[L_XBS + c.tid] = 0.f;
    for (int i = c.tid; i < 640; i += 512) CW[i] = i < 512 ? a.in[14][(size_t)l * 4 * D + (i >> 7) * D + n * 128 + (i & 127)] : a.in[15][(size_t)l * D + n * 128 + (i - 512)];
    bf16x8 Ba[4], Bx[4];
    { const bf16* wl = (const bf16*)(a.ws + WS_W + (size_t)l * WL_STRIDE);
      const bf16* wa = wl + OFF_LWA / 2 + (size_t)(n * 128 + e) * 128 + 8 * fq; const bf16* wx = wl + OFF_LWX / 2 + (size_t)(n * 128 + e) * 128 + 8 * fq;
#pragma unroll
      for (int ks = 0; ks < 4; ++ks) { Ba[ks] = *(const bf16x8*)(wa + 32 * ks); Bx[ks] = *(const bf16x8*)(wx + 32 * ks); } }
    const float ba = a.in[17][(size_t)l * D + ch], bx = a.in[19][(size_t)l * D + ch], sp8 = -8.0f * ((const float*)(a.ws + WS_TAB + 32768))[l * D + ch];
    const bf16* xsrc = XB + (size_t)(b * SEQ + t_ld) * D + n * 128 + c0;
    u32x4 xr0 = *(const u32x4*)xsrc, xr1 = *(const u32x4*)(xsrc + 8);
    for (int t0 = 0; t0 < SEQ; t0 += 64) {
        const int par = (t0 >> 6) & 1;
        unsigned ygr[16];
        { const bf16* yp = YG + (size_t)(b * SEQ + t0 + sg * 16) * D + n * 128 + cch;
#pragma unroll
          for (int tt = 0; tt < 16; ++tt) ygr[tt] = yp[(size_t)tt * D]; }
        WG_BAR();
        { LAS float* dst = L + L_XBS + (3 + t_ld) * 128 + c0;
          *(LAS f32x4*)dst        = (f32x4){bf2f(xr0.x & 0xffffu), bf2f(xr0.x >> 16), bf2f(xr0.y & 0xffffu), bf2f(xr0.y >> 16)};
          *(LAS f32x4*)(dst + 4)  = (f32x4){bf2f(xr0.z & 0xffffu), bf2f(xr0.z >> 16), bf2f(xr0.w & 0xffffu), bf2f(xr0.w >> 16)};
          *(LAS f32x4*)(dst + 8)  = (f32x4){bf2f(xr1.x & 0xffffu), bf2f(xr1.x >> 16), bf2f(xr1.y & 0xffffu), bf2f(xr1.y >> 16)};
          *(LAS f32x4*)(dst + 12) = (f32x4){bf2f(xr1.z & 0xffffu), bf2f(xr1.z >> 16), bf2f(xr1.w & 0xffffu), bf2f(xr1.w >> 16)}; }
        if (t0 + 64 < SEQ) { xr0 = *(const u32x4*)(xsrc + (size_t)(t0 + 64) * D); xr1 = *(const u32x4*)(xsrc + (size_t)(t0 + 64) * D + 8); }
        WG_BAR();
#pragma unroll
        for (int j4 = 0; j4 < 4; ++j4) { const int cc = c0 + 4 * j4;
            f32x4 acc = *(const LAS f32x4*)(CW + 512 + cc);
#pragma unroll
            for (int j = 0; j < 4; ++j) acc += *(const LAS f32x4*)(CW + j * 128 + cc) * *(const LAS f32x4*)(L + L_XBS + (t_ld + j) * 128 + cc);
            *(LAS f32x4*)(L + L_XC + t_ld * 128 + cc) = acc;
            { u32x2 pw; pw.x = pk2(acc[0], acc[1]); pw.y = pk2(acc[2], acc[3]); *(LAS u32x2*)(c.lds + LB_XCB + t_ld * XCB_STRIDE + cc * 2) = pw; } }
        WG_BAR();
#pragma unroll
        for (int m = 0; m < 4; ++m) {
            f32x4 ar = (f32x4){0.f, 0.f, 0.f, 0.f}, ai = (f32x4){0.f, 0.f, 0.f, 0.f};
#pragma unroll
            for (int ks = 0; ks < 4; ++ks) {
                const bf16x8 af = *(const LAS bf16x8*)(c.lds + LB_XCB + (16 * m + fr) * XCB_STRIDE + (32 * ks + 8 * fq) * 2);
                ar = __builtin_amdgcn_mfma_f32_16x16x32_bf16(af, Ba[ks], ar, 0, 0, 0);
                ai = __builtin_amdgcn_mfma_f32_16x16x32_bf16(af, Bx[ks], ai, 0, 0, 0);
            }
#pragma unroll
            for (int j = 0; j < 4; ++j) {
                const int t = 16 * m + 4 * fq + j;
                const float r = sig_fast(ar[j] + ba), ig = sig_fast(ai[j] + bx);
                const float la = sp8 * r, x2 = 2.0f * la;
                const float em = x2 > -0.5f ? x2 * (1.0f + x2 * (0.5f + x2 * (0.16666667f + x2 * (0.041666668f + x2 * 0.0083333338f)))) : __expf(x2) - 1.0f;
                L[L_AS + t * 128 + e] = __expf(la); L[L_BS + t * 128 + e] = __builtin_amdgcn_sqrtf(-em) * ig * L[L_XC + t * 128 + e];
            }
        }
        WG_BAR();
        float P = 1.f, Bv = 0.f;
#pragma unroll
        for (int tt = 0; tt < 16; ++tt) { const float aa = L[L_AS + (sg * 16 + tt) * 128 + cch], bb = L[L_BS + (sg * 16 + tt) * 128 + cch]; Bv = aa * Bv + bb; P *= aa; }
        L[L_SEG + (sg * 128 + cch) * 2] = P; L[L_SEG + (sg * 128 + cch) * 2 + 1] = Bv;
        WG_BAR();
        float h = L[L_CARRY + par * 128 + cch];
        for (int s2 = 0; s2 < sg; ++s2) h = L[L_SEG + (s2 * 128 + cch) * 2] * h + L[L_SEG + (s2 * 128 + cch) * 2 + 1];
        { bf16* op = OB + (size_t)(b * SEQ + t0 + sg * 16) * D + n * 128 + cch;
#pragma unroll
          for (int tt = 0; tt < 16; ++tt) { const int t = sg * 16 + tt;
              h = L[L_AS + t * 128 + cch] * h + L[L_BS + t * 128 + cch];
              op[(size_t)tt * D] = (bf16)f2bf(h * bf2f(ygr[tt])); } }
        if (sg == 3) L[L_CARRY + (par ^ 1) * 128 + cch] = h;
        if (c.tid < 384) L[L_XBS + c.tid] = L[L_XBS + 64 * 128 + c.tid];
    }
    __syncthreads();
    if (c.tid < 128) a.out[O_LRP + ((size_t)l * NBATCH + b) * D + n * 128 + c.tid] = L[L_CARRY + c.tid];
    if (c.tid < 384) a.out[O_CVP + (((size_t)l * NBATCH + b) * 3 + (c.tid >> 7)) * D + n * 128 + (c.tid & 127)] = L[L_XBS + c.tid];
    __syncthreads();
}
__device__ __forceinline__ void lru_sample_item(CArgs& a, Ctx& c, int l, int n, int hf) {
    LAS float* L = (LAS float*)c.lds;
    const bf16* XB = (const bf16*)(a.ws + WS_XB); const bf16* YG = (const bf16*)(a.ws + WS_YG); bf16* OB = (bf16*)(a.ws + WS_OB);
    const int t_ld = c.tid >> 3, c0 = (c.tid & 7) * 16;
    const float* cw = a.in[14] + (size_t)l * 4 * D + n * 128; const float* cb = a.in[15] + (size_t)l * D + n * 128;
    const int bs = hf * 64 + t_ld, row = MP + bs;
    const float* sc = a.in[4] + ((size_t)l * NS + bs) * 3 * D + n * 128;
    float* nc = a.out + O_CVS + ((size_t)l * NS + bs) * 3 * D + n * 128;
    __syncthreads();
#pragma unroll
    for (int j4 = 0; j4 < 4; ++j4) { const int cc = c0 + 4 * j4;
        const f32x4 x = ld_bf4(XB + (size_t)row * D + n * 128 + cc);
        const f32x4 s0 = *(const f32x4*)(sc + cc), s1 = *(const f32x4*)(sc + D + cc), s2 = *(const f32x4*)(sc + 2 * D + cc);
        const f32x4 acc = *(const f32x4*)(cb + cc) + *(const f32x4*)(cw + cc) * s0 + *(const f32x4*)(cw + D + cc) * s1 + *(const f32x4*)(cw + 2 * D + cc) * s2 + *(const f32x4*)(cw + 3 * D + cc) * x;
        *(LAS f32x4*)(L + L_XC + t_ld * 128 + cc) = acc;
        { u32x2 w; w.x = pk2(acc[0], acc[1]); w.y = pk2(acc[2], acc[3]); *(LAS u32x2*)(c.lds + LB_XCB + t_ld * XCB_STRIDE + cc * 2) = w; }
        *(f32x4*)(nc + cc) = s1; *(f32x4*)(nc + D + cc) = s2; *(f32x4*)(nc + 2 * D + cc) = x; }
    __syncthreads();
    lru_gates(a, c, l, n);
    __syncthreads();
    { const int cch = c.tid & 127, tg = c.tid >> 7;
#pragma unroll 4
      for (int tt = 0; tt < 16; ++tt) { const int t = tg * 16 + tt, b2 = hf * 64 + t; const size_t off = (size_t)(MP + b2) * D + n * 128 + cch;
          const float h0 = a.in[3][((size_t)l * NS + b2) * D + n * 128 + cch];
          const float h = L[L_AS + t * 128 + cch] * h0 + L[L_BS + t * 128 + cch];
          a.out[O_LRS + ((size_t)l * NS + b2) * D + n * 128 + cch] = h;
          OB[off] = (bf16)f2bf(h * bf2f(YG[off])); } }
    __syncthreads();
}

__device__ __forceinline__ void mixer_phase(CArgs& a, Ctx& c, int l) {
    if (c.wg < 64) {
        const int b = c.wg >> 3, h = c.wg & 7;
        {
#if FAST_HGRN
        hgrn_fast_prompt(a, c, l, b, h);
#else
        hgrn_naive(a, c, l, b * SEQ, SEQ, h, nullptr, a.out + O_HGP + (((size_t)l * NBATCH + b) * NH + h) * DKV * DKV);
#endif
        }
    } else if (c.wg < 128) {
        const int i = c.wg - 64;
        for (int rep = 0; rep < 1 + ((PROBE_MIX >> 1) & 1); ++rep) lru_prompt_item(a, c, l, i >> 3, i & 7);
        if (i < 16) for (int rep = 0; rep < 1 + ((PROBE_MIX >> 3) & 1); ++rep) lru_sample_item(a, c, l, i >> 1, i & 1);
    } else {
        for (int rep = 0; rep < 1 + ((PROBE_MIX >> 2) & 1); ++rep)
        for (int it = c.wg - 128; it < NS * NH; it += c.G - 128) {
            const int bs = it >> 3, h = it & 7; const size_t so = (((size_t)l * NS + bs) * NH + h) * DKV * DKV;
            hgrn_naive(a, c, l, MP + bs, 1, h, a.in[2] + so, a.out + O_HGS + so);
        }
    }
}

__global__ void __launch_bounds__(512, 2) mega_fwd(Args a0) {
    extern __shared__ __attribute__((aligned(16))) unsigned char lds_raw[];
    Ctx c; c.lds = (LAS unsigned char*)lds_raw; c.tid = threadIdx.x; c.G = gridDim.x; c.wg = blockIdx.x;
    volatile LAS unsigned* MISC = (volatile LAS unsigned*)(c.lds + MISC_OFF);
    if (c.tid < 32) MISC[c.tid] = 0u;
    __syncthreads();
    XcdBarrier bar; bar.bar = (unsigned*)(a0.ws + WS_CTL) + 1024; bar.x = 0; bar.st = nullptr;
    const int nprog = a0.nprog;
    if (nprog > 1) bar = xcd_barrier_post((unsigned*)(a0.ws + WS_CTL) + 1024, MISC + 8);

    for (int pi = 0; pi < nprog; ++pi) {
        CArgs* ap = (CArgs*)__builtin_amdgcn_kernarg_segment_ptr(); asm volatile("" : "+s"(ap));
        CArgs& a = *ap;
        const int ph = a.prog[pi];
        { int t_ = threadIdx.x, w_ = blockIdx.x, g_ = gridDim.x; asm volatile("" : "+v"(t_), "+s"(w_), "+s"(g_)); c.tid = t_; c.wg = w_; c.G = g_; }
        float* X = a.out;
        if (ph == 0) { }
        else if (ph == NPHASE - 1) final_norm_phase(a, c);
        else {
            const int l = (ph - 1) >> 3, j = (ph - 1) & 7;
            const bf16* wl = (const bf16*)(a.ws + WS_W + (size_t)l * WL_STRIDE);
            const float* xp = l == 0 ? a.in[0] : X; const float* xs = l == 0 ? a.in[1] : X + (size_t)MP * D;
            const float* modl = (const float*)(a.ws + WS_MOD) + (size_t)l * NMOD * 6144;
            bf16* H = (bf16*)(a.ws + WS_H);
            if (j == 0) norm_phase(a, c, l, 0, xp, xs);
            else if (j == 1) {
                EpiIn e{(bf16*)(a.ws + WS_Q), (bf16*)(a.ws + WS_K), (bf16*)(a.ws + WS_V), (bf16*)(a.ws + WS_OG), (bf16*)(a.ws + WS_XB), (bf16*)(a.ws + WS_YG), (bf16*)(a.ws + WS_SGA), (bf16*)(a.ws + WS_SGB),
                        (float*)(a.ws + WS_LOGF), (const float*)(a.ws + WS_TAB) + (size_t)l * 3 * D, l == 0 ? 1 : 0};
                gemm_phase_sel<0>(c, H, wl + OFF_WIN / 2, MT, NIN, D, e);
            } else if (j == 2) mixer_phase(a, c, l);
            else if (j == 3) {
                EpiBrA ea{(const bf16*)(a.ws + WS_SGA), (float*)(a.ws + WS_T)};
                gemm_phase_sel<1>(c, (const bf16*)(a.ws + WS_OA), wl + OFF_WA / 2, MT, D, D, ea);
                asm volatile("s_waitcnt vmcnt(0)" ::: "memory"); __syncthreads();
                { int t_ = threadIdx.x; asm volatile("" : "+v"(t_)); c.tid = t_; }
                EpiBrB eb{(const bf16*)(a.ws + WS_SGB), (const float*)(a.ws + WS_T), (bf16*)(a.ws + WS_MG)};
                gemm_phase_sel<2>(c, (const bf16*)(a.ws + WS_OB), wl + OFF_WB / 2, MT, D, D, eb);
            } else if (j == 4) {
                EpiRes e{xp, xs, X, modl, 2};
                gemm_phase_sel<3>(c, (const bf16*)(a.ws + WS_MG), wl + OFF_WO / 2, MT, D, D, e);
            } else if (j == 5) norm_phase(a, c, l, 1, X, X + (size_t)MP * D);
            else if (j == 6) { EpiFF1 e{(bf16*)(a.ws + WS_HM)}; gemm_phase_sel<4>(c, H, wl + OFF_W1 / 2, MT, FF, D, e); }
            else { float* XO = (l == 1 && XOUT_SCRATCH) ? (float*)(a.ws + WS_T) : X;
                   EpiRes e{X, X + (size_t)MP * D, XO, modl, 5}; gemm_phase_sel<5>(c, (const bf16*)(a.ws + WS_HM), wl + OFF_W2 / 2, MT, D, FF, e); }
        }
        if (ph == 0 || (ph == 3 && c.wg >= 128)) {
            { int t_ = threadIdx.x; asm volatile("" : "+v"(t_)); c.tid = t_; }
            p0_work(a, c, ph == 0 ? 0 : 1, ph == 0 ? c.wg : c.wg - 128, ph == 0 ? c.G : c.G - 128, ph == 0);
        }
        if (pi + 1 < nprog) xcd_barrier(bar);
    }
}

extern "C" void kernel_launch(void* const* d_in, const int* in_sizes, int n_in, void* d_out, int out_size, void* d_ws, size_t ws_size, hipStream_t stream) {
    static int grid = 0;
    if (grid == 0) {
        if (n_in != 27 || out_size != (int)O_END || ws_size < WS_END) { fprintf(stderr, "kernel_launch: unexpected shapes (n_in %d out %d ws %zu)\n", n_in, out_size, ws_size); grid = -1; return; }
        int dev = 0, cus = 0, per_cu = 0;
        if (hipGetDevice(&dev) != hipSuccess || hipDeviceGetAttribute(&cus, hipDeviceAttributeMultiprocessorCount, dev) != hipSuccess) { grid = -1; return; }
        if (hipFuncSetAttribute((const void*)mega_fwd, hipFuncAttributeMaxDynamicSharedMemorySize, LDS_BYTES) != hipSuccess) { fprintf(stderr, "kernel_launch: hipFuncSetAttribute failed\n"); grid = -1; return; }
        if (hipOccupancyMaxActiveBlocksPerMultiprocessor(&per_cu, (const void*)mega_fwd, 512, LDS_BYTES) != hipSuccess || per_cu < 1) { fprintf(stderr, "kernel_launch: occupancy query failed (%d)\n", per_cu); (void)hipGetLastError(); per_cu = 1; }
        grid = cus * (per_cu < 1 ? 1 : 1);
        fprintf(stderr, "kernel_launch: cus %d per_cu %d grid %d\n", cus, per_cu, grid);
    }
    if (grid < 0) return;
    (void)hipMemsetAsync((char*)d_ws + WS_CTL, 0, CTL_BYTES, stream);
    Args a{};
    for (int i = 0; i < 27; ++i) a.in[i] = (const float*)d_in[i];
    a.out = (float*)d_out; a.ws = (unsigned char*)d_ws;
    unsigned char prog[60]; int np = 0;
    for (int ph = 0; ph < NPHASE; ++ph) for (int rep = 0; rep < 1 + (int)(((unsigned)PROBE_REPEAT >> ph) & 1u); ++rep) prog[np++] = (unsigned char)ph;
#if ONE_LAUNCH
    a.nprog = np; for (int i = 0; i < np; ++i) a.prog[i] = prog[i];
    void* kargs[] = {&a};
    hipError_t e = hipLaunchCooperativeKernel((const void*)mega_fwd, dim3(grid), dim3(512), kargs, LDS_BYTES, stream);
    if (e != hipSuccess) fprintf(stderr, "kernel_launch: cooperative launch failed: %s (grid %d)\n", hipGetErrorString(e), grid);
#else
    for (int i = 0; i < np; ++i) { a.nprog = 1; a.prog[0] = prog[i]; hipLaunchKernelGGL(mega_fwd, dim3(grid), dim3(512), LDS_BYTES, stream, a); }
#endif
}
```

```cpp
#include <hip/hip_runtime.h>
#include <cstdio>
#include <cstdint>

#ifndef FAST_GEMM
#define FAST_GEMM 63
#endif
#ifndef FAST_HGRN
#define FAST_HGRN 1
#endif
#ifndef FAST_GATES
#define FAST_GATES 1
#endif
#ifndef DBG_SHFL
#define DBG_SHFL 1
#endif
#ifndef PROBE_REPEAT
#define PROBE_REPEAT 0
#endif
#ifndef PROBE_MIX
#define PROBE_MIX 0
#endif
#ifndef PROBE_P0
#define PROBE_P0 0
#endif
#ifndef XOUT_SCRATCH
#define XOUT_SCRATCH 0
#endif
#ifndef PROBE_T
#define PROBE_T 0
#endif
#ifndef ONE_LAUNCH
#define ONE_LAUNCH 1
#endif

#define LAS __attribute__((address_space(3)))
#define GAS __attribute__((address_space(1)))
typedef unsigned short bf16;
typedef float f32x4 __attribute__((ext_vector_type(4)));
typedef float f32x2 __attribute__((ext_vector_type(2)));
typedef short bf16x8 __attribute__((ext_vector_type(8)));
typedef unsigned u32x4 __attribute__((ext_vector_type(4)));
typedef unsigned u32x2 __attribute__((ext_vector_type(2)));

constexpr int D = 1024, NBATCH = 8, SEQ = 2048, MP = NBATCH * SEQ, NS = 128, MR = MP + NS, MT = 16640;
constexpr int NMOD = NBATCH + NS;
constexpr int NIN = 8192, FF = 4096, NH = 8, DKV = 128;
constexpr float EPS = 1e-6f;
constexpr int NPHASE = 20;

constexpr size_t MiB = (size_t)1 << 20;
constexpr size_t WS_CTL = 0, CTL_BYTES = 64 * 1024;
constexpr size_t WS_DBG = 512 * 1024;
constexpr size_t WS_TAB = 1 * MiB;
constexpr size_t WS_MOD = 2 * MiB;
constexpr size_t WS_W = 9 * MiB, WL_STRIDE = 77 * MiB / 2;
constexpr size_t OFF_WIN = 0, OFF_WA = 16 * MiB, OFF_WB = 18 * MiB, OFF_WO = 20 * MiB, OFF_W1 = 22 * MiB, OFF_W2 = 30 * MiB, OFF_LWA = 38 * MiB, OFF_LWX = 38 * MiB + 256 * 1024;
constexpr size_t WS_H = 86 * MiB;
constexpr size_t WS_PREP = 119 * MiB;
constexpr size_t PREP_BLK = 65536;
constexpr size_t WS_V = 247 * MiB, WS_OG = 280 * MiB, WS_XB = 313 * MiB, WS_YG = 346 * MiB, WS_SGA = 379 * MiB, WS_SGB = 412 * MiB;
constexpr size_t WS_OA = 445 * MiB;
constexpr size_t WS_SQ = 478 * MiB, WS_SK = WS_SQ + 256 * 1024, WS_SLOGF = WS_SQ + 512 * 1024;
constexpr size_t WS_OB = WS_H;
constexpr size_t WS_T = WS_PREP;
constexpr size_t WS_MG = WS_PREP + 66 * MiB;
constexpr size_t WS_HM = WS_PREP;
constexpr size_t WS_END = 480 * MiB;
static_assert(WS_W + 2 * WL_STRIDE <= WS_H && WS_H + (size_t)MT * D * 2 <= WS_PREP && WS_PREP + 2048 * PREP_BLK <= WS_V && WS_T + (size_t)MT * D * 4 <= WS_MG && WS_MG + (size_t)MT * D * 2 <= WS_V
              && WS_HM + (size_t)MT * FF * 2 <= WS_OG && WS_OA + (size_t)MT * D * 2 <= WS_SQ && WS_SLOGF + 512 * 1024 <= WS_END, "ws map");

constexpr size_t O_YP = 0, O_YS = (size_t)MP * D, O_HGP = O_YS + (size_t)NS * D, O_LRP = O_HGP + (size_t)2 * NBATCH * NH * DKV * DKV, O_CVP = O_LRP + (size_t)2 * NBATCH * D,
                 O_HGS = O_CVP + (size_t)2 * NBATCH * 3 * D, O_LRS = O_HGS + (size_t)2 * NS * NH * DKV * DKV, O_CVS = O_LRS + (size_t)2 * NS * D, O_END = O_CVS + (size_t)2 * NS * 3 * D;
static_assert(O_END == 53673984, "out map");

constexpr int LDS_BYTES = 163840;
constexpr int MISC_OFF = 158 * 1024;

typedef __bf16 bf16x2_t __attribute__((ext_vector_type(2)));
__device__ __forceinline__ unsigned f2bf(float f) { return (unsigned)__builtin_bit_cast(unsigned short, (__bf16)f); }
__device__ __forceinline__ unsigned pk2(float lo, float hi) { return __builtin_bit_cast(unsigned, __builtin_convertvector((f32x2){lo, hi}, bf16x2_t)); }
__device__ __forceinline__ float bf2f(unsigned b) { return __builtin_bit_cast(float, b << 16); }
__device__ __forceinline__ f32x4 ld_bf4(const bf16* p) { const u32x2 w = *(const u32x2*)p; return (f32x4){bf2f(w.x & 0xffffu), bf2f(w.x >> 16), bf2f(w.y & 0xffffu), bf2f(w.y >> 16)}; }
__device__ __forceinline__ void st_bf4(bf16* p, f32x4 v) { u32x2 w; w.x = pk2(v[0], v[1]); w.y = pk2(v[2], v[3]); *(u32x2*)p = w; }
#define WG_BAR() do { asm volatile("s_waitcnt lgkmcnt(0)" ::: "memory"); __builtin_amdgcn_s_barrier(); asm volatile("" ::: "memory"); } while (0)
__device__ __forceinline__ float sig_fast(float x) { return __builtin_amdgcn_rcpf(1.0f + __expf(-x)); }
__device__ __forceinline__ void st_bf8(bf16* p, f32x4 v0, f32x4 v1) { u32x4 w; w.x = pk2(v0[0], v0[1]); w.y = pk2(v0[2], v0[3]); w.z = pk2(v1[0], v1[1]); w.w = pk2(v1[2], v1[3]); *(u32x4*)p = w; }
__device__ __forceinline__ void ld_bf8(const bf16* p, f32x4& v0, f32x4& v1) { const u32x4 w = *(const u32x4*)p; v0 = (f32x4){bf2f(w.x & 0xffffu), bf2f(w.x >> 16), bf2f(w.y & 0xffffu), bf2f(w.y >> 16)}; v1 = (f32x4){bf2f(w.z & 0xffffu), bf2f(w.z >> 16), bf2f(w.w & 0xffffu), bf2f(w.w >> 16)}; }
__device__ __forceinline__ float sigmoidf_(float x) { return 1.0f / (1.0f + __expf(-x)); }
__device__ __forceinline__ float siluf_(float x) { return x * sigmoidf_(x); }
__device__ __forceinline__ float gelu_tanh_(float x) { const float u = 0.7978845608028654f * (x + 0.044715f * x * x * x); return x * sigmoidf_(2.0f * u); }
__device__ __forceinline__ float softplusf_(float x) { return fmaxf(x, 0.f) + log1pf(expf(-fabsf(x))); }
template <int XM> __device__ __forceinline__ float swz_xor(float v) { return __builtin_bit_cast(float, __builtin_amdgcn_ds_swizzle(__builtin_bit_cast(int, v), (XM << 10) | 0x1f)); }
__device__ __forceinline__ int lane_id_fresh() { int l = (int)__builtin_amdgcn_mbcnt_hi(~0u, __builtin_amdgcn_mbcnt_lo(~0u, 0u)); asm volatile("" : "+v"(l)); return l; }
__device__ __forceinline__ float xchg(float v, int l, int m) { return __builtin_bit_cast(float, __builtin_amdgcn_ds_bpermute((l ^ m) << 2, __builtin_bit_cast(int, v))); }
template <int CTRL> __device__ __forceinline__ float dpp_f(float v) { return __builtin_bit_cast(float, __builtin_amdgcn_update_dpp(0, __builtin_bit_cast(int, v), CTRL, 0xf, 0xf, false)); }
__device__ __forceinline__ float row16_sum(float v) { v += dpp_f<0xB1>(v); v += dpp_f<0x4E>(v); v += dpp_f<0x141>(v); v += dpp_f<0x140>(v); return v; }
__device__ __forceinline__ float half_sum(float v) { const int l = lane_id_fresh(); v += xchg(v, l, 1); v += xchg(v, l, 2); v += xchg(v, l, 4); v += xchg(v, l, 8); v += xchg(v, l, 16); return v; }
__device__ __forceinline__ float wave_sum(float v) { const int l = lane_id_fresh(); v += xchg(v, l, 1); v += xchg(v, l, 2); v += xchg(v, l, 4); v += xchg(v, l, 8); v += xchg(v, l, 16); v += xchg(v, l, 32); return v; }
__device__ __forceinline__ int mod_row(int row) { return row < MP ? (row >> 11) : (NBATCH + row - MP); }

struct Args { const float* in[27]; float* out; unsigned char* ws; int nprog; unsigned char prog[60]; };
typedef const __attribute__((address_space(4))) Args CArgs;
struct Ctx { LAS unsigned char* lds; int tid, G, wg; };
namespace pg8 {
#define PG8_LAS __attribute__((address_space(3)))
typedef unsigned short bf16_t;
typedef short bf16x8 __attribute__((ext_vector_type(8)));
typedef float f32x4 __attribute__((ext_vector_type(4)));
typedef unsigned u32x4 __attribute__((ext_vector_type(4)));
constexpr int BM = 256, BK = 64, HALF = 128, HTB = HALF * BK * 2  , STAGE_BYTES = 8 * HTB, NXCD = 8, WGM = 8;

__host__ __device__ __forceinline__ int lds_byte(int r, int c) { const int st = (r >> 4) * 2 + (c >> 5), rr = r & 15, cc = c & 31, ob = rr * 64 + cc * 2; return st * 1024 + (ob ^ (((ob >> 9) & 1) << 5)); }
__host__ __device__ __forceinline__ void stage_rc(int b, int& R, int& C) { const int st = b / 1024, sb = b % 1024, swz = sb ^ (((sb >> 9) & 1) << 5); R = (st >> 1) * 16 + swz / 64; C = (st & 1) * 32 + (swz % 64) / 2; }
__host__ __device__ __forceinline__ int perm32(int rho) { const int n = rho >> 4, i = rho & 15; return 8 * (i >> 2) + 4 * n + (i & 3); }

struct Unit { int pm, pn; };
struct Gemm { const bf16_t* A; const bf16_t* Bt; int M, N, K; };

struct StaticOrder {
    int nM, nN, nwg, G, c;
    __host__ __device__ void init(int M, int N, int G_, int c_) { nM = M / BM; nN = N / BM; nwg = nM * nN; G = G_; c = c_; }
    __host__ __device__ bool next(int i, Unit& u) const {
        const long L = (long)i * G + c; if (L >= nwg) return false;
        int wgid = (int)L; { const int q = nwg / NXCD, r = nwg % NXCD, xcd = wgid % NXCD, off = wgid / NXCD; wgid = (xcd < r ? xcd * (q + 1) : r * (q + 1) + (xcd - r) * q) + off; }
        const int nig = WGM * nN, gid = wgid / nig, fm = gid * WGM, gsz = (nM - fm) < WGM ? (nM - fm) : WGM;
        u.pm = fm + ((wgid % nig) % gsz); u.pn = (wgid % nig) / gsz; return true;
    }
    __device__ __forceinline__ void a_ready(const Unit&) const {}
    __device__ __forceinline__ void done(const Unit&) const {}
};
template <class Epi, class Sched, bool ALIGN_EPI = false, bool SP2 = false>
__device__ __forceinline__ void gemm_phase(PG8_LAS unsigned char* lds, const Gemm g, const Sched& S, const Epi& E, const int tid_in) {
    const int tid = tid_in, wid = __builtin_amdgcn_readfirstlane(tid >> 6), lane = tid & 63, wr = wid >> 2, wc = wid & 3, fr = lane & 15, fq = lane >> 4;
    const int K = g.K, nt = K / BK;
    unsigned voffA[2], voffB[2];
#pragma unroll
    for (int i = 0; i < 2; ++i) { int R, C; stage_rc(tid * 16 + i * 8192, R, C); const int Rb = Epi::PERM ? ((R & ~31) + perm32(R & 31)) : R;
        voffA[i] = (unsigned)(R * K + C) * 2u; voffB[i] = (unsigned)(Rb * K + C) * 2u; }
    const size_t kstep = (size_t)(BK * 2);
    const size_t hstep = (size_t)HALF * K * 2;
    const size_t tstep = 2 * hstep;
    const unsigned ldsw = (unsigned)wid * 1024u;
    const int aoff = lds_byte(wr * 64 + fr, fq * 8), boff = lds_byte(wc * 32 + fr, fq * 8);
#define PG8_SA(b, h) (((b) * 2 + (h)) * HTB)
#define PG8_SB(b, h) ((4 + (b) * 2 + (h)) * HTB)
#define PG8_STAGE(bufoff, gbase, voff) do { _Pragma("unroll") for (int _i = 0; _i < 2; ++_i) \
        __builtin_amdgcn_global_load_lds((const unsigned*)((const char*)(gbase) + (voff)[_i]), (PG8_LAS unsigned*)(lds + (bufoff) + ldsw + _i * 8192), 16, 0, 0); } while (0)
#define PG8_LDA(dst, b, h) do { _Pragma("unroll") for (int m = 0; m < 4; ++m) _Pragma("unroll") for (int k = 0; k < 2; ++k) dst[m][k] = *(const PG8_LAS bf16x8*)(lds + PG8_SA(b, h) + aoff + m * 2048 + k * 1024); } while (0)
#define PG8_LDB(dst, b, h) do { _Pragma("unroll") for (int n = 0; n < 2; ++n) _Pragma("unroll") for (int k = 0; k < 2; ++k) dst[n][k] = *(const PG8_LAS bf16x8*)(lds + PG8_SB(b, h) + boff + n * 2048 + k * 1024); } while (0)
#define PG8_MMA(ai, bj, At, Bt) do { __builtin_amdgcn_s_setprio(1); _Pragma("unroll") for (int m = 0; m < 4; ++m) _Pragma("unroll") for (int n = 0; n < 2; ++n) _Pragma("unroll") for (int k = 0; k < 2; ++k) \
        acc[ai][bj][m][n] = __builtin_amdgcn_mfma_f32_16x16x32_bf16(Bt[n][k], At[m][k], acc[ai][bj][m][n], 0, 0, 0); __builtin_amdgcn_s_setprio(0); } while (0)
#define PG8_WAIT_V(n) asm volatile("s_waitcnt vmcnt(" #n ")" ::: "memory")
#define PG8_WAIT_L(n) asm volatile("s_waitcnt lgkmcnt(" #n ")" ::: "memory")
#define PG8_BAR __builtin_amdgcn_s_barrier()
#define PG8_SCHED __builtin_amdgcn_sched_barrier(0)
    Unit cur, nxt; int ui = 0;
    if (!S.next(0, cur)) return;
    f32x4 acc[2][2][4][2];
#pragma unroll
    for (int a = 0; a < 2; ++a)
#pragma unroll
        for (int b = 0; b < 2; ++b)
#pragma unroll
            for (int m = 0; m < 4; ++m)
#pragma unroll
                for (int n = 0; n < 2; ++n) acc[a][b][m][n] = (f32x4){0.f, 0.f, 0.f, 0.f};
    bf16x8 At[4][2], B0[2][2], B1[2][2];
    const char* cA = (const char*)g.A + (size_t)cur.pm * tstep; const char* cB = (const char*)g.Bt + (size_t)cur.pn * tstep;
    S.a_ready(cur);
    if constexpr (SP2) {
        PG8_STAGE(PG8_SB(0, 0), cB, voffB); PG8_STAGE(PG8_SB(0, 1), cB + hstep, voffB); PG8_STAGE(PG8_SA(0, 0), cA, voffA); PG8_STAGE(PG8_SA(0, 1), cA + hstep, voffA);
        if (wr == 1) PG8_BAR;
        PG8_WAIT_V(2); PG8_BAR;
        PG8_STAGE(PG8_SB(1, 0), cB + kstep, voffB); PG8_STAGE(PG8_SA(1, 0), cA + kstep, voffA); PG8_STAGE(PG8_SB(1, 1), cB + hstep + kstep, voffB);
        PG8_WAIT_V(6); PG8_BAR;
    } else {
        PG8_STAGE(PG8_SB(0, 0), cB, voffB); PG8_STAGE(PG8_SA(0, 0), cA, voffA); PG8_STAGE(PG8_SB(0, 1), cB + hstep, voffB); PG8_STAGE(PG8_SA(0, 1), cA + hstep, voffA);
        if (wr == 1) PG8_BAR;
        PG8_WAIT_V(4); PG8_BAR;
        PG8_STAGE(PG8_SB(1, 0), cB + kstep, voffB); PG8_STAGE(PG8_SA(1, 0), cA + kstep, voffA); PG8_STAGE(PG8_SB(1, 1), cB + hstep + kstep, voffB);
        PG8_WAIT_V(6); PG8_BAR;
    }
    for (;;) {
        const bool has_next = S.next(ui + 1, nxt);
        const char* nA = has_next ? (const char*)g.A + (size_t)nxt.pm * tstep : cA; const char* nB = has_next ? (const char*)g.Bt + (size_t)nxt.pn * tstep : cB;
        for (int t = 0; t < nt; t += 2) {
            const bool last = (t == nt - 2);
            const char* a1 = cA + (size_t)(t + 1) * kstep;
            const char* a2 = last ? nA : cA + (size_t)(t + 2) * kstep; const char* b2 = last ? nB : cB + (size_t)(t + 2) * kstep;
            const char* a3 = a2 + kstep; const char* b3 = b2 + kstep;
            if (last && has_next) S.a_ready(nxt);
            if constexpr (SP2) {
            PG8_LDB(B0, 0, 0); PG8_LDB(B1, 0, 1); PG8_SCHED; PG8_LDA(At, 0, 0); PG8_STAGE(PG8_SA(1, 1), a1 + hstep, voffA);
            PG8_WAIT_V(8); PG8_WAIT_L(0); PG8_BAR; PG8_MMA(0, 0, At, B0); PG8_MMA(0, 1, At, B1); PG8_BAR; PG8_SCHED;
            PG8_LDA(At, 0, 1); PG8_STAGE(PG8_SB(0, 0), b2, voffB); PG8_STAGE(PG8_SB(0, 1), b2 + hstep, voffB); PG8_STAGE(PG8_SA(0, 0), a2, voffA);
            PG8_WAIT_V(8); PG8_WAIT_L(0); PG8_BAR; PG8_MMA(1, 0, At, B0); PG8_MMA(1, 1, At, B1); PG8_BAR; PG8_SCHED;
            PG8_LDB(B0, 1, 0); PG8_LDB(B1, 1, 1); PG8_SCHED; PG8_LDA(At, 1, 0); PG8_STAGE(PG8_SA(0, 1), a2 + hstep, voffA);
            PG8_WAIT_V(8); PG8_WAIT_L(0); PG8_BAR; PG8_MMA(0, 0, At, B0); PG8_MMA(0, 1, At, B1); PG8_BAR; PG8_SCHED;
            PG8_LDA(At, 1, 1); PG8_STAGE(PG8_SB(1, 0), b3, voffB); PG8_STAGE(PG8_SB(1, 1), b3 + hstep, voffB); PG8_STAGE(PG8_SA(1, 0), a3, voffA);
            PG8_WAIT_V(8); PG8_WAIT_L(0); PG8_BAR; PG8_MMA(1, 0, At, B0); PG8_MMA(1, 1, At, B1); PG8_BAR; PG8_SCHED;
            } else {
            PG8_LDB(B0, 0, 0); PG8_SCHED; PG8_LDA(At, 0, 0); PG8_STAGE(PG8_SA(1, 1), a1 + hstep, voffA);
            PG8_WAIT_L(8); PG8_BAR; PG8_WAIT_L(0); PG8_MMA(0, 0, At, B0); PG8_BAR; PG8_SCHED;
            PG8_LDB(B1, 0, 1); PG8_STAGE(PG8_SB(0, 0), b2, voffB);
            PG8_BAR; PG8_WAIT_L(0); PG8_MMA(0, 1, At, B1); PG8_BAR;
            PG8_LDA(At, 0, 1); PG8_STAGE(PG8_SA(0, 0), a2, voffA);
            PG8_BAR; PG8_WAIT_L(0); PG8_MMA(1, 0, At, B0); PG8_BAR; PG8_SCHED;
            PG8_STAGE(PG8_SB(0, 1), b2 + hstep, voffB);
            PG8_WAIT_V(6); PG8_BAR; PG8_MMA(1, 1, At, B1); PG8_BAR;
            PG8_LDB(B0, 1, 0); PG8_SCHED; PG8_LDA(At, 1, 0); PG8_STAGE(PG8_SA(0, 1), a2 + hstep, voffA);
            PG8_WAIT_L(8); PG8_BAR; PG8_WAIT_L(0); PG8_MMA(0, 0, At, B0); PG8_BAR; PG8_SCHED;
            PG8_LDB(B1, 1, 1); PG8_STAGE(PG8_SB(1, 0), b3, voffB);
            PG8_BAR; PG8_WAIT_L(0); PG8_MMA(0, 1, At, B1); PG8_BAR;
            PG8_LDA(At, 1, 1); PG8_STAGE(PG8_SA(1, 0), a3, voffA);
            PG8_BAR; PG8_WAIT_L(0); PG8_MMA(1, 0, At, B0); PG8_BAR; PG8_SCHED;
            PG8_STAGE(PG8_SB(1, 1), b3 + hstep, voffB);
            PG8_WAIT_V(6); PG8_BAR; PG8_MMA(1, 1, At, B1); PG8_BAR;
            }
        }
        if constexpr (ALIGN_EPI) { if (wr == 0) PG8_BAR; }
        if constexpr (!Epi::AFTER_DRAIN) { int l2 = (int)__builtin_amdgcn_mbcnt_hi(~0u, __builtin_amdgcn_mbcnt_lo(~0u, 0u)); asm volatile("" : "+v"(l2));
            E(acc, cur, wr, wc, l2 & 15, l2 >> 4); S.done(cur); }
        if (!has_next) break;
#pragma unroll
        for (int a = 0; a < 2; ++a)
#pragma unroll
            for (int b = 0; b < 2; ++b)
#pragma unroll
                for (int m = 0; m < 4; ++m)
#pragma unroll
                    for (int n = 0; n < 2; ++n) acc[a][b][m][n] = (f32x4){0.f, 0.f, 0.f, 0.f};
        cur = nxt; cA = nA; cB = nB; ++ui;
        if constexpr (ALIGN_EPI) { if (wr == 1) PG8_BAR; }
    }
    PG8_WAIT_V(0);
    if constexpr (!ALIGN_EPI) { if (wr == 0) PG8_BAR; }
    PG8_BAR;
    if constexpr (Epi::AFTER_DRAIN) { E.fused(acc, cur, wr, wc, fr, fq, lds, wid, lane); S.done(cur); }
#undef PG8_SA
#undef PG8_SB
#undef PG8_STAGE
#undef PG8_LDA
#undef PG8_LDB
#undef PG8_MMA
#undef PG8_WAIT_V
#undef PG8_WAIT_L
#undef PG8_BAR
#undef PG8_SCHED
}
}

template <class E> struct QuadEpi {
    static constexpr bool PERM = false, AFTER_DRAIN = false;
    E e;
    __device__ __forceinline__ void operator()(const f32x4 (&acc)[2][2][4][2], const pg8::Unit& u, int wr, int wc, int fr, int fq) const {
        const int row0 = u.pm * 256 + wr * 64 + fr, col0 = u.pn * 256 + wc * 32 + 4 * fq;
#pragma unroll
        for (int ai = 0; ai < 2; ++ai)
#pragma unroll
            for (int m = 0; m < 4; ++m)
#pragma unroll
                for (int bj = 0; bj < 2; ++bj)
#pragma unroll
                    for (int n = 0; n < 2; ++n) e.quad(row0 + ai * 128 + m * 16, col0 + bj * 128 + n * 16, acc[ai][bj][m][n]);
    }
};

struct EpiIn {
    unsigned char* PREP; bf16 *SQ, *SK; float* SLOGF; bf16 *V, *OG, *XB, *YG, *SGA, *SGB; const float* lbt; int lb0;
    static constexpr bool BY_REGION = true;
    __device__ __forceinline__ size_t blk_off(int row, int cc) const { return (((size_t)(row >> 11) * 32 + ((row >> 6) & 31)) * 8 + (cc >> 7)) * PREP_BLK; }
    __device__ __forceinline__ bf16* q_ptr(int row, int cc) const { return row < MP ? (bf16*)(PREP + blk_off(row, cc) + 32768) + (row & 63) * 128 + (cc & 127) : SQ + (size_t)(row - MP) * D + cc; }
    __device__ __forceinline__ bf16* k_ptr(int row, int cc) const { return row < MP ? (bf16*)(PREP + blk_off(row, cc) + 49152) + (row & 63) * 128 + (cc & 127) : SK + (size_t)(row - MP) * D + cc; }
    __device__ __forceinline__ float* lf_ptr(int row, int cc) const { return row < MP ? (float*)(PREP + blk_off(row, cc)) + (row & 63) * 128 + (cc & 127) : SLOGF + (size_t)(row - MP) * D + cc; }
    __device__ __forceinline__ f32x2 fgate(float fa, float lb, float llb, float l1m) const {
        float lf, kk;
        const float t = __expf(-fabsf(fa));
        const float ls = fminf(fa, 0.f) - __logf(1.0f + t);
        const float sneg = (fa >= 0.f ? t : 1.0f) * __builtin_amdgcn_rcpf(1.0f + t);
        if (lb0) { lf = ls; kk = sneg; }
        else { const float b = l1m + ls, mx = fmaxf(llb, b); lf = mx + __logf(1.0f + __expf(-fabsf(llb - b))); kk = (1.0f - lb) * sneg; }
        return (f32x2){lf, kk};
    }
    template <int R> __device__ __forceinline__ f32x4 act(f32x4 v) const {
        f32x4 r;
#pragma unroll
        for (int j = 0; j < 4; ++j) {
            if constexpr (R == 0 || R == 3) r[j] = v[j] * sig_fast(v[j]);
            else if constexpr (R == 5) { const float x = v[j], u = 0.7978845608028654f * (x + 0.044715f * x * x * x); r[j] = x * sig_fast(2.0f * u); }
            else if constexpr (R >= 6) r[j] = sig_fast(v[j]);
            else r[j] = v[j];
        }
        return r;
    }
    template <int R> __device__ __forceinline__ bf16* dst(int row, int cc) const { return R == 0 ? q_ptr(row, cc) : (R == 2 ? V : R == 3 ? OG : R == 4 ? XB : R == 5 ? YG : R == 6 ? SGA : SGB) + (size_t)row * D + cc; }
    template <int R> __device__ __forceinline__ void quadR(int row, int cc, f32x4 v) const {
        const size_t o = (size_t)row * D + cc;
        if constexpr (R == 1) {
            const f32x4 lb = *(const f32x4*)(lbt + cc), llb = *(const f32x4*)(lbt + 1024 + cc), l1m = *(const f32x4*)(lbt + 2048 + cc);
            f32x4 lf, r;
#pragma unroll
            for (int j = 0; j < 4; ++j) { const f32x2 g = fgate(v[j], lb[j], llb[j], l1m[j]); lf[j] = g.x; r[j] = g.y; }
            *(f32x4*)lf_ptr(row, cc) = lf; st_bf4(k_ptr(row, cc), r);
        } else st_bf4(dst<R>(row, cc), act<R>(v));
    }
    template <int R> __device__ __forceinline__ void octR(int row, int cc, f32x4 v0, f32x4 v1) const {
        const size_t o = (size_t)row * D + cc;
        if constexpr (R == 1) {
            f32x4 lf0, lf1, r0, r1;
            if (lb0) {
#pragma unroll
                for (int j = 0; j < 4; ++j) { const f32x2 g0 = fgate(v0[j], 0.f, 0.f, 0.f), g1 = fgate(v1[j], 0.f, 0.f, 0.f); lf0[j] = g0.x; r0[j] = g0.y; lf1[j] = g1.x; r1[j] = g1.y; }
            } else {
                const f32x4 lba = *(const f32x4*)(lbt + cc), lbb = *(const f32x4*)(lbt + cc + 4), lla = *(const f32x4*)(lbt + 1024 + cc), llb_ = *(const f32x4*)(lbt + 1024 + cc + 4), l1a = *(const f32x4*)(lbt + 2048 + cc), l1b = *(const f32x4*)(lbt + 2048 + cc + 4);
#pragma unroll
                for (int j = 0; j < 4; ++j) { const f32x2 g0 = fgate(v0[j], lba[j], lla[j], l1a[j]), g1 = fgate(v1[j], lbb[j], llb_[j], l1b[j]); lf0[j] = g0.x; r0[j] = g0.y; lf1[j] = g1.x; r1[j] = g1.y; }
            }
            float* lp = lf_ptr(row, cc); *(f32x4*)lp = lf0; *(f32x4*)(lp + 4) = lf1; st_bf8(k_ptr(row, cc), r0, r1);
        } else st_bf8(dst<R>(row, cc), act<R>(v0), act<R>(v1));
    }
    __device__ __forceinline__ void quad(int row, int col, f32x4 v) const {
        const int reg = col >> 10, cc = col & 1023;
        switch (reg) { case 0: quadR<0>(row, cc, v); break; case 1: quadR<1>(row, cc, v); break; case 2: quadR<2>(row, cc, v); break; case 3: quadR<3>(row, cc, v); break;
                       case 4: quadR<4>(row, cc, v); break; case 5: quadR<5>(row, cc, v); break; case 6: quadR<6>(row, cc, v); break; default: quadR<7>(row, cc, v); break; }
    }
};
struct EpiInUnit {
    static constexpr bool PERM = true, AFTER_DRAIN = false;
    EpiIn e;
    template <int KIND> __device__ __forceinline__ void run(const f32x4 (&acc)[2][2][4][2], int row0, int cc0, bf16* dstp, int mode) const {
#pragma unroll
        for (int ai = 0; ai < 2; ++ai)
#pragma unroll
            for (int m = 0; m < 4; ++m) {
#pragma unroll
                for (int bj = 0; bj < 2; ++bj) {
                    const int row = row0 + ai * 128 + m * 16, cc = cc0 + bj * 128;
                    const f32x4 v0 = acc[ai][bj][m][0], v1 = acc[ai][bj][m][1];
                    if constexpr (KIND == 0) e.octR<1>(row, cc, v0, v1);
                    else if constexpr (KIND == 1) st_bf8(dstp + (size_t)row * D + cc, v0, v1);
                    else { f32x4 r0, r1;
#pragma unroll
                        for (int j = 0; j < 4; ++j) {
                            const float x0 = v0[j], x1 = v1[j];
                            const float a0 = mode == 1 ? 1.5957691216057308f * (x0 + 0.044715f * x0 * x0 * x0) : x0, a1 = mode == 1 ? 1.5957691216057308f * (x1 + 0.044715f * x1 * x1 * x1) : x1;
                            const float s0 = sig_fast(a0), s1 = sig_fast(a1);
                            r0[j] = mode == 2 ? s0 : x0 * s0; r1[j] = mode == 2 ? s1 : x1 * s1; }
                        st_bf8(dstp ? dstp + (size_t)row * D + cc : e.q_ptr(row, cc), r0, r1); }
                }
                asm volatile("" ::: "memory"); __builtin_amdgcn_sched_barrier(0); }
    }
    __device__ __forceinline__ void operator()(const f32x4 (&acc)[2][2][4][2], const pg8::Unit& u, int wr, int wc, int fr, int fq) const {
        const int row0 = u.pm * 256 + wr * 64 + fr, cc0 = (u.pn & 3) * 256 + wc * 32 + 8 * fq, reg = u.pn >> 2;
        if (reg == 1) run<0>(acc, row0, cc0, nullptr, 0);
        else if (reg == 2 || reg == 4) run<1>(acc, row0, cc0, reg == 2 ? e.V : e.XB, 0);
        else { bf16* dp = reg == 0 ? nullptr : reg == 3 ? e.OG : reg == 5 ? e.YG : reg == 6 ? e.SGA : e.SGB;
               run<2>(acc, row0, cc0, dp, reg == 5 ? 1 : (reg >= 6 ? 2 : 0)); }
    }
};
template <class E> struct OctEpi {
    static constexpr bool PERM = true, AFTER_DRAIN = false;
    E e;
    __device__ __forceinline__ void operator()(const f32x4 (&acc)[2][2][4][2], const pg8::Unit& u, int wr, int wc, int fr, int fq) const {
        const int row0 = u.pm * 256 + wr * 64 + fr, col0 = u.pn * 256 + wc * 32 + 8 * fq;
#pragma unroll
        for (int ai = 0; ai < 2; ++ai)
#pragma unroll
            for (int m = 0; m < 4; ++m) {
#pragma unroll
                for (int bj = 0; bj < 2; ++bj) e.oct(row0 + ai * 128 + m * 16, col0 + bj * 128, acc[ai][bj][m][0], acc[ai][bj][m][1]);
                asm volatile("" ::: "memory"); __builtin_amdgcn_sched_barrier(0); }
    }
};
struct EpiBrA { static constexpr bool BY_REGION = false; const bf16* SGA; float* T;
    __device__ __forceinline__ void quad(int row, int col, f32x4 v) const { const size_t o = (size_t)row * D + col; *(f32x4*)(T + o) = ld_bf4(SGA + o) * v; }
    __device__ __forceinline__ void oct(int row, int col, f32x4 v0, f32x4 v1) const { const size_t o = (size_t)row * D + col; f32x4 g0, g1; ld_bf8(SGA + o, g0, g1); *(f32x4*)(T + o) = g0 * v0; *(f32x4*)(T + o + 4) = g1 * v1; } };
struct EpiBrB { static constexpr bool BY_REGION = false; const bf16* SGB; const float* T; bf16* MG;
    __device__ __forceinline__ void quad(int row, int col, f32x4 v) const { const size_t o = (size_t)row * D + col; st_bf4(MG + o, *(const f32x4*)(T + o) + ld_bf4(SGB + o) * v); }
    __device__ __forceinline__ void oct(int row, int col, f32x4 v0, f32x4 v1) const { const size_t o = (size_t)row * D + col; f32x4 g0, g1; ld_bf8(SGB + o, g0, g1);
        st_bf8(MG + o, *(const f32x4*)(T + o) + g0 * v0, *(const f32x4*)(T + o + 4) + g1 * v1); } };
struct EpiRes { static constexpr bool BY_REGION = false; const float* xp; const float* xs; float* X; const float* modl; int gi;
    __device__ __forceinline__ void quad(int row, int col, f32x4 v) const {
        if (row >= MR) return;
        const float* src = row < MP ? xp + (size_t)row * D : xs + (size_t)(row - MP) * D;
        const f32x4 g = *(const f32x4*)(modl + (size_t)mod_row(row) * 6144 + gi * 1024 + col);
        *(f32x4*)(X + (size_t)row * D + col) = *(const f32x4*)(src + col) + g * v;
    }
    __device__ __forceinline__ void oct(int row, int col, f32x4 v0, f32x4 v1) const { quad(row, col, v0); quad(row, col + 4, v1); } };
struct EpiFF1 { static constexpr bool BY_REGION = false; bf16* HM;
    __device__ __forceinline__ void quad(int row, int col, f32x4 v) const {
        f32x4 r;
#pragma unroll
        for (int j = 0; j < 4; ++j) { const float t = fmaxf(v[j], 0.f); r[j] = t * t; }
        st_bf4(HM + (size_t)row * FF + col, r);
    }
    __device__ __forceinline__ void oct(int row, int col, f32x4 v0, f32x4 v1) const {
        f32x4 r0, r1;
#pragma unroll
        for (int j = 0; j < 4; ++j) { const float t0 = fmaxf(v0[j], 0.f), t1 = fmaxf(v1[j], 0.f); r0[j] = t0 * t0; r1[j] = t1 * t1; }
        st_bf8(HM + (size_t)row * FF + col, r0, r1);
    } };

template <class E>
__device__ __forceinline__ void naive_gemm_phase(Ctx& c, const bf16* A, const bf16* Bt, int M, int N, int K, const E& e) {
    LAS float* As = (LAS float*)c.lds;
    LAS float* Bs = As + 32 * 132;
    const int ntm = M / 128, ntn = N / 128, tx = c.tid & 31, ty = c.tid >> 5;
    const int lr = c.tid >> 2, lk = (c.tid & 3) * 8;
    for (int tile = c.wg; tile < ntm * ntn; tile += c.G) {
        const int tm = tile % ntm, tn = tile / ntm;
        f32x4 acc[8];
#pragma unroll
        for (int i = 0; i < 8; ++i) acc[i] = (f32x4){0.f, 0.f, 0.f, 0.f};
        for (int k0 = 0; k0 < K; k0 += 32) {
            const u32x4 av = *(const u32x4*)(A + (size_t)(tm * 128 + lr) * K + k0 + lk);
            const u32x4 bv = *(const u32x4*)(Bt + (size_t)(tn * 128 + lr) * K + k0 + lk);
            __syncthreads();
#pragma unroll
            for (int j = 0; j < 4; ++j) {
                As[(lk + 2 * j) * 132 + lr] = bf2f(av[j] & 0xffffu); As[(lk + 2 * j + 1) * 132 + lr] = bf2f(av[j] >> 16);
                Bs[(lk + 2 * j) * 132 + lr] = bf2f(bv[j] & 0xffffu); Bs[(lk + 2 * j + 1) * 132 + lr] = bf2f(bv[j] >> 16);
            }
            __syncthreads();
#pragma unroll 8
            for (int k = 0; k < 32; ++k) {
                const f32x4 a0 = *(const LAS f32x4*)(As + k * 132 + ty * 8), a1 = *(const LAS f32x4*)(As + k * 132 + ty * 8 + 4);
                const f32x4 b = *(const LAS f32x4*)(Bs + k * 132 + tx * 4);
                acc[0] += a0[0] * b; acc[1] += a0[1] * b; acc[2] += a0[2] * b; acc[3] += a0[3] * b;
                acc[4] += a1[0] * b; acc[5] += a1[1] * b; acc[6] += a1[2] * b; acc[7] += a1[3] * b;
            }
        }
#pragma unroll
        for (int i = 0; i < 8; ++i) e.quad(tm * 128 + ty * 8 + i, tn * 128 + tx * 4, acc[i]);
    }
    __syncthreads();
}

struct PowOrder {
    int lgN, nwg, G, c;
    __device__ __forceinline__ void init(int lgN_, int G_, int c_) { lgN = lgN_; nwg = 64 << lgN_; G = G_; c = c_; }
    __device__ __forceinline__ bool next(int i, pg8::Unit& u) const {
        const int L = i * G + c; if (L >= nwg) return false;
        const int w = (L & 7) * (nwg >> 3) + (L >> 3), j = w & ((8 << lgN) - 1), gid = w >> (3 + lgN);
        u.pm = __builtin_amdgcn_readfirstlane(gid * 8 + (j & 7)); u.pn = __builtin_amdgcn_readfirstlane(j >> 3); return true;
    }
    __device__ __forceinline__ void a_ready(const pg8::Unit&) const {}
    __device__ __forceinline__ void done(const pg8::Unit&) const {}
};
template <class E>
__device__ __forceinline__ void sample_gemm_phase(Ctx& c, const bf16* A, const bf16* Bt, int N, int K, const E& e) {
    LAS float* red = (LAS float*)c.lds;
    const int lane = c.tid & 63, w = __builtin_amdgcn_readfirstlane(c.tid >> 6), fr = lane & 15, fq = lane >> 4, chh = w & 1, kq = w >> 1;
    const bf16* As = A + (size_t)MP * K;
    const int kspan = K >> 2;
    for (int mu = c.G - 1 - c.wg; mu < (N >> 5); mu += c.G) {
        const int n0 = 32 * mu;
        f32x4 acc[8];
#pragma unroll
        for (int m = 0; m < 8; ++m) acc[m] = (f32x4){0.f, 0.f, 0.f, 0.f};
        const bf16* bp = Bt + (size_t)(n0 + 16 * chh + fr) * K + kq * kspan + 8 * fq;
        const bf16* ap = As + (size_t)fr * K + kq * kspan + 8 * fq;
#pragma unroll 2
        for (int k = 0; k < kspan; k += 32) {
            const bf16x8 bfr = *(const bf16x8*)(bp + k);
#pragma unroll
            for (int m = 0; m < 8; ++m) acc[m] = __builtin_amdgcn_mfma_f32_16x16x32_bf16(*(const bf16x8*)(ap + (size_t)(16 * m) * K + k), bfr, acc[m], 0, 0, 0);
        }
        __syncthreads();
#pragma unroll
        for (int m = 0; m < 8; ++m)
#pragma unroll
            for (int j = 0; j < 4; ++j) red[(kq * 128 + 16 * m + 4 * fq + j) * 32 + 16 * chh + fr] = acc[m][j];
        __syncthreads();
#pragma unroll
        for (int i = 0; i < 2; ++i) { const int q = c.tid + 512 * i, row = q >> 3, cq = (q & 7) * 4;
            const f32x4 v = *(const LAS f32x4*)(red + row * 32 + cq) + *(const LAS f32x4*)(red + (128 + row) * 32 + cq) + *(const LAS f32x4*)(red + (256 + row) * 32 + cq) + *(const LAS f32x4*)(red + (384 + row) * 32 + cq);
            e.quad(MP + row, n0 + cq, v); }
    }
    __syncthreads();
}

template <int SITE, class E>
__device__ __forceinline__ void gemm_phase_sel(Ctx& c, const bf16* A, const bf16* Bt, int M, int N, int K, const E& e) {
    if constexpr ((FAST_GEMM >> SITE) & 1) {
        pg8::Gemm g{A, Bt, MP, N, K}; PowOrder S; S.init(N == 1024 ? 2 : (N == 4096 ? 4 : 5), c.G, c.wg);
        if constexpr (E::BY_REGION) { EpiInUnit qe{e}; pg8::gemm_phase<EpiInUnit, PowOrder, true, true>(c.lds, g, S, qe, c.tid); }
        else { OctEpi<E> qe{e}; pg8::gemm_phase<OctEpi<E>, PowOrder, true, true>(c.lds, g, S, qe, c.tid); }
        { int t_ = threadIdx.x; asm volatile("" : "+v"(t_)); c.tid = t_; }
        sample_gemm_phase(c, A, Bt, N, K, e);
    } else naive_gemm_phase(c, A, Bt, M, N, K, e);
}

#define XB_TMO      128
#define XB_XCNT(j)  (256  + 64 * (j))
#define XB_XSUB(j)  (1280 + 64 * (j))
#define XB_XGEN(j)  (2304 + 64 * (j))
#define XB_TOP      3328
#define XB_TOPGEN   3392
#define XCD_BAR_WORDS 3456
#define XB_SPIN_CAP (1u << 18)
__device__ __forceinline__ unsigned xb_ld(unsigned* p)              { return __hip_atomic_load(p, __ATOMIC_RELAXED, __HIP_MEMORY_SCOPE_AGENT); }
__device__ __forceinline__ unsigned xb_add(unsigned* p, unsigned v) { return __hip_atomic_fetch_add(p, v, __ATOMIC_RELAXED, __HIP_MEMORY_SCOPE_AGENT); }
__device__ __forceinline__ unsigned xb_xcc_id() { return (unsigned)__builtin_amdgcn_s_getreg((3 << 11) | 20) & 0xFu; }
#define XB_SPIN(cond, bar) do { unsigned _sp = 0; while (cond) { __builtin_amdgcn_s_sleep(1); \
    if ((++_sp & 255u) == 0u) { if (xb_ld(&(bar)[XB_TMO])) break; if (_sp > XB_SPIN_CAP) { atomicAdd(&(bar)[XB_TMO], 1u); break; } } } } while (0)
struct XcdBarrier { unsigned* bar; unsigned x; volatile LAS unsigned* st; };
__device__ __forceinline__ XcdBarrier xcd_barrier_post(unsigned* bar, volatile LAS unsigned* st) {
    XcdBarrier b; b.bar = bar; b.x = xb_xcc_id(); b.st = st;
    if (threadIdx.x == 0) (void)xb_add(&bar[XB_XCNT(b.x)], 1u);
    return b;
}
__device__ __forceinline__ void xcd_barrier_complete(unsigned* bar, unsigned x, unsigned& nloc, unsigned& nx) {
    const unsigned G = gridDim.x * gridDim.y * gridDim.z;
    unsigned sum, cnt, mine, sp = 0u;
    for (;;) {
        sum = 0u; cnt = 0u; mine = 0u;
#pragma unroll
        for (unsigned j = 0; j < 16; ++j) { const unsigned c = xb_ld(&bar[XB_XCNT(j)]); sum += c; cnt += (c > 0u) ? 1u : 0u; mine = (j == x) ? c : mine; }
        if (sum == G) break;
        __builtin_amdgcn_s_sleep(1);
        if ((++sp & 255u) == 0u) { if (xb_ld(&bar[XB_TMO])) break; if (sp > XB_SPIN_CAP) { atomicAdd(&bar[XB_TMO], 1u); break; } }
    }
    nloc = mine > 0u ? mine : 1u; nx = cnt > 0u ? cnt : 1u;
}
__device__ __forceinline__ void xcd_barrier(const XcdBarrier& b) {
    asm volatile("s_waitcnt vmcnt(0)" ::: "memory");
    __syncthreads();
    if (threadIdx.x == 0) {
        unsigned* bar = b.bar; asm volatile("" : "+s"(bar));
        __builtin_amdgcn_s_waitcnt(0);
        unsigned nloc = b.st[0], nx = b.st[1];
        if (nloc == 0u) { xcd_barrier_complete(bar, b.x, nloc, nx); b.st[0] = nloc; b.st[1] = nx; }
        const unsigned old = xb_add(&bar[XB_XSUB(b.x)], 1u);
        const unsigned gen = old / nloc;
        if (old + 1u == (gen + 1u) * nloc) {
            __builtin_amdgcn_fence(__ATOMIC_RELEASE, "agent");
            asm volatile("s_waitcnt vmcnt(0)" ::: "memory");
            const unsigned og = xb_add(&bar[XB_TOP], 1u);
            const unsigned tg = og / nx;
            if (og + 1u == (tg + 1u) * nx) xb_add(&bar[XB_TOPGEN], 1u);
            else XB_SPIN(xb_ld(&bar[XB_TOPGEN]) == tg, bar);
            __builtin_amdgcn_fence(__ATOMIC_ACQUIRE, "agent");
            xb_add(&bar[XB_XGEN(b.x)], 1u);
            asm volatile("s_waitcnt vmcnt(0)" ::: "memory");
        } else {
            XB_SPIN(xb_ld(&bar[XB_XGEN(b.x)]) == gen, bar);
            __builtin_amdgcn_fence(__ATOMIC_ACQUIRE, "agent");
            asm volatile("s_waitcnt vmcnt(0)" ::: "memory");
        }
    }
    __syncthreads();
}

__device__ __forceinline__ void p0_transpose_item(const float* W, int K, int N, bf16* WT, LAS float* scr, int item, int lane) {
    const int nblk = N / 32, kb = item / nblk, nb = item % nblk, k0 = 64 * kb, n0 = 32 * nb;
    float v[32];
#pragma unroll
    for (int i = 0; i < 32; ++i) v[i] = W[(size_t)(k0 + 2 * i + (lane >> 5)) * N + n0 + (lane & 31)];
#pragma unroll
    for (int i = 0; i < 32; ++i) scr[(2 * i + (lane >> 5)) * 33 + (lane & 31)] = v[i];
    asm volatile("s_waitcnt lgkmcnt(0)" ::: "memory");
    const int ch = lane & 7;
#pragma unroll
    for (int j = 0; j < 4; ++j) { const int n = (lane >> 3) + 8 * j; const LAS float* s = scr + (8 * ch) * 33 + n;
        u32x4 o; o.x = pk2(s[0 * 33], s[1 * 33]); o.y = pk2(s[2 * 33], s[3 * 33]); o.z = pk2(s[4 * 33], s[5 * 33]); o.w = pk2(s[6 * 33], s[7 * 33]);
        *(u32x4*)(WT + (size_t)(n0 + n) * K + k0 + 8 * ch) = o; }
    asm volatile("s_waitcnt lgkmcnt(0)" ::: "memory");
}
__device__ __forceinline__ void p0_work(CArgs& a, Ctx& c, int l, int vw, int nvw, bool with_tables, int ntr) {
    for (int lt = l; lt < l + ntr; ++lt) {
        LAS float* scr = (LAS float*)(c.lds + __builtin_amdgcn_readfirstlane(c.tid >> 6) * 16384);
        const int gw = vw * 8 + __builtin_amdgcn_readfirstlane(c.tid >> 6), NGW = nvw * 8;
        constexpr int I_IN = 16 * 256, I_SQ = 16 * 32, I_1 = 16 * 128, I_2 = 64 * 32, I_L = 8 * 8, PER_L = I_IN + 3 * I_SQ + I_1 + I_2 + 2 * I_L;
        bf16* wl = (bf16*)(a.ws + WS_W + (size_t)lt * WL_STRIDE);
        for (int it = gw; it < PER_L; it += NGW) {
            int r = it;
            if (r < I_IN) { p0_transpose_item(a.in[11] + (size_t)lt * D * NIN, D, NIN, wl + OFF_WIN / 2, scr, r, (c.tid & 63)); continue; } r -= I_IN;
            if (r < I_SQ) { p0_transpose_item(a.in[21] + (size_t)lt * D * D, D, D, wl + OFF_WA / 2, scr, r, (c.tid & 63)); continue; } r -= I_SQ;
            if (r < I_SQ) { p0_transpose_item(a.in[22] + (size_t)lt * D * D, D, D, wl + OFF_WB / 2, scr, r, (c.tid & 63)); continue; } r -= I_SQ;
            if (r < I_SQ) { p0_transpose_item(a.in[23] + (size_t)lt * D * D, D, D, wl + OFF_WO / 2, scr, r, (c.tid & 63)); continue; } r -= I_SQ;
            if (r < I_1) { p0_transpose_item(a.in[24] + (size_t)lt * D * FF, D, FF, wl + OFF_W1 / 2, scr, r, (c.tid & 63)); continue; } r -= I_1;
            if (r < I_2) { p0_transpose_item(a.in[25] + (size_t)lt * FF * D, FF, D, wl + OFF_W2 / 2, scr, r, (c.tid & 63)); continue; } r -= I_2;
            if (r < I_L) { const int n = r >> 3; p0_transpose_item(a.in[16] + ((size_t)lt * 8 + n) * 16384, 128, 128, wl + OFF_LWA / 2 + n * 16384, scr, r & 7, (c.tid & 63)); continue; } r -= I_L;
            { const int n = r >> 3; p0_transpose_item(a.in[18] + ((size_t)lt * 8 + n) * 16384, 128, 128, wl + OFF_LWX / 2 + n * 16384, scr, r & 7, (c.tid & 63)); }
        }
    }
    if (with_tables) {
        float* lbt = (float*)(a.ws + WS_TAB); float* sp = (float*)(a.ws + WS_TAB + 32768);
        const int gid = vw * 512 + c.tid;
        if (gid < 2 * D) {
            const int ll = gid >> 10, col = gid & 1023;
            const float h0 = a.in[12][col], h1 = a.in[12][D + col];
            const float p1 = 1.0f / (1.0f + expf(h0 - h1));
            const float lb = ll == 0 ? 0.f : p1;
            lbt[(ll * 3 + 0) * D + col] = lb; lbt[(ll * 3 + 1) * D + col] = logf(fmaxf(lb, 1e-30f)); lbt[(ll * 3 + 2) * D + col] = log1pf(-lb);
            sp[ll * D + col] = softplusf_(-a.in[20][ll * D + col]);
        }
    }
    __syncthreads();
    {
        constexpr int CS_STRIDE = 272;
        LAS unsigned char* csb = c.lds;
        LAS float* ws = (LAS float*)(c.lds + 39168);
        float* MOD = (float*)(a.ws + WS_MOD);
        const int lane = c.tid & 63, w = __builtin_amdgcn_readfirstlane(c.tid >> 6), fr = lane & 15, fq = lane >> 4, ct = w & 1, rt0 = w >> 1;
        for (int item = vw; item < 192; item += nvw) {
            const float* W = a.in[7] + (size_t)l * D * 6144 + item * 32;
            f32x4 acc[3];
#pragma unroll
            for (int i = 0; i < 3; ++i) acc[i] = (f32x4){0.f, 0.f, 0.f, 0.f};
            f32x4 cv[9], wv[2];
#define MOD_LOAD(k0_) do { _Pragma("unroll") for (int i = 0; i < 9; ++i) { const int e4 = c.tid + 512 * i, r = e4 >> 5, kq = (e4 & 31) * 4; const int rr = r < NMOD ? r : 0; \
                const float* src = rr < NBATCH ? a.in[5] + (size_t)rr * D : a.in[6] + (size_t)(rr - NBATCH) * D; cv[i] = *(const f32x4*)(src + (k0_) + kq); } \
              _Pragma("unroll") for (int i = 0; i < 2; ++i) { const int e4 = c.tid + 512 * i, kk = e4 >> 3, c4 = (e4 & 7) * 4; wv[i] = *(const f32x4*)(W + (size_t)((k0_) + kk) * 6144 + c4); } } while (0)
            MOD_LOAD(0);
            for (int k0 = 0; k0 < D; k0 += 128) {
                __syncthreads();
#pragma unroll
                for (int i = 0; i < 9; ++i) { const int e4 = c.tid + 512 * i, r = e4 >> 5, kq = (e4 & 31) * 4;
                    u32x2 pw; pw.x = pk2(siluf_(cv[i][0]), siluf_(cv[i][1])); pw.y = pk2(siluf_(cv[i][2]), siluf_(cv[i][3]));
                    if (r >= NMOD) { pw.x = 0u; pw.y = 0u; }
                    *(LAS u32x2*)(csb + r * CS_STRIDE + kq * 2) = pw; }
#pragma unroll
                for (int i = 0; i < 2; ++i) { const int e4 = c.tid + 512 * i, kk = e4 >> 3, c4 = (e4 & 7) * 4;
                    ws[kk * 33 + c4] = wv[i][0]; ws[kk * 33 + c4 + 1] = wv[i][1]; ws[kk * 33 + c4 + 2] = wv[i][2]; ws[kk * 33 + c4 + 3] = wv[i][3]; }
                if (k0 + 128 < D) MOD_LOAD(k0 + 128);
                WG_BAR();
#pragma unroll
                for (int ks = 0; ks < 4; ++ks) {
                    const LAS float* wp = ws + (32 * ks + 8 * fq) * 33 + 16 * ct + fr;
                    u32x4 bw; bw.x = pk2(wp[0], wp[33]); bw.y = pk2(wp[66], wp[99]); bw.z = pk2(wp[132], wp[165]); bw.w = pk2(wp[198], wp[231]);
                    const bf16x8 bfr = __builtin_bit_cast(bf16x8, bw);
#pragma unroll
                    for (int i = 0; i < 3; ++i) { const int rt = rt0 + 4 * i;
                        if (rt < 9) acc[i] = __builtin_amdgcn_mfma_f32_16x16x32_bf16(*(const LAS bf16x8*)(csb + (16 * rt + fr) * CS_STRIDE + (32 * ks + 8 * fq) * 2), bfr, acc[i], 0, 0, 0); }
                }
            }
#undef MOD_LOAD
            const float bm = a.in[8][(size_t)l * 6144 + item * 32 + 16 * ct + fr];
#pragma unroll
            for (int i = 0; i < 3; ++i) { const int rt = rt0 + 4 * i;
                if (rt < 9) {
#pragma unroll
                    for (int j = 0; j < 4; ++j) { const int row = 16 * rt + 4 * fq + j; if (row < NMOD) MOD[((size_t)l * NMOD + row) * 6144 + item * 32 + 16 * ct + fr] = acc[i][j] + bm; } } }
        }
    }
    __syncthreads();
}

__device__ __forceinline__ void norm_phase(CArgs& a, Ctx& c, int l, int which, const float* xp, const float* xs) {
    const int gw = c.wg * 8 + __builtin_amdgcn_readfirstlane(c.tid >> 6), NGW = c.G * 8;
    bf16* H = (bf16*)(a.ws + WS_H);
    const float* MODL = (const float*)(a.ws + WS_MOD) + (size_t)l * NMOD * 6144;
    const float* g = a.in[which ? 10 : 9] + (size_t)l * D;
    for (int row = gw; row < MR; row += NGW) {
        const float* xr = row < MP ? xp + (size_t)row * D : xs + (size_t)(row - MP) * D;
        const float* md = MODL + (size_t)mod_row(row) * 6144 + (which ? 3 : 0) * 1024;
        f32x4 v[4]; float ss = 0.f;
#pragma unroll
        for (int j = 0; j < 4; ++j) { v[j] = *(const f32x4*)(xr + 4 * (c.tid & 63) + 256 * j); ss += (v[j][0] * v[j][0] + v[j][1] * v[j][1]) + (v[j][2] * v[j][2] + v[j][3] * v[j][3]); }
        const float rstd = 1.0f / sqrtf(wave_sum(ss) * (1.0f / D) + EPS);
#pragma unroll
        for (int j = 0; j < 4; ++j) { const int cc = 4 * (c.tid & 63) + 256 * j;
            const f32x4 gg = *(const f32x4*)(g + cc), sh = *(const f32x4*)(md + cc), sc = *(const f32x4*)(md + 1024 + cc);
            st_bf4(H + (size_t)row * D + cc, v[j] * rstd * gg * (1.0f + sc) + sh); }
    }
}
__device__ __forceinline__ void final_norm_phase(CArgs& a, Ctx& c) {
    const int gw = c.wg * 8 + __builtin_amdgcn_readfirstlane(c.tid >> 6), NGW = c.G * 8;
    const float* g = a.in[26];
    for (int row = gw; row < MR; row += NGW) {
        const float* xr = (XOUT_SCRATCH ? (const float*)(a.ws + WS_T) : (const float*)a.out) + (size_t)row * D; float* yr = a.out + (size_t)row * D;
        f32x4 v[4]; float ss = 0.f;
#pragma unroll
        for (int j = 0; j < 4; ++j) { v[j] = *(const f32x4*)(xr + 4 * (c.tid & 63) + 256 * j); ss += (v[j][0] * v[j][0] + v[j][1] * v[j][1]) + (v[j][2] * v[j][2] + v[j][3] * v[j][3]); }
        const float rstd = 1.0f / sqrtf(wave_sum(ss) * (1.0f / D) + EPS);
#pragma unroll
        for (int j = 0; j < 4; ++j) { const int cc = 4 * (c.tid & 63) + 256 * j; f32x4 y = v[j] * rstd * *(const f32x4*)(g + cc);
            if (PROBE_T && row == 0 && cc == 0) y[0] += *(const float*)(a.ws + WS_DBG);
            *(f32x4*)(yr + cc) = y; }
    }
}

__device__ __forceinline__ void hgrn_naive(CArgs& a, Ctx& c, int l, int row0, int ntok, int h, const float* S0, float* Sout) {
    LAS float* fs = (LAS float*)c.lds;
    LAS float* ks = fs + 2048;
    LAS float* qs = ks + 2048;
    LAS float* vs = qs + 2048;
    LAS float* part = vs + 2048;
    const bf16* Q = (const bf16*)(a.ws + WS_SQ) - (size_t)MP * D; const bf16* Kb = (const bf16*)(a.ws + WS_SK) - (size_t)MP * D; const float* LOGF = (const float*)(a.ws + WS_SLOGF) - (size_t)MP * D;
    const bf16* V = (const bf16*)(a.ws + WS_V); const bf16* OG = (const bf16*)(a.ws + WS_OG); bf16* OA = (bf16*)(a.ws + WS_OA);
    const float* hg = a.in[13] + (size_t)l * DKV;
    const int v = c.tid & 127, kg = c.tid >> 7;
    float S[32];
#pragma unroll
    for (int i = 0; i < 32; ++i) S[i] = S0 ? S0[(size_t)(32 * kg + i) * DKV + v] : 0.f;
    for (int t0 = 0; t0 < ntok; t0 += 16) {
        const int nt = (ntok - t0) < 16 ? (ntok - t0) : 16;
        __syncthreads();
        { const int tt = c.tid >> 5, k4 = (c.tid & 31) * 4;
          if (tt < nt) { const size_t off = (size_t)(row0 + t0 + tt) * D + h * DKV + k4;
              const f32x4 lf = *(const f32x4*)(LOGF + off);
              *(LAS f32x4*)(fs + tt * 128 + k4) = (f32x4){expf(lf[0]), expf(lf[1]), expf(lf[2]), expf(lf[3])};
              *(LAS f32x4*)(ks + tt * 128 + k4) = ld_bf4(Kb + off);
              *(LAS f32x4*)(qs + tt * 128 + k4) = ld_bf4(Q + off);
              *(LAS f32x4*)(vs + tt * 128 + k4) = ld_bf4(V + off); } }
        __syncthreads();
        for (int tt = 0; tt < nt; ++tt) {
            const float vv = vs[tt * 128 + v]; float acc = 0.f;
#pragma unroll
            for (int i4 = 0; i4 < 8; ++i4) {
                const f32x4 f = *(const LAS f32x4*)(fs + tt * 128 + 32 * kg + 4 * i4), kk = *(const LAS f32x4*)(ks + tt * 128 + 32 * kg + 4 * i4), qq = *(const LAS f32x4*)(qs + tt * 128 + 32 * kg + 4 * i4);
#pragma unroll
                for (int j = 0; j < 4; ++j) { S[4 * i4 + j] = f[j] * S[4 * i4 + j] + kk[j] * vv; acc += S[4 * i4 + j] * qq[j]; }
            }
            part[(tt * 4 + kg) * 128 + v] = acc;
        }
        __syncthreads();
        { const int tt = c.tid >> 5, v4 = (c.tid & 31) * 4; const int tc = tt < nt ? tt : 0;
          const f32x4 o = *(const LAS f32x4*)(part + (tc * 4 + 0) * 128 + v4) + *(const LAS f32x4*)(part + (tc * 4 + 1) * 128 + v4)
                        + *(const LAS f32x4*)(part + (tc * 4 + 2) * 128 + v4) + *(const LAS f32x4*)(part + (tc * 4 + 3) * 128 + v4);
          float ss = (o[0] * o[0] + o[1] * o[1]) + (o[2] * o[2] + o[3] * o[3]);
          ss = half_sum(ss);
          const float rstd = 1.0f / sqrtf(ss * (1.0f / DKV) + EPS);
          if (tt < nt) { const size_t off = (size_t)(row0 + t0 + tt) * D + h * DKV + v4;
              st_bf4(OA + off, o * rstd * *(const f32x4*)(hg + v4) * ld_bf4(OG + off)); } }
    }
#pragma unroll
    for (int i = 0; i < 32; ++i) Sout[(size_t)(32 * kg + i) * DKV + v] = S[i];
    __syncthreads();
}


constexpr int HB_Q0 = 0, HB_K0 = 17408, HB_Q1 = 26112, HB_K1 = 34816, HB_KT0 = 43520, HB_KT1 = 53760, HB_VT = 64000, HB_AS = 82432, HB_ST = 91648, HB_VEC = 126464, HB_TOT = 128512, HB_SSQ = 130560;
constexpr int HS_Q = 272, HS_KT = 80, HS_VT = 144, HS_AS = 144;
static_assert(HB_SSQ + 2048 <= MISC_OFF && 64 * 132 * 4 <= HB_VEC - HB_ST, "hgrn lds");
__device__ __forceinline__ float exp_c(float x) { return __expf(fminf(x, 80.f)); }
__device__ __forceinline__ void hgrn_prep_phase(CArgs& a, Ctx& c) {
    LAS unsigned char* lds = c.lds;
    const int tid = c.tid, col = tid & 127, sg = tid >> 7;
    LAS float* VEC = (LAS float*)(lds + HB_VEC); LAS float* TOT = (LAS float*)(lds + HB_TOT);
    for (int it = c.wg; it < 2048; it += c.G) {
        unsigned char* bp = a.ws + WS_PREP + (size_t)it * PREP_BLK;
        const int pb = it >> 8, pn = (it >> 3) & 31, phh = it & 7;
        bf16* vslice = (bf16*)(a.ws + WS_V) + ((size_t)pb * SEQ + 64 * pn) * D + phh * DKV;
        float lf[16]; unsigned qr[16], kr[16], vr[16];
        { const int e0 = (16 * sg) * 128 + col;
#pragma unroll
          for (int i = 0; i < 16; ++i) { lf[i] = ((const float*)bp)[e0 + i * 128]; qr[i] = ((const bf16*)(bp + 32768))[e0 + i * 128]; kr[i] = ((const bf16*)(bp + 49152))[e0 + i * 128]; vr[i] = vslice[(size_t)(16 * sg + i) * D + col]; } }
        float g[16]; g[0] = lf[0];
#pragma unroll
        for (int i = 1; i < 16; ++i) g[i] = g[i - 1] + lf[i];
        __syncthreads();
        TOT[sg * 128 + col] = g[15];
        __syncthreads();
        {
            const float t0 = TOT[col], t1 = TOT[128 + col], t2 = TOT[256 + col], t3 = TOT[384 + col];
            const float off = (sg > 0 ? t0 : 0.f) + (sg > 1 ? t1 : 0.f) + (sg > 2 ? t2 : 0.f);
            const float r0 = t0, r1 = t0 + t1 + t2, last = r1 + t3;
            unsigned kt[8];
#pragma unroll
            for (int i = 0; i < 16; ++i) {
                const float G = g[i] + off, qv = bf2f(qr[i]), kv = bf2f(kr[i]);
                const int t = 16 * sg + i;
                *(LAS bf16*)(lds + HB_Q0 + t * HS_Q + col * 2) = (bf16)f2bf(qv * exp_c(G - r0));
                unsigned kb;
                if (sg < 2) { kb = f2bf(kv * exp_c(r0 - G)); *(LAS bf16*)(lds + HB_K0 + t * HS_Q + col * 2) = (bf16)kb; }
                else { kb = f2bf(kv * exp_c(r1 - G)); *(LAS bf16*)(lds + HB_K1 + (t - 32) * HS_Q + col * 2) = (bf16)kb;
                       *(LAS bf16*)(lds + HB_Q1 + (t - 32) * HS_Q + col * 2) = (bf16)f2bf(qv * exp_c(G - r1)); }
                if (i & 1) kt[i >> 1] |= kb << 16; else kt[i >> 1] = kb;
            }
            { LAS unsigned char* p = lds + (sg < 2 ? HB_KT0 : HB_KT1) + col * HS_KT + (sg & 1) * 32;
              *(LAS u32x4*)p = (u32x4){kt[0], kt[1], kt[2], kt[3]}; *(LAS u32x4*)(p + 16) = (u32x4){kt[4], kt[5], kt[6], kt[7]}; }
            VEC[sg * 128 + col] = exp_c(sg == 0 ? r0 : (sg == 1 ? last : (sg == 2 ? last - r0 : last - r1)));
            { LAS unsigned char* p = lds + HB_VT + col * HS_VT + sg * 32;
              *(LAS u32x4*)p = (u32x4){vr[0] | (vr[1] << 16), vr[2] | (vr[3] << 16), vr[4] | (vr[5] << 16), vr[6] | (vr[7] << 16)};
              *(LAS u32x4*)(p + 16) = (u32x4){vr[8] | (vr[9] << 16), vr[10] | (vr[11] << 16), vr[12] | (vr[13] << 16), vr[14] | (vr[15] << 16)}; }
        }
        __syncthreads();
#pragma unroll
        for (int i = 0; i < 2; ++i) { const int p = tid + 512 * i, row = p >> 4, pc = p & 15; *(u32x4*)(bp + row * 256 + pc * 16) = *(const LAS u32x4*)(lds + HB_Q0 + row * HS_Q + pc * 16); }
        { const int row = tid >> 4, pc = tid & 15;
          *(u32x4*)(bp + 16384 + row * 256 + pc * 16) = *(const LAS u32x4*)(lds + HB_K0 + row * HS_Q + pc * 16);
          *(u32x4*)(bp + 24576 + row * 256 + pc * 16) = *(const LAS u32x4*)(lds + HB_Q1 + row * HS_Q + pc * 16);
          *(u32x4*)(bp + 32768 + row * 256 + pc * 16) = *(const LAS u32x4*)(lds + HB_K1 + row * HS_Q + pc * 16); }
        { const int k = tid >> 2, pc = tid & 3;
          *(u32x4*)(bp + 40960 + k * 64 + pc * 16) = *(const LAS u32x4*)(lds + HB_KT0 + k * HS_KT + pc * 16);
          *(u32x4*)(bp + 49152 + k * 64 + pc * 16) = *(const LAS u32x4*)(lds + HB_KT1 + k * HS_KT + pc * 16); }
        if (tid < 128) *(u32x4*)(bp + 57344 + tid * 16) = *(const LAS u32x4*)(lds + HB_VEC + tid * 16);
#pragma unroll
        for (int i = 0; i < 2; ++i) { const int p = tid + 512 * i, v = p >> 3, pc = p & 7;
            *(u32x4*)((unsigned char*)(vslice + (size_t)(v >> 1) * D) + (v & 1) * 128 + pc * 16) = *(const LAS u32x4*)(lds + HB_VT + v * HS_VT + pc * 16); }
    }
    __syncthreads();
}

__device__ __forceinline__ void hgrn_fast_prompt(CArgs& a, Ctx& c, int l, int b, int h) {
    LAS unsigned char* lds = c.lds;
    const int tid = c.tid, lane = tid & 63, w = __builtin_amdgcn_readfirstlane(tid >> 6), fr = lane & 15, fq = lane >> 4;
    const int col = tid & 127, sg = tid >> 7;
    const bf16* V = (const bf16*)(a.ws + WS_V); const bf16* OG = (const bf16*)(a.ws + WS_OG); bf16* OA = (bf16*)(a.ws + WS_OA);
    const unsigned char* blk0 = a.ws + WS_PREP + ((size_t)b * 32 * 8 + h) * PREP_BLK;
    const size_t base = (size_t)b * SEQ * D + (size_t)h * DKV;
    LAS float* VEC = (LAS float*)(lds + HB_VEC); LAS float* SSQ = (LAS float*)(lds + HB_SSQ);
    LAS unsigned char* STw = lds + HB_ST + w * 4352;
    const float gv = a.in[13][(size_t)l * DKV + 16 * w + fr];
    f32x4 S[8];
#pragma unroll
    for (int i = 0; i < 8; ++i) S[i] = (f32x4){0.f, 0.f, 0.f, 0.f};
    __syncthreads();
    for (int e = tid; e < 2 * 16 * 16; e += 512) { const int which = e >> 8, r = (e >> 4) & 15, cc = e & 15;
        *(LAS bf16*)(lds + HB_AS + ((which ? 32 : 0) + r) * HS_AS + ((which ? 48 : 16) + cc) * 2) = 0; }
    const int prow = tid >> 4, ppc = tid & 15, pk = tid >> 2, pkc = tid & 3;
    const bf16* vt0 = (const bf16*)(a.ws + WS_V) + (size_t)b * SEQ * D + h * DKV;
    const int orow = tid >> 4, oc8 = (tid & 15) * 8;
    u32x4 im[10], ogv[2];
#define HG_LOAD(n_) do { const unsigned char* bp_ = blk0 + (size_t)(n_) * 8 * PREP_BLK; \
        im[0] = *(const u32x4*)(bp_ + prow * 256 + ppc * 16); im[1] = *(const u32x4*)(bp_ + (32 + prow) * 256 + ppc * 16); \
        im[2] = *(const u32x4*)(bp_ + 16384 + prow * 256 + ppc * 16); im[3] = *(const u32x4*)(bp_ + 24576 + prow * 256 + ppc * 16); im[4] = *(const u32x4*)(bp_ + 32768 + prow * 256 + ppc * 16); \
        im[5] = *(const u32x4*)(bp_ + 40960 + pk * 64 + pkc * 16); im[6] = *(const u32x4*)(bp_ + 49152 + pk * 64 + pkc * 16); \
        if (tid < 128) im[7] = *(const u32x4*)(bp_ + 57344 + tid * 16); \
        _Pragma("unroll") for (int i = 0; i < 2; ++i) { const int p_ = tid + 512 * i, v_ = p_ >> 3, pc_ = p_ & 7; \
            im[8 + i] = *(const u32x4*)((const unsigned char*)(vt0 + (size_t)(64 * (n_) + (v_ >> 1)) * D) + (v_ & 1) * 128 + pc_ * 16); } } while (0)
    HG_LOAD(0);
    unsigned long long tacc = 0ull, tst = 0ull;
#define TSTART(id) do { if (PROBE_T == (id)) { __builtin_amdgcn_sched_barrier(0); tst = __builtin_amdgcn_s_memtime(); __builtin_amdgcn_sched_barrier(0); } } while (0)
#define TSTOP(id) do { if (PROBE_T == (id)) { __builtin_amdgcn_sched_barrier(0); tacc += __builtin_amdgcn_s_memtime() - tst; __builtin_amdgcn_sched_barrier(0); } } while (0)
    for (int nn = 0; nn < (SEQ / 64) * (1 + (PROBE_MIX & 1)); ++nn) {
        const int n = nn & (SEQ / 64 - 1);
        if (PROBE_MIX & 1) { if (nn == SEQ / 64) {
#pragma unroll
            for (int i = 0; i < 8; ++i) S[i] = (f32x4){0.f, 0.f, 0.f, 0.f}; } }
        TSTART(1); TSTART(2);
        *(LAS u32x4*)(lds + HB_Q0 + prow * HS_Q + ppc * 16) = im[0]; *(LAS u32x4*)(lds + HB_Q0 + (32 + prow) * HS_Q + ppc * 16) = im[1];
        *(LAS u32x4*)(lds + HB_K0 + prow * HS_Q + ppc * 16) = im[2]; *(LAS u32x4*)(lds + HB_Q1 + prow * HS_Q + ppc * 16) = im[3]; *(LAS u32x4*)(lds + HB_K1 + prow * HS_Q + ppc * 16) = im[4];
        *(LAS u32x4*)(lds + HB_KT0 + pk * HS_KT + pkc * 16) = im[5]; *(LAS u32x4*)(lds + HB_KT1 + pk * HS_KT + pkc * 16) = im[6];
        if (tid < 128) *(LAS u32x4*)(lds + HB_VEC + tid * 16) = im[7];
#pragma unroll
        for (int i = 0; i < 2; ++i) { const int p = tid + 512 * i, v = p >> 3, pc = p & 7; *(LAS u32x4*)(lds + HB_VT + v * HS_VT + pc * 16) = im[8 + i]; }
        ogv[0] = *(const u32x4*)(OG + base + (size_t)(64 * n + orow) * D + oc8); ogv[1] = *(const u32x4*)(OG + base + (size_t)(64 * n + 32 + orow) * D + oc8);
        if ((PROBE_MIX & 1) || n + 1 < SEQ / 64) HG_LOAD((n + 1) & (SEQ / 64 - 1));
        WG_BAR();
        TSTOP(2); TSTART(3);
#pragma unroll
        for (int kt8 = 0; kt8 < 8; ++kt8) { const f32x4 er = *(const LAS f32x4*)(VEC + 16 * kt8 + 4 * fq);
            u32x2 pw; pw.x = pk2(S[kt8][0] * er[0], S[kt8][1] * er[1]); pw.y = pk2(S[kt8][2] * er[2], S[kt8][3] * er[3]);
            *(LAS u32x2*)(STw + fr * HS_Q + (16 * kt8 + 4 * fq) * 2) = pw; }
#pragma unroll
        for (int rep = 0; rep < 2; ++rep) {
            const int id = w + 8 * rep;
            if (id < 10) {
                int tt, st;
                if (id == 0) { tt = 0; st = 0; } else if (id < 7) { tt = (id + 1) >> 1; st = (id + 1) & 1; } else if (id == 7) { tt = 2; st = 2; } else { tt = 3; st = id - 6; }
                const LAS unsigned char* ap = (st < 2) ? lds + HB_Q0 + (16 * tt + fr) * HS_Q : lds + HB_Q1 + (16 * (tt - 2) + fr) * HS_Q;
                const LAS unsigned char* bp = (st < 2) ? lds + HB_K0 + (16 * st + fr) * HS_Q : lds + HB_K1 + (16 * (st - 2) + fr) * HS_Q;
                f32x4 acc = (f32x4){0.f, 0.f, 0.f, 0.f};
#pragma unroll
                for (int ks = 0; ks < 4; ++ks) acc = __builtin_amdgcn_mfma_f32_16x16x32_bf16(*(const LAS bf16x8*)(ap + (32 * ks + 8 * fq) * 2), *(const LAS bf16x8*)(bp + (32 * ks + 8 * fq) * 2), acc, 0, 0, 0);
#pragma unroll
                for (int j = 0; j < 4; ++j) { const float v_ = (tt == st && fr > 4 * fq + j) ? 0.f : acc[j];
                    *(LAS bf16*)(lds + HB_AS + (16 * tt + 4 * fq + j) * HS_AS + (16 * st + fr) * 2) = (bf16)f2bf(v_); }
            }
        }
        f32x4 o[4];
#pragma unroll
        for (int tt = 0; tt < 4; ++tt) o[tt] = (f32x4){0.f, 0.f, 0.f, 0.f};
#pragma unroll
        for (int ks = 0; ks < 4; ++ks) { const bf16x8 bfr = *(const LAS bf16x8*)(STw + fr * HS_Q + (32 * ks + 8 * fq) * 2);
#pragma unroll
            for (int tt = 0; tt < 4; ++tt) o[tt] = __builtin_amdgcn_mfma_f32_16x16x32_bf16(*(const LAS bf16x8*)(lds + HB_Q0 + (16 * tt + fr) * HS_Q + (32 * ks + 8 * fq) * 2), bfr, o[tt], 0, 0, 0); }
        WG_BAR();
        TSTOP(3); TSTART(4);
#pragma unroll
        for (int tt = 0; tt < 4; ++tt)
#pragma unroll
            for (int ks = 0; ks < 2; ++ks) if (ks == 0 || tt >= 2)
                o[tt] = __builtin_amdgcn_mfma_f32_16x16x32_bf16(*(const LAS bf16x8*)(lds + HB_AS + (16 * tt + fr) * HS_AS + (32 * ks + 8 * fq) * 2), *(const LAS bf16x8*)(lds + HB_VT + (16 * w + fr) * HS_VT + (32 * ks + 8 * fq) * 2), o[tt], 0, 0, 0);
#pragma unroll
        for (int tt = 0; tt < 4; ++tt)
#pragma unroll
            for (int j = 0; j < 4; ++j) { float p = o[tt][j] * o[tt][j];
                p = row16_sum(p);
                if (fr == 0) SSQ[w * 64 + 16 * tt + 4 * fq + j] = p; }
#pragma unroll
        for (int kt8 = 0; kt8 < 8; ++kt8) {
            const f32x4 z = (f32x4){0.f, 0.f, 0.f, 0.f};
            const f32x4 U0 = __builtin_amdgcn_mfma_f32_16x16x32_bf16(*(const LAS bf16x8*)(lds + HB_KT0 + (16 * kt8 + fr) * HS_KT + 8 * fq * 2), *(const LAS bf16x8*)(lds + HB_VT + (16 * w + fr) * HS_VT + 8 * fq * 2), z, 0, 0, 0);
            const f32x4 U1 = __builtin_amdgcn_mfma_f32_16x16x32_bf16(*(const LAS bf16x8*)(lds + HB_KT1 + (16 * kt8 + fr) * HS_KT + 8 * fq * 2), *(const LAS bf16x8*)(lds + HB_VT + (16 * w + fr) * HS_VT + (32 + 8 * fq) * 2), z, 0, 0, 0);
            const f32x4 eL = *(const LAS f32x4*)(VEC + 128 + 16 * kt8 + 4 * fq), eL0 = *(const LAS f32x4*)(VEC + 256 + 16 * kt8 + 4 * fq), eL1 = *(const LAS f32x4*)(VEC + 384 + 16 * kt8 + 4 * fq);
            S[kt8] = eL * S[kt8] + eL0 * U0 + eL1 * U1;
        }
        WG_BAR();
        TSTOP(4); TSTART(5);
        { LAS float* OUT = (LAS float*)(lds + HB_ST);
#pragma unroll
          for (int tt = 0; tt < 4; ++tt) {
              f32x4 ss = *(const LAS f32x4*)(SSQ + 16 * tt + 4 * fq);
#pragma unroll
              for (int ww = 1; ww < 8; ++ww) ss += *(const LAS f32x4*)(SSQ + ww * 64 + 16 * tt + 4 * fq);
#pragma unroll
              for (int j = 0; j < 4; ++j) OUT[(16 * tt + 4 * fq + j) * 132 + 16 * w + fr] = o[tt][j] * __builtin_amdgcn_rsqf(ss[j] * (1.0f / DKV) + EPS) * gv; }
          WG_BAR();
#pragma unroll
          for (int i = 0; i < 2; ++i) { const int t = orow + 32 * i;
              const f32x4 x0 = *(const LAS f32x4*)(OUT + t * 132 + oc8), x1 = *(const LAS f32x4*)(OUT + t * 132 + oc8 + 4);
              const u32x4 g_ = ogv[i];
              const f32x4 g0 = (f32x4){bf2f(g_.x & 0xffffu), bf2f(g_.x >> 16), bf2f(g_.y & 0xffffu), bf2f(g_.y >> 16)}, g1 = (f32x4){bf2f(g_.z & 0xffffu), bf2f(g_.z >> 16), bf2f(g_.w & 0xffffu), bf2f(g_.w >> 16)};
              st_bf8(OA + base + (size_t)(64 * n + t) * D + oc8, x0 * g0, x1 * g1); } }
        TSTOP(5); TSTOP(1);
    }
    if (PROBE_T && PROBE_T < 100 && l == 0 && c.wg == 0 && tid == 0) *(float*)(a.ws + WS_DBG) = (float)(tacc >> 5) * 1e-4f;
#undef HG_LOAD
    { float* Sout = a.out + O_HGP + (((size_t)l * NBATCH + b) * NH + h) * DKV * DKV;
#pragma unroll
      for (int kt8 = 0; kt8 < 8; ++kt8)
#pragma unroll
          for (int j = 0; j < 4; ++j) Sout[(size_t)(16 * kt8 + 4 * fq + j) * DKV + 16 * w + fr] = S[kt8][j]; }
    __syncthreads();
}

constexpr int L_XBS = 0, L_XC = 67 * 128, L_AS = L_XC + 8192, L_BS = L_AS + 8192, L_SEG = L_BS + 8192, L_CARRY = L_SEG + 1024;
constexpr int LB_XCB = (L_CARRY + 256) * 4, XCB_STRIDE = 272;
static_assert(LB_XCB + 64 * XCB_STRIDE <= MISC_OFF && LB_XCB % 16 == 0, "lru lds");
__device__ __forceinline__ void lru_gates_naive(CArgs& a, Ctx& c, int l, int n) {
    LAS float* XC = (LAS float*)c.lds + L_XC; LAS float* As = (LAS float*)c.lds + L_AS; LAS float* Bs = (LAS float*)c.lds + L_BS;
    const bf16* wl = (const bf16*)(a.ws + WS_W + (size_t)l * WL_STRIDE);
    const int e = c.tid & 127, tg = c.tid >> 7;
    const bf16* wa = wl + OFF_LWA / 2 + (size_t)(n * 128 + e) * 128; const bf16* wx = wl + OFF_LWX / 2 + (size_t)(n * 128 + e) * 128;
    const int ch = n * 128 + e;
    const float ba = a.in[17][(size_t)l * D + ch], bx = a.in[19][(size_t)l * D + ch], sp = ((const float*)(a.ws + WS_TAB + 32768))[l * D + ch];
#pragma unroll 1
    for (int tq = 0; tq < 4; ++tq) {
        float ra[4], ia[4];
#pragma unroll
        for (int i = 0; i < 4; ++i) { ra[i] = 0.f; ia[i] = 0.f; }
        const LAS float* xc = XC + (tg * 16 + tq * 4) * 128;
#pragma unroll 1
        for (int d0 = 0; d0 < 128; d0 += 8) {
            const f32x4 wa0 = ld_bf4(wa + d0), wa1 = ld_bf4(wa + d0 + 4), wx0 = ld_bf4(wx + d0), wx1 = ld_bf4(wx + d0 + 4);
#pragma unroll
            for (int tt = 0; tt < 4; ++tt) {
                const f32x4 x0 = *(const LAS f32x4*)(xc + tt * 128 + d0), x1 = *(const LAS f32x4*)(xc + tt * 128 + d0 + 4);
                ra[tt] += (x0[0] * wa0[0] + x0[1] * wa0[1]) + (x0[2] * wa0[2] + x0[3] * wa0[3]) + (x1[0] * wa1[0] + x1[1] * wa1[1]) + (x1[2] * wa1[2] + x1[3] * wa1[3]);
                ia[tt] += (x0[0] * wx0[0] + x0[1] * wx0[1]) + (x0[2] * wx0[2] + x0[3] * wx0[3]) + (x1[0] * wx1[0] + x1[1] * wx1[1]) + (x1[2] * wx1[2] + x1[3] * wx1[3]);
            }
        }
#pragma unroll
        for (int tt = 0; tt < 4; ++tt) {
            const int t = tg * 16 + tq * 4 + tt;
            const float r = sigmoidf_(ra[tt] + ba), ig = sigmoidf_(ia[tt] + bx);
            const float la = -8.0f * r * sp, aa = expf(la), mult = sqrtf(-expm1f(2.0f * la));
            As[t * 128 + e] = aa; Bs[t * 128 + e] = mult * ig * XC[t * 128 + e];
        }
    }
}
__device__ __forceinline__ void lru_gates_mfma(CArgs& a, Ctx& c, int l, int n) {
    LAS float* XC = (LAS float*)c.lds + L_XC; LAS float* As = (LAS float*)c.lds + L_AS; LAS float* Bs = (LAS float*)c.lds + L_BS;
    const bf16* wl = (const bf16*)(a.ws + WS_W + (size_t)l * WL_STRIDE);
    const int lane = c.tid & 63, w = __builtin_amdgcn_readfirstlane(c.tid >> 6), fr = lane & 15, fq = lane >> 4;
    const int e = 16 * w + fr, ch = n * 128 + e;
    const bf16* wa = wl + OFF_LWA / 2 + (size_t)(n * 128 + e) * 128 + 8 * fq; const bf16* wx = wl + OFF_LWX / 2 + (size_t)(n * 128 + e) * 128 + 8 * fq;
    bf16x8 Ba[4], Bx[4];
#pragma unroll
    for (int ks = 0; ks < 4; ++ks) { Ba[ks] = *(const bf16x8*)(wa + 32 * ks); Bx[ks] = *(const bf16x8*)(wx + 32 * ks); }
    const float ba = a.in[17][(size_t)l * D + ch], bx = a.in[19][(size_t)l * D + ch], sp = ((const float*)(a.ws + WS_TAB + 32768))[l * D + ch];
#pragma unroll
    for (int m = 0; m < 4; ++m) {
        f32x4 ar = (f32x4){0.f, 0.f, 0.f, 0.f}, ai = (f32x4){0.f, 0.f, 0.f, 0.f};
#pragma unroll
        for (int ks = 0; ks < 4; ++ks) {
            const bf16x8 af = *(const LAS bf16x8*)(c.lds + LB_XCB + (16 * m + fr) * XCB_STRIDE + (32 * ks + 8 * fq) * 2);
            ar = __builtin_amdgcn_mfma_f32_16x16x32_bf16(af, Ba[ks], ar, 0, 0, 0);
            ai = __builtin_amdgcn_mfma_f32_16x16x32_bf16(af, Bx[ks], ai, 0, 0, 0);
        }
#pragma unroll
        for (int j = 0; j < 4; ++j) {
            const int t = 16 * m + 4 * fq + j;
            const float r = sigmoidf_(ar[j] + ba), ig = sigmoidf_(ai[j] + bx);
            const float la = -8.0f * r * sp, aa = expf(la), mult = sqrtf(-expm1f(2.0f * la));
            As[t * 128 + e] = aa; Bs[t * 128 + e] = mult * ig * XC[t * 128 + e];
        }
    }
}
#if FAST_GATES
#define lru_gates lru_gates_mfma
#else
#define lru_gates lru_gates_naive
#endif

constexpr int LB_CW = LB_XCB + 64 * XCB_STRIDE;
static_assert(LB_CW + 2560 <= MISC_OFF, "lru lds");
__device__ __forceinline__ void lru_prompt_item(CArgs& a, Ctx& c, int l, int b, int n, int hc) {
    LAS float* L = (LAS float*)c.lds; LAS float* CW = (LAS float*)(c.lds + LB_CW);
    LAS float* As = L + L_AS; LAS float* Bs = L + L_BS; LAS float* SEG = L + L_SEG; LAS float* CAR = L + L_CARRY;
    const bf16* XB = (const bf16*)(a.ws + WS_XB); const bf16* YG = (const bf16*)(a.ws + WS_YG); bf16* OB = (bf16*)(a.ws + WS_OB);
    const int t_ld = c.tid >> 3, c0 = (c.tid & 7) * 16;
    const int cch = c.tid & 63, sg = c.tid >> 6;
    const int lane = c.tid & 63, w = __builtin_amdgcn_readfirstlane(c.tid >> 6), fr = lane & 15, fq = lane >> 4;
    const int ec = 16 * (w & 3) + fr, e = 64 * hc + ec, ch = n * 128 + e, m0 = 2 * (w >> 2);
    const int chs = n * 128 + 64 * hc + cch;
    __syncthreads();
    if (c.tid < 128) CAR[c.tid] = 0.f;
    if (c.tid < 384) L[L_XBS + c.tid] = 0.f;
    for (int i = c.tid; i < 640; i += 512) CW[i] = i < 512 ? a.in[14][(size_t)l * 4 * D + (i >> 7) * D + n * 128 + (i & 127)] : a.in[15][(size_t)l * D + n * 128 + (i - 512)];
    bf16x8 Ba[4], Bx[4];
    { const bf16* wl = (const bf16*)(a.ws + WS_W + (size_t)l * WL_STRIDE);
      const bf16* wa = wl + OFF_LWA / 2 + (size_t)(n * 128 + e) * 128 + 8 * fq; const bf16* wx = wl + OFF_LWX / 2 + (size_t)(n * 128 + e) * 128 + 8 * fq;
#pragma unroll
      for (int ks = 0; ks < 4; ++ks) { Ba[ks] = *(const bf16x8*)(wa + 32 * ks); Bx[ks] = *(const bf16x8*)(wx + 32 * ks); } }
    const float ba = a.in[17][(size_t)l * D + ch], bx = a.in[19][(size_t)l * D + ch], sp8 = -8.0f * ((const float*)(a.ws + WS_TAB + 32768))[l * D + ch];
    const bf16* xsrc = XB + (size_t)(b * SEQ + t_ld) * D + n * 128 + c0;
    u32x4 xr0 = *(const u32x4*)xsrc, xr1 = *(const u32x4*)(xsrc + 8);
    for (int t0 = 0; t0 < SEQ; t0 += 64) {
        const int par = (t0 >> 6) & 1;
        unsigned ygr[8];
        { const bf16* yp = YG + (size_t)(b * SEQ + t0 + sg * 8) * D + chs;
#pragma unroll
          for (int tt = 0; tt < 8; ++tt) ygr[tt] = yp[(size_t)tt * D]; }
        WG_BAR();
        { LAS float* dst = L + L_XBS + (3 + t_ld) * 128 + c0;
          *(LAS f32x4*)dst        = (f32x4){bf2f(xr0.x & 0xffffu), bf2f(xr0.x >> 16), bf2f(xr0.y & 0xffffu), bf2f(xr0.y >> 16)};
          *(LAS f32x4*)(dst + 4)  = (f32x4){bf2f(xr0.z & 0xffffu), bf2f(xr0.z >> 16), bf2f(xr0.w & 0xffffu), bf2f(xr0.w >> 16)};
          *(LAS f32x4*)(dst + 8)  = (f32x4){bf2f(xr1.x & 0xffffu), bf2f(xr1.x >> 16), bf2f(xr1.y & 0xffffu), bf2f(xr1.y >> 16)};
          *(LAS f32x4*)(dst + 12) = (f32x4){bf2f(xr1.z & 0xffffu), bf2f(xr1.z >> 16), bf2f(xr1.w & 0xffffu), bf2f(xr1.w >> 16)}; }
        if (t0 + 64 < SEQ) { xr0 = *(const u32x4*)(xsrc + (size_t)(t0 + 64) * D); xr1 = *(const u32x4*)(xsrc + (size_t)(t0 + 64) * D + 8); }
        WG_BAR();
#pragma unroll
        for (int j4 = 0; j4 < 4; ++j4) { const int cc = c0 + 4 * j4;
            f32x4 acc = *(const LAS f32x4*)(CW + 512 + cc);
#pragma unroll
            for (int j = 0; j < 4; ++j) acc += *(const LAS f32x4*)(CW + j * 128 + cc) * *(const LAS f32x4*)(L + L_XBS + (t_ld + j) * 128 + cc);
            *(LAS f32x4*)(L + L_XC + t_ld * 128 + cc) = acc;
            { u32x2 pw; pw.x = pk2(acc[0], acc[1]); pw.y = pk2(acc[2], acc[3]); *(LAS u32x2*)(c.lds + LB_XCB + t_ld * XCB_STRIDE + cc * 2) = pw; } }
        WG_BAR();
#pragma unroll
        for (int mm = 0; mm < 2; ++mm) {
            const int m = m0 + mm;
            f32x4 ar = (f32x4){0.f, 0.f, 0.f, 0.f}, ai = (f32x4){0.f, 0.f, 0.f, 0.f};
#pragma unroll
            for (int ks = 0; ks < 4; ++ks) {
                const bf16x8 af = *(const LAS bf16x8*)(c.lds + LB_XCB + (16 * m + fr) * XCB_STRIDE + (32 * ks + 8 * fq) * 2);
                ar = __builtin_amdgcn_mfma_f32_16x16x32_bf16(af, Ba[ks], ar, 0, 0, 0);
                ai = __builtin_amdgcn_mfma_f32_16x16x32_bf16(af, Bx[ks], ai, 0, 0, 0);
            }
#pragma unroll
            for (int j = 0; j < 4; ++j) {
                const int t = 16 * m + 4 * fq + j;
                const float r = sig_fast(ar[j] + ba), ig = sig_fast(ai[j] + bx);
                const float la = sp8 * r, x2 = 2.0f * la;
                const float em = x2 > -0.5f ? x2 * (1.0f + x2 * (0.5f + x2 * (0.16666667f + x2 * (0.041666668f + x2 * 0.0083333338f)))) : __expf(x2) - 1.0f;
                As[t * 64 + ec] = __expf(la); Bs[t * 64 + ec] = __builtin_amdgcn_sqrtf(-em) * ig * L[L_XC + t * 128 + e];
            }
        }
        WG_BAR();
        float P = 1.f, Bv = 0.f;
#pragma unroll
        for (int tt = 0; tt < 8; ++tt) { const float aa = As[(sg * 8 + tt) * 64 + cch], bb = Bs[(sg * 8 + tt) * 64 + cch]; Bv = aa * Bv + bb; P *= aa; }
        SEG[(sg * 64 + cch) * 2] = P; SEG[(sg * 64 + cch) * 2 + 1] = Bv;
        WG_BAR();
        float h = CAR[par * 64 + cch];
        for (int s2 = 0; s2 < sg; ++s2) h = SEG[(s2 * 64 + cch) * 2] * h + SEG[(s2 * 64 + cch) * 2 + 1];
        { bf16* op = OB + (size_t)(b * SEQ + t0 + sg * 8) * D + chs;
#pragma unroll
          for (int tt = 0; tt < 8; ++tt) { const int t = sg * 8 + tt;
              h = As[t * 64 + cch] * h + Bs[t * 64 + cch];
              op[(size_t)tt * D] = (bf16)f2bf(h * bf2f(ygr[tt])); } }
        if (sg == 7) CAR[(par ^ 1) * 64 + cch] = h;
        if (c.tid < 384) L[L_XBS + c.tid] = L[L_XBS + 64 * 128 + c.tid];
    }
    __syncthreads();
    if (c.tid < 64) a.out[O_LRP + ((size_t)l * NBATCH + b) * D + n * 128 + 64 * hc + c.tid] = CAR[c.tid];
    if (hc == 0 && c.tid < 384) a.out[O_CVP + (((size_t)l * NBATCH + b) * 3 + (c.tid >> 7)) * D + n * 128 + (c.tid & 127)] = L[L_XBS + c.tid];
    __syncthreads();
}
__device__ __forceinline__ void lru_sample_item(CArgs& a, Ctx& c, int l, int n, int hf) {
    LAS float* L = (LAS float*)c.lds;
    const bf16* XB = (const bf16*)(a.ws + WS_XB); const bf16* YG = (const bf16*)(a.ws + WS_YG); bf16* OB = (bf16*)(a.ws + WS_OB);
    const int t_ld = c.tid >> 3, c0 = (c.tid & 7) * 16;
    const float* cw = a.in[14] + (size_t)l * 4 * D + n * 128; const float* cb = a.in[15] + (size_t)l * D + n * 128;
    const int bs = hf * 64 + t_ld, row = MP + bs;
    const float* sc = a.in[4] + ((size_t)l * NS + bs) * 3 * D + n * 128;
    float* nc = a.out + O_CVS + ((size_t)l * NS + bs) * 3 * D + n * 128;
    __syncthreads();
#pragma unroll
    for (int j4 = 0; j4 < 4; ++j4) { const int cc = c0 + 4 * j4;
        const f32x4 x = ld_bf4(XB + (size_t)row * D + n * 128 + cc);
        const f32x4 s0 = *(const f32x4*)(sc + cc), s1 = *(const f32x4*)(sc + D + cc), s2 = *(const f32x4*)(sc + 2 * D + cc);
        const f32x4 acc = *(const f32x4*)(cb + cc) + *(const f32x4*)(cw + cc) * s0 + *(const f32x4*)(cw + D + cc) * s1 + *(const f32x4*)(cw + 2 * D + cc) * s2 + *(const f32x4*)(cw + 3 * D + cc) * x;
        *(LAS f32x4*)(L + L_XC + t_ld * 128 + cc) = acc;
        { u32x2 w; w.x = pk2(acc[0], acc[1]); w.y = pk2(acc[2], acc[3]); *(LAS u32x2*)(c.lds + LB_XCB + t_ld * XCB_STRIDE + cc * 2) = w; }
        *(f32x4*)(nc + cc) = s1; *(f32x4*)(nc + D + cc) = s2; *(f32x4*)(nc + 2 * D + cc) = x; }
    __syncthreads();
    lru_gates(a, c, l, n);
    __syncthreads();
    { const int cch = c.tid & 127, tg = c.tid >> 7;
#pragma unroll 4
      for (int tt = 0; tt < 16; ++tt) { const int t = tg * 16 + tt, b2 = hf * 64 + t; const size_t off = (size_t)(MP + b2) * D + n * 128 + cch;
          const float h0 = a.in[3][((size_t)l * NS + b2) * D + n * 128 + cch];
          const float h = L[L_AS + t * 128 + cch] * h0 + L[L_BS + t * 128 + cch];
          a.out[O_LRS + ((size_t)l * NS + b2) * D + n * 128 + cch] = h;
          OB[off] = (bf16)f2bf(h * bf2f(YG[off])); } }
    __syncthreads();
}

__device__ __forceinline__ void mixer_phase(CArgs& a, Ctx& c, int l) {
    if (c.wg < 64) {
        hgrn_fast_prompt(a, c, l, c.wg >> 3, c.wg & 7);
    } else if (c.wg < 192) {
        const int i = c.wg - 64;
        for (int rep = 0; rep < 1 + ((PROBE_MIX >> 1) & 1); ++rep) lru_prompt_item(a, c, l, i >> 4, (i >> 1) & 7, i & 1);
    } else {
        for (int rep = 0; rep < 1 + ((PROBE_MIX >> 2) & 1); ++rep)
        for (int it = c.wg - 192; it < NS * NH; it += c.G - 192) {
            const int bs = it >> 3, h = it & 7; const size_t so = (((size_t)l * NS + bs) * NH + h) * DKV * DKV;
            hgrn_naive(a, c, l, MP + bs, 1, h, a.in[2] + so, a.out + O_HGS + so);
        }
        if (c.wg - 192 < 16) lru_sample_item(a, c, l, (c.wg - 192) >> 1, (c.wg - 192) & 1);
    }
}

__global__ void __launch_bounds__(512, 2) mega_fwd(Args a0) {
    extern __shared__ __attribute__((aligned(16))) unsigned char lds_raw[];
    Ctx c; c.lds = (LAS unsigned char*)lds_raw; c.tid = threadIdx.x; c.G = gridDim.x; c.wg = blockIdx.x;
    volatile LAS unsigned* MISC = (volatile LAS unsigned*)(c.lds + MISC_OFF);
    if (c.tid < 32) MISC[c.tid] = 0u;
    __syncthreads();
    XcdBarrier bar; bar.bar = (unsigned*)(a0.ws + WS_CTL) + 1024; bar.x = 0; bar.st = nullptr;
    const int nprog = a0.nprog;
    if (nprog > 1) bar = xcd_barrier_post((unsigned*)(a0.ws + WS_CTL) + 1024, MISC + 8);

    for (int pi = 0; pi < nprog; ++pi) {
        CArgs* ap = (CArgs*)__builtin_amdgcn_kernarg_segment_ptr(); asm volatile("" : "+s"(ap));
        CArgs& a = *ap;
        const int ph = a.prog[pi];
        unsigned long long pt0 = 0ull; if (PROBE_T >= 100 && ph == PROBE_T - 100) pt0 = __builtin_amdgcn_s_memrealtime();
        { int t_ = threadIdx.x, w_ = blockIdx.x, g_ = gridDim.x; asm volatile("" : "+v"(t_), "+s"(w_), "+s"(g_)); c.tid = t_; c.wg = w_; c.G = g_; }
        float* X = a.out;
        if (ph == 0) { }
        else if (ph == NPHASE - 1) final_norm_phase(a, c);
        else {
            const int l = (ph - 1) / 9, j = (ph - 1) % 9;
            const bf16* wl = (const bf16*)(a.ws + WS_W + (size_t)l * WL_STRIDE);
            const float* xp = l == 0 ? a.in[0] : X; const float* xs = l == 0 ? a.in[1] : X + (size_t)MP * D;
            const float* modl = (const float*)(a.ws + WS_MOD) + (size_t)l * NMOD * 6144;
            bf16* H = (bf16*)(a.ws + WS_H);
            if (j == 0) norm_phase(a, c, l, 0, xp, xs);
            else if (j == 1) {
                EpiIn e{a.ws + WS_PREP, (bf16*)(a.ws + WS_SQ), (bf16*)(a.ws + WS_SK), (float*)(a.ws + WS_SLOGF), (bf16*)(a.ws + WS_V), (bf16*)(a.ws + WS_OG), (bf16*)(a.ws + WS_XB), (bf16*)(a.ws + WS_YG), (bf16*)(a.ws + WS_SGA), (bf16*)(a.ws + WS_SGB),
                        (const float*)(a.ws + WS_TAB) + (size_t)l * 3 * D, l == 0 ? 1 : 0};
                gemm_phase_sel<0>(c, H, wl + OFF_WIN / 2, MT, NIN, D, e);
            } else if (j == 2) hgrn_prep_phase(a, c);
            else if (j == 3) mixer_phase(a, c, l);
            else if (j == 4) {
                EpiBrA ea{(const bf16*)(a.ws + WS_SGA), (float*)(a.ws + WS_T)};
                gemm_phase_sel<1>(c, (const bf16*)(a.ws + WS_OA), wl + OFF_WA / 2, MT, D, D, ea);
                asm volatile("s_waitcnt vmcnt(0)" ::: "memory"); __syncthreads();
                { int t_ = threadIdx.x; asm volatile("" : "+v"(t_)); c.tid = t_; }
                EpiBrB eb{(const bf16*)(a.ws + WS_SGB), (const float*)(a.ws + WS_T), (bf16*)(a.ws + WS_MG)};
                gemm_phase_sel<2>(c, (const bf16*)(a.ws + WS_OB), wl + OFF_WB / 2, MT, D, D, eb);
            } else if (j == 5) {
                EpiRes e{xp, xs, X, modl, 2};
                gemm_phase_sel<3>(c, (const bf16*)(a.ws + WS_MG), wl + OFF_WO / 2, MT, D, D, e);
            } else if (j == 6) norm_phase(a, c, l, 1, X, X + (size_t)MP * D);
            else if (j == 7) { EpiFF1 e{(bf16*)(a.ws + WS_HM)}; gemm_phase_sel<4>(c, H, wl + OFF_W1 / 2, MT, FF, D, e); }
            else { float* XO = (l == 1 && XOUT_SCRATCH) ? (float*)(a.ws + WS_T) : X;
                   EpiRes e{X, X + (size_t)MP * D, XO, modl, 5}; gemm_phase_sel<5>(c, (const bf16*)(a.ws + WS_HM), wl + OFF_W2 / 2, MT, D, FF, e); }
        }
        if (ph == 0 || (ph == 4 && c.wg >= 192)) {
            { int t_ = threadIdx.x; asm volatile("" : "+v"(t_)); c.tid = t_; }
            p0_work(a, c, ph == 0 ? 0 : 1, ph == 0 ? c.wg : c.wg - 192, ph == 0 ? c.G : c.G - 192, ph == 0, ph == 0 ? 2 : 0);
        }
        if (pi + 1 < nprog) xcd_barrier(bar);
        if (PROBE_T >= 100 && ph == PROBE_T - 100 && c.wg == 0 && threadIdx.x == 0) *(float*)(a.ws + WS_DBG) = (float)(__builtin_amdgcn_s_memrealtime() - pt0) * 1e-4f;
    }
}

extern "C" void kernel_launch(void* const* d_in, const int* in_sizes, int n_in, void* d_out, int out_size, void* d_ws, size_t ws_size, hipStream_t stream) {
    static int grid = 0;
    if (grid == 0) {
        if (n_in != 27 || out_size != (int)O_END || ws_size < WS_END) { fprintf(stderr, "kernel_launch: unexpected shapes (n_in %d out %d ws %zu)\n", n_in, out_size, ws_size); grid = -1; return; }
        int dev = 0, cus = 0, per_cu = 0;
        if (hipGetDevice(&dev) != hipSuccess || hipDeviceGetAttribute(&cus, hipDeviceAttributeMultiprocessorCount, dev) != hipSuccess) { grid = -1; return; }
        if (hipFuncSetAttribute((const void*)mega_fwd, hipFuncAttributeMaxDynamicSharedMemorySize, LDS_BYTES) != hipSuccess) { fprintf(stderr, "kernel_launch: hipFuncSetAttribute failed\n"); grid = -1; return; }
        if (hipOccupancyMaxActiveBlocksPerMultiprocessor(&per_cu, (const void*)mega_fwd, 512, LDS_BYTES) != hipSuccess || per_cu < 1) { fprintf(stderr, "kernel_launch: occupancy query failed (%d)\n", per_cu); (void)hipGetLastError(); per_cu = 1; }
        grid = cus * (per_cu < 1 ? 1 : 1);
        fprintf(stderr, "kernel_launch: cus %d per_cu %d grid %d\n", cus, per_cu, grid);
    }
    if (grid < 0) return;
    (void)hipMemsetAsync((char*)d_ws + WS_CTL, 0, CTL_BYTES, stream);
    Args a{};
    for (int i = 0; i < 27; ++i) a.in[i] = (const float*)d_in[i];
    a.out = (float*)d_out; a.ws = (unsigned char*)d_ws;
    unsigned char prog[60]; int np = 0;
    for (int ph = 0; ph < NPHASE; ++ph) for (int rep = 0; rep < 1 + (int)(((unsigned)PROBE_REPEAT >> ph) & 1u); ++rep) prog[np++] = (unsigned char)ph;
#if ONE_LAUNCH
    a.nprog = np; for (int i = 0; i < np; ++i) a.prog[i] = prog[i];
    void* kargs[] = {&a};
    hipError_t e = hipLaunchCooperativeKernel((const void*)mega_fwd, dim3(grid), dim3(512), kargs, LDS_BYTES, stream);
    if (e != hipSuccess) fprintf(stderr, "kernel_launch: cooperative launch failed: %s (grid %d)\n", hipGetErrorString(e), grid);
#else
    for (int i = 0; i < np; ++i) { a.nprog = 1; a.prog[0] = prog[i]; hipLaunchKernelGGL(mega_fwd, dim3(grid), dim3(512), LDS_BYTES, stream, a); }
#endif
}
```

```cpp
#include <hip/hip_runtime.h>
#include <cstdio>
#include <cstdint>

#ifndef FAST_GEMM
#define FAST_GEMM 63
#endif
#ifndef FAST_HGRN
#define FAST_HGRN 1
#endif
#ifndef FAST_GATES
#define FAST_GATES 1
#endif
#ifndef DBG_SHFL
#define DBG_SHFL 1
#endif
#ifndef PROBE_REPEAT
#define PROBE_REPEAT 0
#endif
#ifndef PROBE_MIX
#define PROBE_MIX 0
#endif
#ifndef PROBE_P0
#define PROBE_P0 0
#endif
#ifndef XOUT_SCRATCH
#define XOUT_SCRATCH 0
#endif
#ifndef PROBE_T
#define PROBE_T 0
#endif
#ifndef ONE_LAUNCH
#define ONE_LAUNCH 1
#endif

#define LAS __attribute__((address_space(3)))
#define GAS __attribute__((address_space(1)))
typedef unsigned short bf16;
typedef float f32x4 __attribute__((ext_vector_type(4)));
typedef float f32x2 __attribute__((ext_vector_type(2)));
typedef short bf16x8 __attribute__((ext_vector_type(8)));
typedef unsigned u32x4 __attribute__((ext_vector_type(4)));
typedef unsigned u32x2 __attribute__((ext_vector_type(2)));

constexpr int D = 1024, NBATCH = 8, SEQ = 2048, MP = NBATCH * SEQ, NS = 128, MR = MP + NS, MT = 16640;
constexpr int NMOD = NBATCH + NS;
constexpr int NIN = 8192, FF = 4096, NH = 8, DKV = 128;
constexpr float EPS = 1e-6f;
constexpr int NPHASE = 20;

constexpr size_t MiB = (size_t)1 << 20;
constexpr size_t WS_CTL = 0, CTL_BYTES = 64 * 1024;
constexpr size_t WS_DBG = 512 * 1024;
constexpr size_t WS_TAB = 1 * MiB;
constexpr size_t WS_MOD = 2 * MiB;
constexpr size_t WS_W = 9 * MiB, WL_STRIDE = 77 * MiB / 2;
constexpr size_t OFF_WIN = 0, OFF_WA = 16 * MiB, OFF_WB = 18 * MiB, OFF_WO = 20 * MiB, OFF_W1 = 22 * MiB, OFF_W2 = 30 * MiB, OFF_LWA = 38 * MiB, OFF_LWX = 38 * MiB + 256 * 1024;
constexpr size_t WS_H = 86 * MiB;
constexpr size_t WS_PREP = 119 * MiB;
constexpr size_t PREP_BLK = 65536;
constexpr size_t WS_V = 247 * MiB, WS_OG = 280 * MiB, WS_XB = 313 * MiB, WS_YG = 346 * MiB, WS_SGA = 379 * MiB, WS_SGB = 412 * MiB;
constexpr size_t WS_OA = 445 * MiB;
constexpr size_t WS_SQ = 478 * MiB, WS_SK = WS_SQ + 256 * 1024, WS_SLOGF = WS_SQ + 512 * 1024;
constexpr size_t WS_OB = WS_H;
constexpr size_t WS_T = WS_PREP;
constexpr size_t WS_MG = WS_PREP + 66 * MiB;
constexpr size_t WS_HM = WS_PREP;
constexpr size_t WS_END = 480 * MiB;
static_assert(WS_W + 2 * WL_STRIDE <= WS_H && WS_H + (size_t)MT * D * 2 <= WS_PREP && WS_PREP + 2048 * PREP_BLK <= WS_V && WS_T + (size_t)MT * D * 4 <= WS_MG && WS_MG + (size_t)MT * D * 2 <= WS_V
              && WS_HM + (size_t)MT * FF * 2 <= WS_OG && WS_OA + (size_t)MT * D * 2 <= WS_SQ && WS_SLOGF + 512 * 1024 <= WS_END, "ws map");

constexpr size_t O_YP = 0, O_YS = (size_t)MP * D, O_HGP = O_YS + (size_t)NS * D, O_LRP = O_HGP + (size_t)2 * NBATCH * NH * DKV * DKV, O_CVP = O_LRP + (size_t)2 * NBATCH * D,
                 O_HGS = O_CVP + (size_t)2 * NBATCH * 3 * D, O_LRS = O_HGS + (size_t)2 * NS * NH * DKV * DKV, O_CVS = O_LRS + (size_t)2 * NS * D, O_END = O_CVS + (size_t)2 * NS * 3 * D;
static_assert(O_END == 53673984, "out map");

constexpr int LDS_BYTES = 163840;
constexpr int MISC_OFF = 158 * 1024;

typedef __bf16 bf16x2_t __attribute__((ext_vector_type(2)));
__device__ __forceinline__ unsigned f2bf(float f) { return (unsigned)__builtin_bit_cast(unsigned short, (__bf16)f); }
__device__ __forceinline__ unsigned pk2(float lo, float hi) { return __builtin_bit_cast(unsigned, __builtin_convertvector((f32x2){lo, hi}, bf16x2_t)); }
__device__ __forceinline__ float bf2f(unsigned b) { return __builtin_bit_cast(float, b << 16); }
__device__ __forceinline__ f32x4 ld_bf4(const bf16* p) { const u32x2 w = *(const u32x2*)p; return (f32x4){bf2f(w.x & 0xffffu), bf2f(w.x >> 16), bf2f(w.y & 0xffffu), bf2f(w.y >> 16)}; }
__device__ __forceinline__ void st_bf4(bf16* p, f32x4 v) { u32x2 w; w.x = pk2(v[0], v[1]); w.y = pk2(v[2], v[3]); *(u32x2*)p = w; }
#define WG_BAR() do { asm volatile("s_waitcnt lgkmcnt(0)" ::: "memory"); __builtin_amdgcn_s_barrier(); asm volatile("" ::: "memory"); } while (0)
__device__ __forceinline__ float sig_fast(float x) { return __builtin_amdgcn_rcpf(1.0f + __expf(-x)); }
__device__ __forceinline__ void st_bf8(bf16* p, f32x4 v0, f32x4 v1) { u32x4 w; w.x = pk2(v0[0], v0[1]); w.y = pk2(v0[2], v0[3]); w.z = pk2(v1[0], v1[1]); w.w = pk2(v1[2], v1[3]); *(u32x4*)p = w; }
__device__ __forceinline__ void ld_bf8(const bf16* p, f32x4& v0, f32x4& v1) { const u32x4 w = *(const u32x4*)p; v0 = (f32x4){bf2f(w.x & 0xffffu), bf2f(w.x >> 16), bf2f(w.y & 0xffffu), bf2f(w.y >> 16)}; v1 = (f32x4){bf2f(w.z & 0xffffu), bf2f(w.z >> 16), bf2f(w.w & 0xffffu), bf2f(w.w >> 16)}; }
__device__ __forceinline__ float sigmoidf_(float x) { return 1.0f / (1.0f + __expf(-x)); }
__device__ __forceinline__ float siluf_(float x) { return x * sigmoidf_(x); }
__device__ __forceinline__ float gelu_tanh_(float x) { const float u = 0.7978845608028654f * (x + 0.044715f * x * x * x); return x * sigmoidf_(2.0f * u); }
__device__ __forceinline__ float softplusf_(float x) { return fmaxf(x, 0.f) + log1pf(expf(-fabsf(x))); }
template <int XM> __device__ __forceinline__ float swz_xor(float v) { return __builtin_bit_cast(float, __builtin_amdgcn_ds_swizzle(__builtin_bit_cast(int, v), (XM << 10) | 0x1f)); }
__device__ __forceinline__ int lane_id_fresh() { int l = (int)__builtin_amdgcn_mbcnt_hi(~0u, __builtin_amdgcn_mbcnt_lo(~0u, 0u)); asm volatile("" : "+v"(l)); return l; }
__device__ __forceinline__ float xchg(float v, int l, int m) { return __builtin_bit_cast(float, __builtin_amdgcn_ds_bpermute((l ^ m) << 2, __builtin_bit_cast(int, v))); }
template <int CTRL> __device__ __forceinline__ float dpp_f(float v) { return __builtin_bit_cast(float, __builtin_amdgcn_update_dpp(0, __builtin_bit_cast(int, v), CTRL, 0xf, 0xf, false)); }
__device__ __forceinline__ float row16_sum(float v) { v += dpp_f<0xB1>(v); v += dpp_f<0x4E>(v); v += dpp_f<0x141>(v); v += dpp_f<0x140>(v); return v; }
__device__ __forceinline__ float half_sum(float v) { const int l = lane_id_fresh(); v += xchg(v, l, 1); v += xchg(v, l, 2); v += xchg(v, l, 4); v += xchg(v, l, 8); v += xchg(v, l, 16); return v; }
__device__ __forceinline__ float wave_sum(float v) { const int l = lane_id_fresh(); v += xchg(v, l, 1); v += xchg(v, l, 2); v += xchg(v, l, 4); v += xchg(v, l, 8); v += xchg(v, l, 16); v += xchg(v, l, 32); return v; }
__device__ __forceinline__ int mod_row(int row) { return row < MP ? (row >> 11) : (NBATCH + row - MP); }

struct Args { const float* in[27]; float* out; unsigned char* ws; int nprog; unsigned char prog[60]; };
typedef const __attribute__((address_space(4))) Args CArgs;
struct Ctx { LAS unsigned char* lds; int tid, G, wg; };
namespace pg8 {
#define PG8_LAS __attribute__((address_space(3)))
typedef unsigned short bf16_t;
typedef short bf16x8 __attribute__((ext_vector_type(8)));
typedef float f32x4 __attribute__((ext_vector_type(4)));
typedef unsigned u32x4 __attribute__((ext_vector_type(4)));
constexpr int BM = 256, BK = 64, HALF = 128, HTB = HALF * BK * 2  , STAGE_BYTES = 8 * HTB, NXCD = 8, WGM = 8;

__host__ __device__ __forceinline__ int lds_byte(int r, int c) { const int st = (r >> 4) * 2 + (c >> 5), rr = r & 15, cc = c & 31, ob = rr * 64 + cc * 2; return st * 1024 + (ob ^ (((ob >> 9) & 1) << 5)); }
__host__ __device__ __forceinline__ void stage_rc(int b, int& R, int& C) { const int st = b / 1024, sb = b % 1024, swz = sb ^ (((sb >> 9) & 1) << 5); R = (st >> 1) * 16 + swz / 64; C = (st & 1) * 32 + (swz % 64) / 2; }
__host__ __device__ __forceinline__ int perm32(int rho) { const int n = rho >> 4, i = rho & 15; return 8 * (i >> 2) + 4 * n + (i & 3); }

struct Unit { int pm, pn; };
struct Gemm { const bf16_t* A; const bf16_t* Bt; int M, N, K; };

struct StaticOrder {
    int nM, nN, nwg, G, c;
    __host__ __device__ void init(int M, int N, int G_, int c_) { nM = M / BM; nN = N / BM; nwg = nM * nN; G = G_; c = c_; }
    __host__ __device__ bool next(int i, Unit& u) const {
        const long L = (long)i * G + c; if (L >= nwg) return false;
        int wgid = (int)L; { const int q = nwg / NXCD, r = nwg % NXCD, xcd = wgid % NXCD, off = wgid / NXCD; wgid = (xcd < r ? xcd * (q + 1) : r * (q + 1) + (xcd - r) * q) + off; }
        const int nig = WGM * nN, gid = wgid / nig, fm = gid * WGM, gsz = (nM - fm) < WGM ? (nM - fm) : WGM;
        u.pm = fm + ((wgid % nig) % gsz); u.pn = (wgid % nig) / gsz; return true;
    }
    __device__ __forceinline__ void a_ready(const Unit&) const {}
    __device__ __forceinline__ void done(const Unit&) const {}
};
template <class Epi, class Sched, bool ALIGN_EPI = false, bool SP2 = false>
__device__ __forceinline__ void gemm_phase(PG8_LAS unsigned char* lds, const Gemm g, const Sched& S, const Epi& E, const int tid_in) {
    const int tid = tid_in, wid = __builtin_amdgcn_readfirstlane(tid >> 6), lane = tid & 63, wr = wid >> 2, wc = wid & 3, fr = lane & 15, fq = lane >> 4;
    const int K = g.K, nt = K / BK;
    unsigned voffA[2], voffB[2];
#pragma unroll
    for (int i = 0; i < 2; ++i) { int R, C; stage_rc(tid * 16 + i * 8192, R, C); const int Rb = Epi::PERM ? ((R & ~31) + perm32(R & 31)) : R;
        voffA[i] = (unsigned)(R * K + C) * 2u; voffB[i] = (unsigned)(Rb * K + C) * 2u; }
    const size_t kstep = (size_t)(BK * 2);
    const size_t hstep = (size_t)HALF * K * 2;
    const size_t tstep = 2 * hstep;
    const unsigned ldsw = (unsigned)wid * 1024u;
    const int aoff = lds_byte(wr * 64 + fr, fq * 8), boff = lds_byte(wc * 32 + fr, fq * 8);
#define PG8_SA(b, h) (((b) * 2 + (h)) * HTB)
#define PG8_SB(b, h) ((4 + (b) * 2 + (h)) * HTB)
#define PG8_STAGE(bufoff, gbase, voff) do { _Pragma("unroll") for (int _i = 0; _i < 2; ++_i) \
        __builtin_amdgcn_global_load_lds((const unsigned*)((const char*)(gbase) + (voff)[_i]), (PG8_LAS unsigned*)(lds + (bufoff) + ldsw + _i * 8192), 16, 0, 0); } while (0)
#define PG8_LDA(dst, b, h) do { _Pragma("unroll") for (int m = 0; m < 4; ++m) _Pragma("unroll") for (int k = 0; k < 2; ++k) dst[m][k] = *(const PG8_LAS bf16x8*)(lds + PG8_SA(b, h) + aoff + m * 2048 + k * 1024); } while (0)
#define PG8_LDB(dst, b, h) do { _Pragma("unroll") for (int n = 0; n < 2; ++n) _Pragma("unroll") for (int k = 0; k < 2; ++k) dst[n][k] = *(const PG8_LAS bf16x8*)(lds + PG8_SB(b, h) + boff + n * 2048 + k * 1024); } while (0)
#define PG8_MMA(ai, bj, At, Bt) do { __builtin_amdgcn_s_setprio(1); _Pragma("unroll") for (int m = 0; m < 4; ++m) _Pragma("unroll") for (int n = 0; n < 2; ++n) _Pragma("unroll") for (int k = 0; k < 2; ++k) \
        acc[ai][bj][m][n] = __builtin_amdgcn_mfma_f32_16x16x32_bf16(Bt[n][k], At[m][k], acc[ai][bj][m][n], 0, 0, 0); __builtin_amdgcn_s_setprio(0); } while (0)
#define PG8_WAIT_V(n) asm volatile("s_waitcnt vmcnt(" #n ")" ::: "memory")
#define PG8_WAIT_L(n) asm volatile("s_waitcnt lgkmcnt(" #n ")" ::: "memory")
#define PG8_BAR __builtin_amdgcn_s_barrier()
#define PG8_SCHED __builtin_amdgcn_sched_barrier(0)
    Unit cur, nxt; int ui = 0;
    if (!S.next(0, cur)) return;
    f32x4 acc[2][2][4][2];
#pragma unroll
    for (int a = 0; a < 2; ++a)
#pragma unroll
        for (int b = 0; b < 2; ++b)
#pragma unroll
            for (int m = 0; m < 4; ++m)
#pragma unroll
                for (int n = 0; n < 2; ++n) acc[a][b][m][n] = (f32x4){0.f, 0.f, 0.f, 0.f};
    bf16x8 At[4][2], B0[2][2], B1[2][2];
    const char* cA = (const char*)g.A + (size_t)cur.pm * tstep; const char* cB = (const char*)g.Bt + (size_t)cur.pn * tstep;
    S.a_ready(cur);
    if constexpr (SP2) {
        PG8_STAGE(PG8_SB(0, 0), cB, voffB); PG8_STAGE(PG8_SB(0, 1), cB + hstep, voffB); PG8_STAGE(PG8_SA(0, 0), cA, voffA); PG8_STAGE(PG8_SA(0, 1), cA + hstep, voffA);
        if (wr == 1) PG8_BAR;
        PG8_WAIT_V(2); PG8_BAR;
        PG8_STAGE(PG8_SB(1, 0), cB + kstep, voffB); PG8_STAGE(PG8_SA(1, 0), cA + kstep, voffA); PG8_STAGE(PG8_SB(1, 1), cB + hstep + kstep, voffB);
        PG8_WAIT_V(6); PG8_BAR;
    } else {
        PG8_STAGE(PG8_SB(0, 0), cB, voffB); PG8_STAGE(PG8_SA(0, 0), cA, voffA); PG8_STAGE(PG8_SB(0, 1), cB + hstep, voffB); PG8_STAGE(PG8_SA(0, 1), cA + hstep, voffA);
        if (wr == 1) PG8_BAR;
        PG8_WAIT_V(4); PG8_BAR;
        PG8_STAGE(PG8_SB(1, 0), cB + kstep, voffB); PG8_STAGE(PG8_SA(1, 0), cA + kstep, voffA); PG8_STAGE(PG8_SB(1, 1), cB + hstep + kstep, voffB);
        PG8_WAIT_V(6); PG8_BAR;
    }
    for (;;) {
        const bool has_next = S.next(ui + 1, nxt);
        const char* nA = has_next ? (const char*)g.A + (size_t)nxt.pm * tstep : cA; const char* nB = has_next ? (const char*)g.Bt + (size_t)nxt.pn * tstep : cB;
        for (int t = 0; t < nt; t += 2) {
            const bool last = (t == nt - 2);
            const char* a1 = cA + (size_t)(t + 1) * kstep;
            const char* a2 = last ? nA : cA + (size_t)(t + 2) * kstep; const char* b2 = last ? nB : cB + (size_t)(t + 2) * kstep;
            const char* a3 = a2 + kstep; const char* b3 = b2 + kstep;
            if (last && has_next) S.a_ready(nxt);
            if constexpr (SP2) {
            PG8_LDB(B0, 0, 0); PG8_LDB(B1, 0, 1); PG8_SCHED; PG8_LDA(At, 0, 0); PG8_STAGE(PG8_SA(1, 1), a1 + hstep, voffA);
            PG8_WAIT_V(8); PG8_WAIT_L(0); PG8_BAR; PG8_MMA(0, 0, At, B0); PG8_MMA(0, 1, At, B1); PG8_BAR; PG8_SCHED;
            PG8_LDA(At, 0, 1); PG8_STAGE(PG8_SB(0, 0), b2, voffB); PG8_STAGE(PG8_SB(0, 1), b2 + hstep, voffB); PG8_STAGE(PG8_SA(0, 0), a2, voffA);
            PG8_WAIT_V(8); PG8_WAIT_L(0); PG8_BAR; PG8_MMA(1, 0, At, B0); PG8_MMA(1, 1, At, B1); PG8_BAR; PG8_SCHED;
            PG8_LDB(B0, 1, 0); PG8_LDB(B1, 1, 1); PG8_SCHED; PG8_LDA(At, 1, 0); PG8_STAGE(PG8_SA(0, 1), a2 + hstep, voffA);
            PG8_WAIT_V(8); PG8_WAIT_L(0); PG8_BAR; PG8_MMA(0, 0, At, B0); PG8_MMA(0, 1, At, B1); PG8_BAR; PG8_SCHED;
            PG8_LDA(At, 1, 1); PG8_STAGE(PG8_SB(1, 0), b3, voffB); PG8_STAGE(PG8_SB(1, 1), b3 + hstep, voffB); PG8_STAGE(PG8_SA(1, 0), a3, voffA);
            PG8_WAIT_V(8); PG8_WAIT_L(0); PG8_BAR; PG8_MMA(1, 0, At, B0); PG8_MMA(1, 1, At, B1); PG8_BAR; PG8_SCHED;
            } else {
            PG8_LDB(B0, 0, 0); PG8_SCHED; PG8_LDA(At, 0, 0); PG8_STAGE(PG8_SA(1, 1), a1 + hstep, voffA);
            PG8_WAIT_L(8); PG8_BAR; PG8_WAIT_L(0); PG8_MMA(0, 0, At, B0); PG8_BAR; PG8_SCHED;
            PG8_LDB(B1, 0, 1); PG8_STAGE(PG8_SB(0, 0), b2, voffB);
            PG8_BAR; PG8_WAIT_L(0); PG8_MMA(0, 1, At, B1); PG8_BAR;
            PG8_LDA(At, 0, 1); PG8_STAGE(PG8_SA(0, 0), a2, voffA);
            PG8_BAR; PG8_WAIT_L(0); PG8_MMA(1, 0, At, B0); PG8_BAR; PG8_SCHED;
            PG8_STAGE(PG8_SB(0, 1), b2 + hstep, voffB);
            PG8_WAIT_V(6); PG8_BAR; PG8_MMA(1, 1, At, B1); PG8_BAR;
            PG8_LDB(B0, 1, 0); PG8_SCHED; PG8_LDA(At, 1, 0); PG8_STAGE(PG8_SA(0, 1), a2 + hstep, voffA);
            PG8_WAIT_L(8); PG8_BAR; PG8_WAIT_L(0); PG8_MMA(0, 0, At, B0); PG8_BAR; PG8_SCHED;
            PG8_LDB(B1, 1, 1); PG8_STAGE(PG8_SB(1, 0), b3, voffB);
            PG8_BAR; PG8_WAIT_L(0); PG8_MMA(0, 1, At, B1); PG8_BAR;
            PG8_LDA(At, 1, 1); PG8_STAGE(PG8_SA(1, 0), a3, voffA);
            PG8_BAR; PG8_WAIT_L(0); PG8_MMA(1, 0, At, B0); PG8_BAR; PG8_SCHED;
            PG8_STAGE(PG8_SB(1, 1), b3 + hstep, voffB);
            PG8_WAIT_V(6); PG8_BAR; PG8_MMA(1, 1, At, B1); PG8_BAR;
            }
        }
        if constexpr (ALIGN_EPI) { if (wr == 0) PG8_BAR; }
        if constexpr (!Epi::AFTER_DRAIN) { int l2 = (int)__builtin_amdgcn_mbcnt_hi(~0u, __builtin_amdgcn_mbcnt_lo(~0u, 0u)); asm volatile("" : "+v"(l2));
            E(acc, cur, wr, wc, l2 & 15, l2 >> 4); S.done(cur); }
        if (!has_next) break;
#pragma unroll
        for (int a = 0; a < 2; ++a)
#pragma unroll
            for (int b = 0; b < 2; ++b)
#pragma unroll
                for (int m = 0; m < 4; ++m)
#pragma unroll
                    for (int n = 0; n < 2; ++n) acc[a][b][m][n] = (f32x4){0.f, 0.f, 0.f, 0.f};
        cur = nxt; cA = nA; cB = nB; ++ui;
        if constexpr (ALIGN_EPI) { if (wr == 1) PG8_BAR; }
    }
    PG8_WAIT_V(0);
    if constexpr (!ALIGN_EPI) { if (wr == 0) PG8_BAR; }
    PG8_BAR;
    if constexpr (Epi::AFTER_DRAIN) { E.fused(acc, cur, wr, wc, fr, fq, lds, wid, lane); S.done(cur); }
#undef PG8_SA
#undef PG8_SB
#undef PG8_STAGE
#undef PG8_LDA
#undef PG8_LDB
#undef PG8_MMA
#undef PG8_WAIT_V
#undef PG8_WAIT_L
#undef PG8_BAR
#undef PG8_SCHED
}
}

template <class E> struct QuadEpi {
    static constexpr bool PERM = false, AFTER_DRAIN = false;
    E e;
    __device__ __forceinline__ void operator()(const f32x4 (&acc)[2][2][4][2], const pg8::Unit& u, int wr, int wc, int fr, int fq) const {
        const int row0 = u.pm * 256 + wr * 64 + fr, col0 = u.pn * 256 + wc * 32 + 4 * fq;
#pragma unroll
        for (int ai = 0; ai < 2; ++ai)
#pragma unroll
            for (int m = 0; m < 4; ++m)
#pragma unroll
                for (int bj = 0; bj < 2; ++bj)
#pragma unroll
                    for (int n = 0; n < 2; ++n) e.quad(row0 + ai * 128 + m * 16, col0 + bj * 128 + n * 16, acc[ai][bj][m][n]);
    }
};

struct EpiIn {
    unsigned char* PREP; bf16 *SQ, *SK; float* SLOGF; bf16 *V, *OG, *XB, *YG, *SGA, *SGB; const float* lbt; int lb0;
    static constexpr bool BY_REGION = true;
    __device__ __forceinline__ size_t blk_off(int row, int cc) const { return (((size_t)(row >> 11) * 32 + ((row >> 6) & 31)) * 8 + (cc >> 7)) * PREP_BLK; }
    __device__ __forceinline__ bf16* q_ptr(int row, int cc) const { return row < MP ? (bf16*)(PREP + blk_off(row, cc) + 32768) + (row & 63) * 128 + (cc & 127) : SQ + (size_t)(row - MP) * D + cc; }
    __device__ __forceinline__ bf16* k_ptr(int row, int cc) const { return row < MP ? (bf16*)(PREP + blk_off(row, cc) + 49152) + (row & 63) * 128 + (cc & 127) : SK + (size_t)(row - MP) * D + cc; }
    __device__ __forceinline__ float* lf_ptr(int row, int cc) const { return row < MP ? (float*)(PREP + blk_off(row, cc)) + (row & 63) * 128 + (cc & 127) : SLOGF + (size_t)(row - MP) * D + cc; }
    __device__ __forceinline__ f32x2 fgate(float fa, float lb, float llb, float l1m) const {
        float lf, kk;
        const float t = __expf(-fabsf(fa));
        const float ls = fminf(fa, 0.f) - __logf(1.0f + t);
        const float sneg = (fa >= 0.f ? t : 1.0f) * __builtin_amdgcn_rcpf(1.0f + t);
        if (lb0) { lf = ls; kk = sneg; }
        else { const float b = l1m + ls, mx = fmaxf(llb, b); lf = mx + __logf(1.0f + __expf(-fabsf(llb - b))); kk = (1.0f - lb) * sneg; }
        return (f32x2){lf, kk};
    }
    template <int R> __device__ __forceinline__ f32x4 act(f32x4 v) const {
        f32x4 r;
#pragma unroll
        for (int j = 0; j < 4; ++j) {
            if constexpr (R == 0 || R == 3) r[j] = v[j] * sig_fast(v[j]);
            else if constexpr (R == 5) { const float x = v[j], u = 0.7978845608028654f * (x + 0.044715f * x * x * x); r[j] = x * sig_fast(2.0f * u); }
            else if constexpr (R >= 6) r[j] = sig_fast(v[j]);
            else r[j] = v[j];
        }
        return r;
    }
    template <int R> __device__ __forceinline__ bf16* dst(int row, int cc) const { return R == 0 ? q_ptr(row, cc) : (R == 2 ? V : R == 3 ? OG : R == 4 ? XB : R == 5 ? YG : R == 6 ? SGA : SGB) + (size_t)row * D + cc; }
    template <int R> __device__ __forceinline__ void quadR(int row, int cc, f32x4 v) const {
        const size_t o = (size_t)row * D + cc;
        if constexpr (R == 1) {
            const f32x4 lb = *(const f32x4*)(lbt + cc), llb = *(const f32x4*)(lbt + 1024 + cc), l1m = *(const f32x4*)(lbt + 2048 + cc);
            f32x4 lf, r;
#pragma unroll
            for (int j = 0; j < 4; ++j) { const f32x2 g = fgate(v[j], lb[j], llb[j], l1m[j]); lf[j] = g.x; r[j] = g.y; }
            *(f32x4*)lf_ptr(row, cc) = lf; st_bf4(k_ptr(row, cc), r);
        } else st_bf4(dst<R>(row, cc), act<R>(v));
    }
    template <int R> __device__ __forceinline__ void octR(int row, int cc, f32x4 v0, f32x4 v1) const {
        const size_t o = (size_t)row * D + cc;
        if constexpr (R == 1) {
            f32x4 lf0, lf1, r0, r1;
            if (lb0) {
#pragma unroll
                for (int j = 0; j < 4; ++j) { const f32x2 g0 = fgate(v0[j], 0.f, 0.f, 0.f), g1 = fgate(v1[j], 0.f, 0.f, 0.f); lf0[j] = g0.x; r0[j] = g0.y; lf1[j] = g1.x; r1[j] = g1.y; }
            } else {
                const f32x4 lba = *(const f32x4*)(lbt + cc), lbb = *(const f32x4*)(lbt + cc + 4), lla = *(const f32x4*)(lbt + 1024 + cc), llb_ = *(const f32x4*)(lbt + 1024 + cc + 4), l1a = *(const f32x4*)(lbt + 2048 + cc), l1b = *(const f32x4*)(lbt + 2048 + cc + 4);
#pragma unroll
                for (int j = 0; j < 4; ++j) { const f32x2 g0 = fgate(v0[j], lba[j], lla[j], l1a[j]), g1 = fgate(v1[j], lbb[j], llb_[j], l1b[j]); lf0[j] = g0.x; r0[j] = g0.y; lf1[j] = g1.x; r1[j] = g1.y; }
            }
            float* lp = lf_ptr(row, cc); *(f32x4*)lp = lf0; *(f32x4*)(lp + 4) = lf1; st_bf8(k_ptr(row, cc), r0, r1);
        } else st_bf8(dst<R>(row, cc), act<R>(v0), act<R>(v1));
    }
    __device__ __forceinline__ void quad(int row, int col, f32x4 v) const {
        const int reg = col >> 10, cc = col & 1023;
        switch (reg) { case 0: quadR<0>(row, cc, v); break; case 1: quadR<1>(row, cc, v); break; case 2: quadR<2>(row, cc, v); break; case 3: quadR<3>(row, cc, v); break;
                       case 4: quadR<4>(row, cc, v); break; case 5: quadR<5>(row, cc, v); break; case 6: quadR<6>(row, cc, v); break; default: quadR<7>(row, cc, v); break; }
    }
};
struct EpiInUnit {
    static constexpr bool PERM = true, AFTER_DRAIN = false;
    EpiIn e;
    template <int KIND> __device__ __forceinline__ void run(const f32x4 (&acc)[2][2][4][2], int row0, int cc0, bf16* dstp, int mode) const {
#pragma unroll
        for (int ai = 0; ai < 2; ++ai)
#pragma unroll
            for (int m = 0; m < 4; ++m) {
#pragma unroll
                for (int bj = 0; bj < 2; ++bj) {
                    const int row = row0 + ai * 128 + m * 16, cc = cc0 + bj * 128;
                    const f32x4 v0 = acc[ai][bj][m][0], v1 = acc[ai][bj][m][1];
                    if constexpr (KIND == 0) e.octR<1>(row, cc, v0, v1);
                    else if constexpr (KIND == 1) st_bf8(dstp + (size_t)row * D + cc, v0, v1);
                    else { f32x4 r0, r1;
#pragma unroll
                        for (int j = 0; j < 4; ++j) {
                            const float x0 = v0[j], x1 = v1[j];
                            const float a0 = mode == 1 ? 1.5957691216057308f * (x0 + 0.044715f * x0 * x0 * x0) : x0, a1 = mode == 1 ? 1.5957691216057308f * (x1 + 0.044715f * x1 * x1 * x1) : x1;
                            const float s0 = sig_fast(a0), s1 = sig_fast(a1);
                            r0[j] = mode == 2 ? s0 : x0 * s0; r1[j] = mode == 2 ? s1 : x1 * s1; }
                        st_bf8(dstp ? dstp + (size_t)row * D + cc : e.q_ptr(row, cc), r0, r1); }
                }
                asm volatile("" ::: "memory"); __builtin_amdgcn_sched_barrier(0); }
    }
    __device__ __forceinline__ void operator()(const f32x4 (&acc)[2][2][4][2], const pg8::Unit& u, int wr, int wc, int fr, int fq) const {
        const int row0 = u.pm * 256 + wr * 64 + fr, cc0 = (u.pn & 3) * 256 + wc * 32 + 8 * fq, reg = u.pn >> 2;
        if (reg == 1) run<0>(acc, row0, cc0, nullptr, 0);
        else if (reg == 2 || reg == 4) run<1>(acc, row0, cc0, reg == 2 ? e.V : e.XB, 0);
        else { bf16* dp = reg == 0 ? nullptr : reg == 3 ? e.OG : reg == 5 ? e.YG : reg == 6 ? e.SGA : e.SGB;
               run<2>(acc, row0, cc0, dp, reg == 5 ? 1 : (reg >= 6 ? 2 : 0)); }
    }
};
template <class E> struct OctEpi {
    static constexpr bool PERM = true, AFTER_DRAIN = false;
    E e;
    __device__ __forceinline__ void operator()(const f32x4 (&acc)[2][2][4][2], const pg8::Unit& u, int wr, int wc, int fr, int fq) const {
        const int row0 = u.pm * 256 + wr * 64 + fr, col0 = u.pn * 256 + wc * 32 + 8 * fq;
#pragma unroll
        for (int ai = 0; ai < 2; ++ai)
#pragma unroll
            for (int m = 0; m < 4; ++m) {
#pragma unroll
                for (int bj = 0; bj < 2; ++bj) e.oct(row0 + ai * 128 + m * 16, col0 + bj * 128, acc[ai][bj][m][0], acc[ai][bj][m][1]);
                asm volatile("" ::: "memory"); __builtin_amdgcn_sched_barrier(0); }
    }
};
struct EpiBrA { static constexpr bool BY_REGION = false; const bf16* SGA; float* T;
    __device__ __forceinline__ void quad(int row, int col, f32x4 v) const { const size_t o = (size_t)row * D + col; *(f32x4*)(T + o) = ld_bf4(SGA + o) * v; }
    __device__ __forceinline__ void oct(int row, int col, f32x4 v0, f32x4 v1) const { const size_t o = (size_t)row * D + col; f32x4 g0, g1; ld_bf8(SGA + o, g0, g1); *(f32x4*)(T + o) = g0 * v0; *(f32x4*)(T + o + 4) = g1 * v1; } };
struct EpiBrB { static constexpr bool BY_REGION = false; const bf16* SGB; const float* T; bf16* MG;
    __device__ __forceinline__ void quad(int row, int col, f32x4 v) const { const size_t o = (size_t)row * D + col; st_bf4(MG + o, *(const f32x4*)(T + o) + ld_bf4(SGB + o) * v); }
    __device__ __forceinline__ void oct(int row, int col, f32x4 v0, f32x4 v1) const { const size_t o = (size_t)row * D + col; f32x4 g0, g1; ld_bf8(SGB + o, g0, g1);
        st_bf8(MG + o, *(const f32x4*)(T + o) + g0 * v0, *(const f32x4*)(T + o + 4) + g1 * v1); } };
struct EpiRes { static constexpr bool BY_REGION = false; const float* xp; const float* xs; float* X; const float* modl; int gi;
    __device__ __forceinline__ void quad(int row, int col, f32x4 v) const {
        if (row >= MR) return;
        const float* src = row < MP ? xp + (size_t)row * D : xs + (size_t)(row - MP) * D;
        const f32x4 g = *(const f32x4*)(modl + (size_t)mod_row(row) * 6144 + gi * 1024 + col);
        *(f32x4*)(X + (size_t)row * D + col) = *(const f32x4*)(src + col) + g * v;
    }
    __device__ __forceinline__ void oct(int row, int col, f32x4 v0, f32x4 v1) const { quad(row, col, v0); quad(row, col + 4, v1); } };
struct EpiFF1 { static constexpr bool BY_REGION = false; bf16* HM;
    __device__ __forceinline__ void quad(int row, int col, f32x4 v) const {
        f32x4 r;
#pragma unroll
        for (int j = 0; j < 4; ++j) { const float t = fmaxf(v[j], 0.f); r[j] = t * t; }
        st_bf4(HM + (size_t)row * FF + col, r);
    }
    __device__ __forceinline__ void oct(int row, int col, f32x4 v0, f32x4 v1) const {
        f32x4 r0, r1;
#pragma unroll
        for (int j = 0; j < 4; ++j) { const float t0 = fmaxf(v0[j], 0.f), t1 = fmaxf(v1[j], 0.f); r0[j] = t0 * t0; r1[j] = t1 * t1; }
        st_bf8(HM + (size_t)row * FF + col, r0, r1);
    } };

template <class E>
__device__ __forceinline__ void naive_gemm_phase(Ctx& c, const bf16* A, const bf16* Bt, int M, int N, int K, const E& e) {
    LAS float* As = (LAS float*)c.lds;
    LAS float* Bs = As + 32 * 132;
    const int ntm = M / 128, ntn = N / 128, tx = c.tid & 31, ty = c.tid >> 5;
    const int lr = c.tid >> 2, lk = (c.tid & 3) * 8;
    for (int tile = c.wg; tile < ntm * ntn; tile += c.G) {
        const int tm = tile % ntm, tn = tile / ntm;
        f32x4 acc[8];
#pragma unroll
        for (int i = 0; i < 8; ++i) acc[i] = (f32x4){0.f, 0.f, 0.f, 0.f};
        for (int k0 = 0; k0 < K; k0 += 32) {
            const u32x4 av = *(const u32x4*)(A + (size_t)(tm * 128 + lr) * K + k0 + lk);
            const u32x4 bv = *(const u32x4*)(Bt + (size_t)(tn * 128 + lr) * K + k0 + lk);
            __syncthreads();
#pragma unroll
            for (int j = 0; j < 4; ++j) {
                As[(lk + 2 * j) * 132 + lr] = bf2f(av[j] & 0xffffu); As[(lk + 2 * j + 1) * 132 + lr] = bf2f(av[j] >> 16);
                Bs[(lk + 2 * j) * 132 + lr] = bf2f(bv[j] & 0xffffu); Bs[(lk + 2 * j + 1) * 132 + lr] = bf2f(bv[j] >> 16);
            }
            __syncthreads();
#pragma unroll 8
            for (int k = 0; k < 32; ++k) {
                const f32x4 a0 = *(const LAS f32x4*)(As + k * 132 + ty * 8), a1 = *(const LAS f32x4*)(As + k * 132 + ty * 8 + 4);
                const f32x4 b = *(const LAS f32x4*)(Bs + k * 132 + tx * 4);
                acc[0] += a0[0] * b; acc[1] += a0[1] * b; acc[2] += a0[2] * b; acc[3] += a0[3] * b;
                acc[4] += a1[0] * b; acc[5] += a1[1] * b; acc[6] += a1[2] * b; acc[7] += a1[3] * b;
            }
        }
#pragma unroll
        for (int i = 0; i < 8; ++i) e.quad(tm * 128 + ty * 8 + i, tn * 128 + tx * 4, acc[i]);
    }
    __syncthreads();
}

struct PowOrder {
    int lgN, nwg, G, c;
    __device__ __forceinline__ void init(int lgN_, int G_, int c_) { lgN = lgN_; nwg = 64 << lgN_; G = G_; c = c_; }
    __device__ __forceinline__ bool next(int i, pg8::Unit& u) const {
        const int L = i * G + c; if (L >= nwg) return false;
        const int w = (L & 7) * (nwg >> 3) + (L >> 3), j = w & ((8 << lgN) - 1), gid = w >> (3 + lgN);
        u.pm = __builtin_amdgcn_readfirstlane(gid * 8 + (j & 7)); u.pn = __builtin_amdgcn_readfirstlane(j >> 3); return true;
    }
    __device__ __forceinline__ void a_ready(const pg8::Unit&) const {}
    __device__ __forceinline__ void done(const pg8::Unit&) const {}
};
template <class E>
__device__ __forceinline__ void sample_gemm_phase(Ctx& c, const bf16* A, const bf16* Bt, int N, int K, const E& e) {
    LAS float* red = (LAS float*)c.lds;
    const int lane = c.tid & 63, w = __builtin_amdgcn_readfirstlane(c.tid >> 6), fr = lane & 15, fq = lane >> 4, chh = w & 1, kq = w >> 1;
    const bf16* As = A + (size_t)MP * K;
    const int kspan = K >> 2;
    for (int mu = c.G - 1 - c.wg; mu < (N >> 5); mu += c.G) {
        const int n0 = 32 * mu;
        f32x4 acc[8];
#pragma unroll
        for (int m = 0; m < 8; ++m) acc[m] = (f32x4){0.f, 0.f, 0.f, 0.f};
        const bf16* bp = Bt + (size_t)(n0 + 16 * chh + fr) * K + kq * kspan + 8 * fq;
        const bf16* ap = As + (size_t)fr * K + kq * kspan + 8 * fq;
#pragma unroll 2
        for (int k = 0; k < kspan; k += 32) {
            const bf16x8 bfr = *(const bf16x8*)(bp + k);
#pragma unroll
            for (int m = 0; m < 8; ++m) acc[m] = __builtin_amdgcn_mfma_f32_16x16x32_bf16(*(const bf16x8*)(ap + (size_t)(16 * m) * K + k), bfr, acc[m], 0, 0, 0);
        }
        __syncthreads();
#pragma unroll
        for (int m = 0; m < 8; ++m)
#pragma unroll
            for (int j = 0; j < 4; ++j) red[(kq * 128 + 16 * m + 4 * fq + j) * 32 + 16 * chh + fr] = acc[m][j];
        __syncthreads();
#pragma unroll
        for (int i = 0; i < 2; ++i) { const int q = c.tid + 512 * i, row = q >> 3, cq = (q & 7) * 4;
            const f32x4 v = *(const LAS f32x4*)(red + row * 32 + cq) + *(const LAS f32x4*)(red + (128 + row) * 32 + cq) + *(const LAS f32x4*)(red + (256 + row) * 32 + cq) + *(const LAS f32x4*)(red + (384 + row) * 32 + cq);
            e.quad(MP + row, n0 + cq, v); }
    }
    __syncthreads();
}

template <int SITE, class E>
__device__ __forceinline__ void gemm_phase_sel(Ctx& c, const bf16* A, const bf16* Bt, int M, int N, int K, const E& e) {
    if constexpr ((FAST_GEMM >> SITE) & 1) {
        pg8::Gemm g{A, Bt, MP, N, K}; PowOrder S; S.init(N == 1024 ? 2 : (N == 4096 ? 4 : 5), c.G, c.wg);
        if constexpr (E::BY_REGION) { EpiInUnit qe{e}; pg8::gemm_phase<EpiInUnit, PowOrder, true, true>(c.lds, g, S, qe, c.tid); }
        else { OctEpi<E> qe{e}; pg8::gemm_phase<OctEpi<E>, PowOrder, true, true>(c.lds, g, S, qe, c.tid); }
        { int t_ = threadIdx.x; asm volatile("" : "+v"(t_)); c.tid = t_; }
        sample_gemm_phase(c, A, Bt, N, K, e);
    } else naive_gemm_phase(c, A, Bt, M, N, K, e);
}

#define XB_TMO      128
#define XB_XCNT(j)  (256  + 64 * (j))
#define XB_XSUB(j)  (1280 + 64 * (j))
#define XB_XGEN(j)  (2304 + 64 * (j))
#define XB_TOP      3328
#define XB_TOPGEN   3392
#define XCD_BAR_WORDS 3456
#define XB_SPIN_CAP (1u << 18)
__device__ __forceinline__ unsigned xb_ld(unsigned* p)              { return __hip_atomic_load(p, __ATOMIC_RELAXED, __HIP_MEMORY_SCOPE_AGENT); }
__device__ __forceinline__ unsigned xb_add(unsigned* p, unsigned v) { return __hip_atomic_fetch_add(p, v, __ATOMIC_RELAXED, __HIP_MEMORY_SCOPE_AGENT); }
__device__ __forceinline__ unsigned xb_xcc_id() { return (unsigned)__builtin_amdgcn_s_getreg((3 << 11) | 20) & 0xFu; }
#define XB_SPIN(cond, bar) do { unsigned _sp = 0; while (cond) { __builtin_amdgcn_s_sleep(1); \
    if ((++_sp & 255u) == 0u) { if (xb_ld(&(bar)[XB_TMO])) break; if (_sp > XB_SPIN_CAP) { atomicAdd(&(bar)[XB_TMO], 1u); break; } } } } while (0)
struct XcdBarrier { unsigned* bar; unsigned x; volatile LAS unsigned* st; };
__device__ __forceinline__ XcdBarrier xcd_barrier_post(unsigned* bar, volatile LAS unsigned* st) {
    XcdBarrier b; b.bar = bar; b.x = xb_xcc_id(); b.st = st;
    if (threadIdx.x == 0) (void)xb_add(&bar[XB_XCNT(b.x)], 1u);
    return b;
}
__device__ __forceinline__ void xcd_barrier_complete(unsigned* bar, unsigned x, unsigned& nloc, unsigned& nx) {
    const unsigned G = gridDim.x * gridDim.y * gridDim.z;
    unsigned sum, cnt, mine, sp = 0u;
    for (;;) {
        sum = 0u; cnt = 0u; mine = 0u;
#pragma unroll
        for (unsigned j = 0; j < 16; ++j) { const unsigned c = xb_ld(&bar[XB_XCNT(j)]); sum += c; cnt += (c > 0u) ? 1u : 0u; mine = (j == x) ? c : mine; }
        if (sum == G) break;
        __builtin_amdgcn_s_sleep(1);
        if ((++sp & 255u) == 0u) { if (xb_ld(&bar[XB_TMO])) break; if (sp > XB_SPIN_CAP) { atomicAdd(&bar[XB_TMO], 1u); break; } }
    }
    nloc = mine > 0u ? mine : 1u; nx = cnt > 0u ? cnt : 1u;
}
__device__ __forceinline__ void xcd_barrier(const XcdBarrier& b) {
    asm volatile("s_waitcnt vmcnt(0)" ::: "memory");
    __syncthreads();
    if (threadIdx.x == 0) {
        unsigned* bar = b.bar; asm volatile("" : "+s"(bar));
        __builtin_amdgcn_s_waitcnt(0);
        unsigned nloc = b.st[0], nx = b.st[1];
        if (nloc == 0u) { xcd_barrier_complete(bar, b.x, nloc, nx); b.st[0] = nloc; b.st[1] = nx; }
        const unsigned old = xb_add(&bar[XB_XSUB(b.x)], 1u);
        const unsigned gen = old / nloc;
        if (old + 1u == (gen + 1u) * nloc) {
            __builtin_amdgcn_fence(__ATOMIC_RELEASE, "agent");
            asm volatile("s_waitcnt vmcnt(0)" ::: "memory");
            const unsigned og = xb_add(&bar[XB_TOP], 1u);
            const unsigned tg = og / nx;
            if (og + 1u == (tg + 1u) * nx) xb_add(&bar[XB_TOPGEN], 1u);
            else XB_SPIN(xb_ld(&bar[XB_TOPGEN]) == tg, bar);
            __builtin_amdgcn_fence(__ATOMIC_ACQUIRE, "agent");
            xb_add(&bar[XB_XGEN(b.x)], 1u);
            asm volatile("s_waitcnt vmcnt(0)" ::: "memory");
        } else {
            XB_SPIN(xb_ld(&bar[XB_XGEN(b.x)]) == gen, bar);
            __builtin_amdgcn_fence(__ATOMIC_ACQUIRE, "agent");
            asm volatile("s_waitcnt vmcnt(0)" ::: "memory");
        }
    }
    __syncthreads();
}

__device__ __forceinline__ void p0_transpose_item(const float* W, int K, int N, bf16* WT, LAS float* scr, int item, int lane) {
    const int nblk = N / 32, kb = item / nblk, nb = item % nblk, k0 = 64 * kb, n0 = 32 * nb;
    float v[32];
#pragma unroll
    for (int i = 0; i < 32; ++i) v[i] = W[(size_t)(k0 + 2 * i + (lane >> 5)) * N + n0 + (lane & 31)];
#pragma unroll
    for (int i = 0; i < 32; ++i) scr[(2 * i + (lane >> 5)) * 33 + (lane & 31)] = v[i];
    asm volatile("s_waitcnt lgkmcnt(0)" ::: "memory");
    const int ch = lane & 7;
#pragma unroll
    for (int j = 0; j < 4; ++j) { const int n = (lane >> 3) + 8 * j; const LAS float* s = scr + (8 * ch) * 33 + n;
        u32x4 o; o.x = pk2(s[0 * 33], s[1 * 33]); o.y = pk2(s[2 * 33], s[3 * 33]); o.z = pk2(s[4 * 33], s[5 * 33]); o.w = pk2(s[6 * 33], s[7 * 33]);
        *(u32x4*)(WT + (size_t)(n0 + n) * K + k0 + 8 * ch) = o; }
    asm volatile("s_waitcnt lgkmcnt(0)" ::: "memory");
}
__device__ __forceinline__ void p0_work(CArgs& a, Ctx& c, int l, int vw, int nvw, bool with_tables, int ntr) {
    for (int lt = l; lt < l + ntr; ++lt) {
        LAS float* scr = (LAS float*)(c.lds + __builtin_amdgcn_readfirstlane(c.tid >> 6) * 16384);
        const int gw = vw * 8 + __builtin_amdgcn_readfirstlane(c.tid >> 6), NGW = nvw * 8;
        constexpr int I_IN = 16 * 256, I_SQ = 16 * 32, I_1 = 16 * 128, I_2 = 64 * 32, I_L = 8 * 8, PER_L = I_IN + 3 * I_SQ + I_1 + I_2 + 2 * I_L;
        bf16* wl = (bf16*)(a.ws + WS_W + (size_t)lt * WL_STRIDE);
        for (int it = gw; it < PER_L; it += NGW) {
            int r = it;
            if (r < I_IN) { p0_transpose_item(a.in[11] + (size_t)lt * D * NIN, D, NIN, wl + OFF_WIN / 2, scr, r, (c.tid & 63)); continue; } r -= I_IN;
            if (r < I_SQ) { p0_transpose_item(a.in[21] + (size_t)lt * D * D, D, D, wl + OFF_WA / 2, scr, r, (c.tid & 63)); continue; } r -= I_SQ;
            if (r < I_SQ) { p0_transpose_item(a.in[22] + (size_t)lt * D * D, D, D, wl + OFF_WB / 2, scr, r, (c.tid & 63)); continue; } r -= I_SQ;
            if (r < I_SQ) { p0_transpose_item(a.in[23] + (size_t)lt * D * D, D, D, wl + OFF_WO / 2, scr, r, (c.tid & 63)); continue; } r -= I_SQ;
            if (r < I_1) { p0_transpose_item(a.in[24] + (size_t)lt * D * FF, D, FF, wl + OFF_W1 / 2, scr, r, (c.tid & 63)); continue; } r -= I_1;
            if (r < I_2) { p0_transpose_item(a.in[25] + (size_t)lt * FF * D, FF, D, wl + OFF_W2 / 2, scr, r, (c.tid & 63)); continue; } r -= I_2;
            if (r < I_L) { const int n = r >> 3; p0_transpose_item(a.in[16] + ((size_t)lt * 8 + n) * 16384, 128, 128, wl + OFF_LWA / 2 + n * 16384, scr, r & 7, (c.tid & 63)); continue; } r -= I_L;
            { const int n = r >> 3; p0_transpose_item(a.in[18] + ((size_t)lt * 8 + n) * 16384, 128, 128, wl + OFF_LWX / 2 + n * 16384, scr, r & 7, (c.tid & 63)); }
        }
    }
    if (with_tables) {
        float* lbt = (float*)(a.ws + WS_TAB); float* sp = (float*)(a.ws + WS_TAB + 32768);
        const int gid = vw * 512 + c.tid;
        if (gid < 2 * D) {
            const int ll = gid >> 10, col = gid & 1023;
            const float h0 = a.in[12][col], h1 = a.in[12][D + col];
            const float p1 = 1.0f / (1.0f + expf(h0 - h1));
            const float lb = ll == 0 ? 0.f : p1;
            lbt[(ll * 3 + 0) * D + col] = lb; lbt[(ll * 3 + 1) * D + col] = logf(fmaxf(lb, 1e-30f)); lbt[(ll * 3 + 2) * D + col] = log1pf(-lb);
            sp[ll * D + col] = softplusf_(-a.in[20][ll * D + col]);
        }
    }
    __syncthreads();
    {
        constexpr int CS_STRIDE = 272;
        LAS unsigned char* csb = c.lds;
        LAS float* ws = (LAS float*)(c.lds + 39168);
        float* MOD = (float*)(a.ws + WS_MOD);
        const int lane = c.tid & 63, w = __builtin_amdgcn_readfirstlane(c.tid >> 6), fr = lane & 15, fq = lane >> 4, ct = w & 1, rt0 = w >> 1;
        for (int item = vw; item < 192; item += nvw) {
            const float* W = a.in[7] + (size_t)l * D * 6144 + item * 32;
            f32x4 acc[3];
#pragma unroll
            for (int i = 0; i < 3; ++i) acc[i] = (f32x4){0.f, 0.f, 0.f, 0.f};
            f32x4 cv[9], wv[2];
#define MOD_LOAD(k0_) do { _Pragma("unroll") for (int i = 0; i < 9; ++i) { const int e4 = c.tid + 512 * i, r = e4 >> 5, kq = (e4 & 31) * 4; const int rr = r < NMOD ? r : 0; \
                const float* src = rr < NBATCH ? a.in[5] + (size_t)rr * D : a.in[6] + (size_t)(rr - NBATCH) * D; cv[i] = *(const f32x4*)(src + (k0_) + kq); } \
              _Pragma("unroll") for (int i = 0; i < 2; ++i) { const int e4 = c.tid + 512 * i, kk = e4 >> 3, c4 = (e4 & 7) * 4; wv[i] = *(const f32x4*)(W + (size_t)((k0_) + kk) * 6144 + c4); } } while (0)
            MOD_LOAD(0);
            for (int k0 = 0; k0 < D; k0 += 128) {
                __syncthreads();
#pragma unroll
                for (int i = 0; i < 9; ++i) { const int e4 = c.tid + 512 * i, r = e4 >> 5, kq = (e4 & 31) * 4;
                    u32x2 pw; pw.x = pk2(siluf_(cv[i][0]), siluf_(cv[i][1])); pw.y = pk2(siluf_(cv[i][2]), siluf_(cv[i][3]));
                    if (r >= NMOD) { pw.x = 0u; pw.y = 0u; }
                    *(LAS u32x2*)(csb + r * CS_STRIDE + kq * 2) = pw; }
#pragma unroll
                for (int i = 0; i < 2; ++i) { const int e4 = c.tid + 512 * i, kk = e4 >> 3, c4 = (e4 & 7) * 4;
                    ws[kk * 33 + c4] = wv[i][0]; ws[kk * 33 + c4 + 1] = wv[i][1]; ws[kk * 33 + c4 + 2] = wv[i][2]; ws[kk * 33 + c4 + 3] = wv[i][3]; }
                if (k0 + 128 < D) MOD_LOAD(k0 + 128);
                WG_BAR();
#pragma unroll
                for (int ks = 0; ks < 4; ++ks) {
                    const LAS float* wp = ws + (32 * ks + 8 * fq) * 33 + 16 * ct + fr;
                    u32x4 bw; bw.x = pk2(wp[0], wp[33]); bw.y = pk2(wp[66], wp[99]); bw.z = pk2(wp[132], wp[165]); bw.w = pk2(wp[198], wp[231]);
                    const bf16x8 bfr = __builtin_bit_cast(bf16x8, bw);
#pragma unroll
                    for (int i = 0; i < 3; ++i) { const int rt = rt0 + 4 * i;
                        if (rt < 9) acc[i] = __builtin_amdgcn_mfma_f32_16x16x32_bf16(*(const LAS bf16x8*)(csb + (16 * rt + fr) * CS_STRIDE + (32 * ks + 8 * fq) * 2), bfr, acc[i], 0, 0, 0); }
                }
            }
#undef MOD_LOAD
            const float bm = a.in[8][(size_t)l * 6144 + item * 32 + 16 * ct + fr];
#pragma unroll
            for (int i = 0; i < 3; ++i) { const int rt = rt0 + 4 * i;
                if (rt < 9) {
#pragma unroll
                    for (int j = 0; j < 4; ++j) { const int row = 16 * rt + 4 * fq + j; if (row < NMOD) MOD[((size_t)l * NMOD + row) * 6144 + item * 32 + 16 * ct + fr] = acc[i][j] + bm; } } }
        }
    }
    __syncthreads();
}

__device__ __forceinline__ void norm_phase(CArgs& a, Ctx& c, int l, int which, const float* xp, const float* xs) {
    const int gw = c.wg * 8 + __builtin_amdgcn_readfirstlane(c.tid >> 6), NGW = c.G * 8;
    bf16* H = (bf16*)(a.ws + WS_H);
    const float* MODL = (const float*)(a.ws + WS_MOD) + (size_t)l * NMOD * 6144;
    const float* g = a.in[which ? 10 : 9] + (size_t)l * D;
    for (int row = gw; row < MR; row += NGW) {
        const float* xr = row < MP ? xp + (size_t)row * D : xs + (size_t)(row - MP) * D;
        const float* md = MODL + (size_t)mod_row(row) * 6144 + (which ? 3 : 0) * 1024;
        f32x4 v[4]; float ss = 0.f;
#pragma unroll
        for (int j = 0; j < 4; ++j) { v[j] = *(const f32x4*)(xr + 4 * (c.tid & 63) + 256 * j); ss += (v[j][0] * v[j][0] + v[j][1] * v[j][1]) + (v[j][2] * v[j][2] + v[j][3] * v[j][3]); }
        const float rstd = 1.0f / sqrtf(wave_sum(ss) * (1.0f / D) + EPS);
#pragma unroll
        for (int j = 0; j < 4; ++j) { const int cc = 4 * (c.tid & 63) + 256 * j;
            const f32x4 gg = *(const f32x4*)(g + cc), sh = *(const f32x4*)(md + cc), sc = *(const f32x4*)(md + 1024 + cc);
            st_bf4(H + (size_t)row * D + cc, v[j] * rstd * gg * (1.0f + sc) + sh); }
    }
}
__device__ __forceinline__ void final_norm_phase(CArgs& a, Ctx& c) {
    const int gw = c.wg * 8 + __builtin_amdgcn_readfirstlane(c.tid >> 6), NGW = c.G * 8;
    const float* g = a.in[26];
    for (int row = gw; row < MR; row += NGW) {
        const float* xr = (XOUT_SCRATCH ? (const float*)(a.ws + WS_T) : (const float*)a.out) + (size_t)row * D; float* yr = a.out + (size_t)row * D;
        f32x4 v[4]; float ss = 0.f;
#pragma unroll
        for (int j = 0; j < 4; ++j) { v[j] = *(const f32x4*)(xr + 4 * (c.tid & 63) + 256 * j); ss += (v[j][0] * v[j][0] + v[j][1] * v[j][1]) + (v[j][2] * v[j][2] + v[j][3] * v[j][3]); }
        const float rstd = 1.0f / sqrtf(wave_sum(ss) * (1.0f / D) + EPS);
#pragma unroll
        for (int j = 0; j < 4; ++j) { const int cc = 4 * (c.tid & 63) + 256 * j; f32x4 y = v[j] * rstd * *(const f32x4*)(g + cc);
            if (PROBE_T && row == 0 && cc == 0) y[0] += *(const float*)(a.ws + WS_DBG);
            *(f32x4*)(yr + cc) = y; }
    }
}

__device__ __forceinline__ void hgrn_naive(CArgs& a, Ctx& c, int l, int row0, int ntok, int h, const float* S0, float* Sout) {
    LAS float* fs = (LAS float*)c.lds;
    LAS float* ks = fs + 2048;
    LAS float* qs = ks + 2048;
    LAS float* vs = qs + 2048;
    LAS float* part = vs + 2048;
    const bf16* Q = (const bf16*)(a.ws + WS_SQ) - (size_t)MP * D; const bf16* Kb = (const bf16*)(a.ws + WS_SK) - (size_t)MP * D; const float* LOGF = (const float*)(a.ws + WS_SLOGF) - (size_t)MP * D;
    const bf16* V = (const bf16*)(a.ws + WS_V); const bf16* OG = (const bf16*)(a.ws + WS_OG); bf16* OA = (bf16*)(a.ws + WS_OA);
    const float* hg = a.in[13] + (size_t)l * DKV;
    const int v = c.tid & 127, kg = c.tid >> 7;
    float S[32];
#pragma unroll
    for (int i = 0; i < 32; ++i) S[i] = S0 ? S0[(size_t)(32 * kg + i) * DKV + v] : 0.f;
    for (int t0 = 0; t0 < ntok; t0 += 16) {
        const int nt = (ntok - t0) < 16 ? (ntok - t0) : 16;
        __syncthreads();
        { const int tt = c.tid >> 5, k4 = (c.tid & 31) * 4;
          if (tt < nt) { const size_t off = (size_t)(row0 + t0 + tt) * D + h * DKV + k4;
              const f32x4 lf = *(const f32x4*)(LOGF + off);
              *(LAS f32x4*)(fs + tt * 128 + k4) = (f32x4){expf(lf[0]), expf(lf[1]), expf(lf[2]), expf(lf[3])};
              *(LAS f32x4*)(ks + tt * 128 + k4) = ld_bf4(Kb + off);
              *(LAS f32x4*)(qs + tt * 128 + k4) = ld_bf4(Q + off);
              *(LAS f32x4*)(vs + tt * 128 + k4) = ld_bf4(V + off); } }
        __syncthreads();
        for (int tt = 0; tt < nt; ++tt) {
            const float vv = vs[tt * 128 + v]; float acc = 0.f;
#pragma unroll
            for (int i4 = 0; i4 < 8; ++i4) {
                const f32x4 f = *(const LAS f32x4*)(fs + tt * 128 + 32 * kg + 4 * i4), kk = *(const LAS f32x4*)(ks + tt * 128 + 32 * kg + 4 * i4), qq = *(const LAS f32x4*)(qs + tt * 128 + 32 * kg + 4 * i4);
#pragma unroll
                for (int j = 0; j < 4; ++j) { S[4 * i4 + j] = f[j] * S[4 * i4 + j] + kk[j] * vv; acc += S[4 * i4 + j] * qq[j]; }
            }
            part[(tt * 4 + kg) * 128 + v] = acc;
        }
        __syncthreads();
        { const int tt = c.tid >> 5, v4 = (c.tid & 31) * 4; const int tc = tt < nt ? tt : 0;
          const f32x4 o = *(const LAS f32x4*)(part + (tc * 4 + 0) * 128 + v4) + *(const LAS f32x4*)(part + (tc * 4 + 1) * 128 + v4)
                        + *(const LAS f32x4*)(part + (tc * 4 + 2) * 128 + v4) + *(const LAS f32x4*)(part + (tc * 4 + 3) * 128 + v4);
          float ss = (o[0] * o[0] + o[1] * o[1]) + (o[2] * o[2] + o[3] * o[3]);
          ss = half_sum(ss);
          const float rstd = 1.0f / sqrtf(ss * (1.0f / DKV) + EPS);
          if (tt < nt) { const size_t off = (size_t)(row0 + t0 + tt) * D + h * DKV + v4;
              st_bf4(OA + off, o * rstd * *(const f32x4*)(hg + v4) * ld_bf4(OG + off)); } }
    }
#pragma unroll
    for (int i = 0; i < 32; ++i) Sout[(size_t)(32 * kg + i) * DKV + v] = S[i];
    __syncthreads();
}


constexpr int HB_Q0 = 0, HB_K0 = 17408, HB_Q1 = 26112, HB_K1 = 34816, HB_KT0 = 43520, HB_KT1 = 53760, HB_VT = 64000, HB_AS = 82432, HB_ST = 91648, HB_VEC = 126464, HB_TOT = 128512, HB_SSQ = 130560;
constexpr int HS_Q = 272, HS_KT = 80, HS_VT = 144, HS_AS = 144;
static_assert(HB_SSQ + 2048 <= MISC_OFF && 64 * 132 * 4 <= HB_VEC - HB_ST, "hgrn lds");
__device__ __forceinline__ float exp_c(float x) { return __expf(fminf(x, 80.f)); }
__device__ __forceinline__ void hgrn_prep_phase(CArgs& a, Ctx& c) {
    LAS unsigned char* lds = c.lds;
    const int tid = c.tid, col = tid & 127, sg = tid >> 7;
    LAS float* VEC = (LAS float*)(lds + HB_VEC); LAS float* TOT = (LAS float*)(lds + HB_TOT);
    float lf[16]; unsigned qr[16], kr[16], vr[16];
#define PREP_LOAD(it_) do { const unsigned char* bp_ = a.ws + WS_PREP + (size_t)(it_) * PREP_BLK; const int e0_ = (16 * sg) * 128 + col; \
        const bf16* vs_ = (const bf16*)(a.ws + WS_V) + ((size_t)((it_) >> 8) * SEQ + 64 * (((it_) >> 3) & 31)) * D + ((it_) & 7) * DKV; \
        _Pragma("unroll") for (int i = 0; i < 16; ++i) { lf[i] = ((const float*)bp_)[e0_ + i * 128]; qr[i] = ((const bf16*)(bp_ + 32768))[e0_ + i * 128]; kr[i] = ((const bf16*)(bp_ + 49152))[e0_ + i * 128]; vr[i] = vs_[(size_t)(16 * sg + i) * D + col]; } } while (0)
    if (c.wg < 2048) PREP_LOAD(c.wg);
    for (int it = c.wg; it < 2048; it += c.G) {
        unsigned char* bp = a.ws + WS_PREP + (size_t)it * PREP_BLK;
        const int pb = it >> 8, pn = (it >> 3) & 31, phh = it & 7;
        bf16* vslice = (bf16*)(a.ws + WS_V) + ((size_t)pb * SEQ + 64 * pn) * D + phh * DKV;
        float g[16]; g[0] = lf[0];
#pragma unroll
        for (int i = 1; i < 16; ++i) g[i] = g[i - 1] + lf[i];
        WG_BAR();
        TOT[sg * 128 + col] = g[15];
        WG_BAR();
        {
            const float t0 = TOT[col], t1 = TOT[128 + col], t2 = TOT[256 + col], t3 = TOT[384 + col];
            const float off = (sg > 0 ? t0 : 0.f) + (sg > 1 ? t1 : 0.f) + (sg > 2 ? t2 : 0.f);
            const float r0 = t0, r1 = t0 + t1 + t2, last = r1 + t3;
            unsigned kt[8];
#pragma unroll
            for (int i = 0; i < 16; ++i) {
                const float G = g[i] + off, qv = bf2f(qr[i]), kv = bf2f(kr[i]);
                const int t = 16 * sg + i;
                *(LAS bf16*)(lds + HB_Q0 + t * HS_Q + col * 2) = (bf16)f2bf(qv * exp_c(G - r0));
                if (sg < 2) *(LAS bf16*)(lds + HB_K0 + t * HS_Q + col * 2) = (bf16)f2bf(kv * exp_c(r0 - G));
                else { *(LAS bf16*)(lds + HB_K1 + (t - 32) * HS_Q + col * 2) = (bf16)f2bf(kv * exp_c(r1 - G));
                       *(LAS bf16*)(lds + HB_Q1 + (t - 32) * HS_Q + col * 2) = (bf16)f2bf(qv * exp_c(G - r1)); }
                const unsigned kb = f2bf(kv * __expf(last - G));
                if (i & 1) kt[i >> 1] |= kb << 16; else kt[i >> 1] = kb;
            }
            { LAS unsigned char* p = lds + (sg < 2 ? HB_KT0 : HB_KT1) + col * HS_KT + (sg & 1) * 32;
              *(LAS u32x4*)p = (u32x4){kt[0], kt[1], kt[2], kt[3]}; *(LAS u32x4*)(p + 16) = (u32x4){kt[4], kt[5], kt[6], kt[7]}; }
            if (sg < 2) VEC[sg * 128 + col] = exp_c(sg == 0 ? r0 : last);
            { LAS unsigned char* p = lds + HB_VT + col * HS_VT + sg * 32;
              *(LAS u32x4*)p = (u32x4){vr[0] | (vr[1] << 16), vr[2] | (vr[3] << 16), vr[4] | (vr[5] << 16), vr[6] | (vr[7] << 16)};
              *(LAS u32x4*)(p + 16) = (u32x4){vr[8] | (vr[9] << 16), vr[10] | (vr[11] << 16), vr[12] | (vr[13] << 16), vr[14] | (vr[15] << 16)}; }
        }
        if (it + c.G < 2048) PREP_LOAD(it + c.G);
        WG_BAR();
#pragma unroll
        for (int i = 0; i < 2; ++i) { const int p = tid + 512 * i, row = p >> 4, pc = p & 15; *(u32x4*)(bp + row * 256 + pc * 16) = *(const LAS u32x4*)(lds + HB_Q0 + row * HS_Q + pc * 16); }
        { const int row = tid >> 4, pc = tid & 15;
          *(u32x4*)(bp + 16384 + row * 256 + pc * 16) = *(const LAS u32x4*)(lds + HB_K0 + row * HS_Q + pc * 16);
          *(u32x4*)(bp + 24576 + row * 256 + pc * 16) = *(const LAS u32x4*)(lds + HB_Q1 + row * HS_Q + pc * 16);
          *(u32x4*)(bp + 32768 + row * 256 + pc * 16) = *(const LAS u32x4*)(lds + HB_K1 + row * HS_Q + pc * 16); }
        { const int k = tid >> 2, pc = tid & 3;
          *(u32x4*)(bp + 40960 + k * 64 + pc * 16) = *(const LAS u32x4*)(lds + HB_KT0 + k * HS_KT + pc * 16);
          *(u32x4*)(bp + 49152 + k * 64 + pc * 16) = *(const LAS u32x4*)(lds + HB_KT1 + k * HS_KT + pc * 16); }
        if (tid < 64) *(u32x4*)(bp + 57344 + tid * 16) = *(const LAS u32x4*)(lds + HB_VEC + tid * 16);
#pragma unroll
        for (int i = 0; i < 2; ++i) { const int p = tid + 512 * i, v = p >> 3, pc = p & 7;
            *(u32x4*)((unsigned char*)(vslice + (size_t)(v >> 1) * D) + (v & 1) * 128 + pc * 16) = *(const LAS u32x4*)(lds + HB_VT + v * HS_VT + pc * 16); }
    }
#undef PREP_LOAD
    __syncthreads();
}

__device__ __forceinline__ void hgrn_fast_prompt(CArgs& a, Ctx& c, int l, int b, int h) {
    LAS unsigned char* lds = c.lds;
    const int tid = c.tid, lane = tid & 63, w = __builtin_amdgcn_readfirstlane(tid >> 6), fr = lane & 15, fq = lane >> 4;
    const int col = tid & 127, sg = tid >> 7;
    const bf16* V = (const bf16*)(a.ws + WS_V); const bf16* OG = (const bf16*)(a.ws + WS_OG); bf16* OA = (bf16*)(a.ws + WS_OA);
    const unsigned char* blk0 = a.ws + WS_PREP + ((size_t)b * 32 * 8 + h) * PREP_BLK;
    const size_t base = (size_t)b * SEQ * D + (size_t)h * DKV;
    LAS float* VEC = (LAS float*)(lds + HB_VEC); LAS float* SSQ = (LAS float*)(lds + HB_SSQ);
    LAS unsigned char* STw = lds + HB_ST + w * 4352;
    const float gv = a.in[13][(size_t)l * DKV + 16 * w + fr];
    f32x4 S[8];
#pragma unroll
    for (int i = 0; i < 8; ++i) S[i] = (f32x4){0.f, 0.f, 0.f, 0.f};
    __syncthreads();
    for (int e = tid; e < 2 * 16 * 16; e += 512) { const int which = e >> 8, r = (e >> 4) & 15, cc = e & 15;
        *(LAS bf16*)(lds + HB_AS + ((which ? 32 : 0) + r) * HS_AS + ((which ? 48 : 16) + cc) * 2) = 0; }
    const int prow = tid >> 4, ppc = tid & 15, pk = tid >> 2, pkc = tid & 3;
    const bf16* vt0 = (const bf16*)(a.ws + WS_V) + (size_t)b * SEQ * D + h * DKV;
    const int orow = tid >> 4, oc8 = (tid & 15) * 8;
    u32x4 im[10], ogv[2];
#define HG_LOAD(n_) do { const unsigned char* bp_ = blk0 + (size_t)(n_) * 8 * PREP_BLK; \
        im[0] = *(const u32x4*)(bp_ + prow * 256 + ppc * 16); im[1] = *(const u32x4*)(bp_ + (32 + prow) * 256 + ppc * 16); \
        im[2] = *(const u32x4*)(bp_ + 16384 + prow * 256 + ppc * 16); im[3] = *(const u32x4*)(bp_ + 24576 + prow * 256 + ppc * 16); im[4] = *(const u32x4*)(bp_ + 32768 + prow * 256 + ppc * 16); \
        im[5] = *(const u32x4*)(bp_ + 40960 + pk * 64 + pkc * 16); im[6] = *(const u32x4*)(bp_ + 49152 + pk * 64 + pkc * 16); \
        if (tid < 64) im[7] = *(const u32x4*)(bp_ + 57344 + tid * 16); \
        _Pragma("unroll") for (int i = 0; i < 2; ++i) { const int p_ = tid + 512 * i, v_ = p_ >> 3, pc_ = p_ & 7; \
            im[8 + i] = *(const u32x4*)((const unsigned char*)(vt0 + (size_t)(64 * (n_) + (v_ >> 1)) * D) + (v_ & 1) * 128 + pc_ * 16); } } while (0)
    HG_LOAD(0);
    unsigned long long tacc = 0ull, tst = 0ull;
#define TSTART(id) do { if (PROBE_T == (id)) { __builtin_amdgcn_sched_barrier(0); tst = __builtin_amdgcn_s_memtime(); __builtin_amdgcn_sched_barrier(0); } } while (0)
#define TSTOP(id) do { if (PROBE_T == (id)) { __builtin_amdgcn_sched_barrier(0); tacc += __builtin_amdgcn_s_memtime() - tst; __builtin_amdgcn_sched_barrier(0); } } while (0)
    for (int nn = 0; nn < (SEQ / 64) * (1 + (PROBE_MIX & 1)); ++nn) {
        const int n = nn & (SEQ / 64 - 1);
        if (PROBE_MIX & 1) { if (nn == SEQ / 64) {
#pragma unroll
            for (int i = 0; i < 8; ++i) S[i] = (f32x4){0.f, 0.f, 0.f, 0.f}; } }
        TSTART(1); TSTART(2);
        *(LAS u32x4*)(lds + HB_Q0 + prow * HS_Q + ppc * 16) = im[0]; *(LAS u32x4*)(lds + HB_Q0 + (32 + prow) * HS_Q + ppc * 16) = im[1];
        *(LAS u32x4*)(lds + HB_K0 + prow * HS_Q + ppc * 16) = im[2]; *(LAS u32x4*)(lds + HB_Q1 + prow * HS_Q + ppc * 16) = im[3]; *(LAS u32x4*)(lds + HB_K1 + prow * HS_Q + ppc * 16) = im[4];
        *(LAS u32x4*)(lds + HB_KT0 + pk * HS_KT + pkc * 16) = im[5]; *(LAS u32x4*)(lds + HB_KT1 + pk * HS_KT + pkc * 16) = im[6];
        if (tid < 64) *(LAS u32x4*)(lds + HB_VEC + tid * 16) = im[7];
#pragma unroll
        for (int i = 0; i < 2; ++i) { const int p = tid + 512 * i, v = p >> 3, pc = p & 7; *(LAS u32x4*)(lds + HB_VT + v * HS_VT + pc * 16) = im[8 + i]; }
        ogv[0] = *(const u32x4*)(OG + base + (size_t)(64 * n + orow) * D + oc8); ogv[1] = *(const u32x4*)(OG + base + (size_t)(64 * n + 32 + orow) * D + oc8);
        if ((PROBE_MIX & 1) || n + 1 < SEQ / 64) HG_LOAD((n + 1) & (SEQ / 64 - 1));
        WG_BAR();
        TSTOP(2); TSTART(3);
#pragma unroll
        for (int kt8 = 0; kt8 < 8; ++kt8) { const f32x4 er = *(const LAS f32x4*)(VEC + 16 * kt8 + 4 * fq);
            u32x2 pw; pw.x = pk2(S[kt8][0] * er[0], S[kt8][1] * er[1]); pw.y = pk2(S[kt8][2] * er[2], S[kt8][3] * er[3]);
            *(LAS u32x2*)(STw + fr * HS_Q + (16 * kt8 + 4 * fq) * 2) = pw; }
#pragma unroll
        for (int rep = 0; rep < 2; ++rep) {
            const int id = w + 8 * rep;
            if (id < 10) {
                int tt, st;
                if (id == 0) { tt = 0; st = 0; } else if (id < 7) { tt = (id + 1) >> 1; st = (id + 1) & 1; } else if (id == 7) { tt = 2; st = 2; } else { tt = 3; st = id - 6; }
                const LAS unsigned char* ap = (st < 2) ? lds + HB_Q0 + (16 * tt + fr) * HS_Q : lds + HB_Q1 + (16 * (tt - 2) + fr) * HS_Q;
                const LAS unsigned char* bp = (st < 2) ? lds + HB_K0 + (16 * st + fr) * HS_Q : lds + HB_K1 + (16 * (st - 2) + fr) * HS_Q;
                f32x4 acc = (f32x4){0.f, 0.f, 0.f, 0.f};
#pragma unroll
                for (int ks = 0; ks < 4; ++ks) acc = __builtin_amdgcn_mfma_f32_16x16x32_bf16(*(const LAS bf16x8*)(ap + (32 * ks + 8 * fq) * 2), *(const LAS bf16x8*)(bp + (32 * ks + 8 * fq) * 2), acc, 0, 0, 0);
#pragma unroll
                for (int j = 0; j < 4; ++j) { const float v_ = (tt == st && fr > 4 * fq + j) ? 0.f : acc[j];
                    *(LAS bf16*)(lds + HB_AS + (16 * tt + 4 * fq + j) * HS_AS + (16 * st + fr) * 2) = (bf16)f2bf(v_); }
            }
        }
        f32x4 o[4];
#pragma unroll
        for (int tt = 0; tt < 4; ++tt) o[tt] = (f32x4){0.f, 0.f, 0.f, 0.f};
#pragma unroll
        for (int ks = 0; ks < 4; ++ks) { const bf16x8 bfr = *(const LAS bf16x8*)(STw + fr * HS_Q + (32 * ks + 8 * fq) * 2);
#pragma unroll
            for (int tt = 0; tt < 4; ++tt) o[tt] = __builtin_amdgcn_mfma_f32_16x16x32_bf16(*(const LAS bf16x8*)(lds + HB_Q0 + (16 * tt + fr) * HS_Q + (32 * ks + 8 * fq) * 2), bfr, o[tt], 0, 0, 0); }
        WG_BAR();
        TSTOP(3); TSTART(4);
#pragma unroll
        for (int tt = 0; tt < 4; ++tt)
#pragma unroll
            for (int ks = 0; ks < 2; ++ks) if (ks == 0 || tt >= 2)
                o[tt] = __builtin_amdgcn_mfma_f32_16x16x32_bf16(*(const LAS bf16x8*)(lds + HB_AS + (16 * tt + fr) * HS_AS + (32 * ks + 8 * fq) * 2), *(const LAS bf16x8*)(lds + HB_VT + (16 * w + fr) * HS_VT + (32 * ks + 8 * fq) * 2), o[tt], 0, 0, 0);
#pragma unroll
        for (int tt = 0; tt < 4; ++tt)
#pragma unroll
            for (int j = 0; j < 4; ++j) { float p = o[tt][j] * o[tt][j];
                p = row16_sum(p);
                if (fr == 0) SSQ[w * 64 + 16 * tt + 4 * fq + j] = p; }
#pragma unroll
        for (int kt8 = 0; kt8 < 8; ++kt8) {
            const f32x4 eL = *(const LAS f32x4*)(VEC + 128 + 16 * kt8 + 4 * fq);
            f32x4 sn = eL * S[kt8];
            sn = __builtin_amdgcn_mfma_f32_16x16x32_bf16(*(const LAS bf16x8*)(lds + HB_KT0 + (16 * kt8 + fr) * HS_KT + 8 * fq * 2), *(const LAS bf16x8*)(lds + HB_VT + (16 * w + fr) * HS_VT + 8 * fq * 2), sn, 0, 0, 0);
            S[kt8] = __builtin_amdgcn_mfma_f32_16x16x32_bf16(*(const LAS bf16x8*)(lds + HB_KT1 + (16 * kt8 + fr) * HS_KT + 8 * fq * 2), *(const LAS bf16x8*)(lds + HB_VT + (16 * w + fr) * HS_VT + (32 + 8 * fq) * 2), sn, 0, 0, 0);
        }
        WG_BAR();
        TSTOP(4); TSTART(5);
        { LAS float* OUT = (LAS float*)(lds + HB_ST);
#pragma unroll
          for (int tt = 0; tt < 4; ++tt)
#pragma unroll
              for (int j = 0; j < 4; ++j) OUT[(16 * tt + 4 * fq + j) * 132 + 16 * w + fr] = o[tt][j] * gv;
          WG_BAR();
#pragma unroll
          for (int i = 0; i < 2; ++i) { const int t = orow + 32 * i;
              float ss = SSQ[t];
#pragma unroll
              for (int ww = 1; ww < 8; ++ww) ss += SSQ[ww * 64 + t];
              const float rstd = __builtin_amdgcn_rsqf(ss * (1.0f / DKV) + EPS);
              const f32x4 x0 = *(const LAS f32x4*)(OUT + t * 132 + oc8) * rstd, x1 = *(const LAS f32x4*)(OUT + t * 132 + oc8 + 4) * rstd;
              const u32x4 g_ = ogv[i];
              const f32x4 g0 = (f32x4){bf2f(g_.x & 0xffffu), bf2f(g_.x >> 16), bf2f(g_.y & 0xffffu), bf2f(g_.y >> 16)}, g1 = (f32x4){bf2f(g_.z & 0xffffu), bf2f(g_.z >> 16), bf2f(g_.w & 0xffffu), bf2f(g_.w >> 16)};
              st_bf8(OA + base + (size_t)(64 * n + t) * D + oc8, x0 * g0, x1 * g1); } }
        TSTOP(5); TSTOP(1);
    }
    if (PROBE_T && PROBE_T < 100 && l == 0 && c.wg == 0 && tid == 0) *(float*)(a.ws + WS_DBG) = (float)(tacc >> 5) * 1e-4f;
#undef HG_LOAD
    { float* Sout = a.out + O_HGP + (((size_t)l * NBATCH + b) * NH + h) * DKV * DKV;
#pragma unroll
      for (int kt8 = 0; kt8 < 8; ++kt8)
#pragma unroll
          for (int j = 0; j < 4; ++j) Sout[(size_t)(16 * kt8 + 4 * fq + j) * DKV + 16 * w + fr] = S[kt8][j]; }
    __syncthreads();
}

constexpr int L_XBS = 0, L_XC = 67 * 128, L_AS = L_XC + 8192, L_BS = L_AS + 8192, L_SEG = L_BS + 8192, L_CARRY = L_SEG + 1024;
constexpr int LB_XCB = (L_CARRY + 256) * 4, XCB_STRIDE = 272;
static_assert(LB_XCB + 64 * XCB_STRIDE <= MISC_OFF && LB_XCB % 16 == 0, "lru lds");
__device__ __forceinline__ void lru_gates_naive(CArgs& a, Ctx& c, int l, int n) {
    LAS float* XC = (LAS float*)c.lds + L_XC; LAS float* As = (LAS float*)c.lds + L_AS; LAS float* Bs = (LAS float*)c.lds + L_BS;
    const bf16* wl = (const bf16*)(a.ws + WS_W + (size_t)l * WL_STRIDE);
    const int e = c.tid & 127, tg = c.tid >> 7;
    const bf16* wa = wl + OFF_LWA / 2 + (size_t)(n * 128 + e) * 128; const bf16* wx = wl + OFF_LWX / 2 + (size_t)(n * 128 + e) * 128;
    const int ch = n * 128 + e;
    const float ba = a.in[17][(size_t)l * D + ch], bx = a.in[19][(size_t)l * D + ch], sp = ((const float*)(a.ws + WS_TAB + 32768))[l * D + ch];
#pragma unroll 1
    for (int tq = 0; tq < 4; ++tq) {
        float ra[4], ia[4];
#pragma unroll
        for (int i = 0; i < 4; ++i) { ra[i] = 0.f; ia[i] = 0.f; }
        const LAS float* xc = XC + (tg * 16 + tq * 4) * 128;
#pragma unroll 1
        for (int d0 = 0; d0 < 128; d0 += 8) {
            const f32x4 wa0 = ld_bf4(wa + d0), wa1 = ld_bf4(wa + d0 + 4), wx0 = ld_bf4(wx + d0), wx1 = ld_bf4(wx + d0 + 4);
#pragma unroll
            for (int tt = 0; tt < 4; ++tt) {
                const f32x4 x0 = *(const LAS f32x4*)(xc + tt * 128 + d0), x1 = *(const LAS f32x4*)(xc + tt * 128 + d0 + 4);
                ra[tt] += (x0[0] * wa0[0] + x0[1] * wa0[1]) + (x0[2] * wa0[2] + x0[3] * wa0[3]) + (x1[0] * wa1[0] + x1[1] * wa1[1]) + (x1[2] * wa1[2] + x1[3] * wa1[3]);
                ia[tt] += (x0[0] * wx0[0] + x0[1] * wx0[1]) + (x0[2] * wx0[2] + x0[3] * wx0[3]) + (x1[0] * wx1[0] + x1[1] * wx1[1]) + (x1[2] * wx1[2] + x1[3] * wx1[3]);
            }
        }
#pragma unroll
        for (int tt = 0; tt < 4; ++tt) {
            const int t = tg * 16 + tq * 4 + tt;
            const float r = sigmoidf_(ra[tt] + ba), ig = sigmoidf_(ia[tt] + bx);
            const float la = -8.0f * r * sp, aa = expf(la), mult = sqrtf(-expm1f(2.0f * la));
            As[t * 128 + e] = aa; Bs[t * 128 + e] = mult * ig * XC[t * 128 + e];
        }
    }
}
__device__ __forceinline__ void lru_gates_mfma(CArgs& a, Ctx& c, int l, int n) {
    LAS float* XC = (LAS float*)c.lds + L_XC; LAS float* As = (LAS float*)c.lds + L_AS; LAS float* Bs = (LAS float*)c.lds + L_BS;
    const bf16* wl = (const bf16*)(a.ws + WS_W + (size_t)l * WL_STRIDE);
    const int lane = c.tid & 63, w = __builtin_amdgcn_readfirstlane(c.tid >> 6), fr = lane & 15, fq = lane >> 4;
    const int e = 16 * w + fr, ch = n * 128 + e;
    const bf16* wa = wl + OFF_LWA / 2 + (size_t)(n * 128 + e) * 128 + 8 * fq; const bf16* wx = wl + OFF_LWX / 2 + (size_t)(n * 128 + e) * 128 + 8 * fq;
    bf16x8 Ba[4], Bx[4];
#pragma unroll
    for (int ks = 0; ks < 4; ++ks) { Ba[ks] = *(const bf16x8*)(wa + 32 * ks); Bx[ks] = *(const bf16x8*)(wx + 32 * ks); }
    const float ba = a.in[17][(size_t)l * D + ch], bx = a.in[19][(size_t)l * D + ch], sp = ((const float*)(a.ws + WS_TAB + 32768))[l * D + ch];
#pragma unroll
    for (int m = 0; m < 4; ++m) {
        f32x4 ar = (f32x4){0.f, 0.f, 0.f, 0.f}, ai = (f32x4){0.f, 0.f, 0.f, 0.f};
#pragma unroll
        for (int ks = 0; ks < 4; ++ks) {
            const bf16x8 af = *(const LAS bf16x8*)(c.lds + LB_XCB + (16 * m + fr) * XCB_STRIDE + (32 * ks + 8 * fq) * 2);
            ar = __builtin_amdgcn_mfma_f32_16x16x32_bf16(af, Ba[ks], ar, 0, 0, 0);
            ai = __builtin_amdgcn_mfma_f32_16x16x32_bf16(af, Bx[ks], ai, 0, 0, 0);
        }
#pragma unroll
        for (int j = 0; j < 4; ++j) {
            const int t = 16 * m + 4 * fq + j;
            const float r = sigmoidf_(ar[j] + ba), ig = sigmoidf_(ai[j] + bx);
            const float la = -8.0f * r * sp, aa = expf(la), mult = sqrtf(-expm1f(2.0f * la));
            As[t * 128 + e] = aa; Bs[t * 128 + e] = mult * ig * XC[t * 128 + e];
        }
    }
}
#if FAST_GATES
#define lru_gates lru_gates_mfma
#else
#define lru_gates lru_gates_naive
#endif

constexpr int LB_CW = LB_XCB + 64 * XCB_STRIDE;
static_assert(LB_CW + 2560 <= MISC_OFF, "lru lds");
__device__ __forceinline__ void lru_prompt_item(CArgs& a, Ctx& c, int l, int b, int n, int hc) {
    LAS float* L = (LAS float*)c.lds;
    LAS float* As = L + L_AS; LAS float* Bs = L + L_BS; LAS float* SEG = L + L_SEG; LAS float* CAR = L + L_CARRY;
    const bf16* XB = (const bf16*)(a.ws + WS_XB); const bf16* YG = (const bf16*)(a.ws + WS_YG); bf16* OB = (bf16*)(a.ws + WS_OB);
    const int t_ld = c.tid >> 3, c0 = (c.tid & 7) * 16;
    const int cch = c.tid & 63, sg = c.tid >> 6;
    const int lane = c.tid & 63, w = __builtin_amdgcn_readfirstlane(c.tid >> 6), fr = lane & 15, fq = lane >> 4;
    const int ec = 16 * (w & 3) + fr, e = 64 * hc + ec, ch = n * 128 + e, m0 = 2 * (w >> 2);
    const int chs = n * 128 + 64 * hc + cch;
    __syncthreads();
    if (c.tid < 128) CAR[c.tid] = 0.f;
    if (c.tid < 384) L[L_XBS + c.tid] = 0.f;
    f32x4 cwr[4][4], cbr[4];
#pragma unroll
    for (int j4 = 0; j4 < 4; ++j4) { cbr[j4] = *(const f32x4*)(a.in[15] + (size_t)l * D + n * 128 + c0 + 4 * j4);
#pragma unroll
        for (int j = 0; j < 4; ++j) cwr[j][j4] = *(const f32x4*)(a.in[14] + (size_t)l * 4 * D + j * D + n * 128 + c0 + 4 * j4); }
    bf16x8 Ba[4], Bx[4];
    { const bf16* wl = (const bf16*)(a.ws + WS_W + (size_t)l * WL_STRIDE);
      const bf16* wa = wl + OFF_LWA / 2 + (size_t)(n * 128 + e) * 128 + 8 * fq; const bf16* wx = wl + OFF_LWX / 2 + (size_t)(n * 128 + e) * 128 + 8 * fq;
#pragma unroll
      for (int ks = 0; ks < 4; ++ks) { Ba[ks] = *(const bf16x8*)(wa + 32 * ks); Bx[ks] = *(const bf16x8*)(wx + 32 * ks); } }
    const float ba = a.in[17][(size_t)l * D + ch], bx = a.in[19][(size_t)l * D + ch], sp8 = -8.0f * ((const float*)(a.ws + WS_TAB + 32768))[l * D + ch];
    const bf16* xsrc = XB + (size_t)(b * SEQ + t_ld) * D + n * 128 + c0;
    u32x4 xr0 = *(const u32x4*)xsrc, xr1 = *(const u32x4*)(xsrc + 8);
    for (int t0 = 0; t0 < SEQ; t0 += 64) {
        const int par = (t0 >> 6) & 1;
        unsigned ygr[8];
        { const bf16* yp = YG + (size_t)(b * SEQ + t0 + sg * 8) * D + chs;
#pragma unroll
          for (int tt = 0; tt < 8; ++tt) ygr[tt] = yp[(size_t)tt * D]; }
        WG_BAR();
        { LAS float* dst = L + L_XBS + (3 + t_ld) * 128 + c0;
          *(LAS f32x4*)dst        = (f32x4){bf2f(xr0.x & 0xffffu), bf2f(xr0.x >> 16), bf2f(xr0.y & 0xffffu), bf2f(xr0.y >> 16)};
          *(LAS f32x4*)(dst + 4)  = (f32x4){bf2f(xr0.z & 0xffffu), bf2f(xr0.z >> 16), bf2f(xr0.w & 0xffffu), bf2f(xr0.w >> 16)};
          *(LAS f32x4*)(dst + 8)  = (f32x4){bf2f(xr1.x & 0xffffu), bf2f(xr1.x >> 16), bf2f(xr1.y & 0xffffu), bf2f(xr1.y >> 16)};
          *(LAS f32x4*)(dst + 12) = (f32x4){bf2f(xr1.z & 0xffffu), bf2f(xr1.z >> 16), bf2f(xr1.w & 0xffffu), bf2f(xr1.w >> 16)}; }
        if (t0 + 64 < SEQ) { xr0 = *(const u32x4*)(xsrc + (size_t)(t0 + 64) * D); xr1 = *(const u32x4*)(xsrc + (size_t)(t0 + 64) * D + 8); }
        WG_BAR();
#pragma unroll
        for (int j4 = 0; j4 < 4; ++j4) { const int cc = c0 + 4 * j4;
            f32x4 acc = cbr[j4];
#pragma unroll
            for (int j = 0; j < 4; ++j) acc += cwr[j][j4] * *(const LAS f32x4*)(L + L_XBS + (t_ld + j) * 128 + cc);
            *(LAS f32x4*)(L + L_XC + t_ld * 128 + cc) = acc;
            { u32x2 pw; pw.x = pk2(acc[0], acc[1]); pw.y = pk2(acc[2], acc[3]); *(LAS u32x2*)(c.lds + LB_XCB + t_ld * XCB_STRIDE + cc * 2) = pw; } }
        WG_BAR();
#pragma unroll
        for (int mm = 0; mm < 2; ++mm) {
            const int m = m0 + mm;
            f32x4 ar = (f32x4){0.f, 0.f, 0.f, 0.f}, ai = (f32x4){0.f, 0.f, 0.f, 0.f};
#pragma unroll
            for (int ks = 0; ks < 4; ++ks) {
                const bf16x8 af = *(const LAS bf16x8*)(c.lds + LB_XCB + (16 * m + fr) * XCB_STRIDE + (32 * ks + 8 * fq) * 2);
                ar = __builtin_amdgcn_mfma_f32_16x16x32_bf16(af, Ba[ks], ar, 0, 0, 0);
                ai = __builtin_amdgcn_mfma_f32_16x16x32_bf16(af, Bx[ks], ai, 0, 0, 0);
            }
#pragma unroll
            for (int j = 0; j < 4; ++j) {
                const int t = 16 * m + 4 * fq + j;
                const float r = sig_fast(ar[j] + ba), ig = sig_fast(ai[j] + bx);
                const float la = sp8 * r, x2 = 2.0f * la;
                const float em = x2 > -0.5f ? x2 * (1.0f + x2 * (0.5f + x2 * (0.16666667f + x2 * (0.041666668f + x2 * 0.0083333338f)))) : __expf(x2) - 1.0f;
                As[t * 64 + ec] = __expf(la); Bs[t * 64 + ec] = __builtin_amdgcn_sqrtf(-em) * ig * L[L_XC + t * 128 + e];
            }
        }
        WG_BAR();
        float P = 1.f, Bv = 0.f;
#pragma unroll
        for (int tt = 0; tt < 8; ++tt) { const float aa = As[(sg * 8 + tt) * 64 + cch], bb = Bs[(sg * 8 + tt) * 64 + cch]; Bv = aa * Bv + bb; P *= aa; }
        SEG[(sg * 64 + cch) * 2] = P; SEG[(sg * 64 + cch) * 2 + 1] = Bv;
        WG_BAR();
        float h = CAR[par * 64 + cch];
        for (int s2 = 0; s2 < sg; ++s2) h = SEG[(s2 * 64 + cch) * 2] * h + SEG[(s2 * 64 + cch) * 2 + 1];
        { bf16* op = OB + (size_t)(b * SEQ + t0 + sg * 8) * D + chs;
#pragma unroll
          for (int tt = 0; tt < 8; ++tt) { const int t = sg * 8 + tt;
              h = As[t * 64 + cch] * h + Bs[t * 64 + cch];
              op[(size_t)tt * D] = (bf16)f2bf(h * bf2f(ygr[tt])); } }
        if (sg == 7) CAR[(par ^ 1) * 64 + cch] = h;
        if (c.tid < 384) L[L_XBS + c.tid] = L[L_XBS + 64 * 128 + c.tid];
    }
    __syncthreads();
    if (c.tid < 64) a.out[O_LRP + ((size_t)l * NBATCH + b) * D + n * 128 + 64 * hc + c.tid] = CAR[c.tid];
    if (hc == 0 && c.tid < 384) a.out[O_CVP + (((size_t)l * NBATCH + b) * 3 + (c.tid >> 7)) * D + n * 128 + (c.tid & 127)] = L[L_XBS + c.tid];
    __syncthreads();
}
__device__ __forceinline__ void lru_sample_item(CArgs& a, Ctx& c, int l, int n, int hf) {
    LAS float* L = (LAS float*)c.lds;
    const bf16* XB = (const bf16*)(a.ws + WS_XB); const bf16* YG = (const bf16*)(a.ws + WS_YG); bf16* OB = (bf16*)(a.ws + WS_OB);
    const int t_ld = c.tid >> 3, c0 = (c.tid & 7) * 16;
    const float* cw = a.in[14] + (size_t)l * 4 * D + n * 128; const float* cb = a.in[15] + (size_t)l * D + n * 128;
    const int bs = hf * 64 + t_ld, row = MP + bs;
    const float* sc = a.in[4] + ((size_t)l * NS + bs) * 3 * D + n * 128;
    float* nc = a.out + O_CVS + ((size_t)l * NS + bs) * 3 * D + n * 128;
    __syncthreads();
#pragma unroll
    for (int j4 = 0; j4 < 4; ++j4) { const int cc = c0 + 4 * j4;
        const f32x4 x = ld_bf4(XB + (size_t)row * D + n * 128 + cc);
        const f32x4 s0 = *(const f32x4*)(sc + cc), s1 = *(const f32x4*)(sc + D + cc), s2 = *(const f32x4*)(sc + 2 * D + cc);
        const f32x4 acc = *(const f32x4*)(cb + cc) + *(const f32x4*)(cw + cc) * s0 + *(const f32x4*)(cw + D + cc) * s1 + *(const f32x4*)(cw + 2 * D + cc) * s2 + *(const f32x4*)(cw + 3 * D + cc) * x;
        *(LAS f32x4*)(L + L_XC + t_ld * 128 + cc) = acc;
        { u32x2 w; w.x = pk2(acc[0], acc[1]); w.y = pk2(acc[2], acc[3]); *(LAS u32x2*)(c.lds + LB_XCB + t_ld * XCB_STRIDE + cc * 2) = w; }
        *(f32x4*)(nc + cc) = s1; *(f32x4*)(nc + D + cc) = s2; *(f32x4*)(nc + 2 * D + cc) = x; }
    __syncthreads();
    lru_gates(a, c, l, n);
    __syncthreads();
    { const int cch = c.tid & 127, tg = c.tid >> 7;
#pragma unroll 4
      for (int tt = 0; tt < 16; ++tt) { const int t = tg * 16 + tt, b2 = hf * 64 + t; const size_t off = (size_t)(MP + b2) * D + n * 128 + cch;
          const float h0 = a.in[3][((size_t)l * NS + b2) * D + n * 128 + cch];
          const float h = L[L_AS + t * 128 + cch] * h0 + L[L_BS + t * 128 + cch];
          a.out[O_LRS + ((size_t)l * NS + b2) * D + n * 128 + cch] = h;
          OB[off] = (bf16)f2bf(h * bf2f(YG[off])); } }
    __syncthreads();
}

__device__ __forceinline__ void mixer_phase(CArgs& a, Ctx& c, int l) {
    if (c.wg < 64) {
        hgrn_fast_prompt(a, c, l, c.wg >> 3, c.wg & 7);
    } else if (c.wg < 192) {
        const int i = c.wg - 64;
        for (int rep = 0; rep < 1 + ((PROBE_MIX >> 1) & 1); ++rep) lru_prompt_item(a, c, l, i >> 4, (i >> 1) & 7, i & 1);
    } else {
        for (int rep = 0; rep < 1 + ((PROBE_MIX >> 2) & 1); ++rep)
        for (int it = c.wg - 192; it < NS * NH; it += c.G - 192) {
            const int bs = it >> 3, h = it & 7; const size_t so = (((size_t)l * NS + bs) * NH + h) * DKV * DKV;
            hgrn_naive(a, c, l, MP + bs, 1, h, a.in[2] + so, a.out + O_HGS + so);
        }
        if (c.wg - 192 < 16) lru_sample_item(a, c, l, (c.wg - 192) >> 1, (c.wg - 192) & 1);
    }
}

__global__ void __launch_bounds__(512, 2) mega_fwd(Args a0) {
    extern __shared__ __attribute__((aligned(16))) unsigned char lds_raw[];
    Ctx c; c.lds = (LAS unsigned char*)lds_raw; c.tid = threadIdx.x; c.G = gridDim.x; c.wg = blockIdx.x;
    volatile LAS unsigned* MISC = (volatile LAS unsigned*)(c.lds + MISC_OFF);
    if (c.tid < 32) MISC[c.tid] = 0u;
    __syncthreads();
    XcdBarrier bar; bar.bar = (unsigned*)(a0.ws + WS_CTL) + 1024; bar.x = 0; bar.st = nullptr;
    const int nprog = a0.nprog;
    if (nprog > 1) bar = xcd_barrier_post((unsigned*)(a0.ws + WS_CTL) + 1024, MISC + 8);

    for (int pi = 0; pi < nprog; ++pi) {
        CArgs* ap = (CArgs*)__builtin_amdgcn_kernarg_segment_ptr(); asm volatile("" : "+s"(ap));
        CArgs& a = *ap;
        const int ph = a.prog[pi];
        unsigned long long pt0 = 0ull; if (PROBE_T >= 100 && ph == PROBE_T - 100) pt0 = __builtin_amdgcn_s_memrealtime();
        { int t_ = threadIdx.x, w_ = blockIdx.x, g_ = gridDim.x; asm volatile("" : "+v"(t_), "+s"(w_), "+s"(g_)); c.tid = t_; c.wg = w_; c.G = g_; }
        float* X = a.out;
        if (ph == 0) { }
        else if (ph == NPHASE - 1) final_norm_phase(a, c);
        else {
            const int l = (ph - 1) / 9, j = (ph - 1) % 9;
            const bf16* wl = (const bf16*)(a.ws + WS_W + (size_t)l * WL_STRIDE);
            const float* xp = l == 0 ? a.in[0] : X; const float* xs = l == 0 ? a.in[1] : X + (size_t)MP * D;
            const float* modl = (const float*)(a.ws + WS_MOD) + (size_t)l * NMOD * 6144;
            bf16* H = (bf16*)(a.ws + WS_H);
            if (j == 0) norm_phase(a, c, l, 0, xp, xs);
            else if (j == 1) {
                EpiIn e{a.ws + WS_PREP, (bf16*)(a.ws + WS_SQ), (bf16*)(a.ws + WS_SK), (float*)(a.ws + WS_SLOGF), (bf16*)(a.ws + WS_V), (bf16*)(a.ws + WS_OG), (bf16*)(a.ws + WS_XB), (bf16*)(a.ws + WS_YG), (bf16*)(a.ws + WS_SGA), (bf16*)(a.ws + WS_SGB),
                        (const float*)(a.ws + WS_TAB) + (size_t)l * 3 * D, l == 0 ? 1 : 0};
                gemm_phase_sel<0>(c, H, wl + OFF_WIN / 2, MT, NIN, D, e);
            } else if (j == 2) hgrn_prep_phase(a, c);
            else if (j == 3) mixer_phase(a, c, l);
            else if (j == 4) {
                EpiBrA ea{(const bf16*)(a.ws + WS_SGA), (float*)(a.ws + WS_T)};
                gemm_phase_sel<1>(c, (const bf16*)(a.ws + WS_OA), wl + OFF_WA / 2, MT, D, D, ea);
                asm volatile("s_waitcnt vmcnt(0)" ::: "memory"); __syncthreads();
                { int t_ = threadIdx.x; asm volatile("" : "+v"(t_)); c.tid = t_; }
                EpiBrB eb{(const bf16*)(a.ws + WS_SGB), (const float*)(a.ws + WS_T), (bf16*)(a.ws + WS_MG)};
                gemm_phase_sel<2>(c, (const bf16*)(a.ws + WS_OB), wl + OFF_WB / 2, MT, D, D, eb);
            } else if (j == 5) {
                EpiRes e{xp, xs, X, modl, 2};
                gemm_phase_sel<3>(c, (const bf16*)(a.ws + WS_MG), wl + OFF_WO / 2, MT, D, D, e);
            } else if (j == 6) norm_phase(a, c, l, 1, X, X + (size_t)MP * D);
            else if (j == 7) { EpiFF1 e{(bf16*)(a.ws + WS_HM)}; gemm_phase_sel<4>(c, H, wl + OFF_W1 / 2, MT, FF, D, e); }
            else { float* XO = (l == 1 && XOUT_SCRATCH) ? (float*)(a.ws + WS_T) : X;
                   EpiRes e{X, X + (size_t)MP * D, XO, modl, 5}; gemm_phase_sel<5>(c, (const bf16*)(a.ws + WS_HM), wl + OFF_W2 / 2, MT, D, FF, e); }
        }
        if (ph == 0 || (ph == 4 && c.wg >= 192)) {
            { int t_ = threadIdx.x; asm volatile("" : "+v"(t_)); c.tid = t_; }
            p0_work(a, c, ph == 0 ? 0 : 1, ph == 0 ? c.wg : c.wg - 192, ph == 0 ? c.G : c.G - 192, ph == 0, ph == 0 ? 2 : 0);
        }
        if (pi + 1 < nprog) xcd_barrier(bar);
        if (PROBE_T >= 100 && ph == PROBE_T - 100 && c.wg == 0 && threadIdx.x == 0) *(float*)(a.ws + WS_DBG) = (float)(__builtin_amdgcn_s_memrealtime() - pt0) * 1e-4f;
    }
}

extern "C" void kernel_launch(void* const* d_in, const int* in_sizes, int n_in, void* d_out, int out_size, void* d_ws, size_t ws_size, hipStream_t stream) {
    static int grid = 0;
    if (grid == 0) {
        if (n_in != 27 || out_size != (int)O_END || ws_size < WS_END) { fprintf(stderr, "kernel_launch: unexpected shapes (n_in %d out %d ws %zu)\n", n_in, out_size, ws_size); grid = -1; return; }
        int dev = 0, cus = 0, per_cu = 0;
        if (hipGetDevice(&dev) != hipSuccess || hipDeviceGetAttribute(&cus, hipDeviceAttributeMultiprocessorCount, dev) != hipSuccess) { grid = -1; return; }
        if (hipFuncSetAttribute((const void*)mega_fwd, hipFuncAttributeMaxDynamicSharedMemorySize, LDS_BYTES) != hipSuccess) { fprintf(stderr, "kernel_launch: hipFuncSetAttribute failed\n"); grid = -1; return; }
        if (hipOccupancyMaxActiveBlocksPerMultiprocessor(&per_cu, (const void*)mega_fwd, 512, LDS_BYTES) != hipSuccess || per_cu < 1) { fprintf(stderr, "kernel_launch: occupancy query failed (%d)\n", per_cu); (void)hipGetLastError(); per_cu = 1; }
        grid = cus * (per_cu < 1 ? 1 : 1);
        fprintf(stderr, "kernel_launch: cus %d per_cu %d grid %d\n", cus, per_cu, grid);
    }
    if (grid < 0) return;
    (void)hipMemsetAsync((char*)d_ws + WS_CTL, 0, CTL_BYTES, stream);
    Args a{};
    for (int i = 0; i < 27; ++i) a.in[i] = (const float*)d_in[i];
    a.out = (float*)d_out; a.ws = (unsigned char*)d_ws;
    unsigned char prog[60]; int np = 0;
    for (int ph = 0; ph < NPHASE; ++ph) for (int rep = 0; rep < 1 + (int)(((unsigned)PROBE_REPEAT >> ph) & 1u); ++rep) prog[np++] = (unsigned char)ph;
#if ONE_LAUNCH
    a.nprog = np; for (int i = 0; i < np; ++i) a.prog[i] = prog[i];
    void* kargs[] = {&a};
    hipError_t e = hipLaunchCooperativeKernel((const void*)mega_fwd, dim3(grid), dim3(512), kargs, LDS_BYTES, stream);
    if (e != hipSuccess) fprintf(stderr, "kernel_launch: cooperative launch failed: %s (grid %d)\n", hipGetErrorString(e), grid);
#else
    for (int i = 0; i < np; ++i) { a.nprog = 1; a.prog[0] = prog[i]; hipLaunchKernelGGL(mega_fwd, dim3(grid), dim3(512), LDS_BYTES, stream, a); }
#endif
}
```

```cpp
#include <hip/hip_runtime.h>
#include <cstdio>
#include <cstdint>

#ifndef FAST_GEMM
#define FAST_GEMM 63
#endif
#ifndef FAST_HGRN
#define FAST_HGRN 1
#endif
#ifndef FAST_GATES
#define FAST_GATES 1
#endif
#ifndef DBG_SHFL
#define DBG_SHFL 1
#endif
#ifndef PROBE_REPEAT
#define PROBE_REPEAT 0
#endif
#ifndef PROBE_MIX
#define PROBE_MIX 0
#endif
#ifndef PROBE_P0
#define PROBE_P0 0
#endif
#ifndef XOUT_SCRATCH
#define XOUT_SCRATCH 0
#endif
#ifndef PROBE_T
#define PROBE_T 0
#endif
#ifndef ONE_LAUNCH
#define ONE_LAUNCH 1
#endif

#define LAS __attribute__((address_space(3)))
#define GAS __attribute__((address_space(1)))
typedef unsigned short bf16;
typedef float f32x4 __attribute__((ext_vector_type(4)));
typedef float f32x2 __attribute__((ext_vector_type(2)));
typedef short bf16x8 __attribute__((ext_vector_type(8)));
typedef unsigned u32x4 __attribute__((ext_vector_type(4)));
typedef unsigned u32x2 __attribute__((ext_vector_type(2)));

constexpr int D = 1024, NBATCH = 8, SEQ = 2048, MP = NBATCH * SEQ, NS = 128, MR = MP + NS, MT = 16640;
constexpr int NMOD = NBATCH + NS;
constexpr int NIN = 8192, FF = 4096, NH = 8, DKV = 128;
constexpr float EPS = 1e-6f;
constexpr int NPHASE = 20;

constexpr size_t MiB = (size_t)1 << 20;
constexpr size_t WS_CTL = 0, CTL_BYTES = 64 * 1024;
constexpr size_t WS_DBG = 512 * 1024;
constexpr size_t WS_TAB = 1 * MiB;
constexpr size_t WS_MOD = 2 * MiB;
constexpr size_t WS_W = 9 * MiB, WL_STRIDE = 77 * MiB / 2;
constexpr size_t OFF_WIN = 0, OFF_WA = 16 * MiB, OFF_WB = 18 * MiB, OFF_WO = 20 * MiB, OFF_W1 = 22 * MiB, OFF_W2 = 30 * MiB, OFF_LWA = 38 * MiB, OFF_LWX = 38 * MiB + 256 * 1024;
constexpr size_t WS_H = 86 * MiB;
constexpr size_t WS_PREP = 119 * MiB;
constexpr size_t PREP_BLK = 65536;
constexpr size_t WS_V = 247 * MiB, WS_OG = 280 * MiB, WS_XB = 313 * MiB, WS_YG = 346 * MiB, WS_SGA = 379 * MiB, WS_SGB = 412 * MiB;
constexpr size_t WS_OA = 445 * MiB;
constexpr size_t WS_SQ = 478 * MiB, WS_SK = WS_SQ + 256 * 1024, WS_SLOGF = WS_SQ + 512 * 1024;
constexpr size_t WS_OB = WS_H;
constexpr size_t WS_T = WS_PREP;
constexpr size_t WS_MG = WS_PREP + 66 * MiB;
constexpr size_t WS_HM = WS_PREP;
constexpr size_t WS_END = 480 * MiB;
static_assert(WS_W + 2 * WL_STRIDE <= WS_H && WS_H + (size_t)MT * D * 2 <= WS_PREP && WS_PREP + 2048 * PREP_BLK <= WS_V && WS_T + (size_t)MT * D * 4 <= WS_MG && WS_MG + (size_t)MT * D * 2 <= WS_V
              && WS_HM + (size_t)MT * FF * 2 <= WS_OG && WS_OA + (size_t)MT * D * 2 <= WS_SQ && WS_SLOGF + 512 * 1024 <= WS_END, "ws map");

constexpr size_t O_YP = 0, O_YS = (size_t)MP * D, O_HGP = O_YS + (size_t)NS * D, O_LRP = O_HGP + (size_t)2 * NBATCH * NH * DKV * DKV, O_CVP = O_LRP + (size_t)2 * NBATCH * D,
                 O_HGS = O_CVP + (size_t)2 * NBATCH * 3 * D, O_LRS = O_HGS + (size_t)2 * NS * NH * DKV * DKV, O_CVS = O_LRS + (size_t)2 * NS * D, O_END = O_CVS + (size_t)2 * NS * 3 * D;
static_assert(O_END == 53673984, "out map");

constexpr int LDS_BYTES = 163840;
constexpr int MISC_OFF = 158 * 1024;

typedef __bf16 bf16x2_t __attribute__((ext_vector_type(2)));
__device__ __forceinline__ unsigned f2bf(float f) { return (unsigned)__builtin_bit_cast(unsigned short, (__bf16)f); }
__device__ __forceinline__ unsigned pk2(float lo, float hi) { return __builtin_bit_cast(unsigned, __builtin_convertvector((f32x2){lo, hi}, bf16x2_t)); }
__device__ __forceinline__ float bf2f(unsigned b) { return __builtin_bit_cast(float, b << 16); }
__device__ __forceinline__ f32x4 ld_bf4(const bf16* p) { const u32x2 w = *(const u32x2*)p; return (f32x4){bf2f(w.x & 0xffffu), bf2f(w.x >> 16), bf2f(w.y & 0xffffu), bf2f(w.y >> 16)}; }
__device__ __forceinline__ void st_bf4(bf16* p, f32x4 v) { u32x2 w; w.x = pk2(v[0], v[1]); w.y = pk2(v[2], v[3]); *(u32x2*)p = w; }
#define WG_BAR() do { asm volatile("s_waitcnt lgkmcnt(0)" ::: "memory"); __builtin_amdgcn_s_barrier(); asm volatile("" ::: "memory"); } while (0)
__device__ __forceinline__ float sig_fast(float x) { return __builtin_amdgcn_rcpf(1.0f + __expf(-x)); }
__device__ __forceinline__ void st_bf8(bf16* p, f32x4 v0, f32x4 v1) { u32x4 w; w.x = pk2(v0[0], v0[1]); w.y = pk2(v0[2], v0[3]); w.z = pk2(v1[0], v1[1]); w.w = pk2(v1[2], v1[3]); *(u32x4*)p = w; }
__device__ __forceinline__ void ld_bf8(const bf16* p, f32x4& v0, f32x4& v1) { const u32x4 w = *(const u32x4*)p; v0 = (f32x4){bf2f(w.x & 0xffffu), bf2f(w.x >> 16), bf2f(w.y & 0xffffu), bf2f(w.y >> 16)}; v1 = (f32x4){bf2f(w.z & 0xffffu), bf2f(w.z >> 16), bf2f(w.w & 0xffffu), bf2f(w.w >> 16)}; }
__device__ __forceinline__ float sigmoidf_(float x) { return 1.0f / (1.0f + __expf(-x)); }
__device__ __forceinline__ float siluf_(float x) { return x * sigmoidf_(x); }
__device__ __forceinline__ float gelu_tanh_(float x) { const float u = 0.7978845608028654f * (x + 0.044715f * x * x * x); return x * sigmoidf_(2.0f * u); }
__device__ __forceinline__ float softplusf_(float x) { return fmaxf(x, 0.f) + log1pf(expf(-fabsf(x))); }
template <int XM> __device__ __forceinline__ float swz_xor(float v) { return __builtin_bit_cast(float, __builtin_amdgcn_ds_swizzle(__builtin_bit_cast(int, v), (XM << 10) | 0x1f)); }
__device__ __forceinline__ int lane_id_fresh() { int l = (int)__builtin_amdgcn_mbcnt_hi(~0u, __builtin_amdgcn_mbcnt_lo(~0u, 0u)); asm volatile("" : "+v"(l)); return l; }
__device__ __forceinline__ float xchg(float v, int l, int m) { return __builtin_bit_cast(float, __builtin_amdgcn_ds_bpermute((l ^ m) << 2, __builtin_bit_cast(int, v))); }
template <int CTRL> __device__ __forceinline__ float dpp_f(float v) { return __builtin_bit_cast(float, __builtin_amdgcn_update_dpp(0, __builtin_bit_cast(int, v), CTRL, 0xf, 0xf, false)); }
__device__ __forceinline__ float row16_sum(float v) { v += dpp_f<0xB1>(v); v += dpp_f<0x4E>(v); v += dpp_f<0x141>(v); v += dpp_f<0x140>(v); return v; }
__device__ __forceinline__ float half_sum(float v) { const int l = lane_id_fresh(); v += xchg(v, l, 1); v += xchg(v, l, 2); v += xchg(v, l, 4); v += xchg(v, l, 8); v += xchg(v, l, 16); return v; }
__device__ __forceinline__ float wave_sum(float v) { const int l = lane_id_fresh(); v += xchg(v, l, 1); v += xchg(v, l, 2); v += xchg(v, l, 4); v += xchg(v, l, 8); v += xchg(v, l, 16); v += xchg(v, l, 32); return v; }
__device__ __forceinline__ int mod_row(int row) { return row < MP ? (row >> 11) : (NBATCH + row - MP); }

struct Args { const float* in[27]; float* out; unsigned char* ws; int nprog; unsigned char prog[60]; };
typedef const __attribute__((address_space(4))) Args CArgs;
struct Ctx { LAS unsigned char* lds; int tid, G, wg; };
namespace pg8 {
#define PG8_LAS __attribute__((address_space(3)))
typedef unsigned short bf16_t;
typedef short bf16x8 __attribute__((ext_vector_type(8)));
typedef float f32x4 __attribute__((ext_vector_type(4)));
typedef unsigned u32x4 __attribute__((ext_vector_type(4)));
constexpr int BM = 256, BK = 64, HALF = 128, HTB = HALF * BK * 2  , STAGE_BYTES = 8 * HTB, NXCD = 8, WGM = 8;

__host__ __device__ __forceinline__ int lds_byte(int r, int c) { const int st = (r >> 4) * 2 + (c >> 5), rr = r & 15, cc = c & 31, ob = rr * 64 + cc * 2; return st * 1024 + (ob ^ (((ob >> 9) & 1) << 5)); }
__host__ __device__ __forceinline__ void stage_rc(int b, int& R, int& C) { const int st = b / 1024, sb = b % 1024, swz = sb ^ (((sb >> 9) & 1) << 5); R = (st >> 1) * 16 + swz / 64; C = (st & 1) * 32 + (swz % 64) / 2; }
__host__ __device__ __forceinline__ int perm32(int rho) { const int n = rho >> 4, i = rho & 15; return 8 * (i >> 2) + 4 * n + (i & 3); }

struct Unit { int pm, pn, z; };
struct Gemm { const bf16_t* A; const bf16_t* Bt; int M, N, K; const bf16_t* A2; const bf16_t* Bt2; };

struct StaticOrder {
    int nM, nN, nwg, G, c;
    __host__ __device__ void init(int M, int N, int G_, int c_) { nM = M / BM; nN = N / BM; nwg = nM * nN; G = G_; c = c_; }
    __host__ __device__ bool next(int i, Unit& u) const {
        const long L = (long)i * G + c; if (L >= nwg) return false;
        int wgid = (int)L; { const int q = nwg / NXCD, r = nwg % NXCD, xcd = wgid % NXCD, off = wgid / NXCD; wgid = (xcd < r ? xcd * (q + 1) : r * (q + 1) + (xcd - r) * q) + off; }
        const int nig = WGM * nN, gid = wgid / nig, fm = gid * WGM, gsz = (nM - fm) < WGM ? (nM - fm) : WGM;
        u.pm = fm + ((wgid % nig) % gsz); u.pn = (wgid % nig) / gsz; u.z = 0; return true;
    }
    __device__ __forceinline__ void a_ready(const Unit&) const {}
    __device__ __forceinline__ void done(const Unit&) const {}
};
template <class Epi, class Sched, bool ALIGN_EPI = false, bool SP2 = false>
__device__ __forceinline__ void gemm_phase(PG8_LAS unsigned char* lds, const Gemm g, const Sched& S, const Epi& E, const int tid_in) {
    const int tid = tid_in, wid = __builtin_amdgcn_readfirstlane(tid >> 6), lane = tid & 63, wr = wid >> 2, wc = wid & 3, fr = lane & 15, fq = lane >> 4;
    const int K = g.K, nt = K / BK;
    unsigned voffA[2], voffB[2];
#pragma unroll
    for (int i = 0; i < 2; ++i) { int R, C; stage_rc(tid * 16 + i * 8192, R, C); const int Rb = Epi::PERM ? ((R & ~31) + perm32(R & 31)) : R;
        voffA[i] = (unsigned)(R * K + C) * 2u; voffB[i] = (unsigned)(Rb * K + C) * 2u; }
    const size_t kstep = (size_t)(BK * 2);
    const size_t hstep = (size_t)HALF * K * 2;
    const size_t tstep = 2 * hstep;
    const unsigned ldsw = (unsigned)wid * 1024u;
    const int aoff = lds_byte(wr * 64 + fr, fq * 8), boff = lds_byte(wc * 32 + fr, fq * 8);
#define PG8_SA(b, h) (((b) * 2 + (h)) * HTB)
#define PG8_SB(b, h) ((4 + (b) * 2 + (h)) * HTB)
#define PG8_STAGE(bufoff, gbase, voff) do { _Pragma("unroll") for (int _i = 0; _i < 2; ++_i) \
        __builtin_amdgcn_global_load_lds((const unsigned*)((const char*)(gbase) + (voff)[_i]), (PG8_LAS unsigned*)(lds + (bufoff) + ldsw + _i * 8192), 16, 0, 0); } while (0)
#define PG8_LDA(dst, b, h) do { _Pragma("unroll") for (int m = 0; m < 4; ++m) _Pragma("unroll") for (int k = 0; k < 2; ++k) dst[m][k] = *(const PG8_LAS bf16x8*)(lds + PG8_SA(b, h) + aoff + m * 2048 + k * 1024); } while (0)
#define PG8_LDB(dst, b, h) do { _Pragma("unroll") for (int n = 0; n < 2; ++n) _Pragma("unroll") for (int k = 0; k < 2; ++k) dst[n][k] = *(const PG8_LAS bf16x8*)(lds + PG8_SB(b, h) + boff + n * 2048 + k * 1024); } while (0)
#define PG8_MMA(ai, bj, At, Bt) do { __builtin_amdgcn_s_setprio(1); _Pragma("unroll") for (int m = 0; m < 4; ++m) _Pragma("unroll") for (int n = 0; n < 2; ++n) _Pragma("unroll") for (int k = 0; k < 2; ++k) \
        acc[ai][bj][m][n] = __builtin_amdgcn_mfma_f32_16x16x32_bf16(Bt[n][k], At[m][k], acc[ai][bj][m][n], 0, 0, 0); __builtin_amdgcn_s_setprio(0); } while (0)
#define PG8_WAIT_V(n) asm volatile("s_waitcnt vmcnt(" #n ")" ::: "memory")
#define PG8_WAIT_L(n) asm volatile("s_waitcnt lgkmcnt(" #n ")" ::: "memory")
#define PG8_BAR __builtin_amdgcn_s_barrier()
#define PG8_SCHED __builtin_amdgcn_sched_barrier(0)
    Unit cur, nxt; int ui = 0;
    if (!S.next(0, cur)) return;
    f32x4 acc[2][2][4][2];
#pragma unroll
    for (int a = 0; a < 2; ++a)
#pragma unroll
        for (int b = 0; b < 2; ++b)
#pragma unroll
            for (int m = 0; m < 4; ++m)
#pragma unroll
                for (int n = 0; n < 2; ++n) acc[a][b][m][n] = (f32x4){0.f, 0.f, 0.f, 0.f};
    bf16x8 At[4][2], B0[2][2], B1[2][2];
    const char* cA = (const char*)(cur.z ? g.A2 : g.A) + (size_t)cur.pm * tstep; const char* cB = (const char*)(cur.z ? g.Bt2 : g.Bt) + (size_t)cur.pn * tstep;
    S.a_ready(cur);
    if constexpr (SP2) {
        PG8_STAGE(PG8_SB(0, 0), cB, voffB); PG8_STAGE(PG8_SB(0, 1), cB + hstep, voffB); PG8_STAGE(PG8_SA(0, 0), cA, voffA); PG8_STAGE(PG8_SA(0, 1), cA + hstep, voffA);
        if (wr == 1) PG8_BAR;
        PG8_WAIT_V(2); PG8_BAR;
        PG8_STAGE(PG8_SB(1, 0), cB + kstep, voffB); PG8_STAGE(PG8_SA(1, 0), cA + kstep, voffA); PG8_STAGE(PG8_SB(1, 1), cB + hstep + kstep, voffB);
        PG8_WAIT_V(6); PG8_BAR;
    } else {
        PG8_STAGE(PG8_SB(0, 0), cB, voffB); PG8_STAGE(PG8_SA(0, 0), cA, voffA); PG8_STAGE(PG8_SB(0, 1), cB + hstep, voffB); PG8_STAGE(PG8_SA(0, 1), cA + hstep, voffA);
        if (wr == 1) PG8_BAR;
        PG8_WAIT_V(4); PG8_BAR;
        PG8_STAGE(PG8_SB(1, 0), cB + kstep, voffB); PG8_STAGE(PG8_SA(1, 0), cA + kstep, voffA); PG8_STAGE(PG8_SB(1, 1), cB + hstep + kstep, voffB);
        PG8_WAIT_V(6); PG8_BAR;
    }
    for (;;) {
        const bool has_next = S.next(ui + 1, nxt);
        const char* nA = has_next ? (const char*)(nxt.z ? g.A2 : g.A) + (size_t)nxt.pm * tstep : cA; const char* nB = has_next ? (const char*)(nxt.z ? g.Bt2 : g.Bt) + (size_t)nxt.pn * tstep : cB;
        for (int t = 0; t < nt; t += 2) {
            const bool last = (t == nt - 2);
            const char* a1 = cA + (size_t)(t + 1) * kstep;
            const char* a2 = last ? nA : cA + (size_t)(t + 2) * kstep; const char* b2 = last ? nB : cB + (size_t)(t + 2) * kstep;
            const char* a3 = a2 + kstep; const char* b3 = b2 + kstep;
            if (last && has_next) S.a_ready(nxt);
            if constexpr (SP2) {
            PG8_LDB(B0, 0, 0); PG8_LDB(B1, 0, 1); PG8_SCHED; PG8_LDA(At, 0, 0); PG8_STAGE(PG8_SA(1, 1), a1 + hstep, voffA);
            PG8_WAIT_V(8); PG8_WAIT_L(0); PG8_BAR; PG8_MMA(0, 0, At, B0); PG8_MMA(0, 1, At, B1); PG8_BAR; PG8_SCHED;
            PG8_LDA(At, 0, 1); PG8_STAGE(PG8_SB(0, 0), b2, voffB); PG8_STAGE(PG8_SB(0, 1), b2 + hstep, voffB); PG8_STAGE(PG8_SA(0, 0), a2, voffA);
            PG8_WAIT_V(8); PG8_WAIT_L(0); PG8_BAR; PG8_MMA(1, 0, At, B0); PG8_MMA(1, 1, At, B1); PG8_BAR; PG8_SCHED;
            PG8_LDB(B0, 1, 0); PG8_LDB(B1, 1, 1); PG8_SCHED; PG8_LDA(At, 1, 0); PG8_STAGE(PG8_SA(0, 1), a2 + hstep, voffA);
            PG8_WAIT_V(8); PG8_WAIT_L(0); PG8_BAR; PG8_MMA(0, 0, At, B0); PG8_MMA(0, 1, At, B1); PG8_BAR; PG8_SCHED;
            PG8_LDA(At, 1, 1); PG8_STAGE(PG8_SB(1, 0), b3, voffB); PG8_STAGE(PG8_SB(1, 1), b3 + hstep, voffB); PG8_STAGE(PG8_SA(1, 0), a3, voffA);
            PG8_WAIT_V(8); PG8_WAIT_L(0); PG8_BAR; PG8_MMA(1, 0, At, B0); PG8_MMA(1, 1, At, B1); PG8_BAR; PG8_SCHED;
            } else {
            PG8_LDB(B0, 0, 0); PG8_SCHED; PG8_LDA(At, 0, 0); PG8_STAGE(PG8_SA(1, 1), a1 + hstep, voffA);
            PG8_WAIT_L(8); PG8_BAR; PG8_WAIT_L(0); PG8_MMA(0, 0, At, B0); PG8_BAR; PG8_SCHED;
            PG8_LDB(B1, 0, 1); PG8_STAGE(PG8_SB(0, 0), b2, voffB);
            PG8_BAR; PG8_WAIT_L(0); PG8_MMA(0, 1, At, B1); PG8_BAR;
            PG8_LDA(At, 0, 1); PG8_STAGE(PG8_SA(0, 0), a2, voffA);
            PG8_BAR; PG8_WAIT_L(0); PG8_MMA(1, 0, At, B0); PG8_BAR; PG8_SCHED;
            PG8_STAGE(PG8_SB(0, 1), b2 + hstep, voffB);
            PG8_WAIT_V(6); PG8_BAR; PG8_MMA(1, 1, At, B1); PG8_BAR;
            PG8_LDB(B0, 1, 0); PG8_SCHED; PG8_LDA(At, 1, 0); PG8_STAGE(PG8_SA(0, 1), a2 + hstep, voffA);
            PG8_WAIT_L(8); PG8_BAR; PG8_WAIT_L(0); PG8_MMA(0, 0, At, B0); PG8_BAR; PG8_SCHED;
            PG8_LDB(B1, 1, 1); PG8_STAGE(PG8_SB(1, 0), b3, voffB);
            PG8_BAR; PG8_WAIT_L(0); PG8_MMA(0, 1, At, B1); PG8_BAR;
            PG8_LDA(At, 1, 1); PG8_STAGE(PG8_SA(1, 0), a3, voffA);
            PG8_BAR; PG8_WAIT_L(0); PG8_MMA(1, 0, At, B0); PG8_BAR; PG8_SCHED;
            PG8_STAGE(PG8_SB(1, 1), b3 + hstep, voffB);
            PG8_WAIT_V(6); PG8_BAR; PG8_MMA(1, 1, At, B1); PG8_BAR;
            }
        }
        if constexpr (ALIGN_EPI) { if (wr == 0) PG8_BAR; }
        if constexpr (!Epi::AFTER_DRAIN) { int l2 = (int)__builtin_amdgcn_mbcnt_hi(~0u, __builtin_amdgcn_mbcnt_lo(~0u, 0u)); asm volatile("" : "+v"(l2));
            E(acc, cur, wr, wc, l2 & 15, l2 >> 4); S.done(cur); }
        if (!has_next) break;
        if (!(Epi::KEEP && cur.z == 0)) {
#pragma unroll
        for (int a = 0; a < 2; ++a)
#pragma unroll
            for (int b = 0; b < 2; ++b)
#pragma unroll
                for (int m = 0; m < 4; ++m)
#pragma unroll
                    for (int n = 0; n < 2; ++n) acc[a][b][m][n] = (f32x4){0.f, 0.f, 0.f, 0.f};
        }
        cur = nxt; cA = nA; cB = nB; ++ui;
        if constexpr (ALIGN_EPI) { if (wr == 1) PG8_BAR; }
    }
    PG8_WAIT_V(0);
    if constexpr (!ALIGN_EPI) { if (wr == 0) PG8_BAR; }
    PG8_BAR;
    if constexpr (Epi::AFTER_DRAIN) { E.fused(acc, cur, wr, wc, fr, fq, lds, wid, lane); S.done(cur); }
#undef PG8_SA
#undef PG8_SB
#undef PG8_STAGE
#undef PG8_LDA
#undef PG8_LDB
#undef PG8_MMA
#undef PG8_WAIT_V
#undef PG8_WAIT_L
#undef PG8_BAR
#undef PG8_SCHED
}
}

template <class E> struct QuadEpi {
    static constexpr bool PERM = false, AFTER_DRAIN = false, KEEP = false;
    E e;
    __device__ __forceinline__ void operator()(const f32x4 (&acc)[2][2][4][2], const pg8::Unit& u, int wr, int wc, int fr, int fq) const {
        const int row0 = u.pm * 256 + wr * 64 + fr, col0 = u.pn * 256 + wc * 32 + 4 * fq;
#pragma unroll
        for (int ai = 0; ai < 2; ++ai)
#pragma unroll
            for (int m = 0; m < 4; ++m)
#pragma unroll
                for (int bj = 0; bj < 2; ++bj)
#pragma unroll
                    for (int n = 0; n < 2; ++n) e.quad(row0 + ai * 128 + m * 16, col0 + bj * 128 + n * 16, acc[ai][bj][m][n]);
    }
};

struct EpiIn {
    unsigned char* PREP; bf16 *SQ, *SK; float* SLOGF; bf16 *V, *OG, *XB, *YG, *SGA, *SGB; const float* lbt; int lb0;
    static constexpr bool BY_REGION = true;
    __device__ __forceinline__ size_t blk_off(int row, int cc) const { return (((size_t)(row >> 11) * 32 + ((row >> 6) & 31)) * 8 + (cc >> 7)) * PREP_BLK; }
    __device__ __forceinline__ bf16* q_ptr(int row, int cc) const { return row < MP ? (bf16*)(PREP + blk_off(row, cc) + 32768) + (row & 63) * 128 + (cc & 127) : SQ + (size_t)(row - MP) * D + cc; }
    __device__ __forceinline__ bf16* k_ptr(int row, int cc) const { return row < MP ? (bf16*)(PREP + blk_off(row, cc) + 49152) + (row & 63) * 128 + (cc & 127) : SK + (size_t)(row - MP) * D + cc; }
    __device__ __forceinline__ float* lf_ptr(int row, int cc) const { return row < MP ? (float*)(PREP + blk_off(row, cc)) + (row & 63) * 128 + (cc & 127) : SLOGF + (size_t)(row - MP) * D + cc; }
    __device__ __forceinline__ f32x2 fgate(float fa, float lb, float llb, float l1m) const {
        float lf, kk;
        const float t = __expf(-fabsf(fa));
        const float ls = fminf(fa, 0.f) - __logf(1.0f + t);
        const float sneg = (fa >= 0.f ? t : 1.0f) * __builtin_amdgcn_rcpf(1.0f + t);
        if (lb0) { lf = ls; kk = sneg; }
        else { const float b = l1m + ls, mx = fmaxf(llb, b); lf = mx + __logf(1.0f + __expf(-fabsf(llb - b))); kk = (1.0f - lb) * sneg; }
        return (f32x2){lf, kk};
    }
    template <int R> __device__ __forceinline__ f32x4 act(f32x4 v) const {
        f32x4 r;
#pragma unroll
        for (int j = 0; j < 4; ++j) {
            if constexpr (R == 0 || R == 3) r[j] = v[j] * sig_fast(v[j]);
            else if constexpr (R == 5) { const float x = v[j], u = 0.7978845608028654f * (x + 0.044715f * x * x * x); r[j] = x * sig_fast(2.0f * u); }
            else if constexpr (R >= 6) r[j] = sig_fast(v[j]);
            else r[j] = v[j];
        }
        return r;
    }
    template <int R> __device__ __forceinline__ bf16* dst(int row, int cc) const { return R == 0 ? q_ptr(row, cc) : (R == 2 ? V : R == 3 ? OG : R == 4 ? XB : R == 5 ? YG : R == 6 ? SGA : SGB) + (size_t)row * D + cc; }
    template <int R> __device__ __forceinline__ void quadR(int row, int cc, f32x4 v) const {
        const size_t o = (size_t)row * D + cc;
        if constexpr (R == 1) {
            const f32x4 lb = *(const f32x4*)(lbt + cc), llb = *(const f32x4*)(lbt + 1024 + cc), l1m = *(const f32x4*)(lbt + 2048 + cc);
            f32x4 lf, r;
#pragma unroll
            for (int j = 0; j < 4; ++j) { const f32x2 g = fgate(v[j], lb[j], llb[j], l1m[j]); lf[j] = g.x; r[j] = g.y; }
            *(f32x4*)lf_ptr(row, cc) = lf; st_bf4(k_ptr(row, cc), r);
        } else st_bf4(dst<R>(row, cc), act<R>(v));
    }
    template <int R> __device__ __forceinline__ void octR(int row, int cc, f32x4 v0, f32x4 v1) const {
        const size_t o = (size_t)row * D + cc;
        if constexpr (R == 1) {
            f32x4 lf0, lf1, r0, r1;
            if (lb0) {
#pragma unroll
                for (int j = 0; j < 4; ++j) { const f32x2 g0 = fgate(v0[j], 0.f, 0.f, 0.f), g1 = fgate(v1[j], 0.f, 0.f, 0.f); lf0[j] = g0.x; r0[j] = g0.y; lf1[j] = g1.x; r1[j] = g1.y; }
            } else {
                const f32x4 lba = *(const f32x4*)(lbt + cc), lbb = *(const f32x4*)(lbt + cc + 4), lla = *(const f32x4*)(lbt + 1024 + cc), llb_ = *(const f32x4*)(lbt + 1024 + cc + 4), l1a = *(const f32x4*)(lbt + 2048 + cc), l1b = *(const f32x4*)(lbt + 2048 + cc + 4);
#pragma unroll
                for (int j = 0; j < 4; ++j) { const f32x2 g0 = fgate(v0[j], lba[j], lla[j], l1a[j]), g1 = fgate(v1[j], lbb[j], llb_[j], l1b[j]); lf0[j] = g0.x; r0[j] = g0.y; lf1[j] = g1.x; r1[j] = g1.y; }
            }
            float* lp = lf_ptr(row, cc); *(f32x4*)lp = lf0; *(f32x4*)(lp + 4) = lf1; st_bf8(k_ptr(row, cc), r0, r1);
        } else st_bf8(dst<R>(row, cc), act<R>(v0), act<R>(v1));
    }
    __device__ __forceinline__ void quad(int row, int col, f32x4 v) const {
        const int reg = col >> 10, cc = col & 1023;
        switch (reg) { case 0: quadR<0>(row, cc, v); break; case 1: quadR<1>(row, cc, v); break; case 2: quadR<2>(row, cc, v); break; case 3: quadR<3>(row, cc, v); break;
                       case 4: quadR<4>(row, cc, v); break; case 5: quadR<5>(row, cc, v); break; case 6: quadR<6>(row, cc, v); break; default: quadR<7>(row, cc, v); break; }
    }
};
struct EpiInUnit {
    static constexpr bool PERM = true, AFTER_DRAIN = false, KEEP = false;
    EpiIn e;
    template <int KIND> __device__ __forceinline__ void run(const f32x4 (&acc)[2][2][4][2], int row0, int cc0, bf16* dstp, int mode) const {
#pragma unroll
        for (int ai = 0; ai < 2; ++ai)
#pragma unroll
            for (int m = 0; m < 4; ++m) {
#pragma unroll
                for (int bj = 0; bj < 2; ++bj) {
                    const int row = row0 + ai * 128 + m * 16, cc = cc0 + bj * 128;
                    const f32x4 v0 = acc[ai][bj][m][0], v1 = acc[ai][bj][m][1];
                    if constexpr (KIND == 0) e.octR<1>(row, cc, v0, v1);
                    else if constexpr (KIND == 1) st_bf8(dstp + (size_t)row * D + cc, v0, v1);
                    else { f32x4 r0, r1;
#pragma unroll
                        for (int j = 0; j < 4; ++j) {
                            const float x0 = v0[j], x1 = v1[j];
                            const float a0 = mode == 1 ? 1.5957691216057308f * (x0 + 0.044715f * x0 * x0 * x0) : x0, a1 = mode == 1 ? 1.5957691216057308f * (x1 + 0.044715f * x1 * x1 * x1) : x1;
                            const float s0 = sig_fast(a0), s1 = sig_fast(a1);
                            r0[j] = mode == 2 ? s0 : x0 * s0; r1[j] = mode == 2 ? s1 : x1 * s1; }
                        st_bf8(dstp ? dstp + (size_t)row * D + cc : e.q_ptr(row, cc), r0, r1); }
                }
                asm volatile("" ::: "memory"); __builtin_amdgcn_sched_barrier(0); }
    }
    __device__ __forceinline__ void operator()(const f32x4 (&acc)[2][2][4][2], const pg8::Unit& u, int wr, int wc, int fr, int fq) const {
        const int row0 = u.pm * 256 + wr * 64 + fr, cc0 = (u.pn & 3) * 256 + wc * 32 + 8 * fq, reg = u.pn >> 2;
        if (reg == 1) run<0>(acc, row0, cc0, nullptr, 0);
        else if (reg == 2 || reg == 4) run<1>(acc, row0, cc0, reg == 2 ? e.V : e.XB, 0);
        else { bf16* dp = reg == 0 ? nullptr : reg == 3 ? e.OG : reg == 5 ? e.YG : reg == 6 ? e.SGA : e.SGB;
               run<2>(acc, row0, cc0, dp, reg == 5 ? 1 : (reg >= 6 ? 2 : 0)); }
    }
};
template <class E> struct OctEpi {
    static constexpr bool PERM = true, AFTER_DRAIN = false, KEEP = false;
    E e;
    __device__ __forceinline__ void operator()(const f32x4 (&acc)[2][2][4][2], const pg8::Unit& u, int wr, int wc, int fr, int fq) const {
        const int row0 = u.pm * 256 + wr * 64 + fr, col0 = u.pn * 256 + wc * 32 + 8 * fq;
#pragma unroll
        for (int ai = 0; ai < 2; ++ai)
#pragma unroll
            for (int m = 0; m < 4; ++m) {
#pragma unroll
                for (int bj = 0; bj < 2; ++bj) e.oct(row0 + ai * 128 + m * 16, col0 + bj * 128, acc[ai][bj][m][0], acc[ai][bj][m][1]);
                asm volatile("" ::: "memory"); __builtin_amdgcn_sched_barrier(0); }
    }
};
struct EpiBrA { static constexpr bool BY_REGION = false; const bf16* SGA; float* T;
    __device__ __forceinline__ void quad(int row, int col, f32x4 v) const { const size_t o = (size_t)row * D + col; *(f32x4*)(T + o) = ld_bf4(SGA + o) * v; }
    __device__ __forceinline__ void oct(int row, int col, f32x4 v0, f32x4 v1) const { const size_t o = (size_t)row * D + col; f32x4 g0, g1; ld_bf8(SGA + o, g0, g1); *(f32x4*)(T + o) = g0 * v0; *(f32x4*)(T + o + 4) = g1 * v1; } };
struct EpiBrB { static constexpr bool BY_REGION = false; const bf16* SGB; const float* T; bf16* MG;
    __device__ __forceinline__ void quad(int row, int col, f32x4 v) const { const size_t o = (size_t)row * D + col; st_bf4(MG + o, *(const f32x4*)(T + o) + ld_bf4(SGB + o) * v); }
    __device__ __forceinline__ void oct(int row, int col, f32x4 v0, f32x4 v1) const { const size_t o = (size_t)row * D + col; f32x4 g0, g1; ld_bf8(SGB + o, g0, g1);
        st_bf8(MG + o, *(const f32x4*)(T + o) + g0 * v0, *(const f32x4*)(T + o + 4) + g1 * v1); } };
struct EpiBranchUnit {
    static constexpr bool PERM = true, AFTER_DRAIN = false, KEEP = true;
    const bf16* SGA; const bf16* SGB; bf16* MG;
    __device__ __forceinline__ void operator()(const f32x4 (&acc_c)[2][2][4][2], const pg8::Unit& u, int wr, int wc, int fr, int fq) const {
        f32x4 (&acc)[2][2][4][2] = const_cast<f32x4 (&)[2][2][4][2]>(acc_c);
        const int row0 = u.pm * 256 + wr * 64 + fr, col0 = u.pn * 256 + wc * 32 + 8 * fq;
#pragma unroll
        for (int ai = 0; ai < 2; ++ai)
#pragma unroll
            for (int m = 0; m < 4; ++m) {
#pragma unroll
                for (int bj = 0; bj < 2; ++bj) { const size_t o = (size_t)(row0 + ai * 128 + m * 16) * D + col0 + bj * 128;
                    f32x4 b0, b1; ld_bf8(SGB + o, b0, b1);
                    if (u.z == 0) { f32x4 a0, a1; ld_bf8(SGA + o, a0, a1);
#pragma unroll
                        for (int j = 0; j < 4; ++j) { acc[ai][bj][m][0][j] *= a0[j] * __builtin_amdgcn_rcpf(fmaxf(b0[j], 1e-30f)); acc[ai][bj][m][1][j] *= a1[j] * __builtin_amdgcn_rcpf(fmaxf(b1[j], 1e-30f)); } }
                    else st_bf8(MG + o, acc[ai][bj][m][0] * b0, acc[ai][bj][m][1] * b1); }
                asm volatile("" ::: "memory"); __builtin_amdgcn_sched_barrier(0); }
    }
};
struct EpiRes { static constexpr bool BY_REGION = false; const float* xp; const float* xs; float* X; const float* modl; int gi;
    __device__ __forceinline__ void quad(int row, int col, f32x4 v) const {
        if (row >= MR) return;
        const float* src = row < MP ? xp + (size_t)row * D : xs + (size_t)(row - MP) * D;
        const f32x4 g = *(const f32x4*)(modl + (size_t)mod_row(row) * 6144 + gi * 1024 + col);
        *(f32x4*)(X + (size_t)row * D + col) = *(const f32x4*)(src + col) + g * v;
    }
    __device__ __forceinline__ void oct(int row, int col, f32x4 v0, f32x4 v1) const { quad(row, col, v0); quad(row, col + 4, v1); } };
struct EpiFF1 { static constexpr bool BY_REGION = false; bf16* HM;
    __device__ __forceinline__ void quad(int row, int col, f32x4 v) const {
        f32x4 r;
#pragma unroll
        for (int j = 0; j < 4; ++j) { const float t = fmaxf(v[j], 0.f); r[j] = t * t; }
        st_bf4(HM + (size_t)row * FF + col, r);
    }
    __device__ __forceinline__ void oct(int row, int col, f32x4 v0, f32x4 v1) const {
        f32x4 r0, r1;
#pragma unroll
        for (int j = 0; j < 4; ++j) { const float t0 = fmaxf(v0[j], 0.f), t1 = fmaxf(v1[j], 0.f); r0[j] = t0 * t0; r1[j] = t1 * t1; }
        st_bf8(HM + (size_t)row * FF + col, r0, r1);
    } };

template <class E>
__device__ __forceinline__ void naive_gemm_phase(Ctx& c, const bf16* A, const bf16* Bt, int M, int N, int K, const E& e) {
    LAS float* As = (LAS float*)c.lds;
    LAS float* Bs = As + 32 * 132;
    const int ntm = M / 128, ntn = N / 128, tx = c.tid & 31, ty = c.tid >> 5;
    const int lr = c.tid >> 2, lk = (c.tid & 3) * 8;
    for (int tile = c.wg; tile < ntm * ntn; tile += c.G) {
        const int tm = tile % ntm, tn = tile / ntm;
        f32x4 acc[8];
#pragma unroll
        for (int i = 0; i < 8; ++i) acc[i] = (f32x4){0.f, 0.f, 0.f, 0.f};
        for (int k0 = 0; k0 < K; k0 += 32) {
            const u32x4 av = *(const u32x4*)(A + (size_t)(tm * 128 + lr) * K + k0 + lk);
            const u32x4 bv = *(const u32x4*)(Bt + (size_t)(tn * 128 + lr) * K + k0 + lk);
            __syncthreads();
#pragma unroll
            for (int j = 0; j < 4; ++j) {
                As[(lk + 2 * j) * 132 + lr] = bf2f(av[j] & 0xffffu); As[(lk + 2 * j + 1) * 132 + lr] = bf2f(av[j] >> 16);
                Bs[(lk + 2 * j) * 132 + lr] = bf2f(bv[j] & 0xffffu); Bs[(lk + 2 * j + 1) * 132 + lr] = bf2f(bv[j] >> 16);
            }
            __syncthreads();
#pragma unroll 8
            for (int k = 0; k < 32; ++k) {
                const f32x4 a0 = *(const LAS f32x4*)(As + k * 132 + ty * 8), a1 = *(const LAS f32x4*)(As + k * 132 + ty * 8 + 4);
                const f32x4 b = *(const LAS f32x4*)(Bs + k * 132 + tx * 4);
                acc[0] += a0[0] * b; acc[1] += a0[1] * b; acc[2] += a0[2] * b; acc[3] += a0[3] * b;
                acc[4] += a1[0] * b; acc[5] += a1[1] * b; acc[6] += a1[2] * b; acc[7] += a1[3] * b;
            }
        }
#pragma unroll
        for (int i = 0; i < 8; ++i) e.quad(tm * 128 + ty * 8 + i, tn * 128 + tx * 4, acc[i]);
    }
    __syncthreads();
}

struct PowOrder {
    int lgN, nwg, G, c, two;
    __device__ __forceinline__ void init(int lgN_, int G_, int c_, int two_ = 0) { lgN = lgN_; nwg = 64 << lgN_; G = G_; c = c_; two = two_; }
    __device__ __forceinline__ bool next(int i, pg8::Unit& u) const {
        const int ii = two ? (i >> 1) : i;
        const int L = ii * G + c; if (L >= nwg) return false;
        const int w = (L & 7) * (nwg >> 3) + (L >> 3), j = w & ((8 << lgN) - 1), gid = w >> (3 + lgN);
        u.pm = __builtin_amdgcn_readfirstlane(gid * 8 + (j & 7)); u.pn = __builtin_amdgcn_readfirstlane(j >> 3); u.z = two ? (i & 1) : 0; return true;
    }
    __device__ __forceinline__ void a_ready(const pg8::Unit&) const {}
    __device__ __forceinline__ void done(const pg8::Unit&) const {}
};
template <class E>
__device__ __forceinline__ void sample_gemm_phase(Ctx& c, const bf16* A, const bf16* Bt, int N, int K, const E& e) {
    LAS float* red = (LAS float*)c.lds;
    const int lane = c.tid & 63, w = __builtin_amdgcn_readfirstlane(c.tid >> 6), fr = lane & 15, fq = lane >> 4, chh = w & 1, kq = w >> 1;
    const bf16* As = A + (size_t)MP * K;
    const int kspan = K >> 2;
    for (int mu = c.G - 1 - c.wg; mu < (N >> 5); mu += c.G) {
        const int n0 = 32 * mu;
        f32x4 acc[8];
#pragma unroll
        for (int m = 0; m < 8; ++m) acc[m] = (f32x4){0.f, 0.f, 0.f, 0.f};
        const bf16* bp = Bt + (size_t)(n0 + 16 * chh + fr) * K + kq * kspan + 8 * fq;
        const bf16* ap = As + (size_t)fr * K + kq * kspan + 8 * fq;
#pragma unroll 2
        for (int k = 0; k < kspan; k += 32) {
            const bf16x8 bfr = *(const bf16x8*)(bp + k);
#pragma unroll
            for (int m = 0; m < 8; ++m) acc[m] = __builtin_amdgcn_mfma_f32_16x16x32_bf16(*(const bf16x8*)(ap + (size_t)(16 * m) * K + k), bfr, acc[m], 0, 0, 0);
        }
        __syncthreads();
#pragma unroll
        for (int m = 0; m < 8; ++m)
#pragma unroll
            for (int j = 0; j < 4; ++j) red[(kq * 128 + 16 * m + 4 * fq + j) * 32 + 16 * chh + fr] = acc[m][j];
        __syncthreads();
#pragma unroll
        for (int i = 0; i < 2; ++i) { const int q = c.tid + 512 * i, row = q >> 3, cq = (q & 7) * 4;
            const f32x4 v = *(const LAS f32x4*)(red + row * 32 + cq) + *(const LAS f32x4*)(red + (128 + row) * 32 + cq) + *(const LAS f32x4*)(red + (256 + row) * 32 + cq) + *(const LAS f32x4*)(red + (384 + row) * 32 + cq);
            e.quad(MP + row, n0 + cq, v); }
    }
    __syncthreads();
}

template <int SITE, class E>
__device__ __forceinline__ void gemm_phase_sel(Ctx& c, const bf16* A, const bf16* Bt, int M, int N, int K, const E& e) {
    if constexpr ((FAST_GEMM >> SITE) & 1) {
        pg8::Gemm g{A, Bt, MP, N, K, A, Bt}; PowOrder S; S.init(N == 1024 ? 2 : (N == 4096 ? 4 : 5), c.G, c.wg);
        if constexpr (E::BY_REGION) { EpiInUnit qe{e}; pg8::gemm_phase<EpiInUnit, PowOrder, true, true>(c.lds, g, S, qe, c.tid); }
        else { OctEpi<E> qe{e}; pg8::gemm_phase<OctEpi<E>, PowOrder, true, true>(c.lds, g, S, qe, c.tid); }
        { int t_ = threadIdx.x; asm volatile("" : "+v"(t_)); c.tid = t_; }
        sample_gemm_phase(c, A, Bt, N, K, e);
    } else naive_gemm_phase(c, A, Bt, M, N, K, e);
}

#define XB_TMO      128
#define XB_XCNT(j)  (256  + 64 * (j))
#define XB_XSUB(j)  (1280 + 64 * (j))
#define XB_XGEN(j)  (2304 + 64 * (j))
#define XB_TOP      3328
#define XB_TOPGEN   3392
#define XCD_BAR_WORDS 3456
#define XB_SPIN_CAP (1u << 18)
__device__ __forceinline__ unsigned xb_ld(unsigned* p)              { return __hip_atomic_load(p, __ATOMIC_RELAXED, __HIP_MEMORY_SCOPE_AGENT); }
__device__ __forceinline__ unsigned xb_add(unsigned* p, unsigned v) { return __hip_atomic_fetch_add(p, v, __ATOMIC_RELAXED, __HIP_MEMORY_SCOPE_AGENT); }
__device__ __forceinline__ unsigned xb_xcc_id() { return (unsigned)__builtin_amdgcn_s_getreg((3 << 11) | 20) & 0xFu; }
#define XB_SPIN(cond, bar) do { unsigned _sp = 0; while (cond) { __builtin_amdgcn_s_sleep(1); \
    if ((++_sp & 255u) == 0u) { if (xb_ld(&(bar)[XB_TMO])) break; if (_sp > XB_SPIN_CAP) { atomicAdd(&(bar)[XB_TMO], 1u); break; } } } } while (0)
struct XcdBarrier { unsigned* bar; unsigned x; volatile LAS unsigned* st; };
__device__ __forceinline__ XcdBarrier xcd_barrier_post(unsigned* bar, volatile LAS unsigned* st) {
    XcdBarrier b; b.bar = bar; b.x = xb_xcc_id(); b.st = st;
    if (threadIdx.x == 0) (void)xb_add(&bar[XB_XCNT(b.x)], 1u);
    return b;
}
__device__ __forceinline__ void xcd_barrier_complete(unsigned* bar, unsigned x, unsigned& nloc, unsigned& nx) {
    const unsigned G = gridDim.x * gridDim.y * gridDim.z;
    unsigned sum, cnt, mine, sp = 0u;
    for (;;) {
        sum = 0u; cnt = 0u; mine = 0u;
#pragma unroll
        for (unsigned j = 0; j < 16; ++j) { const unsigned c = xb_ld(&bar[XB_XCNT(j)]); sum += c; cnt += (c > 0u) ? 1u : 0u; mine = (j == x) ? c : mine; }
        if (sum == G) break;
        __builtin_amdgcn_s_sleep(1);
        if ((++sp & 255u) == 0u) { if (xb_ld(&bar[XB_TMO])) break; if (sp > XB_SPIN_CAP) { atomicAdd(&bar[XB_TMO], 1u); break; } }
    }
    nloc = mine > 0u ? mine : 1u; nx = cnt > 0u ? cnt : 1u;
}
__device__ __forceinline__ void xcd_barrier(const XcdBarrier& b) {
    asm volatile("s_waitcnt vmcnt(0)" ::: "memory");
    __syncthreads();
    if (threadIdx.x == 0) {
        unsigned* bar = b.bar; asm volatile("" : "+s"(bar));
        __builtin_amdgcn_s_waitcnt(0);
        unsigned nloc = b.st[0], nx = b.st[1];
        if (nloc == 0u) { xcd_barrier_complete(bar, b.x, nloc, nx); b.st[0] = nloc; b.st[1] = nx; }
        const unsigned old = xb_add(&bar[XB_XSUB(b.x)], 1u);
        const unsigned gen = old / nloc;
        if (old + 1u == (gen + 1u) * nloc) {
            __builtin_amdgcn_fence(__ATOMIC_RELEASE, "agent");
            asm volatile("s_waitcnt vmcnt(0)" ::: "memory");
            const unsigned og = xb_add(&bar[XB_TOP], 1u);
            const unsigned tg = og / nx;
            if (og + 1u == (tg + 1u) * nx) xb_add(&bar[XB_TOPGEN], 1u);
            else XB_SPIN(xb_ld(&bar[XB_TOPGEN]) == tg, bar);
            __builtin_amdgcn_fence(__ATOMIC_ACQUIRE, "agent");
            xb_add(&bar[XB_XGEN(b.x)], 1u);
            asm volatile("s_waitcnt vmcnt(0)" ::: "memory");
        } else {
            XB_SPIN(xb_ld(&bar[XB_XGEN(b.x)]) == gen, bar);
            __builtin_amdgcn_fence(__ATOMIC_ACQUIRE, "agent");
            asm volatile("s_waitcnt vmcnt(0)" ::: "memory");
        }
    }
    __syncthreads();
}

__device__ __forceinline__ void p0_transpose_item(const float* W, int K, int N, bf16* WT, LAS float* scr, int item, int lane) {
    const int nblk = N / 32, kb = item / nblk, nb = item % nblk, k0 = 64 * kb, n0 = 32 * nb;
    float v[32];
#pragma unroll
    for (int i = 0; i < 32; ++i) v[i] = W[(size_t)(k0 + 2 * i + (lane >> 5)) * N + n0 + (lane & 31)];
#pragma unroll
    for (int i = 0; i < 32; ++i) scr[(2 * i + (lane >> 5)) * 33 + (lane & 31)] = v[i];
    asm volatile("s_waitcnt lgkmcnt(0)" ::: "memory");
    const int ch = lane & 7;
#pragma unroll
    for (int j = 0; j < 4; ++j) { const int n = (lane >> 3) + 8 * j; const LAS float* s = scr + (8 * ch) * 33 + n;
        u32x4 o; o.x = pk2(s[0 * 33], s[1 * 33]); o.y = pk2(s[2 * 33], s[3 * 33]); o.z = pk2(s[4 * 33], s[5 * 33]); o.w = pk2(s[6 * 33], s[7 * 33]);
        *(u32x4*)(WT + (size_t)(n0 + n) * K + k0 + 8 * ch) = o; }
    asm volatile("s_waitcnt lgkmcnt(0)" ::: "memory");
}
__device__ __forceinline__ void p0_work(CArgs& a, Ctx& c, int l, int vw, int nvw, bool with_tables, int ntr) {
    for (int lt = l; lt < l + ntr; ++lt) {
        LAS float* scr = (LAS float*)(c.lds + __builtin_amdgcn_readfirstlane(c.tid >> 6) * 16384);
        const int gw = vw * 8 + __builtin_amdgcn_readfirstlane(c.tid >> 6), NGW = nvw * 8;
        constexpr int I_IN = 16 * 256, I_SQ = 16 * 32, I_1 = 16 * 128, I_2 = 64 * 32, I_L = 8 * 8, PER_L = I_IN + 3 * I_SQ + I_1 + I_2 + 2 * I_L;
        bf16* wl = (bf16*)(a.ws + WS_W + (size_t)lt * WL_STRIDE);
        for (int it = gw; it < PER_L; it += NGW) {
            int r = it;
            if (r < I_IN) { p0_transpose_item(a.in[11] + (size_t)lt * D * NIN, D, NIN, wl + OFF_WIN / 2, scr, r, (c.tid & 63)); continue; } r -= I_IN;
            if (r < I_SQ) { p0_transpose_item(a.in[21] + (size_t)lt * D * D, D, D, wl + OFF_WA / 2, scr, r, (c.tid & 63)); continue; } r -= I_SQ;
            if (r < I_SQ) { p0_transpose_item(a.in[22] + (size_t)lt * D * D, D, D, wl + OFF_WB / 2, scr, r, (c.tid & 63)); continue; } r -= I_SQ;
            if (r < I_SQ) { p0_transpose_item(a.in[23] + (size_t)lt * D * D, D, D, wl + OFF_WO / 2, scr, r, (c.tid & 63)); continue; } r -= I_SQ;
            if (r < I_1) { p0_transpose_item(a.in[24] + (size_t)lt * D * FF, D, FF, wl + OFF_W1 / 2, scr, r, (c.tid & 63)); continue; } r -= I_1;
            if (r < I_2) { p0_transpose_item(a.in[25] + (size_t)lt * FF * D, FF, D, wl + OFF_W2 / 2, scr, r, (c.tid & 63)); continue; } r -= I_2;
            if (r < I_L) { const int n = r >> 3; p0_transpose_item(a.in[16] + ((size_t)lt * 8 + n) * 16384, 128, 128, wl + OFF_LWA / 2 + n * 16384, scr, r & 7, (c.tid & 63)); continue; } r -= I_L;
            { const int n = r >> 3; p0_transpose_item(a.in[18] + ((size_t)lt * 8 + n) * 16384, 128, 128, wl + OFF_LWX / 2 + n * 16384, scr, r & 7, (c.tid & 63)); }
        }
    }
    if (with_tables) {
        float* lbt = (float*)(a.ws + WS_TAB); float* sp = (float*)(a.ws + WS_TAB + 32768);
        const int gid = vw * 512 + c.tid;
        if (gid < 2 * D) {
            const int ll = gid >> 10, col = gid & 1023;
            const float h0 = a.in[12][col], h1 = a.in[12][D + col];
            const float p1 = 1.0f / (1.0f + expf(h0 - h1));
            const float lb = ll == 0 ? 0.f : p1;
            lbt[(ll * 3 + 0) * D + col] = lb; lbt[(ll * 3 + 1) * D + col] = logf(fmaxf(lb, 1e-30f)); lbt[(ll * 3 + 2) * D + col] = log1pf(-lb);
            sp[ll * D + col] = softplusf_(-a.in[20][ll * D + col]);
        }
    }
    __syncthreads();
    {
        constexpr int CS_STRIDE = 272;
        LAS unsigned char* csb = c.lds;
        LAS float* ws = (LAS float*)(c.lds + 39168);
        float* MOD = (float*)(a.ws + WS_MOD);
        const int lane = c.tid & 63, w = __builtin_amdgcn_readfirstlane(c.tid >> 6), fr = lane & 15, fq = lane >> 4, ct = w & 1, rt0 = w >> 1;
        for (int item = vw; item < 192; item += nvw) {
            const float* W = a.in[7] + (size_t)l * D * 6144 + item * 32;
            f32x4 acc[3];
#pragma unroll
            for (int i = 0; i < 3; ++i) acc[i] = (f32x4){0.f, 0.f, 0.f, 0.f};
            f32x4 cv[9], wv[2];
#define MOD_LOAD(k0_) do { _Pragma("unroll") for (int i = 0; i < 9; ++i) { const int e4 = c.tid + 512 * i, r = e4 >> 5, kq = (e4 & 31) * 4; const int rr = r < NMOD ? r : 0; \
                const float* src = rr < NBATCH ? a.in[5] + (size_t)rr * D : a.in[6] + (size_t)(rr - NBATCH) * D; cv[i] = *(const f32x4*)(src + (k0_) + kq); } \
              _Pragma("unroll") for (int i = 0; i < 2; ++i) { const int e4 = c.tid + 512 * i, kk = e4 >> 3, c4 = (e4 & 7) * 4; wv[i] = *(const f32x4*)(W + (size_t)((k0_) + kk) * 6144 + c4); } } while (0)
            MOD_LOAD(0);
            for (int k0 = 0; k0 < D; k0 += 128) {
                __syncthreads();
#pragma unroll
                for (int i = 0; i < 9; ++i) { const int e4 = c.tid + 512 * i, r = e4 >> 5, kq = (e4 & 31) * 4;
                    u32x2 pw; pw.x = pk2(siluf_(cv[i][0]), siluf_(cv[i][1])); pw.y = pk2(siluf_(cv[i][2]), siluf_(cv[i][3]));
                    if (r >= NMOD) { pw.x = 0u; pw.y = 0u; }
                    *(LAS u32x2*)(csb + r * CS_STRIDE + kq * 2) = pw; }
#pragma unroll
                for (int i = 0; i < 2; ++i) { const int e4 = c.tid + 512 * i, kk = e4 >> 3, c4 = (e4 & 7) * 4;
                    ws[kk * 33 + c4] = wv[i][0]; ws[kk * 33 + c4 + 1] = wv[i][1]; ws[kk * 33 + c4 + 2] = wv[i][2]; ws[kk * 33 + c4 + 3] = wv[i][3]; }
                if (k0 + 128 < D) MOD_LOAD(k0 + 128);
                WG_BAR();
#pragma unroll
                for (int ks = 0; ks < 4; ++ks) {
                    const LAS float* wp = ws + (32 * ks + 8 * fq) * 33 + 16 * ct + fr;
                    u32x4 bw; bw.x = pk2(wp[0], wp[33]); bw.y = pk2(wp[66], wp[99]); bw.z = pk2(wp[132], wp[165]); bw.w = pk2(wp[198], wp[231]);
                    const bf16x8 bfr = __builtin_bit_cast(bf16x8, bw);
#pragma unroll
                    for (int i = 0; i < 3; ++i) { const int rt = rt0 + 4 * i;
                        if (rt < 9) acc[i] = __builtin_amdgcn_mfma_f32_16x16x32_bf16(*(const LAS bf16x8*)(csb + (16 * rt + fr) * CS_STRIDE + (32 * ks + 8 * fq) * 2), bfr, acc[i], 0, 0, 0); }
                }
            }
#undef MOD_LOAD
            const float bm = a.in[8][(size_t)l * 6144 + item * 32 + 16 * ct + fr];
#pragma unroll
            for (int i = 0; i < 3; ++i) { const int rt = rt0 + 4 * i;
                if (rt < 9) {
#pragma unroll
                    for (int j = 0; j < 4; ++j) { const int row = 16 * rt + 4 * fq + j; if (row < NMOD) MOD[((size_t)l * NMOD + row) * 6144 + item * 32 + 16 * ct + fr] = acc[i][j] + bm; } } }
        }
    }
    __syncthreads();
}

__device__ __forceinline__ void norm_phase(CArgs& a, Ctx& c, int l, int which, const float* xp, const float* xs) {
    const int gw = c.wg * 8 + __builtin_amdgcn_readfirstlane(c.tid >> 6), NGW = c.G * 8;
    bf16* H = (bf16*)(a.ws + WS_H);
    const float* MODL = (const float*)(a.ws + WS_MOD) + (size_t)l * NMOD * 6144;
    const float* g = a.in[which ? 10 : 9] + (size_t)l * D;
    for (int row = gw; row < MR; row += NGW) {
        const float* xr = row < MP ? xp + (size_t)row * D : xs + (size_t)(row - MP) * D;
        const float* md = MODL + (size_t)mod_row(row) * 6144 + (which ? 3 : 0) * 1024;
        f32x4 v[4]; float ss = 0.f;
#pragma unroll
        for (int j = 0; j < 4; ++j) { v[j] = *(const f32x4*)(xr + 4 * (c.tid & 63) + 256 * j); ss += (v[j][0] * v[j][0] + v[j][1] * v[j][1]) + (v[j][2] * v[j][2] + v[j][3] * v[j][3]); }
        const float rstd = 1.0f / sqrtf(wave_sum(ss) * (1.0f / D) + EPS);
#pragma unroll
        for (int j = 0; j < 4; ++j) { const int cc = 4 * (c.tid & 63) + 256 * j;
            const f32x4 gg = *(const f32x4*)(g + cc), sh = *(const f32x4*)(md + cc), sc = *(const f32x4*)(md + 1024 + cc);
            st_bf4(H + (size_t)row * D + cc, v[j] * rstd * gg * (1.0f + sc) + sh); }
    }
}
__device__ __forceinline__ void final_norm_phase(CArgs& a, Ctx& c) {
    const int gw = c.wg * 8 + __builtin_amdgcn_readfirstlane(c.tid >> 6), NGW = c.G * 8;
    const float* g = a.in[26];
    for (int row = gw; row < MR; row += NGW) {
        const float* xr = (XOUT_SCRATCH ? (const float*)(a.ws + WS_T) : (const float*)a.out) + (size_t)row * D; float* yr = a.out + (size_t)row * D;
        f32x4 v[4]; float ss = 0.f;
#pragma unroll
        for (int j = 0; j < 4; ++j) { v[j] = *(const f32x4*)(xr + 4 * (c.tid & 63) + 256 * j); ss += (v[j][0] * v[j][0] + v[j][1] * v[j][1]) + (v[j][2] * v[j][2] + v[j][3] * v[j][3]); }
        const float rstd = 1.0f / sqrtf(wave_sum(ss) * (1.0f / D) + EPS);
#pragma unroll
        for (int j = 0; j < 4; ++j) { const int cc = 4 * (c.tid & 63) + 256 * j; f32x4 y = v[j] * rstd * *(const f32x4*)(g + cc);
            if (PROBE_T && row == 0 && cc == 0) y[0] += *(const float*)(a.ws + WS_DBG);
            *(f32x4*)(yr + cc) = y; }
    }
}

__device__ __forceinline__ void hgrn_naive(CArgs& a, Ctx& c, int l, int row0, int ntok, int h, const float* S0, float* Sout) {
    LAS float* fs = (LAS float*)c.lds;
    LAS float* ks = fs + 2048;
    LAS float* qs = ks + 2048;
    LAS float* vs = qs + 2048;
    LAS float* part = vs + 2048;
    const bf16* Q = (const bf16*)(a.ws + WS_SQ) - (size_t)MP * D; const bf16* Kb = (const bf16*)(a.ws + WS_SK) - (size_t)MP * D; const float* LOGF = (const float*)(a.ws + WS_SLOGF) - (size_t)MP * D;
    const bf16* V = (const bf16*)(a.ws + WS_V); const bf16* OG = (const bf16*)(a.ws + WS_OG); bf16* OA = (bf16*)(a.ws + WS_OA);
    const float* hg = a.in[13] + (size_t)l * DKV;
    const int v = c.tid & 127, kg = c.tid >> 7;
    float S[32];
#pragma unroll
    for (int i = 0; i < 32; ++i) S[i] = S0 ? S0[(size_t)(32 * kg + i) * DKV + v] : 0.f;
    for (int t0 = 0; t0 < ntok; t0 += 16) {
        const int nt = (ntok - t0) < 16 ? (ntok - t0) : 16;
        __syncthreads();
        { const int tt = c.tid >> 5, k4 = (c.tid & 31) * 4;
          if (tt < nt) { const size_t off = (size_t)(row0 + t0 + tt) * D + h * DKV + k4;
              const f32x4 lf = *(const f32x4*)(LOGF + off);
              *(LAS f32x4*)(fs + tt * 128 + k4) = (f32x4){expf(lf[0]), expf(lf[1]), expf(lf[2]), expf(lf[3])};
              *(LAS f32x4*)(ks + tt * 128 + k4) = ld_bf4(Kb + off);
              *(LAS f32x4*)(qs + tt * 128 + k4) = ld_bf4(Q + off);
              *(LAS f32x4*)(vs + tt * 128 + k4) = ld_bf4(V + off); } }
        __syncthreads();
        for (int tt = 0; tt < nt; ++tt) {
            const float vv = vs[tt * 128 + v]; float acc = 0.f;
#pragma unroll
            for (int i4 = 0; i4 < 8; ++i4) {
                const f32x4 f = *(const LAS f32x4*)(fs + tt * 128 + 32 * kg + 4 * i4), kk = *(const LAS f32x4*)(ks + tt * 128 + 32 * kg + 4 * i4), qq = *(const LAS f32x4*)(qs + tt * 128 + 32 * kg + 4 * i4);
#pragma unroll
                for (int j = 0; j < 4; ++j) { S[4 * i4 + j] = f[j] * S[4 * i4 + j] + kk[j] * vv; acc += S[4 * i4 + j] * qq[j]; }
            }
            part[(tt * 4 + kg) * 128 + v] = acc;
        }
        __syncthreads();
        { const int tt = c.tid >> 5, v4 = (c.tid & 31) * 4; const int tc = tt < nt ? tt : 0;
          const f32x4 o = *(const LAS f32x4*)(part + (tc * 4 + 0) * 128 + v4) + *(const LAS f32x4*)(part + (tc * 4 + 1) * 128 + v4)
                        + *(const LAS f32x4*)(part + (tc * 4 + 2) * 128 + v4) + *(const LAS f32x4*)(part + (tc * 4 + 3) * 128 + v4);
          float ss = (o[0] * o[0] + o[1] * o[1]) + (o[2] * o[2] + o[3] * o[3]);
          ss = half_sum(ss);
          const float rstd = 1.0f / sqrtf(ss * (1.0f / DKV) + EPS);
          if (tt < nt) { const size_t off = (size_t)(row0 + t0 + tt) * D + h * DKV + v4;
              st_bf4(OA + off, o * rstd * *(const f32x4*)(hg + v4) * ld_bf4(OG + off)); } }
    }
#pragma unroll
    for (int i = 0; i < 32; ++i) Sout[(size_t)(32 * kg + i) * DKV + v] = S[i];
    __syncthreads();
}


constexpr int HB_Q0 = 0, HB_K0 = 17408, HB_Q1 = 26112, HB_K1 = 34816, HB_KT0 = 43520, HB_KT1 = 53760, HB_VT = 64000, HB_AS = 82432, HB_ST = 91648, HB_VEC = 126464, HB_TOT = 128512, HB_SSQ = 130560;
constexpr int HS_Q = 272, HS_KT = 80, HS_VT = 144, HS_AS = 144;
static_assert(HB_SSQ + 2048 <= MISC_OFF && 64 * 132 * 4 <= HB_VEC - HB_ST, "hgrn lds");
__device__ __forceinline__ float exp_c(float x) { return __expf(fminf(x, 80.f)); }
__device__ __forceinline__ void hgrn_prep_phase(CArgs& a, Ctx& c) {
    LAS unsigned char* lds = c.lds;
    const int tid = c.tid, col = tid & 127, sg = tid >> 7;
    LAS float* VEC = (LAS float*)(lds + HB_VEC); LAS float* TOT = (LAS float*)(lds + HB_TOT);
    float lf[16]; unsigned qr[16], kr[16], vr[16];
#define PREP_LOAD(it_) do { const unsigned char* bp_ = a.ws + WS_PREP + (size_t)(it_) * PREP_BLK; const int e0_ = (16 * sg) * 128 + col; \
        const bf16* vs_ = (const bf16*)(a.ws + WS_V) + ((size_t)((it_) >> 8) * SEQ + 64 * (((it_) >> 3) & 31)) * D + ((it_) & 7) * DKV; \
        _Pragma("unroll") for (int i = 0; i < 16; ++i) { lf[i] = ((const float*)bp_)[e0_ + i * 128]; qr[i] = ((const bf16*)(bp_ + 32768))[e0_ + i * 128]; kr[i] = ((const bf16*)(bp_ + 49152))[e0_ + i * 128]; vr[i] = vs_[(size_t)(16 * sg + i) * D + col]; } } while (0)
    if (c.wg < 2048) PREP_LOAD(c.wg);
    for (int it = c.wg; it < 2048; it += c.G) {
        unsigned char* bp = a.ws + WS_PREP + (size_t)it * PREP_BLK;
        const int pb = it >> 8, pn = (it >> 3) & 31, phh = it & 7;
        bf16* vslice = (bf16*)(a.ws + WS_V) + ((size_t)pb * SEQ + 64 * pn) * D + phh * DKV;
        float g[16]; g[0] = lf[0];
#pragma unroll
        for (int i = 1; i < 16; ++i) g[i] = g[i - 1] + lf[i];
        WG_BAR();
        TOT[sg * 128 + col] = g[15];
        WG_BAR();
        {
            const float t0 = TOT[col], t1 = TOT[128 + col], t2 = TOT[256 + col], t3 = TOT[384 + col];
            const float off = (sg > 0 ? t0 : 0.f) + (sg > 1 ? t1 : 0.f) + (sg > 2 ? t2 : 0.f);
            const float r0 = t0, r1 = t0 + t1 + t2, last = r1 + t3;
            unsigned kt[8];
#pragma unroll
            for (int i = 0; i < 16; ++i) {
                const float G = g[i] + off, qv = bf2f(qr[i]), kv = bf2f(kr[i]);
                const int t = 16 * sg + i;
                *(LAS bf16*)(lds + HB_Q0 + t * HS_Q + col * 2) = (bf16)f2bf(qv * exp_c(G - r0));
                if (sg < 2) *(LAS bf16*)(lds + HB_K0 + t * HS_Q + col * 2) = (bf16)f2bf(kv * exp_c(r0 - G));
                else { *(LAS bf16*)(lds + HB_K1 + (t - 32) * HS_Q + col * 2) = (bf16)f2bf(kv * exp_c(r1 - G));
                       *(LAS bf16*)(lds + HB_Q1 + (t - 32) * HS_Q + col * 2) = (bf16)f2bf(qv * exp_c(G - r1)); }
                const unsigned kb = f2bf(kv * __expf(last - G));
                if (i & 1) kt[i >> 1] |= kb << 16; else kt[i >> 1] = kb;
            }
            { LAS unsigned char* p = lds + (sg < 2 ? HB_KT0 : HB_KT1) + col * HS_KT + (sg & 1) * 32;
              *(LAS u32x4*)p = (u32x4){kt[0], kt[1], kt[2], kt[3]}; *(LAS u32x4*)(p + 16) = (u32x4){kt[4], kt[5], kt[6], kt[7]}; }
            if (sg < 2) VEC[sg * 128 + col] = exp_c(sg == 0 ? r0 : last);
            { LAS unsigned char* p = lds + HB_VT + col * HS_VT + sg * 32;
              *(LAS u32x4*)p = (u32x4){vr[0] | (vr[1] << 16), vr[2] | (vr[3] << 16), vr[4] | (vr[5] << 16), vr[6] | (vr[7] << 16)};
              *(LAS u32x4*)(p + 16) = (u32x4){vr[8] | (vr[9] << 16), vr[10] | (vr[11] << 16), vr[12] | (vr[13] << 16), vr[14] | (vr[15] << 16)}; }
        }
        if (it + c.G < 2048) PREP_LOAD(it + c.G);
        WG_BAR();
#pragma unroll
        for (int i = 0; i < 2; ++i) { const int p = tid + 512 * i, row = p >> 4, pc = p & 15; *(u32x4*)(bp + row * 256 + pc * 16) = *(const LAS u32x4*)(lds + HB_Q0 + row * HS_Q + pc * 16); }
        { const int row = tid >> 4, pc = tid & 15;
          *(u32x4*)(bp + 16384 + row * 256 + pc * 16) = *(const LAS u32x4*)(lds + HB_K0 + row * HS_Q + pc * 16);
          *(u32x4*)(bp + 24576 + row * 256 + pc * 16) = *(const LAS u32x4*)(lds + HB_Q1 + row * HS_Q + pc * 16);
          *(u32x4*)(bp + 32768 + row * 256 + pc * 16) = *(const LAS u32x4*)(lds + HB_K1 + row * HS_Q + pc * 16); }
        { const int k = tid >> 2, pc = tid & 3;
          *(u32x4*)(bp + 40960 + k * 64 + pc * 16) = *(const LAS u32x4*)(lds + HB_KT0 + k * HS_KT + pc * 16);
          *(u32x4*)(bp + 49152 + k * 64 + pc * 16) = *(const LAS u32x4*)(lds + HB_KT1 + k * HS_KT + pc * 16); }
        if (tid < 64) *(u32x4*)(bp + 57344 + tid * 16) = *(const LAS u32x4*)(lds + HB_VEC + tid * 16);
#pragma unroll
        for (int i = 0; i < 2; ++i) { const int p = tid + 512 * i, v = p >> 3, pc = p & 7;
            *(u32x4*)((unsigned char*)(vslice + (size_t)(v >> 1) * D) + (v & 1) * 128 + pc * 16) = *(const LAS u32x4*)(lds + HB_VT + v * HS_VT + pc * 16); }
    }
#undef PREP_LOAD
    __syncthreads();
}

__device__ __forceinline__ void hgrn_fast_prompt(CArgs& a, Ctx& c, int l, int b, int h) {
    LAS unsigned char* lds = c.lds;
    const int tid = c.tid, lane = tid & 63, w = __builtin_amdgcn_readfirstlane(tid >> 6), fr = lane & 15, fq = lane >> 4;
    const int col = tid & 127, sg = tid >> 7;
    const bf16* V = (const bf16*)(a.ws + WS_V); const bf16* OG = (const bf16*)(a.ws + WS_OG); bf16* OA = (bf16*)(a.ws + WS_OA);
    const unsigned char* blk0 = a.ws + WS_PREP + ((size_t)b * 32 * 8 + h) * PREP_BLK;
    const size_t base = (size_t)b * SEQ * D + (size_t)h * DKV;
    LAS float* VEC = (LAS float*)(lds + HB_VEC); LAS float* SSQ = (LAS float*)(lds + HB_SSQ);
    LAS unsigned char* STw = lds + HB_ST + w * 4352;
    const float gv = a.in[13][(size_t)l * DKV + 16 * w + fr];
    f32x4 S[8];
#pragma unroll
    for (int i = 0; i < 8; ++i) S[i] = (f32x4){0.f, 0.f, 0.f, 0.f};
    __syncthreads();
    for (int e = tid; e < 2 * 16 * 16; e += 512) { const int which = e >> 8, r = (e >> 4) & 15, cc = e & 15;
        *(LAS bf16*)(lds + HB_AS + ((which ? 32 : 0) + r) * HS_AS + ((which ? 48 : 16) + cc) * 2) = 0; }
    const int prow = tid >> 4, ppc = tid & 15, pk = tid >> 2, pkc = tid & 3;
    const bf16* vt0 = (const bf16*)(a.ws + WS_V) + (size_t)b * SEQ * D + h * DKV;
    const int orow = tid >> 4, oc8 = (tid & 15) * 8;
    u32x4 im[10], ogv[2];
#define HG_LOAD(n_) do { const unsigned char* bp_ = blk0 + (size_t)(n_) * 8 * PREP_BLK; \
        im[0] = *(const u32x4*)(bp_ + prow * 256 + ppc * 16); im[1] = *(const u32x4*)(bp_ + (32 + prow) * 256 + ppc * 16); \
        im[2] = *(const u32x4*)(bp_ + 16384 + prow * 256 + ppc * 16); im[3] = *(const u32x4*)(bp_ + 24576 + prow * 256 + ppc * 16); im[4] = *(const u32x4*)(bp_ + 32768 + prow * 256 + ppc * 16); \
        im[5] = *(const u32x4*)(bp_ + 40960 + pk * 64 + pkc * 16); im[6] = *(const u32x4*)(bp_ + 49152 + pk * 64 + pkc * 16); \
        if (tid < 64) im[7] = *(const u32x4*)(bp_ + 57344 + tid * 16); \
        _Pragma("unroll") for (int i = 0; i < 2; ++i) { const int p_ = tid + 512 * i, v_ = p_ >> 3, pc_ = p_ & 7; \
            im[8 + i] = *(const u32x4*)((const unsigned char*)(vt0 + (size_t)(64 * (n_) + (v_ >> 1)) * D) + (v_ & 1) * 128 + pc_ * 16); } } while (0)
    HG_LOAD(0);
    unsigned long long tacc = 0ull, tst = 0ull;
#define TSTART(id) do { if (PROBE_T == (id)) { __builtin_amdgcn_sched_barrier(0); tst = __builtin_amdgcn_s_memtime(); __builtin_amdgcn_sched_barrier(0); } } while (0)
#define TSTOP(id) do { if (PROBE_T == (id)) { __builtin_amdgcn_sched_barrier(0); tacc += __builtin_amdgcn_s_memtime() - tst; __builtin_amdgcn_sched_barrier(0); } } while (0)
    for (int nn = 0; nn < (SEQ / 64) * (1 + (PROBE_MIX & 1)); ++nn) {
        const int n = nn & (SEQ / 64 - 1);
        if (PROBE_MIX & 1) { if (nn == SEQ / 64) {
#pragma unroll
            for (int i = 0; i < 8; ++i) S[i] = (f32x4){0.f, 0.f, 0.f, 0.f}; } }
        TSTART(1); TSTART(2);
        *(LAS u32x4*)(lds + HB_Q0 + prow * HS_Q + ppc * 16) = im[0]; *(LAS u32x4*)(lds + HB_Q0 + (32 + prow) * HS_Q + ppc * 16) = im[1];
        *(LAS u32x4*)(lds + HB_K0 + prow * HS_Q + ppc * 16) = im[2]; *(LAS u32x4*)(lds + HB_Q1 + prow * HS_Q + ppc * 16) = im[3]; *(LAS u32x4*)(lds + HB_K1 + prow * HS_Q + ppc * 16) = im[4];
        *(LAS u32x4*)(lds + HB_KT0 + pk * HS_KT + pkc * 16) = im[5]; *(LAS u32x4*)(lds + HB_KT1 + pk * HS_KT + pkc * 16) = im[6];
        if (tid < 64) *(LAS u32x4*)(lds + HB_VEC + tid * 16) = im[7];
#pragma unroll
        for (int i = 0; i < 2; ++i) { const int p = tid + 512 * i, v = p >> 3, pc = p & 7; *(LAS u32x4*)(lds + HB_VT + v * HS_VT + pc * 16) = im[8 + i]; }
        ogv[0] = *(const u32x4*)(OG + base + (size_t)(64 * n + orow) * D + oc8); ogv[1] = *(const u32x4*)(OG + base + (size_t)(64 * n + 32 + orow) * D + oc8);
        if ((PROBE_MIX & 1) || n + 1 < SEQ / 64) HG_LOAD((n + 1) & (SEQ / 64 - 1));
        WG_BAR();
        TSTOP(2); TSTART(3);
#pragma unroll
        for (int kt8 = 0; kt8 < 8; ++kt8) { const f32x4 er = *(const LAS f32x4*)(VEC + 16 * kt8 + 4 * fq);
            u32x2 pw; pw.x = pk2(S[kt8][0] * er[0], S[kt8][1] * er[1]); pw.y = pk2(S[kt8][2] * er[2], S[kt8][3] * er[3]);
            *(LAS u32x2*)(STw + fr * HS_Q + (16 * kt8 + 4 * fq) * 2) = pw; }
#pragma unroll
        for (int rep = 0; rep < 2; ++rep) {
            const int id = w + 8 * rep;
            if (id < 10) {
                int tt, st;
                if (id == 0) { tt = 0; st = 0; } else if (id < 7) { tt = (id + 1) >> 1; st = (id + 1) & 1; } else if (id == 7) { tt = 2; st = 2; } else { tt = 3; st = id - 6; }
                const LAS unsigned char* ap = (st < 2) ? lds + HB_Q0 + (16 * tt + fr) * HS_Q : lds + HB_Q1 + (16 * (tt - 2) + fr) * HS_Q;
                const LAS unsigned char* bp = (st < 2) ? lds + HB_K0 + (16 * st + fr) * HS_Q : lds + HB_K1 + (16 * (st - 2) + fr) * HS_Q;
                f32x4 acc = (f32x4){0.f, 0.f, 0.f, 0.f};
#pragma unroll
                for (int ks = 0; ks < 4; ++ks) acc = __builtin_amdgcn_mfma_f32_16x16x32_bf16(*(const LAS bf16x8*)(ap + (32 * ks + 8 * fq) * 2), *(const LAS bf16x8*)(bp + (32 * ks + 8 * fq) * 2), acc, 0, 0, 0);
#pragma unroll
                for (int j = 0; j < 4; ++j) { const float v_ = (tt == st && fr > 4 * fq + j) ? 0.f : acc[j];
                    *(LAS bf16*)(lds + HB_AS + (16 * tt + 4 * fq + j) * HS_AS + (16 * st + fr) * 2) = (bf16)f2bf(v_); }
            }
        }
        f32x4 o[4];
#pragma unroll
        for (int tt = 0; tt < 4; ++tt) o[tt] = (f32x4){0.f, 0.f, 0.f, 0.f};
#pragma unroll
        for (int ks = 0; ks < 4; ++ks) { const bf16x8 bfr = *(const LAS bf16x8*)(STw + fr * HS_Q + (32 * ks + 8 * fq) * 2);
#pragma unroll
            for (int tt = 0; tt < 4; ++tt) o[tt] = __builtin_amdgcn_mfma_f32_16x16x32_bf16(*(const LAS bf16x8*)(lds + HB_Q0 + (16 * tt + fr) * HS_Q + (32 * ks + 8 * fq) * 2), bfr, o[tt], 0, 0, 0); }
        WG_BAR();
        TSTOP(3); TSTART(4);
#pragma unroll
        for (int tt = 0; tt < 4; ++tt)
#pragma unroll
            for (int ks = 0; ks < 2; ++ks) if (ks == 0 || tt >= 2)
                o[tt] = __builtin_amdgcn_mfma_f32_16x16x32_bf16(*(const LAS bf16x8*)(lds + HB_AS + (16 * tt + fr) * HS_AS + (32 * ks + 8 * fq) * 2), *(const LAS bf16x8*)(lds + HB_VT + (16 * w + fr) * HS_VT + (32 * ks + 8 * fq) * 2), o[tt], 0, 0, 0);
#pragma unroll
        for (int tt = 0; tt < 4; ++tt)
#pragma unroll
            for (int j = 0; j < 4; ++j) { float p = o[tt][j] * o[tt][j];
                p = row16_sum(p);
                if (fr == 0) SSQ[w * 64 + 16 * tt + 4 * fq + j] = p; }
#pragma unroll
        for (int kt8 = 0; kt8 < 8; ++kt8) {
            const f32x4 eL = *(const LAS f32x4*)(VEC + 128 + 16 * kt8 + 4 * fq);
            f32x4 sn = eL * S[kt8];
            sn = __builtin_amdgcn_mfma_f32_16x16x32_bf16(*(const LAS bf16x8*)(lds + HB_KT0 + (16 * kt8 + fr) * HS_KT + 8 * fq * 2), *(const LAS bf16x8*)(lds + HB_VT + (16 * w + fr) * HS_VT + 8 * fq * 2), sn, 0, 0, 0);
            S[kt8] = __builtin_amdgcn_mfma_f32_16x16x32_bf16(*(const LAS bf16x8*)(lds + HB_KT1 + (16 * kt8 + fr) * HS_KT + 8 * fq * 2), *(const LAS bf16x8*)(lds + HB_VT + (16 * w + fr) * HS_VT + (32 + 8 * fq) * 2), sn, 0, 0, 0);
        }
        WG_BAR();
        TSTOP(4); TSTART(5);
        { LAS float* OUT = (LAS float*)(lds + HB_ST);
#pragma unroll
          for (int tt = 0; tt < 4; ++tt)
#pragma unroll
              for (int j = 0; j < 4; ++j) OUT[(16 * tt + 4 * fq + j) * 132 + 16 * w + fr] = o[tt][j] * gv;
          WG_BAR();
#pragma unroll
          for (int i = 0; i < 2; ++i) { const int t = orow + 32 * i;
              float ss = SSQ[t];
#pragma unroll
              for (int ww = 1; ww < 8; ++ww) ss += SSQ[ww * 64 + t];
              const float rstd = __builtin_amdgcn_rsqf(ss * (1.0f / DKV) + EPS);
              const f32x4 x0 = *(const LAS f32x4*)(OUT + t * 132 + oc8) * rstd, x1 = *(const LAS f32x4*)(OUT + t * 132 + oc8 + 4) * rstd;
              const u32x4 g_ = ogv[i];
              const f32x4 g0 = (f32x4){bf2f(g_.x & 0xffffu), bf2f(g_.x >> 16), bf2f(g_.y & 0xffffu), bf2f(g_.y >> 16)}, g1 = (f32x4){bf2f(g_.z & 0xffffu), bf2f(g_.z >> 16), bf2f(g_.w & 0xffffu), bf2f(g_.w >> 16)};
              st_bf8(OA + base + (size_t)(64 * n + t) * D + oc8, x0 * g0, x1 * g1); } }
        TSTOP(5); TSTOP(1);
    }
    if (PROBE_T && PROBE_T < 100 && l == 0 && c.wg == 0 && tid == 0) *(float*)(a.ws + WS_DBG) = (float)(tacc >> 5) * 1e-4f;
#undef HG_LOAD
    { float* Sout = a.out + O_HGP + (((size_t)l * NBATCH + b) * NH + h) * DKV * DKV;
#pragma unroll
      for (int kt8 = 0; kt8 < 8; ++kt8)
#pragma unroll
          for (int j = 0; j < 4; ++j) Sout[(size_t)(16 * kt8 + 4 * fq + j) * DKV + 16 * w + fr] = S[kt8][j]; }
    __syncthreads();
}

constexpr int L_XBS = 0, L_XC = 67 * 128, L_AS = L_XC + 8192, L_BS = L_AS + 8192, L_SEG = L_BS + 8192, L_CARRY = L_SEG + 1024;
constexpr int LB_XCB = (L_CARRY + 256) * 4, XCB_STRIDE = 272;
static_assert(LB_XCB + 64 * XCB_STRIDE <= MISC_OFF && LB_XCB % 16 == 0, "lru lds");
__device__ __forceinline__ void lru_gates_naive(CArgs& a, Ctx& c, int l, int n) {
    LAS float* XC = (LAS float*)c.lds + L_XC; LAS float* As = (LAS float*)c.lds + L_AS; LAS float* Bs = (LAS float*)c.lds + L_BS;
    const bf16* wl = (const bf16*)(a.ws + WS_W + (size_t)l * WL_STRIDE);
    const int e = c.tid & 127, tg = c.tid >> 7;
    const bf16* wa = wl + OFF_LWA / 2 + (size_t)(n * 128 + e) * 128; const bf16* wx = wl + OFF_LWX / 2 + (size_t)(n * 128 + e) * 128;
    const int ch = n * 128 + e;
    const float ba = a.in[17][(size_t)l * D + ch], bx = a.in[19][(size_t)l * D + ch], sp = ((const float*)(a.ws + WS_TAB + 32768))[l * D + ch];
#pragma unroll 1
    for (int tq = 0; tq < 4; ++tq) {
        float ra[4], ia[4];
#pragma unroll
        for (int i = 0; i < 4; ++i) { ra[i] = 0.f; ia[i] = 0.f; }
        const LAS float* xc = XC + (tg * 16 + tq * 4) * 128;
#pragma unroll 1
        for (int d0 = 0; d0 < 128; d0 += 8) {
            const f32x4 wa0 = ld_bf4(wa + d0), wa1 = ld_bf4(wa + d0 + 4), wx0 = ld_bf4(wx + d0), wx1 = ld_bf4(wx + d0 + 4);
#pragma unroll
            for (int tt = 0; tt < 4; ++tt) {
                const f32x4 x0 = *(const LAS f32x4*)(xc + tt * 128 + d0), x1 = *(const LAS f32x4*)(xc + tt * 128 + d0 + 4);
                ra[tt] += (x0[0] * wa0[0] + x0[1] * wa0[1]) + (x0[2] * wa0[2] + x0[3] * wa0[3]) + (x1[0] * wa1[0] + x1[1] * wa1[1]) + (x1[2] * wa1[2] + x1[3] * wa1[3]);
                ia[tt] += (x0[0] * wx0[0] + x0[1] * wx0[1]) + (x0[2] * wx0[2] + x0[3] * wx0[3]) + (x1[0] * wx1[0] + x1[1] * wx1[1]) + (x1[2] * wx1[2] + x1[3] * wx1[3]);
            }
        }
#pragma unroll
        for (int tt = 0; tt < 4; ++tt) {
            const int t = tg * 16 + tq * 4 + tt;
            const float r = sigmoidf_(ra[tt] + ba), ig = sigmoidf_(ia[tt] + bx);
            const float la = -8.0f * r * sp, aa = expf(la), mult = sqrtf(-expm1f(2.0f * la));
            As[t * 128 + e] = aa; Bs[t * 128 + e] = mult * ig * XC[t * 128 + e];
        }
    }
}
__device__ __forceinline__ void lru_gates_mfma(CArgs& a, Ctx& c, int l, int n) {
    LAS float* XC = (LAS float*)c.lds + L_XC; LAS float* As = (LAS float*)c.lds + L_AS; LAS float* Bs = (LAS float*)c.lds + L_BS;
    const bf16* wl = (const bf16*)(a.ws + WS_W + (size_t)l * WL_STRIDE);
    const int lane = c.tid & 63, w = __builtin_amdgcn_readfirstlane(c.tid >> 6), fr = lane & 15, fq = lane >> 4;
    const int e = 16 * w + fr, ch = n * 128 + e;
    const bf16* wa = wl + OFF_LWA / 2 + (size_t)(n * 128 + e) * 128 + 8 * fq; const bf16* wx = wl + OFF_LWX / 2 + (size_t)(n * 128 + e) * 128 + 8 * fq;
    bf16x8 Ba[4], Bx[4];
#pragma unroll
    for (int ks = 0; ks < 4; ++ks) { Ba[ks] = *(const bf16x8*)(wa + 32 * ks); Bx[ks] = *(const bf16x8*)(wx + 32 * ks); }
    const float ba = a.in[17][(size_t)l * D + ch], bx = a.in[19][(size_t)l * D + ch], sp = ((const float*)(a.ws + WS_TAB + 32768))[l * D + ch];
#pragma unroll
    for (int m = 0; m < 4; ++m) {
        f32x4 ar = (f32x4){0.f, 0.f, 0.f, 0.f}, ai = (f32x4){0.f, 0.f, 0.f, 0.f};
#pragma unroll
        for (int ks = 0; ks < 4; ++ks) {
            const bf16x8 af = *(const LAS bf16x8*)(c.lds + LB_XCB + (16 * m + fr) * XCB_STRIDE + (32 * ks + 8 * fq) * 2);
            ar = __builtin_amdgcn_mfma_f32_16x16x32_bf16(af, Ba[ks], ar, 0, 0, 0);
            ai = __builtin_amdgcn_mfma_f32_16x16x32_bf16(af, Bx[ks], ai, 0, 0, 0);
        }
#pragma unroll
        for (int j = 0; j < 4; ++j) {
            const int t = 16 * m + 4 * fq + j;
            const float r = sigmoidf_(ar[j] + ba), ig = sigmoidf_(ai[j] + bx);
            const float la = -8.0f * r * sp, aa = expf(la), mult = sqrtf(-expm1f(2.0f * la));
            As[t * 128 + e] = aa; Bs[t * 128 + e] = mult * ig * XC[t * 128 + e];
        }
    }
}
#if FAST_GATES
#define lru_gates lru_gates_mfma
#else
#define lru_gates lru_gates_naive
#endif

constexpr int LB_CW = LB_XCB + 64 * XCB_STRIDE;
static_assert(LB_CW + 2560 <= MISC_OFF, "lru lds");
__device__ __forceinline__ void lru_prompt_item(CArgs& a, Ctx& c, int l, int b, int n, int hc) {
    LAS float* L = (LAS float*)c.lds;
    LAS float* As = L + L_AS; LAS float* Bs = L + L_BS; LAS float* SEG = L + L_SEG; LAS float* CAR = L + L_CARRY;
    const bf16* XB = (const bf16*)(a.ws + WS_XB); const bf16* YG = (const bf16*)(a.ws + WS_YG); bf16* OB = (bf16*)(a.ws + WS_OB);
    const int t_ld = c.tid >> 3, c0 = (c.tid & 7) * 16;
    const int cch = c.tid & 63, sg = c.tid >> 6;
    const int lane = c.tid & 63, w = __builtin_amdgcn_readfirstlane(c.tid >> 6), fr = lane & 15, fq = lane >> 4;
    const int ec = 16 * (w & 3) + fr, e = 64 * hc + ec, ch = n * 128 + e, m0 = 2 * (w >> 2);
    const int chs = n * 128 + 64 * hc + cch;
    __syncthreads();
    if (c.tid < 128) CAR[c.tid] = 0.f;
    if (c.tid < 384) L[L_XBS + c.tid] = 0.f;
    f32x4 cwr[4][4], cbr[4];
#pragma unroll
    for (int j4 = 0; j4 < 4; ++j4) { cbr[j4] = *(const f32x4*)(a.in[15] + (size_t)l * D + n * 128 + c0 + 4 * j4);
#pragma unroll
        for (int j = 0; j < 4; ++j) cwr[j][j4] = *(const f32x4*)(a.in[14] + (size_t)l * 4 * D + j * D + n * 128 + c0 + 4 * j4); }
    bf16x8 Ba[4], Bx[4];
    { const bf16* wl = (const bf16*)(a.ws + WS_W + (size_t)l * WL_STRIDE);
      const bf16* wa = wl + OFF_LWA / 2 + (size_t)(n * 128 + e) * 128 + 8 * fq; const bf16* wx = wl + OFF_LWX / 2 + (size_t)(n * 128 + e) * 128 + 8 * fq;
#pragma unroll
      for (int ks = 0; ks < 4; ++ks) { Ba[ks] = *(const bf16x8*)(wa + 32 * ks); Bx[ks] = *(const bf16x8*)(wx + 32 * ks); } }
    const float ba = a.in[17][(size_t)l * D + ch], bx = a.in[19][(size_t)l * D + ch], sp8 = -8.0f * ((const float*)(a.ws + WS_TAB + 32768))[l * D + ch];
    const bf16* xsrc = XB + (size_t)(b * SEQ + t_ld) * D + n * 128 + c0;
    u32x4 xr0 = *(const u32x4*)xsrc, xr1 = *(const u32x4*)(xsrc + 8);
    for (int t0 = 0; t0 < SEQ; t0 += 64) {
        const int par = (t0 >> 6) & 1;
        unsigned ygr[8];
        { const bf16* yp = YG + (size_t)(b * SEQ + t0 + sg * 8) * D + chs;
#pragma unroll
          for (int tt = 0; tt < 8; ++tt) ygr[tt] = yp[(size_t)tt * D]; }
        WG_BAR();
        { LAS float* dst = L + L_XBS + (3 + t_ld) * 128 + c0;
          *(LAS f32x4*)dst        = (f32x4){bf2f(xr0.x & 0xffffu), bf2f(xr0.x >> 16), bf2f(xr0.y & 0xffffu), bf2f(xr0.y >> 16)};
          *(LAS f32x4*)(dst + 4)  = (f32x4){bf2f(xr0.z & 0xffffu), bf2f(xr0.z >> 16), bf2f(xr0.w & 0xffffu), bf2f(xr0.w >> 16)};
          *(LAS f32x4*)(dst + 8)  = (f32x4){bf2f(xr1.x & 0xffffu), bf2f(xr1.x >> 16), bf2f(xr1.y & 0xffffu), bf2f(xr1.y >> 16)};
          *(LAS f32x4*)(dst + 12) = (f32x4){bf2f(xr1.z & 0xffffu), bf2f(xr1.z >> 16), bf2f(xr1.w & 0xffffu), bf2f(xr1.w >> 16)}; }
        if (t0 + 64 < SEQ) { xr0 = *(const u32x4*)(xsrc + (size_t)(t0 + 64) * D); xr1 = *(const u32x4*)(xsrc + (size_t)(t0 + 64) * D + 8); }
        WG_BAR();
#pragma unroll
        for (int j4 = 0; j4 < 4; ++j4) { const int cc = c0 + 4 * j4;
            f32x4 acc = cbr[j4];
#pragma unroll
            for (int j = 0; j < 4; ++j) acc += cwr[j][j4] * *(const LAS f32x4*)(L + L_XBS + (t_ld + j) * 128 + cc);
            *(LAS f32x4*)(L + L_XC + t_ld * 128 + cc) = acc;
            { u32x2 pw; pw.x = pk2(acc[0], acc[1]); pw.y = pk2(acc[2], acc[3]); *(LAS u32x2*)(c.lds + LB_XCB + t_ld * XCB_STRIDE + cc * 2) = pw; } }
        WG_BAR();
#pragma unroll
        for (int mm = 0; mm < 2; ++mm) {
            const int m = m0 + mm;
            f32x4 ar = (f32x4){0.f, 0.f, 0.f, 0.f}, ai = (f32x4){0.f, 0.f, 0.f, 0.f};
#pragma unroll
            for (int ks = 0; ks < 4; ++ks) {
                const bf16x8 af = *(const LAS bf16x8*)(c.lds + LB_XCB + (16 * m + fr) * XCB_STRIDE + (32 * ks + 8 * fq) * 2);
                ar = __builtin_amdgcn_mfma_f32_16x16x32_bf16(af, Ba[ks], ar, 0, 0, 0);
                ai = __builtin_amdgcn_mfma_f32_16x16x32_bf16(af, Bx[ks], ai, 0, 0, 0);
            }
#pragma unroll
            for (int j = 0; j < 4; ++j) {
                const int t = 16 * m + 4 * fq + j;
                const float r = sig_fast(ar[j] + ba), ig = sig_fast(ai[j] + bx);
                const float la = sp8 * r, x2 = 2.0f * la;
                const float em = x2 > -0.5f ? x2 * (1.0f + x2 * (0.5f + x2 * (0.16666667f + x2 * (0.041666668f + x2 * 0.0083333338f)))) : __expf(x2) - 1.0f;
                As[t * 64 + ec] = __expf(la); Bs[t * 64 + ec] = __builtin_amdgcn_sqrtf(-em) * ig * L[L_XC + t * 128 + e];
            }
        }
        WG_BAR();
        float P = 1.f, Bv = 0.f;
#pragma unroll
        for (int tt = 0; tt < 8; ++tt) { const float aa = As[(sg * 8 + tt) * 64 + cch], bb = Bs[(sg * 8 + tt) * 64 + cch]; Bv = aa * Bv + bb; P *= aa; }
        SEG[(sg * 64 + cch) * 2] = P; SEG[(sg * 64 + cch) * 2 + 1] = Bv;
        WG_BAR();
        float h = CAR[par * 64 + cch];
        for (int s2 = 0; s2 < sg; ++s2) h = SEG[(s2 * 64 + cch) * 2] * h + SEG[(s2 * 64 + cch) * 2 + 1];
        { bf16* op = OB + (size_t)(b * SEQ + t0 + sg * 8) * D + chs;
#pragma unroll
          for (int tt = 0; tt < 8; ++tt) { const int t = sg * 8 + tt;
              h = As[t * 64 + cch] * h + Bs[t * 64 + cch];
              op[(size_t)tt * D] = (bf16)f2bf(h * bf2f(ygr[tt])); } }
        if (sg == 7) CAR[(par ^ 1) * 64 + cch] = h;
        if (c.tid < 384) L[L_XBS + c.tid] = L[L_XBS + 64 * 128 + c.tid];
    }
    __syncthreads();
    if (c.tid < 64) a.out[O_LRP + ((size_t)l * NBATCH + b) * D + n * 128 + 64 * hc + c.tid] = CAR[c.tid];
    if (hc == 0 && c.tid < 384) a.out[O_CVP + (((size_t)l * NBATCH + b) * 3 + (c.tid >> 7)) * D + n * 128 + (c.tid & 127)] = L[L_XBS + c.tid];
    __syncthreads();
}
__device__ __forceinline__ void lru_sample_item(CArgs& a, Ctx& c, int l, int n, int hf) {
    LAS float* L = (LAS float*)c.lds;
    const bf16* XB = (const bf16*)(a.ws + WS_XB); const bf16* YG = (const bf16*)(a.ws + WS_YG); bf16* OB = (bf16*)(a.ws + WS_OB);
    const int t_ld = c.tid >> 3, c0 = (c.tid & 7) * 16;
    const float* cw = a.in[14] + (size_t)l * 4 * D + n * 128; const float* cb = a.in[15] + (size_t)l * D + n * 128;
    const int bs = hf * 64 + t_ld, row = MP + bs;
    const float* sc = a.in[4] + ((size_t)l * NS + bs) * 3 * D + n * 128;
    float* nc = a.out + O_CVS + ((size_t)l * NS + bs) * 3 * D + n * 128;
    __syncthreads();
#pragma unroll
    for (int j4 = 0; j4 < 4; ++j4) { const int cc = c0 + 4 * j4;
        const f32x4 x = ld_bf4(XB + (size_t)row * D + n * 128 + cc);
        const f32x4 s0 = *(const f32x4*)(sc + cc), s1 = *(const f32x4*)(sc + D + cc), s2 = *(const f32x4*)(sc + 2 * D + cc);
        const f32x4 acc = *(const f32x4*)(cb + cc) + *(const f32x4*)(cw + cc) * s0 + *(const f32x4*)(cw + D + cc) * s1 + *(const f32x4*)(cw + 2 * D + cc) * s2 + *(const f32x4*)(cw + 3 * D + cc) * x;
        *(LAS f32x4*)(L + L_XC + t_ld * 128 + cc) = acc;
        { u32x2 w; w.x = pk2(acc[0], acc[1]); w.y = pk2(acc[2], acc[3]); *(LAS u32x2*)(c.lds + LB_XCB + t_ld * XCB_STRIDE + cc * 2) = w; }
        *(f32x4*)(nc + cc) = s1; *(f32x4*)(nc + D + cc) = s2; *(f32x4*)(nc + 2 * D + cc) = x; }
    __syncthreads();
    lru_gates(a, c, l, n);
    __syncthreads();
    { const int cch = c.tid & 127, tg = c.tid >> 7;
#pragma unroll 4
      for (int tt = 0; tt < 16; ++tt) { const int t = tg * 16 + tt, b2 = hf * 64 + t; const size_t off = (size_t)(MP + b2) * D + n * 128 + cch;
          const float h0 = a.in[3][((size_t)l * NS + b2) * D + n * 128 + cch];
          const float h = L[L_AS + t * 128 + cch] * h0 + L[L_BS + t * 128 + cch];
          a.out[O_LRS + ((size_t)l * NS + b2) * D + n * 128 + cch] = h;
          OB[off] = (bf16)f2bf(h * bf2f(YG[off])); } }
    __syncthreads();
}

__device__ __forceinline__ void mixer_phase(CArgs& a, Ctx& c, int l) {
    if (c.wg < 64) {
        hgrn_fast_prompt(a, c, l, c.wg >> 3, c.wg & 7);
    } else if (c.wg < 192) {
        const int i = c.wg - 64;
        for (int rep = 0; rep < 1 + ((PROBE_MIX >> 1) & 1); ++rep) lru_prompt_item(a, c, l, i >> 4, (i >> 1) & 7, i & 1);
    } else {
        for (int rep = 0; rep < 1 + ((PROBE_MIX >> 2) & 1); ++rep)
        for (int it = c.wg - 192; it < NS * NH; it += c.G - 192) {
            const int bs = it >> 3, h = it & 7; const size_t so = (((size_t)l * NS + bs) * NH + h) * DKV * DKV;
            hgrn_naive(a, c, l, MP + bs, 1, h, a.in[2] + so, a.out + O_HGS + so);
        }
        if (c.wg - 192 < 16) lru_sample_item(a, c, l, (c.wg - 192) >> 1, (c.wg - 192) & 1);
    }
}

__global__ void __launch_bounds__(512, 2) mega_fwd(Args a0) {
    extern __shared__ __attribute__((aligned(16))) unsigned char lds_raw[];
    Ctx c; c.lds = (LAS unsigned char*)lds_raw; c.tid = threadIdx.x; c.G = gridDim.x; c.wg = blockIdx.x;
    volatile LAS unsigned* MISC = (volatile LAS unsigned*)(c.lds + MISC_OFF);
    if (c.tid < 32) MISC[c.tid] = 0u;
    __syncthreads();
    XcdBarrier bar; bar.bar = (unsigned*)(a0.ws + WS_CTL) + 1024; bar.x = 0; bar.st = nullptr;
    const int nprog = a0.nprog;
    if (nprog > 1) bar = xcd_barrier_post((unsigned*)(a0.ws + WS_CTL) + 1024, MISC + 8);

    for (int pi = 0; pi < nprog; ++pi) {
        CArgs* ap = (CArgs*)__builtin_amdgcn_kernarg_segment_ptr(); asm volatile("" : "+s"(ap));
        CArgs& a = *ap;
        const int ph = a.prog[pi];
        unsigned long long pt0 = 0ull; if (PROBE_T >= 100 && ph == PROBE_T - 100) pt0 = __builtin_amdgcn_s_memrealtime();
        { int t_ = threadIdx.x, w_ = blockIdx.x, g_ = gridDim.x; asm volatile("" : "+v"(t_), "+s"(w_), "+s"(g_)); c.tid = t_; c.wg = w_; c.G = g_; }
        float* X = a.out;
        if (ph == 0) { }
        else if (ph == NPHASE - 1) final_norm_phase(a, c);
        else {
            const int l = (ph - 1) / 9, j = (ph - 1) % 9;
            const bf16* wl = (const bf16*)(a.ws + WS_W + (size_t)l * WL_STRIDE);
            const float* xp = l == 0 ? a.in[0] : X; const float* xs = l == 0 ? a.in[1] : X + (size_t)MP * D;
            const float* modl = (const float*)(a.ws + WS_MOD) + (size_t)l * NMOD * 6144;
            bf16* H = (bf16*)(a.ws + WS_H);
            if (j == 0) norm_phase(a, c, l, 0, xp, xs);
            else if (j == 1) {
                EpiIn e{a.ws + WS_PREP, (bf16*)(a.ws + WS_SQ), (bf16*)(a.ws + WS_SK), (float*)(a.ws + WS_SLOGF), (bf16*)(a.ws + WS_V), (bf16*)(a.ws + WS_OG), (bf16*)(a.ws + WS_XB), (bf16*)(a.ws + WS_YG), (bf16*)(a.ws + WS_SGA), (bf16*)(a.ws + WS_SGB),
                        (const float*)(a.ws + WS_TAB) + (size_t)l * 3 * D, l == 0 ? 1 : 0};
                gemm_phase_sel<0>(c, H, wl + OFF_WIN / 2, MT, NIN, D, e);
            } else if (j == 2) hgrn_prep_phase(a, c);
            else if (j == 3) mixer_phase(a, c, l);
            else if (j == 4) {
                EpiBrA ea{(const bf16*)(a.ws + WS_SGA), (float*)(a.ws + WS_T)};
                EpiBrB eb{(const bf16*)(a.ws + WS_SGB), (const float*)(a.ws + WS_T), (bf16*)(a.ws + WS_MG)};
                {
                    pg8::Gemm g{(const bf16*)(a.ws + WS_OA), wl + OFF_WA / 2, MP, D, D, (const bf16*)(a.ws + WS_OB), wl + OFF_WB / 2};
                    PowOrder S; S.init(2, c.G, c.wg, 1);
                    EpiBranchUnit qe{(const bf16*)(a.ws + WS_SGA), (const bf16*)(a.ws + WS_SGB), (bf16*)(a.ws + WS_MG)};
                    pg8::gemm_phase<EpiBranchUnit, PowOrder, true, true>(c.lds, g, S, qe, c.tid);
                }
                { int t_ = threadIdx.x; asm volatile("" : "+v"(t_)); c.tid = t_; }
                sample_gemm_phase(c, (const bf16*)(a.ws + WS_OA), wl + OFF_WA / 2, D, D, ea);
                asm volatile("s_waitcnt vmcnt(0)" ::: "memory"); __syncthreads();
                sample_gemm_phase(c, (const bf16*)(a.ws + WS_OB), wl + OFF_WB / 2, D, D, eb);
            } else if (j == 5) {
                EpiRes e{xp, xs, X, modl, 2};
                gemm_phase_sel<3>(c, (const bf16*)(a.ws + WS_MG), wl + OFF_WO / 2, MT, D, D, e);
            } else if (j == 6) norm_phase(a, c, l, 1, X, X + (size_t)MP * D);
            else if (j == 7) { EpiFF1 e{(bf16*)(a.ws + WS_HM)}; gemm_phase_sel<4>(c, H, wl + OFF_W1 / 2, MT, FF, D, e); }
            else { float* XO = (l == 1 && XOUT_SCRATCH) ? (float*)(a.ws + WS_T) : X;
                   EpiRes e{X, X + (size_t)MP * D, XO, modl, 5}; gemm_phase_sel<5>(c, (const bf16*)(a.ws + WS_HM), wl + OFF_W2 / 2, MT, D, FF, e); }
        }
        if (ph == 0 || (ph == 4 && c.wg >= 192)) {
            { int t_ = threadIdx.x; asm volatile("" : "+v"(t_)); c.tid = t_; }
            p0_work(a, c, ph == 0 ? 0 : 1, ph == 0 ? c.wg : c.wg - 192, ph == 0 ? c.G : c.G - 192, ph == 0, ph == 0 ? 2 : 0);
        }
        if (pi + 1 < nprog) xcd_barrier(bar);
        if (PROBE_T >= 100 && ph == PROBE_T - 100 && c.wg == 0 && threadIdx.x == 0) *(float*)(a.ws + WS_DBG) = (float)(__builtin_amdgcn_s_memrealtime() - pt0) * 1e-4f;
    }
}

extern "C" void kernel_launch(void* const* d_in, const int* in_sizes, int n_in, void* d_out, int out_size, void* d_ws, size_t ws_size, hipStream_t stream) {
    static int grid = 0;
    if (grid == 0) {
        if (n_in != 27 || out_size != (int)O_END || ws_size < WS_END) { fprintf(stderr, "kernel_launch: unexpected shapes (n_in %d out %d ws %zu)\n", n_in, out_size, ws_size); grid = -1; return; }
        int dev = 0, cus = 0, per_cu = 0;
        if (hipGetDevice(&dev) != hipSuccess || hipDeviceGetAttribute(&cus, hipDeviceAttributeMultiprocessorCount, dev) != hipSuccess) { grid = -1; return; }
        if (hipFuncSetAttribute((const void*)mega_fwd, hipFuncAttributeMaxDynamicSharedMemorySize, LDS_BYTES) != hipSuccess) { fprintf(stderr, "kernel_launch: hipFuncSetAttribute failed\n"); grid = -1; return; }
        if (hipOccupancyMaxActiveBlocksPerMultiprocessor(&per_cu, (const void*)mega_fwd, 512, LDS_BYTES) != hipSuccess || per_cu < 1) { fprintf(stderr, "kernel_launch: occupancy query failed (%d)\n", per_cu); (void)hipGetLastError(); per_cu = 1; }
        grid = cus * (per_cu < 1 ? 1 : 1);
        fprintf(stderr, "kernel_launch: cus %d per_cu %d grid %d\n", cus, per_cu, grid);
    }
    if (grid < 0) return;
    (void)hipMemsetAsync((char*)d_ws + WS_CTL, 0, CTL_BYTES, stream);
    Args a{};
    for (int i = 0; i < 27; ++i) a.in[i] = (const float*)d_in[i];
    a.out = (float*)d_out; a.ws = (unsigned char*)d_ws;
    unsigned char prog[60]; int np = 0;
    for (int ph = 0; ph < NPHASE; ++ph) for (int rep = 0; rep < 1 + (int)(((unsigned)PROBE_REPEAT >> ph) & 1u); ++rep) prog[np++] = (unsigned char)ph;
#if ONE_LAUNCH
    a.nprog = np; for (int i = 0; i < np; ++i) a.prog[i] = prog[i];
    void* kargs[] = {&a};
    hipError_t e = hipLaunchCooperativeKernel((const void*)mega_fwd, dim3(grid), dim3(512), kargs, LDS_BYTES, stream);
    if (e != hipSuccess) fprintf(stderr, "kernel_launch: cooperative launch failed: %s (grid %d)\n", hipGetErrorString(e), grid);
#else
    for (int i = 0; i < np; ++i) { a.nprog = 1; a.prog[0] = prog[i]; hipLaunchKernelGGL(mega_fwd, dim3(grid), dim3(512), LDS_BYTES, stream, a); }
#endif
}
```

```cpp
#include <hip/hip_runtime.h>
#include <cstdio>
#include <cstdint>

#ifndef FAST_GEMM
#define FAST_GEMM 63
#endif
#ifndef FAST_HGRN
#define FAST_HGRN 1
#endif
#ifndef FAST_GATES
#define FAST_GATES 1
#endif
#ifndef DBG_SHFL
#define DBG_SHFL 1
#endif
#ifndef PROBE_REPEAT
#define PROBE_REPEAT 0
#endif
#ifndef PROBE_MIX
#define PROBE_MIX 0
#endif
#ifndef PROBE_P0
#define PROBE_P0 0
#endif
#ifndef XOUT_SCRATCH
#define XOUT_SCRATCH 0
#endif
#ifndef PROBE_T
#define PROBE_T 0
#endif
#ifndef ONE_LAUNCH
#define ONE_LAUNCH 1
#endif

#define LAS __attribute__((address_space(3)))
#define GAS __attribute__((address_space(1)))
typedef unsigned short bf16;
typedef float f32x4 __attribute__((ext_vector_type(4)));
typedef float f32x2 __attribute__((ext_vector_type(2)));
typedef short bf16x8 __attribute__((ext_vector_type(8)));
typedef unsigned u32x4 __attribute__((ext_vector_type(4)));
typedef unsigned u32x2 __attribute__((ext_vector_type(2)));

constexpr int D = 1024, NBATCH = 8, SEQ = 2048, MP = NBATCH * SEQ, NS = 128, MR = MP + NS, MT = 16640;
constexpr int NMOD = NBATCH + NS;
constexpr int NIN = 8192, FF = 4096, NH = 8, DKV = 128;
constexpr float EPS = 1e-6f;
constexpr int NPHASE = 20;

constexpr size_t MiB = (size_t)1 << 20;
constexpr size_t WS_CTL = 0, CTL_BYTES = 64 * 1024;
constexpr size_t WS_DBG = 512 * 1024;
constexpr size_t WS_TAB = 1 * MiB;
constexpr size_t WS_MOD = 2 * MiB;
constexpr size_t WS_W = 9 * MiB, WL_STRIDE = 77 * MiB / 2;
constexpr size_t OFF_WIN = 0, OFF_WA = 16 * MiB, OFF_WB = 18 * MiB, OFF_WO = 20 * MiB, OFF_W1 = 22 * MiB, OFF_W2 = 30 * MiB, OFF_LWA = 38 * MiB, OFF_LWX = 38 * MiB + 256 * 1024;
constexpr size_t WS_H = 86 * MiB;
constexpr size_t WS_PREP = 119 * MiB;
constexpr size_t PREP_BLK = 65536;
constexpr size_t WS_V = 247 * MiB, WS_OG = 280 * MiB, WS_XB = 313 * MiB, WS_YG = 346 * MiB, WS_SGA = 379 * MiB, WS_SGB = 412 * MiB;
constexpr size_t WS_OA = 445 * MiB;
constexpr size_t WS_SQ = 478 * MiB, WS_SK = WS_SQ + 256 * 1024, WS_SLOGF = WS_SQ + 512 * 1024;
constexpr size_t WS_OB = WS_H;
constexpr size_t WS_T = WS_PREP;
constexpr size_t WS_MG = WS_PREP + 66 * MiB;
constexpr size_t WS_HM = WS_PREP;
constexpr size_t WS_END = 480 * MiB;
static_assert(WS_W + 2 * WL_STRIDE <= WS_H && WS_H + (size_t)MT * D * 2 <= WS_PREP && WS_PREP + 2048 * PREP_BLK <= WS_V && WS_T + (size_t)MT * D * 4 <= WS_MG && WS_MG + (size_t)MT * D * 2 <= WS_V
              && WS_HM + (size_t)MT * FF * 2 <= WS_OG && WS_OA + (size_t)MT * D * 2 <= WS_SQ && WS_SLOGF + 512 * 1024 <= WS_END, "ws map");

constexpr size_t O_YP = 0, O_YS = (size_t)MP * D, O_HGP = O_YS + (size_t)NS * D, O_LRP = O_HGP + (size_t)2 * NBATCH * NH * DKV * DKV, O_CVP = O_LRP + (size_t)2 * NBATCH * D,
                 O_HGS = O_CVP + (size_t)2 * NBATCH * 3 * D, O_LRS = O_HGS + (size_t)2 * NS * NH * DKV * DKV, O_CVS = O_LRS + (size_t)2 * NS * D, O_END = O_CVS + (size_t)2 * NS * 3 * D;
static_assert(O_END == 53673984, "out map");

constexpr int LDS_BYTES = 163840;
constexpr int MISC_OFF = 158 * 1024;

typedef __bf16 bf16x2_t __attribute__((ext_vector_type(2)));
__device__ __forceinline__ unsigned f2bf(float f) { return (unsigned)__builtin_bit_cast(unsigned short, (__bf16)f); }
__device__ __forceinline__ unsigned pk2(float lo, float hi) { return __builtin_bit_cast(unsigned, __builtin_convertvector((f32x2){lo, hi}, bf16x2_t)); }
__device__ __forceinline__ float bf2f(unsigned b) { return __builtin_bit_cast(float, b << 16); }
__device__ __forceinline__ f32x4 ld_bf4(const bf16* p) { const u32x2 w = *(const u32x2*)p; return (f32x4){bf2f(w.x & 0xffffu), bf2f(w.x >> 16), bf2f(w.y & 0xffffu), bf2f(w.y >> 16)}; }
__device__ __forceinline__ void st_bf4(bf16* p, f32x4 v) { u32x2 w; w.x = pk2(v[0], v[1]); w.y = pk2(v[2], v[3]); *(u32x2*)p = w; }
#define WG_BAR() do { asm volatile("s_waitcnt lgkmcnt(0)" ::: "memory"); __builtin_amdgcn_s_barrier(); asm volatile("" ::: "memory"); } while (0)
__device__ __forceinline__ float sig_fast(float x) { return __builtin_amdgcn_rcpf(1.0f + __expf(-x)); }
__device__ __forceinline__ void st_bf8(bf16* p, f32x4 v0, f32x4 v1) { u32x4 w; w.x = pk2(v0[0], v0[1]); w.y = pk2(v0[2], v0[3]); w.z = pk2(v1[0], v1[1]); w.w = pk2(v1[2], v1[3]); *(u32x4*)p = w; }
__device__ __forceinline__ void ld_bf8(const bf16* p, f32x4& v0, f32x4& v1) { const u32x4 w = *(const u32x4*)p; v0 = (f32x4){bf2f(w.x & 0xffffu), bf2f(w.x >> 16), bf2f(w.y & 0xffffu), bf2f(w.y >> 16)}; v1 = (f32x4){bf2f(w.z & 0xffffu), bf2f(w.z >> 16), bf2f(w.w & 0xffffu), bf2f(w.w >> 16)}; }
__device__ __forceinline__ float sigmoidf_(float x) { return 1.0f / (1.0f + __expf(-x)); }
__device__ __forceinline__ float siluf_(float x) { return x * sigmoidf_(x); }
__device__ __forceinline__ float gelu_tanh_(float x) { const float u = 0.7978845608028654f * (x + 0.044715f * x * x * x); return x * sigmoidf_(2.0f * u); }
__device__ __forceinline__ float softplusf_(float x) { return fmaxf(x, 0.f) + log1pf(expf(-fabsf(x))); }
template <int XM> __device__ __forceinline__ float swz_xor(float v) { return __builtin_bit_cast(float, __builtin_amdgcn_ds_swizzle(__builtin_bit_cast(int, v), (XM << 10) | 0x1f)); }
__device__ __forceinline__ int lane_id_fresh() { int l = (int)__builtin_amdgcn_mbcnt_hi(~0u, __builtin_amdgcn_mbcnt_lo(~0u, 0u)); asm volatile("" : "+v"(l)); return l; }
__device__ __forceinline__ float xchg(float v, int l, int m) { return __builtin_bit_cast(float, __builtin_amdgcn_ds_bpermute((l ^ m) << 2, __builtin_bit_cast(int, v))); }
template <int CTRL> __device__ __forceinline__ float dpp_f(float v) { return __builtin_bit_cast(float, __builtin_amdgcn_update_dpp(0, __builtin_bit_cast(int, v), CTRL, 0xf, 0xf, false)); }
__device__ __forceinline__ float row16_sum(float v) { v += dpp_f<0xB1>(v); v += dpp_f<0x4E>(v); v += dpp_f<0x141>(v); v += dpp_f<0x140>(v); return v; }
__device__ __forceinline__ float half_sum(float v) { const int l = lane_id_fresh(); v += xchg(v, l, 1); v += xchg(v, l, 2); v += xchg(v, l, 4); v += xchg(v, l, 8); v += xchg(v, l, 16); return v; }
__device__ __forceinline__ float wave_sum(float v) { const int l = lane_id_fresh(); v += xchg(v, l, 1); v += xchg(v, l, 2); v += xchg(v, l, 4); v += xchg(v, l, 8); v += xchg(v, l, 16); v += xchg(v, l, 32); return v; }
__device__ __forceinline__ int mod_row(int row) { return row < MP ? (row >> 11) : (NBATCH + row - MP); }

struct Args { const float* in[27]; float* out; unsigned char* ws; int nprog; unsigned char prog[60]; };
typedef const __attribute__((address_space(4))) Args CArgs;
struct Ctx { LAS unsigned char* lds; int tid, G, wg; };
namespace pg8 {
#define PG8_LAS __attribute__((address_space(3)))
typedef unsigned short bf16_t;
typedef short bf16x8 __attribute__((ext_vector_type(8)));
typedef float f32x4 __attribute__((ext_vector_type(4)));
typedef unsigned u32x4 __attribute__((ext_vector_type(4)));
constexpr int BM = 256, BK = 64, HALF = 128, HTB = HALF * BK * 2  , STAGE_BYTES = 8 * HTB, NXCD = 8, WGM = 8;

__host__ __device__ __forceinline__ int lds_byte(int r, int c) { const int st = (r >> 4) * 2 + (c >> 5), rr = r & 15, cc = c & 31, ob = rr * 64 + cc * 2; return st * 1024 + (ob ^ (((ob >> 9) & 1) << 5)); }
__host__ __device__ __forceinline__ void stage_rc(int b, int& R, int& C) { const int st = b / 1024, sb = b % 1024, swz = sb ^ (((sb >> 9) & 1) << 5); R = (st >> 1) * 16 + swz / 64; C = (st & 1) * 32 + (swz % 64) / 2; }
__host__ __device__ __forceinline__ int perm32(int rho) { const int n = rho >> 4, i = rho & 15; return 8 * (i >> 2) + 4 * n + (i & 3); }

struct Unit { int pm, pn, z; };
struct Gemm { const bf16_t* A; const bf16_t* Bt; int M, N, K; const bf16_t* A2; const bf16_t* Bt2; };

struct StaticOrder {
    int nM, nN, nwg, G, c;
    __host__ __device__ void init(int M, int N, int G_, int c_) { nM = M / BM; nN = N / BM; nwg = nM * nN; G = G_; c = c_; }
    __host__ __device__ bool next(int i, Unit& u) const {
        const long L = (long)i * G + c; if (L >= nwg) return false;
        int wgid = (int)L; { const int q = nwg / NXCD, r = nwg % NXCD, xcd = wgid % NXCD, off = wgid / NXCD; wgid = (xcd < r ? xcd * (q + 1) : r * (q + 1) + (xcd - r) * q) + off; }
        const int nig = WGM * nN, gid = wgid / nig, fm = gid * WGM, gsz = (nM - fm) < WGM ? (nM - fm) : WGM;
        u.pm = fm + ((wgid % nig) % gsz); u.pn = (wgid % nig) / gsz; u.z = 0; return true;
    }
    __device__ __forceinline__ void a_ready(const Unit&) const {}
    __device__ __forceinline__ void done(const Unit&) const {}
};
template <class Epi, class Sched, bool ALIGN_EPI = false, bool SP2 = false>
__device__ __forceinline__ void gemm_phase(PG8_LAS unsigned char* lds, const Gemm g, const Sched& S, const Epi& E, const int tid_in) {
    const int tid = tid_in, wid = __builtin_amdgcn_readfirstlane(tid >> 6), lane = tid & 63, wr = wid >> 2, wc = wid & 3, fr = lane & 15, fq = lane >> 4;
    const int K = g.K, nt = K / BK;
    unsigned voffA[2], voffB[2];
#pragma unroll
    for (int i = 0; i < 2; ++i) { int R, C; stage_rc(tid * 16 + i * 8192, R, C); const int Rb = Epi::PERM ? ((R & ~31) + perm32(R & 31)) : R;
        voffA[i] = (unsigned)(R * K + C) * 2u; voffB[i] = (unsigned)(Rb * K + C) * 2u; }
    const size_t kstep = (size_t)(BK * 2);
    const size_t hstep = (size_t)HALF * K * 2;
    const size_t tstep = 2 * hstep;
    const unsigned ldsw = (unsigned)wid * 1024u;
    const int aoff = lds_byte(wr * 64 + fr, fq * 8), boff = lds_byte(wc * 32 + fr, fq * 8);
#define PG8_SA(b, h) (((b) * 2 + (h)) * HTB)
#define PG8_SB(b, h) ((4 + (b) * 2 + (h)) * HTB)
#define PG8_STAGE(bufoff, gbase, voff) do { _Pragma("unroll") for (int _i = 0; _i < 2; ++_i) \
        __builtin_amdgcn_global_load_lds((const unsigned*)((const char*)(gbase) + (voff)[_i]), (PG8_LAS unsigned*)(lds + (bufoff) + ldsw + _i * 8192), 16, 0, 0); } while (0)
#define PG8_LDA(dst, b, h) do { _Pragma("unroll") for (int m = 0; m < 4; ++m) _Pragma("unroll") for (int k = 0; k < 2; ++k) dst[m][k] = *(const PG8_LAS bf16x8*)(lds + PG8_SA(b, h) + aoff + m * 2048 + k * 1024); } while (0)
#define PG8_LDB(dst, b, h) do { _Pragma("unroll") for (int n = 0; n < 2; ++n) _Pragma("unroll") for (int k = 0; k < 2; ++k) dst[n][k] = *(const PG8_LAS bf16x8*)(lds + PG8_SB(b, h) + boff + n * 2048 + k * 1024); } while (0)
#define PG8_MMA(ai, bj, At, Bt) do { __builtin_amdgcn_s_setprio(1); _Pragma("unroll") for (int m = 0; m < 4; ++m) _Pragma("unroll") for (int n = 0; n < 2; ++n) _Pragma("unroll") for (int k = 0; k < 2; ++k) \
        acc[ai][bj][m][n] = __builtin_amdgcn_mfma_f32_16x16x32_bf16(Bt[n][k], At[m][k], acc[ai][bj][m][n], 0, 0, 0); __builtin_amdgcn_s_setprio(0); } while (0)
#define PG8_WAIT_V(n) asm volatile("s_waitcnt vmcnt(" #n ")" ::: "memory")
#define PG8_WAIT_L(n) asm volatile("s_waitcnt lgkmcnt(" #n ")" ::: "memory")
#define PG8_BAR __builtin_amdgcn_s_barrier()
#define PG8_SCHED __builtin_amdgcn_sched_barrier(0)
    Unit cur, nxt; int ui = 0;
    if (!S.next(0, cur)) return;
    f32x4 acc[2][2][4][2];
#pragma unroll
    for (int a = 0; a < 2; ++a)
#pragma unroll
        for (int b = 0; b < 2; ++b)
#pragma unroll
            for (int m = 0; m < 4; ++m)
#pragma unroll
                for (int n = 0; n < 2; ++n) acc[a][b][m][n] = (f32x4){0.f, 0.f, 0.f, 0.f};
    bf16x8 At[4][2], B0[2][2], B1[2][2];
    const char* cA = (const char*)(cur.z ? g.A2 : g.A) + (size_t)cur.pm * tstep; const char* cB = (const char*)(cur.z ? g.Bt2 : g.Bt) + (size_t)cur.pn * tstep;
    S.a_ready(cur);
    if constexpr (SP2) {
        PG8_STAGE(PG8_SB(0, 0), cB, voffB); PG8_STAGE(PG8_SB(0, 1), cB + hstep, voffB); PG8_STAGE(PG8_SA(0, 0), cA, voffA); PG8_STAGE(PG8_SA(0, 1), cA + hstep, voffA);
        if (wr == 1) PG8_BAR;
        PG8_WAIT_V(2); PG8_BAR;
        PG8_STAGE(PG8_SB(1, 0), cB + kstep, voffB); PG8_STAGE(PG8_SA(1, 0), cA + kstep, voffA); PG8_STAGE(PG8_SB(1, 1), cB + hstep + kstep, voffB);
        PG8_WAIT_V(6); PG8_BAR;
    } else {
        PG8_STAGE(PG8_SB(0, 0), cB, voffB); PG8_STAGE(PG8_SA(0, 0), cA, voffA); PG8_STAGE(PG8_SB(0, 1), cB + hstep, voffB); PG8_STAGE(PG8_SA(0, 1), cA + hstep, voffA);
        if (wr == 1) PG8_BAR;
        PG8_WAIT_V(4); PG8_BAR;
        PG8_STAGE(PG8_SB(1, 0), cB + kstep, voffB); PG8_STAGE(PG8_SA(1, 0), cA + kstep, voffA); PG8_STAGE(PG8_SB(1, 1), cB + hstep + kstep, voffB);
        PG8_WAIT_V(6); PG8_BAR;
    }
    for (;;) {
        const bool has_next = S.next(ui + 1, nxt);
        const char* nA = has_next ? (const char*)(nxt.z ? g.A2 : g.A) + (size_t)nxt.pm * tstep : cA; const char* nB = has_next ? (const char*)(nxt.z ? g.Bt2 : g.Bt) + (size_t)nxt.pn * tstep : cB;
        for (int t = 0; t < nt; t += 2) {
            const bool last = (t == nt - 2);
            const char* a1 = cA + (size_t)(t + 1) * kstep;
            const char* a2 = last ? nA : cA + (size_t)(t + 2) * kstep; const char* b2 = last ? nB : cB + (size_t)(t + 2) * kstep;
            const char* a3 = a2 + kstep; const char* b3 = b2 + kstep;
            if (last && has_next) S.a_ready(nxt);
            if constexpr (SP2) {
            PG8_LDB(B0, 0, 0); PG8_LDB(B1, 0, 1); PG8_SCHED; PG8_LDA(At, 0, 0); PG8_STAGE(PG8_SA(1, 1), a1 + hstep, voffA);
            PG8_WAIT_V(8); PG8_WAIT_L(0); PG8_BAR; PG8_MMA(0, 0, At, B0); PG8_MMA(0, 1, At, B1); PG8_BAR; PG8_SCHED;
            PG8_LDA(At, 0, 1); PG8_STAGE(PG8_SB(0, 0), b2, voffB); PG8_STAGE(PG8_SB(0, 1), b2 + hstep, voffB); PG8_STAGE(PG8_SA(0, 0), a2, voffA);
            PG8_WAIT_V(8); PG8_WAIT_L(0); PG8_BAR; PG8_MMA(1, 0, At, B0); PG8_MMA(1, 1, At, B1); PG8_BAR; PG8_SCHED;
            PG8_LDB(B0, 1, 0); PG8_LDB(B1, 1, 1); PG8_SCHED; PG8_LDA(At, 1, 0); PG8_STAGE(PG8_SA(0, 1), a2 + hstep, voffA);
            PG8_WAIT_V(8); PG8_WAIT_L(0); PG8_BAR; PG8_MMA(0, 0, At, B0); PG8_MMA(0, 1, At, B1); PG8_BAR; PG8_SCHED;
            PG8_LDA(At, 1, 1); PG8_STAGE(PG8_SB(1, 0), b3, voffB); PG8_STAGE(PG8_SB(1, 1), b3 + hstep, voffB); PG8_STAGE(PG8_SA(1, 0), a3, voffA);
            PG8_WAIT_V(8); PG8_WAIT_L(0); PG8_BAR; PG8_MMA(1, 0, At, B0); PG8_MMA(1, 1, At, B1); PG8_BAR; PG8_SCHED;
            } else {
            PG8_LDB(B0, 0, 0); PG8_SCHED; PG8_LDA(At, 0, 0); PG8_STAGE(PG8_SA(1, 1), a1 + hstep, voffA);
            PG8_WAIT_L(8); PG8_BAR; PG8_WAIT_L(0); PG8_MMA(0, 0, At, B0); PG8_BAR; PG8_SCHED;
            PG8_LDB(B1, 0, 1); PG8_STAGE(PG8_SB(0, 0), b2, voffB);
            PG8_BAR; PG8_WAIT_L(0); PG8_MMA(0, 1, At, B1); PG8_BAR;
            PG8_LDA(At, 0, 1); PG8_STAGE(PG8_SA(0, 0), a2, voffA);
            PG8_BAR; PG8_WAIT_L(0); PG8_MMA(1, 0, At, B0); PG8_BAR; PG8_SCHED;
            PG8_STAGE(PG8_SB(0, 1), b2 + hstep, voffB);
            PG8_WAIT_V(6); PG8_BAR; PG8_MMA(1, 1, At, B1); PG8_BAR;
            PG8_LDB(B0, 1, 0); PG8_SCHED; PG8_LDA(At, 1, 0); PG8_STAGE(PG8_SA(0, 1), a2 + hstep, voffA);
            PG8_WAIT_L(8); PG8_BAR; PG8_WAIT_L(0); PG8_MMA(0, 0, At, B0); PG8_BAR; PG8_SCHED;
            PG8_LDB(B1, 1, 1); PG8_STAGE(PG8_SB(1, 0), b3, voffB);
            PG8_BAR; PG8_WAIT_L(0); PG8_MMA(0, 1, At, B1); PG8_BAR;
            PG8_LDA(At, 1, 1); PG8_STAGE(PG8_SA(1, 0), a3, voffA);
            PG8_BAR; PG8_WAIT_L(0); PG8_MMA(1, 0, At, B0); PG8_BAR; PG8_SCHED;
            PG8_STAGE(PG8_SB(1, 1), b3 + hstep, voffB);
            PG8_WAIT_V(6); PG8_BAR; PG8_MMA(1, 1, At, B1); PG8_BAR;
            }
        }
        if constexpr (ALIGN_EPI) { if (wr == 0) PG8_BAR; }
        if constexpr (!Epi::AFTER_DRAIN) { int l2 = (int)__builtin_amdgcn_mbcnt_hi(~0u, __builtin_amdgcn_mbcnt_lo(~0u, 0u)); asm volatile("" : "+v"(l2));
            E(acc, cur, wr, wc, l2 & 15, l2 >> 4); S.done(cur); }
        if (!has_next) break;
        if (!(Epi::KEEP && cur.z == 0)) {
#pragma unroll
        for (int a = 0; a < 2; ++a)
#pragma unroll
            for (int b = 0; b < 2; ++b)
#pragma unroll
                for (int m = 0; m < 4; ++m)
#pragma unroll
                    for (int n = 0; n < 2; ++n) acc[a][b][m][n] = (f32x4){0.f, 0.f, 0.f, 0.f};
        }
        cur = nxt; cA = nA; cB = nB; ++ui;
        if constexpr (ALIGN_EPI) { if (wr == 1) PG8_BAR; }
    }
    PG8_WAIT_V(0);
    if constexpr (!ALIGN_EPI) { if (wr == 0) PG8_BAR; }
    PG8_BAR;
    if constexpr (Epi::AFTER_DRAIN) { E.fused(acc, cur, wr, wc, fr, fq, lds, wid, lane); S.done(cur); }
#undef PG8_SA
#undef PG8_SB
#undef PG8_STAGE
#undef PG8_LDA
#undef PG8_LDB
#undef PG8_MMA
#undef PG8_WAIT_V
#undef PG8_WAIT_L
#undef PG8_BAR
#undef PG8_SCHED
}
}

template <class E> struct QuadEpi {
    static constexpr bool PERM = false, AFTER_DRAIN = false, KEEP = false;
    E e;
    __device__ __forceinline__ void operator()(const f32x4 (&acc)[2][2][4][2], const pg8::Unit& u, int wr, int wc, int fr, int fq) const {
        const int row0 = u.pm * 256 + wr * 64 + fr, col0 = u.pn * 256 + wc * 32 + 4 * fq;
#pragma unroll
        for (int ai = 0; ai < 2; ++ai)
#pragma unroll
            for (int m = 0; m < 4; ++m)
#pragma unroll
                for (int bj = 0; bj < 2; ++bj)
#pragma unroll
                    for (int n = 0; n < 2; ++n) e.quad(row0 + ai * 128 + m * 16, col0 + bj * 128 + n * 16, acc[ai][bj][m][n]);
    }
};

struct EpiIn {
    unsigned char* PREP; bf16 *SQ, *SK; float* SLOGF; bf16 *V, *OG, *XB, *YG, *SGA, *SGB; const float* lbt; int lb0;
    static constexpr bool BY_REGION = true;
    __device__ __forceinline__ size_t blk_off(int row, int cc) const { return (((size_t)(row >> 11) * 32 + ((row >> 6) & 31)) * 8 + (cc >> 7)) * PREP_BLK; }
    __device__ __forceinline__ bf16* q_ptr(int row, int cc) const { return row < MP ? (bf16*)(PREP + blk_off(row, cc) + 32768) + (row & 63) * 128 + (cc & 127) : SQ + (size_t)(row - MP) * D + cc; }
    __device__ __forceinline__ bf16* k_ptr(int row, int cc) const { return row < MP ? (bf16*)(PREP + blk_off(row, cc) + 49152) + (row & 63) * 128 + (cc & 127) : SK + (size_t)(row - MP) * D + cc; }
    __device__ __forceinline__ float* lf_ptr(int row, int cc) const { return row < MP ? (float*)(PREP + blk_off(row, cc)) + (row & 63) * 128 + (cc & 127) : SLOGF + (size_t)(row - MP) * D + cc; }
    __device__ __forceinline__ f32x2 fgate(float fa, float lb, float llb, float l1m) const {
        float lf, kk;
        const float t = __expf(-fabsf(fa));
        const float ls = fminf(fa, 0.f) - __logf(1.0f + t);
        const float sneg = (fa >= 0.f ? t : 1.0f) * __builtin_amdgcn_rcpf(1.0f + t);
        if (lb0) { lf = ls; kk = sneg; }
        else { const float b = l1m + ls, mx = fmaxf(llb, b); lf = mx + __logf(1.0f + __expf(-fabsf(llb - b))); kk = (1.0f - lb) * sneg; }
        return (f32x2){lf, kk};
    }
    template <int R> __device__ __forceinline__ f32x4 act(f32x4 v) const {
        f32x4 r;
#pragma unroll
        for (int j = 0; j < 4; ++j) {
            if constexpr (R == 0 || R == 3) r[j] = v[j] * sig_fast(v[j]);
            else if constexpr (R == 5) { const float x = v[j], u = 0.7978845608028654f * (x + 0.044715f * x * x * x); r[j] = x * sig_fast(2.0f * u); }
            else if constexpr (R >= 6) r[j] = sig_fast(v[j]);
            else r[j] = v[j];
        }
        return r;
    }
    template <int R> __device__ __forceinline__ bf16* dst(int row, int cc) const { return R == 0 ? q_ptr(row, cc) : (R == 2 ? V : R == 3 ? OG : R == 4 ? XB : R == 5 ? YG : R == 6 ? SGA : SGB) + (size_t)row * D + cc; }
    template <int R> __device__ __forceinline__ void quadR(int row, int cc, f32x4 v) const {
        const size_t o = (size_t)row * D + cc;
        if constexpr (R == 1) {
            const f32x4 lb = *(const f32x4*)(lbt + cc), llb = *(const f32x4*)(lbt + 1024 + cc), l1m = *(const f32x4*)(lbt + 2048 + cc);
            f32x4 lf, r;
#pragma unroll
            for (int j = 0; j < 4; ++j) { const f32x2 g = fgate(v[j], lb[j], llb[j], l1m[j]); lf[j] = g.x; r[j] = g.y; }
            *(f32x4*)lf_ptr(row, cc) = lf; (void)r;
        } else st_bf4(dst<R>(row, cc), act<R>(v));
    }
    template <int R> __device__ __forceinline__ void octR(int row, int cc, f32x4 v0, f32x4 v1) const {
        const size_t o = (size_t)row * D + cc;
        if constexpr (R == 1) {
            f32x4 lf0, lf1, r0, r1;
            if (lb0) {
#pragma unroll
                for (int j = 0; j < 4; ++j) { const f32x2 g0 = fgate(v0[j], 0.f, 0.f, 0.f), g1 = fgate(v1[j], 0.f, 0.f, 0.f); lf0[j] = g0.x; r0[j] = g0.y; lf1[j] = g1.x; r1[j] = g1.y; }
            } else {
                const f32x4 lba = *(const f32x4*)(lbt + cc), lbb = *(const f32x4*)(lbt + cc + 4), lla = *(const f32x4*)(lbt + 1024 + cc), llb_ = *(const f32x4*)(lbt + 1024 + cc + 4), l1a = *(const f32x4*)(lbt + 2048 + cc), l1b = *(const f32x4*)(lbt + 2048 + cc + 4);
#pragma unroll
                for (int j = 0; j < 4; ++j) { const f32x2 g0 = fgate(v0[j], lba[j], lla[j], l1a[j]), g1 = fgate(v1[j], lbb[j], llb_[j], l1b[j]); lf0[j] = g0.x; r0[j] = g0.y; lf1[j] = g1.x; r1[j] = g1.y; }
            }
            float* lp = lf_ptr(row, cc); *(f32x4*)lp = lf0; *(f32x4*)(lp + 4) = lf1; (void)r0; (void)r1;
        } else st_bf8(dst<R>(row, cc), act<R>(v0), act<R>(v1));
    }
    __device__ __forceinline__ void quad(int row, int col, f32x4 v) const {
        const int reg = col >> 10, cc = col & 1023;
        switch (reg) { case 0: quadR<0>(row, cc, v); break; case 1: quadR<1>(row, cc, v); break; case 2: quadR<2>(row, cc, v); break; case 3: quadR<3>(row, cc, v); break;
                       case 4: quadR<4>(row, cc, v); break; case 5: quadR<5>(row, cc, v); break; case 6: quadR<6>(row, cc, v); break; default: quadR<7>(row, cc, v); break; }
    }
};
struct EpiInUnit {
    static constexpr bool PERM = true, AFTER_DRAIN = false, KEEP = false;
    EpiIn e;
    template <int KIND> __device__ __forceinline__ void run(const f32x4 (&acc)[2][2][4][2], int row0, int cc0, bf16* dstp, int mode) const {
#pragma unroll
        for (int ai = 0; ai < 2; ++ai)
#pragma unroll
            for (int m = 0; m < 4; ++m) {
#pragma unroll
                for (int bj = 0; bj < 2; ++bj) {
                    const int row = row0 + ai * 128 + m * 16, cc = cc0 + bj * 128;
                    const f32x4 v0 = acc[ai][bj][m][0], v1 = acc[ai][bj][m][1];
                    if constexpr (KIND == 0) e.octR<1>(row, cc, v0, v1);
                    else if constexpr (KIND == 1) st_bf8(dstp + (size_t)row * D + cc, v0, v1);
                    else { f32x4 r0, r1;
#pragma unroll
                        for (int j = 0; j < 4; ++j) {
                            const float x0 = v0[j], x1 = v1[j];
                            const float a0 = mode == 1 ? 1.5957691216057308f * (x0 + 0.044715f * x0 * x0 * x0) : x0, a1 = mode == 1 ? 1.5957691216057308f * (x1 + 0.044715f * x1 * x1 * x1) : x1;
                            const float s0 = sig_fast(a0), s1 = sig_fast(a1);
                            r0[j] = mode == 2 ? s0 : x0 * s0; r1[j] = mode == 2 ? s1 : x1 * s1; }
                        st_bf8(dstp ? dstp + (size_t)row * D + cc : e.q_ptr(row, cc), r0, r1); }
                }
                asm volatile("" ::: "memory"); __builtin_amdgcn_sched_barrier(0); }
    }
    __device__ __forceinline__ void operator()(const f32x4 (&acc)[2][2][4][2], const pg8::Unit& u, int wr, int wc, int fr, int fq) const {
        const int row0 = u.pm * 256 + wr * 64 + fr, cc0 = (u.pn & 3) * 256 + wc * 32 + 8 * fq, reg = u.pn >> 2;
        if (reg == 1) run<0>(acc, row0, cc0, nullptr, 0);
        else if (reg == 2 || reg == 4) run<1>(acc, row0, cc0, reg == 2 ? e.V : e.XB, 0);
        else { bf16* dp = reg == 0 ? nullptr : reg == 3 ? e.OG : reg == 5 ? e.YG : reg == 6 ? e.SGA : e.SGB;
               run<2>(acc, row0, cc0, dp, reg == 5 ? 1 : (reg >= 6 ? 2 : 0)); }
    }
};
template <class E> struct OctEpi {
    static constexpr bool PERM = true, AFTER_DRAIN = false, KEEP = false;
    E e;
    __device__ __forceinline__ void operator()(const f32x4 (&acc)[2][2][4][2], const pg8::Unit& u, int wr, int wc, int fr, int fq) const {
        const int row0 = u.pm * 256 + wr * 64 + fr, col0 = u.pn * 256 + wc * 32 + 8 * fq;
#pragma unroll
        for (int ai = 0; ai < 2; ++ai)
#pragma unroll
            for (int m = 0; m < 4; ++m) {
#pragma unroll
                for (int bj = 0; bj < 2; ++bj) e.oct(row0 + ai * 128 + m * 16, col0 + bj * 128, acc[ai][bj][m][0], acc[ai][bj][m][1]);
                asm volatile("" ::: "memory"); __builtin_amdgcn_sched_barrier(0); }
    }
};
struct EpiBrA { static constexpr bool BY_REGION = false; const bf16* SGA; float* T;
    __device__ __forceinline__ void quad(int row, int col, f32x4 v) const { const size_t o = (size_t)row * D + col; *(f32x4*)(T + o) = ld_bf4(SGA + o) * v; }
    __device__ __forceinline__ void oct(int row, int col, f32x4 v0, f32x4 v1) const { const size_t o = (size_t)row * D + col; f32x4 g0, g1; ld_bf8(SGA + o, g0, g1); *(f32x4*)(T + o) = g0 * v0; *(f32x4*)(T + o + 4) = g1 * v1; } };
struct EpiBrB { static constexpr bool BY_REGION = false; const bf16* SGB; const float* T; bf16* MG;
    __device__ __forceinline__ void quad(int row, int col, f32x4 v) const { const size_t o = (size_t)row * D + col; st_bf4(MG + o, *(const f32x4*)(T + o) + ld_bf4(SGB + o) * v); }
    __device__ __forceinline__ void oct(int row, int col, f32x4 v0, f32x4 v1) const { const size_t o = (size_t)row * D + col; f32x4 g0, g1; ld_bf8(SGB + o, g0, g1);
        st_bf8(MG + o, *(const f32x4*)(T + o) + g0 * v0, *(const f32x4*)(T + o + 4) + g1 * v1); } };
struct EpiBranchUnit {
    static constexpr bool PERM = true, AFTER_DRAIN = false, KEEP = true;
    const bf16* SGA; const bf16* SGB; bf16* MG;
    __device__ __forceinline__ void operator()(const f32x4 (&acc_c)[2][2][4][2], const pg8::Unit& u, int wr, int wc, int fr, int fq) const {
        f32x4 (&acc)[2][2][4][2] = const_cast<f32x4 (&)[2][2][4][2]>(acc_c);
        const int row0 = u.pm * 256 + wr * 64 + fr, col0 = u.pn * 256 + wc * 32 + 8 * fq;
#pragma unroll
        for (int ai = 0; ai < 2; ++ai)
#pragma unroll
            for (int m = 0; m < 4; ++m) {
#pragma unroll
                for (int bj = 0; bj < 2; ++bj) { const size_t o = (size_t)(row0 + ai * 128 + m * 16) * D + col0 + bj * 128;
                    f32x4 b0, b1; ld_bf8(SGB + o, b0, b1);
                    if (u.z == 0) { f32x4 a0, a1; ld_bf8(SGA + o, a0, a1);
#pragma unroll
                        for (int j = 0; j < 4; ++j) { acc[ai][bj][m][0][j] *= a0[j] * __builtin_amdgcn_rcpf(fmaxf(b0[j], 1e-30f)); acc[ai][bj][m][1][j] *= a1[j] * __builtin_amdgcn_rcpf(fmaxf(b1[j], 1e-30f)); } }
                    else st_bf8(MG + o, acc[ai][bj][m][0] * b0, acc[ai][bj][m][1] * b1); }
                asm volatile("" ::: "memory"); __builtin_amdgcn_sched_barrier(0); }
    }
};
struct EpiRes { static constexpr bool BY_REGION = false; const float* xp; const float* xs; float* X; const float* modl; int gi;
    __device__ __forceinline__ void quad(int row, int col, f32x4 v) const {
        if (row >= MR) return;
        const float* src = row < MP ? xp + (size_t)row * D : xs + (size_t)(row - MP) * D;
        const f32x4 g = *(const f32x4*)(modl + (size_t)mod_row(row) * 6144 + gi * 1024 + col);
        *(f32x4*)(X + (size_t)row * D + col) = *(const f32x4*)(src + col) + g * v;
    }
    __device__ __forceinline__ void oct(int row, int col, f32x4 v0, f32x4 v1) const { quad(row, col, v0); quad(row, col + 4, v1); } };
struct EpiFF1 { static constexpr bool BY_REGION = false; bf16* HM;
    __device__ __forceinline__ void quad(int row, int col, f32x4 v) const {
        f32x4 r;
#pragma unroll
        for (int j = 0; j < 4; ++j) { const float t = fmaxf(v[j], 0.f); r[j] = t * t; }
        st_bf4(HM + (size_t)row * FF + col, r);
    }
    __device__ __forceinline__ void oct(int row, int col, f32x4 v0, f32x4 v1) const {
        f32x4 r0, r1;
#pragma unroll
        for (int j = 0; j < 4; ++j) { const float t0 = fmaxf(v0[j], 0.f), t1 = fmaxf(v1[j], 0.f); r0[j] = t0 * t0; r1[j] = t1 * t1; }
        st_bf8(HM + (size_t)row * FF + col, r0, r1);
    } };

template <class E>
__device__ __forceinline__ void naive_gemm_phase(Ctx& c, const bf16* A, const bf16* Bt, int M, int N, int K, const E& e) {
    LAS float* As = (LAS float*)c.lds;
    LAS float* Bs = As + 32 * 132;
    const int ntm = M / 128, ntn = N / 128, tx = c.tid & 31, ty = c.tid >> 5;
    const int lr = c.tid >> 2, lk = (c.tid & 3) * 8;
    for (int tile = c.wg; tile < ntm * ntn; tile += c.G) {
        const int tm = tile % ntm, tn = tile / ntm;
        f32x4 acc[8];
#pragma unroll
        for (int i = 0; i < 8; ++i) acc[i] = (f32x4){0.f, 0.f, 0.f, 0.f};
        for (int k0 = 0; k0 < K; k0 += 32) {
            const u32x4 av = *(const u32x4*)(A + (size_t)(tm * 128 + lr) * K + k0 + lk);
            const u32x4 bv = *(const u32x4*)(Bt + (size_t)(tn * 128 + lr) * K + k0 + lk);
            __syncthreads();
#pragma unroll
            for (int j = 0; j < 4; ++j) {
                As[(lk + 2 * j) * 132 + lr] = bf2f(av[j] & 0xffffu); As[(lk + 2 * j + 1) * 132 + lr] = bf2f(av[j] >> 16);
                Bs[(lk + 2 * j) * 132 + lr] = bf2f(bv[j] & 0xffffu); Bs[(lk + 2 * j + 1) * 132 + lr] = bf2f(bv[j] >> 16);
            }
            __syncthreads();
#pragma unroll 8
            for (int k = 0; k < 32; ++k) {
                const f32x4 a0 = *(const LAS f32x4*)(As + k * 132 + ty * 8), a1 = *(const LAS f32x4*)(As + k * 132 + ty * 8 + 4);
                const f32x4 b = *(const LAS f32x4*)(Bs + k * 132 + tx * 4);
                acc[0] += a0[0] * b; acc[1] += a0[1] * b; acc[2] += a0[2] * b; acc[3] += a0[3] * b;
                acc[4] += a1[0] * b; acc[5] += a1[1] * b; acc[6] += a1[2] * b; acc[7] += a1[3] * b;
            }
        }
#pragma unroll
        for (int i = 0; i < 8; ++i) e.quad(tm * 128 + ty * 8 + i, tn * 128 + tx * 4, acc[i]);
    }
    __syncthreads();
}

struct PowOrder {
    int lgN, nwg, G, c, two;
    __device__ __forceinline__ void init(int lgN_, int G_, int c_, int two_ = 0) { lgN = lgN_; nwg = 64 << lgN_; G = G_; c = c_; two = two_; }
    __device__ __forceinline__ bool next(int i, pg8::Unit& u) const {
        const int ii = two ? (i >> 1) : i;
        const int L = ii * G + c; if (L >= nwg) return false;
        const int w = (L & 7) * (nwg >> 3) + (L >> 3), j = w & ((8 << lgN) - 1), gid = w >> (3 + lgN);
        u.pm = __builtin_amdgcn_readfirstlane(gid * 8 + (j & 7)); u.pn = __builtin_amdgcn_readfirstlane(j >> 3); u.z = two ? (i & 1) : 0; return true;
    }
    __device__ __forceinline__ void a_ready(const pg8::Unit&) const {}
    __device__ __forceinline__ void done(const pg8::Unit&) const {}
};
template <class E>
__device__ __forceinline__ void sample_gemm_phase(Ctx& c, const bf16* A, const bf16* Bt, int N, int K, const E& e) {
    LAS float* red = (LAS float*)c.lds;
    const int lane = c.tid & 63, w = __builtin_amdgcn_readfirstlane(c.tid >> 6), fr = lane & 15, fq = lane >> 4, chh = w & 1, kq = w >> 1;
    const bf16* As = A + (size_t)MP * K;
    const int kspan = K >> 2;
    for (int mu = c.G - 1 - c.wg; mu < (N >> 5); mu += c.G) {
        const int n0 = 32 * mu;
        f32x4 acc[8];
#pragma unroll
        for (int m = 0; m < 8; ++m) acc[m] = (f32x4){0.f, 0.f, 0.f, 0.f};
        const bf16* bp = Bt + (size_t)(n0 + 16 * chh + fr) * K + kq * kspan + 8 * fq;
        const bf16* ap = As + (size_t)fr * K + kq * kspan + 8 * fq;
#pragma unroll 2
        for (int k = 0; k < kspan; k += 32) {
            const bf16x8 bfr = *(const bf16x8*)(bp + k);
#pragma unroll
            for (int m = 0; m < 8; ++m) acc[m] = __builtin_amdgcn_mfma_f32_16x16x32_bf16(*(const bf16x8*)(ap + (size_t)(16 * m) * K + k), bfr, acc[m], 0, 0, 0);
        }
        __syncthreads();
#pragma unroll
        for (int m = 0; m < 8; ++m)
#pragma unroll
            for (int j = 0; j < 4; ++j) red[(kq * 128 + 16 * m + 4 * fq + j) * 32 + 16 * chh + fr] = acc[m][j];
        __syncthreads();
#pragma unroll
        for (int i = 0; i < 2; ++i) { const int q = c.tid + 512 * i, row = q >> 3, cq = (q & 7) * 4;
            const f32x4 v = *(const LAS f32x4*)(red + row * 32 + cq) + *(const LAS f32x4*)(red + (128 + row) * 32 + cq) + *(const LAS f32x4*)(red + (256 + row) * 32 + cq) + *(const LAS f32x4*)(red + (384 + row) * 32 + cq);
            e.quad(MP + row, n0 + cq, v); }
    }
    __syncthreads();
}

template <int SITE, class E>
__device__ __forceinline__ void gemm_phase_sel(Ctx& c, const bf16* A, const bf16* Bt, int M, int N, int K, const E& e) {
    if constexpr ((FAST_GEMM >> SITE) & 1) {
        pg8::Gemm g{A, Bt, MP, N, K, A, Bt}; PowOrder S; S.init(N == 1024 ? 2 : (N == 4096 ? 4 : 5), c.G, c.wg);
        if constexpr (E::BY_REGION) { EpiInUnit qe{e}; pg8::gemm_phase<EpiInUnit, PowOrder, true, true>(c.lds, g, S, qe, c.tid); }
        else { OctEpi<E> qe{e}; pg8::gemm_phase<OctEpi<E>, PowOrder, true, true>(c.lds, g, S, qe, c.tid); }
        { int t_ = threadIdx.x; asm volatile("" : "+v"(t_)); c.tid = t_; }
        sample_gemm_phase(c, A, Bt, N, K, e);
    } else naive_gemm_phase(c, A, Bt, M, N, K, e);
}

#define XB_TMO      128
#define XB_XCNT(j)  (256  + 64 * (j))
#define XB_XSUB(j)  (1280 + 64 * (j))
#define XB_XGEN(j)  (2304 + 64 * (j))
#define XB_TOP      3328
#define XB_TOPGEN   3392
#define XCD_BAR_WORDS 3456
#define XB_SPIN_CAP (1u << 18)
__device__ __forceinline__ unsigned xb_ld(unsigned* p)              { return __hip_atomic_load(p, __ATOMIC_RELAXED, __HIP_MEMORY_SCOPE_AGENT); }
__device__ __forceinline__ unsigned xb_add(unsigned* p, unsigned v) { return __hip_atomic_fetch_add(p, v, __ATOMIC_RELAXED, __HIP_MEMORY_SCOPE_AGENT); }
__device__ __forceinline__ unsigned xb_xcc_id() { return (unsigned)__builtin_amdgcn_s_getreg((3 << 11) | 20) & 0xFu; }
#define XB_SPIN(cond, bar) do { unsigned _sp = 0; while (cond) { __builtin_amdgcn_s_sleep(1); \
    if ((++_sp & 255u) == 0u) { if (xb_ld(&(bar)[XB_TMO])) break; if (_sp > XB_SPIN_CAP) { atomicAdd(&(bar)[XB_TMO], 1u); break; } } } } while (0)
struct XcdBarrier { unsigned* bar; unsigned x; volatile LAS unsigned* st; };
__device__ __forceinline__ XcdBarrier xcd_barrier_post(unsigned* bar, volatile LAS unsigned* st) {
    XcdBarrier b; b.bar = bar; b.x = xb_xcc_id(); b.st = st;
    if (threadIdx.x == 0) (void)xb_add(&bar[XB_XCNT(b.x)], 1u);
    return b;
}
__device__ __forceinline__ void xcd_barrier_complete(unsigned* bar, unsigned x, unsigned& nloc, unsigned& nx) {
    const unsigned G = gridDim.x * gridDim.y * gridDim.z;
    unsigned sum, cnt, mine, sp = 0u;
    for (;;) {
        sum = 0u; cnt = 0u; mine = 0u;
#pragma unroll
        for (unsigned j = 0; j < 16; ++j) { const unsigned c = xb_ld(&bar[XB_XCNT(j)]); sum += c; cnt += (c > 0u) ? 1u : 0u; mine = (j == x) ? c : mine; }
        if (sum == G) break;
        __builtin_amdgcn_s_sleep(1);
        if ((++sp & 255u) == 0u) { if (xb_ld(&bar[XB_TMO])) break; if (sp > XB_SPIN_CAP) { atomicAdd(&bar[XB_TMO], 1u); break; } }
    }
    nloc = mine > 0u ? mine : 1u; nx = cnt > 0u ? cnt : 1u;
}
__device__ __forceinline__ void xcd_barrier(const XcdBarrier& b) {
    asm volatile("s_waitcnt vmcnt(0)" ::: "memory");
    __syncthreads();
    if (threadIdx.x == 0) {
        unsigned* bar = b.bar; asm volatile("" : "+s"(bar));
        __builtin_amdgcn_s_waitcnt(0);
        unsigned nloc = b.st[0], nx = b.st[1];
        if (nloc == 0u) { xcd_barrier_complete(bar, b.x, nloc, nx); b.st[0] = nloc; b.st[1] = nx; }
        const unsigned old = xb_add(&bar[XB_XSUB(b.x)], 1u);
        const unsigned gen = old / nloc;
        if (old + 1u == (gen + 1u) * nloc) {
            __builtin_amdgcn_fence(__ATOMIC_RELEASE, "agent");
            asm volatile("s_waitcnt vmcnt(0)" ::: "memory");
            const unsigned og = xb_add(&bar[XB_TOP], 1u);
            const unsigned tg = og / nx;
            if (og + 1u == (tg + 1u) * nx) xb_add(&bar[XB_TOPGEN], 1u);
            else XB_SPIN(xb_ld(&bar[XB_TOPGEN]) == tg, bar);
            __builtin_amdgcn_fence(__ATOMIC_ACQUIRE, "agent");
            xb_add(&bar[XB_XGEN(b.x)], 1u);
            asm volatile("s_waitcnt vmcnt(0)" ::: "memory");
        } else {
            XB_SPIN(xb_ld(&bar[XB_XGEN(b.x)]) == gen, bar);
            __builtin_amdgcn_fence(__ATOMIC_ACQUIRE, "agent");
            asm volatile("s_waitcnt vmcnt(0)" ::: "memory");
        }
    }
    __syncthreads();
}

__device__ __forceinline__ void p0_transpose_item(const float* W, int K, int N, bf16* WT, LAS float* scr, int item, int lane) {
    const int nblk = N / 32, kb = item / nblk, nb = item % nblk, k0 = 64 * kb, n0 = 32 * nb;
    float v[32];
#pragma unroll
    for (int i = 0; i < 32; ++i) v[i] = W[(size_t)(k0 + 2 * i + (lane >> 5)) * N + n0 + (lane & 31)];
#pragma unroll
    for (int i = 0; i < 32; ++i) scr[(2 * i + (lane >> 5)) * 33 + (lane & 31)] = v[i];
    asm volatile("s_waitcnt lgkmcnt(0)" ::: "memory");
    const int ch = lane & 7;
#pragma unroll
    for (int j = 0; j < 4; ++j) { const int n = (lane >> 3) + 8 * j; const LAS float* s = scr + (8 * ch) * 33 + n;
        u32x4 o; o.x = pk2(s[0 * 33], s[1 * 33]); o.y = pk2(s[2 * 33], s[3 * 33]); o.z = pk2(s[4 * 33], s[5 * 33]); o.w = pk2(s[6 * 33], s[7 * 33]);
        *(u32x4*)(WT + (size_t)(n0 + n) * K + k0 + 8 * ch) = o; }
    asm volatile("s_waitcnt lgkmcnt(0)" ::: "memory");
}
__device__ __forceinline__ void p0_work(CArgs& a, Ctx& c, int l, int vw, int nvw, bool with_tables, int ntr) {
    for (int lt = l; lt < l + ntr; ++lt) {
        LAS float* scr = (LAS float*)(c.lds + __builtin_amdgcn_readfirstlane(c.tid >> 6) * 16384);
        const int gw = vw * 8 + __builtin_amdgcn_readfirstlane(c.tid >> 6), NGW = nvw * 8;
        constexpr int I_IN = 16 * 256, I_SQ = 16 * 32, I_1 = 16 * 128, I_2 = 64 * 32, I_L = 8 * 8, PER_L = I_IN + 3 * I_SQ + I_1 + I_2 + 2 * I_L;
        bf16* wl = (bf16*)(a.ws + WS_W + (size_t)lt * WL_STRIDE);
        for (int it = gw; it < PER_L; it += NGW) {
            int r = it;
            if (r < I_IN) { p0_transpose_item(a.in[11] + (size_t)lt * D * NIN, D, NIN, wl + OFF_WIN / 2, scr, r, (c.tid & 63)); continue; } r -= I_IN;
            if (r < I_SQ) { p0_transpose_item(a.in[21] + (size_t)lt * D * D, D, D, wl + OFF_WA / 2, scr, r, (c.tid & 63)); continue; } r -= I_SQ;
            if (r < I_SQ) { p0_transpose_item(a.in[22] + (size_t)lt * D * D, D, D, wl + OFF_WB / 2, scr, r, (c.tid & 63)); continue; } r -= I_SQ;
            if (r < I_SQ) { p0_transpose_item(a.in[23] + (size_t)lt * D * D, D, D, wl + OFF_WO / 2, scr, r, (c.tid & 63)); continue; } r -= I_SQ;
            if (r < I_1) { p0_transpose_item(a.in[24] + (size_t)lt * D * FF, D, FF, wl + OFF_W1 / 2, scr, r, (c.tid & 63)); continue; } r -= I_1;
            if (r < I_2) { p0_transpose_item(a.in[25] + (size_t)lt * FF * D, FF, D, wl + OFF_W2 / 2, scr, r, (c.tid & 63)); continue; } r -= I_2;
            if (r < I_L) { const int n = r >> 3; p0_transpose_item(a.in[16] + ((size_t)lt * 8 + n) * 16384, 128, 128, wl + OFF_LWA / 2 + n * 16384, scr, r & 7, (c.tid & 63)); continue; } r -= I_L;
            { const int n = r >> 3; p0_transpose_item(a.in[18] + ((size_t)lt * 8 + n) * 16384, 128, 128, wl + OFF_LWX / 2 + n * 16384, scr, r & 7, (c.tid & 63)); }
        }
    }
    if (with_tables) {
        float* lbt = (float*)(a.ws + WS_TAB); float* sp = (float*)(a.ws + WS_TAB + 32768);
        const int gid = vw * 512 + c.tid;
        if (gid < 2 * D) {
            const int ll = gid >> 10, col = gid & 1023;
            const float h0 = a.in[12][col], h1 = a.in[12][D + col];
            const float p1 = 1.0f / (1.0f + expf(h0 - h1));
            const float lb = ll == 0 ? 0.f : p1;
            lbt[(ll * 3 + 0) * D + col] = lb; lbt[(ll * 3 + 1) * D + col] = logf(fmaxf(lb, 1e-30f)); lbt[(ll * 3 + 2) * D + col] = log1pf(-lb);
            sp[ll * D + col] = softplusf_(-a.in[20][ll * D + col]);
        }
    }
    __syncthreads();
    {
        constexpr int CS_STRIDE = 272;
        LAS unsigned char* csb = c.lds;
        LAS float* ws = (LAS float*)(c.lds + 39168);
        float* MOD = (float*)(a.ws + WS_MOD);
        const int lane = c.tid & 63, w = __builtin_amdgcn_readfirstlane(c.tid >> 6), fr = lane & 15, fq = lane >> 4, ct = w & 1, rt0 = w >> 1;
        for (int item = vw; item < 192; item += nvw) {
            const float* W = a.in[7] + (size_t)l * D * 6144 + item * 32;
            f32x4 acc[3];
#pragma unroll
            for (int i = 0; i < 3; ++i) acc[i] = (f32x4){0.f, 0.f, 0.f, 0.f};
            f32x4 cv[9], wv[2];
#define MOD_LOAD(k0_) do { _Pragma("unroll") for (int i = 0; i < 9; ++i) { const int e4 = c.tid + 512 * i, r = e4 >> 5, kq = (e4 & 31) * 4; const int rr = r < NMOD ? r : 0; \
                const float* src = rr < NBATCH ? a.in[5] + (size_t)rr * D : a.in[6] + (size_t)(rr - NBATCH) * D; cv[i] = *(const f32x4*)(src + (k0_) + kq); } \
              _Pragma("unroll") for (int i = 0; i < 2; ++i) { const int e4 = c.tid + 512 * i, kk = e4 >> 3, c4 = (e4 & 7) * 4; wv[i] = *(const f32x4*)(W + (size_t)((k0_) + kk) * 6144 + c4); } } while (0)
            MOD_LOAD(0);
            for (int k0 = 0; k0 < D; k0 += 128) {
                __syncthreads();
#pragma unroll
                for (int i = 0; i < 9; ++i) { const int e4 = c.tid + 512 * i, r = e4 >> 5, kq = (e4 & 31) * 4;
                    u32x2 pw; pw.x = pk2(siluf_(cv[i][0]), siluf_(cv[i][1])); pw.y = pk2(siluf_(cv[i][2]), siluf_(cv[i][3]));
                    if (r >= NMOD) { pw.x = 0u; pw.y = 0u; }
                    *(LAS u32x2*)(csb + r * CS_STRIDE + kq * 2) = pw; }
#pragma unroll
                for (int i = 0; i < 2; ++i) { const int e4 = c.tid + 512 * i, kk = e4 >> 3, c4 = (e4 & 7) * 4;
                    ws[kk * 33 + c4] = wv[i][0]; ws[kk * 33 + c4 + 1] = wv[i][1]; ws[kk * 33 + c4 + 2] = wv[i][2]; ws[kk * 33 + c4 + 3] = wv[i][3]; }
                if (k0 + 128 < D) MOD_LOAD(k0 + 128);
                WG_BAR();
#pragma unroll
                for (int ks = 0; ks < 4; ++ks) {
                    const LAS float* wp = ws + (32 * ks + 8 * fq) * 33 + 16 * ct + fr;
                    u32x4 bw; bw.x = pk2(wp[0], wp[33]); bw.y = pk2(wp[66], wp[99]); bw.z = pk2(wp[132], wp[165]); bw.w = pk2(wp[198], wp[231]);
                    const bf16x8 bfr = __builtin_bit_cast(bf16x8, bw);
#pragma unroll
                    for (int i = 0; i < 3; ++i) { const int rt = rt0 + 4 * i;
                        if (rt < 9) acc[i] = __builtin_amdgcn_mfma_f32_16x16x32_bf16(*(const LAS bf16x8*)(csb + (16 * rt + fr) * CS_STRIDE + (32 * ks + 8 * fq) * 2), bfr, acc[i], 0, 0, 0); }
                }
            }
#undef MOD_LOAD
            const float bm = a.in[8][(size_t)l * 6144 + item * 32 + 16 * ct + fr];
#pragma unroll
            for (int i = 0; i < 3; ++i) { const int rt = rt0 + 4 * i;
                if (rt < 9) {
#pragma unroll
                    for (int j = 0; j < 4; ++j) { const int row = 16 * rt + 4 * fq + j; if (row < NMOD) MOD[((size_t)l * NMOD + row) * 6144 + item * 32 + 16 * ct + fr] = acc[i][j] + bm; } } }
        }
    }
    __syncthreads();
}

__device__ __forceinline__ void norm_phase(CArgs& a, Ctx& c, int l, int which, const float* xp, const float* xs) {
    const int gw = c.wg * 8 + __builtin_amdgcn_readfirstlane(c.tid >> 6), NGW = c.G * 8;
    bf16* H = (bf16*)(a.ws + WS_H);
    const float* MODL = (const float*)(a.ws + WS_MOD) + (size_t)l * NMOD * 6144;
    const float* g = a.in[which ? 10 : 9] + (size_t)l * D;
    for (int row = gw; row < MR; row += NGW) {
        const float* xr = row < MP ? xp + (size_t)row * D : xs + (size_t)(row - MP) * D;
        const float* md = MODL + (size_t)mod_row(row) * 6144 + (which ? 3 : 0) * 1024;
        f32x4 v[4]; float ss = 0.f;
#pragma unroll
        for (int j = 0; j < 4; ++j) { v[j] = *(const f32x4*)(xr + 4 * (c.tid & 63) + 256 * j); ss += (v[j][0] * v[j][0] + v[j][1] * v[j][1]) + (v[j][2] * v[j][2] + v[j][3] * v[j][3]); }
        const float rstd = 1.0f / sqrtf(wave_sum(ss) * (1.0f / D) + EPS);
#pragma unroll
        for (int j = 0; j < 4; ++j) { const int cc = 4 * (c.tid & 63) + 256 * j;
            const f32x4 gg = *(const f32x4*)(g + cc), sh = *(const f32x4*)(md + cc), sc = *(const f32x4*)(md + 1024 + cc);
            st_bf4(H + (size_t)row * D + cc, v[j] * rstd * gg * (1.0f + sc) + sh); }
    }
}
__device__ __forceinline__ void final_norm_phase(CArgs& a, Ctx& c) {
    const int gw = c.wg * 8 + __builtin_amdgcn_readfirstlane(c.tid >> 6), NGW = c.G * 8;
    const float* g = a.in[26];
    for (int row = gw; row < MR; row += NGW) {
        const float* xr = (XOUT_SCRATCH ? (const float*)(a.ws + WS_T) : (const float*)a.out) + (size_t)row * D; float* yr = a.out + (size_t)row * D;
        f32x4 v[4]; float ss = 0.f;
#pragma unroll
        for (int j = 0; j < 4; ++j) { v[j] = *(const f32x4*)(xr + 4 * (c.tid & 63) + 256 * j); ss += (v[j][0] * v[j][0] + v[j][1] * v[j][1]) + (v[j][2] * v[j][2] + v[j][3] * v[j][3]); }
        const float rstd = 1.0f / sqrtf(wave_sum(ss) * (1.0f / D) + EPS);
#pragma unroll
        for (int j = 0; j < 4; ++j) { const int cc = 4 * (c.tid & 63) + 256 * j; f32x4 y = v[j] * rstd * *(const f32x4*)(g + cc);
            if (PROBE_T && row == 0 && cc == 0) y[0] += *(const float*)(a.ws + WS_DBG);
            *(f32x4*)(yr + cc) = y; }
    }
}

__device__ __forceinline__ void hgrn_naive(CArgs& a, Ctx& c, int l, int row0, int ntok, int h, const float* S0, float* Sout) {
    LAS float* fs = (LAS float*)c.lds;
    LAS float* ks = fs + 2048;
    LAS float* qs = ks + 2048;
    LAS float* vs = qs + 2048;
    LAS float* part = vs + 2048;
    const bf16* Q = (const bf16*)(a.ws + WS_SQ) - (size_t)MP * D; const float* LOGF = (const float*)(a.ws + WS_SLOGF) - (size_t)MP * D;
    const bf16* V = (const bf16*)(a.ws + WS_V); const bf16* OG = (const bf16*)(a.ws + WS_OG); bf16* OA = (bf16*)(a.ws + WS_OA);
    const float* hg = a.in[13] + (size_t)l * DKV;
    const int v = c.tid & 127, kg = c.tid >> 7;
    float S[32];
#pragma unroll
    for (int i = 0; i < 32; ++i) S[i] = S0 ? S0[(size_t)(32 * kg + i) * DKV + v] : 0.f;
    for (int t0 = 0; t0 < ntok; t0 += 16) {
        const int nt = (ntok - t0) < 16 ? (ntok - t0) : 16;
        __syncthreads();
        { const int tt = c.tid >> 5, k4 = (c.tid & 31) * 4;
          if (tt < nt) { const size_t off = (size_t)(row0 + t0 + tt) * D + h * DKV + k4;
              const f32x4 lf = *(const f32x4*)(LOGF + off);
              *(LAS f32x4*)(fs + tt * 128 + k4) = (f32x4){expf(lf[0]), expf(lf[1]), expf(lf[2]), expf(lf[3])};
              *(LAS f32x4*)(ks + tt * 128 + k4) = (f32x4){1.0f - expf(lf[0]), 1.0f - expf(lf[1]), 1.0f - expf(lf[2]), 1.0f - expf(lf[3])};
              *(LAS f32x4*)(qs + tt * 128 + k4) = ld_bf4(Q + off);
              *(LAS f32x4*)(vs + tt * 128 + k4) = ld_bf4(V + off); } }
        __syncthreads();
        for (int tt = 0; tt < nt; ++tt) {
            const float vv = vs[tt * 128 + v]; float acc = 0.f;
#pragma unroll
            for (int i4 = 0; i4 < 8; ++i4) {
                const f32x4 f = *(const LAS f32x4*)(fs + tt * 128 + 32 * kg + 4 * i4), kk = *(const LAS f32x4*)(ks + tt * 128 + 32 * kg + 4 * i4), qq = *(const LAS f32x4*)(qs + tt * 128 + 32 * kg + 4 * i4);
#pragma unroll
                for (int j = 0; j < 4; ++j) { S[4 * i4 + j] = f[j] * S[4 * i4 + j] + kk[j] * vv; acc += S[4 * i4 + j] * qq[j]; }
            }
            part[(tt * 4 + kg) * 128 + v] = acc;
        }
        __syncthreads();
        { const int tt = c.tid >> 5, v4 = (c.tid & 31) * 4; const int tc = tt < nt ? tt : 0;
          const f32x4 o = *(const LAS f32x4*)(part + (tc * 4 + 0) * 128 + v4) + *(const LAS f32x4*)(part + (tc * 4 + 1) * 128 + v4)
                        + *(const LAS f32x4*)(part + (tc * 4 + 2) * 128 + v4) + *(const LAS f32x4*)(part + (tc * 4 + 3) * 128 + v4);
          float ss = (o[0] * o[0] + o[1] * o[1]) + (o[2] * o[2] + o[3] * o[3]);
          ss = half_sum(ss);
          const float rstd = 1.0f / sqrtf(ss * (1.0f / DKV) + EPS);
          if (tt < nt) { const size_t off = (size_t)(row0 + t0 + tt) * D + h * DKV + v4;
              st_bf4(OA + off, o * rstd * *(const f32x4*)(hg + v4) * ld_bf4(OG + off)); } }
    }
#pragma unroll
    for (int i = 0; i < 32; ++i) Sout[(size_t)(32 * kg + i) * DKV + v] = S[i];
    __syncthreads();
}


constexpr int HB_Q0 = 0, HB_K0 = 17408, HB_Q1 = 26112, HB_K1 = 34816, HB_KT0 = 43520, HB_KT1 = 53760, HB_VT = 64000, HB_AS = 82432, HB_ST = 91648, HB_VEC = 126464, HB_TOT = 128512, HB_SSQ = 130560;
constexpr int HS_Q = 272, HS_KT = 80, HS_VT = 144, HS_AS = 144;
static_assert(HB_SSQ + 2048 <= MISC_OFF && 64 * 132 * 4 <= HB_VEC - HB_ST, "hgrn lds");
__device__ __forceinline__ float exp_c(float x) { return __expf(fminf(x, 80.f)); }
__device__ __forceinline__ void hgrn_prep_phase(CArgs& a, Ctx& c) {
    LAS unsigned char* lds = c.lds;
    const int tid = c.tid, cp = tid & 63, sg = tid >> 6;
    LAS float* VEC = (LAS float*)(lds + HB_VEC); LAS float* TOT = (LAS float*)(lds + HB_TOT);
    f32x2 lf[8]; unsigned qr[8], vr[8];
#define PREP_LOAD(it_) do { const unsigned char* bp_ = a.ws + WS_PREP + (size_t)(it_) * PREP_BLK; const int e0_ = (8 * sg) * 128 + 2 * cp; \
        const bf16* vs_ = (const bf16*)(a.ws + WS_V) + ((size_t)((it_) >> 8) * SEQ + 64 * (((it_) >> 3) & 31)) * D + ((it_) & 7) * DKV; \
        _Pragma("unroll") for (int i = 0; i < 8; ++i) { lf[i] = *(const f32x2*)((const float*)bp_ + e0_ + i * 128); qr[i] = *(const unsigned*)((const bf16*)(bp_ + 32768) + e0_ + i * 128); \
            vr[i] = *(const unsigned*)(vs_ + (size_t)(8 * sg + i) * D + 2 * cp); } } while (0)
    if (c.wg < 2048) PREP_LOAD(c.wg);
    for (int it = c.wg; it < 2048; it += c.G) {
        unsigned char* bp = a.ws + WS_PREP + (size_t)it * PREP_BLK;
        const int pb = it >> 8, pn = (it >> 3) & 31, phh = it & 7;
        bf16* vslice = (bf16*)(a.ws + WS_V) + ((size_t)pb * SEQ + 64 * pn) * D + phh * DKV;
        f32x2 g[8], lfk[8]; g[0] = lf[0]; lfk[0] = lf[0];
#pragma unroll
        for (int i = 1; i < 8; ++i) { g[i] = g[i - 1] + lf[i]; lfk[i] = lf[i]; }
        WG_BAR();
        *(LAS f32x2*)(TOT + sg * 128 + 2 * cp) = g[7];
        WG_BAR();
        {
            f32x2 off = (f32x2){0.f, 0.f}, r0 = off, r1 = off, last = off;
#pragma unroll
            for (int s2 = 0; s2 < 8; ++s2) { const f32x2 tv = *(const LAS f32x2*)(TOT + s2 * 128 + 2 * cp);
                if (s2 < sg) off += tv; if (s2 < 2) r0 += tv; if (s2 < 6) r1 += tv; last += tv; }
            unsigned kt0[4], kt1[4], vt0[4], vt1[4];
#pragma unroll
            for (int i = 0; i < 8; ++i) {
                const f32x2 G = g[i] + off; const float q0 = bf2f(qr[i] & 0xffffu), q1 = bf2f(qr[i] >> 16), k0 = 1.0f - __expf(lfk[i].x), k1 = 1.0f - __expf(lfk[i].y);
                const int t = 8 * sg + i;
                *(LAS unsigned*)(lds + HB_Q0 + t * HS_Q + cp * 4) = pk2(q0 * exp_c(G.x - r0.x), q1 * exp_c(G.y - r0.y));
                if (sg < 4) *(LAS unsigned*)(lds + HB_K0 + t * HS_Q + cp * 4) = pk2(k0 * exp_c(r0.x - G.x), k1 * exp_c(r0.y - G.y));
                else { *(LAS unsigned*)(lds + HB_K1 + (t - 32) * HS_Q + cp * 4) = pk2(k0 * exp_c(r1.x - G.x), k1 * exp_c(r1.y - G.y));
                       *(LAS unsigned*)(lds + HB_Q1 + (t - 32) * HS_Q + cp * 4) = pk2(q0 * exp_c(G.x - r1.x), q1 * exp_c(G.y - r1.y)); }
                const unsigned kd = pk2(k0 * __expf(last.x - G.x), k1 * __expf(last.y - G.y));
                if (i & 1) { kt0[i >> 1] |= kd << 16; kt1[i >> 1] |= kd & 0xffff0000u; vt0[i >> 1] |= vr[i] << 16; vt1[i >> 1] |= vr[i] & 0xffff0000u; }
                else { kt0[i >> 1] = kd & 0xffffu; kt1[i >> 1] = kd >> 16; vt0[i >> 1] = vr[i] & 0xffffu; vt1[i >> 1] = vr[i] >> 16; }
            }
            { LAS unsigned char* p = lds + (sg < 4 ? HB_KT0 : HB_KT1) + (2 * cp) * HS_KT + (sg & 3) * 16;
              *(LAS u32x4*)p = (u32x4){kt0[0], kt0[1], kt0[2], kt0[3]}; *(LAS u32x4*)(p + HS_KT) = (u32x4){kt1[0], kt1[1], kt1[2], kt1[3]}; }
            { LAS unsigned char* p = lds + HB_VT + (2 * cp) * HS_VT + sg * 16;
              *(LAS u32x4*)p = (u32x4){vt0[0], vt0[1], vt0[2], vt0[3]}; *(LAS u32x4*)(p + HS_VT) = (u32x4){vt1[0], vt1[1], vt1[2], vt1[3]}; }
            if (sg == 0) *(LAS f32x2*)(VEC + 2 * cp) = (f32x2){exp_c(r0.x), exp_c(r0.y)};
            if (sg == 1) *(LAS f32x2*)(VEC + 128 + 2 * cp) = (f32x2){exp_c(last.x), exp_c(last.y)};
        }
        if (it + c.G < 2048) PREP_LOAD(it + c.G);
        WG_BAR();
#pragma unroll
        for (int i = 0; i < 2; ++i) { const int p = tid + 512 * i, row = p >> 4, pc = p & 15; *(u32x4*)(bp + row * 256 + pc * 16) = *(const LAS u32x4*)(lds + HB_Q0 + row * HS_Q + pc * 16); }
        { const int row = tid >> 4, pc = tid & 15;
          *(u32x4*)(bp + 16384 + row * 256 + pc * 16) = *(const LAS u32x4*)(lds + HB_K0 + row * HS_Q + pc * 16);
          *(u32x4*)(bp + 24576 + row * 256 + pc * 16) = *(const LAS u32x4*)(lds + HB_Q1 + row * HS_Q + pc * 16);
          *(u32x4*)(bp + 32768 + row * 256 + pc * 16) = *(const LAS u32x4*)(lds + HB_K1 + row * HS_Q + pc * 16); }
        { const int k = tid >> 2, pc = tid & 3;
          *(u32x4*)(bp + 40960 + k * 64 + pc * 16) = *(const LAS u32x4*)(lds + HB_KT0 + k * HS_KT + pc * 16);
          *(u32x4*)(bp + 49152 + k * 64 + pc * 16) = *(const LAS u32x4*)(lds + HB_KT1 + k * HS_KT + pc * 16); }
        if (tid < 64) *(u32x4*)(bp + 57344 + tid * 16) = *(const LAS u32x4*)(lds + HB_VEC + tid * 16);
#pragma unroll
        for (int i = 0; i < 2; ++i) { const int p = tid + 512 * i, v = p >> 3, pc = p & 7;
            *(u32x4*)((unsigned char*)(vslice + (size_t)(v >> 1) * D) + (v & 1) * 128 + pc * 16) = *(const LAS u32x4*)(lds + HB_VT + v * HS_VT + pc * 16); }
    }
#undef PREP_LOAD
    __syncthreads();
}

__device__ __forceinline__ void hgrn_fast_prompt(CArgs& a, Ctx& c, int l, int b, int h) {
    LAS unsigned char* lds = c.lds;
    const int tid = c.tid, lane = tid & 63, w = __builtin_amdgcn_readfirstlane(tid >> 6), fr = lane & 15, fq = lane >> 4;
    const int col = tid & 127, sg = tid >> 7;
    const bf16* V = (const bf16*)(a.ws + WS_V); const bf16* OG = (const bf16*)(a.ws + WS_OG); bf16* OA = (bf16*)(a.ws + WS_OA);
    const unsigned char* blk0 = a.ws + WS_PREP + ((size_t)b * 32 * 8 + h) * PREP_BLK;
    const size_t base = (size_t)b * SEQ * D + (size_t)h * DKV;
    LAS float* VEC = (LAS float*)(lds + HB_VEC); LAS float* SSQ = (LAS float*)(lds + HB_SSQ);
    LAS unsigned char* STw = lds + HB_ST + w * 4352;
    const float gv = a.in[13][(size_t)l * DKV + 16 * w + fr];
    f32x4 S[8];
#pragma unroll
    for (int i = 0; i < 8; ++i) S[i] = (f32x4){0.f, 0.f, 0.f, 0.f};
    __syncthreads();
    for (int e = tid; e < 2 * 16 * 16; e += 512) { const int which = e >> 8, r = (e >> 4) & 15, cc = e & 15;
        *(LAS bf16*)(lds + HB_AS + ((which ? 32 : 0) + r) * HS_AS + ((which ? 48 : 16) + cc) * 2) = 0; }
    const int prow = tid >> 4, ppc = tid & 15, pk = tid >> 2, pkc = tid & 3;
    const bf16* vt0 = (const bf16*)(a.ws + WS_V) + (size_t)b * SEQ * D + h * DKV;
    const int orow = tid >> 4, oc8 = (tid & 15) * 8;
    u32x4 im[10], ogv[2];
#define HG_LOAD(n_) do { const unsigned char* bp_ = blk0 + (size_t)(n_) * 8 * PREP_BLK; \
        im[0] = *(const u32x4*)(bp_ + prow * 256 + ppc * 16); im[1] = *(const u32x4*)(bp_ + (32 + prow) * 256 + ppc * 16); \
        im[2] = *(const u32x4*)(bp_ + 16384 + prow * 256 + ppc * 16); im[3] = *(const u32x4*)(bp_ + 24576 + prow * 256 + ppc * 16); im[4] = *(const u32x4*)(bp_ + 32768 + prow * 256 + ppc * 16); \
        im[5] = *(const u32x4*)(bp_ + 40960 + pk * 64 + pkc * 16); im[6] = *(const u32x4*)(bp_ + 49152 + pk * 64 + pkc * 16); \
        if (tid < 64) im[7] = *(const u32x4*)(bp_ + 57344 + tid * 16); \
        _Pragma("unroll") for (int i = 0; i < 2; ++i) { const int p_ = tid + 512 * i, v_ = p_ >> 3, pc_ = p_ & 7; \
            im[8 + i] = *(const u32x4*)((const unsigned char*)(vt0 + (size_t)(64 * (n_) + (v_ >> 1)) * D) + (v_ & 1) * 128 + pc_ * 16); } } while (0)
    HG_LOAD(0);
    unsigned long long tacc = 0ull, tst = 0ull;
#define TSTART(id) do { if (PROBE_T == (id)) { __builtin_amdgcn_sched_barrier(0); tst = __builtin_amdgcn_s_memtime(); __builtin_amdgcn_sched_barrier(0); } } while (0)
#define TSTOP(id) do { if (PROBE_T == (id)) { __builtin_amdgcn_sched_barrier(0); tacc += __builtin_amdgcn_s_memtime() - tst; __builtin_amdgcn_sched_barrier(0); } } while (0)
    for (int nn = 0; nn < (SEQ / 64) * (1 + (PROBE_MIX & 1)); ++nn) {
        const int n = nn & (SEQ / 64 - 1);
        if (PROBE_MIX & 1) { if (nn == SEQ / 64) {
#pragma unroll
            for (int i = 0; i < 8; ++i) S[i] = (f32x4){0.f, 0.f, 0.f, 0.f}; } }
        TSTART(1); TSTART(2);
        *(LAS u32x4*)(lds + HB_Q0 + prow * HS_Q + ppc * 16) = im[0]; *(LAS u32x4*)(lds + HB_Q0 + (32 + prow) * HS_Q + ppc * 16) = im[1];
        *(LAS u32x4*)(lds + HB_K0 + prow * HS_Q + ppc * 16) = im[2]; *(LAS u32x4*)(lds + HB_Q1 + prow * HS_Q + ppc * 16) = im[3]; *(LAS u32x4*)(lds + HB_K1 + prow * HS_Q + ppc * 16) = im[4];
        *(LAS u32x4*)(lds + HB_KT0 + pk * HS_KT + pkc * 16) = im[5]; *(LAS u32x4*)(lds + HB_KT1 + pk * HS_KT + pkc * 16) = im[6];
        if (tid < 64) *(LAS u32x4*)(lds + HB_VEC + tid * 16) = im[7];
#pragma unroll
        for (int i = 0; i < 2; ++i) { const int p = tid + 512 * i, v = p >> 3, pc = p & 7; *(LAS u32x4*)(lds + HB_VT + v * HS_VT + pc * 16) = im[8 + i]; }
        ogv[0] = *(const u32x4*)(OG + base + (size_t)(64 * n + orow) * D + oc8); ogv[1] = *(const u32x4*)(OG + base + (size_t)(64 * n + 32 + orow) * D + oc8);
        if ((PROBE_MIX & 1) || n + 1 < SEQ / 64) HG_LOAD((n + 1) & (SEQ / 64 - 1));
        WG_BAR();
        TSTOP(2); TSTART(3);
#pragma unroll
        for (int kt8 = 0; kt8 < 8; ++kt8) { const f32x4 er = *(const LAS f32x4*)(VEC + 16 * kt8 + 4 * fq);
            u32x2 pw; pw.x = pk2(S[kt8][0] * er[0], S[kt8][1] * er[1]); pw.y = pk2(S[kt8][2] * er[2], S[kt8][3] * er[3]);
            *(LAS u32x2*)(STw + fr * HS_Q + (16 * kt8 + 4 * fq) * 2) = pw; }
#pragma unroll
        for (int rep = 0; rep < 2; ++rep) {
            const int id = w + 8 * rep;
            if (id < 10) {
                int tt, st;
                if (id == 0) { tt = 0; st = 0; } else if (id < 7) { tt = (id + 1) >> 1; st = (id + 1) & 1; } else if (id == 7) { tt = 2; st = 2; } else { tt = 3; st = id - 6; }
                const LAS unsigned char* ap = (st < 2) ? lds + HB_Q0 + (16 * tt + fr) * HS_Q : lds + HB_Q1 + (16 * (tt - 2) + fr) * HS_Q;
                const LAS unsigned char* bp = (st < 2) ? lds + HB_K0 + (16 * st + fr) * HS_Q : lds + HB_K1 + (16 * (st - 2) + fr) * HS_Q;
                f32x4 acc = (f32x4){0.f, 0.f, 0.f, 0.f};
#pragma unroll
                for (int ks = 0; ks < 4; ++ks) acc = __builtin_amdgcn_mfma_f32_16x16x32_bf16(*(const LAS bf16x8*)(ap + (32 * ks + 8 * fq) * 2), *(const LAS bf16x8*)(bp + (32 * ks + 8 * fq) * 2), acc, 0, 0, 0);
#pragma unroll
                for (int j = 0; j < 4; ++j) { const float v_ = (tt == st && fr > 4 * fq + j) ? 0.f : acc[j];
                    *(LAS bf16*)(lds + HB_AS + (16 * tt + 4 * fq + j) * HS_AS + (16 * st + fr) * 2) = (bf16)f2bf(v_); }
            }
        }
        f32x4 o[4];
#pragma unroll
        for (int tt = 0; tt < 4; ++tt) o[tt] = (f32x4){0.f, 0.f, 0.f, 0.f};
#pragma unroll
        for (int ks = 0; ks < 4; ++ks) { const bf16x8 bfr = *(const LAS bf16x8*)(STw + fr * HS_Q + (32 * ks + 8 * fq) * 2);
#pragma unroll
            for (int tt = 0; tt < 4; ++tt) o[tt] = __builtin_amdgcn_mfma_f32_16x16x32_bf16(*(const LAS bf16x8*)(lds + HB_Q0 + (16 * tt + fr) * HS_Q + (32 * ks + 8 * fq) * 2), bfr, o[tt], 0, 0, 0); }
        WG_BAR();
        TSTOP(3); TSTART(4);
#pragma unroll
        for (int tt = 0; tt < 4; ++tt)
#pragma unroll
            for (int ks = 0; ks < 2; ++ks) if (ks == 0 || tt >= 2)
                o[tt] = __builtin_amdgcn_mfma_f32_16x16x32_bf16(*(const LAS bf16x8*)(lds + HB_AS + (16 * tt + fr) * HS_AS + (32 * ks + 8 * fq) * 2), *(const LAS bf16x8*)(lds + HB_VT + (16 * w + fr) * HS_VT + (32 * ks + 8 * fq) * 2), o[tt], 0, 0, 0);
#pragma unroll
        for (int tt = 0; tt < 4; ++tt)
#pragma unroll
            for (int j = 0; j < 4; ++j) { float p = o[tt][j] * o[tt][j];
                p = row16_sum(p);
                if (fr == 0) SSQ[w * 64 + 16 * tt + 4 * fq + j] = p; }
#pragma unroll
        for (int kt8 = 0; kt8 < 8; ++kt8) {
            const f32x4 eL = *(const LAS f32x4*)(VEC + 128 + 16 * kt8 + 4 * fq);
            f32x4 sn = eL * S[kt8];
            sn = __builtin_amdgcn_mfma_f32_16x16x32_bf16(*(const LAS bf16x8*)(lds + HB_KT0 + (16 * kt8 + fr) * HS_KT + 8 * fq * 2), *(const LAS bf16x8*)(lds + HB_VT + (16 * w + fr) * HS_VT + 8 * fq * 2), sn, 0, 0, 0);
            S[kt8] = __builtin_amdgcn_mfma_f32_16x16x32_bf16(*(const LAS bf16x8*)(lds + HB_KT1 + (16 * kt8 + fr) * HS_KT + 8 * fq * 2), *(const LAS bf16x8*)(lds + HB_VT + (16 * w + fr) * HS_VT + (32 + 8 * fq) * 2), sn, 0, 0, 0);
        }
        WG_BAR();
        TSTOP(4); TSTART(5);
        { LAS float* OUT = (LAS float*)(lds + HB_ST);
#pragma unroll
          for (int tt = 0; tt < 4; ++tt)
#pragma unroll
              for (int j = 0; j < 4; ++j) OUT[(16 * tt + 4 * fq + j) * 132 + 16 * w + fr] = o[tt][j] * gv;
          WG_BAR();
#pragma unroll
          for (int i = 0; i < 2; ++i) { const int t = orow + 32 * i;
              float ss = SSQ[t];
#pragma unroll
              for (int ww = 1; ww < 8; ++ww) ss += SSQ[ww * 64 + t];
              const float rstd = __builtin_amdgcn_rsqf(ss * (1.0f / DKV) + EPS);
              const f32x4 x0 = *(const LAS f32x4*)(OUT + t * 132 + oc8) * rstd, x1 = *(const LAS f32x4*)(OUT + t * 132 + oc8 + 4) * rstd;
              const u32x4 g_ = ogv[i];
              const f32x4 g0 = (f32x4){bf2f(g_.x & 0xffffu), bf2f(g_.x >> 16), bf2f(g_.y & 0xffffu), bf2f(g_.y >> 16)}, g1 = (f32x4){bf2f(g_.z & 0xffffu), bf2f(g_.z >> 16), bf2f(g_.w & 0xffffu), bf2f(g_.w >> 16)};
              st_bf8(OA + base + (size_t)(64 * n + t) * D + oc8, x0 * g0, x1 * g1); } }
        TSTOP(5); TSTOP(1);
    }
    if (PROBE_T && PROBE_T < 100 && l == 0 && c.wg == 0 && tid == 0) *(float*)(a.ws + WS_DBG) = (float)(tacc >> 5) * 1e-4f;
#undef HG_LOAD
    { float* Sout = a.out + O_HGP + (((size_t)l * NBATCH + b) * NH + h) * DKV * DKV;
#pragma unroll
      for (int kt8 = 0; kt8 < 8; ++kt8)
#pragma unroll
          for (int j = 0; j < 4; ++j) Sout[(size_t)(16 * kt8 + 4 * fq + j) * DKV + 16 * w + fr] = S[kt8][j]; }
    __syncthreads();
}

constexpr int L_XBS = 0, L_XC = 67 * 128, L_AS = L_XC + 8192, L_BS = L_AS + 8192, L_SEG = L_BS + 8192, L_CARRY = L_SEG + 1024;
constexpr int LB_XCB = (L_CARRY + 256) * 4, XCB_STRIDE = 272;
static_assert(LB_XCB + 64 * XCB_STRIDE <= MISC_OFF && LB_XCB % 16 == 0, "lru lds");
__device__ __forceinline__ void lru_gates_naive(CArgs& a, Ctx& c, int l, int n) {
    LAS float* XC = (LAS float*)c.lds + L_XC; LAS float* As = (LAS float*)c.lds + L_AS; LAS float* Bs = (LAS float*)c.lds + L_BS;
    const bf16* wl = (const bf16*)(a.ws + WS_W + (size_t)l * WL_STRIDE);
    const int e = c.tid & 127, tg = c.tid >> 7;
    const bf16* wa = wl + OFF_LWA / 2 + (size_t)(n * 128 + e) * 128; const bf16* wx = wl + OFF_LWX / 2 + (size_t)(n * 128 + e) * 128;
    const int ch = n * 128 + e;
    const float ba = a.in[17][(size_t)l * D + ch], bx = a.in[19][(size_t)l * D + ch], sp = ((const float*)(a.ws + WS_TAB + 32768))[l * D + ch];
#pragma unroll 1
    for (int tq = 0; tq < 4; ++tq) {
        float ra[4], ia[4];
#pragma unroll
        for (int i = 0; i < 4; ++i) { ra[i] = 0.f; ia[i] = 0.f; }
        const LAS float* xc = XC + (tg * 16 + tq * 4) * 128;
#pragma unroll 1
        for (int d0 = 0; d0 < 128; d0 += 8) {
            const f32x4 wa0 = ld_bf4(wa + d0), wa1 = ld_bf4(wa + d0 + 4), wx0 = ld_bf4(wx + d0), wx1 = ld_bf4(wx + d0 + 4);
#pragma unroll
            for (int tt = 0; tt < 4; ++tt) {
                const f32x4 x0 = *(const LAS f32x4*)(xc + tt * 128 + d0), x1 = *(const LAS f32x4*)(xc + tt * 128 + d0 + 4);
                ra[tt] += (x0[0] * wa0[0] + x0[1] * wa0[1]) + (x0[2] * wa0[2] + x0[3] * wa0[3]) + (x1[0] * wa1[0] + x1[1] * wa1[1]) + (x1[2] * wa1[2] + x1[3] * wa1[3]);
                ia[tt] += (x0[0] * wx0[0] + x0[1] * wx0[1]) + (x0[2] * wx0[2] + x0[3] * wx0[3]) + (x1[0] * wx1[0] + x1[1] * wx1[1]) + (x1[2] * wx1[2] + x1[3] * wx1[3]);
            }
        }
#pragma unroll
        for (int tt = 0; tt < 4; ++tt) {
            const int t = tg * 16 + tq * 4 + tt;
            const float r = sigmoidf_(ra[tt] + ba), ig = sigmoidf_(ia[tt] + bx);
            const float la = -8.0f * r * sp, aa = expf(la), mult = sqrtf(-expm1f(2.0f * la));
            As[t * 128 + e] = aa; Bs[t * 128 + e] = mult * ig * XC[t * 128 + e];
        }
    }
}
__device__ __forceinline__ void lru_gates_mfma(CArgs& a, Ctx& c, int l, int n) {
    LAS float* XC = (LAS float*)c.lds + L_XC; LAS float* As = (LAS float*)c.lds + L_AS; LAS float* Bs = (LAS float*)c.lds + L_BS;
    const bf16* wl = (const bf16*)(a.ws + WS_W + (size_t)l * WL_STRIDE);
    const int lane = c.tid & 63, w = __builtin_amdgcn_readfirstlane(c.tid >> 6), fr = lane & 15, fq = lane >> 4;
    const int e = 16 * w + fr, ch = n * 128 + e;
    const bf16* wa = wl + OFF_LWA / 2 + (size_t)(n * 128 + e) * 128 + 8 * fq; const bf16* wx = wl + OFF_LWX / 2 + (size_t)(n * 128 + e) * 128 + 8 * fq;
    bf16x8 Ba[4], Bx[4];
#pragma unroll
    for (int ks = 0; ks < 4; ++ks) { Ba[ks] = *(const bf16x8*)(wa + 32 * ks); Bx[ks] = *(const bf16x8*)(wx + 32 * ks); }
    const float ba = a.in[17][(size_t)l * D + ch], bx = a.in[19][(size_t)l * D + ch], sp = ((const float*)(a.ws + WS_TAB + 32768))[l * D + ch];
#pragma unroll
    for (int m = 0; m < 4; ++m) {
        f32x4 ar = (f32x4){0.f, 0.f, 0.f, 0.f}, ai = (f32x4){0.f, 0.f, 0.f, 0.f};
#pragma unroll
        for (int ks = 0; ks < 4; ++ks) {
            const bf16x8 af = *(const LAS bf16x8*)(c.lds + LB_XCB + (16 * m + fr) * XCB_STRIDE + (32 * ks + 8 * fq) * 2);
            ar = __builtin_amdgcn_mfma_f32_16x16x32_bf16(af, Ba[ks], ar, 0, 0, 0);
            ai = __builtin_amdgcn_mfma_f32_16x16x32_bf16(af, Bx[ks], ai, 0, 0, 0);
        }
#pragma unroll
        for (int j = 0; j < 4; ++j) {
            const int t = 16 * m + 4 * fq + j;
            const float r = sigmoidf_(ar[j] + ba), ig = sigmoidf_(ai[j] + bx);
            const float la = -8.0f * r * sp, aa = expf(la), mult = sqrtf(-expm1f(2.0f * la));
            As[t * 128 + e] = aa; Bs[t * 128 + e] = mult * ig * XC[t * 128 + e];
        }
    }
}
#if FAST_GATES
#define lru_gates lru_gates_mfma
#else
#define lru_gates lru_gates_naive
#endif

constexpr int LB_CW = LB_XCB + 64 * XCB_STRIDE;
static_assert(LB_CW + 2560 <= MISC_OFF, "lru lds");
__device__ __forceinline__ void lru_prompt_item(CArgs& a, Ctx& c, int l, int b, int n, int hc) {
    LAS float* L = (LAS float*)c.lds;
    LAS float* As = L + L_AS; LAS float* Bs = L + L_BS; LAS float* SEG = L + L_SEG; LAS float* CAR = L + L_CARRY;
    const bf16* XB = (const bf16*)(a.ws + WS_XB); const bf16* YG = (const bf16*)(a.ws + WS_YG); bf16* OB = (bf16*)(a.ws + WS_OB);
    const int t_ld = c.tid >> 3, c0 = (c.tid & 7) * 16;
    const int cch = c.tid & 63, sg = c.tid >> 6;
    const int lane = c.tid & 63, w = __builtin_amdgcn_readfirstlane(c.tid >> 6), fr = lane & 15, fq = lane >> 4;
    const int ec = 16 * (w & 3) + fr, e = 64 * hc + ec, ch = n * 128 + e, m0 = 2 * (w >> 2);
    const int chs = n * 128 + 64 * hc + cch;
    __syncthreads();
    if (c.tid < 128) CAR[c.tid] = 0.f;
    if (c.tid < 384) L[L_XBS + c.tid] = 0.f;
    f32x4 cwr[4][4], cbr[4];
#pragma unroll
    for (int j4 = 0; j4 < 4; ++j4) { cbr[j4] = *(const f32x4*)(a.in[15] + (size_t)l * D + n * 128 + c0 + 4 * j4);
#pragma unroll
        for (int j = 0; j < 4; ++j) cwr[j][j4] = *(const f32x4*)(a.in[14] + (size_t)l * 4 * D + j * D + n * 128 + c0 + 4 * j4); }
    bf16x8 Ba[4], Bx[4];
    { const bf16* wl = (const bf16*)(a.ws + WS_W + (size_t)l * WL_STRIDE);
      const bf16* wa = wl + OFF_LWA / 2 + (size_t)(n * 128 + e) * 128 + 8 * fq; const bf16* wx = wl + OFF_LWX / 2 + (size_t)(n * 128 + e) * 128 + 8 * fq;
#pragma unroll
      for (int ks = 0; ks < 4; ++ks) { Ba[ks] = *(const bf16x8*)(wa + 32 * ks); Bx[ks] = *(const bf16x8*)(wx + 32 * ks); } }
    const float ba = a.in[17][(size_t)l * D + ch], bx = a.in[19][(size_t)l * D + ch], sp8 = -8.0f * ((const float*)(a.ws + WS_TAB + 32768))[l * D + ch];
    const bf16* xsrc = XB + (size_t)(b * SEQ + t_ld) * D + n * 128 + c0;
    u32x4 xr0 = *(const u32x4*)xsrc, xr1 = *(const u32x4*)(xsrc + 8);
    for (int t0 = 0; t0 < SEQ; t0 += 64) {
        const int par = (t0 >> 6) & 1;
        unsigned ygr[8];
        { const bf16* yp = YG + (size_t)(b * SEQ + t0 + sg * 8) * D + chs;
#pragma unroll
          for (int tt = 0; tt < 8; ++tt) ygr[tt] = yp[(size_t)tt * D]; }
        WG_BAR();
        { LAS float* dst = L + L_XBS + (3 + t_ld) * 128 + c0;
          *(LAS f32x4*)dst        = (f32x4){bf2f(xr0.x & 0xffffu), bf2f(xr0.x >> 16), bf2f(xr0.y & 0xffffu), bf2f(xr0.y >> 16)};
          *(LAS f32x4*)(dst + 4)  = (f32x4){bf2f(xr0.z & 0xffffu), bf2f(xr0.z >> 16), bf2f(xr0.w & 0xffffu), bf2f(xr0.w >> 16)};
          *(LAS f32x4*)(dst + 8)  = (f32x4){bf2f(xr1.x & 0xffffu), bf2f(xr1.x >> 16), bf2f(xr1.y & 0xffffu), bf2f(xr1.y >> 16)};
          *(LAS f32x4*)(dst + 12) = (f32x4){bf2f(xr1.z & 0xffffu), bf2f(xr1.z >> 16), bf2f(xr1.w & 0xffffu), bf2f(xr1.w >> 16)}; }
        if (t0 + 64 < SEQ) { xr0 = *(const u32x4*)(xsrc + (size_t)(t0 + 64) * D); xr1 = *(const u32x4*)(xsrc + (size_t)(t0 + 64) * D + 8); }
        WG_BAR();
#pragma unroll
        for (int j4 = 0; j4 < 4; ++j4) { const int cc = c0 + 4 * j4;
            f32x4 acc = cbr[j4];
#pragma unroll
            for (int j = 0; j < 4; ++j) acc += cwr[j][j4] * *(const LAS f32x4*)(L + L_XBS + (t_ld + j) * 128 + cc);
            *(LAS f32x4*)(L + L_XC + t_ld * 128 + cc) = acc;
            { u32x2 pw; pw.x = pk2(acc[0], acc[1]); pw.y = pk2(acc[2], acc[3]); *(LAS u32x2*)(c.lds + LB_XCB + t_ld * XCB_STRIDE + cc * 2) = pw; } }
        WG_BAR();
#pragma unroll
        for (int mm = 0; mm < 2; ++mm) {
            const int m = m0 + mm;
            f32x4 ar = (f32x4){0.f, 0.f, 0.f, 0.f}, ai = (f32x4){0.f, 0.f, 0.f, 0.f};
#pragma unroll
            for (int ks = 0; ks < 4; ++ks) {
                const bf16x8 af = *(const LAS bf16x8*)(c.lds + LB_XCB + (16 * m + fr) * XCB_STRIDE + (32 * ks + 8 * fq) * 2);
                ar = __builtin_amdgcn_mfma_f32_16x16x32_bf16(af, Ba[ks], ar, 0, 0, 0);
                ai = __builtin_amdgcn_mfma_f32_16x16x32_bf16(af, Bx[ks], ai, 0, 0, 0);
            }
#pragma unroll
            for (int j = 0; j < 4; ++j) {
                const int t = 16 * m + 4 * fq + j;
                const float r = sig_fast(ar[j] + ba), ig = sig_fast(ai[j] + bx);
                const float la = sp8 * r, x2 = 2.0f * la;
                const float em = x2 > -0.5f ? x2 * (1.0f + x2 * (0.5f + x2 * (0.16666667f + x2 * (0.041666668f + x2 * 0.0083333338f)))) : __expf(x2) - 1.0f;
                As[t * 64 + ec] = __expf(la); Bs[t * 64 + ec] = __builtin_amdgcn_sqrtf(-em) * ig * L[L_XC + t * 128 + e];
            }
        }
        WG_BAR();
        float P = 1.f, Bv = 0.f;
#pragma unroll
        for (int tt = 0; tt < 8; ++tt) { const float aa = As[(sg * 8 + tt) * 64 + cch], bb = Bs[(sg * 8 + tt) * 64 + cch]; Bv = aa * Bv + bb; P *= aa; }
        SEG[(sg * 64 + cch) * 2] = P; SEG[(sg * 64 + cch) * 2 + 1] = Bv;
        WG_BAR();
        float h = CAR[par * 64 + cch];
        for (int s2 = 0; s2 < sg; ++s2) h = SEG[(s2 * 64 + cch) * 2] * h + SEG[(s2 * 64 + cch) * 2 + 1];
        { bf16* op = OB + (size_t)(b * SEQ + t0 + sg * 8) * D + chs;
#pragma unroll
          for (int tt = 0; tt < 8; ++tt) { const int t = sg * 8 + tt;
              h = As[t * 64 + cch] * h + Bs[t * 64 + cch];
              op[(size_t)tt * D] = (bf16)f2bf(h * bf2f(ygr[tt])); } }
        if (sg == 7) CAR[(par ^ 1) * 64 + cch] = h;
        if (c.tid < 384) L[L_XBS + c.tid] = L[L_XBS + 64 * 128 + c.tid];
    }
    __syncthreads();
    if (c.tid < 64) a.out[O_LRP + ((size_t)l * NBATCH + b) * D + n * 128 + 64 * hc + c.tid] = CAR[c.tid];
    if (hc == 0 && c.tid < 384) a.out[O_CVP + (((size_t)l * NBATCH + b) * 3 + (c.tid >> 7)) * D + n * 128 + (c.tid & 127)] = L[L_XBS + c.tid];
    __syncthreads();
}
__device__ __forceinline__ void lru_sample_item(CArgs& a, Ctx& c, int l, int n, int hf) {
    LAS float* L = (LAS float*)c.lds;
    const bf16* XB = (const bf16*)(a.ws + WS_XB); const bf16* YG = (const bf16*)(a.ws + WS_YG); bf16* OB = (bf16*)(a.ws + WS_OB);
    const int t_ld = c.tid >> 3, c0 = (c.tid & 7) * 16;
    const float* cw = a.in[14] + (size_t)l * 4 * D + n * 128; const float* cb = a.in[15] + (size_t)l * D + n * 128;
    const int bs = hf * 64 + t_ld, row = MP + bs;
    const float* sc = a.in[4] + ((size_t)l * NS + bs) * 3 * D + n * 128;
    float* nc = a.out + O_CVS + ((size_t)l * NS + bs) * 3 * D + n * 128;
    __syncthreads();
#pragma unroll
    for (int j4 = 0; j4 < 4; ++j4) { const int cc = c0 + 4 * j4;
        const f32x4 x = ld_bf4(XB + (size_t)row * D + n * 128 + cc);
        const f32x4 s0 = *(const f32x4*)(sc + cc), s1 = *(const f32x4*)(sc + D + cc), s2 = *(const f32x4*)(sc + 2 * D + cc);
        const f32x4 acc = *(const f32x4*)(cb + cc) + *(const f32x4*)(cw + cc) * s0 + *(const f32x4*)(cw + D + cc) * s1 + *(const f32x4*)(cw + 2 * D + cc) * s2 + *(const f32x4*)(cw + 3 * D + cc) * x;
        *(LAS f32x4*)(L + L_XC + t_ld * 128 + cc) = acc;
        { u32x2 w; w.x = pk2(acc[0], acc[1]); w.y = pk2(acc[2], acc[3]); *(LAS u32x2*)(c.lds + LB_XCB + t_ld * XCB_STRIDE + cc * 2) = w; }
        *(f32x4*)(nc + cc) = s1; *(f32x4*)(nc + D + cc) = s2; *(f32x4*)(nc + 2 * D + cc) = x; }
    __syncthreads();
    lru_gates(a, c, l, n);
    __syncthreads();
    { const int cch = c.tid & 127, tg = c.tid >> 7;
#pragma unroll 4
      for (int tt = 0; tt < 16; ++tt) { const int t = tg * 16 + tt, b2 = hf * 64 + t; const size_t off = (size_t)(MP + b2) * D + n * 128 + cch;
          const float h0 = a.in[3][((size_t)l * NS + b2) * D + n * 128 + cch];
          const float h = L[L_AS + t * 128 + cch] * h0 + L[L_BS + t * 128 + cch];
          a.out[O_LRS + ((size_t)l * NS + b2) * D + n * 128 + cch] = h;
          OB[off] = (bf16)f2bf(h * bf2f(YG[off])); } }
    __syncthreads();
}

__device__ __forceinline__ void mixer_phase(CArgs& a, Ctx& c, int l) {
    if (c.wg < 64) {
        hgrn_fast_prompt(a, c, l, c.wg >> 3, c.wg & 7);
    } else if (c.wg < 192) {
        const int i = c.wg - 64;
        for (int rep = 0; rep < 1 + ((PROBE_MIX >> 1) & 1); ++rep) lru_prompt_item(a, c, l, i >> 4, (i >> 1) & 7, i & 1);
    } else {
        for (int rep = 0; rep < 1 + ((PROBE_MIX >> 2) & 1); ++rep)
        for (int it = c.wg - 192; it < NS * NH; it += c.G - 192) {
            const int bs = it >> 3, h = it & 7; const size_t so = (((size_t)l * NS + bs) * NH + h) * DKV * DKV;
            hgrn_naive(a, c, l, MP + bs, 1, h, a.in[2] + so, a.out + O_HGS + so);
        }
        if (c.wg - 192 < 16) lru_sample_item(a, c, l, (c.wg - 192) >> 1, (c.wg - 192) & 1);
    }
}

__global__ void __launch_bounds__(512, 2) mega_fwd(Args a0) {
    extern __shared__ __attribute__((aligned(16))) unsigned char lds_raw[];
    Ctx c; c.lds = (LAS unsigned char*)lds_raw; c.tid = threadIdx.x; c.G = gridDim.x; c.wg = blockIdx.x;
    volatile LAS unsigned* MISC = (volatile LAS unsigned*)(c.lds + MISC_OFF);
    if (c.tid < 32) MISC[c.tid] = 0u;
    __syncthreads();
    XcdBarrier bar; bar.bar = (unsigned*)(a0.ws + WS_CTL) + 1024; bar.x = 0; bar.st = nullptr;
    const int nprog = a0.nprog;
    if (nprog > 1) bar = xcd_barrier_post((unsigned*)(a0.ws + WS_CTL) + 1024, MISC + 8);

    for (int pi = 0; pi < nprog; ++pi) {
        CArgs* ap = (CArgs*)__builtin_amdgcn_kernarg_segment_ptr(); asm volatile("" : "+s"(ap));
        CArgs& a = *ap;
        const int ph = a.prog[pi];
        unsigned long long pt0 = 0ull; if (PROBE_T >= 100 && ph == PROBE_T - 100) pt0 = __builtin_amdgcn_s_memrealtime();
        { int t_ = threadIdx.x, w_ = blockIdx.x, g_ = gridDim.x; asm volatile("" : "+v"(t_), "+s"(w_), "+s"(g_)); c.tid = t_; c.wg = w_; c.G = g_; }
        float* X = a.out;
        if (ph == 0) { }
        else if (ph == NPHASE - 1) final_norm_phase(a, c);
        else {
            const int l = (ph - 1) / 9, j = (ph - 1) % 9;
            const bf16* wl = (const bf16*)(a.ws + WS_W + (size_t)l * WL_STRIDE);
            const float* xp = l == 0 ? a.in[0] : X; const float* xs = l == 0 ? a.in[1] : X + (size_t)MP * D;
            const float* modl = (const float*)(a.ws + WS_MOD) + (size_t)l * NMOD * 6144;
            bf16* H = (bf16*)(a.ws + WS_H);
            if (j == 0) norm_phase(a, c, l, 0, xp, xs);
            else if (j == 1) {
                EpiIn e{a.ws + WS_PREP, (bf16*)(a.ws + WS_SQ), (bf16*)(a.ws + WS_SK), (float*)(a.ws + WS_SLOGF), (bf16*)(a.ws + WS_V), (bf16*)(a.ws + WS_OG), (bf16*)(a.ws + WS_XB), (bf16*)(a.ws + WS_YG), (bf16*)(a.ws + WS_SGA), (bf16*)(a.ws + WS_SGB),
                        (const float*)(a.ws + WS_TAB) + (size_t)l * 3 * D, l == 0 ? 1 : 0};
                gemm_phase_sel<0>(c, H, wl + OFF_WIN / 2, MT, NIN, D, e);
            } else if (j == 2) hgrn_prep_phase(a, c);
            else if (j == 3) mixer_phase(a, c, l);
            else if (j == 4) {
                EpiBrA ea{(const bf16*)(a.ws + WS_SGA), (float*)(a.ws + WS_T)};
                EpiBrB eb{(const bf16*)(a.ws + WS_SGB), (const float*)(a.ws + WS_T), (bf16*)(a.ws + WS_MG)};
                {
                    pg8::Gemm g{(const bf16*)(a.ws + WS_OA), wl + OFF_WA / 2, MP, D, D, (const bf16*)(a.ws + WS_OB), wl + OFF_WB / 2};
                    PowOrder S; S.init(2, c.G, c.wg, 1);
                    EpiBranchUnit qe{(const bf16*)(a.ws + WS_SGA), (const bf16*)(a.ws + WS_SGB), (bf16*)(a.ws + WS_MG)};
                    pg8::gemm_phase<EpiBranchUnit, PowOrder, true, true>(c.lds, g, S, qe, c.tid);
                }
                { int t_ = threadIdx.x; asm volatile("" : "+v"(t_)); c.tid = t_; }
                sample_gemm_phase(c, (const bf16*)(a.ws + WS_OA), wl + OFF_WA / 2, D, D, ea);
                asm volatile("s_waitcnt vmcnt(0)" ::: "memory"); __syncthreads();
                sample_gemm_phase(c, (const bf16*)(a.ws + WS_OB), wl + OFF_WB / 2, D, D, eb);
            } else if (j == 5) {
                EpiRes e{xp, xs, X, modl, 2};
                gemm_phase_sel<3>(c, (const bf16*)(a.ws + WS_MG), wl + OFF_WO / 2, MT, D, D, e);
            } else if (j == 6) norm_phase(a, c, l, 1, X, X + (size_t)MP * D);
            else if (j == 7) { EpiFF1 e{(bf16*)(a.ws + WS_HM)}; gemm_phase_sel<4>(c, H, wl + OFF_W1 / 2, MT, FF, D, e); }
            else { float* XO = (l == 1 && XOUT_SCRATCH) ? (float*)(a.ws + WS_T) : X;
                   EpiRes e{X, X + (size_t)MP * D, XO, modl, 5}; gemm_phase_sel<5>(c, (const bf16*)(a.ws + WS_HM), wl + OFF_W2 / 2, MT, D, FF, e); }
        }
        if (ph == 0 || (ph == 4 && c.wg >= 192)) {
            { int t_ = threadIdx.x; asm volatile("" : "+v"(t_)); c.tid = t_; }
            p0_work(a, c, ph == 0 ? 0 : 1, ph == 0 ? c.wg : c.wg - 192, ph == 0 ? c.G : c.G - 192, ph == 0, ph == 0 ? 2 : 0);
        }
        if (pi + 1 < nprog) xcd_barrier(bar);
        if (PROBE_T >= 100 && ph == PROBE_T - 100 && c.wg == 0 && threadIdx.x == 0) *(float*)(a.ws + WS_DBG) = (float)(__builtin_amdgcn_s_memrealtime() - pt0) * 1e-4f;
    }
}

extern "C" void kernel_launch(void* const* d_in, const int* in_sizes, int n_in, void* d_out, int out_size, void* d_ws, size_t ws_size, hipStream_t stream) {
    static int grid = 0;
    if (grid == 0) {
        if (n_in != 27 || out_size != (int)O_END || ws_size < WS_END) { fprintf(stderr, "kernel_launch: unexpected shapes (n_in %d out %d ws %zu)\n", n_in, out_size, ws_size); grid = -1; return; }
        int dev = 0, cus = 0, per_cu = 0;
        if (hipGetDevice(&dev) != hipSuccess || hipDeviceGetAttribute(&cus, hipDeviceAttributeMultiprocessorCount, dev) != hipSuccess) { grid = -1; return; }
        if (hipFuncSetAttribute((const void*)mega_fwd, hipFuncAttributeMaxDynamicSharedMemorySize, LDS_BYTES) != hipSuccess) { fprintf(stderr, "kernel_launch: hipFuncSetAttribute failed\n"); grid = -1; return; }
        if (hipOccupancyMaxActiveBlocksPerMultiprocessor(&per_cu, (const void*)mega_fwd, 512, LDS_BYTES) != hipSuccess || per_cu < 1) { fprintf(stderr, "kernel_launch: occupancy query failed (%d)\n", per_cu); (void)hipGetLastError(); per_cu = 1; }
        grid = cus * (per_cu < 1 ? 1 : 1);
        fprintf(stderr, "kernel_launch: cus %d per_cu %d grid %d\n", cus, per_cu, grid);
    }
    if (grid < 0) return;
    (void)hipMemsetAsync((char*)d_ws + WS_CTL, 0, CTL_BYTES, stream);
    Args a{};
    for (int i = 0; i < 27; ++i) a.in[i] = (const float*)d_in[i];
    a.out = (float*)d_out; a.ws = (unsigned char*)d_ws;
    unsigned char prog[60]; int np = 0;
    for (int ph = 0; ph < NPHASE; ++ph) for (int rep = 0; rep < 1 + (int)(((unsigned)PROBE_REPEAT >> ph) & 1u); ++rep) prog[np++] = (unsigned char)ph;
#if ONE_LAUNCH
    a.nprog = np; for (int i = 0; i < np; ++i) a.prog[i] = prog[i];
    void* kargs[] = {&a};
    hipError_t e = hipLaunchCooperativeKernel((const void*)mega_fwd, dim3(grid), dim3(512), kargs, LDS_BYTES, stream);
    if (e != hipSuccess) fprintf(stderr, "kernel_launch: cooperative launch failed: %s (grid %d)\n", hipGetErrorString(e), grid);
#else
    for (int i = 0; i < np; ++i) { a.nprog = 1; a.prog[0] = prog[i]; hipLaunchKernelGGL(mega_fwd, dim3(grid), dim3(512), LDS_BYTES, stream, a); }
#endif
}
```

```cpp
#include <hip/hip_runtime.h>
#include <cstdio>
#include <cstdint>

#ifndef FAST_GEMM
#define FAST_GEMM 63
#endif
#ifndef FAST_HGRN
#define FAST_HGRN 1
#endif
#ifndef FAST_GATES
#define FAST_GATES 1
#endif
#ifndef DBG_SHFL
#define DBG_SHFL 1
#endif
#ifndef PROBE_REPEAT
#define PROBE_REPEAT 0
#endif
#ifndef PROBE_MIX
#define PROBE_MIX 0
#endif
#ifndef PROBE_P0
#define PROBE_P0 0
#endif
#ifndef XOUT_SCRATCH
#define XOUT_SCRATCH 0
#endif
#ifndef PROBE_T
#define PROBE_T 0
#endif
#ifndef ONE_LAUNCH
#define ONE_LAUNCH 1
#endif

#define LAS __attribute__((address_space(3)))
#define GAS __attribute__((address_space(1)))
typedef unsigned short bf16;
typedef float f32x4 __attribute__((ext_vector_type(4)));
typedef float f32x2 __attribute__((ext_vector_type(2)));
typedef short bf16x8 __attribute__((ext_vector_type(8)));
typedef unsigned u32x4 __attribute__((ext_vector_type(4)));
typedef unsigned u32x2 __attribute__((ext_vector_type(2)));

constexpr int D = 1024, NBATCH = 8, SEQ = 2048, MP = NBATCH * SEQ, NS = 128, MR = MP + NS, MT = 16640;
constexpr int NMOD = NBATCH + NS;
constexpr int NIN = 8192, FF = 4096, NH = 8, DKV = 128;
constexpr float EPS = 1e-6f;
constexpr int NPHASE = 20;

constexpr size_t MiB = (size_t)1 << 20;
constexpr size_t WS_CTL = 0, CTL_BYTES = 64 * 1024;
constexpr size_t WS_DBG = 512 * 1024;
constexpr size_t WS_TAB = 1 * MiB;
constexpr size_t WS_MOD = 2 * MiB;
constexpr size_t WS_W = 9 * MiB, WL_STRIDE = 77 * MiB / 2;
constexpr size_t OFF_WIN = 0, OFF_WA = 16 * MiB, OFF_WB = 18 * MiB, OFF_WO = 20 * MiB, OFF_W1 = 22 * MiB, OFF_W2 = 30 * MiB, OFF_LWA = 38 * MiB, OFF_LWX = 38 * MiB + 256 * 1024;
constexpr size_t WS_H = 86 * MiB;
constexpr size_t WS_PREP = 119 * MiB;
constexpr size_t PREP_BLK = 65536;
constexpr size_t WS_V = 247 * MiB, WS_OG = 280 * MiB, WS_XB = 313 * MiB, WS_YG = 346 * MiB, WS_SGA = 379 * MiB, WS_SGB = 412 * MiB;
constexpr size_t WS_OA = 445 * MiB;
constexpr size_t WS_SQ = 478 * MiB, WS_SK = WS_SQ + 256 * 1024, WS_SLOGF = WS_SQ + 512 * 1024;
constexpr size_t WS_OB = WS_H;
constexpr size_t WS_T = WS_PREP;
constexpr size_t WS_MG = WS_PREP + 66 * MiB;
constexpr size_t WS_HM = WS_PREP;
constexpr size_t WS_END = 480 * MiB;
static_assert(WS_W + 2 * WL_STRIDE <= WS_H && WS_H + (size_t)MT * D * 2 <= WS_PREP && WS_PREP + 2048 * PREP_BLK <= WS_V && WS_T + (size_t)MT * D * 4 <= WS_MG && WS_MG + (size_t)MT * D * 2 <= WS_V
              && WS_HM + (size_t)MT * FF * 2 <= WS_OG && WS_OA + (size_t)MT * D * 2 <= WS_SQ && WS_SLOGF + 512 * 1024 <= WS_END, "ws map");

constexpr size_t O_YP = 0, O_YS = (size_t)MP * D, O_HGP = O_YS + (size_t)NS * D, O_LRP = O_HGP + (size_t)2 * NBATCH * NH * DKV * DKV, O_CVP = O_LRP + (size_t)2 * NBATCH * D,
                 O_HGS = O_CVP + (size_t)2 * NBATCH * 3 * D, O_LRS = O_HGS + (size_t)2 * NS * NH * DKV * DKV, O_CVS = O_LRS + (size_t)2 * NS * D, O_END = O_CVS + (size_t)2 * NS * 3 * D;
static_assert(O_END == 53673984, "out map");

constexpr int LDS_BYTES = 163840;
constexpr int MISC_OFF = 158 * 1024;

typedef __bf16 bf16x2_t __attribute__((ext_vector_type(2)));
__device__ __forceinline__ unsigned f2bf(float f) { return (unsigned)__builtin_bit_cast(unsigned short, (__bf16)f); }
__device__ __forceinline__ unsigned pk2(float lo, float hi) { return __builtin_bit_cast(unsigned, __builtin_convertvector((f32x2){lo, hi}, bf16x2_t)); }
__device__ __forceinline__ float bf2f(unsigned b) { return __builtin_bit_cast(float, b << 16); }
__device__ __forceinline__ f32x4 ld_bf4(const bf16* p) { const u32x2 w = *(const u32x2*)p; return (f32x4){bf2f(w.x & 0xffffu), bf2f(w.x >> 16), bf2f(w.y & 0xffffu), bf2f(w.y >> 16)}; }
__device__ __forceinline__ void st_bf4(bf16* p, f32x4 v) { u32x2 w; w.x = pk2(v[0], v[1]); w.y = pk2(v[2], v[3]); *(u32x2*)p = w; }
#define WG_BAR() do { asm volatile("s_waitcnt lgkmcnt(0)" ::: "memory"); __builtin_amdgcn_s_barrier(); asm volatile("" ::: "memory"); } while (0)
__device__ __forceinline__ float sig_fast(float x) { return __builtin_amdgcn_rcpf(1.0f + __expf(-x)); }
__device__ __forceinline__ void st_bf8(bf16* p, f32x4 v0, f32x4 v1) { u32x4 w; w.x = pk2(v0[0], v0[1]); w.y = pk2(v0[2], v0[3]); w.z = pk2(v1[0], v1[1]); w.w = pk2(v1[2], v1[3]); *(u32x4*)p = w; }
__device__ __forceinline__ void ld_bf8(const bf16* p, f32x4& v0, f32x4& v1) { const u32x4 w = *(const u32x4*)p; v0 = (f32x4){bf2f(w.x & 0xffffu), bf2f(w.x >> 16), bf2f(w.y & 0xffffu), bf2f(w.y >> 16)}; v1 = (f32x4){bf2f(w.z & 0xffffu), bf2f(w.z >> 16), bf2f(w.w & 0xffffu), bf2f(w.w >> 16)}; }
__device__ __forceinline__ float sigmoidf_(float x) { return 1.0f / (1.0f + __expf(-x)); }
__device__ __forceinline__ float siluf_(float x) { return x * sigmoidf_(x); }
__device__ __forceinline__ float gelu_tanh_(float x) { const float u = 0.7978845608028654f * (x + 0.044715f * x * x * x); return x * sigmoidf_(2.0f * u); }
__device__ __forceinline__ float softplusf_(float x) { return fmaxf(x, 0.f) + log1pf(expf(-fabsf(x))); }
template <int XM> __device__ __forceinline__ float swz_xor(float v) { return __builtin_bit_cast(float, __builtin_amdgcn_ds_swizzle(__builtin_bit_cast(int, v), (XM << 10) | 0x1f)); }
__device__ __forceinline__ int lane_id_fresh() { int l = (int)__builtin_amdgcn_mbcnt_hi(~0u, __builtin_amdgcn_mbcnt_lo(~0u, 0u)); asm volatile("" : "+v"(l)); return l; }
__device__ __forceinline__ float xchg(float v, int l, int m) { return __builtin_bit_cast(float, __builtin_amdgcn_ds_bpermute((l ^ m) << 2, __builtin_bit_cast(int, v))); }
template <int CTRL> __device__ __forceinline__ float dpp_f(float v) { return __builtin_bit_cast(float, __builtin_amdgcn_update_dpp(0, __builtin_bit_cast(int, v), CTRL, 0xf, 0xf, false)); }
__device__ __forceinline__ float row16_sum(float v) { v += dpp_f<0xB1>(v); v += dpp_f<0x4E>(v); v += dpp_f<0x141>(v); v += dpp_f<0x140>(v); return v; }
__device__ __forceinline__ float half_sum(float v) { const int l = lane_id_fresh(); v += xchg(v, l, 1); v += xchg(v, l, 2); v += xchg(v, l, 4); v += xchg(v, l, 8); v += xchg(v, l, 16); return v; }
__device__ __forceinline__ float wave_sum(float v) { const int l = lane_id_fresh(); v += xchg(v, l, 1); v += xchg(v, l, 2); v += xchg(v, l, 4); v += xchg(v, l, 8); v += xchg(v, l, 16); v += xchg(v, l, 32); return v; }
__device__ __forceinline__ int mod_row(int row) { return row < MP ? (row >> 11) : (NBATCH + row - MP); }

struct Args { const float* in[27]; float* out; unsigned char* ws; int nprog; unsigned char prog[60]; };
typedef const __attribute__((address_space(4))) Args CArgs;
struct Ctx { LAS unsigned char* lds; int tid, G, wg; };
namespace pg8 {
#define PG8_LAS __attribute__((address_space(3)))
typedef unsigned short bf16_t;
typedef short bf16x8 __attribute__((ext_vector_type(8)));
typedef float f32x4 __attribute__((ext_vector_type(4)));
typedef unsigned u32x4 __attribute__((ext_vector_type(4)));
constexpr int BM = 256, BK = 64, HALF = 128, HTB = HALF * BK * 2  , STAGE_BYTES = 8 * HTB, NXCD = 8, WGM = 8;

__host__ __device__ __forceinline__ int lds_byte(int r, int c) { const int st = (r >> 4) * 2 + (c >> 5), rr = r & 15, cc = c & 31, ob = rr * 64 + cc * 2; return st * 1024 + (ob ^ (((ob >> 9) & 1) << 5)); }
__host__ __device__ __forceinline__ void stage_rc(int b, int& R, int& C) { const int st = b / 1024, sb = b % 1024, swz = sb ^ (((sb >> 9) & 1) << 5); R = (st >> 1) * 16 + swz / 64; C = (st & 1) * 32 + (swz % 64) / 2; }
__host__ __device__ __forceinline__ int perm32(int rho) { const int n = rho >> 4, i = rho & 15; return 8 * (i >> 2) + 4 * n + (i & 3); }

struct Unit { int pm, pn, z; };
struct Gemm { const bf16_t* A; const bf16_t* Bt; int M, N, K; const bf16_t* A2; const bf16_t* Bt2; };

struct StaticOrder {
    int nM, nN, nwg, G, c;
    __host__ __device__ void init(int M, int N, int G_, int c_) { nM = M / BM; nN = N / BM; nwg = nM * nN; G = G_; c = c_; }
    __host__ __device__ bool next(int i, Unit& u) const {
        const long L = (long)i * G + c; if (L >= nwg) return false;
        int wgid = (int)L; { const int q = nwg / NXCD, r = nwg % NXCD, xcd = wgid % NXCD, off = wgid / NXCD; wgid = (xcd < r ? xcd * (q + 1) : r * (q + 1) + (xcd - r) * q) + off; }
        const int nig = WGM * nN, gid = wgid / nig, fm = gid * WGM, gsz = (nM - fm) < WGM ? (nM - fm) : WGM;
        u.pm = fm + ((wgid % nig) % gsz); u.pn = (wgid % nig) / gsz; u.z = 0; return true;
    }
    __device__ __forceinline__ void a_ready(const Unit&) const {}
    __device__ __forceinline__ void done(const Unit&) const {}
};
template <class Epi, class Sched, bool ALIGN_EPI = false, bool SP2 = false>
__device__ __forceinline__ void gemm_phase(PG8_LAS unsigned char* lds, const Gemm g, const Sched& S, const Epi& E, const int tid_in) {
    const int tid = tid_in, wid = __builtin_amdgcn_readfirstlane(tid >> 6), lane = tid & 63, wr = wid >> 2, wc = wid & 3, fr = lane & 15, fq = lane >> 4;
    const int K = g.K, nt = K / BK;
    unsigned voffA[2], voffB[2];
#pragma unroll
    for (int i = 0; i < 2; ++i) { int R, C; stage_rc(tid * 16 + i * 8192, R, C); const int Rb = Epi::PERM ? ((R & ~31) + perm32(R & 31)) : R;
        voffA[i] = (unsigned)(R * K + C) * 2u; voffB[i] = (unsigned)(Rb * K + C) * 2u; }
    const size_t kstep = (size_t)(BK * 2);
    const size_t hstep = (size_t)HALF * K * 2;
    const size_t tstep = 2 * hstep;
    const unsigned ldsw = (unsigned)wid * 1024u;
    const int aoff = lds_byte(wr * 64 + fr, fq * 8), boff = lds_byte(wc * 32 + fr, fq * 8);
#define PG8_SA(b, h) (((b) * 2 + (h)) * HTB)
#define PG8_SB(b, h) ((4 + (b) * 2 + (h)) * HTB)
#define PG8_STAGE(bufoff, gbase, voff) do { _Pragma("unroll") for (int _i = 0; _i < 2; ++_i) \
        __builtin_amdgcn_global_load_lds((const unsigned*)((const char*)(gbase) + (voff)[_i]), (PG8_LAS unsigned*)(lds + (bufoff) + ldsw + _i * 8192), 16, 0, 0); } while (0)
#define PG8_LDA(dst, b, h) do { _Pragma("unroll") for (int m = 0; m < 4; ++m) _Pragma("unroll") for (int k = 0; k < 2; ++k) dst[m][k] = *(const PG8_LAS bf16x8*)(lds + PG8_SA(b, h) + aoff + m * 2048 + k * 1024); } while (0)
#define PG8_LDB(dst, b, h) do { _Pragma("unroll") for (int n = 0; n < 2; ++n) _Pragma("unroll") for (int k = 0; k < 2; ++k) dst[n][k] = *(const PG8_LAS bf16x8*)(lds + PG8_SB(b, h) + boff + n * 2048 + k * 1024); } while (0)
#define PG8_MMA(ai, bj, At, Bt) do { __builtin_amdgcn_s_setprio(1); _Pragma("unroll") for (int m = 0; m < 4; ++m) _Pragma("unroll") for (int n = 0; n < 2; ++n) _Pragma("unroll") for (int k = 0; k < 2; ++k) \
        acc[ai][bj][m][n] = __builtin_amdgcn_mfma_f32_16x16x32_bf16(Bt[n][k], At[m][k], acc[ai][bj][m][n], 0, 0, 0); __builtin_amdgcn_s_setprio(0); } while (0)
#define PG8_WAIT_V(n) asm volatile("s_waitcnt vmcnt(" #n ")" ::: "memory")
#define PG8_WAIT_L(n) asm volatile("s_waitcnt lgkmcnt(" #n ")" ::: "memory")
#define PG8_BAR __builtin_amdgcn_s_barrier()
#define PG8_SCHED __builtin_amdgcn_sched_barrier(0)
    Unit cur, nxt; int ui = 0;
    if (!S.next(0, cur)) return;
    f32x4 acc[2][2][4][2];
#pragma unroll
    for (int a = 0; a < 2; ++a)
#pragma unroll
        for (int b = 0; b < 2; ++b)
#pragma unroll
            for (int m = 0; m < 4; ++m)
#pragma unroll
                for (int n = 0; n < 2; ++n) acc[a][b][m][n] = (f32x4){0.f, 0.f, 0.f, 0.f};
    bf16x8 At[4][2], B0[2][2], B1[2][2];
    const char* cA = (const char*)(cur.z ? g.A2 : g.A) + (size_t)cur.pm * tstep; const char* cB = (const char*)(cur.z ? g.Bt2 : g.Bt) + (size_t)cur.pn * tstep;
    S.a_ready(cur);
    if constexpr (SP2) {
        PG8_STAGE(PG8_SB(0, 0), cB, voffB); PG8_STAGE(PG8_SB(0, 1), cB + hstep, voffB); PG8_STAGE(PG8_SA(0, 0), cA, voffA); PG8_STAGE(PG8_SA(0, 1), cA + hstep, voffA);
        if (wr == 1) PG8_BAR;
        PG8_WAIT_V(2); PG8_BAR;
        PG8_STAGE(PG8_SB(1, 0), cB + kstep, voffB); PG8_STAGE(PG8_SA(1, 0), cA + kstep, voffA); PG8_STAGE(PG8_SB(1, 1), cB + hstep + kstep, voffB);
        PG8_WAIT_V(6); PG8_BAR;
    } else {
        PG8_STAGE(PG8_SB(0, 0), cB, voffB); PG8_STAGE(PG8_SA(0, 0), cA, voffA); PG8_STAGE(PG8_SB(0, 1), cB + hstep, voffB); PG8_STAGE(PG8_SA(0, 1), cA + hstep, voffA);
        if (wr == 1) PG8_BAR;
        PG8_WAIT_V(4); PG8_BAR;
        PG8_STAGE(PG8_SB(1, 0), cB + kstep, voffB); PG8_STAGE(PG8_SA(1, 0), cA + kstep, voffA); PG8_STAGE(PG8_SB(1, 1), cB + hstep + kstep, voffB);
        PG8_WAIT_V(6); PG8_BAR;
    }
    for (;;) {
        const bool has_next = S.next(ui + 1, nxt);
        const char* nA = has_next ? (const char*)(nxt.z ? g.A2 : g.A) + (size_t)nxt.pm * tstep : cA; const char* nB = has_next ? (const char*)(nxt.z ? g.Bt2 : g.Bt) + (size_t)nxt.pn * tstep : cB;
        for (int t = 0; t < nt; t += 2) {
            const bool last = (t == nt - 2);
            const char* a1 = cA + (size_t)(t + 1) * kstep;
            const char* a2 = last ? nA : cA + (size_t)(t + 2) * kstep; const char* b2 = last ? nB : cB + (size_t)(t + 2) * kstep;
            const char* a3 = a2 + kstep; const char* b3 = b2 + kstep;
            if (last && has_next) S.a_ready(nxt);
            if constexpr (SP2) {
            PG8_LDB(B0, 0, 0); PG8_LDB(B1, 0, 1); PG8_SCHED; PG8_LDA(At, 0, 0); PG8_STAGE(PG8_SA(1, 1), a1 + hstep, voffA);
            PG8_WAIT_V(8); PG8_WAIT_L(0); PG8_BAR; PG8_MMA(0, 0, At, B0); PG8_MMA(0, 1, At, B1); PG8_BAR; PG8_SCHED;
            PG8_LDA(At, 0, 1); PG8_STAGE(PG8_SB(0, 0), b2, voffB); PG8_STAGE(PG8_SB(0, 1), b2 + hstep, voffB); PG8_STAGE(PG8_SA(0, 0), a2, voffA);
            PG8_WAIT_V(8); PG8_WAIT_L(0); PG8_BAR; PG8_MMA(1, 0, At, B0); PG8_MMA(1, 1, At, B1); PG8_BAR; PG8_SCHED;
            PG8_LDB(B0, 1, 0); PG8_LDB(B1, 1, 1); PG8_SCHED; PG8_LDA(At, 1, 0); PG8_STAGE(PG8_SA(0, 1), a2 + hstep, voffA);
            PG8_WAIT_V(8); PG8_WAIT_L(0); PG8_BAR; PG8_MMA(0, 0, At, B0); PG8_MMA(0, 1, At, B1); PG8_BAR; PG8_SCHED;
            PG8_LDA(At, 1, 1); PG8_STAGE(PG8_SB(1, 0), b3, voffB); PG8_STAGE(PG8_SB(1, 1), b3 + hstep, voffB); PG8_STAGE(PG8_SA(1, 0), a3, voffA);
            PG8_WAIT_V(8); PG8_WAIT_L(0); PG8_BAR; PG8_MMA(1, 0, At, B0); PG8_MMA(1, 1, At, B1); PG8_BAR; PG8_SCHED;
            } else {
            PG8_LDB(B0, 0, 0); PG8_SCHED; PG8_LDA(At, 0, 0); PG8_STAGE(PG8_SA(1, 1), a1 + hstep, voffA);
            PG8_WAIT_L(8); PG8_BAR; PG8_WAIT_L(0); PG8_MMA(0, 0, At, B0); PG8_BAR; PG8_SCHED;
            PG8_LDB(B1, 0, 1); PG8_STAGE(PG8_SB(0, 0), b2, voffB);
            PG8_BAR; PG8_WAIT_L(0); PG8_MMA(0, 1, At, B1); PG8_BAR;
            PG8_LDA(At, 0, 1); PG8_STAGE(PG8_SA(0, 0), a2, voffA);
            PG8_BAR; PG8_WAIT_L(0); PG8_MMA(1, 0, At, B0); PG8_BAR; PG8_SCHED;
            PG8_STAGE(PG8_SB(0, 1), b2 + hstep, voffB);
            PG8_WAIT_V(6); PG8_BAR; PG8_MMA(1, 1, At, B1); PG8_BAR;
            PG8_LDB(B0, 1, 0); PG8_SCHED; PG8_LDA(At, 1, 0); PG8_STAGE(PG8_SA(0, 1), a2 + hstep, voffA);
            PG8_WAIT_L(8); PG8_BAR; PG8_WAIT_L(0); PG8_MMA(0, 0, At, B0); PG8_BAR; PG8_SCHED;
            PG8_LDB(B1, 1, 1); PG8_STAGE(PG8_SB(1, 0), b3, voffB);
            PG8_BAR; PG8_WAIT_L(0); PG8_MMA(0, 1, At, B1); PG8_BAR;
            PG8_LDA(At, 1, 1); PG8_STAGE(PG8_SA(1, 0), a3, voffA);
            PG8_BAR; PG8_WAIT_L(0); PG8_MMA(1, 0, At, B0); PG8_BAR; PG8_SCHED;
            PG8_STAGE(PG8_SB(1, 1), b3 + hstep, voffB);
            PG8_WAIT_V(6); PG8_BAR; PG8_MMA(1, 1, At, B1); PG8_BAR;
            }
        }
        if constexpr (ALIGN_EPI) { if (wr == 0) PG8_BAR; }
        if constexpr (!Epi::AFTER_DRAIN) { int l2 = (int)__builtin_amdgcn_mbcnt_hi(~0u, __builtin_amdgcn_mbcnt_lo(~0u, 0u)); asm volatile("" : "+v"(l2));
            E(acc, cur, wr, wc, l2 & 15, l2 >> 4); S.done(cur); }
        if (!has_next) break;
        if (!(Epi::KEEP && cur.z == 0)) {
#pragma unroll
        for (int a = 0; a < 2; ++a)
#pragma unroll
            for (int b = 0; b < 2; ++b)
#pragma unroll
                for (int m = 0; m < 4; ++m)
#pragma unroll
                    for (int n = 0; n < 2; ++n) acc[a][b][m][n] = (f32x4){0.f, 0.f, 0.f, 0.f};
        }
        cur = nxt; cA = nA; cB = nB; ++ui;
        if constexpr (ALIGN_EPI) { if (wr == 1) PG8_BAR; }
    }
    PG8_WAIT_V(0);
    if constexpr (!ALIGN_EPI) { if (wr == 0) PG8_BAR; }
    PG8_BAR;
    if constexpr (Epi::AFTER_DRAIN) { E.fused(acc, cur, wr, wc, fr, fq, lds, wid, lane); S.done(cur); }
#undef PG8_SA
#undef PG8_SB
#undef PG8_STAGE
#undef PG8_LDA
#undef PG8_LDB
#undef PG8_MMA
#undef PG8_WAIT_V
#undef PG8_WAIT_L
#undef PG8_BAR
#undef PG8_SCHED
}
}

template <class E> struct QuadEpi {
    static constexpr bool PERM = false, AFTER_DRAIN = false, KEEP = false;
    E e;
    __device__ __forceinline__ void operator()(const f32x4 (&acc)[2][2][4][2], const pg8::Unit& u, int wr, int wc, int fr, int fq) const {
        const int row0 = u.pm * 256 + wr * 64 + fr, col0 = u.pn * 256 + wc * 32 + 4 * fq;
#pragma unroll
        for (int ai = 0; ai < 2; ++ai)
#pragma unroll
            for (int m = 0; m < 4; ++m)
#pragma unroll
                for (int bj = 0; bj < 2; ++bj)
#pragma unroll
                    for (int n = 0; n < 2; ++n) e.quad(row0 + ai * 128 + m * 16, col0 + bj * 128 + n * 16, acc[ai][bj][m][n]);
    }
};

struct EpiIn {
    unsigned char* PREP; bf16 *SQ, *SK; float* SLOGF; bf16 *V, *OG, *XB, *YG, *SGA, *SGB; const float* lbt; int lb0;
    static constexpr bool BY_REGION = true;
    __device__ __forceinline__ size_t blk_off(int row, int cc) const { return (((size_t)(row >> 11) * 32 + ((row >> 6) & 31)) * 8 + (cc >> 7)) * PREP_BLK; }
    __device__ __forceinline__ bf16* q_ptr(int row, int cc) const { return row < MP ? (bf16*)(PREP + blk_off(row, cc) + 32768) + (row & 63) * 128 + (cc & 127) : SQ + (size_t)(row - MP) * D + cc; }
    __device__ __forceinline__ bf16* k_ptr(int row, int cc) const { return row < MP ? (bf16*)(PREP + blk_off(row, cc) + 49152) + (row & 63) * 128 + (cc & 127) : SK + (size_t)(row - MP) * D + cc; }
    __device__ __forceinline__ float* lf_ptr(int row, int cc) const { return row < MP ? (float*)(PREP + blk_off(row, cc)) + (row & 63) * 128 + (cc & 127) : SLOGF + (size_t)(row - MP) * D + cc; }
    __device__ __forceinline__ f32x2 fgate(float fa, float lb, float llb, float l1m) const {
        float lf, kk;
        const float t = __expf(-fabsf(fa));
        const float ls = fminf(fa, 0.f) - __logf(1.0f + t);
        const float sneg = (fa >= 0.f ? t : 1.0f) * __builtin_amdgcn_rcpf(1.0f + t);
        if (lb0) { lf = ls; kk = sneg; }
        else { const float b = l1m + ls, mx = fmaxf(llb, b); lf = mx + __logf(1.0f + __expf(-fabsf(llb - b))); kk = (1.0f - lb) * sneg; }
        return (f32x2){lf, kk};
    }
    template <int R> __device__ __forceinline__ f32x4 act(f32x4 v) const {
        f32x4 r;
#pragma unroll
        for (int j = 0; j < 4; ++j) {
            if constexpr (R == 0 || R == 3) r[j] = v[j] * sig_fast(v[j]);
            else if constexpr (R == 5) { const float x = v[j], u = 0.7978845608028654f * (x + 0.044715f * x * x * x); r[j] = x * sig_fast(2.0f * u); }
            else if constexpr (R >= 6) r[j] = sig_fast(v[j]);
            else r[j] = v[j];
        }
        return r;
    }
    template <int R> __device__ __forceinline__ bf16* dst(int row, int cc) const { return R == 0 ? q_ptr(row, cc) : (R == 2 ? V : R == 3 ? OG : R == 4 ? XB : R == 5 ? YG : R == 6 ? SGA : SGB) + (size_t)row * D + cc; }
    template <int R> __device__ __forceinline__ void quadR(int row, int cc, f32x4 v) const {
        const size_t o = (size_t)row * D + cc;
        if constexpr (R == 1) {
            const f32x4 lb = *(const f32x4*)(lbt + cc), llb = *(const f32x4*)(lbt + 1024 + cc), l1m = *(const f32x4*)(lbt + 2048 + cc);
            f32x4 lf, r;
#pragma unroll
            for (int j = 0; j < 4; ++j) { const f32x2 g = fgate(v[j], lb[j], llb[j], l1m[j]); lf[j] = g.x; r[j] = g.y; }
            *(f32x4*)lf_ptr(row, cc) = lf; (void)r;
        } else st_bf4(dst<R>(row, cc), act<R>(v));
    }
    template <int R> __device__ __forceinline__ void octR(int row, int cc, f32x4 v0, f32x4 v1) const {
        const size_t o = (size_t)row * D + cc;
        if constexpr (R == 1) {
            f32x4 lf0, lf1, r0, r1;
            if (lb0) {
#pragma unroll
                for (int j = 0; j < 4; ++j) { const f32x2 g0 = fgate(v0[j], 0.f, 0.f, 0.f), g1 = fgate(v1[j], 0.f, 0.f, 0.f); lf0[j] = g0.x; r0[j] = g0.y; lf1[j] = g1.x; r1[j] = g1.y; }
            } else {
                const f32x4 lba = *(const f32x4*)(lbt + cc), lbb = *(const f32x4*)(lbt + cc + 4), lla = *(const f32x4*)(lbt + 1024 + cc), llb_ = *(const f32x4*)(lbt + 1024 + cc + 4), l1a = *(const f32x4*)(lbt + 2048 + cc), l1b = *(const f32x4*)(lbt + 2048 + cc + 4);
#pragma unroll
                for (int j = 0; j < 4; ++j) { const f32x2 g0 = fgate(v0[j], lba[j], lla[j], l1a[j]), g1 = fgate(v1[j], lbb[j], llb_[j], l1b[j]); lf0[j] = g0.x; r0[j] = g0.y; lf1[j] = g1.x; r1[j] = g1.y; }
            }
            float* lp = lf_ptr(row, cc); *(f32x4*)lp = lf0; *(f32x4*)(lp + 4) = lf1; (void)r0; (void)r1;
        } else st_bf8(dst<R>(row, cc), act<R>(v0), act<R>(v1));
    }
    __device__ __forceinline__ void quad(int row, int col, f32x4 v) const {
        const int reg = col >> 10, cc = col & 1023;
        switch (reg) { case 0: quadR<0>(row, cc, v); break; case 1: quadR<1>(row, cc, v); break; case 2: quadR<2>(row, cc, v); break; case 3: quadR<3>(row, cc, v); break;
                       case 4: quadR<4>(row, cc, v); break; case 5: quadR<5>(row, cc, v); break; case 6: quadR<6>(row, cc, v); break; default: quadR<7>(row, cc, v); break; }
    }
};
struct EpiInUnit {
    static constexpr bool PERM = true, AFTER_DRAIN = false, KEEP = false;
    EpiIn e;
    template <int KIND> __device__ __forceinline__ void run(const f32x4 (&acc)[2][2][4][2], int row0, int cc0, bf16* dstp, int mode) const {
#pragma unroll
        for (int ai = 0; ai < 2; ++ai)
#pragma unroll
            for (int m = 0; m < 4; ++m) {
#pragma unroll
                for (int bj = 0; bj < 2; ++bj) {
                    const int row = row0 + ai * 128 + m * 16, cc = cc0 + bj * 128;
                    const f32x4 v0 = acc[ai][bj][m][0], v1 = acc[ai][bj][m][1];
                    if constexpr (KIND == 0) e.octR<1>(row, cc, v0, v1);
                    else if constexpr (KIND == 1) st_bf8(dstp + (size_t)row * D + cc, v0, v1);
                    else { f32x4 r0, r1;
#pragma unroll
                        for (int j = 0; j < 4; ++j) {
                            const float x0 = v0[j], x1 = v1[j];
                            const float a0 = mode == 1 ? 1.5957691216057308f * (x0 + 0.044715f * x0 * x0 * x0) : x0, a1 = mode == 1 ? 1.5957691216057308f * (x1 + 0.044715f * x1 * x1 * x1) : x1;
                            const float s0 = sig_fast(a0), s1 = sig_fast(a1);
                            r0[j] = mode == 2 ? s0 : x0 * s0; r1[j] = mode == 2 ? s1 : x1 * s1; }
                        st_bf8(dstp ? dstp + (size_t)row * D + cc : e.q_ptr(row, cc), r0, r1); }
                }
                asm volatile("" ::: "memory"); __builtin_amdgcn_sched_barrier(0); }
    }
    __device__ __forceinline__ void operator()(const f32x4 (&acc)[2][2][4][2], const pg8::Unit& u, int wr, int wc, int fr, int fq) const {
        const int row0 = u.pm * 256 + wr * 64 + fr, cc0 = (u.pn & 3) * 256 + wc * 32 + 8 * fq, reg = u.pn >> 2;
        if (reg == 1) run<0>(acc, row0, cc0, nullptr, 0);
        else if (reg == 2 || reg == 4) run<1>(acc, row0, cc0, reg == 2 ? e.V : e.XB, 0);
        else { bf16* dp = reg == 0 ? nullptr : reg == 3 ? e.OG : reg == 5 ? e.YG : reg == 6 ? e.SGA : e.SGB;
               run<2>(acc, row0, cc0, dp, reg == 5 ? 1 : (reg >= 6 ? 2 : 0)); }
    }
};
template <class E> struct OctEpi {
    static constexpr bool PERM = true, AFTER_DRAIN = false, KEEP = false;
    E e;
    __device__ __forceinline__ void operator()(const f32x4 (&acc)[2][2][4][2], const pg8::Unit& u, int wr, int wc, int fr, int fq) const {
        const int row0 = u.pm * 256 + wr * 64 + fr, col0 = u.pn * 256 + wc * 32 + 8 * fq;
#pragma unroll
        for (int ai = 0; ai < 2; ++ai)
#pragma unroll
            for (int m = 0; m < 4; ++m) {
#pragma unroll
                for (int bj = 0; bj < 2; ++bj) e.oct(row0 + ai * 128 + m * 16, col0 + bj * 128, acc[ai][bj][m][0], acc[ai][bj][m][1]);
                asm volatile("" ::: "memory"); __builtin_amdgcn_sched_barrier(0); }
    }
};
struct EpiBrA { static constexpr bool BY_REGION = false; const bf16* SGA; float* T;
    __device__ __forceinline__ void quad(int row, int col, f32x4 v) const { const size_t o = (size_t)row * D + col; *(f32x4*)(T + o) = ld_bf4(SGA + o) * v; }
    __device__ __forceinline__ void oct(int row, int col, f32x4 v0, f32x4 v1) const { const size_t o = (size_t)row * D + col; f32x4 g0, g1; ld_bf8(SGA + o, g0, g1); *(f32x4*)(T + o) = g0 * v0; *(f32x4*)(T + o + 4) = g1 * v1; } };
struct EpiBrB { static constexpr bool BY_REGION = false; const bf16* SGB; const float* T; bf16* MG;
    __device__ __forceinline__ void quad(int row, int col, f32x4 v) const { const size_t o = (size_t)row * D + col; st_bf4(MG + o, *(const f32x4*)(T + o) + ld_bf4(SGB + o) * v); }
    __device__ __forceinline__ void oct(int row, int col, f32x4 v0, f32x4 v1) const { const size_t o = (size_t)row * D + col; f32x4 g0, g1; ld_bf8(SGB + o, g0, g1);
        st_bf8(MG + o, *(const f32x4*)(T + o) + g0 * v0, *(const f32x4*)(T + o + 4) + g1 * v1); } };
struct EpiBranchUnit {
    static constexpr bool PERM = true, AFTER_DRAIN = false, KEEP = true;
    const bf16* SGA; const bf16* SGB; bf16* MG;
    __device__ __forceinline__ void operator()(const f32x4 (&acc_c)[2][2][4][2], const pg8::Unit& u, int wr, int wc, int fr, int fq) const {
        f32x4 (&acc)[2][2][4][2] = const_cast<f32x4 (&)[2][2][4][2]>(acc_c);
        const int row0 = u.pm * 256 + wr * 64 + fr, col0 = u.pn * 256 + wc * 32 + 8 * fq;
#pragma unroll
        for (int ai = 0; ai < 2; ++ai)
#pragma unroll
            for (int m = 0; m < 4; ++m) {
#pragma unroll
                for (int bj = 0; bj < 2; ++bj) { const size_t o = (size_t)(row0 + ai * 128 + m * 16) * D + col0 + bj * 128;
                    f32x4 b0, b1; ld_bf8(SGB + o, b0, b1);
                    if (u.z == 0) { f32x4 a0, a1; ld_bf8(SGA + o, a0, a1);
#pragma unroll
                        for (int j = 0; j < 4; ++j) { acc[ai][bj][m][0][j] *= a0[j] * __builtin_amdgcn_rcpf(fmaxf(b0[j], 1e-30f)); acc[ai][bj][m][1][j] *= a1[j] * __builtin_amdgcn_rcpf(fmaxf(b1[j], 1e-30f)); } }
                    else st_bf8(MG + o, acc[ai][bj][m][0] * b0, acc[ai][bj][m][1] * b1); }
                asm volatile("" ::: "memory"); __builtin_amdgcn_sched_barrier(0); }
    }
};
struct EpiRes { static constexpr bool BY_REGION = false; const float* xp; const float* xs; float* X; const float* modl; int gi;
    __device__ __forceinline__ void quad(int row, int col, f32x4 v) const {
        if (row >= MR) return;
        const float* src = row < MP ? xp + (size_t)row * D : xs + (size_t)(row - MP) * D;
        const f32x4 g = *(const f32x4*)(modl + (size_t)mod_row(row) * 6144 + gi * 1024 + col);
        *(f32x4*)(X + (size_t)row * D + col) = *(const f32x4*)(src + col) + g * v;
    }
    __device__ __forceinline__ void oct(int row, int col, f32x4 v0, f32x4 v1) const { quad(row, col, v0); quad(row, col + 4, v1); } };
struct EpiFF1 { static constexpr bool BY_REGION = false; bf16* HM;
    __device__ __forceinline__ void quad(int row, int col, f32x4 v) const {
        f32x4 r;
#pragma unroll
        for (int j = 0; j < 4; ++j) { const float t = fmaxf(v[j], 0.f); r[j] = t * t; }
        st_bf4(HM + (size_t)row * FF + col, r);
    }
    __device__ __forceinline__ void oct(int row, int col, f32x4 v0, f32x4 v1) const {
        f32x4 r0, r1;
#pragma unroll
        for (int j = 0; j < 4; ++j) { const float t0 = fmaxf(v0[j], 0.f), t1 = fmaxf(v1[j], 0.f); r0[j] = t0 * t0; r1[j] = t1 * t1; }
        st_bf8(HM + (size_t)row * FF + col, r0, r1);
    } };

template <class E>
__device__ __forceinline__ void naive_gemm_phase(Ctx& c, const bf16* A, const bf16* Bt, int M, int N, int K, const E& e) {
    LAS float* As = (LAS float*)c.lds;
    LAS float* Bs = As + 32 * 132;
    const int ntm = M / 128, ntn = N / 128, tx = c.tid & 31, ty = c.tid >> 5;
    const int lr = c.tid >> 2, lk = (c.tid & 3) * 8;
    for (int tile = c.wg; tile < ntm * ntn; tile += c.G) {
        const int tm = tile % ntm, tn = tile / ntm;
        f32x4 acc[8];
#pragma unroll
        for (int i = 0; i < 8; ++i) acc[i] = (f32x4){0.f, 0.f, 0.f, 0.f};
        for (int k0 = 0; k0 < K; k0 += 32) {
            const u32x4 av = *(const u32x4*)(A + (size_t)(tm * 128 + lr) * K + k0 + lk);
            const u32x4 bv = *(const u32x4*)(Bt + (size_t)(tn * 128 + lr) * K + k0 + lk);
            __syncthreads();
#pragma unroll
            for (int j = 0; j < 4; ++j) {
                As[(lk + 2 * j) * 132 + lr] = bf2f(av[j] & 0xffffu); As[(lk + 2 * j + 1) * 132 + lr] = bf2f(av[j] >> 16);
                Bs[(lk + 2 * j) * 132 + lr] = bf2f(bv[j] & 0xffffu); Bs[(lk + 2 * j + 1) * 132 + lr] = bf2f(bv[j] >> 16);
            }
            __syncthreads();
#pragma unroll 8
            for (int k = 0; k < 32; ++k) {
                const f32x4 a0 = *(const LAS f32x4*)(As + k * 132 + ty * 8), a1 = *(const LAS f32x4*)(As + k * 132 + ty * 8 + 4);
                const f32x4 b = *(const LAS f32x4*)(Bs + k * 132 + tx * 4);
                acc[0] += a0[0] * b; acc[1] += a0[1] * b; acc[2] += a0[2] * b; acc[3] += a0[3] * b;
                acc[4] += a1[0] * b; acc[5] += a1[1] * b; acc[6] += a1[2] * b; acc[7] += a1[3] * b;
            }
        }
#pragma unroll
        for (int i = 0; i < 8; ++i) e.quad(tm * 128 + ty * 8 + i, tn * 128 + tx * 4, acc[i]);
    }
    __syncthreads();
}

struct PowOrder {
    int lgN, nwg, G, c, two;
    __device__ __forceinline__ void init(int lgN_, int G_, int c_, int two_ = 0) { lgN = lgN_; nwg = 64 << lgN_; G = G_; c = c_; two = two_; }
    __device__ __forceinline__ bool next(int i, pg8::Unit& u) const {
        const int ii = two ? (i >> 1) : i;
        const int L = ii * G + c; if (L >= nwg) return false;
        const int w = (L & 7) * (nwg >> 3) + (L >> 3), j = w & ((8 << lgN) - 1), gid = w >> (3 + lgN);
        u.pm = __builtin_amdgcn_readfirstlane(gid * 8 + (j & 7)); u.pn = __builtin_amdgcn_readfirstlane(j >> 3); u.z = two ? (i & 1) : 0; return true;
    }
    __device__ __forceinline__ void a_ready(const pg8::Unit&) const {}
    __device__ __forceinline__ void done(const pg8::Unit&) const {}
};
template <class E>
__device__ __forceinline__ void sample_gemm_phase(Ctx& c, const bf16* A, const bf16* Bt, int N, int K, const E& e) {
    LAS float* red = (LAS float*)c.lds;
    const int lane = c.tid & 63, w = __builtin_amdgcn_readfirstlane(c.tid >> 6), fr = lane & 15, fq = lane >> 4, chh = w & 1, kq = w >> 1;
    const bf16* As = A + (size_t)MP * K;
    const int kspan = K >> 2;
    for (int mu = c.G - 1 - c.wg; mu < (N >> 5); mu += c.G) {
        const int n0 = 32 * mu;
        f32x4 acc[8];
#pragma unroll
        for (int m = 0; m < 8; ++m) acc[m] = (f32x4){0.f, 0.f, 0.f, 0.f};
        const bf16* bp = Bt + (size_t)(n0 + 16 * chh + fr) * K + kq * kspan + 8 * fq;
        const bf16* ap = As + (size_t)fr * K + kq * kspan + 8 * fq;
#pragma unroll 2
        for (int k = 0; k < kspan; k += 32) {
            const bf16x8 bfr = *(const bf16x8*)(bp + k);
#pragma unroll
            for (int m = 0; m < 8; ++m) acc[m] = __builtin_amdgcn_mfma_f32_16x16x32_bf16(*(const bf16x8*)(ap + (size_t)(16 * m) * K + k), bfr, acc[m], 0, 0, 0);
        }
        __syncthreads();
#pragma unroll
        for (int m = 0; m < 8; ++m)
#pragma unroll
            for (int j = 0; j < 4; ++j) red[(kq * 128 + 16 * m + 4 * fq + j) * 32 + 16 * chh + fr] = acc[m][j];
        __syncthreads();
#pragma unroll
        for (int i = 0; i < 2; ++i) { const int q = c.tid + 512 * i, row = q >> 3, cq = (q & 7) * 4;
            const f32x4 v = *(const LAS f32x4*)(red + row * 32 + cq) + *(const LAS f32x4*)(red + (128 + row) * 32 + cq) + *(const LAS f32x4*)(red + (256 + row) * 32 + cq) + *(const LAS f32x4*)(red + (384 + row) * 32 + cq);
            e.quad(MP + row, n0 + cq, v); }
    }
    __syncthreads();
}

template <int SITE, class E>
__device__ __forceinline__ void gemm_phase_sel(Ctx& c, const bf16* A, const bf16* Bt, int M, int N, int K, const E& e) {
    if constexpr ((FAST_GEMM >> SITE) & 1) {
        pg8::Gemm g{A, Bt, MP, N, K, A, Bt}; PowOrder S; S.init(N == 1024 ? 2 : (N == 4096 ? 4 : 5), c.G, c.wg);
        if constexpr (E::BY_REGION) { EpiInUnit qe{e}; pg8::gemm_phase<EpiInUnit, PowOrder, true, true>(c.lds, g, S, qe, c.tid); }
        else { OctEpi<E> qe{e}; pg8::gemm_phase<OctEpi<E>, PowOrder, true, true>(c.lds, g, S, qe, c.tid); }
        { int t_ = threadIdx.x; asm volatile("" : "+v"(t_)); c.tid = t_; }
        sample_gemm_phase(c, A, Bt, N, K, e);
    } else naive_gemm_phase(c, A, Bt, M, N, K, e);
}

#define XB_TMO      128
#define XB_XCNT(j)  (256  + 64 * (j))
#define XB_XSUB(j)  (1280 + 64 * (j))
#define XB_XGEN(j)  (2304 + 64 * (j))
#define XB_TOP      3328
#define XB_TOPGEN   3392
#define XCD_BAR_WORDS 3456
#define XB_SPIN_CAP (1u << 18)
__device__ __forceinline__ unsigned xb_ld(unsigned* p)              { return __hip_atomic_load(p, __ATOMIC_RELAXED, __HIP_MEMORY_SCOPE_AGENT); }
__device__ __forceinline__ unsigned xb_add(unsigned* p, unsigned v) { return __hip_atomic_fetch_add(p, v, __ATOMIC_RELAXED, __HIP_MEMORY_SCOPE_AGENT); }
__device__ __forceinline__ unsigned xb_xcc_id() { return (unsigned)__builtin_amdgcn_s_getreg((3 << 11) | 20) & 0xFu; }
#define XB_SPIN(cond, bar) do { unsigned _sp = 0; while (cond) { __builtin_amdgcn_s_sleep(1); \
    if ((++_sp & 255u) == 0u) { if (xb_ld(&(bar)[XB_TMO])) break; if (_sp > XB_SPIN_CAP) { atomicAdd(&(bar)[XB_TMO], 1u); break; } } } } while (0)
struct XcdBarrier { unsigned* bar; unsigned x; volatile LAS unsigned* st; };
__device__ __forceinline__ XcdBarrier xcd_barrier_post(unsigned* bar, volatile LAS unsigned* st) {
    XcdBarrier b; b.bar = bar; b.x = xb_xcc_id(); b.st = st;
    if (threadIdx.x == 0) (void)xb_add(&bar[XB_XCNT(b.x)], 1u);
    return b;
}
__device__ __forceinline__ void xcd_barrier_complete(unsigned* bar, unsigned x, unsigned& nloc, unsigned& nx) {
    const unsigned G = gridDim.x * gridDim.y * gridDim.z;
    unsigned sum, cnt, mine, sp = 0u;
    for (;;) {
        sum = 0u; cnt = 0u; mine = 0u;
#pragma unroll
        for (unsigned j = 0; j < 16; ++j) { const unsigned c = xb_ld(&bar[XB_XCNT(j)]); sum += c; cnt += (c > 0u) ? 1u : 0u; mine = (j == x) ? c : mine; }
        if (sum == G) break;
        __builtin_amdgcn_s_sleep(1);
        if ((++sp & 255u) == 0u) { if (xb_ld(&bar[XB_TMO])) break; if (sp > XB_SPIN_CAP) { atomicAdd(&bar[XB_TMO], 1u); break; } }
    }
    nloc = mine > 0u ? mine : 1u; nx = cnt > 0u ? cnt : 1u;
}
__device__ __forceinline__ void xcd_barrier(const XcdBarrier& b) {
    asm volatile("s_waitcnt vmcnt(0)" ::: "memory");
    __syncthreads();
    if (threadIdx.x == 0) {
        unsigned* bar = b.bar; asm volatile("" : "+s"(bar));
        __builtin_amdgcn_s_waitcnt(0);
        unsigned nloc = b.st[0], nx = b.st[1];
        if (nloc == 0u) { xcd_barrier_complete(bar, b.x, nloc, nx); b.st[0] = nloc; b.st[1] = nx; }
        const unsigned old = xb_add(&bar[XB_XSUB(b.x)], 1u);
        const unsigned gen = old / nloc;
        if (old + 1u == (gen + 1u) * nloc) {
            __builtin_amdgcn_fence(__ATOMIC_RELEASE, "agent");
            asm volatile("s_waitcnt vmcnt(0)" ::: "memory");
            const unsigned og = xb_add(&bar[XB_TOP], 1u);
            const unsigned tg = og / nx;
            if (og + 1u == (tg + 1u) * nx) xb_add(&bar[XB_TOPGEN], 1u);
            else XB_SPIN(xb_ld(&bar[XB_TOPGEN]) == tg, bar);
            __builtin_amdgcn_fence(__ATOMIC_ACQUIRE, "agent");
            xb_add(&bar[XB_XGEN(b.x)], 1u);
            asm volatile("s_waitcnt vmcnt(0)" ::: "memory");
        } else {
            XB_SPIN(xb_ld(&bar[XB_XGEN(b.x)]) == gen, bar);
            __builtin_amdgcn_fence(__ATOMIC_ACQUIRE, "agent");
            asm volatile("s_waitcnt vmcnt(0)" ::: "memory");
        }
    }
    __syncthreads();
}

__device__ __forceinline__ void p0_transpose_item(const float* W, int K, int N, bf16* WT, LAS float* scr, int item, int lane) {
    const int nblk = N / 32, kb = item / nblk, nb = item % nblk, k0 = 64 * kb, n0 = 32 * nb;
    float v[32];
#pragma unroll
    for (int i = 0; i < 32; ++i) v[i] = W[(size_t)(k0 + 2 * i + (lane >> 5)) * N + n0 + (lane & 31)];
#pragma unroll
    for (int i = 0; i < 32; ++i) scr[(2 * i + (lane >> 5)) * 33 + (lane & 31)] = v[i];
    asm volatile("s_waitcnt lgkmcnt(0)" ::: "memory");
    const int ch = lane & 7;
#pragma unroll
    for (int j = 0; j < 4; ++j) { const int n = (lane >> 3) + 8 * j; const LAS float* s = scr + (8 * ch) * 33 + n;
        u32x4 o; o.x = pk2(s[0 * 33], s[1 * 33]); o.y = pk2(s[2 * 33], s[3 * 33]); o.z = pk2(s[4 * 33], s[5 * 33]); o.w = pk2(s[6 * 33], s[7 * 33]);
        *(u32x4*)(WT + (size_t)(n0 + n) * K + k0 + 8 * ch) = o; }
    asm volatile("s_waitcnt lgkmcnt(0)" ::: "memory");
}
__device__ __forceinline__ void p0_work(CArgs& a, Ctx& c, int l, int vw, int nvw, bool with_tables, int tr_sel, bool do_mod) {
    if (tr_sel) {
        LAS float* scr = (LAS float*)(c.lds + __builtin_amdgcn_readfirstlane(c.tid >> 6) * 16384);
        const int gw = vw * 8 + __builtin_amdgcn_readfirstlane(c.tid >> 6), NGW = nvw * 8;
        constexpr int I_IN = 16 * 256, I_SQ = 16 * 32, I_1 = 16 * 128, I_2 = 64 * 32, I_L = 8 * 8, PER_L = I_IN + 3 * I_SQ + I_1 + I_2 + 2 * I_L, FF0 = I_IN + 3 * I_SQ, NFF = I_1 + I_2;
        const int nit = tr_sel == 1 ? PER_L + I_IN : (tr_sel == 2 ? 3 * I_SQ + 2 * I_L : NFF);
        for (int it = gw; it < nit; it += NGW) {
            int lt, r;
            if (tr_sel == 1) { lt = it < PER_L ? 0 : 1; r = it < PER_L ? it : it - PER_L; }
            else if (tr_sel == 2) { lt = 1; r = it < 3 * I_SQ ? I_IN + it : FF0 + NFF + (it - 3 * I_SQ); }
            else { lt = 1; r = FF0 + it; }
            bf16* wl = (bf16*)(a.ws + WS_W + (size_t)lt * WL_STRIDE);
            if (r < I_IN) { p0_transpose_item(a.in[11] + (size_t)lt * D * NIN, D, NIN, wl + OFF_WIN / 2, scr, r, (c.tid & 63)); continue; } r -= I_IN;
            if (r < I_SQ) { p0_transpose_item(a.in[21] + (size_t)lt * D * D, D, D, wl + OFF_WA / 2, scr, r, (c.tid & 63)); continue; } r -= I_SQ;
            if (r < I_SQ) { p0_transpose_item(a.in[22] + (size_t)lt * D * D, D, D, wl + OFF_WB / 2, scr, r, (c.tid & 63)); continue; } r -= I_SQ;
            if (r < I_SQ) { p0_transpose_item(a.in[23] + (size_t)lt * D * D, D, D, wl + OFF_WO / 2, scr, r, (c.tid & 63)); continue; } r -= I_SQ;
            if (r < I_1) { p0_transpose_item(a.in[24] + (size_t)lt * D * FF, D, FF, wl + OFF_W1 / 2, scr, r, (c.tid & 63)); continue; } r -= I_1;
            if (r < I_2) { p0_transpose_item(a.in[25] + (size_t)lt * FF * D, FF, D, wl + OFF_W2 / 2, scr, r, (c.tid & 63)); continue; } r -= I_2;
            if (r < I_L) { const int n = r >> 3; p0_transpose_item(a.in[16] + ((size_t)lt * 8 + n) * 16384, 128, 128, wl + OFF_LWA / 2 + n * 16384, scr, r & 7, (c.tid & 63)); continue; } r -= I_L;
            { const int n = r >> 3; p0_transpose_item(a.in[18] + ((size_t)lt * 8 + n) * 16384, 128, 128, wl + OFF_LWX / 2 + n * 16384, scr, r & 7, (c.tid & 63)); }
        }
    }
    if (with_tables) {
        float* lbt = (float*)(a.ws + WS_TAB); float* sp = (float*)(a.ws + WS_TAB + 32768);
        const int gid = vw * 512 + c.tid;
        if (gid < 2 * D) {
            const int ll = gid >> 10, col = gid & 1023;
            const float h0 = a.in[12][col], h1 = a.in[12][D + col];
            const float p1 = 1.0f / (1.0f + expf(h0 - h1));
            const float lb = ll == 0 ? 0.f : p1;
            lbt[(ll * 3 + 0) * D + col] = lb; lbt[(ll * 3 + 1) * D + col] = logf(fmaxf(lb, 1e-30f)); lbt[(ll * 3 + 2) * D + col] = log1pf(-lb);
            sp[ll * D + col] = softplusf_(-a.in[20][ll * D + col]);
        }
    }
    __syncthreads();
    if (!do_mod) return;
    {
        constexpr int CS_STRIDE = 272;
        LAS unsigned char* csb = c.lds;
        LAS float* ws = (LAS float*)(c.lds + 39168);
        float* MOD = (float*)(a.ws + WS_MOD);
        const int lane = c.tid & 63, w = __builtin_amdgcn_readfirstlane(c.tid >> 6), fr = lane & 15, fq = lane >> 4, ct = w & 1, rt0 = w >> 1;
        for (int item = vw; item < 192; item += nvw) {
            const float* W = a.in[7] + (size_t)l * D * 6144 + item * 32;
            f32x4 acc[3];
#pragma unroll
            for (int i = 0; i < 3; ++i) acc[i] = (f32x4){0.f, 0.f, 0.f, 0.f};
            f32x4 cv[9], wv[2];
#define MOD_LOAD(k0_) do { _Pragma("unroll") for (int i = 0; i < 9; ++i) { const int e4 = c.tid + 512 * i, r = e4 >> 5, kq = (e4 & 31) * 4; const int rr = r < NMOD ? r : 0; \
                const float* src = rr < NBATCH ? a.in[5] + (size_t)rr * D : a.in[6] + (size_t)(rr - NBATCH) * D; cv[i] = *(const f32x4*)(src + (k0_) + kq); } \
              _Pragma("unroll") for (int i = 0; i < 2; ++i) { const int e4 = c.tid + 512 * i, kk = e4 >> 3, c4 = (e4 & 7) * 4; wv[i] = *(const f32x4*)(W + (size_t)((k0_) + kk) * 6144 + c4); } } while (0)
            MOD_LOAD(0);
            for (int k0 = 0; k0 < D; k0 += 128) {
                __syncthreads();
#pragma unroll
                for (int i = 0; i < 9; ++i) { const int e4 = c.tid + 512 * i, r = e4 >> 5, kq = (e4 & 31) * 4;
                    u32x2 pw; pw.x = pk2(siluf_(cv[i][0]), siluf_(cv[i][1])); pw.y = pk2(siluf_(cv[i][2]), siluf_(cv[i][3]));
                    if (r >= NMOD) { pw.x = 0u; pw.y = 0u; }
                    *(LAS u32x2*)(csb + r * CS_STRIDE + kq * 2) = pw; }
#pragma unroll
                for (int i = 0; i < 2; ++i) { const int e4 = c.tid + 512 * i, kk = e4 >> 3, c4 = (e4 & 7) * 4;
                    ws[kk * 33 + c4] = wv[i][0]; ws[kk * 33 + c4 + 1] = wv[i][1]; ws[kk * 33 + c4 + 2] = wv[i][2]; ws[kk * 33 + c4 + 3] = wv[i][3]; }
                if (k0 + 128 < D) MOD_LOAD(k0 + 128);
                WG_BAR();
#pragma unroll
                for (int ks = 0; ks < 4; ++ks) {
                    const LAS float* wp = ws + (32 * ks + 8 * fq) * 33 + 16 * ct + fr;
                    u32x4 bw; bw.x = pk2(wp[0], wp[33]); bw.y = pk2(wp[66], wp[99]); bw.z = pk2(wp[132], wp[165]); bw.w = pk2(wp[198], wp[231]);
                    const bf16x8 bfr = __builtin_bit_cast(bf16x8, bw);
#pragma unroll
                    for (int i = 0; i < 3; ++i) { const int rt = rt0 + 4 * i;
                        if (rt < 9) acc[i] = __builtin_amdgcn_mfma_f32_16x16x32_bf16(*(const LAS bf16x8*)(csb + (16 * rt + fr) * CS_STRIDE + (32 * ks + 8 * fq) * 2), bfr, acc[i], 0, 0, 0); }
                }
            }
#undef MOD_LOAD
            const float bm = a.in[8][(size_t)l * 6144 + item * 32 + 16 * ct + fr];
#pragma unroll
            for (int i = 0; i < 3; ++i) { const int rt = rt0 + 4 * i;
                if (rt < 9) {
#pragma unroll
                    for (int j = 0; j < 4; ++j) { const int row = 16 * rt + 4 * fq + j; if (row < NMOD) MOD[((size_t)l * NMOD + row) * 6144 + item * 32 + 16 * ct + fr] = acc[i][j] + bm; } } }
        }
    }
    __syncthreads();
}

__device__ __forceinline__ void norm_phase(CArgs& a, Ctx& c, int l, int which, const float* xp, const float* xs) {
    const int gw = c.wg * 8 + __builtin_amdgcn_readfirstlane(c.tid >> 6), NGW = c.G * 8;
    bf16* H = (bf16*)(a.ws + WS_H);
    const float* MODL = (const float*)(a.ws + WS_MOD) + (size_t)l * NMOD * 6144;
    const float* g = a.in[which ? 10 : 9] + (size_t)l * D;
    for (int row = gw; row < MR; row += NGW) {
        const float* xr = row < MP ? xp + (size_t)row * D : xs + (size_t)(row - MP) * D;
        const float* md = MODL + (size_t)mod_row(row) * 6144 + (which ? 3 : 0) * 1024;
        f32x4 v[4]; float ss = 0.f;
#pragma unroll
        for (int j = 0; j < 4; ++j) { v[j] = *(const f32x4*)(xr + 4 * (c.tid & 63) + 256 * j); ss += (v[j][0] * v[j][0] + v[j][1] * v[j][1]) + (v[j][2] * v[j][2] + v[j][3] * v[j][3]); }
        const float rstd = 1.0f / sqrtf(wave_sum(ss) * (1.0f / D) + EPS);
#pragma unroll
        for (int j = 0; j < 4; ++j) { const int cc = 4 * (c.tid & 63) + 256 * j;
            const f32x4 gg = *(const f32x4*)(g + cc), sh = *(const f32x4*)(md + cc), sc = *(const f32x4*)(md + 1024 + cc);
            st_bf4(H + (size_t)row * D + cc, v[j] * rstd * gg * (1.0f + sc) + sh); }
    }
}
__device__ __forceinline__ void final_norm_phase(CArgs& a, Ctx& c) {
    const int gw = c.wg * 8 + __builtin_amdgcn_readfirstlane(c.tid >> 6), NGW = c.G * 8;
    const float* g = a.in[26];
    for (int row = gw; row < MR; row += NGW) {
        const float* xr = (XOUT_SCRATCH ? (const float*)(a.ws + WS_T) : (const float*)a.out) + (size_t)row * D; float* yr = a.out + (size_t)row * D;
        f32x4 v[4]; float ss = 0.f;
#pragma unroll
        for (int j = 0; j < 4; ++j) { v[j] = *(const f32x4*)(xr + 4 * (c.tid & 63) + 256 * j); ss += (v[j][0] * v[j][0] + v[j][1] * v[j][1]) + (v[j][2] * v[j][2] + v[j][3] * v[j][3]); }
        const float rstd = 1.0f / sqrtf(wave_sum(ss) * (1.0f / D) + EPS);
#pragma unroll
        for (int j = 0; j < 4; ++j) { const int cc = 4 * (c.tid & 63) + 256 * j; f32x4 y = v[j] * rstd * *(const f32x4*)(g + cc);
            if (PROBE_T && row == 0 && cc == 0) y[0] += *(const float*)(a.ws + WS_DBG);
            *(f32x4*)(yr + cc) = y; }
    }
}

__device__ __forceinline__ void hgrn_naive(CArgs& a, Ctx& c, int l, int row0, int ntok, int h, const float* S0, float* Sout) {
    LAS float* fs = (LAS float*)c.lds;
    LAS float* ks = fs + 2048;
    LAS float* qs = ks + 2048;
    LAS float* vs = qs + 2048;
    LAS float* part = vs + 2048;
    const bf16* Q = (const bf16*)(a.ws + WS_SQ) - (size_t)MP * D; const float* LOGF = (const float*)(a.ws + WS_SLOGF) - (size_t)MP * D;
    const bf16* V = (const bf16*)(a.ws + WS_V); const bf16* OG = (const bf16*)(a.ws + WS_OG); bf16* OA = (bf16*)(a.ws + WS_OA);
    const float* hg = a.in[13] + (size_t)l * DKV;
    const int v = c.tid & 127, kg = c.tid >> 7;
    float S[32];
#pragma unroll
    for (int i = 0; i < 32; ++i) S[i] = S0 ? S0[(size_t)(32 * kg + i) * DKV + v] : 0.f;
    for (int t0 = 0; t0 < ntok; t0 += 16) {
        const int nt = (ntok - t0) < 16 ? (ntok - t0) : 16;
        __syncthreads();
        { const int tt = c.tid >> 5, k4 = (c.tid & 31) * 4;
          if (tt < nt) { const size_t off = (size_t)(row0 + t0 + tt) * D + h * DKV + k4;
              const f32x4 lf = *(const f32x4*)(LOGF + off);
              *(LAS f32x4*)(fs + tt * 128 + k4) = (f32x4){expf(lf[0]), expf(lf[1]), expf(lf[2]), expf(lf[3])};
              *(LAS f32x4*)(ks + tt * 128 + k4) = (f32x4){1.0f - expf(lf[0]), 1.0f - expf(lf[1]), 1.0f - expf(lf[2]), 1.0f - expf(lf[3])};
              *(LAS f32x4*)(qs + tt * 128 + k4) = ld_bf4(Q + off);
              *(LAS f32x4*)(vs + tt * 128 + k4) = ld_bf4(V + off); } }
        __syncthreads();
        for (int tt = 0; tt < nt; ++tt) {
            const float vv = vs[tt * 128 + v]; float acc = 0.f;
#pragma unroll
            for (int i4 = 0; i4 < 8; ++i4) {
                const f32x4 f = *(const LAS f32x4*)(fs + tt * 128 + 32 * kg + 4 * i4), kk = *(const LAS f32x4*)(ks + tt * 128 + 32 * kg + 4 * i4), qq = *(const LAS f32x4*)(qs + tt * 128 + 32 * kg + 4 * i4);
#pragma unroll
                for (int j = 0; j < 4; ++j) { S[4 * i4 + j] = f[j] * S[4 * i4 + j] + kk[j] * vv; acc += S[4 * i4 + j] * qq[j]; }
            }
            part[(tt * 4 + kg) * 128 + v] = acc;
        }
        __syncthreads();
        { const int tt = c.tid >> 5, v4 = (c.tid & 31) * 4; const int tc = tt < nt ? tt : 0;
          const f32x4 o = *(const LAS f32x4*)(part + (tc * 4 + 0) * 128 + v4) + *(const LAS f32x4*)(part + (tc * 4 + 1) * 128 + v4)
                        + *(const LAS f32x4*)(part + (tc * 4 + 2) * 128 + v4) + *(const LAS f32x4*)(part + (tc * 4 + 3) * 128 + v4);
          float ss = (o[0] * o[0] + o[1] * o[1]) + (o[2] * o[2] + o[3] * o[3]);
          ss = half_sum(ss);
          const float rstd = 1.0f / sqrtf(ss * (1.0f / DKV) + EPS);
          if (tt < nt) { const size_t off = (size_t)(row0 + t0 + tt) * D + h * DKV + v4;
              st_bf4(OA + off, o * rstd * *(const f32x4*)(hg + v4) * ld_bf4(OG + off)); } }
    }
#pragma unroll
    for (int i = 0; i < 32; ++i) Sout[(size_t)(32 * kg + i) * DKV + v] = S[i];
    __syncthreads();
}


constexpr int HB_Q0 = 0, HB_K0 = 17408, HB_Q1 = 26112, HB_K1 = 34816, HB_KT0 = 43520, HB_KT1 = 53760, HB_VT = 64000, HB_AS = 82432, HB_ST = 91648, HB_VEC = 126464, HB_TOT = 128512, HB_SSQ = 130560;
constexpr int HS_Q = 272, HS_KT = 80, HS_VT = 144, HS_AS = 144;
static_assert(HB_SSQ + 2048 <= MISC_OFF && 64 * 132 * 4 <= HB_VEC - HB_ST, "hgrn lds");
__device__ __forceinline__ float exp_c(float x) { return __expf(fminf(x, 80.f)); }
__device__ __forceinline__ void hgrn_prep_phase(CArgs& a, Ctx& c) {
    LAS unsigned char* lds = c.lds;
    const int tid = c.tid, cp = tid & 63, sg = tid >> 6;
    LAS float* VEC = (LAS float*)(lds + HB_VEC); LAS float* TOT = (LAS float*)(lds + HB_TOT);
    f32x2 lf[8]; unsigned qr[8], vr[8];
#define PREP_LOAD(it_) do { const unsigned char* bp_ = a.ws + WS_PREP + (size_t)(it_) * PREP_BLK; const int e0_ = (8 * sg) * 128 + 2 * cp; \
        const bf16* vs_ = (const bf16*)(a.ws + WS_V) + ((size_t)((it_) >> 8) * SEQ + 64 * (((it_) >> 3) & 31)) * D + ((it_) & 7) * DKV; \
        _Pragma("unroll") for (int i = 0; i < 8; ++i) { lf[i] = *(const f32x2*)((const float*)bp_ + e0_ + i * 128); qr[i] = *(const unsigned*)((const bf16*)(bp_ + 32768) + e0_ + i * 128); \
            vr[i] = *(const unsigned*)(vs_ + (size_t)(8 * sg + i) * D + 2 * cp); } } while (0)
    if (c.wg < 2048) PREP_LOAD(c.wg);
    for (int it = c.wg; it < 2048; it += c.G) {
        unsigned char* bp = a.ws + WS_PREP + (size_t)it * PREP_BLK;
        const int pb = it >> 8, pn = (it >> 3) & 31, phh = it & 7;
        bf16* vslice = (bf16*)(a.ws + WS_V) + ((size_t)pb * SEQ + 64 * pn) * D + phh * DKV;
        f32x2 g[8], lfk[8]; g[0] = lf[0]; lfk[0] = lf[0];
#pragma unroll
        for (int i = 1; i < 8; ++i) { g[i] = g[i - 1] + lf[i]; lfk[i] = lf[i]; }
        WG_BAR();
        *(LAS f32x2*)(TOT + sg * 128 + 2 * cp) = g[7];
        WG_BAR();
        {
            f32x2 off = (f32x2){0.f, 0.f}, r0 = off, r1 = off, last = off;
#pragma unroll
            for (int s2 = 0; s2 < 8; ++s2) { const f32x2 tv = *(const LAS f32x2*)(TOT + s2 * 128 + 2 * cp);
                if (s2 < sg) off += tv; if (s2 < 2) r0 += tv; if (s2 < 6) r1 += tv; last += tv; }
            unsigned kt0[4], kt1[4], vt0[4], vt1[4];
#pragma unroll
            for (int i = 0; i < 8; ++i) {
                const f32x2 G = g[i] + off; const float q0 = bf2f(qr[i] & 0xffffu), q1 = bf2f(qr[i] >> 16), k0 = 1.0f - __expf(lfk[i].x), k1 = 1.0f - __expf(lfk[i].y);
                const int t = 8 * sg + i;
                *(LAS unsigned*)(lds + HB_Q0 + t * HS_Q + cp * 4) = pk2(q0 * exp_c(G.x - r0.x), q1 * exp_c(G.y - r0.y));
                if (sg < 4) *(LAS unsigned*)(lds + HB_K0 + t * HS_Q + cp * 4) = pk2(k0 * exp_c(r0.x - G.x), k1 * exp_c(r0.y - G.y));
                else { *(LAS unsigned*)(lds + HB_K1 + (t - 32) * HS_Q + cp * 4) = pk2(k0 * exp_c(r1.x - G.x), k1 * exp_c(r1.y - G.y));
                       *(LAS unsigned*)(lds + HB_Q1 + (t - 32) * HS_Q + cp * 4) = pk2(q0 * exp_c(G.x - r1.x), q1 * exp_c(G.y - r1.y)); }
                const unsigned kd = pk2(k0 * __expf(last.x - G.x), k1 * __expf(last.y - G.y));
                if (i & 1) { kt0[i >> 1] |= kd << 16; kt1[i >> 1] |= kd & 0xffff0000u; vt0[i >> 1] |= vr[i] << 16; vt1[i >> 1] |= vr[i] & 0xffff0000u; }
                else { kt0[i >> 1] = kd & 0xffffu; kt1[i >> 1] = kd >> 16; vt0[i >> 1] = vr[i] & 0xffffu; vt1[i >> 1] = vr[i] >> 16; }
            }
            { LAS unsigned char* p = lds + (sg < 4 ? HB_KT0 : HB_KT1) + (2 * cp) * HS_KT + (sg & 3) * 16;
              *(LAS u32x4*)p = (u32x4){kt0[0], kt0[1], kt0[2], kt0[3]}; *(LAS u32x4*)(p + HS_KT) = (u32x4){kt1[0], kt1[1], kt1[2], kt1[3]}; }
            { LAS unsigned char* p = lds + HB_VT + (2 * cp) * HS_VT + sg * 16;
              *(LAS u32x4*)p = (u32x4){vt0[0], vt0[1], vt0[2], vt0[3]}; *(LAS u32x4*)(p + HS_VT) = (u32x4){vt1[0], vt1[1], vt1[2], vt1[3]}; }
            if (sg == 0) *(LAS f32x2*)(VEC + 2 * cp) = (f32x2){exp_c(r0.x), exp_c(r0.y)};
            if (sg == 1) *(LAS f32x2*)(VEC + 128 + 2 * cp) = (f32x2){exp_c(last.x), exp_c(last.y)};
        }
        if (it + c.G < 2048) PREP_LOAD(it + c.G);
        WG_BAR();
#pragma unroll
        for (int i = 0; i < 2; ++i) { const int p = tid + 512 * i, row = p >> 4, pc = p & 15; *(u32x4*)(bp + row * 256 + pc * 16) = *(const LAS u32x4*)(lds + HB_Q0 + row * HS_Q + pc * 16); }
        { const int row = tid >> 4, pc = tid & 15;
          *(u32x4*)(bp + 16384 + row * 256 + pc * 16) = *(const LAS u32x4*)(lds + HB_K0 + row * HS_Q + pc * 16);
          *(u32x4*)(bp + 24576 + row * 256 + pc * 16) = *(const LAS u32x4*)(lds + HB_Q1 + row * HS_Q + pc * 16);
          *(u32x4*)(bp + 32768 + row * 256 + pc * 16) = *(const LAS u32x4*)(lds + HB_K1 + row * HS_Q + pc * 16); }
        { const int k = tid >> 2, pc = tid & 3;
          *(u32x4*)(bp + 40960 + k * 64 + pc * 16) = *(const LAS u32x4*)(lds + HB_KT0 + k * HS_KT + pc * 16);
          *(u32x4*)(bp + 49152 + k * 64 + pc * 16) = *(const LAS u32x4*)(lds + HB_KT1 + k * HS_KT + pc * 16); }
        if (tid < 64) *(u32x4*)(bp + 57344 + tid * 16) = *(const LAS u32x4*)(lds + HB_VEC + tid * 16);
#pragma unroll
        for (int i = 0; i < 2; ++i) { const int p = tid + 512 * i, v = p >> 3, pc = p & 7;
            *(u32x4*)((unsigned char*)(vslice + (size_t)(v >> 1) * D) + (v & 1) * 128 + pc * 16) = *(const LAS u32x4*)(lds + HB_VT + v * HS_VT + pc * 16); }
    }
#undef PREP_LOAD
    __syncthreads();
}

__device__ __forceinline__ void hgrn_fast_prompt(CArgs& a, Ctx& c, int l, int b, int h) {
    LAS unsigned char* lds = c.lds;
    const int tid = c.tid, lane = tid & 63, w = __builtin_amdgcn_readfirstlane(tid >> 6), fr = lane & 15, fq = lane >> 4;
    const int col = tid & 127, sg = tid >> 7;
    const bf16* V = (const bf16*)(a.ws + WS_V); const bf16* OG = (const bf16*)(a.ws + WS_OG); bf16* OA = (bf16*)(a.ws + WS_OA);
    const unsigned char* blk0 = a.ws + WS_PREP + ((size_t)b * 32 * 8 + h) * PREP_BLK;
    const size_t base = (size_t)b * SEQ * D + (size_t)h * DKV;
    LAS float* VEC = (LAS float*)(lds + HB_VEC); LAS float* SSQ = (LAS float*)(lds + HB_SSQ);
    LAS unsigned char* STw = lds + HB_ST + w * 4352;
    const float gv = a.in[13][(size_t)l * DKV + 16 * w + fr];
    f32x4 S[8];
#pragma unroll
    for (int i = 0; i < 8; ++i) S[i] = (f32x4){0.f, 0.f, 0.f, 0.f};
    __syncthreads();
    for (int e = tid; e < 2 * 16 * 16; e += 512) { const int which = e >> 8, r = (e >> 4) & 15, cc = e & 15;
        *(LAS bf16*)(lds + HB_AS + ((which ? 32 : 0) + r) * HS_AS + ((which ? 48 : 16) + cc) * 2) = 0; }
    const int prow = tid >> 4, ppc = tid & 15, pk = tid >> 2, pkc = tid & 3;
    const bf16* vt0 = (const bf16*)(a.ws + WS_V) + (size_t)b * SEQ * D + h * DKV;
    const int orow = tid >> 4, oc8 = (tid & 15) * 8;
    u32x4 im[10], ogv[2];
#define HG_LOAD(n_) do { const unsigned char* bp_ = blk0 + (size_t)(n_) * 8 * PREP_BLK; \
        im[0] = *(const u32x4*)(bp_ + prow * 256 + ppc * 16); im[1] = *(const u32x4*)(bp_ + (32 + prow) * 256 + ppc * 16); \
        im[2] = *(const u32x4*)(bp_ + 16384 + prow * 256 + ppc * 16); im[3] = *(const u32x4*)(bp_ + 24576 + prow * 256 + ppc * 16); im[4] = *(const u32x4*)(bp_ + 32768 + prow * 256 + ppc * 16); \
        im[5] = *(const u32x4*)(bp_ + 40960 + pk * 64 + pkc * 16); im[6] = *(const u32x4*)(bp_ + 49152 + pk * 64 + pkc * 16); \
        if (tid < 64) im[7] = *(const u32x4*)(bp_ + 57344 + tid * 16); \
        _Pragma("unroll") for (int i = 0; i < 2; ++i) { const int p_ = tid + 512 * i, v_ = p_ >> 3, pc_ = p_ & 7; \
            im[8 + i] = *(const u32x4*)((const unsigned char*)(vt0 + (size_t)(64 * (n_) + (v_ >> 1)) * D) + (v_ & 1) * 128 + pc_ * 16); } } while (0)
    HG_LOAD(0);
    unsigned long long tacc = 0ull, tst = 0ull;
#define TSTART(id) do { if (PROBE_T == (id)) { __builtin_amdgcn_sched_barrier(0); tst = __builtin_amdgcn_s_memtime(); __builtin_amdgcn_sched_barrier(0); } } while (0)
#define TSTOP(id) do { if (PROBE_T == (id)) { __builtin_amdgcn_sched_barrier(0); tacc += __builtin_amdgcn_s_memtime() - tst; __builtin_amdgcn_sched_barrier(0); } } while (0)
    for (int nn = 0; nn < (SEQ / 64) * (1 + (PROBE_MIX & 1)); ++nn) {
        const int n = nn & (SEQ / 64 - 1);
        if (PROBE_MIX & 1) { if (nn == SEQ / 64) {
#pragma unroll
            for (int i = 0; i < 8; ++i) S[i] = (f32x4){0.f, 0.f, 0.f, 0.f}; } }
        TSTART(1); TSTART(2);
        *(LAS u32x4*)(lds + HB_Q0 + prow * HS_Q + ppc * 16) = im[0]; *(LAS u32x4*)(lds + HB_Q0 + (32 + prow) * HS_Q + ppc * 16) = im[1];
        *(LAS u32x4*)(lds + HB_K0 + prow * HS_Q + ppc * 16) = im[2]; *(LAS u32x4*)(lds + HB_Q1 + prow * HS_Q + ppc * 16) = im[3]; *(LAS u32x4*)(lds + HB_K1 + prow * HS_Q + ppc * 16) = im[4];
        *(LAS u32x4*)(lds + HB_KT0 + pk * HS_KT + pkc * 16) = im[5]; *(LAS u32x4*)(lds + HB_KT1 + pk * HS_KT + pkc * 16) = im[6];
        if (tid < 64) *(LAS u32x4*)(lds + HB_VEC + tid * 16) = im[7];
#pragma unroll
        for (int i = 0; i < 2; ++i) { const int p = tid + 512 * i, v = p >> 3, pc = p & 7; *(LAS u32x4*)(lds + HB_VT + v * HS_VT + pc * 16) = im[8 + i]; }
        ogv[0] = *(const u32x4*)(OG + base + (size_t)(64 * n + orow) * D + oc8); ogv[1] = *(const u32x4*)(OG + base + (size_t)(64 * n + 32 + orow) * D + oc8);
        if ((PROBE_MIX & 1) || n + 1 < SEQ / 64) HG_LOAD((n + 1) & (SEQ / 64 - 1));
        WG_BAR();
        TSTOP(2); TSTART(3);
#pragma unroll
        for (int kt8 = 0; kt8 < 8; ++kt8) { const f32x4 er = *(const LAS f32x4*)(VEC + 16 * kt8 + 4 * fq);
            u32x2 pw; pw.x = pk2(S[kt8][0] * er[0], S[kt8][1] * er[1]); pw.y = pk2(S[kt8][2] * er[2], S[kt8][3] * er[3]);
            *(LAS u32x2*)(STw + fr * HS_Q + (16 * kt8 + 4 * fq) * 2) = pw; }
#pragma unroll
        for (int rep = 0; rep < 2; ++rep) {
            const int id = w + 8 * rep;
            if (id < 10) {
                int tt, st;
                if (id == 0) { tt = 0; st = 0; } else if (id < 7) { tt = (id + 1) >> 1; st = (id + 1) & 1; } else if (id == 7) { tt = 2; st = 2; } else { tt = 3; st = id - 6; }
                const LAS unsigned char* ap = (st < 2) ? lds + HB_Q0 + (16 * tt + fr) * HS_Q : lds + HB_Q1 + (16 * (tt - 2) + fr) * HS_Q;
                const LAS unsigned char* bp = (st < 2) ? lds + HB_K0 + (16 * st + fr) * HS_Q : lds + HB_K1 + (16 * (st - 2) + fr) * HS_Q;
                f32x4 acc = (f32x4){0.f, 0.f, 0.f, 0.f};
#pragma unroll
                for (int ks = 0; ks < 4; ++ks) acc = __builtin_amdgcn_mfma_f32_16x16x32_bf16(*(const LAS bf16x8*)(ap + (32 * ks + 8 * fq) * 2), *(const LAS bf16x8*)(bp + (32 * ks + 8 * fq) * 2), acc, 0, 0, 0);
#pragma unroll
                for (int j = 0; j < 4; ++j) { const float v_ = (tt == st && fr > 4 * fq + j) ? 0.f : acc[j];
                    *(LAS bf16*)(lds + HB_AS + (16 * tt + 4 * fq + j) * HS_AS + (16 * st + fr) * 2) = (bf16)f2bf(v_); }
            }
        }
        f32x4 o[4];
#pragma unroll
        for (int tt = 0; tt < 4; ++tt) o[tt] = (f32x4){0.f, 0.f, 0.f, 0.f};
#pragma unroll
        for (int ks = 0; ks < 4; ++ks) { const bf16x8 bfr = *(const LAS bf16x8*)(STw + fr * HS_Q + (32 * ks + 8 * fq) * 2);
#pragma unroll
            for (int tt = 0; tt < 4; ++tt) o[tt] = __builtin_amdgcn_mfma_f32_16x16x32_bf16(*(const LAS bf16x8*)(lds + HB_Q0 + (16 * tt + fr) * HS_Q + (32 * ks + 8 * fq) * 2), bfr, o[tt], 0, 0, 0); }
        WG_BAR();
        TSTOP(3); TSTART(4);
#pragma unroll
        for (int tt = 0; tt < 4; ++tt)
#pragma unroll
            for (int ks = 0; ks < 2; ++ks) if (ks == 0 || tt >= 2)
                o[tt] = __builtin_amdgcn_mfma_f32_16x16x32_bf16(*(const LAS bf16x8*)(lds + HB_AS + (16 * tt + fr) * HS_AS + (32 * ks + 8 * fq) * 2), *(const LAS bf16x8*)(lds + HB_VT + (16 * w + fr) * HS_VT + (32 * ks + 8 * fq) * 2), o[tt], 0, 0, 0);
#pragma unroll
        for (int tt = 0; tt < 4; ++tt)
#pragma unroll
            for (int j = 0; j < 4; ++j) { float p = o[tt][j] * o[tt][j];
                p = row16_sum(p);
                if (fr == 0) SSQ[w * 64 + 16 * tt + 4 * fq + j] = p; }
#pragma unroll
        for (int kt8 = 0; kt8 < 8; ++kt8) {
            const f32x4 eL = *(const LAS f32x4*)(VEC + 128 + 16 * kt8 + 4 * fq);
            f32x4 sn = eL * S[kt8];
            sn = __builtin_amdgcn_mfma_f32_16x16x32_bf16(*(const LAS bf16x8*)(lds + HB_KT0 + (16 * kt8 + fr) * HS_KT + 8 * fq * 2), *(const LAS bf16x8*)(lds + HB_VT + (16 * w + fr) * HS_VT + 8 * fq * 2), sn, 0, 0, 0);
            S[kt8] = __builtin_amdgcn_mfma_f32_16x16x32_bf16(*(const LAS bf16x8*)(lds + HB_KT1 + (16 * kt8 + fr) * HS_KT + 8 * fq * 2), *(const LAS bf16x8*)(lds + HB_VT + (16 * w + fr) * HS_VT + (32 + 8 * fq) * 2), sn, 0, 0, 0);
        }
        WG_BAR();
        TSTOP(4); TSTART(5);
        { LAS float* OUT = (LAS float*)(lds + HB_ST);
#pragma unroll
          for (int tt = 0; tt < 4; ++tt)
#pragma unroll
              for (int j = 0; j < 4; ++j) OUT[(16 * tt + 4 * fq + j) * 132 + 16 * w + fr] = o[tt][j] * gv;
          WG_BAR();
#pragma unroll
          for (int i = 0; i < 2; ++i) { const int t = orow + 32 * i;
              float ss = SSQ[t];
#pragma unroll
              for (int ww = 1; ww < 8; ++ww) ss += SSQ[ww * 64 + t];
              const float rstd = __builtin_amdgcn_rsqf(ss * (1.0f / DKV) + EPS);
              const f32x4 x0 = *(const LAS f32x4*)(OUT + t * 132 + oc8) * rstd, x1 = *(const LAS f32x4*)(OUT + t * 132 + oc8 + 4) * rstd;
              const u32x4 g_ = ogv[i];
              const f32x4 g0 = (f32x4){bf2f(g_.x & 0xffffu), bf2f(g_.x >> 16), bf2f(g_.y & 0xffffu), bf2f(g_.y >> 16)}, g1 = (f32x4){bf2f(g_.z & 0xffffu), bf2f(g_.z >> 16), bf2f(g_.w & 0xffffu), bf2f(g_.w >> 16)};
              st_bf8(OA + base + (size_t)(64 * n + t) * D + oc8, x0 * g0, x1 * g1); } }
        TSTOP(5); TSTOP(1);
    }
    if (PROBE_T && PROBE_T < 100 && l == 0 && c.wg == 0 && tid == 0) *(float*)(a.ws + WS_DBG) = (float)(tacc >> 5) * 1e-4f;
#undef HG_LOAD
    { float* Sout = a.out + O_HGP + (((size_t)l * NBATCH + b) * NH + h) * DKV * DKV;
#pragma unroll
      for (int kt8 = 0; kt8 < 8; ++kt8)
#pragma unroll
          for (int j = 0; j < 4; ++j) Sout[(size_t)(16 * kt8 + 4 * fq + j) * DKV + 16 * w + fr] = S[kt8][j]; }
    __syncthreads();
}

constexpr int L_XBS = 0, L_XC = 67 * 128, L_AS = L_XC + 8192, L_BS = L_AS + 8192, L_SEG = L_BS + 8192, L_CARRY = L_SEG + 1024;
constexpr int LB_XCB = (L_CARRY + 256) * 4, XCB_STRIDE = 272;
static_assert(LB_XCB + 64 * XCB_STRIDE <= MISC_OFF && LB_XCB % 16 == 0, "lru lds");
__device__ __forceinline__ void lru_gates_naive(CArgs& a, Ctx& c, int l, int n) {
    LAS float* XC = (LAS float*)c.lds + L_XC; LAS float* As = (LAS float*)c.lds + L_AS; LAS float* Bs = (LAS float*)c.lds + L_BS;
    const bf16* wl = (const bf16*)(a.ws + WS_W + (size_t)l * WL_STRIDE);
    const int e = c.tid & 127, tg = c.tid >> 7;
    const bf16* wa = wl + OFF_LWA / 2 + (size_t)(n * 128 + e) * 128; const bf16* wx = wl + OFF_LWX / 2 + (size_t)(n * 128 + e) * 128;
    const int ch = n * 128 + e;
    const float ba = a.in[17][(size_t)l * D + ch], bx = a.in[19][(size_t)l * D + ch], sp = ((const float*)(a.ws + WS_TAB + 32768))[l * D + ch];
#pragma unroll 1
    for (int tq = 0; tq < 4; ++tq) {
        float ra[4], ia[4];
#pragma unroll
        for (int i = 0; i < 4; ++i) { ra[i] = 0.f; ia[i] = 0.f; }
        const LAS float* xc = XC + (tg * 16 + tq * 4) * 128;
#pragma unroll 1
        for (int d0 = 0; d0 < 128; d0 += 8) {
            const f32x4 wa0 = ld_bf4(wa + d0), wa1 = ld_bf4(wa + d0 + 4), wx0 = ld_bf4(wx + d0), wx1 = ld_bf4(wx + d0 + 4);
#pragma unroll
            for (int tt = 0; tt < 4; ++tt) {
                const f32x4 x0 = *(const LAS f32x4*)(xc + tt * 128 + d0), x1 = *(const LAS f32x4*)(xc + tt * 128 + d0 + 4);
                ra[tt] += (x0[0] * wa0[0] + x0[1] * wa0[1]) + (x0[2] * wa0[2] + x0[3] * wa0[3]) + (x1[0] * wa1[0] + x1[1] * wa1[1]) + (x1[2] * wa1[2] + x1[3] * wa1[3]);
                ia[tt] += (x0[0] * wx0[0] + x0[1] * wx0[1]) + (x0[2] * wx0[2] + x0[3] * wx0[3]) + (x1[0] * wx1[0] + x1[1] * wx1[1]) + (x1[2] * wx1[2] + x1[3] * wx1[3]);
            }
        }
#pragma unroll
        for (int tt = 0; tt < 4; ++tt) {
            const int t = tg * 16 + tq * 4 + tt;
            const float r = sigmoidf_(ra[tt] + ba), ig = sigmoidf_(ia[tt] + bx);
            const float la = -8.0f * r * sp, aa = expf(la), mult = sqrtf(-expm1f(2.0f * la));
            As[t * 128 + e] = aa; Bs[t * 128 + e] = mult * ig * XC[t * 128 + e];
        }
    }
}
__device__ __forceinline__ void lru_gates_mfma(CArgs& a, Ctx& c, int l, int n) {
    LAS float* XC = (LAS float*)c.lds + L_XC; LAS float* As = (LAS float*)c.lds + L_AS; LAS float* Bs = (LAS float*)c.lds + L_BS;
    const bf16* wl = (const bf16*)(a.ws + WS_W + (size_t)l * WL_STRIDE);
    const int lane = c.tid & 63, w = __builtin_amdgcn_readfirstlane(c.tid >> 6), fr = lane & 15, fq = lane >> 4;
    const int e = 16 * w + fr, ch = n * 128 + e;
    const bf16* wa = wl + OFF_LWA / 2 + (size_t)(n * 128 + e) * 128 + 8 * fq; const bf16* wx = wl + OFF_LWX / 2 + (size_t)(n * 128 + e) * 128 + 8 * fq;
    bf16x8 Ba[4], Bx[4];
#pragma unroll
    for (int ks = 0; ks < 4; ++ks) { Ba[ks] = *(const bf16x8*)(wa + 32 * ks); Bx[ks] = *(const bf16x8*)(wx + 32 * ks); }
    const float ba = a.in[17][(size_t)l * D + ch], bx = a.in[19][(size_t)l * D + ch], sp = ((const float*)(a.ws + WS_TAB + 32768))[l * D + ch];
#pragma unroll
    for (int m = 0; m < 4; ++m) {
        f32x4 ar = (f32x4){0.f, 0.f, 0.f, 0.f}, ai = (f32x4){0.f, 0.f, 0.f, 0.f};
#pragma unroll
        for (int ks = 0; ks < 4; ++ks) {
            const bf16x8 af = *(const LAS bf16x8*)(c.lds + LB_XCB + (16 * m + fr) * XCB_STRIDE + (32 * ks + 8 * fq) * 2);
            ar = __builtin_amdgcn_mfma_f32_16x16x32_bf16(af, Ba[ks], ar, 0, 0, 0);
            ai = __builtin_amdgcn_mfma_f32_16x16x32_bf16(af, Bx[ks], ai, 0, 0, 0);
        }
#pragma unroll
        for (int j = 0; j < 4; ++j) {
            const int t = 16 * m + 4 * fq + j;
            const float r = sigmoidf_(ar[j] + ba), ig = sigmoidf_(ai[j] + bx);
            const float la = -8.0f * r * sp, aa = expf(la), mult = sqrtf(-expm1f(2.0f * la));
            As[t * 128 + e] = aa; Bs[t * 128 + e] = mult * ig * XC[t * 128 + e];
        }
    }
}
#if FAST_GATES
#define lru_gates lru_gates_mfma
#else
#define lru_gates lru_gates_naive
#endif

constexpr int LB_CW = LB_XCB + 64 * XCB_STRIDE;
static_assert(LB_CW + 2560 <= MISC_OFF, "lru lds");
__device__ __forceinline__ void lru_prompt_item(CArgs& a, Ctx& c, int l, int b, int n, int hc) {
    LAS float* L = (LAS float*)c.lds;
    LAS float* As = L + L_AS; LAS float* Bs = L + L_BS; LAS float* SEG = L + L_SEG; LAS float* CAR = L + L_CARRY;
    const bf16* XB = (const bf16*)(a.ws + WS_XB); const bf16* YG = (const bf16*)(a.ws + WS_YG); bf16* OB = (bf16*)(a.ws + WS_OB);
    const int t_ld = c.tid >> 3, c0 = (c.tid & 7) * 16;
    const int cch = c.tid & 63, sg = c.tid >> 6;
    const int lane = c.tid & 63, w = __builtin_amdgcn_readfirstlane(c.tid >> 6), fr = lane & 15, fq = lane >> 4;
    const int ec = 16 * (w & 3) + fr, e = 64 * hc + ec, ch = n * 128 + e, m0 = 2 * (w >> 2);
    const int chs = n * 128 + 64 * hc + cch;
    __syncthreads();
    if (c.tid < 128) CAR[c.tid] = 0.f;
    if (c.tid < 384) L[L_XBS + c.tid] = 0.f;
    f32x4 cwr[4][4], cbr[4];
#pragma unroll
    for (int j4 = 0; j4 < 4; ++j4) { cbr[j4] = *(const f32x4*)(a.in[15] + (size_t)l * D + n * 128 + c0 + 4 * j4);
#pragma unroll
        for (int j = 0; j < 4; ++j) cwr[j][j4] = *(const f32x4*)(a.in[14] + (size_t)l * 4 * D + j * D + n * 128 + c0 + 4 * j4); }
    bf16x8 Ba[4], Bx[4];
    { const bf16* wl = (const bf16*)(a.ws + WS_W + (size_t)l * WL_STRIDE);
      const bf16* wa = wl + OFF_LWA / 2 + (size_t)(n * 128 + e) * 128 + 8 * fq; const bf16* wx = wl + OFF_LWX / 2 + (size_t)(n * 128 + e) * 128 + 8 * fq;
#pragma unroll
      for (int ks = 0; ks < 4; ++ks) { Ba[ks] = *(const bf16x8*)(wa + 32 * ks); Bx[ks] = *(const bf16x8*)(wx + 32 * ks); } }
    const float ba = a.in[17][(size_t)l * D + ch], bx = a.in[19][(size_t)l * D + ch], sp8 = -8.0f * ((const float*)(a.ws + WS_TAB + 32768))[l * D + ch];
    const bf16* xsrc = XB + (size_t)(b * SEQ + t_ld) * D + n * 128 + c0;
    u32x4 xr0 = *(const u32x4*)xsrc, xr1 = *(const u32x4*)(xsrc + 8);
    for (int t0 = 0; t0 < SEQ; t0 += 64) {
        const int par = (t0 >> 6) & 1;
        unsigned ygr[8];
        { const bf16* yp = YG + (size_t)(b * SEQ + t0 + sg * 8) * D + chs;
#pragma unroll
          for (int tt = 0; tt < 8; ++tt) ygr[tt] = yp[(size_t)tt * D]; }
        WG_BAR();
        { LAS float* dst = L + L_XBS + (3 + t_ld) * 128 + c0;
          *(LAS f32x4*)dst        = (f32x4){bf2f(xr0.x & 0xffffu), bf2f(xr0.x >> 16), bf2f(xr0.y & 0xffffu), bf2f(xr0.y >> 16)};
          *(LAS f32x4*)(dst + 4)  = (f32x4){bf2f(xr0.z & 0xffffu), bf2f(xr0.z >> 16), bf2f(xr0.w & 0xffffu), bf2f(xr0.w >> 16)};
          *(LAS f32x4*)(dst + 8)  = (f32x4){bf2f(xr1.x & 0xffffu), bf2f(xr1.x >> 16), bf2f(xr1.y & 0xffffu), bf2f(xr1.y >> 16)};
          *(LAS f32x4*)(dst + 12) = (f32x4){bf2f(xr1.z & 0xffffu), bf2f(xr1.z >> 16), bf2f(xr1.w & 0xffffu), bf2f(xr1.w >> 16)}; }
        if (t0 + 64 < SEQ) { xr0 = *(const u32x4*)(xsrc + (size_t)(t0 + 64) * D); xr1 = *(const u32x4*)(xsrc + (size_t)(t0 + 64) * D + 8); }
        WG_BAR();
#pragma unroll
        for (int j4 = 0; j4 < 4; ++j4) { const int cc = c0 + 4 * j4;
            f32x4 acc = cbr[j4];
#pragma unroll
            for (int j = 0; j < 4; ++j) acc += cwr[j][j4] * *(const LAS f32x4*)(L + L_XBS + (t_ld + j) * 128 + cc);
            *(LAS f32x4*)(L + L_XC + t_ld * 128 + cc) = acc;
            { u32x2 pw; pw.x = pk2(acc[0], acc[1]); pw.y = pk2(acc[2], acc[3]); *(LAS u32x2*)(c.lds + LB_XCB + t_ld * XCB_STRIDE + cc * 2) = pw; } }
        WG_BAR();
#pragma unroll
        for (int mm = 0; mm < 2; ++mm) {
            const int m = m0 + mm;
            f32x4 ar = (f32x4){0.f, 0.f, 0.f, 0.f}, ai = (f32x4){0.f, 0.f, 0.f, 0.f};
#pragma unroll
            for (int ks = 0; ks < 4; ++ks) {
                const bf16x8 af = *(const LAS bf16x8*)(c.lds + LB_XCB + (16 * m + fr) * XCB_STRIDE + (32 * ks + 8 * fq) * 2);
                ar = __builtin_amdgcn_mfma_f32_16x16x32_bf16(af, Ba[ks], ar, 0, 0, 0);
                ai = __builtin_amdgcn_mfma_f32_16x16x32_bf16(af, Bx[ks], ai, 0, 0, 0);
            }
#pragma unroll
            for (int j = 0; j < 4; ++j) {
                const int t = 16 * m + 4 * fq + j;
                const float r = sig_fast(ar[j] + ba), ig = sig_fast(ai[j] + bx);
                const float la = sp8 * r, x2 = 2.0f * la;
                const float em = x2 > -0.5f ? x2 * (1.0f + x2 * (0.5f + x2 * (0.16666667f + x2 * (0.041666668f + x2 * 0.0083333338f)))) : __expf(x2) - 1.0f;
                As[t * 64 + ec] = __expf(la); Bs[t * 64 + ec] = __builtin_amdgcn_sqrtf(-em) * ig * L[L_XC + t * 128 + e];
            }
        }
        WG_BAR();
        float P = 1.f, Bv = 0.f;
#pragma unroll
        for (int tt = 0; tt < 8; ++tt) { const float aa = As[(sg * 8 + tt) * 64 + cch], bb = Bs[(sg * 8 + tt) * 64 + cch]; Bv = aa * Bv + bb; P *= aa; }
        SEG[(sg * 64 + cch) * 2] = P; SEG[(sg * 64 + cch) * 2 + 1] = Bv;
        WG_BAR();
        float h = CAR[par * 64 + cch];
        for (int s2 = 0; s2 < sg; ++s2) h = SEG[(s2 * 64 + cch) * 2] * h + SEG[(s2 * 64 + cch) * 2 + 1];
        { bf16* op = OB + (size_t)(b * SEQ + t0 + sg * 8) * D + chs;
#pragma unroll
          for (int tt = 0; tt < 8; ++tt) { const int t = sg * 8 + tt;
              h = As[t * 64 + cch] * h + Bs[t * 64 + cch];
              op[(size_t)tt * D] = (bf16)f2bf(h * bf2f(ygr[tt])); } }
        if (sg == 7) CAR[(par ^ 1) * 64 + cch] = h;
        if (c.tid < 384) L[L_XBS + c.tid] = L[L_XBS + 64 * 128 + c.tid];
    }
    __syncthreads();
    if (c.tid < 64) a.out[O_LRP + ((size_t)l * NBATCH + b) * D + n * 128 + 64 * hc + c.tid] = CAR[c.tid];
    if (hc == 0 && c.tid < 384) a.out[O_CVP + (((size_t)l * NBATCH + b) * 3 + (c.tid >> 7)) * D + n * 128 + (c.tid & 127)] = L[L_XBS + c.tid];
    __syncthreads();
}
__device__ __forceinline__ void lru_sample_item(CArgs& a, Ctx& c, int l, int n, int hf) {
    LAS float* L = (LAS float*)c.lds;
    const bf16* XB = (const bf16*)(a.ws + WS_XB); const bf16* YG = (const bf16*)(a.ws + WS_YG); bf16* OB = (bf16*)(a.ws + WS_OB);
    const int t_ld = c.tid >> 3, c0 = (c.tid & 7) * 16;
    const float* cw = a.in[14] + (size_t)l * 4 * D + n * 128; const float* cb = a.in[15] + (size_t)l * D + n * 128;
    const int bs = hf * 64 + t_ld, row = MP + bs;
    const float* sc = a.in[4] + ((size_t)l * NS + bs) * 3 * D + n * 128;
    float* nc = a.out + O_CVS + ((size_t)l * NS + bs) * 3 * D + n * 128;
    __syncthreads();
#pragma unroll
    for (int j4 = 0; j4 < 4; ++j4) { const int cc = c0 + 4 * j4;
        const f32x4 x = ld_bf4(XB + (size_t)row * D + n * 128 + cc);
        const f32x4 s0 = *(const f32x4*)(sc + cc), s1 = *(const f32x4*)(sc + D + cc), s2 = *(const f32x4*)(sc + 2 * D + cc);
        const f32x4 acc = *(const f32x4*)(cb + cc) + *(const f32x4*)(cw + cc) * s0 + *(const f32x4*)(cw + D + cc) * s1 + *(const f32x4*)(cw + 2 * D + cc) * s2 + *(const f32x4*)(cw + 3 * D + cc) * x;
        *(LAS f32x4*)(L + L_XC + t_ld * 128 + cc) = acc;
        { u32x2 w; w.x = pk2(acc[0], acc[1]); w.y = pk2(acc[2], acc[3]); *(LAS u32x2*)(c.lds + LB_XCB + t_ld * XCB_STRIDE + cc * 2) = w; }
        *(f32x4*)(nc + cc) = s1; *(f32x4*)(nc + D + cc) = s2; *(f32x4*)(nc + 2 * D + cc) = x; }
    __syncthreads();
    lru_gates(a, c, l, n);
    __syncthreads();
    { const int cch = c.tid & 127, tg = c.tid >> 7;
#pragma unroll 4
      for (int tt = 0; tt < 16; ++tt) { const int t = tg * 16 + tt, b2 = hf * 64 + t; const size_t off = (size_t)(MP + b2) * D + n * 128 + cch;
          const float h0 = a.in[3][((size_t)l * NS + b2) * D + n * 128 + cch];
          const float h = L[L_AS + t * 128 + cch] * h0 + L[L_BS + t * 128 + cch];
          a.out[O_LRS + ((size_t)l * NS + b2) * D + n * 128 + cch] = h;
          OB[off] = (bf16)f2bf(h * bf2f(YG[off])); } }
    __syncthreads();
}

__device__ __forceinline__ void mixer_phase(CArgs& a, Ctx& c, int l) {
    if (c.wg < 64) {
        hgrn_fast_prompt(a, c, l, c.wg >> 3, c.wg & 7);
    } else if (c.wg < 192) {
        const int i = c.wg - 64;
        for (int rep = 0; rep < 1 + ((PROBE_MIX >> 1) & 1); ++rep) lru_prompt_item(a, c, l, i >> 4, (i >> 1) & 7, i & 1);
    } else {
        for (int rep = 0; rep < 1 + ((PROBE_MIX >> 2) & 1); ++rep)
        for (int it = c.wg - 192; it < NS * NH; it += c.G - 192) {
            const int bs = it >> 3, h = it & 7; const size_t so = (((size_t)l * NS + bs) * NH + h) * DKV * DKV;
            hgrn_naive(a, c, l, MP + bs, 1, h, a.in[2] + so, a.out + O_HGS + so);
        }
        if (c.wg - 192 < 16) lru_sample_item(a, c, l, (c.wg - 192) >> 1, (c.wg - 192) & 1);
    }
}

__global__ void __launch_bounds__(512, 2) mega_fwd(Args a0) {
    extern __shared__ __attribute__((aligned(16))) unsigned char lds_raw[];
    Ctx c; c.lds = (LAS unsigned char*)lds_raw; c.tid = threadIdx.x; c.G = gridDim.x; c.wg = blockIdx.x;
    volatile LAS unsigned* MISC = (volatile LAS unsigned*)(c.lds + MISC_OFF);
    if (c.tid < 32) MISC[c.tid] = 0u;
    __syncthreads();
    XcdBarrier bar; bar.bar = (unsigned*)(a0.ws + WS_CTL) + 1024; bar.x = 0; bar.st = nullptr;
    const int nprog = a0.nprog;
    if (nprog > 1) bar = xcd_barrier_post((unsigned*)(a0.ws + WS_CTL) + 1024, MISC + 8);

    for (int pi = 0; pi < nprog; ++pi) {
        CArgs* ap = (CArgs*)__builtin_amdgcn_kernarg_segment_ptr(); asm volatile("" : "+s"(ap));
        CArgs& a = *ap;
        const int ph = a.prog[pi];
        unsigned long long pt0 = 0ull; if (PROBE_T >= 100 && ph == PROBE_T - 100) pt0 = __builtin_amdgcn_s_memrealtime();
        { int t_ = threadIdx.x, w_ = blockIdx.x, g_ = gridDim.x; asm volatile("" : "+v"(t_), "+s"(w_), "+s"(g_)); c.tid = t_; c.wg = w_; c.G = g_; }
        float* X = a.out;
        if (ph == 0) { }
        else if (ph == NPHASE - 1) final_norm_phase(a, c);
        else {
            const int l = (ph - 1) / 9, j = (ph - 1) % 9;
            const bf16* wl = (const bf16*)(a.ws + WS_W + (size_t)l * WL_STRIDE);
            const float* xp = l == 0 ? a.in[0] : X; const float* xs = l == 0 ? a.in[1] : X + (size_t)MP * D;
            const float* modl = (const float*)(a.ws + WS_MOD) + (size_t)l * NMOD * 6144;
            bf16* H = (bf16*)(a.ws + WS_H);
            if (j == 0) norm_phase(a, c, l, 0, xp, xs);
            else if (j == 1) {
                EpiIn e{a.ws + WS_PREP, (bf16*)(a.ws + WS_SQ), (bf16*)(a.ws + WS_SK), (float*)(a.ws + WS_SLOGF), (bf16*)(a.ws + WS_V), (bf16*)(a.ws + WS_OG), (bf16*)(a.ws + WS_XB), (bf16*)(a.ws + WS_YG), (bf16*)(a.ws + WS_SGA), (bf16*)(a.ws + WS_SGB),
                        (const float*)(a.ws + WS_TAB) + (size_t)l * 3 * D, l == 0 ? 1 : 0};
                gemm_phase_sel<0>(c, H, wl + OFF_WIN / 2, MT, NIN, D, e);
            } else if (j == 2) hgrn_prep_phase(a, c);
            else if (j == 3) mixer_phase(a, c, l);
            else if (j == 4) {
                EpiBrA ea{(const bf16*)(a.ws + WS_SGA), (float*)(a.ws + WS_T)};
                EpiBrB eb{(const bf16*)(a.ws + WS_SGB), (const float*)(a.ws + WS_T), (bf16*)(a.ws + WS_MG)};
                {
                    pg8::Gemm g{(const bf16*)(a.ws + WS_OA), wl + OFF_WA / 2, MP, D, D, (const bf16*)(a.ws + WS_OB), wl + OFF_WB / 2};
                    PowOrder S; S.init(2, c.G, c.wg, 1);
                    EpiBranchUnit qe{(const bf16*)(a.ws + WS_SGA), (const bf16*)(a.ws + WS_SGB), (bf16*)(a.ws + WS_MG)};
                    pg8::gemm_phase<EpiBranchUnit, PowOrder, true, true>(c.lds, g, S, qe, c.tid);
                }
                { int t_ = threadIdx.x; asm volatile("" : "+v"(t_)); c.tid = t_; }
                sample_gemm_phase(c, (const bf16*)(a.ws + WS_OA), wl + OFF_WA / 2, D, D, ea);
                asm volatile("s_waitcnt vmcnt(0)" ::: "memory"); __syncthreads();
                sample_gemm_phase(c, (const bf16*)(a.ws + WS_OB), wl + OFF_WB / 2, D, D, eb);
            } else if (j == 5) {
                EpiRes e{xp, xs, X, modl, 2};
                gemm_phase_sel<3>(c, (const bf16*)(a.ws + WS_MG), wl + OFF_WO / 2, MT, D, D, e);
            } else if (j == 6) norm_phase(a, c, l, 1, X, X + (size_t)MP * D);
            else if (j == 7) { EpiFF1 e{(bf16*)(a.ws + WS_HM)}; gemm_phase_sel<4>(c, H, wl + OFF_W1 / 2, MT, FF, D, e); }
            else { float* XO = (l == 1 && XOUT_SCRATCH) ? (float*)(a.ws + WS_T) : X;
                   EpiRes e{X, X + (size_t)MP * D, XO, modl, 5}; gemm_phase_sel<5>(c, (const bf16*)(a.ws + WS_HM), wl + OFF_W2 / 2, MT, D, FF, e); }
        }
        if (ph == 0 || ((ph == 4 || ph == 13) && c.wg >= 192)) {
            { int t_ = threadIdx.x; asm volatile("" : "+v"(t_)); c.tid = t_; }
            p0_work(a, c, ph == 0 ? 0 : 1, ph == 0 ? c.wg : c.wg - 192, ph == 0 ? c.G : c.G - 192, ph == 0, ph == 0 ? 1 : (ph == 4 ? 2 : 3), ph != 13);
        }
        if (pi + 1 < nprog) xcd_barrier(bar);
        if (PROBE_T >= 100 && ph == PROBE_T - 100 && c.wg == 0 && threadIdx.x == 0) *(float*)(a.ws + WS_DBG) = (float)(__builtin_amdgcn_s_memrealtime() - pt0) * 1e-4f;
    }
}

extern "C" void kernel_launch(void* const* d_in, const int* in_sizes, int n_in, void* d_out, int out_size, void* d_ws, size_t ws_size, hipStream_t stream) {
    static int grid = 0;
    if (grid == 0) {
        if (n_in != 27 || out_size != (int)O_END || ws_size < WS_END) { fprintf(stderr, "kernel_launch: unexpected shapes (n_in %d out %d ws %zu)\n", n_in, out_size, ws_size); grid = -1; return; }
        int dev = 0, cus = 0, per_cu = 0;
        if (hipGetDevice(&dev) != hipSuccess || hipDeviceGetAttribute(&cus, hipDeviceAttributeMultiprocessorCount, dev) != hipSuccess) { grid = -1; return; }
        if (hipFuncSetAttribute((const void*)mega_fwd, hipFuncAttributeMaxDynamicSharedMemorySize, LDS_BYTES) != hipSuccess) { fprintf(stderr, "kernel_launch: hipFuncSetAttribute failed\n"); grid = -1; return; }
        if (hipOccupancyMaxActiveBlocksPerMultiprocessor(&per_cu, (const void*)mega_fwd, 512, LDS_BYTES) != hipSuccess || per_cu < 1) { fprintf(stderr, "kernel_launch: occupancy query failed (%d)\n", per_cu); (void)hipGetLastError(); per_cu = 1; }
        grid = cus * (per_cu < 1 ? 1 : 1);
        fprintf(stderr, "kernel_launch: cus %d per_cu %d grid %d\n", cus, per_cu, grid);
    }
    if (grid < 0) return;
    (void)hipMemsetAsync((char*)d_ws + WS_CTL, 0, CTL_BYTES, stream);
    Args a{};
    for (int i = 0; i < 27; ++i) a.in[i] = (const float*)d_in[i];
    a.out = (float*)d_out; a.ws = (unsigned char*)d_ws;
    unsigned char prog[60]; int np = 0;
    for (int ph = 0; ph < NPHASE; ++ph) for (int rep = 0; rep < 1 + (int)(((unsigned)PROBE_REPEAT >> ph) & 1u); ++rep) prog[np++] = (unsigned char)ph;
#if ONE_LAUNCH
    a.nprog = np; for (int i = 0; i < np; ++i) a.prog[i] = prog[i];
    void* kargs[] = {&a};
    hipError_t e = hipLaunchCooperativeKernel((const void*)mega_fwd, dim3(grid), dim3(512), kargs, LDS_BYTES, stream);
    if (e != hipSuccess) fprintf(stderr, "kernel_launch: cooperative launch failed: %s (grid %d)\n", hipGetErrorString(e), grid);
#else
    for (int i = 0; i < np; ++i) { a.nprog = 1; a.prog[0] = prog[i]; hipLaunchKernelGGL(mega_fwd, dim3(grid), dim3(512), LDS_BYTES, stream, a); }
#endif
}
```

```cpp
#include <hip/hip_runtime.h>
#include <cstdio>
#include <cstdint>

#ifndef FAST_GEMM
#define FAST_GEMM 63
#endif
#ifndef FAST_HGRN
#define FAST_HGRN 1
#endif
#ifndef FAST_GATES
#define FAST_GATES 1
#endif
#ifndef DBG_SHFL
#define DBG_SHFL 1
#endif
#ifndef PROBE_REPEAT
#define PROBE_REPEAT 0
#endif
#ifndef PROBE_MIX
#define PROBE_MIX 0
#endif
#ifndef PROBE_P0
#define PROBE_P0 0
#endif
#ifndef XOUT_SCRATCH
#define XOUT_SCRATCH 0
#endif
#ifndef PROBE_T
#define PROBE_T 0
#endif
#ifndef ONE_LAUNCH
#define ONE_LAUNCH 1
#endif

#define LAS __attribute__((address_space(3)))
#define GAS __attribute__((address_space(1)))
typedef unsigned short bf16;
typedef float f32x4 __attribute__((ext_vector_type(4)));
typedef float f32x2 __attribute__((ext_vector_type(2)));
typedef short bf16x8 __attribute__((ext_vector_type(8)));
typedef unsigned u32x4 __attribute__((ext_vector_type(4)));
typedef unsigned u32x2 __attribute__((ext_vector_type(2)));

constexpr int D = 1024, NBATCH = 8, SEQ = 2048, MP = NBATCH * SEQ, NS = 128, MR = MP + NS, MT = 16640;
constexpr int NMOD = NBATCH + NS;
constexpr int NIN = 8192, FF = 4096, NH = 8, DKV = 128;
constexpr float EPS = 1e-6f;
constexpr int NPHASE = 20;

constexpr size_t MiB = (size_t)1 << 20;
constexpr size_t WS_CTL = 0, CTL_BYTES = 64 * 1024;
constexpr size_t WS_DBG = 512 * 1024;
constexpr size_t WS_TAB = 1 * MiB;
constexpr size_t WS_MOD = 2 * MiB;
constexpr size_t WS_W = 9 * MiB, WL_STRIDE = 77 * MiB / 2;
constexpr size_t OFF_WIN = 0, OFF_WA = 16 * MiB, OFF_WB = 18 * MiB, OFF_WO = 20 * MiB, OFF_W1 = 22 * MiB, OFF_W2 = 30 * MiB, OFF_LWA = 38 * MiB, OFF_LWX = 38 * MiB + 256 * 1024;
constexpr size_t WS_H = 86 * MiB;
constexpr size_t WS_PREP = 119 * MiB;
constexpr size_t PREP_BLK = 65536;
constexpr size_t WS_V = 247 * MiB, WS_OG = 280 * MiB, WS_XB = 313 * MiB, WS_YG = 346 * MiB, WS_SGA = 379 * MiB, WS_SGB = 412 * MiB;
constexpr size_t WS_OA = 445 * MiB;
constexpr size_t WS_SQ = 478 * MiB, WS_SK = WS_SQ + 256 * 1024, WS_SLOGF = WS_SQ + 512 * 1024;
constexpr size_t WS_OB = WS_H;
constexpr size_t WS_T = WS_PREP;
constexpr size_t WS_MG = WS_PREP + 66 * MiB;
constexpr size_t WS_HM = WS_PREP;
constexpr size_t WS_END = 480 * MiB;
static_assert(WS_W + 2 * WL_STRIDE <= WS_H && WS_H + (size_t)MT * D * 2 <= WS_PREP && WS_PREP + 2048 * PREP_BLK <= WS_V && WS_T + (size_t)MT * D * 4 <= WS_MG && WS_MG + (size_t)MT * D * 2 <= WS_V
              && WS_HM + (size_t)MT * FF * 2 <= WS_OG && WS_OA + (size_t)MT * D * 2 <= WS_SQ && WS_SLOGF + 512 * 1024 <= WS_END, "ws map");

constexpr size_t O_YP = 0, O_YS = (size_t)MP * D, O_HGP = O_YS + (size_t)NS * D, O_LRP = O_HGP + (size_t)2 * NBATCH * NH * DKV * DKV, O_CVP = O_LRP + (size_t)2 * NBATCH * D,
                 O_HGS = O_CVP + (size_t)2 * NBATCH * 3 * D, O_LRS = O_HGS + (size_t)2 * NS * NH * DKV * DKV, O_CVS = O_LRS + (size_t)2 * NS * D, O_END = O_CVS + (size_t)2 * NS * 3 * D;
static_assert(O_END == 53673984, "out map");

constexpr int LDS_BYTES = 163840;
constexpr int MISC_OFF = 158 * 1024;

typedef __bf16 bf16x2_t __attribute__((ext_vector_type(2)));
__device__ __forceinline__ unsigned f2bf(float f) { return (unsigned)__builtin_bit_cast(unsigned short, (__bf16)f); }
__device__ __forceinline__ unsigned pk2(float lo, float hi) { return __builtin_bit_cast(unsigned, __builtin_convertvector((f32x2){lo, hi}, bf16x2_t)); }
__device__ __forceinline__ float bf2f(unsigned b) { return __builtin_bit_cast(float, b << 16); }
__device__ __forceinline__ f32x4 ld_bf4(const bf16* p) { const u32x2 w = *(const u32x2*)p; return (f32x4){bf2f(w.x & 0xffffu), bf2f(w.x >> 16), bf2f(w.y & 0xffffu), bf2f(w.y >> 16)}; }
__device__ __forceinline__ void st_bf4(bf16* p, f32x4 v) { u32x2 w; w.x = pk2(v[0], v[1]); w.y = pk2(v[2], v[3]); *(u32x2*)p = w; }
#define WG_BAR() do { asm volatile("s_waitcnt lgkmcnt(0)" ::: "memory"); __builtin_amdgcn_s_barrier(); asm volatile("" ::: "memory"); } while (0)
__device__ __forceinline__ float sig_fast(float x) { return __builtin_amdgcn_rcpf(1.0f + __expf(-x)); }
__device__ __forceinline__ void st_bf8(bf16* p, f32x4 v0, f32x4 v1) { u32x4 w; w.x = pk2(v0[0], v0[1]); w.y = pk2(v0[2], v0[3]); w.z = pk2(v1[0], v1[1]); w.w = pk2(v1[2], v1[3]); *(u32x4*)p = w; }
__device__ __forceinline__ void ld_bf8(const bf16* p, f32x4& v0, f32x4& v1) { const u32x4 w = *(const u32x4*)p; v0 = (f32x4){bf2f(w.x & 0xffffu), bf2f(w.x >> 16), bf2f(w.y & 0xffffu), bf2f(w.y >> 16)}; v1 = (f32x4){bf2f(w.z & 0xffffu), bf2f(w.z >> 16), bf2f(w.w & 0xffffu), bf2f(w.w >> 16)}; }
__device__ __forceinline__ float sigmoidf_(float x) { return 1.0f / (1.0f + __expf(-x)); }
__device__ __forceinline__ float siluf_(float x) { return x * sigmoidf_(x); }
__device__ __forceinline__ float gelu_tanh_(float x) { const float u = 0.7978845608028654f * (x + 0.044715f * x * x * x); return x * sigmoidf_(2.0f * u); }
__device__ __forceinline__ float softplusf_(float x) { return fmaxf(x, 0.f) + log1pf(expf(-fabsf(x))); }
template <int XM> __device__ __forceinline__ float swz_xor(float v) { return __builtin_bit_cast(float, __builtin_amdgcn_ds_swizzle(__builtin_bit_cast(int, v), (XM << 10) | 0x1f)); }
__device__ __forceinline__ int lane_id_fresh() { int l = (int)__builtin_amdgcn_mbcnt_hi(~0u, __builtin_amdgcn_mbcnt_lo(~0u, 0u)); asm volatile("" : "+v"(l)); return l; }
__device__ __forceinline__ float xchg(float v, int l, int m) { return __builtin_bit_cast(float, __builtin_amdgcn_ds_bpermute((l ^ m) << 2, __builtin_bit_cast(int, v))); }
template <int CTRL> __device__ __forceinline__ float dpp_f(float v) { return __builtin_bit_cast(float, __builtin_amdgcn_update_dpp(0, __builtin_bit_cast(int, v), CTRL, 0xf, 0xf, false)); }
__device__ __forceinline__ float row16_sum(float v) { v += dpp_f<0xB1>(v); v += dpp_f<0x4E>(v); v += dpp_f<0x141>(v); v += dpp_f<0x140>(v); return v; }
__device__ __forceinline__ float half_sum(float v) { const int l = lane_id_fresh(); v += xchg(v, l, 1); v += xchg(v, l, 2); v += xchg(v, l, 4); v += xchg(v, l, 8); v += xchg(v, l, 16); return v; }
__device__ __forceinline__ float wave_sum(float v) { const int l = lane_id_fresh(); v += xchg(v, l, 1); v += xchg(v, l, 2); v += xchg(v, l, 4); v += xchg(v, l, 8); v += xchg(v, l, 16); v += xchg(v, l, 32); return v; }
__device__ __forceinline__ int mod_row(int row) { return row < MP ? (row >> 11) : (NBATCH + row - MP); }

struct Args { const float* in[27]; float* out; unsigned char* ws; int nprog; unsigned char prog[60]; };
typedef const __attribute__((address_space(4))) Args CArgs;
struct Ctx { LAS unsigned char* lds; int tid, G, wg; };
namespace pg8 {
#define PG8_LAS __attribute__((address_space(3)))
typedef unsigned short bf16_t;
typedef short bf16x8 __attribute__((ext_vector_type(8)));
typedef float f32x4 __attribute__((ext_vector_type(4)));
typedef unsigned u32x4 __attribute__((ext_vector_type(4)));
constexpr int BM = 256, BK = 64, HALF = 128, HTB = HALF * BK * 2  , STAGE_BYTES = 8 * HTB, NXCD = 8, WGM = 8;

__host__ __device__ __forceinline__ int lds_byte(int r, int c) { const int st = (r >> 4) * 2 + (c >> 5), rr = r & 15, cc = c & 31, ob = rr * 64 + cc * 2; return st * 1024 + (ob ^ (((ob >> 9) & 1) << 5)); }
__host__ __device__ __forceinline__ void stage_rc(int b, int& R, int& C) { const int st = b / 1024, sb = b % 1024, swz = sb ^ (((sb >> 9) & 1) << 5); R = (st >> 1) * 16 + swz / 64; C = (st & 1) * 32 + (swz % 64) / 2; }
__host__ __device__ __forceinline__ int perm32(int rho) { const int n = rho >> 4, i = rho & 15; return 8 * (i >> 2) + 4 * n + (i & 3); }

struct Unit { int pm, pn, z; };
struct Gemm { const bf16_t* A; const bf16_t* Bt; int M, N, K; const bf16_t* A2; const bf16_t* Bt2; };

struct StaticOrder {
    int nM, nN, nwg, G, c;
    __host__ __device__ void init(int M, int N, int G_, int c_) { nM = M / BM; nN = N / BM; nwg = nM * nN; G = G_; c = c_; }
    __host__ __device__ bool next(int i, Unit& u) const {
        const long L = (long)i * G + c; if (L >= nwg) return false;
        int wgid = (int)L; { const int q = nwg / NXCD, r = nwg % NXCD, xcd = wgid % NXCD, off = wgid / NXCD; wgid = (xcd < r ? xcd * (q + 1) : r * (q + 1) + (xcd - r) * q) + off; }
        const int nig = WGM * nN, gid = wgid / nig, fm = gid * WGM, gsz = (nM - fm) < WGM ? (nM - fm) : WGM;
        u.pm = fm + ((wgid % nig) % gsz); u.pn = (wgid % nig) / gsz; u.z = 0; return true;
    }
    __device__ __forceinline__ void a_ready(const Unit&) const {}
    __device__ __forceinline__ void done(const Unit&) const {}
};
template <class Epi, class Sched, bool ALIGN_EPI = false, bool SP2 = false>
__device__ __forceinline__ void gemm_phase(PG8_LAS unsigned char* lds, const Gemm g, const Sched& S, const Epi& E, const int tid_in) {
    const int tid = tid_in, wid = __builtin_amdgcn_readfirstlane(tid >> 6), lane = tid & 63, wr = wid >> 2, wc = wid & 3, fr = lane & 15, fq = lane >> 4;
    const int K = g.K, nt = K / BK;
    unsigned voffA[2], voffB[2];
#pragma unroll
    for (int i = 0; i < 2; ++i) { int R, C; stage_rc(tid * 16 + i * 8192, R, C); const int Rb = Epi::PERM ? ((R & ~31) + perm32(R & 31)) : R;
        voffA[i] = (unsigned)(R * K + C) * 2u; voffB[i] = (unsigned)(Rb * K + C) * 2u; }
    const size_t kstep = (size_t)(BK * 2);
    const size_t hstep = (size_t)HALF * K * 2;
    const size_t tstep = 2 * hstep;
    const unsigned ldsw = (unsigned)wid * 1024u;
    const int aoff = lds_byte(wr * 64 + fr, fq * 8), boff = lds_byte(wc * 32 + fr, fq * 8);
#define PG8_SA(b, h) (((b) * 2 + (h)) * HTB)
#define PG8_SB(b, h) ((4 + (b) * 2 + (h)) * HTB)
#define PG8_STAGE(bufoff, gbase, voff) do { _Pragma("unroll") for (int _i = 0; _i < 2; ++_i) \
        __builtin_amdgcn_global_load_lds((const unsigned*)((const char*)(gbase) + (voff)[_i]), (PG8_LAS unsigned*)(lds + (bufoff) + ldsw + _i * 8192), 16, 0, 0); } while (0)
#define PG8_LDA(dst, b, h) do { _Pragma("unroll") for (int m = 0; m < 4; ++m) _Pragma("unroll") for (int k = 0; k < 2; ++k) dst[m][k] = *(const PG8_LAS bf16x8*)(lds + PG8_SA(b, h) + aoff + m * 2048 + k * 1024); } while (0)
#define PG8_LDB(dst, b, h) do { _Pragma("unroll") for (int n = 0; n < 2; ++n) _Pragma("unroll") for (int k = 0; k < 2; ++k) dst[n][k] = *(const PG8_LAS bf16x8*)(lds + PG8_SB(b, h) + boff + n * 2048 + k * 1024); } while (0)
#define PG8_MMA(ai, bj, At, Bt) do { __builtin_amdgcn_s_setprio(1); _Pragma("unroll") for (int m = 0; m < 4; ++m) _Pragma("unroll") for (int n = 0; n < 2; ++n) _Pragma("unroll") for (int k = 0; k < 2; ++k) \
        acc[ai][bj][m][n] = __builtin_amdgcn_mfma_f32_16x16x32_bf16(Bt[n][k], At[m][k], acc[ai][bj][m][n], 0, 0, 0); __builtin_amdgcn_s_setprio(0); } while (0)
#define PG8_WAIT_V(n) asm volatile("s_waitcnt vmcnt(" #n ")" ::: "memory")
#define PG8_WAIT_L(n) asm volatile("s_waitcnt lgkmcnt(" #n ")" ::: "memory")
#define PG8_BAR __builtin_amdgcn_s_barrier()
#define PG8_SCHED __builtin_amdgcn_sched_barrier(0)
    Unit cur, nxt; int ui = 0;
    if (!S.next(0, cur)) return;
    f32x4 acc[2][2][4][2];
#pragma unroll
    for (int a = 0; a < 2; ++a)
#pragma unroll
        for (int b = 0; b < 2; ++b)
#pragma unroll
            for (int m = 0; m < 4; ++m)
#pragma unroll
                for (int n = 0; n < 2; ++n) acc[a][b][m][n] = (f32x4){0.f, 0.f, 0.f, 0.f};
    bf16x8 At[4][2], B0[2][2], B1[2][2];
    const char* cA = (const char*)(cur.z ? g.A2 : g.A) + (size_t)cur.pm * tstep; const char* cB = (const char*)(cur.z ? g.Bt2 : g.Bt) + (size_t)cur.pn * tstep;
    S.a_ready(cur);
    if constexpr (SP2) {
        PG8_STAGE(PG8_SB(0, 0), cB, voffB); PG8_STAGE(PG8_SB(0, 1), cB + hstep, voffB); PG8_STAGE(PG8_SA(0, 0), cA, voffA); PG8_STAGE(PG8_SA(0, 1), cA + hstep, voffA);
        if (wr == 1) PG8_BAR;
        PG8_WAIT_V(2); PG8_BAR;
        PG8_STAGE(PG8_SB(1, 0), cB + kstep, voffB); PG8_STAGE(PG8_SA(1, 0), cA + kstep, voffA); PG8_STAGE(PG8_SB(1, 1), cB + hstep + kstep, voffB);
        PG8_WAIT_V(6); PG8_BAR;
    } else {
        PG8_STAGE(PG8_SB(0, 0), cB, voffB); PG8_STAGE(PG8_SA(0, 0), cA, voffA); PG8_STAGE(PG8_SB(0, 1), cB + hstep, voffB); PG8_STAGE(PG8_SA(0, 1), cA + hstep, voffA);
        if (wr == 1) PG8_BAR;
        PG8_WAIT_V(4); PG8_BAR;
        PG8_STAGE(PG8_SB(1, 0), cB + kstep, voffB); PG8_STAGE(PG8_SA(1, 0), cA + kstep, voffA); PG8_STAGE(PG8_SB(1, 1), cB + hstep + kstep, voffB);
        PG8_WAIT_V(6); PG8_BAR;
    }
    for (;;) {
        const bool has_next = S.next(ui + 1, nxt);
        const char* nA = has_next ? (const char*)(nxt.z ? g.A2 : g.A) + (size_t)nxt.pm * tstep : cA; const char* nB = has_next ? (const char*)(nxt.z ? g.Bt2 : g.Bt) + (size_t)nxt.pn * tstep : cB;
        for (int t = 0; t < nt; t += 2) {
            const bool last = (t == nt - 2);
            const char* a1 = cA + (size_t)(t + 1) * kstep;
            const char* a2 = last ? nA : cA + (size_t)(t + 2) * kstep; const char* b2 = last ? nB : cB + (size_t)(t + 2) * kstep;
            const char* a3 = a2 + kstep; const char* b3 = b2 + kstep;
            if (last && has_next) S.a_ready(nxt);
            if constexpr (SP2) {
            PG8_LDB(B0, 0, 0); PG8_LDB(B1, 0, 1); PG8_SCHED; PG8_LDA(At, 0, 0); PG8_STAGE(PG8_SA(1, 1), a1 + hstep, voffA);
            PG8_WAIT_V(8); PG8_WAIT_L(0); PG8_BAR; PG8_MMA(0, 0, At, B0); PG8_MMA(0, 1, At, B1); PG8_BAR; PG8_SCHED;
            PG8_LDA(At, 0, 1); PG8_STAGE(PG8_SB(0, 0), b2, voffB); PG8_STAGE(PG8_SB(0, 1), b2 + hstep, voffB); PG8_STAGE(PG8_SA(0, 0), a2, voffA);
            PG8_WAIT_V(8); PG8_WAIT_L(0); PG8_BAR; PG8_MMA(1, 0, At, B0); PG8_MMA(1, 1, At, B1); PG8_BAR; PG8_SCHED;
            PG8_LDB(B0, 1, 0); PG8_LDB(B1, 1, 1); PG8_SCHED; PG8_LDA(At, 1, 0); PG8_STAGE(PG8_SA(0, 1), a2 + hstep, voffA);
            PG8_WAIT_V(8); PG8_WAIT_L(0); PG8_BAR; PG8_MMA(0, 0, At, B0); PG8_MMA(0, 1, At, B1); PG8_BAR; PG8_SCHED;
            PG8_LDA(At, 1, 1); PG8_STAGE(PG8_SB(1, 0), b3, voffB); PG8_STAGE(PG8_SB(1, 1), b3 + hstep, voffB); PG8_STAGE(PG8_SA(1, 0), a3, voffA);
            PG8_WAIT_V(8); PG8_WAIT_L(0); PG8_BAR; PG8_MMA(1, 0, At, B0); PG8_MMA(1, 1, At, B1); PG8_BAR; PG8_SCHED;
            } else {
            PG8_LDB(B0, 0, 0); PG8_SCHED; PG8_LDA(At, 0, 0); PG8_STAGE(PG8_SA(1, 1), a1 + hstep, voffA);
            PG8_WAIT_L(8); PG8_BAR; PG8_WAIT_L(0); PG8_MMA(0, 0, At, B0); PG8_BAR; PG8_SCHED;
            PG8_LDB(B1, 0, 1); PG8_STAGE(PG8_SB(0, 0), b2, voffB);
            PG8_BAR; PG8_WAIT_L(0); PG8_MMA(0, 1, At, B1); PG8_BAR;
            PG8_LDA(At, 0, 1); PG8_STAGE(PG8_SA(0, 0), a2, voffA);
            PG8_BAR; PG8_WAIT_L(0); PG8_MMA(1, 0, At, B0); PG8_BAR; PG8_SCHED;
            PG8_STAGE(PG8_SB(0, 1), b2 + hstep, voffB);
            PG8_WAIT_V(6); PG8_BAR; PG8_MMA(1, 1, At, B1); PG8_BAR;
            PG8_LDB(B0, 1, 0); PG8_SCHED; PG8_LDA(At, 1, 0); PG8_STAGE(PG8_SA(0, 1), a2 + hstep, voffA);
            PG8_WAIT_L(8); PG8_BAR; PG8_WAIT_L(0); PG8_MMA(0, 0, At, B0); PG8_BAR; PG8_SCHED;
            PG8_LDB(B1, 1, 1); PG8_STAGE(PG8_SB(1, 0), b3, voffB);
            PG8_BAR; PG8_WAIT_L(0); PG8_MMA(0, 1, At, B1); PG8_BAR;
            PG8_LDA(At, 1, 1); PG8_STAGE(PG8_SA(1, 0), a3, voffA);
            PG8_BAR; PG8_WAIT_L(0); PG8_MMA(1, 0, At, B0); PG8_BAR; PG8_SCHED;
            PG8_STAGE(PG8_SB(1, 1), b3 + hstep, voffB);
            PG8_WAIT_V(6); PG8_BAR; PG8_MMA(1, 1, At, B1); PG8_BAR;
            }
        }
        if constexpr (ALIGN_EPI) { if (wr == 0) PG8_BAR; }
        if constexpr (!Epi::AFTER_DRAIN) { int l2 = (int)__builtin_amdgcn_mbcnt_hi(~0u, __builtin_amdgcn_mbcnt_lo(~0u, 0u)); asm volatile("" : "+v"(l2));
            E(acc, cur, wr, wc, l2 & 15, l2 >> 4); S.done(cur); }
        if (!has_next) break;
        if (!(Epi::KEEP && cur.z == 0)) {
#pragma unroll
        for (int a = 0; a < 2; ++a)
#pragma unroll
            for (int b = 0; b < 2; ++b)
#pragma unroll
                for (int m = 0; m < 4; ++m)
#pragma unroll
                    for (int n = 0; n < 2; ++n) acc[a][b][m][n] = (f32x4){0.f, 0.f, 0.f, 0.f};
        }
        cur = nxt; cA = nA; cB = nB; ++ui;
        if constexpr (ALIGN_EPI) { if (wr == 1) PG8_BAR; }
    }
    PG8_WAIT_V(0);
    if constexpr (!ALIGN_EPI) { if (wr == 0) PG8_BAR; }
    PG8_BAR;
    if constexpr (Epi::AFTER_DRAIN) { E.fused(acc, cur, wr, wc, fr, fq, lds, wid, lane); S.done(cur); }
#undef PG8_SA
#undef PG8_SB
#undef PG8_STAGE
#undef PG8_LDA
#undef PG8_LDB
#undef PG8_MMA
#undef PG8_WAIT_V
#undef PG8_WAIT_L
#undef PG8_BAR
#undef PG8_SCHED
}
}

template <class E> struct QuadEpi {
    static constexpr bool PERM = false, AFTER_DRAIN = false, KEEP = false;
    E e;
    __device__ __forceinline__ void operator()(const f32x4 (&acc)[2][2][4][2], const pg8::Unit& u, int wr, int wc, int fr, int fq) const {
        const int row0 = u.pm * 256 + wr * 64 + fr, col0 = u.pn * 256 + wc * 32 + 4 * fq;
#pragma unroll
        for (int ai = 0; ai < 2; ++ai)
#pragma unroll
            for (int m = 0; m < 4; ++m)
#pragma unroll
                for (int bj = 0; bj < 2; ++bj)
#pragma unroll
                    for (int n = 0; n < 2; ++n) e.quad(row0 + ai * 128 + m * 16, col0 + bj * 128 + n * 16, acc[ai][bj][m][n]);
    }
};

struct EpiIn {
    unsigned char* PREP; bf16 *SQ, *SK; float* SLOGF; bf16 *V, *OG, *XB, *YG, *SGA, *SGB; const float* lbt; int lb0;
    static constexpr bool BY_REGION = true;
    __device__ __forceinline__ size_t blk_off(int row, int cc) const { return (((size_t)(row >> 11) * 32 + ((row >> 6) & 31)) * 8 + (cc >> 7)) * PREP_BLK; }
    __device__ __forceinline__ bf16* q_ptr(int row, int cc) const { return row < MP ? (bf16*)(PREP + blk_off(row, cc) + 32768) + (row & 63) * 128 + (cc & 127) : SQ + (size_t)(row - MP) * D + cc; }
    __device__ __forceinline__ bf16* k_ptr(int row, int cc) const { return row < MP ? (bf16*)(PREP + blk_off(row, cc) + 49152) + (row & 63) * 128 + (cc & 127) : SK + (size_t)(row - MP) * D + cc; }
    __device__ __forceinline__ float* lf_ptr(int row, int cc) const { return row < MP ? (float*)(PREP + blk_off(row, cc)) + (row & 63) * 128 + (cc & 127) : SLOGF + (size_t)(row - MP) * D + cc; }
    __device__ __forceinline__ f32x2 fgate(float fa, float lb, float llb, float l1m) const {
        float lf, kk;
        const float t = __expf(-fabsf(fa));
        const float ls = fminf(fa, 0.f) - __logf(1.0f + t);
        const float sneg = (fa >= 0.f ? t : 1.0f) * __builtin_amdgcn_rcpf(1.0f + t);
        if (lb0) { lf = ls; kk = sneg; }
        else { const float b = l1m + ls, mx = fmaxf(llb, b); lf = mx + __logf(1.0f + __expf(-fabsf(llb - b))); kk = (1.0f - lb) * sneg; }
        return (f32x2){lf, kk};
    }
    template <int R> __device__ __forceinline__ f32x4 act(f32x4 v) const {
        f32x4 r;
#pragma unroll
        for (int j = 0; j < 4; ++j) {
            if constexpr (R == 0 || R == 3) r[j] = v[j] * sig_fast(v[j]);
            else if constexpr (R == 5) { const float x = v[j], u = 0.7978845608028654f * (x + 0.044715f * x * x * x); r[j] = x * sig_fast(2.0f * u); }
            else if constexpr (R >= 6) r[j] = sig_fast(v[j]);
            else r[j] = v[j];
        }
        return r;
    }
    template <int R> __device__ __forceinline__ bf16* dst(int row, int cc) const { return R == 0 ? q_ptr(row, cc) : (R == 2 ? V : R == 3 ? OG : R == 4 ? XB : R == 5 ? YG : R == 6 ? SGA : SGB) + (size_t)row * D + cc; }
    template <int R> __device__ __forceinline__ void quadR(int row, int cc, f32x4 v) const {
        const size_t o = (size_t)row * D + cc;
        if constexpr (R == 1) {
            const f32x4 lb = *(const f32x4*)(lbt + cc), llb = *(const f32x4*)(lbt + 1024 + cc), l1m = *(const f32x4*)(lbt + 2048 + cc);
            f32x4 lf, r;
#pragma unroll
            for (int j = 0; j < 4; ++j) { const f32x2 g = fgate(v[j], lb[j], llb[j], l1m[j]); lf[j] = g.x; r[j] = g.y; }
            *(f32x4*)lf_ptr(row, cc) = lf; (void)r;
        } else st_bf4(dst<R>(row, cc), act<R>(v));
    }
    template <int R> __device__ __forceinline__ void octR(int row, int cc, f32x4 v0, f32x4 v1) const {
        const size_t o = (size_t)row * D + cc;
        if constexpr (R == 1) {
            f32x4 lf0, lf1, r0, r1;
            if (lb0) {
#pragma unroll
                for (int j = 0; j < 4; ++j) { const f32x2 g0 = fgate(v0[j], 0.f, 0.f, 0.f), g1 = fgate(v1[j], 0.f, 0.f, 0.f); lf0[j] = g0.x; r0[j] = g0.y; lf1[j] = g1.x; r1[j] = g1.y; }
            } else {
                const f32x4 lba = *(const f32x4*)(lbt + cc), lbb = *(const f32x4*)(lbt + cc + 4), lla = *(const f32x4*)(lbt + 1024 + cc), llb_ = *(const f32x4*)(lbt + 1024 + cc + 4), l1a = *(const f32x4*)(lbt + 2048 + cc), l1b = *(const f32x4*)(lbt + 2048 + cc + 4);
#pragma unroll
                for (int j = 0; j < 4; ++j) { const f32x2 g0 = fgate(v0[j], lba[j], lla[j], l1a[j]), g1 = fgate(v1[j], lbb[j], llb_[j], l1b[j]); lf0[j] = g0.x; r0[j] = g0.y; lf1[j] = g1.x; r1[j] = g1.y; }
            }
            float* lp = lf_ptr(row, cc); *(f32x4*)lp = lf0; *(f32x4*)(lp + 4) = lf1; (void)r0; (void)r1;
        } else st_bf8(dst<R>(row, cc), act<R>(v0), act<R>(v1));
    }
    __device__ __forceinline__ void quad(int row, int col, f32x4 v) const {
        const int reg = col >> 10, cc = col & 1023;
        switch (reg) { case 0: quadR<0>(row, cc, v); break; case 1: quadR<1>(row, cc, v); break; case 2: quadR<2>(row, cc, v); break; case 3: quadR<3>(row, cc, v); break;
                       case 4: quadR<4>(row, cc, v); break; case 5: quadR<5>(row, cc, v); break; case 6: quadR<6>(row, cc, v); break; default: quadR<7>(row, cc, v); break; }
    }
};
struct EpiInUnit {
    static constexpr bool PERM = true, AFTER_DRAIN = false, KEEP = false;
    EpiIn e;
    template <int KIND> __device__ __forceinline__ void run(const f32x4 (&acc)[2][2][4][2], int row0, int cc0, bf16* dstp, int mode) const {
#pragma unroll
        for (int ai = 0; ai < 2; ++ai)
#pragma unroll
            for (int m = 0; m < 4; ++m) {
#pragma unroll
                for (int bj = 0; bj < 2; ++bj) {
                    const int row = row0 + ai * 128 + m * 16, cc = cc0 + bj * 128;
                    const f32x4 v0 = acc[ai][bj][m][0], v1 = acc[ai][bj][m][1];
                    if constexpr (KIND == 0) e.octR<1>(row, cc, v0, v1);
                    else if constexpr (KIND == 1) st_bf8(dstp + (size_t)row * D + cc, v0, v1);
                    else { f32x4 r0, r1;
#pragma unroll
                        for (int j = 0; j < 4; ++j) {
                            const float x0 = v0[j], x1 = v1[j];
                            const float a0 = mode == 1 ? 1.5957691216057308f * (x0 + 0.044715f * x0 * x0 * x0) : x0, a1 = mode == 1 ? 1.5957691216057308f * (x1 + 0.044715f * x1 * x1 * x1) : x1;
                            const float s0 = sig_fast(a0), s1 = sig_fast(a1);
                            r0[j] = mode == 2 ? s0 : x0 * s0; r1[j] = mode == 2 ? s1 : x1 * s1; }
                        st_bf8(dstp ? dstp + (size_t)row * D + cc : e.q_ptr(row, cc), r0, r1); }
                }
                asm volatile("" ::: "memory"); __builtin_amdgcn_sched_barrier(0); }
    }
    __device__ __forceinline__ void operator()(const f32x4 (&acc)[2][2][4][2], const pg8::Unit& u, int wr, int wc, int fr, int fq) const {
        const int row0 = u.pm * 256 + wr * 64 + fr, cc0 = (u.pn & 3) * 256 + wc * 32 + 8 * fq, reg = u.pn >> 2;
        if (reg == 1) run<0>(acc, row0, cc0, nullptr, 0);
        else if (reg == 2 || reg == 4) run<1>(acc, row0, cc0, reg == 2 ? e.V : e.XB, 0);
        else { bf16* dp = reg == 0 ? nullptr : reg == 3 ? e.OG : reg == 5 ? e.YG : reg == 6 ? e.SGA : e.SGB;
               run<2>(acc, row0, cc0, dp, reg == 5 ? 1 : (reg >= 6 ? 2 : 0)); }
    }
};
template <class E> struct OctEpi {
    static constexpr bool PERM = true, AFTER_DRAIN = false, KEEP = false;
    E e;
    __device__ __forceinline__ void operator()(const f32x4 (&acc)[2][2][4][2], const pg8::Unit& u, int wr, int wc, int fr, int fq) const {
        const int row0 = u.pm * 256 + wr * 64 + fr, col0 = u.pn * 256 + wc * 32 + 8 * fq;
#pragma unroll
        for (int ai = 0; ai < 2; ++ai)
#pragma unroll
            for (int m = 0; m < 4; ++m) {
#pragma unroll
                for (int bj = 0; bj < 2; ++bj) e.oct(row0 + ai * 128 + m * 16, col0 + bj * 128, acc[ai][bj][m][0], acc[ai][bj][m][1]);
                asm volatile("" ::: "memory"); __builtin_amdgcn_sched_barrier(0); }
    }
};
struct EpiBrA { static constexpr bool BY_REGION = false; const bf16* SGA; float* T;
    __device__ __forceinline__ void quad(int row, int col, f32x4 v) const { const size_t o = (size_t)row * D + col; *(f32x4*)(T + o) = ld_bf4(SGA + o) * v; }
    __device__ __forceinline__ void oct(int row, int col, f32x4 v0, f32x4 v1) const { const size_t o = (size_t)row * D + col; f32x4 g0, g1; ld_bf8(SGA + o, g0, g1); *(f32x4*)(T + o) = g0 * v0; *(f32x4*)(T + o + 4) = g1 * v1; } };
struct EpiBrB { static constexpr bool BY_REGION = false; const bf16* SGB; const float* T; bf16* MG;
    __device__ __forceinline__ void quad(int row, int col, f32x4 v) const { const size_t o = (size_t)row * D + col; st_bf4(MG + o, *(const f32x4*)(T + o) + ld_bf4(SGB + o) * v); }
    __device__ __forceinline__ void oct(int row, int col, f32x4 v0, f32x4 v1) const { const size_t o = (size_t)row * D + col; f32x4 g0, g1; ld_bf8(SGB + o, g0, g1);
        st_bf8(MG + o, *(const f32x4*)(T + o) + g0 * v0, *(const f32x4*)(T + o + 4) + g1 * v1); } };
struct EpiBranchUnit {
    static constexpr bool PERM = true, AFTER_DRAIN = false, KEEP = true;
    const bf16* SGA; const bf16* SGB; bf16* MG;
    __device__ __forceinline__ void operator()(const f32x4 (&acc_c)[2][2][4][2], const pg8::Unit& u, int wr, int wc, int fr, int fq) const {
        f32x4 (&acc)[2][2][4][2] = const_cast<f32x4 (&)[2][2][4][2]>(acc_c);
        const int row0 = u.pm * 256 + wr * 64 + fr, col0 = u.pn * 256 + wc * 32 + 8 * fq;
#pragma unroll
        for (int ai = 0; ai < 2; ++ai)
#pragma unroll
            for (int m = 0; m < 4; ++m) {
#pragma unroll
                for (int bj = 0; bj < 2; ++bj) { const size_t o = (size_t)(row0 + ai * 128 + m * 16) * D + col0 + bj * 128;
                    f32x4 b0, b1; ld_bf8(SGB + o, b0, b1);
                    if (u.z == 0) { f32x4 a0, a1; ld_bf8(SGA + o, a0, a1);
#pragma unroll
                        for (int j = 0; j < 4; ++j) { acc[ai][bj][m][0][j] *= a0[j] * __builtin_amdgcn_rcpf(fmaxf(b0[j], 1e-30f)); acc[ai][bj][m][1][j] *= a1[j] * __builtin_amdgcn_rcpf(fmaxf(b1[j], 1e-30f)); } }
                    else st_bf8(MG + o, acc[ai][bj][m][0] * b0, acc[ai][bj][m][1] * b1); }
                asm volatile("" ::: "memory"); __builtin_amdgcn_sched_barrier(0); }
    }
};
struct EpiRes { static constexpr bool BY_REGION = false; const float* xp; const float* xs; float* X; const float* modl; int gi;
    __device__ __forceinline__ void quad(int row, int col, f32x4 v) const {
        if (row >= MR) return;
        const float* src = row < MP ? xp + (size_t)row * D : xs + (size_t)(row - MP) * D;
        const f32x4 g = *(const f32x4*)(modl + (size_t)mod_row(row) * 6144 + gi * 1024 + col);
        *(f32x4*)(X + (size_t)row * D + col) = *(const f32x4*)(src + col) + g * v;
    }
    __device__ __forceinline__ void oct(int row, int col, f32x4 v0, f32x4 v1) const { quad(row, col, v0); quad(row, col + 4, v1); } };
struct EpiFF1 { static constexpr bool BY_REGION = false; bf16* HM;
    __device__ __forceinline__ void quad(int row, int col, f32x4 v) const {
        f32x4 r;
#pragma unroll
        for (int j = 0; j < 4; ++j) { const float t = fmaxf(v[j], 0.f); r[j] = t * t; }
        st_bf4(HM + (size_t)row * FF + col, r);
    }
    __device__ __forceinline__ void oct(int row, int col, f32x4 v0, f32x4 v1) const {
        f32x4 r0, r1;
#pragma unroll
        for (int j = 0; j < 4; ++j) { const float t0 = fmaxf(v0[j], 0.f), t1 = fmaxf(v1[j], 0.f); r0[j] = t0 * t0; r1[j] = t1 * t1; }
        st_bf8(HM + (size_t)row * FF + col, r0, r1);
    } };

template <class E>
__device__ __forceinline__ void naive_gemm_phase(Ctx& c, const bf16* A, const bf16* Bt, int M, int N, int K, const E& e) {
    LAS float* As = (LAS float*)c.lds;
    LAS float* Bs = As + 32 * 132;
    const int ntm = M / 128, ntn = N / 128, tx = c.tid & 31, ty = c.tid >> 5;
    const int lr = c.tid >> 2, lk = (c.tid & 3) * 8;
    for (int tile = c.wg; tile < ntm * ntn; tile += c.G) {
        const int tm = tile % ntm, tn = tile / ntm;
        f32x4 acc[8];
#pragma unroll
        for (int i = 0; i < 8; ++i) acc[i] = (f32x4){0.f, 0.f, 0.f, 0.f};
        for (int k0 = 0; k0 < K; k0 += 32) {
            const u32x4 av = *(const u32x4*)(A + (size_t)(tm * 128 + lr) * K + k0 + lk);
            const u32x4 bv = *(const u32x4*)(Bt + (size_t)(tn * 128 + lr) * K + k0 + lk);
            __syncthreads();
#pragma unroll
            for (int j = 0; j < 4; ++j) {
                As[(lk + 2 * j) * 132 + lr] = bf2f(av[j] & 0xffffu); As[(lk + 2 * j + 1) * 132 + lr] = bf2f(av[j] >> 16);
                Bs[(lk + 2 * j) * 132 + lr] = bf2f(bv[j] & 0xffffu); Bs[(lk + 2 * j + 1) * 132 + lr] = bf2f(bv[j] >> 16);
            }
            __syncthreads();
#pragma unroll 8
            for (int k = 0; k < 32; ++k) {
                const f32x4 a0 = *(const LAS f32x4*)(As + k * 132 + ty * 8), a1 = *(const LAS f32x4*)(As + k * 132 + ty * 8 + 4);
                const f32x4 b = *(const LAS f32x4*)(Bs + k * 132 + tx * 4);
                acc[0] += a0[0] * b; acc[1] += a0[1] * b; acc[2] += a0[2] * b; acc[3] += a0[3] * b;
                acc[4] += a1[0] * b; acc[5] += a1[1] * b; acc[6] += a1[2] * b; acc[7] += a1[3] * b;
            }
        }
#pragma unroll
        for (int i = 0; i < 8; ++i) e.quad(tm * 128 + ty * 8 + i, tn * 128 + tx * 4, acc[i]);
    }
    __syncthreads();
}

struct PowOrder {
    int lgN, nwg, G, c, two;
    __device__ __forceinline__ void init(int lgN_, int G_, int c_, int two_ = 0) { lgN = lgN_; nwg = 64 << lgN_; G = G_; c = c_; two = two_; }
    __device__ __forceinline__ bool next(int i, pg8::Unit& u) const {
        const int ii = two ? (i >> 1) : i;
        const int L = ii * G + c; if (L >= nwg) return false;
        const int w = (L & 7) * (nwg >> 3) + (L >> 3), j = w & ((8 << lgN) - 1), gid = w >> (3 + lgN);
        u.pm = __builtin_amdgcn_readfirstlane(gid * 8 + (j & 7)); u.pn = __builtin_amdgcn_readfirstlane(j >> 3); u.z = two ? (i & 1) : 0; return true;
    }
    __device__ __forceinline__ void a_ready(const pg8::Unit&) const {}
    __device__ __forceinline__ void done(const pg8::Unit&) const {}
};
template <class E>
__device__ __forceinline__ void sample_gemm_phase(Ctx& c, const bf16* A, const bf16* Bt, int N, int K, const E& e) {
    LAS float* red = (LAS float*)c.lds;
    const int lane = c.tid & 63, w = __builtin_amdgcn_readfirstlane(c.tid >> 6), fr = lane & 15, fq = lane >> 4, chh = w & 1, kq = w >> 1;
    const bf16* As = A + (size_t)MP * K;
    const int kspan = K >> 2;
    for (int mu = c.G - 1 - c.wg; mu < (N >> 5); mu += c.G) {
        const int n0 = 32 * mu;
        f32x4 acc[8];
#pragma unroll
        for (int m = 0; m < 8; ++m) acc[m] = (f32x4){0.f, 0.f, 0.f, 0.f};
        const bf16* bp = Bt + (size_t)(n0 + 16 * chh + fr) * K + kq * kspan + 8 * fq;
        const bf16* ap = As + (size_t)fr * K + kq * kspan + 8 * fq;
#pragma unroll 2
        for (int k = 0; k < kspan; k += 32) {
            const bf16x8 bfr = *(const bf16x8*)(bp + k);
#pragma unroll
            for (int m = 0; m < 8; ++m) acc[m] = __builtin_amdgcn_mfma_f32_16x16x32_bf16(*(const bf16x8*)(ap + (size_t)(16 * m) * K + k), bfr, acc[m], 0, 0, 0);
        }
        __syncthreads();
#pragma unroll
        for (int m = 0; m < 8; ++m)
#pragma unroll
            for (int j = 0; j < 4; ++j) red[(kq * 128 + 16 * m + 4 * fq + j) * 32 + 16 * chh + fr] = acc[m][j];
        __syncthreads();
#pragma unroll
        for (int i = 0; i < 2; ++i) { const int q = c.tid + 512 * i, row = q >> 3, cq = (q & 7) * 4;
            const f32x4 v = *(const LAS f32x4*)(red + row * 32 + cq) + *(const LAS f32x4*)(red + (128 + row) * 32 + cq) + *(const LAS f32x4*)(red + (256 + row) * 32 + cq) + *(const LAS f32x4*)(red + (384 + row) * 32 + cq);
            e.quad(MP + row, n0 + cq, v); }
    }
    __syncthreads();
}

template <int SITE, class E>
__device__ __forceinline__ void gemm_phase_sel(Ctx& c, const bf16* A, const bf16* Bt, int M, int N, int K, const E& e) {
    if constexpr ((FAST_GEMM >> SITE) & 1) {
        pg8::Gemm g{A, Bt, MP, N, K, A, Bt}; PowOrder S; S.init(N == 1024 ? 2 : (N == 4096 ? 4 : 5), c.G, c.wg);
        if constexpr (E::BY_REGION) { EpiInUnit qe{e}; pg8::gemm_phase<EpiInUnit, PowOrder, true, true>(c.lds, g, S, qe, c.tid); }
        else { OctEpi<E> qe{e}; pg8::gemm_phase<OctEpi<E>, PowOrder, true, true>(c.lds, g, S, qe, c.tid); }
        { int t_ = threadIdx.x; asm volatile("" : "+v"(t_)); c.tid = t_; }
        sample_gemm_phase(c, A, Bt, N, K, e);
    } else naive_gemm_phase(c, A, Bt, M, N, K, e);
}

#define XB_TMO      128
#define XB_XCNT(j)  (256  + 64 * (j))
#define XB_XSUB(j)  (1280 + 64 * (j))
#define XB_XGEN(j)  (2304 + 64 * (j))
#define XB_TOP      3328
#define XB_TOPGEN   3392
#define XCD_BAR_WORDS 3456
#define XB_SPIN_CAP (1u << 18)
__device__ __forceinline__ unsigned xb_ld(unsigned* p)              { return __hip_atomic_load(p, __ATOMIC_RELAXED, __HIP_MEMORY_SCOPE_AGENT); }
__device__ __forceinline__ unsigned xb_add(unsigned* p, unsigned v) { return __hip_atomic_fetch_add(p, v, __ATOMIC_RELAXED, __HIP_MEMORY_SCOPE_AGENT); }
__device__ __forceinline__ unsigned xb_xcc_id() { return (unsigned)__builtin_amdgcn_s_getreg((3 << 11) | 20) & 0xFu; }
#define XB_SPIN(cond, bar) do { unsigned _sp = 0; while (cond) { __builtin_amdgcn_s_sleep(1); \
    if ((++_sp & 255u) == 0u) { if (xb_ld(&(bar)[XB_TMO])) break; if (_sp > XB_SPIN_CAP) { atomicAdd(&(bar)[XB_TMO], 1u); break; } } } } while (0)
struct XcdBarrier { unsigned* bar; unsigned x; volatile LAS unsigned* st; };
__device__ __forceinline__ XcdBarrier xcd_barrier_post(unsigned* bar, volatile LAS unsigned* st) {
    XcdBarrier b; b.bar = bar; b.x = xb_xcc_id(); b.st = st;
    if (threadIdx.x == 0) (void)xb_add(&bar[XB_XCNT(b.x)], 1u);
    return b;
}
__device__ __forceinline__ void xcd_barrier_complete(unsigned* bar, unsigned x, unsigned& nloc, unsigned& nx) {
    const unsigned G = gridDim.x * gridDim.y * gridDim.z;
    unsigned sum, cnt, mine, sp = 0u;
    for (;;) {
        sum = 0u; cnt = 0u; mine = 0u;
#pragma unroll
        for (unsigned j = 0; j < 16; ++j) { const unsigned c = xb_ld(&bar[XB_XCNT(j)]); sum += c; cnt += (c > 0u) ? 1u : 0u; mine = (j == x) ? c : mine; }
        if (sum == G) break;
        __builtin_amdgcn_s_sleep(1);
        if ((++sp & 255u) == 0u) { if (xb_ld(&bar[XB_TMO])) break; if (sp > XB_SPIN_CAP) { atomicAdd(&bar[XB_TMO], 1u); break; } }
    }
    nloc = mine > 0u ? mine : 1u; nx = cnt > 0u ? cnt : 1u;
}
__device__ __forceinline__ void xcd_barrier(const XcdBarrier& b) {
    asm volatile("s_waitcnt vmcnt(0)" ::: "memory");
    __syncthreads();
    if (threadIdx.x == 0) {
        unsigned* bar = b.bar; asm volatile("" : "+s"(bar));
        __builtin_amdgcn_s_waitcnt(0);
        unsigned nloc = b.st[0], nx = b.st[1];
        if (nloc == 0u) { xcd_barrier_complete(bar, b.x, nloc, nx); b.st[0] = nloc; b.st[1] = nx; }
        const unsigned old = xb_add(&bar[XB_XSUB(b.x)], 1u);
        const unsigned gen = old / nloc;
        if (old + 1u == (gen + 1u) * nloc) {
            __builtin_amdgcn_fence(__ATOMIC_RELEASE, "agent");
            asm volatile("s_waitcnt vmcnt(0)" ::: "memory");
            const unsigned og = xb_add(&bar[XB_TOP], 1u);
            const unsigned tg = og / nx;
            if (og + 1u == (tg + 1u) * nx) xb_add(&bar[XB_TOPGEN], 1u);
            else XB_SPIN(xb_ld(&bar[XB_TOPGEN]) == tg, bar);
            __builtin_amdgcn_fence(__ATOMIC_ACQUIRE, "agent");
            xb_add(&bar[XB_XGEN(b.x)], 1u);
            asm volatile("s_waitcnt vmcnt(0)" ::: "memory");
        } else {
            XB_SPIN(xb_ld(&bar[XB_XGEN(b.x)]) == gen, bar);
            __builtin_amdgcn_fence(__ATOMIC_ACQUIRE, "agent");
            asm volatile("s_waitcnt vmcnt(0)" ::: "memory");
        }
    }
    __syncthreads();
}

__device__ __forceinline__ void p0_transpose_item(const float* W, int K, int N, bf16* WT, LAS float* scr, int item, int lane) {
    const int nblk = N / 32, kb = item / nblk, nb = item % nblk, k0 = 64 * kb, n0 = 32 * nb;
    float v[32];
#pragma unroll
    for (int i = 0; i < 32; ++i) v[i] = W[(size_t)(k0 + 2 * i + (lane >> 5)) * N + n0 + (lane & 31)];
#pragma unroll
    for (int i = 0; i < 32; ++i) scr[(2 * i + (lane >> 5)) * 33 + (lane & 31)] = v[i];
    asm volatile("s_waitcnt lgkmcnt(0)" ::: "memory");
    const int ch = lane & 7;
#pragma unroll
    for (int j = 0; j < 4; ++j) { const int n = (lane >> 3) + 8 * j; const LAS float* s = scr + (8 * ch) * 33 + n;
        u32x4 o; o.x = pk2(s[0 * 33], s[1 * 33]); o.y = pk2(s[2 * 33], s[3 * 33]); o.z = pk2(s[4 * 33], s[5 * 33]); o.w = pk2(s[6 * 33], s[7 * 33]);
        *(u32x4*)(WT + (size_t)(n0 + n) * K + k0 + 8 * ch) = o; }
    asm volatile("s_waitcnt lgkmcnt(0)" ::: "memory");
}
__device__ __forceinline__ void p0_work(CArgs& a, Ctx& c, int l, int vw, int nvw, bool with_tables, int tr_sel, bool do_mod) {
    if (tr_sel) {
        LAS float* scr = (LAS float*)(c.lds + __builtin_amdgcn_readfirstlane(c.tid >> 6) * 16384);
        const int gw = vw * 8 + __builtin_amdgcn_readfirstlane(c.tid >> 6), NGW = nvw * 8;
        constexpr int I_IN = 16 * 256, I_SQ = 16 * 32, I_1 = 16 * 128, I_2 = 64 * 32, I_L = 8 * 8, PER_L = I_IN + 3 * I_SQ + I_1 + I_2 + 2 * I_L, FF0 = I_IN + 3 * I_SQ, NFF = I_1 + I_2;
        const int nit = tr_sel == 1 ? PER_L + I_IN : (tr_sel == 2 ? 3 * I_SQ + 2 * I_L : NFF);
        for (int it = gw; it < nit; it += NGW) {
            int lt, r;
            if (tr_sel == 1) { lt = it < PER_L ? 0 : 1; r = it < PER_L ? it : it - PER_L; }
            else if (tr_sel == 2) { lt = 1; r = it < 3 * I_SQ ? I_IN + it : FF0 + NFF + (it - 3 * I_SQ); }
            else { lt = 1; r = FF0 + it; }
            bf16* wl = (bf16*)(a.ws + WS_W + (size_t)lt * WL_STRIDE);
            if (r < I_IN) { p0_transpose_item(a.in[11] + (size_t)lt * D * NIN, D, NIN, wl + OFF_WIN / 2, scr, r, (c.tid & 63)); continue; } r -= I_IN;
            if (r < I_SQ) { p0_transpose_item(a.in[21] + (size_t)lt * D * D, D, D, wl + OFF_WA / 2, scr, r, (c.tid & 63)); continue; } r -= I_SQ;
            if (r < I_SQ) { p0_transpose_item(a.in[22] + (size_t)lt * D * D, D, D, wl + OFF_WB / 2, scr, r, (c.tid & 63)); continue; } r -= I_SQ;
            if (r < I_SQ) { p0_transpose_item(a.in[23] + (size_t)lt * D * D, D, D, wl + OFF_WO / 2, scr, r, (c.tid & 63)); continue; } r -= I_SQ;
            if (r < I_1) { p0_transpose_item(a.in[24] + (size_t)lt * D * FF, D, FF, wl + OFF_W1 / 2, scr, r, (c.tid & 63)); continue; } r -= I_1;
            if (r < I_2) { p0_transpose_item(a.in[25] + (size_t)lt * FF * D, FF, D, wl + OFF_W2 / 2, scr, r, (c.tid & 63)); continue; } r -= I_2;
            if (r < I_L) { const int n = r >> 3; p0_transpose_item(a.in[16] + ((size_t)lt * 8 + n) * 16384, 128, 128, wl + OFF_LWA / 2 + n * 16384, scr, r & 7, (c.tid & 63)); continue; } r -= I_L;
            { const int n = r >> 3; p0_transpose_item(a.in[18] + ((size_t)lt * 8 + n) * 16384, 128, 128, wl + OFF_LWX / 2 + n * 16384, scr, r & 7, (c.tid & 63)); }
        }
    }
    if (with_tables) {
        float* lbt = (float*)(a.ws + WS_TAB); float* sp = (float*)(a.ws + WS_TAB + 32768);
        const int gid = vw * 512 + c.tid;
        if (gid < 2 * D) {
            const int ll = gid >> 10, col = gid & 1023;
            const float h0 = a.in[12][col], h1 = a.in[12][D + col];
            const float p1 = 1.0f / (1.0f + expf(h0 - h1));
            const float lb = ll == 0 ? 0.f : p1;
            lbt[(ll * 3 + 0) * D + col] = lb; lbt[(ll * 3 + 1) * D + col] = logf(fmaxf(lb, 1e-30f)); lbt[(ll * 3 + 2) * D + col] = log1pf(-lb);
            sp[ll * D + col] = softplusf_(-a.in[20][ll * D + col]);
        }
    }
    __syncthreads();
    if (!do_mod) return;
    {
        constexpr int CS_STRIDE = 272;
        LAS unsigned char* csb = c.lds;
        LAS float* ws = (LAS float*)(c.lds + 39168);
        float* MOD = (float*)(a.ws + WS_MOD);
        const int lane = c.tid & 63, w = __builtin_amdgcn_readfirstlane(c.tid >> 6), fr = lane & 15, fq = lane >> 4, ct = w & 1, rt0 = w >> 1;
        for (int item = vw; item < 192; item += nvw) {
            const float* W = a.in[7] + (size_t)l * D * 6144 + item * 32;
            f32x4 acc[3];
#pragma unroll
            for (int i = 0; i < 3; ++i) acc[i] = (f32x4){0.f, 0.f, 0.f, 0.f};
            f32x4 cv[9], wv[2];
#define MOD_LOAD(k0_) do { _Pragma("unroll") for (int i = 0; i < 9; ++i) { const int e4 = c.tid + 512 * i, r = e4 >> 5, kq = (e4 & 31) * 4; const int rr = r < NMOD ? r : 0; \
                const float* src = rr < NBATCH ? a.in[5] + (size_t)rr * D : a.in[6] + (size_t)(rr - NBATCH) * D; cv[i] = *(const f32x4*)(src + (k0_) + kq); } \
              _Pragma("unroll") for (int i = 0; i < 2; ++i) { const int e4 = c.tid + 512 * i, kk = e4 >> 3, c4 = (e4 & 7) * 4; wv[i] = *(const f32x4*)(W + (size_t)((k0_) + kk) * 6144 + c4); } } while (0)
            MOD_LOAD(0);
            for (int k0 = 0; k0 < D; k0 += 128) {
                __syncthreads();
#pragma unroll
                for (int i = 0; i < 9; ++i) { const int e4 = c.tid + 512 * i, r = e4 >> 5, kq = (e4 & 31) * 4;
                    u32x2 pw; pw.x = pk2(siluf_(cv[i][0]), siluf_(cv[i][1])); pw.y = pk2(siluf_(cv[i][2]), siluf_(cv[i][3]));
                    if (r >= NMOD) { pw.x = 0u; pw.y = 0u; }
                    *(LAS u32x2*)(csb + r * CS_STRIDE + kq * 2) = pw; }
#pragma unroll
                for (int i = 0; i < 2; ++i) { const int e4 = c.tid + 512 * i, kk = e4 >> 3, c4 = (e4 & 7) * 4;
                    ws[kk * 33 + c4] = wv[i][0]; ws[kk * 33 + c4 + 1] = wv[i][1]; ws[kk * 33 + c4 + 2] = wv[i][2]; ws[kk * 33 + c4 + 3] = wv[i][3]; }
                if (k0 + 128 < D) MOD_LOAD(k0 + 128);
                WG_BAR();
#pragma unroll
                for (int ks = 0; ks < 4; ++ks) {
                    const LAS float* wp = ws + (32 * ks + 8 * fq) * 33 + 16 * ct + fr;
                    u32x4 bw; bw.x = pk2(wp[0], wp[33]); bw.y = pk2(wp[66], wp[99]); bw.z = pk2(wp[132], wp[165]); bw.w = pk2(wp[198], wp[231]);
                    const bf16x8 bfr = __builtin_bit_cast(bf16x8, bw);
#pragma unroll
                    for (int i = 0; i < 3; ++i) { const int rt = rt0 + 4 * i;
                        if (rt < 9) acc[i] = __builtin_amdgcn_mfma_f32_16x16x32_bf16(*(const LAS bf16x8*)(csb + (16 * rt + fr) * CS_STRIDE + (32 * ks + 8 * fq) * 2), bfr, acc[i], 0, 0, 0); }
                }
            }
#undef MOD_LOAD
            const float bm = a.in[8][(size_t)l * 6144 + item * 32 + 16 * ct + fr];
#pragma unroll
            for (int i = 0; i < 3; ++i) { const int rt = rt0 + 4 * i;
                if (rt < 9) {
#pragma unroll
                    for (int j = 0; j < 4; ++j) { const int row = 16 * rt + 4 * fq + j; if (row < NMOD) MOD[((size_t)l * NMOD + row) * 6144 + item * 32 + 16 * ct + fr] = acc[i][j] + bm; } } }
        }
    }
    __syncthreads();
}

__device__ __forceinline__ void norm_phase(CArgs& a, Ctx& c, int l, int which, const float* xp, const float* xs) {
    const int gw = c.wg * 8 + __builtin_amdgcn_readfirstlane(c.tid >> 6), NGW = c.G * 8;
    bf16* H = (bf16*)(a.ws + WS_H);
    const float* MODL = (const float*)(a.ws + WS_MOD) + (size_t)l * NMOD * 6144;
    const float* g = a.in[which ? 10 : 9] + (size_t)l * D;
    for (int row = gw; row < MR; row += NGW) {
        const float* xr = row < MP ? xp + (size_t)row * D : xs + (size_t)(row - MP) * D;
        const float* md = MODL + (size_t)mod_row(row) * 6144 + (which ? 3 : 0) * 1024;
        f32x4 v[4]; float ss = 0.f;
#pragma unroll
        for (int j = 0; j < 4; ++j) { v[j] = *(const f32x4*)(xr + 4 * (c.tid & 63) + 256 * j); ss += (v[j][0] * v[j][0] + v[j][1] * v[j][1]) + (v[j][2] * v[j][2] + v[j][3] * v[j][3]); }
        const float rstd = 1.0f / sqrtf(wave_sum(ss) * (1.0f / D) + EPS);
#pragma unroll
        for (int j = 0; j < 4; ++j) { const int cc = 4 * (c.tid & 63) + 256 * j;
            const f32x4 gg = *(const f32x4*)(g + cc), sh = *(const f32x4*)(md + cc), sc = *(const f32x4*)(md + 1024 + cc);
            st_bf4(H + (size_t)row * D + cc, v[j] * rstd * gg * (1.0f + sc) + sh); }
    }
}
__device__ __forceinline__ void final_norm_phase(CArgs& a, Ctx& c) {
    const int gw = c.wg * 8 + __builtin_amdgcn_readfirstlane(c.tid >> 6), NGW = c.G * 8;
    const float* g = a.in[26];
    for (int row = gw; row < MR; row += NGW) {
        const float* xr = (XOUT_SCRATCH ? (const float*)(a.ws + WS_T) : (const float*)a.out) + (size_t)row * D; float* yr = a.out + (size_t)row * D;
        f32x4 v[4]; float ss = 0.f;
#pragma unroll
        for (int j = 0; j < 4; ++j) { v[j] = *(const f32x4*)(xr + 4 * (c.tid & 63) + 256 * j); ss += (v[j][0] * v[j][0] + v[j][1] * v[j][1]) + (v[j][2] * v[j][2] + v[j][3] * v[j][3]); }
        const float rstd = 1.0f / sqrtf(wave_sum(ss) * (1.0f / D) + EPS);
#pragma unroll
        for (int j = 0; j < 4; ++j) { const int cc = 4 * (c.tid & 63) + 256 * j; f32x4 y = v[j] * rstd * *(const f32x4*)(g + cc);
            if (PROBE_T && row == 0 && cc == 0) y[0] += *(const float*)(a.ws + WS_DBG);
            *(f32x4*)(yr + cc) = y; }
    }
}

__device__ __forceinline__ void hgrn_naive(CArgs& a, Ctx& c, int l, int row0, int ntok, int h, const float* S0, float* Sout) {
    LAS float* fs = (LAS float*)c.lds;
    LAS float* ks = fs + 2048;
    LAS float* qs = ks + 2048;
    LAS float* vs = qs + 2048;
    LAS float* part = vs + 2048;
    const bf16* Q = (const bf16*)(a.ws + WS_SQ) - (size_t)MP * D; const float* LOGF = (const float*)(a.ws + WS_SLOGF) - (size_t)MP * D;
    const bf16* V = (const bf16*)(a.ws + WS_V); const bf16* OG = (const bf16*)(a.ws + WS_OG); bf16* OA = (bf16*)(a.ws + WS_OA);
    const float* hg = a.in[13] + (size_t)l * DKV;
    const int v = c.tid & 127, kg = c.tid >> 7;
    float S[32];
#pragma unroll
    for (int i = 0; i < 32; ++i) S[i] = S0 ? S0[(size_t)(32 * kg + i) * DKV + v] : 0.f;
    for (int t0 = 0; t0 < ntok; t0 += 16) {
        const int nt = (ntok - t0) < 16 ? (ntok - t0) : 16;
        __syncthreads();
        { const int tt = c.tid >> 5, k4 = (c.tid & 31) * 4;
          if (tt < nt) { const size_t off = (size_t)(row0 + t0 + tt) * D + h * DKV + k4;
              const f32x4 lf = *(const f32x4*)(LOGF + off);
              *(LAS f32x4*)(fs + tt * 128 + k4) = (f32x4){expf(lf[0]), expf(lf[1]), expf(lf[2]), expf(lf[3])};
              *(LAS f32x4*)(ks + tt * 128 + k4) = (f32x4){1.0f - expf(lf[0]), 1.0f - expf(lf[1]), 1.0f - expf(lf[2]), 1.0f - expf(lf[3])};
              *(LAS f32x4*)(qs + tt * 128 + k4) = ld_bf4(Q + off);
              *(LAS f32x4*)(vs + tt * 128 + k4) = ld_bf4(V + off); } }
        __syncthreads();
        for (int tt = 0; tt < nt; ++tt) {
            const float vv = vs[tt * 128 + v]; float acc = 0.f;
#pragma unroll
            for (int i4 = 0; i4 < 8; ++i4) {
                const f32x4 f = *(const LAS f32x4*)(fs + tt * 128 + 32 * kg + 4 * i4), kk = *(const LAS f32x4*)(ks + tt * 128 + 32 * kg + 4 * i4), qq = *(const LAS f32x4*)(qs + tt * 128 + 32 * kg + 4 * i4);
#pragma unroll
                for (int j = 0; j < 4; ++j) { S[4 * i4 + j] = f[j] * S[4 * i4 + j] + kk[j] * vv; acc += S[4 * i4 + j] * qq[j]; }
            }
            part[(tt * 4 + kg) * 128 + v] = acc;
        }
        __syncthreads();
        { const int tt = c.tid >> 5, v4 = (c.tid & 31) * 4; const int tc = tt < nt ? tt : 0;
          const f32x4 o = *(const LAS f32x4*)(part + (tc * 4 + 0) * 128 + v4) + *(const LAS f32x4*)(part + (tc * 4 + 1) * 128 + v4)
                        + *(const LAS f32x4*)(part + (tc * 4 + 2) * 128 + v4) + *(const LAS f32x4*)(part + (tc * 4 + 3) * 128 + v4);
          float ss = (o[0] * o[0] + o[1] * o[1]) + (o[2] * o[2] + o[3] * o[3]);
          ss = half_sum(ss);
          const float rstd = 1.0f / sqrtf(ss * (1.0f / DKV) + EPS);
          if (tt < nt) { const size_t off = (size_t)(row0 + t0 + tt) * D + h * DKV + v4;
              st_bf4(OA + off, o * rstd * *(const f32x4*)(hg + v4) * ld_bf4(OG + off)); } }
    }
#pragma unroll
    for (int i = 0; i < 32; ++i) Sout[(size_t)(32 * kg + i) * DKV + v] = S[i];
    __syncthreads();
}


constexpr int HB_Q0 = 0, HB_K0 = 17408, HB_Q1 = 26112, HB_K1 = 34816, HB_KT0 = 43520, HB_KT1 = 53760, HB_VT = 64000, HB_AS = 82432, HB_ST = 91648, HB_VEC = 126464, HB_TOT = 128512, HB_SSQ = 130560;
constexpr int HS_Q = 272, HS_KT = 80, HS_VT = 144, HS_AS = 144;
static_assert(HB_SSQ + 2048 <= MISC_OFF && 64 * 132 * 4 <= HB_VEC - HB_ST, "hgrn lds");
__device__ __forceinline__ float exp_c(float x) { return __expf(fminf(x, 80.f)); }
__device__ __forceinline__ void hgrn_prep_phase(CArgs& a, Ctx& c) {
    LAS unsigned char* lds = c.lds;
    const int tid = c.tid, cp = tid & 63, sg = tid >> 6;
    LAS float* VEC = (LAS float*)(lds + HB_VEC); LAS float* TOT = (LAS float*)(lds + HB_TOT);
    f32x2 lf[8]; unsigned qr[8], vr[8];
#define PREP_LOAD(it_) do { const unsigned char* bp_ = a.ws + WS_PREP + (size_t)(it_) * PREP_BLK; const int e0_ = (8 * sg) * 128 + 2 * cp; \
        const bf16* vs_ = (const bf16*)(a.ws + WS_V) + ((size_t)((it_) >> 8) * SEQ + 64 * (((it_) >> 3) & 31)) * D + ((it_) & 7) * DKV; \
        _Pragma("unroll") for (int i = 0; i < 8; ++i) { lf[i] = *(const f32x2*)((const float*)bp_ + e0_ + i * 128); qr[i] = *(const unsigned*)((const bf16*)(bp_ + 32768) + e0_ + i * 128); \
            vr[i] = *(const unsigned*)(vs_ + (size_t)(8 * sg + i) * D + 2 * cp); } } while (0)
    if (c.wg < 2048) PREP_LOAD(c.wg);
    const int lane = tid & 63, w = __builtin_amdgcn_readfirstlane(tid >> 6), fr = lane & 15, fq = lane >> 4;
    for (int e = tid; e < 2 * 16 * 16; e += 512) { const int which = e >> 8, r = (e >> 4) & 15, cc = e & 15;
        *(LAS bf16*)(lds + HB_AS + ((which ? 32 : 0) + r) * HS_AS + ((which ? 48 : 16) + cc) * 2) = 0; }
    for (int it = c.wg; it < 2048; it += c.G) {
        unsigned char* bp = a.ws + WS_PREP + (size_t)it * PREP_BLK;
        const int pb = it >> 8, pn = (it >> 3) & 31, phh = it & 7;
        bf16* vslice = (bf16*)(a.ws + WS_V) + ((size_t)pb * SEQ + 64 * pn) * D + phh * DKV;
        f32x2 g[8], lfk[8]; g[0] = lf[0]; lfk[0] = lf[0];
#pragma unroll
        for (int i = 1; i < 8; ++i) { g[i] = g[i - 1] + lf[i]; lfk[i] = lf[i]; }
        WG_BAR();
        *(LAS f32x2*)(TOT + sg * 128 + 2 * cp) = g[7];
        WG_BAR();
        {
            f32x2 off = (f32x2){0.f, 0.f}, r0 = off, r1 = off, last = off;
#pragma unroll
            for (int s2 = 0; s2 < 8; ++s2) { const f32x2 tv = *(const LAS f32x2*)(TOT + s2 * 128 + 2 * cp);
                if (s2 < sg) off += tv; if (s2 < 2) r0 += tv; if (s2 < 6) r1 += tv; last += tv; }
            unsigned kt0[4], kt1[4], vt0[4], vt1[4];
#pragma unroll
            for (int i = 0; i < 8; ++i) {
                const f32x2 G = g[i] + off; const float q0 = bf2f(qr[i] & 0xffffu), q1 = bf2f(qr[i] >> 16), k0 = 1.0f - __expf(lfk[i].x), k1 = 1.0f - __expf(lfk[i].y);
                const int t = 8 * sg + i;
                *(LAS unsigned*)(lds + HB_Q0 + t * HS_Q + cp * 4) = pk2(q0 * exp_c(G.x - r0.x), q1 * exp_c(G.y - r0.y));
                if (sg < 4) *(LAS unsigned*)(lds + HB_K0 + t * HS_Q + cp * 4) = pk2(k0 * exp_c(r0.x - G.x), k1 * exp_c(r0.y - G.y));
                else { *(LAS unsigned*)(lds + HB_K1 + (t - 32) * HS_Q + cp * 4) = pk2(k0 * exp_c(r1.x - G.x), k1 * exp_c(r1.y - G.y));
                       *(LAS unsigned*)(lds + HB_Q1 + (t - 32) * HS_Q + cp * 4) = pk2(q0 * exp_c(G.x - r1.x), q1 * exp_c(G.y - r1.y)); }
                const unsigned kd = pk2(k0 * __expf(last.x - G.x), k1 * __expf(last.y - G.y));
                if (i & 1) { kt0[i >> 1] |= kd << 16; kt1[i >> 1] |= kd & 0xffff0000u; vt0[i >> 1] |= vr[i] << 16; vt1[i >> 1] |= vr[i] & 0xffff0000u; }
                else { kt0[i >> 1] = kd & 0xffffu; kt1[i >> 1] = kd >> 16; vt0[i >> 1] = vr[i] & 0xffffu; vt1[i >> 1] = vr[i] >> 16; }
            }
            { LAS unsigned char* p = lds + (sg < 4 ? HB_KT0 : HB_KT1) + (2 * cp) * HS_KT + (sg & 3) * 16;
              *(LAS u32x4*)p = (u32x4){kt0[0], kt0[1], kt0[2], kt0[3]}; *(LAS u32x4*)(p + HS_KT) = (u32x4){kt1[0], kt1[1], kt1[2], kt1[3]}; }
            { LAS unsigned char* p = lds + HB_VT + (2 * cp) * HS_VT + sg * 16;
              *(LAS u32x4*)p = (u32x4){vt0[0], vt0[1], vt0[2], vt0[3]}; *(LAS u32x4*)(p + HS_VT) = (u32x4){vt1[0], vt1[1], vt1[2], vt1[3]}; }
            if (sg == 0) *(LAS f32x2*)(VEC + 2 * cp) = (f32x2){exp_c(r0.x), exp_c(r0.y)};
            if (sg == 1) *(LAS f32x2*)(VEC + 128 + 2 * cp) = (f32x2){exp_c(last.x), exp_c(last.y)};
        }
        if (it + c.G < 2048) PREP_LOAD(it + c.G);
        WG_BAR();
#pragma unroll
        for (int rep = 0; rep < 2; ++rep) {
            const int id = w + 8 * rep;
            if (id < 10) {
                int tt, st;
                if (id == 0) { tt = 0; st = 0; } else if (id < 7) { tt = (id + 1) >> 1; st = (id + 1) & 1; } else if (id == 7) { tt = 2; st = 2; } else { tt = 3; st = id - 6; }
                const LAS unsigned char* ap = (st < 2) ? lds + HB_Q0 + (16 * tt + fr) * HS_Q : lds + HB_Q1 + (16 * (tt - 2) + fr) * HS_Q;
                const LAS unsigned char* bq = (st < 2) ? lds + HB_K0 + (16 * st + fr) * HS_Q : lds + HB_K1 + (16 * (st - 2) + fr) * HS_Q;
                f32x4 acc = (f32x4){0.f, 0.f, 0.f, 0.f};
#pragma unroll
                for (int ks = 0; ks < 4; ++ks) acc = __builtin_amdgcn_mfma_f32_16x16x32_bf16(*(const LAS bf16x8*)(ap + (32 * ks + 8 * fq) * 2), *(const LAS bf16x8*)(bq + (32 * ks + 8 * fq) * 2), acc, 0, 0, 0);
#pragma unroll
                for (int j = 0; j < 4; ++j) { const float v_ = (tt == st && fr > 4 * fq + j) ? 0.f : acc[j];
                    *(LAS bf16*)(lds + HB_AS + (16 * tt + 4 * fq + j) * HS_AS + (16 * st + fr) * 2) = (bf16)f2bf(v_); }
            }
        }
        WG_BAR();
#pragma unroll
        for (int i = 0; i < 2; ++i) { const int p = tid + 512 * i, row = p >> 4, pc = p & 15; *(u32x4*)(bp + row * 256 + pc * 16) = *(const LAS u32x4*)(lds + HB_Q0 + row * HS_Q + pc * 16); }
        { const int k = tid >> 2, pc = tid & 3;
          *(u32x4*)(bp + 16384 + k * 64 + pc * 16) = *(const LAS u32x4*)(lds + HB_KT0 + k * HS_KT + pc * 16);
          *(u32x4*)(bp + 24576 + k * 64 + pc * 16) = *(const LAS u32x4*)(lds + HB_KT1 + k * HS_KT + pc * 16); }
        { const int row = tid >> 3, pc = tid & 7; *(u32x4*)(bp + 32768 + row * 128 + pc * 16) = *(const LAS u32x4*)(lds + HB_AS + row * HS_AS + pc * 16); }
        if (tid < 64) *(u32x4*)(bp + 40960 + tid * 16) = *(const LAS u32x4*)(lds + HB_VEC + tid * 16);
#pragma unroll
        for (int i = 0; i < 2; ++i) { const int p = tid + 512 * i, v = p >> 3, pc = p & 7;
            *(u32x4*)((unsigned char*)(vslice + (size_t)(v >> 1) * D) + (v & 1) * 128 + pc * 16) = *(const LAS u32x4*)(lds + HB_VT + v * HS_VT + pc * 16); }
    }
#undef PREP_LOAD
    __syncthreads();
}

__device__ __forceinline__ void hgrn_fast_prompt(CArgs& a, Ctx& c, int l, int b, int h) {
    LAS unsigned char* lds = c.lds;
    const int tid = c.tid, lane = tid & 63, w = __builtin_amdgcn_readfirstlane(tid >> 6), fr = lane & 15, fq = lane >> 4;
    const int col = tid & 127, sg = tid >> 7;
    const bf16* V = (const bf16*)(a.ws + WS_V); const bf16* OG = (const bf16*)(a.ws + WS_OG); bf16* OA = (bf16*)(a.ws + WS_OA);
    const unsigned char* blk0 = a.ws + WS_PREP + ((size_t)b * 32 * 8 + h) * PREP_BLK;
    const size_t base = (size_t)b * SEQ * D + (size_t)h * DKV;
    LAS float* VEC = (LAS float*)(lds + HB_VEC); LAS float* SSQ = (LAS float*)(lds + HB_SSQ);
    LAS unsigned char* STw = lds + HB_ST + w * 4352;
    const float gv = a.in[13][(size_t)l * DKV + 16 * w + fr];
    f32x4 S[8];
#pragma unroll
    for (int i = 0; i < 8; ++i) S[i] = (f32x4){0.f, 0.f, 0.f, 0.f};
    __syncthreads();
    const int prow = tid >> 4, ppc = tid & 15, pk = tid >> 2, pkc = tid & 3;
    const bf16* vt0 = (const bf16*)(a.ws + WS_V) + (size_t)b * SEQ * D + h * DKV;
    const int orow = tid >> 4, oc8 = (tid & 15) * 8;
    const int arow = tid >> 3, apc = tid & 7;
    u32x4 im[8], ogv[2];
#define HG_LOAD(n_) do { const unsigned char* bp_ = blk0 + (size_t)(n_) * 8 * PREP_BLK; \
        im[0] = *(const u32x4*)(bp_ + prow * 256 + ppc * 16); im[1] = *(const u32x4*)(bp_ + (32 + prow) * 256 + ppc * 16); \
        im[2] = *(const u32x4*)(bp_ + 16384 + pk * 64 + pkc * 16); im[3] = *(const u32x4*)(bp_ + 24576 + pk * 64 + pkc * 16); \
        im[4] = *(const u32x4*)(bp_ + 32768 + arow * 128 + apc * 16); \
        if (tid < 64) im[5] = *(const u32x4*)(bp_ + 40960 + tid * 16); \
        _Pragma("unroll") for (int i = 0; i < 2; ++i) { const int p_ = tid + 512 * i, v_ = p_ >> 3, pc_ = p_ & 7; \
            im[6 + i] = *(const u32x4*)((const unsigned char*)(vt0 + (size_t)(64 * (n_) + (v_ >> 1)) * D) + (v_ & 1) * 128 + pc_ * 16); } } while (0)
    HG_LOAD(0);
    unsigned long long tacc = 0ull, tst = 0ull;
#define TSTART(id) do { if (PROBE_T == (id)) { __builtin_amdgcn_sched_barrier(0); tst = __builtin_amdgcn_s_memtime(); __builtin_amdgcn_sched_barrier(0); } } while (0)
#define TSTOP(id) do { if (PROBE_T == (id)) { __builtin_amdgcn_sched_barrier(0); tacc += __builtin_amdgcn_s_memtime() - tst; __builtin_amdgcn_sched_barrier(0); } } while (0)
    for (int nn = 0; nn < (SEQ / 64) * (1 + (PROBE_MIX & 1)); ++nn) {
        const int n = nn & (SEQ / 64 - 1);
        if (PROBE_MIX & 1) { if (nn == SEQ / 64) {
#pragma unroll
            for (int i = 0; i < 8; ++i) S[i] = (f32x4){0.f, 0.f, 0.f, 0.f}; } }
        TSTART(1); TSTART(2);
        *(LAS u32x4*)(lds + HB_Q0 + prow * HS_Q + ppc * 16) = im[0]; *(LAS u32x4*)(lds + HB_Q0 + (32 + prow) * HS_Q + ppc * 16) = im[1];
        *(LAS u32x4*)(lds + HB_KT0 + pk * HS_KT + pkc * 16) = im[2]; *(LAS u32x4*)(lds + HB_KT1 + pk * HS_KT + pkc * 16) = im[3];
        *(LAS u32x4*)(lds + HB_AS + arow * HS_AS + apc * 16) = im[4];
        if (tid < 64) *(LAS u32x4*)(lds + HB_VEC + tid * 16) = im[5];
#pragma unroll
        for (int i = 0; i < 2; ++i) { const int p = tid + 512 * i, v = p >> 3, pc = p & 7; *(LAS u32x4*)(lds + HB_VT + v * HS_VT + pc * 16) = im[6 + i]; }
        ogv[0] = *(const u32x4*)(OG + base + (size_t)(64 * n + orow) * D + oc8); ogv[1] = *(const u32x4*)(OG + base + (size_t)(64 * n + 32 + orow) * D + oc8);
        if ((PROBE_MIX & 1) || n + 1 < SEQ / 64) HG_LOAD((n + 1) & (SEQ / 64 - 1));
        WG_BAR();
        TSTOP(2); TSTART(3);
#pragma unroll
        for (int kt8 = 0; kt8 < 8; ++kt8) { const f32x4 er = *(const LAS f32x4*)(VEC + 16 * kt8 + 4 * fq);
            u32x2 pw; pw.x = pk2(S[kt8][0] * er[0], S[kt8][1] * er[1]); pw.y = pk2(S[kt8][2] * er[2], S[kt8][3] * er[3]);
            *(LAS u32x2*)(STw + fr * HS_Q + (16 * kt8 + 4 * fq) * 2) = pw; }
        f32x4 o[4];
#pragma unroll
        for (int tt = 0; tt < 4; ++tt) o[tt] = (f32x4){0.f, 0.f, 0.f, 0.f};
#pragma unroll
        for (int ks = 0; ks < 4; ++ks) { const bf16x8 bfr = *(const LAS bf16x8*)(STw + fr * HS_Q + (32 * ks + 8 * fq) * 2);
#pragma unroll
            for (int tt = 0; tt < 4; ++tt) o[tt] = __builtin_amdgcn_mfma_f32_16x16x32_bf16(*(const LAS bf16x8*)(lds + HB_Q0 + (16 * tt + fr) * HS_Q + (32 * ks + 8 * fq) * 2), bfr, o[tt], 0, 0, 0); }
        TSTOP(3); TSTART(4);
#pragma unroll
        for (int tt = 0; tt < 4; ++tt)
#pragma unroll
            for (int ks = 0; ks < 2; ++ks) if (ks == 0 || tt >= 2)
                o[tt] = __builtin_amdgcn_mfma_f32_16x16x32_bf16(*(const LAS bf16x8*)(lds + HB_AS + (16 * tt + fr) * HS_AS + (32 * ks + 8 * fq) * 2), *(const LAS bf16x8*)(lds + HB_VT + (16 * w + fr) * HS_VT + (32 * ks + 8 * fq) * 2), o[tt], 0, 0, 0);
#pragma unroll
        for (int tt = 0; tt < 4; ++tt)
#pragma unroll
            for (int j = 0; j < 4; ++j) { float p = o[tt][j] * o[tt][j];
                p = row16_sum(p);
                if (fr == 0) SSQ[w * 64 + 16 * tt + 4 * fq + j] = p; }
#pragma unroll
        for (int kt8 = 0; kt8 < 8; ++kt8) {
            const f32x4 eL = *(const LAS f32x4*)(VEC + 128 + 16 * kt8 + 4 * fq);
            f32x4 sn = eL * S[kt8];
            sn = __builtin_amdgcn_mfma_f32_16x16x32_bf16(*(const LAS bf16x8*)(lds + HB_KT0 + (16 * kt8 + fr) * HS_KT + 8 * fq * 2), *(const LAS bf16x8*)(lds + HB_VT + (16 * w + fr) * HS_VT + 8 * fq * 2), sn, 0, 0, 0);
            S[kt8] = __builtin_amdgcn_mfma_f32_16x16x32_bf16(*(const LAS bf16x8*)(lds + HB_KT1 + (16 * kt8 + fr) * HS_KT + 8 * fq * 2), *(const LAS bf16x8*)(lds + HB_VT + (16 * w + fr) * HS_VT + (32 + 8 * fq) * 2), sn, 0, 0, 0);
        }
        WG_BAR();
        TSTOP(4); TSTART(5);
        { LAS float* OUT = (LAS float*)(lds + HB_ST);
#pragma unroll
          for (int tt = 0; tt < 4; ++tt)
#pragma unroll
              for (int j = 0; j < 4; ++j) OUT[(16 * tt + 4 * fq + j) * 132 + 16 * w + fr] = o[tt][j] * gv;
          WG_BAR();
#pragma unroll
          for (int i = 0; i < 2; ++i) { const int t = orow + 32 * i;
              float ss = SSQ[t];
#pragma unroll
              for (int ww = 1; ww < 8; ++ww) ss += SSQ[ww * 64 + t];
              const float rstd = __builtin_amdgcn_rsqf(ss * (1.0f / DKV) + EPS);
              const f32x4 x0 = *(const LAS f32x4*)(OUT + t * 132 + oc8) * rstd, x1 = *(const LAS f32x4*)(OUT + t * 132 + oc8 + 4) * rstd;
              const u32x4 g_ = ogv[i];
              const f32x4 g0 = (f32x4){bf2f(g_.x & 0xffffu), bf2f(g_.x >> 16), bf2f(g_.y & 0xffffu), bf2f(g_.y >> 16)}, g1 = (f32x4){bf2f(g_.z & 0xffffu), bf2f(g_.z >> 16), bf2f(g_.w & 0xffffu), bf2f(g_.w >> 16)};
              st_bf8(OA + base + (size_t)(64 * n + t) * D + oc8, x0 * g0, x1 * g1); } }
        TSTOP(5); TSTOP(1);
    }
    if (PROBE_T && PROBE_T < 100 && l == 0 && c.wg == 0 && tid == 0) *(float*)(a.ws + WS_DBG) = (float)(tacc >> 5) * 1e-4f;
#undef HG_LOAD
    { float* Sout = a.out + O_HGP + (((size_t)l * NBATCH + b) * NH + h) * DKV * DKV;
#pragma unroll
      for (int kt8 = 0; kt8 < 8; ++kt8)
#pragma unroll
          for (int j = 0; j < 4; ++j) Sout[(size_t)(16 * kt8 + 4 * fq + j) * DKV + 16 * w + fr] = S[kt8][j]; }
    __syncthreads();
}

constexpr int L_XBS = 0, L_XC = 67 * 128, L_AS = L_XC + 8192, L_BS = L_AS + 8192, L_SEG = L_BS + 8192, L_CARRY = L_SEG + 1024;
constexpr int LB_XCB = (L_CARRY + 256) * 4, XCB_STRIDE = 272;
static_assert(LB_XCB + 64 * XCB_STRIDE <= MISC_OFF && LB_XCB % 16 == 0, "lru lds");
__device__ __forceinline__ void lru_gates_naive(CArgs& a, Ctx& c, int l, int n) {
    LAS float* XC = (LAS float*)c.lds + L_XC; LAS float* As = (LAS float*)c.lds + L_AS; LAS float* Bs = (LAS float*)c.lds + L_BS;
    const bf16* wl = (const bf16*)(a.ws + WS_W + (size_t)l * WL_STRIDE);
    const int e = c.tid & 127, tg = c.tid >> 7;
    const bf16* wa = wl + OFF_LWA / 2 + (size_t)(n * 128 + e) * 128; const bf16* wx = wl + OFF_LWX / 2 + (size_t)(n * 128 + e) * 128;
    const int ch = n * 128 + e;
    const float ba = a.in[17][(size_t)l * D + ch], bx = a.in[19][(size_t)l * D + ch], sp = ((const float*)(a.ws + WS_TAB + 32768))[l * D + ch];
#pragma unroll 1
    for (int tq = 0; tq < 4; ++tq) {
        float ra[4], ia[4];
#pragma unroll
        for (int i = 0; i < 4; ++i) { ra[i] = 0.f; ia[i] = 0.f; }
        const LAS float* xc = XC + (tg * 16 + tq * 4) * 128;
#pragma unroll 1
        for (int d0 = 0; d0 < 128; d0 += 8) {
            const f32x4 wa0 = ld_bf4(wa + d0), wa1 = ld_bf4(wa + d0 + 4), wx0 = ld_bf4(wx + d0), wx1 = ld_bf4(wx + d0 + 4);
#pragma unroll
            for (int tt = 0; tt < 4; ++tt) {
                const f32x4 x0 = *(const LAS f32x4*)(xc + tt * 128 + d0), x1 = *(const LAS f32x4*)(xc + tt * 128 + d0 + 4);
                ra[tt] += (x0[0] * wa0[0] + x0[1] * wa0[1]) + (x0[2] * wa0[2] + x0[3] * wa0[3]) + (x1[0] * wa1[0] + x1[1] * wa1[1]) + (x1[2] * wa1[2] + x1[3] * wa1[3]);
                ia[tt] += (x0[0] * wx0[0] + x0[1] * wx0[1]) + (x0[2] * wx0[2] + x0[3] * wx0[3]) + (x1[0] * wx1[0] + x1[1] * wx1[1]) + (x1[2] * wx1[2] + x1[3] * wx1[3]);
            }
        }
#pragma unroll
        for (int tt = 0; tt < 4; ++tt) {
            const int t = tg * 16 + tq * 4 + tt;
            const float r = sigmoidf_(ra[tt] + ba), ig = sigmoidf_(ia[tt] + bx);
            const float la = -8.0f * r * sp, aa = expf(la), mult = sqrtf(-expm1f(2.0f * la));
            As[t * 128 + e] = aa; Bs[t * 128 + e] = mult * ig * XC[t * 128 + e];
        }
    }
}
__device__ __forceinline__ void lru_gates_mfma(CArgs& a, Ctx& c, int l, int n) {
    LAS float* XC = (LAS float*)c.lds + L_XC; LAS float* As = (LAS float*)c.lds + L_AS; LAS float* Bs = (LAS float*)c.lds + L_BS;
    const bf16* wl = (const bf16*)(a.ws + WS_W + (size_t)l * WL_STRIDE);
    const int lane = c.tid & 63, w = __builtin_amdgcn_readfirstlane(c.tid >> 6), fr = lane & 15, fq = lane >> 4;
    const int e = 16 * w + fr, ch = n * 128 + e;
    const bf16* wa = wl + OFF_LWA / 2 + (size_t)(n * 128 + e) * 128 + 8 * fq; const bf16* wx = wl + OFF_LWX / 2 + (size_t)(n * 128 + e) * 128 + 8 * fq;
    bf16x8 Ba[4], Bx[4];
#pragma unroll
    for (int ks = 0; ks < 4; ++ks) { Ba[ks] = *(const bf16x8*)(wa + 32 * ks); Bx[ks] = *(const bf16x8*)(wx + 32 * ks); }
    const float ba = a.in[17][(size_t)l * D + ch], bx = a.in[19][(size_t)l * D + ch], sp = ((const float*)(a.ws + WS_TAB + 32768))[l * D + ch];
#pragma unroll
    for (int m = 0; m < 4; ++m) {
        f32x4 ar = (f32x4){0.f, 0.f, 0.f, 0.f}, ai = (f32x4){0.f, 0.f, 0.f, 0.f};
#pragma unroll
        for (int ks = 0; ks < 4; ++ks) {
            const bf16x8 af = *(const LAS bf16x8*)(c.lds + LB_XCB + (16 * m + fr) * XCB_STRIDE + (32 * ks + 8 * fq) * 2);
            ar = __builtin_amdgcn_mfma_f32_16x16x32_bf16(af, Ba[ks], ar, 0, 0, 0);
            ai = __builtin_amdgcn_mfma_f32_16x16x32_bf16(af, Bx[ks], ai, 0, 0, 0);
        }
#pragma unroll
        for (int j = 0; j < 4; ++j) {
            const int t = 16 * m + 4 * fq + j;
            const float r = sigmoidf_(ar[j] + ba), ig = sigmoidf_(ai[j] + bx);
            const float la = -8.0f * r * sp, aa = expf(la), mult = sqrtf(-expm1f(2.0f * la));
            As[t * 128 + e] = aa; Bs[t * 128 + e] = mult * ig * XC[t * 128 + e];
        }
    }
}
#if FAST_GATES
#define lru_gates lru_gates_mfma
#else
#define lru_gates lru_gates_naive
#endif

constexpr int LB_CW = LB_XCB + 64 * XCB_STRIDE;
static_assert(LB_CW + 2560 <= MISC_OFF, "lru lds");
__device__ __forceinline__ void lru_prompt_item(CArgs& a, Ctx& c, int l, int b, int n, int hc) {
    LAS float* L = (LAS float*)c.lds;
    LAS float* As = L + L_AS; LAS float* Bs = L + L_BS; LAS float* SEG = L + L_SEG; LAS float* CAR = L + L_CARRY;
    const bf16* XB = (const bf16*)(a.ws + WS_XB); const bf16* YG = (const bf16*)(a.ws + WS_YG); bf16* OB = (bf16*)(a.ws + WS_OB);
    const int t_ld = c.tid >> 3, c0 = (c.tid & 7) * 16;
    const int cch = c.tid & 63, sg = c.tid >> 6;
    const int lane = c.tid & 63, w = __builtin_amdgcn_readfirstlane(c.tid >> 6), fr = lane & 15, fq = lane >> 4;
    const int ec = 16 * (w & 3) + fr, e = 64 * hc + ec, ch = n * 128 + e, m0 = 2 * (w >> 2);
    const int chs = n * 128 + 64 * hc + cch;
    __syncthreads();
    if (c.tid < 128) CAR[c.tid] = 0.f;
    if (c.tid < 384) L[L_XBS + c.tid] = 0.f;
    f32x4 cwr[4][4], cbr[4];
#pragma unroll
    for (int j4 = 0; j4 < 4; ++j4) { cbr[j4] = *(const f32x4*)(a.in[15] + (size_t)l * D + n * 128 + c0 + 4 * j4);
#pragma unroll
        for (int j = 0; j < 4; ++j) cwr[j][j4] = *(const f32x4*)(a.in[14] + (size_t)l * 4 * D + j * D + n * 128 + c0 + 4 * j4); }
    bf16x8 Ba[4], Bx[4];
    { const bf16* wl = (const bf16*)(a.ws + WS_W + (size_t)l * WL_STRIDE);
      const bf16* wa = wl + OFF_LWA / 2 + (size_t)(n * 128 + e) * 128 + 8 * fq; const bf16* wx = wl + OFF_LWX / 2 + (size_t)(n * 128 + e) * 128 + 8 * fq;
#pragma unroll
      for (int ks = 0; ks < 4; ++ks) { Ba[ks] = *(const bf16x8*)(wa + 32 * ks); Bx[ks] = *(const bf16x8*)(wx + 32 * ks); } }
    const float ba = a.in[17][(size_t)l * D + ch], bx = a.in[19][(size_t)l * D + ch], sp8 = -8.0f * ((const float*)(a.ws + WS_TAB + 32768))[l * D + ch];
    const bf16* xsrc = XB + (size_t)(b * SEQ + t_ld) * D + n * 128 + c0;
    u32x4 xr0 = *(const u32x4*)xsrc, xr1 = *(const u32x4*)(xsrc + 8);
    unsigned long long tacc = 0ull, tst = 0ull;
#define LT0(id) do { if (PROBE_T == (id)) { __builtin_amdgcn_sched_barrier(0); tst = __builtin_amdgcn_s_memtime(); __builtin_amdgcn_sched_barrier(0); } } while (0)
#define LT1(id) do { if (PROBE_T == (id)) { __builtin_amdgcn_sched_barrier(0); tacc += __builtin_amdgcn_s_memtime() - tst; __builtin_amdgcn_sched_barrier(0); } } while (0)
    for (int t0 = 0; t0 < SEQ; t0 += 64) {
        const int par = (t0 >> 6) & 1;
        LT0(10); LT0(11);
        unsigned ygr[8];
        { const bf16* yp = YG + (size_t)(b * SEQ + t0 + sg * 8) * D + chs;
#pragma unroll
          for (int tt = 0; tt < 8; ++tt) ygr[tt] = yp[(size_t)tt * D]; }
        WG_BAR();
        { LAS float* dst = L + L_XBS + (3 + t_ld) * 128 + c0;
          *(LAS f32x4*)dst        = (f32x4){bf2f(xr0.x & 0xffffu), bf2f(xr0.x >> 16), bf2f(xr0.y & 0xffffu), bf2f(xr0.y >> 16)};
          *(LAS f32x4*)(dst + 4)  = (f32x4){bf2f(xr0.z & 0xffffu), bf2f(xr0.z >> 16), bf2f(xr0.w & 0xffffu), bf2f(xr0.w >> 16)};
          *(LAS f32x4*)(dst + 8)  = (f32x4){bf2f(xr1.x & 0xffffu), bf2f(xr1.x >> 16), bf2f(xr1.y & 0xffffu), bf2f(xr1.y >> 16)};
          *(LAS f32x4*)(dst + 12) = (f32x4){bf2f(xr1.z & 0xffffu), bf2f(xr1.z >> 16), bf2f(xr1.w & 0xffffu), bf2f(xr1.w >> 16)}; }
        if (t0 + 64 < SEQ) { xr0 = *(const u32x4*)(xsrc + (size_t)(t0 + 64) * D); xr1 = *(const u32x4*)(xsrc + (size_t)(t0 + 64) * D + 8); }
        WG_BAR();
        LT1(11); LT0(12);
#pragma unroll
        for (int j4 = 0; j4 < 4; ++j4) { const int cc = c0 + 4 * j4;
            f32x4 acc = cbr[j4];
#pragma unroll
            for (int j = 0; j < 4; ++j) acc += cwr[j][j4] * *(const LAS f32x4*)(L + L_XBS + (t_ld + j) * 128 + cc);
            *(LAS f32x4*)(L + L_XC + t_ld * 128 + cc) = acc;
            { u32x2 pw; pw.x = pk2(acc[0], acc[1]); pw.y = pk2(acc[2], acc[3]); *(LAS u32x2*)(c.lds + LB_XCB + t_ld * XCB_STRIDE + cc * 2) = pw; } }
        WG_BAR();
        LT1(12); LT0(13);
#pragma unroll
        for (int mm = 0; mm < 2; ++mm) {
            const int m = m0 + mm;
            f32x4 ar = (f32x4){0.f, 0.f, 0.f, 0.f}, ai = (f32x4){0.f, 0.f, 0.f, 0.f};
#pragma unroll
            for (int ks = 0; ks < 4; ++ks) {
                const bf16x8 af = *(const LAS bf16x8*)(c.lds + LB_XCB + (16 * m + fr) * XCB_STRIDE + (32 * ks + 8 * fq) * 2);
                ar = __builtin_amdgcn_mfma_f32_16x16x32_bf16(af, Ba[ks], ar, 0, 0, 0);
                ai = __builtin_amdgcn_mfma_f32_16x16x32_bf16(af, Bx[ks], ai, 0, 0, 0);
            }
#pragma unroll
            for (int j = 0; j < 4; ++j) {
                const int t = 16 * m + 4 * fq + j;
                const float r = sig_fast(ar[j] + ba), ig = sig_fast(ai[j] + bx);
                const float la = sp8 * r, x2 = 2.0f * la;
                const float em = x2 > -0.5f ? x2 * (1.0f + x2 * (0.5f + x2 * (0.16666667f + x2 * (0.041666668f + x2 * 0.0083333338f)))) : __expf(x2) - 1.0f;
                As[t * 64 + ec] = __expf(la); Bs[t * 64 + ec] = __builtin_amdgcn_sqrtf(-em) * ig * L[L_XC + t * 128 + e];
            }
        }
        WG_BAR();
        LT1(13); LT0(14);
        float P = 1.f, Bv = 0.f;
#pragma unroll
        for (int tt = 0; tt < 8; ++tt) { const float aa = As[(sg * 8 + tt) * 64 + cch], bb = Bs[(sg * 8 + tt) * 64 + cch]; Bv = aa * Bv + bb; P *= aa; }
        SEG[(sg * 64 + cch) * 2] = P; SEG[(sg * 64 + cch) * 2 + 1] = Bv;
        WG_BAR();
        LT1(14); LT0(15);
        float h = CAR[par * 64 + cch];
        for (int s2 = 0; s2 < sg; ++s2) h = SEG[(s2 * 64 + cch) * 2] * h + SEG[(s2 * 64 + cch) * 2 + 1];
        { bf16* op = OB + (size_t)(b * SEQ + t0 + sg * 8) * D + chs;
#pragma unroll
          for (int tt = 0; tt < 8; ++tt) { const int t = sg * 8 + tt;
              h = As[t * 64 + cch] * h + Bs[t * 64 + cch];
              op[(size_t)tt * D] = (bf16)f2bf(h * bf2f(ygr[tt])); } }
        if (sg == 7) CAR[(par ^ 1) * 64 + cch] = h;
        if (c.tid < 384) L[L_XBS + c.tid] = L[L_XBS + 64 * 128 + c.tid];
        LT1(15); LT1(10);
    }
    if (PROBE_T >= 10 && PROBE_T < 20 && l == 0 && c.wg == 64 && c.tid == 0) *(float*)(a.ws + WS_DBG) = (float)(tacc >> 5) * 1e-4f;
#undef LT0
#undef LT1
    __syncthreads();
    if (c.tid < 64) a.out[O_LRP + ((size_t)l * NBATCH + b) * D + n * 128 + 64 * hc + c.tid] = CAR[c.tid];
    if (hc == 0 && c.tid < 384) a.out[O_CVP + (((size_t)l * NBATCH + b) * 3 + (c.tid >> 7)) * D + n * 128 + (c.tid & 127)] = L[L_XBS + c.tid];
    __syncthreads();
}
__device__ __forceinline__ void lru_sample_item(CArgs& a, Ctx& c, int l, int n, int hf) {
    LAS float* L = (LAS float*)c.lds;
    const bf16* XB = (const bf16*)(a.ws + WS_XB); const bf16* YG = (const bf16*)(a.ws + WS_YG); bf16* OB = (bf16*)(a.ws + WS_OB);
    const int t_ld = c.tid >> 3, c0 = (c.tid & 7) * 16;
    const float* cw = a.in[14] + (size_t)l * 4 * D + n * 128; const float* cb = a.in[15] + (size_t)l * D + n * 128;
    const int bs = hf * 64 + t_ld, row = MP + bs;
    const float* sc = a.in[4] + ((size_t)l * NS + bs) * 3 * D + n * 128;
    float* nc = a.out + O_CVS + ((size_t)l * NS + bs) * 3 * D + n * 128;
    __syncthreads();
#pragma unroll
    for (int j4 = 0; j4 < 4; ++j4) { const int cc = c0 + 4 * j4;
        const f32x4 x = ld_bf4(XB + (size_t)row * D + n * 128 + cc);
        const f32x4 s0 = *(const f32x4*)(sc + cc), s1 = *(const f32x4*)(sc + D + cc), s2 = *(const f32x4*)(sc + 2 * D + cc);
        const f32x4 acc = *(const f32x4*)(cb + cc) + *(const f32x4*)(cw + cc) * s0 + *(const f32x4*)(cw + D + cc) * s1 + *(const f32x4*)(cw + 2 * D + cc) * s2 + *(const f32x4*)(cw + 3 * D + cc) * x;
        *(LAS f32x4*)(L + L_XC + t_ld * 128 + cc) = acc;
        { u32x2 w; w.x = pk2(acc[0], acc[1]); w.y = pk2(acc[2], acc[3]); *(LAS u32x2*)(c.lds + LB_XCB + t_ld * XCB_STRIDE + cc * 2) = w; }
        *(f32x4*)(nc + cc) = s1; *(f32x4*)(nc + D + cc) = s2; *(f32x4*)(nc + 2 * D + cc) = x; }
    __syncthreads();
    lru_gates(a, c, l, n);
    __syncthreads();
    { const int cch = c.tid & 127, tg = c.tid >> 7;
#pragma unroll 4
      for (int tt = 0; tt < 16; ++tt) { const int t = tg * 16 + tt, b2 = hf * 64 + t; const size_t off = (size_t)(MP + b2) * D + n * 128 + cch;
          const float h0 = a.in[3][((size_t)l * NS + b2) * D + n * 128 + cch];
          const float h = L[L_AS + t * 128 + cch] * h0 + L[L_BS + t * 128 + cch];
          a.out[O_LRS + ((size_t)l * NS + b2) * D + n * 128 + cch] = h;
          OB[off] = (bf16)f2bf(h * bf2f(YG[off])); } }
    __syncthreads();
}

__device__ __forceinline__ void mixer_phase(CArgs& a, Ctx& c, int l) {
    if (c.wg < 64) {
        hgrn_fast_prompt(a, c, l, c.wg >> 3, c.wg & 7);
    } else if (c.wg < 192) {
        const int i = c.wg - 64;
        for (int rep = 0; rep < 1 + ((PROBE_MIX >> 1) & 1); ++rep) lru_prompt_item(a, c, l, i >> 4, (i >> 1) & 7, i & 1);
    } else {
        for (int rep = 0; rep < 1 + ((PROBE_MIX >> 2) & 1); ++rep)
        for (int it = c.wg - 192; it < NS * NH; it += c.G - 192) {
            const int bs = it >> 3, h = it & 7; const size_t so = (((size_t)l * NS + bs) * NH + h) * DKV * DKV;
            hgrn_naive(a, c, l, MP + bs, 1, h, a.in[2] + so, a.out + O_HGS + so);
        }
        if (c.wg - 192 < 16) lru_sample_item(a, c, l, (c.wg - 192) >> 1, (c.wg - 192) & 1);
    }
}

__global__ void __launch_bounds__(512, 2) mega_fwd(Args a0) {
    extern __shared__ __attribute__((aligned(16))) unsigned char lds_raw[];
    Ctx c; c.lds = (LAS unsigned char*)lds_raw; c.tid = threadIdx.x; c.G = gridDim.x; c.wg = blockIdx.x;
    volatile LAS unsigned* MISC = (volatile LAS unsigned*)(c.lds + MISC_OFF);
    if (c.tid < 32) MISC[c.tid] = 0u;
    __syncthreads();
    XcdBarrier bar; bar.bar = (unsigned*)(a0.ws + WS_CTL) + 1024; bar.x = 0; bar.st = nullptr;
    const int nprog = a0.nprog;
    if (nprog > 1) bar = xcd_barrier_post((unsigned*)(a0.ws + WS_CTL) + 1024, MISC + 8);

    for (int pi = 0; pi < nprog; ++pi) {
        CArgs* ap = (CArgs*)__builtin_amdgcn_kernarg_segment_ptr(); asm volatile("" : "+s"(ap));
        CArgs& a = *ap;
        const int ph = a.prog[pi];
        unsigned long long pt0 = 0ull; if (PROBE_T >= 100 && ph == PROBE_T - 100) pt0 = __builtin_amdgcn_s_memrealtime();
        { int t_ = threadIdx.x, w_ = blockIdx.x, g_ = gridDim.x; asm volatile("" : "+v"(t_), "+s"(w_), "+s"(g_)); c.tid = t_; c.wg = w_; c.G = g_; }
        float* X = a.out;
        if (ph == 0) { }
        else if (ph == NPHASE - 1) final_norm_phase(a, c);
        else {
            const int l = (ph - 1) / 9, j = (ph - 1) % 9;
            const bf16* wl = (const bf16*)(a.ws + WS_W + (size_t)l * WL_STRIDE);
            const float* xp = l == 0 ? a.in[0] : X; const float* xs = l == 0 ? a.in[1] : X + (size_t)MP * D;
            const float* modl = (const float*)(a.ws + WS_MOD) + (size_t)l * NMOD * 6144;
            bf16* H = (bf16*)(a.ws + WS_H);
            if (j == 0) norm_phase(a, c, l, 0, xp, xs);
            else if (j == 1) {
                EpiIn e{a.ws + WS_PREP, (bf16*)(a.ws + WS_SQ), (bf16*)(a.ws + WS_SK), (float*)(a.ws + WS_SLOGF), (bf16*)(a.ws + WS_V), (bf16*)(a.ws + WS_OG), (bf16*)(a.ws + WS_XB), (bf16*)(a.ws + WS_YG), (bf16*)(a.ws + WS_SGA), (bf16*)(a.ws + WS_SGB),
                        (const float*)(a.ws + WS_TAB) + (size_t)l * 3 * D, l == 0 ? 1 : 0};
                gemm_phase_sel<0>(c, H, wl + OFF_WIN / 2, MT, NIN, D, e);
            } else if (j == 2) hgrn_prep_phase(a, c);
            else if (j == 3) mixer_phase(a, c, l);
            else if (j == 4) {
                EpiBrA ea{(const bf16*)(a.ws + WS_SGA), (float*)(a.ws + WS_T)};
                EpiBrB eb{(const bf16*)(a.ws + WS_SGB), (const float*)(a.ws + WS_T), (bf16*)(a.ws + WS_MG)};
                {
                    pg8::Gemm g{(const bf16*)(a.ws + WS_OA), wl + OFF_WA / 2, MP, D, D, (const bf16*)(a.ws + WS_OB), wl + OFF_WB / 2};
                    PowOrder S; S.init(2, c.G, c.wg, 1);
                    EpiBranchUnit qe{(const bf16*)(a.ws + WS_SGA), (const bf16*)(a.ws + WS_SGB), (bf16*)(a.ws + WS_MG)};
                    pg8::gemm_phase<EpiBranchUnit, PowOrder, true, true>(c.lds, g, S, qe, c.tid);
                }
                { int t_ = threadIdx.x; asm volatile("" : "+v"(t_)); c.tid = t_; }
                sample_gemm_phase(c, (const bf16*)(a.ws + WS_OA), wl + OFF_WA / 2, D, D, ea);
                asm volatile("s_waitcnt vmcnt(0)" ::: "memory"); __syncthreads();
                sample_gemm_phase(c, (const bf16*)(a.ws + WS_OB), wl + OFF_WB / 2, D, D, eb);
            } else if (j == 5) {
                EpiRes e{xp, xs, X, modl, 2};
                gemm_phase_sel<3>(c, (const bf16*)(a.ws + WS_MG), wl + OFF_WO / 2, MT, D, D, e);
            } else if (j == 6) norm_phase(a, c, l, 1, X, X + (size_t)MP * D);
            else if (j == 7) { EpiFF1 e{(bf16*)(a.ws + WS_HM)}; gemm_phase_sel<4>(c, H, wl + OFF_W1 / 2, MT, FF, D, e); }
            else { float* XO = (l == 1 && XOUT_SCRATCH) ? (float*)(a.ws + WS_T) : X;
                   EpiRes e{X, X + (size_t)MP * D, XO, modl, 5}; gemm_phase_sel<5>(c, (const bf16*)(a.ws + WS_HM), wl + OFF_W2 / 2, MT, D, FF, e); }
        }
        if (ph == 0 || ((ph == 4 || ph == 13) && c.wg >= 192)) {
            { int t_ = threadIdx.x; asm volatile("" : "+v"(t_)); c.tid = t_; }
            p0_work(a, c, ph == 0 ? 0 : 1, ph == 0 ? c.wg : c.wg - 192, ph == 0 ? c.G : c.G - 192, ph == 0, ph == 0 ? 1 : (ph == 4 ? 2 : 3), ph != 13);
        }
        if (pi + 1 < nprog) xcd_barrier(bar);
        if (PROBE_T >= 100 && ph == PROBE_T - 100 && c.wg == 0 && threadIdx.x == 0) *(float*)(a.ws + WS_DBG) = (float)(__builtin_amdgcn_s_memrealtime() - pt0) * 1e-4f;
    }
}

extern "C" void kernel_launch(void* const* d_in, const int* in_sizes, int n_in, void* d_out, int out_size, void* d_ws, size_t ws_size, hipStream_t stream) {
    static int grid = 0;
    if (grid == 0) {
        if (n_in != 27 || out_size != (int)O_END || ws_size < WS_END) { fprintf(stderr, "kernel_launch: unexpected shapes (n_in %d out %d ws %zu)\n", n_in, out_size, ws_size); grid = -1; return; }
        int dev = 0, cus = 0, per_cu = 0;
        if (hipGetDevice(&dev) != hipSuccess || hipDeviceGetAttribute(&cus, hipDeviceAttributeMultiprocessorCount, dev) != hipSuccess) { grid = -1; return; }
        if (hipFuncSetAttribute((const void*)mega_fwd, hipFuncAttributeMaxDynamicSharedMemorySize, LDS_BYTES) != hipSuccess) { fprintf(stderr, "kernel_launch: hipFuncSetAttribute failed\n"); grid = -1; return; }
        if (hipOccupancyMaxActiveBlocksPerMultiprocessor(&per_cu, (const void*)mega_fwd, 512, LDS_BYTES) != hipSuccess || per_cu < 1) { fprintf(stderr, "kernel_launch: occupancy query failed (%d)\n", per_cu); (void)hipGetLastError(); per_cu = 1; }
        grid = cus * (per_cu < 1 ? 1 : 1);
        fprintf(stderr, "kernel_launch: cus %d per_cu %d grid %d\n", cus, per_cu, grid);
    }
    if (grid < 0) return;
    (void)hipMemsetAsync((char*)d_ws + WS_CTL, 0, CTL_BYTES, stream);
    Args a{};
    for (int i = 0; i < 27; ++i) a.in[i] = (const float*)d_in[i];
    a.out = (float*)d_out; a.ws = (unsigned char*)d_ws;
    unsigned char prog[60]; int np = 0;
    for (int ph = 0; ph < NPHASE; ++ph) for (int rep = 0; rep < 1 + (int)(((unsigned)PROBE_REPEAT >> ph) & 1u); ++rep) prog[np++] = (unsigned char)ph;
#if ONE_LAUNCH
    a.nprog = np; for (int i = 0; i < np; ++i) a.prog[i] = prog[i];
    void* kargs[] = {&a};
    hipError_t e = hipLaunchCooperativeKernel((const void*)mega_fwd, dim3(grid), dim3(512), kargs, LDS_BYTES, stream);
    if (e != hipSuccess) fprintf(stderr, "kernel_launch: cooperative launch failed: %s (grid %d)\n", hipGetErrorString(e), grid);
#else
    for (int i = 0; i < np; ++i) { a.nprog = 1; a.prog[0] = prog[i]; hipLaunchKernelGGL(mega_fwd, dim3(grid), dim3(512), LDS_BYTES, stream, a); }
#endif
}
```

```cpp
#include <hip/hip_runtime.h>
#include <cstdio>
#include <cstdint>

#ifndef FAST_GEMM
#define FAST_GEMM 63
#endif
#ifndef FAST_HGRN
#define FAST_HGRN 1
#endif
#ifndef FAST_GATES
#define FAST_GATES 1
#endif
#ifndef DBG_SHFL
#define DBG_SHFL 1
#endif
#ifndef PROBE_REPEAT
#define PROBE_REPEAT 0
#endif
#ifndef PROBE_MIX
#define PROBE_MIX 0
#endif
#ifndef PROBE_P0
#define PROBE_P0 0
#endif
#ifndef XOUT_SCRATCH
#define XOUT_SCRATCH 0
#endif
#ifndef PROBE_T
#define PROBE_T 0
#endif
#ifndef GEMM_ALIGN
#define GEMM_ALIGN true
#endif
#ifndef STAGGER
#define STAGGER 1
#endif
#ifndef PROBE_KL
#define PROBE_KL 0
#endif
#ifndef PROBE_KLE
#define PROBE_KLE 0
#endif
#ifndef PG8_PRESTAGE
#define PG8_PRESTAGE 1
#endif
#ifndef PROBE_TOFS
#define PROBE_TOFS 0
#endif
#ifndef PROBE_SITE
#define PROBE_SITE 3
#endif
#ifndef P0_DEFER
#define P0_DEFER 1
#endif
#ifndef FUSE_PREP
#define FUSE_PREP 1
#endif
#ifndef P0_UNDER
#define P0_UNDER 1
#endif
#ifndef STAGGER_BR
#define STAGGER_BR 0
#endif
#ifndef FUSE_NORM
#define FUSE_NORM 1
#endif
#ifndef GEMM_SP2
#define GEMM_SP2 true
#endif
#ifndef ONE_LAUNCH
#define ONE_LAUNCH 1
#endif

#define LAS __attribute__((address_space(3)))
#define GAS __attribute__((address_space(1)))
typedef unsigned short bf16;
typedef float f32x4 __attribute__((ext_vector_type(4)));
typedef float f32x2 __attribute__((ext_vector_type(2)));
typedef short bf16x8 __attribute__((ext_vector_type(8)));
typedef unsigned u32x4 __attribute__((ext_vector_type(4)));
typedef unsigned u32x2 __attribute__((ext_vector_type(2)));

constexpr int D = 1024, NBATCH = 8, SEQ = 2048, MP = NBATCH * SEQ, NS = 128, MR = MP + NS, MT = 16640;
constexpr int NMOD = NBATCH + NS;
constexpr int NIN = 8192, FF = 4096, NH = 8, DKV = 128;
constexpr float EPS = 1e-6f;
constexpr int NPHASE = 20;

constexpr size_t MiB = (size_t)1 << 20;
constexpr size_t WS_CTL = 0, CTL_BYTES = 64 * 1024;
constexpr size_t WS_DBG = 512 * 1024;
constexpr size_t WS_TAB = 1 * MiB;
constexpr size_t WS_MOD = 2 * MiB;
constexpr size_t WS_W = 9 * MiB, WL_STRIDE = 77 * MiB / 2;
constexpr size_t OFF_WIN = 0, OFF_WA = 16 * MiB, OFF_WB = 18 * MiB, OFF_WO = 20 * MiB, OFF_W1 = 22 * MiB, OFF_W2 = 30 * MiB, OFF_LWA = 38 * MiB, OFF_LWX = 38 * MiB + 256 * 1024;
constexpr size_t WS_H = 86 * MiB;
constexpr size_t WS_PREP = 119 * MiB;
constexpr size_t PREP_BLK = 65536;
constexpr size_t WS_V = 247 * MiB, WS_OG = 280 * MiB, WS_XB = 313 * MiB, WS_YG = 346 * MiB, WS_SGA = 379 * MiB, WS_SGB = 412 * MiB;
constexpr size_t WS_OA = 445 * MiB;
constexpr size_t WS_SQ = 478 * MiB, WS_SK = WS_SQ + 256 * 1024, WS_SLOGF = WS_SQ + 512 * 1024;
constexpr size_t WS_OB = WS_H;
constexpr size_t WS_T = WS_PREP;
constexpr size_t WS_MG = WS_PREP + 66 * MiB;
constexpr size_t WS_HM = WS_PREP;
constexpr size_t WS_HMS = 480 * MiB;
constexpr size_t WS_END = 481 * MiB;
static_assert(WS_W + 2 * WL_STRIDE <= WS_H && WS_H + (size_t)MT * D * 2 <= WS_PREP && WS_PREP + 2048 * PREP_BLK <= WS_V && WS_T + (size_t)MT * D * 4 <= WS_MG && WS_MG + (size_t)MT * D * 2 <= WS_V
              && WS_HM + (size_t)MT * FF * 2 <= WS_OG && WS_OA + (size_t)MT * D * 2 <= WS_SQ && WS_SLOGF + 512 * 1024 <= WS_HMS && WS_HMS + (size_t)NS * FF * 2 <= WS_END, "ws map");

constexpr size_t O_YP = 0, O_YS = (size_t)MP * D, O_HGP = O_YS + (size_t)NS * D, O_LRP = O_HGP + (size_t)2 * NBATCH * NH * DKV * DKV, O_CVP = O_LRP + (size_t)2 * NBATCH * D,
                 O_HGS = O_CVP + (size_t)2 * NBATCH * 3 * D, O_LRS = O_HGS + (size_t)2 * NS * NH * DKV * DKV, O_CVS = O_LRS + (size_t)2 * NS * D, O_END = O_CVS + (size_t)2 * NS * 3 * D;
static_assert(O_END == 53673984, "out map");

constexpr int LDS_BYTES = 163840;
constexpr int MISC_OFF = 158 * 1024;

typedef __bf16 bf16x2_t __attribute__((ext_vector_type(2)));
__device__ __forceinline__ unsigned f2bf(float f) { return (unsigned)__builtin_bit_cast(unsigned short, (__bf16)f); }
__device__ __forceinline__ unsigned pk2(float lo, float hi) { return __builtin_bit_cast(unsigned, __builtin_convertvector((f32x2){lo, hi}, bf16x2_t)); }
__device__ __forceinline__ float bf2f(unsigned b) { return __builtin_bit_cast(float, b << 16); }
__device__ __forceinline__ f32x4 ld_bf4(const bf16* p) { const u32x2 w = *(const u32x2*)p; return (f32x4){bf2f(w.x & 0xffffu), bf2f(w.x >> 16), bf2f(w.y & 0xffffu), bf2f(w.y >> 16)}; }
__device__ __forceinline__ void st_bf4(bf16* p, f32x4 v) { u32x2 w; w.x = pk2(v[0], v[1]); w.y = pk2(v[2], v[3]); *(u32x2*)p = w; }
#define WG_BAR() do { asm volatile("s_waitcnt lgkmcnt(0)" ::: "memory"); __builtin_amdgcn_s_barrier(); asm volatile("" ::: "memory"); } while (0)
__device__ __forceinline__ float sig_fast(float x) { return __builtin_amdgcn_rcpf(1.0f + __expf(-x)); }
__device__ __forceinline__ void st_bf8(bf16* p, f32x4 v0, f32x4 v1) { u32x4 w; w.x = pk2(v0[0], v0[1]); w.y = pk2(v0[2], v0[3]); w.z = pk2(v1[0], v1[1]); w.w = pk2(v1[2], v1[3]); *(u32x4*)p = w; }
#ifndef ST_NT
#define ST_NT 0
#endif
__device__ __forceinline__ void st_bf8n(bf16* p, f32x4 v0, f32x4 v1) { u32x4 w; w.x = pk2(v0[0], v0[1]); w.y = pk2(v0[2], v0[3]); w.z = pk2(v1[0], v1[1]); w.w = pk2(v1[2], v1[3]);
    if (ST_NT) __builtin_nontemporal_store(w, (u32x4*)p); else *(u32x4*)p = w; }
__device__ __forceinline__ void up_bf8(const u32x4 w, f32x4& v0, f32x4& v1) { v0 = (f32x4){bf2f(w.x & 0xffffu), bf2f(w.x >> 16), bf2f(w.y & 0xffffu), bf2f(w.y >> 16)}; v1 = (f32x4){bf2f(w.z & 0xffffu), bf2f(w.z >> 16), bf2f(w.w & 0xffffu), bf2f(w.w >> 16)}; }
__device__ __forceinline__ void ld_bf8(const bf16* p, f32x4& v0, f32x4& v1) { const u32x4 w = *(const u32x4*)p; v0 = (f32x4){bf2f(w.x & 0xffffu), bf2f(w.x >> 16), bf2f(w.y & 0xffffu), bf2f(w.y >> 16)}; v1 = (f32x4){bf2f(w.z & 0xffffu), bf2f(w.z >> 16), bf2f(w.w & 0xffffu), bf2f(w.w >> 16)}; }
__device__ __forceinline__ float sigmoidf_(float x) { return __builtin_amdgcn_rcpf(1.0f + __expf(-x)); }
__device__ __forceinline__ float siluf_(float x) { return x * sigmoidf_(x); }
__device__ __forceinline__ float gelu_tanh_(float x) { const float u = 0.7978845608028654f * (x + 0.044715f * x * x * x); return x * sigmoidf_(2.0f * u); }
__device__ __forceinline__ float softplusf_(float x) { return fmaxf(x, 0.f) + log1pf(expf(-fabsf(x))); }
template <int XM> __device__ __forceinline__ float swz_xor(float v) { return __builtin_bit_cast(float, __builtin_amdgcn_ds_swizzle(__builtin_bit_cast(int, v), (XM << 10) | 0x1f)); }
__device__ __forceinline__ int lane_id_fresh() { int l = (int)__builtin_amdgcn_mbcnt_hi(~0u, __builtin_amdgcn_mbcnt_lo(~0u, 0u)); asm volatile("" : "+v"(l)); return l; }
__device__ __forceinline__ float xchg(float v, int l, int m) { return __builtin_bit_cast(float, __builtin_amdgcn_ds_bpermute((l ^ m) << 2, __builtin_bit_cast(int, v))); }
template <int CTRL> __device__ __forceinline__ float dpp_f(float v) { return __builtin_bit_cast(float, __builtin_amdgcn_update_dpp(0, __builtin_bit_cast(int, v), CTRL, 0xf, 0xf, false)); }
__device__ __forceinline__ float row16_sum(float v) { v += dpp_f<0xB1>(v); v += dpp_f<0x4E>(v); v += dpp_f<0x141>(v); v += dpp_f<0x140>(v); return v; }
__device__ __forceinline__ float half_sum(float v) { const int l = lane_id_fresh(); v += xchg(v, l, 1); v += xchg(v, l, 2); v += xchg(v, l, 4); v += xchg(v, l, 8); v += xchg(v, l, 16); return v; }
__device__ __forceinline__ float wave_sum(float v) { const int l = lane_id_fresh(); v += xchg(v, l, 1); v += xchg(v, l, 2); v += xchg(v, l, 4); v += xchg(v, l, 8); v += xchg(v, l, 16); v += xchg(v, l, 32); return v; }
__device__ __forceinline__ int mod_row(int row) { return row < MP ? (row >> 11) : (NBATCH + row - MP); }

struct Args { const float* in[27]; float* out; unsigned char* ws; int nprog; unsigned char prog[60]; };
typedef const __attribute__((address_space(4))) Args CArgs;
struct Ctx { LAS unsigned char* lds; int tid, G, wg; };
namespace pg8 {
#define PG8_LAS __attribute__((address_space(3)))
typedef unsigned short bf16_t;
typedef short bf16x8 __attribute__((ext_vector_type(8)));
typedef float f32x4 __attribute__((ext_vector_type(4)));
typedef unsigned u32x4 __attribute__((ext_vector_type(4)));
constexpr int BM = 256, BK = 64, HALF = 128, HTB = HALF * BK * 2  , STAGE_BYTES = 8 * HTB, NXCD = 8, WGM = 8;

__host__ __device__ __forceinline__ int lds_byte(int r, int c) { const int st = (r >> 4) * 2 + (c >> 5), rr = r & 15, cc = c & 31, ob = rr * 64 + cc * 2; return st * 1024 + (ob ^ (((ob >> 9) & 1) << 5)); }
__host__ __device__ __forceinline__ void stage_rc(int b, int& R, int& C) { const int st = b / 1024, sb = b % 1024, swz = sb ^ (((sb >> 9) & 1) << 5); R = (st >> 1) * 16 + swz / 64; C = (st & 1) * 32 + (swz % 64) / 2; }
__host__ __device__ __forceinline__ int perm32(int rho) { const int n = rho >> 4, i = rho & 15; return 8 * (i >> 2) + 4 * n + (i & 3); }

struct Unit { int pm, pn, z; };
struct Gemm { const bf16_t* A; const bf16_t* Bt; int M, N, K; const bf16_t* A2; const bf16_t* Bt2; int ablk; };

struct StaticOrder {
    int nM, nN, nwg, G, c;
    __host__ __device__ void init(int M, int N, int G_, int c_) { nM = M / BM; nN = N / BM; nwg = nM * nN; G = G_; c = c_; }
    __host__ __device__ bool next(int i, Unit& u) const {
        const long L = (long)i * G + c; if (L >= nwg) return false;
        int wgid = (int)L; { const int q = nwg / NXCD, r = nwg % NXCD, xcd = wgid % NXCD, off = wgid / NXCD; wgid = (xcd < r ? xcd * (q + 1) : r * (q + 1) + (xcd - r) * q) + off; }
        const int nig = WGM * nN, gid = wgid / nig, fm = gid * WGM, gsz = (nM - fm) < WGM ? (nM - fm) : WGM;
        u.pm = fm + ((wgid % nig) % gsz); u.pn = (wgid % nig) / gsz; u.z = 0; return true;
    }
    __device__ __forceinline__ void a_ready(const Unit&) const {}
    __device__ __forceinline__ void done(const Unit&) const {}
};
template <class Epi, class Sched, bool ALIGN_EPI = false, bool SP2 = false>
__device__ __forceinline__ void gemm_phase(PG8_LAS unsigned char* lds, const Gemm g, const Sched& S, const Epi& E, const int tid_in) {
    const int tid = tid_in, wid = __builtin_amdgcn_readfirstlane(tid >> 6), lane = tid & 63, wr = wid >> 2, wc = wid & 3, fr = lane & 15, fq = lane >> 4;
    const int K = g.K, nt = K / BK;
    unsigned voffA[2], voffB[2];
#pragma unroll
    for (int i = 0; i < 2; ++i) { int R, C; stage_rc(tid * 16 + i * 8192, R, C); const int Rb = Epi::PERM ? ((R & ~31) + perm32(R & 31)) : R;
        voffA[i] = (unsigned)(R * (g.ablk ? BK : K) + C) * 2u; voffB[i] = (unsigned)(Rb * K + C) * 2u; }
    const size_t kstep = (size_t)(BK * 2);
    const size_t hstep = (size_t)HALF * K * 2;
    const size_t tstep = 2 * hstep;
    const size_t kstepA = g.ablk ? (size_t)BM * BK * 2 : kstep, hstepA = g.ablk ? (size_t)HALF * BK * 2 : hstep;
    const unsigned ldsw = (unsigned)wid * 1024u;
    const int aoff = lds_byte(wr * 64 + fr, fq * 8), boff = lds_byte(wc * 32 + fr, fq * 8);
#define PG8_SA(b, h) (((b) * 2 + (h)) * HTB)
#define PG8_SB(b, h) ((4 + (b) * 2 + (h)) * HTB)
#define PG8_STAGE(bufoff, gbase, voff) do { _Pragma("unroll") for (int _i = 0; _i < 2; ++_i) \
        __builtin_amdgcn_global_load_lds((const unsigned*)((const char*)(gbase) + (voff)[_i]), (PG8_LAS unsigned*)(lds + (bufoff) + ldsw + _i * 8192), 16, 0, 0); } while (0)
#define PG8_LDA(dst, b, h) do { _Pragma("unroll") for (int m = 0; m < 4; ++m) _Pragma("unroll") for (int k = 0; k < 2; ++k) dst[m][k] = *(const PG8_LAS bf16x8*)(lds + PG8_SA(b, h) + aoff + m * 2048 + k * 1024); } while (0)
#define PG8_LDB(dst, b, h) do { _Pragma("unroll") for (int n = 0; n < 2; ++n) _Pragma("unroll") for (int k = 0; k < 2; ++k) dst[n][k] = *(const PG8_LAS bf16x8*)(lds + PG8_SB(b, h) + boff + n * 2048 + k * 1024); } while (0)
#define PG8_MMA(ai, bj, At, Bt) do { __builtin_amdgcn_s_setprio(1); _Pragma("unroll") for (int m = 0; m < 4; ++m) _Pragma("unroll") for (int n = 0; n < 2; ++n) _Pragma("unroll") for (int k = 0; k < 2; ++k) \
        acc[ai][bj][m][n] = __builtin_amdgcn_mfma_f32_16x16x32_bf16(Bt[n][k], At[m][k], acc[ai][bj][m][n], 0, 0, 0); __builtin_amdgcn_s_setprio(0); } while (0)
#define PG8_WAIT_V(n) asm volatile("s_waitcnt vmcnt(" #n ")" ::: "memory")
#define PG8_WAIT_L(n) asm volatile("s_waitcnt lgkmcnt(" #n ")" ::: "memory")
#define PG8_BAR __builtin_amdgcn_s_barrier()
#define PG8_SCHED __builtin_amdgcn_sched_barrier(0)
    Unit cur, nxt; int ui = 0;
    if (!S.next(0, cur)) return;
    f32x4 acc[2][2][4][2];
#pragma unroll
    for (int a = 0; a < 2; ++a)
#pragma unroll
        for (int b = 0; b < 2; ++b)
#pragma unroll
            for (int m = 0; m < 4; ++m)
#pragma unroll
                for (int n = 0; n < 2; ++n) acc[a][b][m][n] = (f32x4){0.f, 0.f, 0.f, 0.f};
    bf16x8 At[4][2], B0[2][2], B1[2][2];
    const char* cA = (const char*)(cur.z ? g.A2 : g.A) + (size_t)cur.pm * tstep; const char* cB = (const char*)(cur.z ? g.Bt2 : g.Bt) + (size_t)cur.pn * tstep;
    S.a_ready(cur);
    if constexpr (SP2) {
        PG8_STAGE(PG8_SB(0, 0), cB, voffB); PG8_STAGE(PG8_SB(0, 1), cB + hstep, voffB); PG8_STAGE(PG8_SA(0, 0), cA, voffA); PG8_STAGE(PG8_SA(0, 1), cA + hstepA, voffA);
        if (wr == 1) PG8_BAR;
        PG8_WAIT_V(2); PG8_BAR;
        PG8_STAGE(PG8_SB(1, 0), cB + kstep, voffB); PG8_STAGE(PG8_SA(1, 0), cA + kstepA, voffA); PG8_STAGE(PG8_SB(1, 1), cB + hstep + kstep, voffB);
        PG8_WAIT_V(6); PG8_BAR;
    } else {
        PG8_STAGE(PG8_SB(0, 0), cB, voffB); PG8_STAGE(PG8_SA(0, 0), cA, voffA); PG8_STAGE(PG8_SB(0, 1), cB + hstep, voffB); PG8_STAGE(PG8_SA(0, 1), cA + hstepA, voffA);
        if (wr == 1) PG8_BAR;
        PG8_WAIT_V(4); PG8_BAR;
        PG8_STAGE(PG8_SB(1, 0), cB + kstep, voffB); PG8_STAGE(PG8_SA(1, 0), cA + kstepA, voffA); PG8_STAGE(PG8_SB(1, 1), cB + hstep + kstep, voffB);
        PG8_WAIT_V(6); PG8_BAR;
    }
    for (;;) {
        const bool has_next = S.next(ui + 1, nxt);
        const char* nA = has_next ? (const char*)(nxt.z ? g.A2 : g.A) + (size_t)nxt.pm * tstep : cA; const char* nB = has_next ? (const char*)(nxt.z ? g.Bt2 : g.Bt) + (size_t)nxt.pn * tstep : cB;
        for (int t = 0; t < nt; t += 2) {
            const bool last = (t == nt - 2);
            const char* a1 = cA + (size_t)(t + 1) * kstepA;
            const char* a2 = last ? nA : cA + (size_t)(t + 2) * kstepA; const char* b2 = last ? nB : cB + (size_t)(t + 2) * kstep;
            const char* a3 = a2 + kstepA; const char* b3 = b2 + kstep;
            if (last && has_next) S.a_ready(nxt);
            if constexpr (SP2) {
            PG8_LDB(B0, 0, 0); PG8_LDB(B1, 0, 1); PG8_SCHED; PG8_LDA(At, 0, 0); PG8_STAGE(PG8_SA(1, 1), a1 + hstepA, voffA);
            PG8_WAIT_V(8); PG8_WAIT_L(0); PG8_BAR; PG8_MMA(0, 0, At, B0); PG8_MMA(0, 1, At, B1); PG8_BAR; PG8_SCHED;
            PG8_LDA(At, 0, 1); PG8_STAGE(PG8_SB(0, 0), b2, voffB); PG8_STAGE(PG8_SB(0, 1), b2 + hstep, voffB); PG8_STAGE(PG8_SA(0, 0), a2, voffA);
            PG8_WAIT_V(8); PG8_WAIT_L(0); PG8_BAR; PG8_MMA(1, 0, At, B0); PG8_MMA(1, 1, At, B1); PG8_BAR; PG8_SCHED;
            PG8_LDB(B0, 1, 0); PG8_LDB(B1, 1, 1); PG8_SCHED; PG8_LDA(At, 1, 0); PG8_STAGE(PG8_SA(0, 1), a2 + hstepA, voffA);
            PG8_WAIT_V(8); PG8_WAIT_L(0); PG8_BAR; PG8_MMA(0, 0, At, B0); PG8_MMA(0, 1, At, B1); PG8_BAR; PG8_SCHED;
            PG8_LDA(At, 1, 1); PG8_STAGE(PG8_SB(1, 0), b3, voffB); PG8_STAGE(PG8_SB(1, 1), b3 + hstep, voffB); PG8_STAGE(PG8_SA(1, 0), a3, voffA);
            PG8_WAIT_V(8); PG8_WAIT_L(0); PG8_BAR; PG8_MMA(1, 0, At, B0); PG8_MMA(1, 1, At, B1); PG8_BAR; PG8_SCHED;
            } else {
            PG8_LDB(B0, 0, 0); PG8_SCHED; PG8_LDA(At, 0, 0); PG8_STAGE(PG8_SA(1, 1), a1 + hstepA, voffA);
            PG8_WAIT_L(8); PG8_BAR; PG8_WAIT_L(0); PG8_MMA(0, 0, At, B0); PG8_BAR; PG8_SCHED;
            PG8_LDB(B1, 0, 1); PG8_STAGE(PG8_SB(0, 0), b2, voffB);
            PG8_BAR; PG8_WAIT_L(0); PG8_MMA(0, 1, At, B1); PG8_BAR;
            PG8_LDA(At, 0, 1); PG8_STAGE(PG8_SA(0, 0), a2, voffA);
            PG8_BAR; PG8_WAIT_L(0); PG8_MMA(1, 0, At, B0); PG8_BAR; PG8_SCHED;
            PG8_STAGE(PG8_SB(0, 1), b2 + hstep, voffB);
            PG8_WAIT_V(6); PG8_BAR; PG8_MMA(1, 1, At, B1); PG8_BAR;
            PG8_LDB(B0, 1, 0); PG8_SCHED; PG8_LDA(At, 1, 0); PG8_STAGE(PG8_SA(0, 1), a2 + hstepA, voffA);
            PG8_WAIT_L(8); PG8_BAR; PG8_WAIT_L(0); PG8_MMA(0, 0, At, B0); PG8_BAR; PG8_SCHED;
            PG8_LDB(B1, 1, 1); PG8_STAGE(PG8_SB(1, 0), b3, voffB);
            PG8_BAR; PG8_WAIT_L(0); PG8_MMA(0, 1, At, B1); PG8_BAR;
            PG8_LDA(At, 1, 1); PG8_STAGE(PG8_SA(1, 0), a3, voffA);
            PG8_BAR; PG8_WAIT_L(0); PG8_MMA(1, 0, At, B0); PG8_BAR; PG8_SCHED;
            PG8_STAGE(PG8_SB(1, 1), b3 + hstep, voffB);
            PG8_WAIT_V(6); PG8_BAR; PG8_MMA(1, 1, At, B1); PG8_BAR;
            }
        }
        if constexpr (ALIGN_EPI) { if (wr == 0) PG8_BAR; }
        if constexpr (!Epi::AFTER_DRAIN) { int l2 = (int)__builtin_amdgcn_mbcnt_hi(~0u, __builtin_amdgcn_mbcnt_lo(~0u, 0u)); asm volatile("" : "+v"(l2));
            E(acc, cur, wr, wc, l2 & 15, l2 >> 4); S.done(cur); }
        if (!has_next) break;
        if (!(Epi::KEEP && cur.z == 0)) {
#pragma unroll
        for (int a = 0; a < 2; ++a)
#pragma unroll
            for (int b = 0; b < 2; ++b)
#pragma unroll
                for (int m = 0; m < 4; ++m)
#pragma unroll
                    for (int n = 0; n < 2; ++n) acc[a][b][m][n] = (f32x4){0.f, 0.f, 0.f, 0.f};
        }
        cur = nxt; cA = nA; cB = nB; ++ui;
        if constexpr (ALIGN_EPI) { if (wr == 1) PG8_BAR; }
    }
    PG8_WAIT_V(0);
    if constexpr (!ALIGN_EPI) { if (wr == 0) PG8_BAR; }
    PG8_BAR;
    if constexpr (Epi::AFTER_DRAIN) { E.fused(acc, cur, wr, wc, fr, fq, lds, wid, lane); S.done(cur); }
#undef PG8_SA
#undef PG8_SB
#undef PG8_STAGE
#undef PG8_LDA
#undef PG8_LDB
#undef PG8_MMA
#undef PG8_WAIT_V
#undef PG8_WAIT_L
#undef PG8_BAR
#undef PG8_SCHED
}
}

template <class E> struct QuadEpi {
    static constexpr bool PERM = false, AFTER_DRAIN = false, KEEP = false;
    E e;
    __device__ __forceinline__ void operator()(const f32x4 (&acc)[2][2][4][2], const pg8::Unit& u, int wr, int wc, int fr, int fq) const {
        const int row0 = u.pm * 256 + wr * 64 + fr, col0 = u.pn * 256 + wc * 32 + 4 * fq;
#pragma unroll
        for (int ai = 0; ai < 2; ++ai)
#pragma unroll
            for (int m = 0; m < 4; ++m)
#pragma unroll
                for (int bj = 0; bj < 2; ++bj)
#pragma unroll
                    for (int n = 0; n < 2; ++n) e.quad(row0 + ai * 128 + m * 16, col0 + bj * 128 + n * 16, acc[ai][bj][m][n]);
    }
};

struct EpiIn {
    unsigned char* PREP; bf16 *SQ, *SK; float* SLOGF; bf16 *V, *OG, *XB, *YG, *SGA, *SGB; const float* lbt; int lb0;
    static constexpr bool BY_REGION = true;
    __device__ __forceinline__ size_t blk_off(int row, int cc) const { return (((size_t)(row >> 11) * 32 + ((row >> 6) & 31)) * 8 + (cc >> 7)) * PREP_BLK; }
    __device__ __forceinline__ bf16* q_ptr(int row, int cc) const { return row < MP ? (bf16*)(PREP + blk_off(row, cc) + 32768) + (row & 63) * 128 + (cc & 127) : SQ + (size_t)(row - MP) * D + cc; }
    __device__ __forceinline__ bf16* k_ptr(int row, int cc) const { return row < MP ? (bf16*)(PREP + blk_off(row, cc) + 49152) + (row & 63) * 128 + (cc & 127) : SK + (size_t)(row - MP) * D + cc; }
    __device__ __forceinline__ float* lf_ptr(int row, int cc) const { return row < MP ? (float*)(PREP + blk_off(row, cc)) + (row & 63) * 128 + (cc & 127) : SLOGF + (size_t)(row - MP) * D + cc; }
    __device__ __forceinline__ f32x2 fgate(float fa, float lb, float llb, float l1m) const {
        float lf, kk;
        const float t = __expf(-fabsf(fa));
        const float ls = fminf(fa, 0.f) - __logf(1.0f + t);
        const float sneg = (fa >= 0.f ? t : 1.0f) * __builtin_amdgcn_rcpf(1.0f + t);
        if (lb0) { lf = ls; kk = sneg; }
        else { const float b = l1m + ls, mx = fmaxf(llb, b); lf = mx + __logf(1.0f + __expf(-fabsf(llb - b))); kk = (1.0f - lb) * sneg; }
        return (f32x2){lf, kk};
    }
    template <int R> __device__ __forceinline__ f32x4 act(f32x4 v) const {
        f32x4 r;
#pragma unroll
        for (int j = 0; j < 4; ++j) {
            if constexpr (R == 0 || R == 3) r[j] = v[j] * sig_fast(v[j]);
            else if constexpr (R == 5) { const float x = v[j], u = 0.7978845608028654f * (x + 0.044715f * x * x * x); r[j] = x * sig_fast(2.0f * u); }
            else if constexpr (R >= 6) r[j] = sig_fast(v[j]);
            else r[j] = v[j];
        }
        return r;
    }
    template <int R> __device__ __forceinline__ bf16* dst(int row, int cc) const { return R == 0 ? q_ptr(row, cc) : (R == 2 ? V : R == 3 ? OG : R == 4 ? XB : R == 5 ? YG : R == 6 ? SGA : SGB) + (size_t)row * D + cc; }
    template <int R> __device__ __forceinline__ void quadR(int row, int cc, f32x4 v) const {
        const size_t o = (size_t)row * D + cc;
        if constexpr (R == 1) {
            const f32x4 lb = *(const f32x4*)(lbt + cc), llb = *(const f32x4*)(lbt + 1024 + cc), l1m = *(const f32x4*)(lbt + 2048 + cc);
            f32x4 lf, r;
#pragma unroll
            for (int j = 0; j < 4; ++j) { const f32x2 g = fgate(v[j], lb[j], llb[j], l1m[j]); lf[j] = g.x; r[j] = g.y; }
            *(f32x4*)lf_ptr(row, cc) = lf; (void)r;
        } else st_bf4(dst<R>(row, cc), act<R>(v));
    }
    template <int R> __device__ __forceinline__ void octR(int row, int cc, f32x4 v0, f32x4 v1) const {
        const size_t o = (size_t)row * D + cc;
        if constexpr (R == 1) {
            f32x4 lf0, lf1, r0, r1;
            if (lb0) {
#pragma unroll
                for (int j = 0; j < 4; ++j) { const f32x2 g0 = fgate(v0[j], 0.f, 0.f, 0.f), g1 = fgate(v1[j], 0.f, 0.f, 0.f); lf0[j] = g0.x; r0[j] = g0.y; lf1[j] = g1.x; r1[j] = g1.y; }
            } else {
                const f32x4 lba = *(const f32x4*)(lbt + cc), lbb = *(const f32x4*)(lbt + cc + 4), lla = *(const f32x4*)(lbt + 1024 + cc), llb_ = *(const f32x4*)(lbt + 1024 + cc + 4), l1a = *(const f32x4*)(lbt + 2048 + cc), l1b = *(const f32x4*)(lbt + 2048 + cc + 4);
#pragma unroll
                for (int j = 0; j < 4; ++j) { const f32x2 g0 = fgate(v0[j], lba[j], lla[j], l1a[j]), g1 = fgate(v1[j], lbb[j], llb_[j], l1b[j]); lf0[j] = g0.x; r0[j] = g0.y; lf1[j] = g1.x; r1[j] = g1.y; }
            }
            float* lp = lf_ptr(row, cc); *(f32x4*)lp = lf0; *(f32x4*)(lp + 4) = lf1; (void)r0; (void)r1;
        } else st_bf8n(dst<R>(row, cc), act<R>(v0), act<R>(v1));
    }
    __device__ __forceinline__ void quad(int row, int col, f32x4 v) const {
        const int reg = col >> 10, cc = col & 1023;
        switch (reg) { case 0: quadR<0>(row, cc, v); break; case 1: quadR<1>(row, cc, v); break; case 2: quadR<2>(row, cc, v); break; case 3: quadR<3>(row, cc, v); break;
                       case 4: quadR<4>(row, cc, v); break; case 5: quadR<5>(row, cc, v); break; case 6: quadR<6>(row, cc, v); break; default: quadR<7>(row, cc, v); break; }
    }
};
struct EpiInUnit {
    static constexpr bool PERM = true, AFTER_DRAIN = false, KEEP = false; static constexpr int MIN_VMEM = 16;
    EpiIn e;
    template <int KIND> __device__ __forceinline__ void run(const f32x4 (&acc)[2][2][4][2], int row0, int cc0, bf16* dstp, int mode) const {
#pragma unroll
        for (int ai = 0; ai < 2; ++ai)
#pragma unroll
            for (int m = 0; m < 4; ++m) {
#pragma unroll
                for (int bj = 0; bj < 2; ++bj) {
                    const int row = row0 + ai * 128 + m * 16, cc = cc0 + bj * 128;
                    const f32x4 v0 = acc[ai][bj][m][0], v1 = acc[ai][bj][m][1];
                    if constexpr (KIND == 0) e.octR<1>(row, cc, v0, v1);
                    else if constexpr (KIND == 1) st_bf8n(dstp + (size_t)row * D + cc, v0, v1);
                    else { f32x4 r0, r1;
#pragma unroll
                        for (int j = 0; j < 4; ++j) {
                            const float x0 = v0[j], x1 = v1[j];
                            const float a0 = mode == 1 ? 1.5957691216057308f * (x0 + 0.044715f * x0 * x0 * x0) : x0, a1 = mode == 1 ? 1.5957691216057308f * (x1 + 0.044715f * x1 * x1 * x1) : x1;
                            const float s0 = sig_fast(a0), s1 = sig_fast(a1);
                            r0[j] = mode == 2 ? s0 : x0 * s0; r1[j] = mode == 2 ? s1 : x1 * s1; }
                        st_bf8n(dstp ? dstp + (size_t)row * D + cc : e.q_ptr(row, cc), r0, r1); }
                }
                asm volatile("" ::: "memory"); __builtin_amdgcn_sched_barrier(0); }
    }
    __device__ __forceinline__ void run_f(const f32x4 (&acc)[2][2][4][2], int row0, int cc0) const {
#pragma unroll
        for (int bj = 0; bj < 2; ++bj) {
            const int cc = cc0 + bj * 128;
            f32x4 lba = (f32x4){0.f, 0.f, 0.f, 0.f}, lbb = lba, lla = lba, llb_ = lba, l1a = lba, l1b = lba;
            const bool z = e.lb0 != 0;
            if (!z) { lba = *(const f32x4*)(e.lbt + cc); lbb = *(const f32x4*)(e.lbt + cc + 4); lla = *(const f32x4*)(e.lbt + 1024 + cc); llb_ = *(const f32x4*)(e.lbt + 1024 + cc + 4);
                      l1a = *(const f32x4*)(e.lbt + 2048 + cc); l1b = *(const f32x4*)(e.lbt + 2048 + cc + 4); }
#pragma unroll
            for (int ai = 0; ai < 2; ++ai)
#pragma unroll
                for (int m = 0; m < 4; ++m) {
                    const int row = row0 + ai * 128 + m * 16;
                    const f32x4 v0 = acc[ai][bj][m][0], v1 = acc[ai][bj][m][1];
                    f32x4 lf0, lf1;
                    if (z) {
#pragma unroll
                        for (int j = 0; j < 4; ++j) { lf0[j] = e.fgate(v0[j], 0.f, 0.f, 0.f).x; lf1[j] = e.fgate(v1[j], 0.f, 0.f, 0.f).x; }
                    } else {
#pragma unroll
                        for (int j = 0; j < 4; ++j) { lf0[j] = e.fgate(v0[j], lba[j], lla[j], l1a[j]).x; lf1[j] = e.fgate(v1[j], lbb[j], llb_[j], l1b[j]).x; }
                    }
                    float* lp = e.lf_ptr(row, cc); *(f32x4*)lp = lf0; *(f32x4*)(lp + 4) = lf1;
                    asm volatile("" ::: "memory"); __builtin_amdgcn_sched_barrier(0); }
        }
    }
    __device__ __forceinline__ void operator()(const f32x4 (&acc)[2][2][4][2], const pg8::Unit& u, int wr, int wc, int fr, int fq) const {
        const int row0 = u.pm * 256 + wr * 64 + fr, cc0 = (u.pn & 3) * 256 + wc * 32 + 8 * fq, reg = u.pn >> 2;
        if (reg == 1) run_f(acc, row0, cc0);
        else if (reg == 2 || reg == 4) run<1>(acc, row0, cc0, reg == 2 ? e.V : e.XB, 0);
        else { bf16* dp = reg == 0 ? nullptr : reg == 3 ? e.OG : reg == 5 ? e.YG : reg == 6 ? e.SGA : e.SGB;
               run<2>(acc, row0, cc0, dp, reg == 5 ? 1 : (reg >= 6 ? 2 : 0)); }
    }
};
template <class E> struct OctEpi {
    static constexpr bool PERM = true, AFTER_DRAIN = false, KEEP = false; static constexpr int MIN_VMEM = 16;
    E e;
    __device__ __forceinline__ void operator()(const f32x4 (&acc)[2][2][4][2], const pg8::Unit& u, int wr, int wc, int fr, int fq) const {
        const int row0 = u.pm * 256 + wr * 64 + fr, col0 = u.pn * 256 + wc * 32 + 8 * fq;
#pragma unroll
        for (int ai = 0; ai < 2; ++ai)
#pragma unroll
            for (int m = 0; m < 4; ++m) {
#pragma unroll
                for (int bj = 0; bj < 2; ++bj) e.oct(row0 + ai * 128 + m * 16, col0 + bj * 128, acc[ai][bj][m][0], acc[ai][bj][m][1]);
                asm volatile("" ::: "memory"); __builtin_amdgcn_sched_barrier(0); }
    }
};
struct EpiBrA { static constexpr bool BY_REGION = false; const bf16* SGA; float* T;
    __device__ __forceinline__ void quad(int row, int col, f32x4 v) const { const size_t o = (size_t)row * D + col; *(f32x4*)(T + o) = ld_bf4(SGA + o) * v; }
    __device__ __forceinline__ void oct(int row, int col, f32x4 v0, f32x4 v1) const { const size_t o = (size_t)row * D + col; f32x4 g0, g1; ld_bf8(SGA + o, g0, g1); *(f32x4*)(T + o) = g0 * v0; *(f32x4*)(T + o + 4) = g1 * v1; } };
struct EpiBrB { static constexpr bool BY_REGION = false; const bf16* SGB; const float* T; bf16* MG;
    __device__ __forceinline__ void quad(int row, int col, f32x4 v) const { const size_t o = (size_t)row * D + col; st_bf4(MG + o, *(const f32x4*)(T + o) + ld_bf4(SGB + o) * v); }
    __device__ __forceinline__ void oct(int row, int col, f32x4 v0, f32x4 v1) const { const size_t o = (size_t)row * D + col; f32x4 g0, g1; ld_bf8(SGB + o, g0, g1);
        st_bf8(MG + o, *(const f32x4*)(T + o) + g0 * v0, *(const f32x4*)(T + o + 4) + g1 * v1); } };
struct EpiBranchUnit {
    static constexpr bool PERM = true, AFTER_DRAIN = false, KEEP = true; static constexpr int MIN_VMEM = 16;
    const bf16* SGA; const bf16* SGB; bf16* MG;
    __device__ __forceinline__ void operator()(const f32x4 (&acc_c)[2][2][4][2], const pg8::Unit& u, int wr, int wc, int fr, int fq) const {
        f32x4 (&acc)[2][2][4][2] = const_cast<f32x4 (&)[2][2][4][2]>(acc_c);
        const int row0 = u.pm * 256 + wr * 64 + fr, col0 = u.pn * 256 + wc * 32 + 8 * fq;
        if (u.z == 0) {
#pragma unroll
            for (int ai = 0; ai < 2; ++ai) {
                u32x4 ga[4][2], gb[4][2];
#pragma unroll
                for (int m = 0; m < 4; ++m)
#pragma unroll
                    for (int bj = 0; bj < 2; ++bj) { const size_t o = (size_t)(row0 + ai * 128 + m * 16) * D + col0 + bj * 128; ga[m][bj] = *(const u32x4*)(SGA + o); gb[m][bj] = *(const u32x4*)(SGB + o); }
#pragma unroll
                for (int m = 0; m < 4; ++m)
#pragma unroll
                    for (int bj = 0; bj < 2; ++bj) { f32x4 a0, a1, b0, b1; up_bf8(ga[m][bj], a0, a1); up_bf8(gb[m][bj], b0, b1);
#pragma unroll
                        for (int j = 0; j < 4; ++j) { acc[ai][bj][m][0][j] *= a0[j] * __builtin_amdgcn_rcpf(fmaxf(b0[j], 1e-30f)); acc[ai][bj][m][1][j] *= a1[j] * __builtin_amdgcn_rcpf(fmaxf(b1[j], 1e-30f)); } }
                asm volatile("" ::: "memory"); __builtin_amdgcn_sched_barrier(0); }
        } else {
#pragma unroll
            for (int ai = 0; ai < 2; ++ai) {
                u32x4 gb[4][2];
#pragma unroll
                for (int m = 0; m < 4; ++m)
#pragma unroll
                    for (int bj = 0; bj < 2; ++bj) gb[m][bj] = *(const u32x4*)(SGB + (size_t)(row0 + ai * 128 + m * 16) * D + col0 + bj * 128);
#pragma unroll
                for (int m = 0; m < 4; ++m)
#pragma unroll
                    for (int bj = 0; bj < 2; ++bj) { f32x4 b0, b1; up_bf8(gb[m][bj], b0, b1); st_bf8(MG + (size_t)(row0 + ai * 128 + m * 16) * D + col0 + bj * 128, acc[ai][bj][m][0] * b0, acc[ai][bj][m][1] * b1); }
                asm volatile("" ::: "memory"); __builtin_amdgcn_sched_barrier(0); }
        }
    }
};
constexpr int XS = 2048;
struct EpiRes { static constexpr bool BY_REGION = false; const float* xp; const float* xs; bf16* X; const float* modl; int gi;
    __device__ __forceinline__ void quad(int row, int col, f32x4 v) const {
        if (row >= MR) return;
        const f32x4 g = *(const f32x4*)(modl + (size_t)mod_row(row) * 6144 + gi * 1024 + col);
        bf16* xo = X + (size_t)row * XS + col;
        const f32x4 s = xp ? *(const f32x4*)((row < MP ? xp + (size_t)row * D : xs + (size_t)(row - MP) * D) + col) : ld_bf4(xo);
        const f32x4 r = s + g * v;
        __hip_atomic_store((unsigned long long*)xo, (unsigned long long)pk2(r[0], r[1]) | ((unsigned long long)pk2(r[2], r[3]) << 32), __ATOMIC_RELAXED, __HIP_MEMORY_SCOPE_AGENT);
    }
    __device__ __forceinline__ void oct(int row, int col, f32x4 v0, f32x4 v1) const {
        if (row >= MR) return;
        const float* gp = modl + (size_t)mod_row(row) * 6144 + gi * 1024 + col;
        const f32x4 g0 = *(const f32x4*)gp, g1 = *(const f32x4*)(gp + 4);
        bf16* xo = X + (size_t)row * XS + col;
        f32x4 s0, s1;
        if (xp) { const float* sp = (row < MP ? xp + (size_t)row * D : xs + (size_t)(row - MP) * D) + col; s0 = *(const f32x4*)sp; s1 = *(const f32x4*)(sp + 4); }
        else ld_bf8(xo, s0, s1);
        st_bf8(xo, s0 + g0 * v0, s1 + g1 * v1);
    } };
struct EpiResUnit {
    static constexpr bool PERM = true, AFTER_DRAIN = false, KEEP = false; static constexpr int MIN_VMEM = 16;
    EpiRes e;
    __device__ __forceinline__ void operator()(const f32x4 (&acc)[2][2][4][2], const pg8::Unit& u, int wr, int wc, int fr, int fq) const {
        const int row0 = u.pm * 256 + wr * 64 + fr, col0 = u.pn * 256 + wc * 32 + 8 * fq;
        const float* gp = e.modl + (size_t)mod_row(u.pm * 256) * 6144 + e.gi * 1024 + col0;
        f32x4 g[2][2];
#pragma unroll
        for (int bj = 0; bj < 2; ++bj) { g[bj][0] = *(const f32x4*)(gp + bj * 128); g[bj][1] = *(const f32x4*)(gp + bj * 128 + 4); }
        if (e.xp == nullptr) {
#pragma unroll
            for (int ai = 0; ai < 2; ++ai) {
                u32x4 xr[4][2];
#pragma unroll
                for (int m = 0; m < 4; ++m)
#pragma unroll
                    for (int bj = 0; bj < 2; ++bj) xr[m][bj] = *(const u32x4*)(e.X + (size_t)(row0 + ai * 128 + m * 16) * XS + col0 + bj * 128);
#pragma unroll
                for (int m = 0; m < 4; ++m)
#pragma unroll
                    for (int bj = 0; bj < 2; ++bj) { f32x4 s0, s1; up_bf8(xr[m][bj], s0, s1);
                        st_bf8(e.X + (size_t)(row0 + ai * 128 + m * 16) * XS + col0 + bj * 128, s0 + g[bj][0] * acc[ai][bj][m][0], s1 + g[bj][1] * acc[ai][bj][m][1]); }
                asm volatile("" ::: "memory"); __builtin_amdgcn_sched_barrier(0); }
        } else {
#pragma unroll
            for (int ai = 0; ai < 2; ++ai)
#pragma unroll
                for (int mh = 0; mh < 2; ++mh) {
                    f32x4 xs_[2][2][2];
#pragma unroll
                    for (int mm = 0; mm < 2; ++mm)
#pragma unroll
                        for (int bj = 0; bj < 2; ++bj) { const float* sp = e.xp + (size_t)(row0 + ai * 128 + (2 * mh + mm) * 16) * D + col0 + bj * 128; xs_[mm][bj][0] = *(const f32x4*)sp; xs_[mm][bj][1] = *(const f32x4*)(sp + 4); }
#pragma unroll
                    for (int mm = 0; mm < 2; ++mm)
#pragma unroll
                        for (int bj = 0; bj < 2; ++bj) { const int m = 2 * mh + mm;
                            st_bf8(e.X + (size_t)(row0 + ai * 128 + m * 16) * XS + col0 + bj * 128, xs_[mm][bj][0] + g[bj][0] * acc[ai][bj][m][0], xs_[mm][bj][1] + g[bj][1] * acc[ai][bj][m][1]); }
                    asm volatile("" ::: "memory"); __builtin_amdgcn_sched_barrier(0); }
        }
    }
};
struct EpiFF1 { static constexpr bool BY_REGION = false; bf16* HM; bf16* HMS; int dummy = 0;
    __device__ __forceinline__ bf16* ptr(int row, int col) const { return PROBE_KLE && dummy ? HM + (((size_t)row * FF + col) & 16383) : HM + (size_t)row * FF + col; }
    __device__ __forceinline__ void quad(int row, int col, f32x4 v) const {
        f32x4 r;
#pragma unroll
        for (int j = 0; j < 4; ++j) { const float t = fmaxf(v[j], 0.f); r[j] = t * t; }
        st_bf4(ptr(row, col), r);
    }
    __device__ __forceinline__ void oct(int row, int col, f32x4 v0, f32x4 v1) const {
        f32x4 r0, r1;
#pragma unroll
        for (int j = 0; j < 4; ++j) { const float t0 = fmaxf(v0[j], 0.f), t1 = fmaxf(v1[j], 0.f); r0[j] = t0 * t0; r1[j] = t1 * t1; }
        st_bf8n(ptr(row, col), r0, r1);
    } };

template <class E>
__device__ __forceinline__ void naive_gemm_phase(Ctx& c, const bf16* A, const bf16* Bt, int M, int N, int K, const E& e) {
    LAS float* As = (LAS float*)c.lds;
    LAS float* Bs = As + 32 * 132;
    const int ntm = M / 128, ntn = N / 128, tx = c.tid & 31, ty = c.tid >> 5;
    const int lr = c.tid >> 2, lk = (c.tid & 3) * 8;
    for (int tile = c.wg; tile < ntm * ntn; tile += c.G) {
        const int tm = tile % ntm, tn = tile / ntm;
        f32x4 acc[8];
#pragma unroll
        for (int i = 0; i < 8; ++i) acc[i] = (f32x4){0.f, 0.f, 0.f, 0.f};
        for (int k0 = 0; k0 < K; k0 += 32) {
            const u32x4 av = *(const u32x4*)(A + (size_t)(tm * 128 + lr) * K + k0 + lk);
            const u32x4 bv = *(const u32x4*)(Bt + (size_t)(tn * 128 + lr) * K + k0 + lk);
            __syncthreads();
#pragma unroll
            for (int j = 0; j < 4; ++j) {
                As[(lk + 2 * j) * 132 + lr] = bf2f(av[j] & 0xffffu); As[(lk + 2 * j + 1) * 132 + lr] = bf2f(av[j] >> 16);
                Bs[(lk + 2 * j) * 132 + lr] = bf2f(bv[j] & 0xffffu); Bs[(lk + 2 * j + 1) * 132 + lr] = bf2f(bv[j] >> 16);
            }
            __syncthreads();
#pragma unroll 8
            for (int k = 0; k < 32; ++k) {
                const f32x4 a0 = *(const LAS f32x4*)(As + k * 132 + ty * 8), a1 = *(const LAS f32x4*)(As + k * 132 + ty * 8 + 4);
                const f32x4 b = *(const LAS f32x4*)(Bs + k * 132 + tx * 4);
                acc[0] += a0[0] * b; acc[1] += a0[1] * b; acc[2] += a0[2] * b; acc[3] += a0[3] * b;
                acc[4] += a1[0] * b; acc[5] += a1[1] * b; acc[6] += a1[2] * b; acc[7] += a1[3] * b;
            }
        }
#pragma unroll
        for (int i = 0; i < 8; ++i) e.quad(tm * 128 + ty * 8 + i, tn * 128 + tx * 4, acc[i]);
    }
    __syncthreads();
}

template <class Q> struct SkipZ0 { static constexpr bool PERM = Q::PERM, AFTER_DRAIN = false, KEEP = false; static constexpr int MIN_VMEM = 0; Q q; Q qd;
    __device__ __forceinline__ void operator()(const f32x4 (&acc)[2][2][4][2], const pg8::Unit& u, int wr, int wc, int fr, int fq) const { if (u.z == 0) { if (PROBE_KLE) qd(acc, u, wr, wc, fr, fq); return; } q(acc, u, wr, wc, fr, fq); } };
struct PowOrder {
    int lgN, nwg, G, c, two, ib, ie;
    __device__ __forceinline__ void init(int lgN_, int G_, int c_, int two_ = 0) { lgN = lgN_; nwg = 64 << lgN_; G = G_; c = c_; two = two_; ib = 0; ie = 1 << 30; }
    __device__ __forceinline__ bool next(int i0, pg8::Unit& u) const {
        const int i = i0 + ib; if (i >= ie) return false;
        const int ii = two ? (i >> 1) : i;
        const int L = ii * G + c; if (L >= nwg) return false;
        const int w = (L & 7) * (nwg >> 3) + (L >> 3), j = w & ((8 << lgN) - 1), gid = w >> (3 + lgN);
        u.pm = __builtin_amdgcn_readfirstlane(gid * 8 + (j & 7)); u.pn = __builtin_amdgcn_readfirstlane(j >> 3); u.z = two ? (i & 1) : 0; return true;
    }
    __device__ __forceinline__ void a_ready(const pg8::Unit&) const {}
    __device__ __forceinline__ void done(const pg8::Unit&) const {}
};
#define XB_TMO      128
#define XB_XCNT(j)  (256  + 64 * (j))
#define XB_XSUB(j)  (1280 + 64 * (j))
#define XB_XGEN(j)  (2304 + 64 * (j))
#define XB_TOP      3328
#define XB_TOPGEN   3392
#define XCD_BAR_WORDS 3456
#define XB_SPIN_CAP (1u << 18)
__device__ __forceinline__ unsigned xb_ld(unsigned* p)              { return __hip_atomic_load(p, __ATOMIC_RELAXED, __HIP_MEMORY_SCOPE_AGENT); }
__device__ __forceinline__ unsigned xb_add(unsigned* p, unsigned v) { return __hip_atomic_fetch_add(p, v, __ATOMIC_RELAXED, __HIP_MEMORY_SCOPE_AGENT); }
__device__ __forceinline__ unsigned xb_xcc_id() { return (unsigned)__builtin_amdgcn_s_getreg((3 << 11) | 20) & 0xFu; }
#define XB_SPIN(cond, bar) do { unsigned _sp = 0; while (cond) { __builtin_amdgcn_s_sleep(1); \
    if ((++_sp & 255u) == 0u) { if (xb_ld(&(bar)[XB_TMO])) break; if (_sp > XB_SPIN_CAP) { atomicAdd(&(bar)[XB_TMO], 1u); break; } } } } while (0)
struct XcdBarrier { unsigned* bar; unsigned x; volatile LAS unsigned* st; };
__device__ __forceinline__ XcdBarrier xcd_barrier_post(unsigned* bar, volatile LAS unsigned* st) {
    XcdBarrier b; b.bar = bar; b.x = xb_xcc_id(); b.st = st;
    if (threadIdx.x == 0) (void)xb_add(&bar[XB_XCNT(b.x)], 1u);
    return b;
}
__device__ __forceinline__ void xcd_barrier_complete(unsigned* bar, unsigned x, unsigned& nloc, unsigned& nx) {
    const unsigned G = gridDim.x * gridDim.y * gridDim.z;
    unsigned sum, cnt, mine, sp = 0u;
    for (;;) {
        sum = 0u; cnt = 0u; mine = 0u;
#pragma unroll
        for (unsigned j = 0; j < 16; ++j) { const unsigned c = xb_ld(&bar[XB_XCNT(j)]); sum += c; cnt += (c > 0u) ? 1u : 0u; mine = (j == x) ? c : mine; }
        if (sum == G) break;
        __builtin_amdgcn_s_sleep(1);
        if ((++sp & 255u) == 0u) { if (xb_ld(&bar[XB_TMO])) break; if (sp > XB_SPIN_CAP) { atomicAdd(&bar[XB_TMO], 1u); break; } }
    }
    nloc = mine > 0u ? mine : 1u; nx = cnt > 0u ? cnt : 1u;
}
__device__ __forceinline__ void xcd_barrier(const XcdBarrier& b) {
    asm volatile("s_waitcnt vmcnt(0)" ::: "memory");
    __syncthreads();
    if (threadIdx.x == 0) {
        unsigned* bar = b.bar; asm volatile("" : "+s"(bar));
        __builtin_amdgcn_s_waitcnt(0);
        unsigned nloc = b.st[0], nx = b.st[1];
        if (nloc == 0u) { xcd_barrier_complete(bar, b.x, nloc, nx); b.st[0] = nloc; b.st[1] = nx; }
        const unsigned old = xb_add(&bar[XB_XSUB(b.x)], 1u);
        const unsigned gen = old / nloc;
        if (old + 1u == (gen + 1u) * nloc) {
            __builtin_amdgcn_fence(__ATOMIC_RELEASE, "agent");
            asm volatile("s_waitcnt vmcnt(0)" ::: "memory");
            const unsigned og = xb_add(&bar[XB_TOP], 1u);
            const unsigned tg = og / nx;
            if (og + 1u == (tg + 1u) * nx) xb_add(&bar[XB_TOPGEN], 1u);
            else XB_SPIN(xb_ld(&bar[XB_TOPGEN]) == tg, bar);
            __builtin_amdgcn_fence(__ATOMIC_ACQUIRE, "agent");
            xb_add(&bar[XB_XGEN(b.x)], 1u);
            asm volatile("s_waitcnt vmcnt(0)" ::: "memory");
        } else {
            XB_SPIN(xb_ld(&bar[XB_XGEN(b.x)]) == gen, bar);
            __builtin_amdgcn_fence(__ATOMIC_ACQUIRE, "agent");
            asm volatile("s_waitcnt vmcnt(0)" ::: "memory");
        }
    }
    __syncthreads();
}

struct NormJob { int mode; const float* g; const float* modl; int mdo; unsigned* cnt; unsigned* bar; bf16* H; float* out; const float* dbg; };
template <bool COH, int NRB>
__device__ __forceinline__ void norm_rows(Ctx& c, const NormJob& nj, int row0, int nrows) {
    const int w = __builtin_amdgcn_readfirstlane(c.tid >> 6); int lane = lane_id_fresh();
    const bf16* XR = (const bf16*)nj.out;
    for (int r = row0 + NRB * w; r < row0 + nrows; r += 8 * NRB) {
        f32x4 v[NRB][4]; float rstd[NRB];
#pragma unroll
        for (int i = 0; i < NRB; ++i)
#pragma unroll
            for (int j = 0; j < 2; ++j) { const bf16* p = XR + (size_t)(r + i) * XS + 8 * lane + 512 * j;
                if constexpr (COH) { const unsigned long long q0 = __hip_atomic_load((const unsigned long long*)p, __ATOMIC_RELAXED, __HIP_MEMORY_SCOPE_AGENT), q1 = __hip_atomic_load((const unsigned long long*)p + 1, __ATOMIC_RELAXED, __HIP_MEMORY_SCOPE_AGENT);
                    v[i][2 * j] = (f32x4){bf2f((unsigned)q0 & 0xffffu), bf2f((unsigned)q0 >> 16), bf2f((unsigned)(q0 >> 32) & 0xffffu), bf2f((unsigned)(q0 >> 48))};
                    v[i][2 * j + 1] = (f32x4){bf2f((unsigned)q1 & 0xffffu), bf2f((unsigned)q1 >> 16), bf2f((unsigned)(q1 >> 32) & 0xffffu), bf2f((unsigned)(q1 >> 48))}; }
                else ld_bf8(p, v[i][2 * j], v[i][2 * j + 1]); }
#pragma unroll
        for (int i = 0; i < NRB; ++i) { float ss = 0.f;
#pragma unroll
            for (int j = 0; j < 4; ++j) ss += (v[i][j][0] * v[i][j][0] + v[i][j][1] * v[i][j][1]) + (v[i][j][2] * v[i][j][2] + v[i][j][3] * v[i][j][3]);
            rstd[i] = 1.0f / sqrtf(wave_sum(ss) * (1.0f / D) + EPS); }
        if (nj.mode == 1) {
#pragma unroll
            for (int j = 0; j < 2; ++j) { const int cc = 8 * lane + 512 * j;
                const f32x4 g0 = *(const f32x4*)(nj.g + cc), g1 = *(const f32x4*)(nj.g + cc + 4);
#pragma unroll
                for (int i = 0; i < NRB; ++i) { const float* md = nj.modl + (size_t)mod_row(r + i) * 6144 + nj.mdo + cc;
                    const f32x4 h0 = *(const f32x4*)md, h1 = *(const f32x4*)(md + 4), c0 = *(const f32x4*)(md + 1024), c1 = *(const f32x4*)(md + 1028);
                    st_bf8(nj.H + (size_t)(r + i) * D + cc, v[i][2 * j] * rstd[i] * g0 * (1.0f + c0) + h0, v[i][2 * j + 1] * rstd[i] * g1 * (1.0f + c1) + h1); } }
        } else {
#pragma unroll
            for (int j = 0; j < 4; ++j) { const int cc = 8 * lane + 512 * (j >> 1) + 4 * (j & 1); const f32x4 gg = *(const f32x4*)(nj.g + cc);
#pragma unroll
                for (int i = 0; i < NRB; ++i) { f32x4 y = v[i][j] * rstd[i] * gg; if (PROBE_T && r + i == 0 && cc == 0) y[0] += *nj.dbg;
                    *(f32x4*)(nj.out + (size_t)(r + i) * D + cc) = y; } }
        }
    }
}
struct NoPost { __device__ __forceinline__ void operator()(Ctx&, int) const {} };
struct NormPost { NormJob nj; int ncg;
    __device__ __forceinline__ void operator()(Ctx& c, int rg) const {
        if (nj.mode == 0) return;
        volatile LAS unsigned* MISC = (volatile LAS unsigned*)(c.lds + MISC_OFF);
        asm volatile("s_waitcnt vmcnt(0)" ::: "memory"); __syncthreads();
        if (threadIdx.x == 0) { const unsigned old = xb_add(nj.cnt + (64 + rg) * 16, 1u); MISC[16] = old; }
        __syncthreads();
        if (MISC[16] == (unsigned)(ncg - 1)) { asm volatile("" ::: "memory"); norm_rows<true, 4>(c, nj, MP + 32 * rg, 32); }
    } };
template <int RA, int CB, int NBLK, int SB, class E, class P>
__device__ __forceinline__ void sample_gemm_splitk(Ctx& c, const bf16* A, const bf16* Bt, int N, const E& e, int r0, int r1, const P& post) {
    constexpr int K = NBLK * 64 * 8, NRG = 8 / RA, LRG = (NRG == 4 ? 2 : (NRG == 2 ? 1 : 0)), NF = RA + CB, FRB = 16 * 144;
    LAS unsigned char* lds = c.lds;
    const int tid = c.tid, lane = tid & 63, w = __builtin_amdgcn_readfirstlane(tid >> 6), fr = lane & 15, fq = lane >> 4, lr = lane >> 3, lp = lane & 7;
    LAS unsigned char* wl = lds + w * (NF * FRB);
    const bf16* As = A + (size_t)MP * K;
    const int nitems = NRG * (N / (16 * CB));
    for (int r = r0; r < r1; ++r) { const int it = c.G - 1 - c.wg + r * c.G; if (it >= nitems) break;
        const int rg = (it >> 3) & (NRG - 1), cg = (it & 7) + 8 * (it >> (3 + LRG));
        const int m0 = rg * 16 * RA, n0 = cg * 16 * CB;
        f32x4 acc[RA][CB];
#pragma unroll
        for (int i = 0; i < RA; ++i)
#pragma unroll
            for (int j = 0; j < CB; ++j) acc[i][j] = (f32x4){0.f, 0.f, 0.f, 0.f};
        const bf16* pa = As + (size_t)(m0 + lr) * K + w * (K / 8) + lp * 8;
        const bf16* pb = Bt + (size_t)(n0 + lr) * K + w * (K / 8) + lp * 8;
        __syncthreads();
#pragma unroll
        for (int b0 = 0; b0 < NBLK; b0 += SB) {
            u32x4 rr[SB][NF][2];
#pragma unroll
            for (int b = 0; b < SB; ++b)
#pragma unroll
                for (int f = 0; f < NF; ++f)
#pragma unroll
                    for (int i2 = 0; i2 < 2; ++i2) rr[b][f][i2] = *(const u32x4*)((f < CB ? pb + (size_t)(16 * f + 8 * i2) * K : pa + (size_t)(16 * (f - CB) + 8 * i2) * K) + 64 * (b0 + b));
#pragma unroll
            for (int b = 0; b < SB; ++b) {
#pragma unroll
                for (int f = 0; f < NF; ++f)
#pragma unroll
                    for (int i2 = 0; i2 < 2; ++i2) *(LAS u32x4*)(wl + f * FRB + (lr + 8 * i2) * 144 + lp * 16) = rr[b][f][i2];
                asm volatile("s_waitcnt lgkmcnt(0)" ::: "memory");
                bf16x8 fg[NF][2];
#pragma unroll
                for (int f = 0; f < NF; ++f)
#pragma unroll
                    for (int h = 0; h < 2; ++h) fg[f][h] = *(const LAS bf16x8*)(wl + f * FRB + fr * 144 + fq * 32 + h * 16);
                asm volatile("s_waitcnt lgkmcnt(0)" ::: "memory");
#pragma unroll
                for (int h = 0; h < 2; ++h)
#pragma unroll
                    for (int i = 0; i < RA; ++i)
#pragma unroll
                        for (int j = 0; j < CB; ++j) acc[i][j] = __builtin_amdgcn_mfma_f32_16x16x32_bf16(fg[j][h], fg[CB + i][h], acc[i][j], 0, 0, 0);
            }
        }
        __syncthreads();
#pragma unroll
        for (int i = 0; i < RA; ++i)
#pragma unroll
            for (int j = 0; j < CB; ++j) *(LAS f32x4*)(lds + (((w * RA + i) * CB + j) * 64 + lane) * 16) = acc[i][j];
        __syncthreads();
        if (tid < RA * CB * 64) {
            const int f = tid >> 6, i = f / CB, j = f % CB;
            f32x4 s = *(const LAS f32x4*)(lds + (f * 64 + lane) * 16);
#pragma unroll
            for (int ww = 1; ww < 8; ++ww) { const f32x4 t = *(const LAS f32x4*)(lds + ((ww * RA * CB + f) * 64 + lane) * 16); s[0] += t[0]; s[1] += t[1]; s[2] += t[2]; s[3] += t[3]; }
            e.quad(MP + m0 + 16 * i + fr, n0 + 16 * j + 4 * fq, s);
        }
        post(c, rg);
    }
    __syncthreads();
}
template <class E, class P = NoPost>
__device__ __forceinline__ void sample_gemm_phase(Ctx& c, const bf16* A, const bf16* Bt, int N, int K, const E& e, int r0 = 0, int r1 = 1 << 20, const P& post = P()) {
    if (K == 4096) sample_gemm_splitk<2, 1, 8, 4>(c, A, Bt, N, e, r0, r1, post);
    else if (N == 1024) sample_gemm_splitk<2, 1, 2, 2>(c, A, Bt, N, e, r0, r1, post);
    else sample_gemm_splitk<4, 2, 2, 2>(c, A, Bt, N, e, r0, r1, post);
}
__device__ __forceinline__ int sample_rounds(int N, int K, int G) { const int nitems = (K == 4096 || N == 1024) ? 4 * (N / 16) : 2 * (N / 32); return (nitems + G - 1) / G; }

template <bool FUSED> __device__ __forceinline__ void hgrn_prep_items(CArgs& a, Ctx& c, int fbase);
template <int SITE, class E, bool ABLK = false>
__device__ __forceinline__ void gemm_phase_sel(Ctx& c, const bf16* A, const bf16* Bt, int M, int N, int K, const E& e, const bf16* As_rowmajor = nullptr, float* dbg_ptr = nullptr, const NormJob nj = NormJob{0, nullptr, nullptr, 0, nullptr, nullptr, nullptr, nullptr, nullptr}, CArgs* ap = nullptr) {
    if constexpr ((FAST_GEMM >> SITE) & 1) {
        const int nr = sample_rounds(N, K, c.G);
        unsigned long long gt0_ = 0ull; if (PROBE_T >= 40 && PROBE_T < 50 && SITE == PROBE_SITE) gt0_ = __builtin_amdgcn_s_memrealtime();
        const int pre = STAGGER ? ((c.wg >> 3) & 1) * nr : 0;
        int mid_done = 0;
#pragma nounroll
        for (int pass = 0; pass < 3; ++pass) {
            if (pass != 1) {
                { int t_ = threadIdx.x; asm volatile("" : "+v"(t_)); c.tid = t_; }
                unsigned long long st0_ = 0ull; if (PROBE_T == 30 + SITE) st0_ = __builtin_amdgcn_s_memrealtime();
                if constexpr (SITE == 3 || SITE == 5) { NormPost post{nj, N / 16}; sample_gemm_phase(c, A, Bt, N, K, e, pass == 0 ? 0 : pre, pass == 0 ? pre : nr, post); }
                else sample_gemm_phase(c, ABLK ? As_rowmajor - (size_t)MP * K : A, Bt, N, K, e, pass == 0 ? 0 : (mid_done ? nr : pre), pass == 0 ? pre : nr);
                if (PROBE_T == 30 + SITE && c.wg == c.G - 9 && threadIdx.x == 0 && pass == 2) *dbg_ptr = (float)(__builtin_amdgcn_s_memrealtime() - st0_) * 1e-3f;
            } else {
                { int t_ = threadIdx.x; asm volatile("" : "+v"(t_)); c.tid = t_; }
                pg8::Gemm g{A, Bt, MP, N, K, A, Bt, ABLK ? 1 : 0}; PowOrder S; S.init(N == 1024 ? 2 : (N == 4096 ? 4 : 5), c.G, c.wg);
                if constexpr (SITE == 3 || SITE == 5) {
                    if (nj.mode && threadIdx.x == 0) { const unsigned xcc = xb_xcc_id();
                        for (int i = 0; ; ++i) { pg8::Unit u; if (!S.next(i, u)) break;
                            (void)__hip_atomic_fetch_or(nj.cnt + u.pm * 16 + 9, 1u << xcc, __ATOMIC_RELAXED, __HIP_MEMORY_SCOPE_AGENT); asm volatile("s_waitcnt vmcnt(0)" ::: "memory");
                            (void)xb_add(nj.cnt + u.pm * 16 + 8, 1u); } }
                }
                if constexpr (((PROBE_KL >> SITE) & 1) != 0) { S.two = 1;
                    if constexpr (E::BY_REGION) { SkipZ0<EpiInUnit> qe{EpiInUnit{e}, EpiInUnit{e}}; pg8::gemm_phase<SkipZ0<EpiInUnit>, PowOrder, true, true>(c.lds, g, S, qe, c.tid); }
                    else { E ed = e; if constexpr (SITE == 4) ed.dummy = 1; SkipZ0<OctEpi<E>> qe{OctEpi<E>{e}, OctEpi<E>{ed}}; pg8::gemm_phase<SkipZ0<OctEpi<E>>, PowOrder, GEMM_ALIGN, GEMM_SP2>(c.lds, g, S, qe, c.tid); }
                    S.two = 0; }
                else if constexpr (E::BY_REGION) {
                    const bool fuse_prep = FUSE_PREP && ap != nullptr && c.G == 256;
#pragma nounroll
                    for (int part = 0; part < (fuse_prep ? 2 : 1); ++part) {
                        const int ps = ((c.wg >> 3) & 1) ? 6 : 3;
                        if (fuse_prep) { S.ib = part ? ps : 0; S.ie = part ? (1 << 30) : ps; }
                        { int t_ = threadIdx.x; asm volatile("" : "+v"(t_)); c.tid = t_; }
                        EpiInUnit qe{e}; pg8::gemm_phase<EpiInUnit, PowOrder, true, true>(c.lds, g, S, qe, c.tid);
                        if (fuse_prep && part == 0) { pg8::Unit u0; S.ib = 0; S.ie = 1; (void)S.next(0, u0);
                            { int t_ = threadIdx.x; asm volatile("" : "+v"(t_)); c.tid = t_; }
                            unsigned long long pq0_ = 0ull; if (PROBE_T == 45) pq0_ = __builtin_amdgcn_s_memrealtime();
                            hgrn_prep_items<true>(*ap, c, (u0.pm >> 3) * 256 + 32 * (u0.pm & 7) + 2 * u0.pn);
                            if (PROBE_T == 45 && c.wg == 0 && threadIdx.x == 0) *dbg_ptr = (float)(__builtin_amdgcn_s_memrealtime() - pq0_) * 1e-3f; }
                        if (fuse_prep && part == 0 && pre == 0) { { int t_ = threadIdx.x; asm volatile("" : "+v"(t_)); c.tid = t_; }
                            sample_gemm_phase(c, A, Bt, N, K, e, 0, nr); mid_done = 1; }
                    }
                }
                else if constexpr (SITE == 3 || SITE == 5) { EpiResUnit qe{e}; pg8::gemm_phase<EpiResUnit, PowOrder, GEMM_ALIGN, GEMM_SP2>(c.lds, g, S, qe, c.tid); }
                else { OctEpi<E> qe{e}; pg8::gemm_phase<OctEpi<E>, PowOrder, GEMM_ALIGN, GEMM_SP2>(c.lds, g, S, qe, c.tid); }
                if (PROBE_T == 40 && SITE == PROBE_SITE && c.wg == 0 && threadIdx.x == 0) *dbg_ptr = (float)(__builtin_amdgcn_s_memrealtime() - gt0_) * 1e-3f;
                if constexpr (SITE == 3 || SITE == 5) {
                    if (nj.mode) {
                        { int t_ = threadIdx.x; asm volatile("" : "+v"(t_)); c.tid = t_; }
                        volatile LAS unsigned* MISC = (volatile LAS unsigned*)(c.lds + MISC_OFF);
                        const unsigned npn = (unsigned)(N >> 8);
                        for (int i = 0; ; ++i) { pg8::Unit u; if (!S.next(i, u)) break;
                            __syncthreads();
                            if (threadIdx.x == 0) { unsigned* p = nj.cnt + u.pm * 16;
                                const unsigned av = xb_ld(p + 8), xm = xb_ld(p + 9);
                                if (!(av == npn && (xm & (xm - 1u)) == 0u)) { __builtin_amdgcn_fence(__ATOMIC_RELEASE, "agent"); asm volatile("s_waitcnt vmcnt(0)" ::: "memory"); }
                                (void)xb_add(p, 1u); unsigned v = 0u;
                                XB_SPIN(((v = xb_ld(p)) & 255u) < npn, nj.bar);
                                __builtin_amdgcn_fence(__ATOMIC_ACQUIRE, "agent");
                                asm volatile("s_waitcnt vmcnt(0)" ::: "memory"); }
                            __syncthreads();
                            asm volatile("" ::: "memory");
                            norm_rows<false, 8>(c, nj, u.pm * 256 + u.pn * (256 / (N >> 8)), 256 / (N >> 8));
                        }
                    }
                }
                if (PROBE_T == 41 && SITE == PROBE_SITE && c.wg == 0 && threadIdx.x == 0) *dbg_ptr = (float)(__builtin_amdgcn_s_memrealtime() - gt0_) * 1e-3f;
            }
        }
        if (PROBE_T == 42 && SITE == PROBE_SITE && c.wg == 0 && threadIdx.x == 0) *dbg_ptr = (float)(__builtin_amdgcn_s_memrealtime() - gt0_) * 1e-3f;
        if ((PROBE_T == 43 || PROBE_T == 44) && SITE == PROBE_SITE && threadIdx.x == 0) { const float el = (float)(__builtin_amdgcn_s_memrealtime() - gt0_) * 1e-3f;
            if (PROBE_T == 43) { unsigned* mx = (unsigned*)dbg_ptr - (WS_DBG - WS_CTL) / 4 + 15360; const unsigned o = atomicMax(mx, __float_as_uint(el)); if (o < __float_as_uint(el)) *dbg_ptr = el; }
            else atomicMin((unsigned*)dbg_ptr, __float_as_uint(el)); }
    } else naive_gemm_phase(c, A, Bt, M, N, K, e);
}

__device__ __forceinline__ void p0_transpose_item(const float* W, int K, int N, bf16* WT, LAS float* scr, int item, int lane) {
    const int nblk = N / 32, kb = item / nblk, nb = item % nblk, k0 = 64 * kb, n0 = 32 * nb;
    float v[32];
#pragma unroll
    for (int i = 0; i < 32; ++i) v[i] = W[(size_t)(k0 + 2 * i + (lane >> 5)) * N + n0 + (lane & 31)];
#pragma unroll
    for (int i = 0; i < 32; ++i) scr[(2 * i + (lane >> 5)) * 33 + (lane & 31)] = v[i];
    asm volatile("s_waitcnt lgkmcnt(0)" ::: "memory");
    const int ch = lane & 7;
#pragma unroll
    for (int j = 0; j < 4; ++j) { const int n = (lane >> 3) + 8 * j; const LAS float* s = scr + (8 * ch) * 33 + n;
        u32x4 o; o.x = pk2(s[0 * 33], s[1 * 33]); o.y = pk2(s[2 * 33], s[3 * 33]); o.z = pk2(s[4 * 33], s[5 * 33]); o.w = pk2(s[6 * 33], s[7 * 33]);
        *(u32x4*)(WT + (size_t)(n0 + n) * K + k0 + 8 * ch) = o; }
    asm volatile("s_waitcnt lgkmcnt(0)" ::: "memory");
}
__device__ __forceinline__ void p0_work(CArgs& a, Ctx& c, int vw, int nvw, bool with_tables, int tr_sel, bool do_mod) {
    if (tr_sel) {
        LAS float* scr = (LAS float*)(c.lds + __builtin_amdgcn_readfirstlane(c.tid >> 6) * 16384);
        const int gw = vw * 8 + __builtin_amdgcn_readfirstlane(c.tid >> 6), NGW = nvw * 8;
        constexpr int I_IN = 16 * 256, I_SQ = 16 * 32, I_1 = 16 * 128, I_2 = 64 * 32, I_L = 8 * 8, PER_L = I_IN + 3 * I_SQ + I_1 + I_2 + 2 * I_L;
        const bool defer = P0_DEFER && nvw > 208, under = defer && P0_UNDER;
        constexpr int SQ3 = 3 * I_SQ, MID = SQ3 + I_1 + I_2, DEF_B = PER_L + I_IN + SQ3, DEF_BN = I_1 + I_2;
        const int NV = under ? I_IN + 2 * I_L + SQ3 + 2 * I_L : defer ? PER_L + SQ3 + 2 * I_L : 2 * PER_L, N1 = under ? 192 * 10 : defer ? 192 * 8 * 4 : 192 * 8 * 8;
        const int wv = __builtin_amdgcn_readfirstlane(c.tid >> 6);
        int v0, vn, vs;
        if (tr_sel == 4) { v0 = vw * 8 + wv; vn = MID; vs = nvw * 8; }
        else if (tr_sel >= 2) { v0 = (vw - 208) * 8 + wv; vn = tr_sel == 2 ? I_IN : DEF_BN; vs = (nvw - 208) * 8; }
        else { v0 = vw < 192 ? vw * 8 + wv : N1 + (vw - 192) * 8 + wv; vn = vw < 192 ? N1 : NV; vs = vw < 192 ? 192 * 8 : (nvw - 192) * 8; }
        (void)gw; (void)NGW;
        for (int v = v0; v < vn; v += vs) {
            int it;
            if (tr_sel == 4) it = I_IN + v;
            else if (tr_sel == 2) it = PER_L + v;
            else if (tr_sel == 3) it = DEF_B + v;
            else if (under) { const int v2 = v - I_IN - 2 * I_L; it = v < I_IN ? v : (v2 < 0 ? v + MID : (v2 < SQ3 ? PER_L + I_IN + v2 : PER_L + I_IN + MID + (v2 - SQ3))); }
            else it = (!defer || v < PER_L) ? v : (v - PER_L < SQ3 ? v + I_IN : v + I_IN + DEF_BN);
            const int lt = it < PER_L ? 0 : 1; int r = it < PER_L ? it : it - PER_L;
            bf16* wl = (bf16*)(a.ws + WS_W + (size_t)lt * WL_STRIDE);
            if (r < I_IN) { p0_transpose_item(a.in[11] + (size_t)lt * D * NIN, D, NIN, wl + OFF_WIN / 2, scr, r, (c.tid & 63)); continue; } r -= I_IN;
            if (r < I_SQ) { p0_transpose_item(a.in[21] + (size_t)lt * D * D, D, D, wl + OFF_WA / 2, scr, r, (c.tid & 63)); continue; } r -= I_SQ;
            if (r < I_SQ) { p0_transpose_item(a.in[22] + (size_t)lt * D * D, D, D, wl + OFF_WB / 2, scr, r, (c.tid & 63)); continue; } r -= I_SQ;
            if (r < I_SQ) { p0_transpose_item(a.in[23] + (size_t)lt * D * D, D, D, wl + OFF_WO / 2, scr, r, (c.tid & 63)); continue; } r -= I_SQ;
            if (r < I_1) { p0_transpose_item(a.in[24] + (size_t)lt * D * FF, D, FF, wl + OFF_W1 / 2, scr, r, (c.tid & 63)); continue; } r -= I_1;
            if (r < I_2) { p0_transpose_item(a.in[25] + (size_t)lt * FF * D, FF, D, wl + OFF_W2 / 2, scr, r, (c.tid & 63)); continue; } r -= I_2;
            if (r < I_L) { const int n = r >> 3; p0_transpose_item(a.in[16] + ((size_t)lt * 8 + n) * 16384, 128, 128, wl + OFF_LWA / 2 + n * 16384, scr, r & 7, (c.tid & 63)); continue; } r -= I_L;
            { const int n = r >> 3; p0_transpose_item(a.in[18] + ((size_t)lt * 8 + n) * 16384, 128, 128, wl + OFF_LWX / 2 + n * 16384, scr, r & 7, (c.tid & 63)); }
        }
    }
    if (with_tables) {
        float* lbt = (float*)(a.ws + WS_TAB); float* sp = (float*)(a.ws + WS_TAB + 32768);
        const int gid = vw * 512 + c.tid;
        if (gid < 2 * D) {
            const int ll = gid >> 10, col = gid & 1023;
            const float h0 = a.in[12][col], h1 = a.in[12][D + col];
            const float p1 = 1.0f / (1.0f + expf(h0 - h1));
            const float lb = ll == 0 ? 0.f : p1;
            lbt[(ll * 3 + 0) * D + col] = lb; lbt[(ll * 3 + 1) * D + col] = logf(fmaxf(lb, 1e-30f)); lbt[(ll * 3 + 2) * D + col] = log1pf(-lb);
            sp[ll * D + col] = softplusf_(-a.in[20][ll * D + col]);
        }
    }
    __syncthreads();
    if (!do_mod) return;
    {
        constexpr int CS_STRIDE = 272;
        LAS unsigned char* csb = c.lds;
        LAS float* ws = (LAS float*)(c.lds + 39168);
        float* MOD = (float*)(a.ws + WS_MOD);
        const int lane = c.tid & 63, w = __builtin_amdgcn_readfirstlane(c.tid >> 6), fr = lane & 15, fq = lane >> 4, ct = w & 3, rt0 = w >> 2;
        for (int item2 = vw; item2 < 2 * 96; item2 += nvw) {
            const int l = item2 / 96, item = item2 % 96;
            const float* W = a.in[7] + (size_t)l * D * 6144 + item * 64;
            f32x4 acc[5];
#pragma unroll
            for (int i = 0; i < 5; ++i) acc[i] = (f32x4){0.f, 0.f, 0.f, 0.f};
            f32x4 cv[9], wv4[4];
#define MOD_LOAD(k0_) do { _Pragma("unroll") for (int i = 0; i < 9; ++i) { const int e4 = c.tid + 512 * i, r = e4 >> 5, kq = (e4 & 31) * 4; const int rr = r < NMOD ? r : 0; \
                const float* src = rr < NBATCH ? a.in[5] + (size_t)rr * D : a.in[6] + (size_t)(rr - NBATCH) * D; cv[i] = *(const f32x4*)(src + (k0_) + kq); } \
              _Pragma("unroll") for (int i = 0; i < 4; ++i) { const int e4 = c.tid + 512 * i, kk = e4 >> 4, c4 = (e4 & 15) * 4; wv4[i] = *(const f32x4*)(W + (size_t)((k0_) + kk) * 6144 + c4); } } while (0)
            MOD_LOAD(0);
            for (int k0 = 0; k0 < D; k0 += 128) {
                __syncthreads();
#pragma unroll
                for (int i = 0; i < 9; ++i) { const int e4 = c.tid + 512 * i, r = e4 >> 5, kq = (e4 & 31) * 4;
                    u32x2 pw; pw.x = pk2(siluf_(cv[i][0]), siluf_(cv[i][1])); pw.y = pk2(siluf_(cv[i][2]), siluf_(cv[i][3]));
                    if (r >= NMOD) { pw.x = 0u; pw.y = 0u; }
                    *(LAS u32x2*)(csb + r * CS_STRIDE + kq * 2) = pw; }
#pragma unroll
                for (int i = 0; i < 4; ++i) { const int e4 = c.tid + 512 * i, kk = e4 >> 4, c4 = (e4 & 15) * 4;
                    ws[kk * 65 + c4] = wv4[i][0]; ws[kk * 65 + c4 + 1] = wv4[i][1]; ws[kk * 65 + c4 + 2] = wv4[i][2]; ws[kk * 65 + c4 + 3] = wv4[i][3]; }
                if (k0 + 128 < D) MOD_LOAD(k0 + 128);
                WG_BAR();
#pragma unroll
                for (int ks = 0; ks < 4; ++ks) {
                    const LAS float* wp = ws + (32 * ks + 8 * fq) * 65 + 16 * ct + fr;
                    u32x4 bw; bw.x = pk2(wp[0], wp[65]); bw.y = pk2(wp[130], wp[195]); bw.z = pk2(wp[260], wp[325]); bw.w = pk2(wp[390], wp[455]);
                    const bf16x8 bfr = __builtin_bit_cast(bf16x8, bw);
#pragma unroll
                    for (int i = 0; i < 5; ++i) { const int rt = rt0 + 2 * i;
                        if (rt < 9) acc[i] = __builtin_amdgcn_mfma_f32_16x16x32_bf16(*(const LAS bf16x8*)(csb + (16 * rt + fr) * CS_STRIDE + (32 * ks + 8 * fq) * 2), bfr, acc[i], 0, 0, 0); }
                }
            }
#undef MOD_LOAD
            const float bm = a.in[8][(size_t)l * 6144 + item * 64 + 16 * ct + fr];
#pragma unroll
            for (int i = 0; i < 5; ++i) { const int rt = rt0 + 2 * i;
                if (rt < 9) {
#pragma unroll
                    for (int j = 0; j < 4; ++j) { const int row = 16 * rt + 4 * fq + j; if (row < NMOD) MOD[((size_t)l * NMOD + row) * 6144 + item * 64 + 16 * ct + fr] = acc[i][j] + bm; } } }
        }
    }
    __syncthreads();
}

__device__ __forceinline__ void norm_phase(CArgs& a, Ctx& c, int l, int which, const float* xp, const float* xs) {
    const int gw = c.wg * 8 + __builtin_amdgcn_readfirstlane(c.tid >> 6), NGW = c.G * 8;
    bf16* H = (bf16*)(a.ws + WS_H);
    const bf16* XR = (const bf16*)a.out;
    const float* MODL = (const float*)(a.ws + WS_MOD) + (size_t)l * NMOD * 6144;
    const float* g = a.in[which ? 10 : 9] + (size_t)l * D;
    const int lane = c.tid & 63;
    for (int row = gw; row < MR; row += NGW) {
        const float* md = MODL + (size_t)mod_row(row) * 6144 + (which ? 3 : 0) * 1024;
        f32x4 v[4]; float ss = 0.f;
        if (xp) { const float* xr = row < MP ? xp + (size_t)row * D : xs + (size_t)(row - MP) * D;
#pragma unroll
            for (int j = 0; j < 4; ++j) v[j] = *(const f32x4*)(xr + 8 * lane + 512 * (j >> 1) + 4 * (j & 1)); }
        else {
#pragma unroll
            for (int j = 0; j < 2; ++j) ld_bf8(XR + (size_t)row * XS + 8 * lane + 512 * j, v[2 * j], v[2 * j + 1]); }
#pragma unroll
        for (int j = 0; j < 4; ++j) ss += (v[j][0] * v[j][0] + v[j][1] * v[j][1]) + (v[j][2] * v[j][2] + v[j][3] * v[j][3]);
        const float rstd = 1.0f / sqrtf(wave_sum(ss) * (1.0f / D) + EPS);
#pragma unroll
        for (int j = 0; j < 2; ++j) { const int cc = 8 * lane + 512 * j;
            const f32x4 g0 = *(const f32x4*)(g + cc), g1 = *(const f32x4*)(g + cc + 4), h0 = *(const f32x4*)(md + cc), h1 = *(const f32x4*)(md + cc + 4), c0 = *(const f32x4*)(md + 1024 + cc), c1 = *(const f32x4*)(md + 1024 + cc + 4);
            st_bf8(H + (size_t)row * D + cc, v[2 * j] * rstd * g0 * (1.0f + c0) + h0, v[2 * j + 1] * rstd * g1 * (1.0f + c1) + h1); }
    }
}
__device__ __forceinline__ void final_norm_phase(CArgs& a, Ctx& c) {
    const int gw = c.wg * 8 + __builtin_amdgcn_readfirstlane(c.tid >> 6), NGW = c.G * 8;
    const float* g = a.in[26];
    const int lane = c.tid & 63;
    for (int row = gw; row < MR; row += NGW) {
        const bf16* xr = (const bf16*)a.out + (size_t)row * XS; float* yr = a.out + (size_t)row * D;
        f32x4 v[4]; float ss = 0.f;
#pragma unroll
        for (int j = 0; j < 2; ++j) ld_bf8(xr + 8 * lane + 512 * j, v[2 * j], v[2 * j + 1]);
#pragma unroll
        for (int j = 0; j < 4; ++j) ss += (v[j][0] * v[j][0] + v[j][1] * v[j][1]) + (v[j][2] * v[j][2] + v[j][3] * v[j][3]);
        const float rstd = 1.0f / sqrtf(wave_sum(ss) * (1.0f / D) + EPS);
#pragma unroll
        for (int j = 0; j < 4; ++j) { const int cc = 8 * lane + 512 * (j >> 1) + 4 * (j & 1); f32x4 y = v[j] * rstd * *(const f32x4*)(g + cc);
            if (PROBE_T && row == 0 && cc == 0) y[0] += *(const float*)(a.ws + WS_DBG);
            *(f32x4*)(yr + cc) = y; }
    }
}

__device__ __forceinline__ void hgrn_naive(CArgs& a, Ctx& c, int l, int row0, int ntok, int h, const float* S0, float* Sout) {
    LAS float* fs = (LAS float*)c.lds;
    LAS float* ks = fs + 2048;
    LAS float* qs = ks + 2048;
    LAS float* vs = qs + 2048;
    LAS float* part = vs + 2048;
    const bf16* Q = (const bf16*)(a.ws + WS_SQ) - (size_t)MP * D; const float* LOGF = (const float*)(a.ws + WS_SLOGF) - (size_t)MP * D;
    const bf16* V = (const bf16*)(a.ws + WS_V); const bf16* OG = (const bf16*)(a.ws + WS_OG); bf16* OA = (bf16*)(a.ws + WS_OA);
    const float* hg = a.in[13] + (size_t)l * DKV;
    const int v = c.tid & 127, kg = c.tid >> 7;
    float S[32];
#pragma unroll
    for (int i = 0; i < 32; ++i) S[i] = S0 ? __builtin_nontemporal_load(S0 + (size_t)(32 * kg + i) * DKV + v) : 0.f;
    for (int t0 = 0; t0 < ntok; t0 += 16) {
        const int nt = (ntok - t0) < 16 ? (ntok - t0) : 16;
        __syncthreads();
        { const int tt = c.tid >> 5, k4 = (c.tid & 31) * 4;
          if (tt < nt) { const size_t off = (size_t)(row0 + t0 + tt) * D + h * DKV + k4;
              const f32x4 lf = *(const f32x4*)(LOGF + off);
              *(LAS f32x4*)(fs + tt * 128 + k4) = (f32x4){expf(lf[0]), expf(lf[1]), expf(lf[2]), expf(lf[3])};
              *(LAS f32x4*)(ks + tt * 128 + k4) = (f32x4){1.0f - expf(lf[0]), 1.0f - expf(lf[1]), 1.0f - expf(lf[2]), 1.0f - expf(lf[3])};
              *(LAS f32x4*)(qs + tt * 128 + k4) = ld_bf4(Q + off);
              *(LAS f32x4*)(vs + tt * 128 + k4) = ld_bf4(V + off); } }
        __syncthreads();
        for (int tt = 0; tt < nt; ++tt) {
            const float vv = vs[tt * 128 + v]; float acc = 0.f;
#pragma unroll
            for (int i4 = 0; i4 < 8; ++i4) {
                const f32x4 f = *(const LAS f32x4*)(fs + tt * 128 + 32 * kg + 4 * i4), kk = *(const LAS f32x4*)(ks + tt * 128 + 32 * kg + 4 * i4), qq = *(const LAS f32x4*)(qs + tt * 128 + 32 * kg + 4 * i4);
#pragma unroll
                for (int j = 0; j < 4; ++j) { S[4 * i4 + j] = f[j] * S[4 * i4 + j] + kk[j] * vv; acc += S[4 * i4 + j] * qq[j]; }
            }
            part[(tt * 4 + kg) * 128 + v] = acc;
        }
        __syncthreads();
        { const int tt = c.tid >> 5, v4 = (c.tid & 31) * 4; const int tc = tt < nt ? tt : 0;
          const f32x4 o = *(const LAS f32x4*)(part + (tc * 4 + 0) * 128 + v4) + *(const LAS f32x4*)(part + (tc * 4 + 1) * 128 + v4)
                        + *(const LAS f32x4*)(part + (tc * 4 + 2) * 128 + v4) + *(const LAS f32x4*)(part + (tc * 4 + 3) * 128 + v4);
          float ss = (o[0] * o[0] + o[1] * o[1]) + (o[2] * o[2] + o[3] * o[3]);
          ss = half_sum(ss);
          const float rstd = 1.0f / sqrtf(ss * (1.0f / DKV) + EPS);
          if (tt < nt) { const size_t off = (size_t)(row0 + t0 + tt) * D + h * DKV + v4;
              st_bf4(OA + off, o * rstd * *(const f32x4*)(hg + v4) * ld_bf4(OG + off)); } }
    }
#pragma unroll
    for (int i = 0; i < 32; ++i) __builtin_nontemporal_store(S[i], Sout + (size_t)(32 * kg + i) * DKV + v);
    __syncthreads();
}


constexpr int HB_Q0 = 0, HB_K0 = 17408, HB_Q1 = 26112, HB_K1 = 34816, HB_KT0 = 43520, HB_KT1 = 53760, HB_VT = 64000, HB_AS = 82432, HB_ST = 91648, HB_VEC = 126464, HB_TOT = 128512, HB_SSQ = 130560;
constexpr int HS_Q = 272, HS_KT = 80, HS_VT = 144, HS_AS = 144;
constexpr int IM_Q0 = 0, IM_KT0 = 17408, IM_KT1 = 27648, IM_AS = 37888, IM_VEC = 47104, IM_BYTES = 49152;
constexpr int CB_IMG = 0, CB_VT = 2 * IM_BYTES, CB_ST = CB_VT + 16384, CB_SSQ = CB_ST + 34816;
static_assert(CB_SSQ + 2048 <= MISC_OFF, "hgrn consumer lds");
static_assert(HB_SSQ + 2048 <= MISC_OFF && 64 * 132 * 4 <= HB_VEC - HB_ST, "hgrn lds");
__device__ __forceinline__ float exp_c(float x) { return __expf(fminf(x, 80.f)); }
template <bool FUSED>
__device__ __forceinline__ void hgrn_prep_items(CArgs& a, Ctx& c, int fbase) {
#define PREP_IT(n_) (FUSED ? fbase + ((n_) >> 1) * 8 + ((n_) & 1) : c.wg + (n_) * c.G)
#define PREP_HAS(n_) (FUSED ? (n_) < 8 : PREP_IT(n_) < 2048)
    LAS unsigned char* lds = c.lds;
    const int tid = c.tid, cp = tid & 63, sg = tid >> 6;
    LAS float* VEC = (LAS float*)(lds + HB_VEC); LAS float* TOT = (LAS float*)(lds + HB_TOT);
    f32x2 lf[8]; unsigned qr[8], vr[8];
#define PREP_LOAD(it_) do { const unsigned char* bp_ = a.ws + WS_PREP + (size_t)(it_) * PREP_BLK; const int e0_ = (8 * sg) * 128 + 2 * cp; \
        const bf16* vs_ = (const bf16*)(a.ws + WS_V) + ((size_t)((it_) >> 8) * SEQ + 64 * (((it_) >> 3) & 31)) * D + ((it_) & 7) * DKV; \
        _Pragma("unroll") for (int i = 0; i < 8; ++i) { lf[i] = *(const f32x2*)((const float*)bp_ + e0_ + i * 128); qr[i] = *(const unsigned*)((const bf16*)(bp_ + 32768) + e0_ + i * 128); \
            vr[i] = *(const unsigned*)(vs_ + (size_t)(8 * sg + i) * D + 2 * cp); } } while (0)
    if (PREP_HAS(0)) PREP_LOAD(PREP_IT(0));
    const int lane = tid & 63, w = __builtin_amdgcn_readfirstlane(tid >> 6), fr = lane & 15, fq = lane >> 4;
    for (int e = tid; e < 2 * 16 * 16; e += 512) { const int which = e >> 8, r = (e >> 4) & 15, cc = e & 15;
        *(LAS bf16*)(lds + HB_AS + ((which ? 32 : 0) + r) * HS_AS + ((which ? 48 : 16) + cc) * 2) = 0; }
    for (int n = 0; PREP_HAS(n); ++n) { const int it = PREP_IT(n);
        unsigned char* bp = a.ws + WS_PREP + (size_t)it * PREP_BLK;
        const int pb = it >> 8, pn = (it >> 3) & 31, phh = it & 7;
        bf16* vslice = (bf16*)(a.ws + WS_V) + ((size_t)pb * SEQ + 64 * pn) * D + phh * DKV;
        f32x2 g[8], lfk[8]; g[0] = lf[0]; lfk[0] = lf[0];
#pragma unroll
        for (int i = 1; i < 8; ++i) { g[i] = g[i - 1] + lf[i]; lfk[i] = lf[i]; }
        WG_BAR();
        *(LAS f32x2*)(TOT + sg * 128 + 2 * cp) = g[7];
        WG_BAR();
        {
            f32x2 off = (f32x2){0.f, 0.f}, r0 = off, r1 = off, last = off;
#pragma unroll
            for (int s2 = 0; s2 < 8; ++s2) { const f32x2 tv = *(const LAS f32x2*)(TOT + s2 * 128 + 2 * cp);
                if (s2 < sg) off += tv; if (s2 < 2) r0 += tv; if (s2 < 6) r1 += tv; last += tv; }
            unsigned kt0[4], kt1[4], vt0[4], vt1[4];
#pragma unroll
            for (int i = 0; i < 8; ++i) {
                const f32x2 G = g[i] + off; const float q0 = bf2f(qr[i] & 0xffffu), q1 = bf2f(qr[i] >> 16), k0 = 1.0f - __expf(lfk[i].x), k1 = 1.0f - __expf(lfk[i].y);
                const int t = 8 * sg + i;
                *(LAS unsigned*)(lds + HB_Q0 + t * HS_Q + cp * 4) = pk2(q0 * exp_c(G.x - r0.x), q1 * exp_c(G.y - r0.y));
                if (sg < 4) *(LAS unsigned*)(lds + HB_K0 + t * HS_Q + cp * 4) = pk2(k0 * exp_c(r0.x - G.x), k1 * exp_c(r0.y - G.y));
                else { *(LAS unsigned*)(lds + HB_K1 + (t - 32) * HS_Q + cp * 4) = pk2(k0 * exp_c(r1.x - G.x), k1 * exp_c(r1.y - G.y));
                       *(LAS unsigned*)(lds + HB_Q1 + (t - 32) * HS_Q + cp * 4) = pk2(q0 * exp_c(G.x - r1.x), q1 * exp_c(G.y - r1.y)); }
                const unsigned kd = pk2(k0 * __expf(last.x - G.x), k1 * __expf(last.y - G.y));
                if (i & 1) { kt0[i >> 1] |= kd << 16; kt1[i >> 1] |= kd & 0xffff0000u; vt0[i >> 1] |= vr[i] << 16; vt1[i >> 1] |= vr[i] & 0xffff0000u; }
                else { kt0[i >> 1] = kd & 0xffffu; kt1[i >> 1] = kd >> 16; vt0[i >> 1] = vr[i] & 0xffffu; vt1[i >> 1] = vr[i] >> 16; }
            }
            { LAS unsigned char* p = lds + (sg < 4 ? HB_KT0 : HB_KT1) + (2 * cp) * HS_KT + (sg & 3) * 16;
              *(LAS u32x4*)p = (u32x4){kt0[0], kt0[1], kt0[2], kt0[3]}; *(LAS u32x4*)(p + HS_KT) = (u32x4){kt1[0], kt1[1], kt1[2], kt1[3]}; }
            { LAS unsigned char* p = lds + HB_VT + (2 * cp) * HS_VT + sg * 16;
              *(LAS u32x4*)p = (u32x4){vt0[0], vt0[1], vt0[2], vt0[3]}; *(LAS u32x4*)(p + HS_VT) = (u32x4){vt1[0], vt1[1], vt1[2], vt1[3]}; }
            if (sg == 0) *(LAS f32x2*)(VEC + 2 * cp) = (f32x2){exp_c(r0.x), exp_c(r0.y)};
            if (sg == 1) *(LAS f32x2*)(VEC + 128 + 2 * cp) = (f32x2){exp_c(last.x), exp_c(last.y)};
        }
        if (PREP_HAS(n + 1)) PREP_LOAD(PREP_IT(n + 1));
        WG_BAR();
#pragma unroll
        for (int rep = 0; rep < 2; ++rep) {
            const int id = w + 8 * rep;
            if (id < 10) {
                int tt, st;
                if (id == 0) { tt = 0; st = 0; } else if (id < 7) { tt = (id + 1) >> 1; st = (id + 1) & 1; } else if (id == 7) { tt = 2; st = 2; } else { tt = 3; st = id - 6; }
                const LAS unsigned char* ap = (st < 2) ? lds + HB_Q0 + (16 * tt + fr) * HS_Q : lds + HB_Q1 + (16 * (tt - 2) + fr) * HS_Q;
                const LAS unsigned char* bq = (st < 2) ? lds + HB_K0 + (16 * st + fr) * HS_Q : lds + HB_K1 + (16 * (st - 2) + fr) * HS_Q;
                f32x4 acc = (f32x4){0.f, 0.f, 0.f, 0.f};
#pragma unroll
                for (int ks = 0; ks < 4; ++ks) acc = __builtin_amdgcn_mfma_f32_16x16x32_bf16(*(const LAS bf16x8*)(ap + (32 * ks + 8 * fq) * 2), *(const LAS bf16x8*)(bq + (32 * ks + 8 * fq) * 2), acc, 0, 0, 0);
#pragma unroll
                for (int j = 0; j < 4; ++j) { const float v_ = (tt == st && fr > 4 * fq + j) ? 0.f : acc[j];
                    *(LAS bf16*)(lds + HB_AS + (16 * tt + 4 * fq + j) * HS_AS + (16 * st + fr) * 2) = (bf16)f2bf(v_); }
            }
        }
        WG_BAR();
        for (int p = tid; p < IM_BYTES / 16; p += 512) { const int o = p * 16;
            const int src = o < IM_KT0 ? HB_Q0 + o : (o < IM_KT1 ? HB_KT0 + (o - IM_KT0) : (o < IM_AS ? HB_KT1 + (o - IM_KT1) : (o < IM_VEC ? HB_AS + (o - IM_AS) : (o < IM_VEC + 1024 ? HB_VEC + (o - IM_VEC) : -1))));
            if (src >= 0) *(u32x4*)(bp + o) = *(const LAS u32x4*)(lds + src); }
#pragma unroll
        for (int i = 0; i < 2; ++i) { const int p = tid + 512 * i, v = p >> 3, pc = p & 7;
            *(u32x4*)((unsigned char*)(vslice + (size_t)(v >> 1) * D) + (v & 1) * 128 + pc * 16) = *(const LAS u32x4*)(lds + HB_VT + v * HS_VT + pc * 16); }
    }
#undef PREP_LOAD
#undef PREP_IT
#undef PREP_HAS
    __syncthreads();
}

__device__ __forceinline__ void hgrn_fast_prompt(CArgs& a, Ctx& c, int l, int b, int h) {
    LAS unsigned char* lds = c.lds;
    const int tid = c.tid, lane = tid & 63, w = __builtin_amdgcn_readfirstlane(tid >> 6), fr = lane & 15, fq = lane >> 4;
    const bf16* OG = (const bf16*)(a.ws + WS_OG); bf16* OA = (bf16*)(a.ws + WS_OA);
    const unsigned char* blk0 = a.ws + WS_PREP + ((size_t)b * 32 * 8 + h) * PREP_BLK;
    const size_t base = (size_t)b * SEQ * D + (size_t)h * DKV;
    const unsigned char* vt0 = (const unsigned char*)((const bf16*)(a.ws + WS_V) + (size_t)b * SEQ * D + h * DKV);
    LAS float* SSQ = (LAS float*)(lds + CB_SSQ);
    LAS unsigned char* STw = lds + CB_ST + w * 4352;
    const float gv = a.in[13][(size_t)l * DKV + 16 * w + fr];
    const int orow = tid >> 4, oc8 = (tid & 15) * 8;
    f32x4 S[8];
#pragma unroll
    for (int i = 0; i < 8; ++i) S[i] = (f32x4){0.f, 0.f, 0.f, 0.f};
    __syncthreads();
#define HG_DMA_IMG(n_, buf_) do { const unsigned char* bp_ = blk0 + (size_t)(n_) * 8 * PREP_BLK + lane * 16; \
        _Pragma("unroll") for (int i = 0; i < 6; ++i) __builtin_amdgcn_global_load_lds((const unsigned*)(bp_ + (w + 8 * i) * 1024), (LAS unsigned*)(lds + CB_IMG + (buf_) * IM_BYTES + (w + 8 * i) * 1024), 16, 0, 0); } while (0)
#define HG_DMA_VT(n_) do { _Pragma("unroll") for (int i = 0; i < 2; ++i) { const int q_ = (w + 8 * i) * 64 + lane, v_ = q_ >> 3, lp_ = (q_ & 7) ^ (v_ & 7); \
        __builtin_amdgcn_global_load_lds((const unsigned*)(vt0 + ((size_t)(64 * (n_) + (v_ >> 1)) * D) * 2 + (v_ & 1) * 128 + lp_ * 16), (LAS unsigned*)(lds + CB_VT + (w + 8 * i) * 1024), 16, 0, 0); } } while (0)
    HG_DMA_IMG(0, 0); HG_DMA_VT(0);
    unsigned long long tacc = 0ull, tst = 0ull;
#define TSTART(id) do { if (PROBE_T == (id)) { __builtin_amdgcn_sched_barrier(0); tst = __builtin_amdgcn_s_memtime(); __builtin_amdgcn_sched_barrier(0); } } while (0)
#define TSTOP(id) do { if (PROBE_T == (id)) { __builtin_amdgcn_sched_barrier(0); tacc += __builtin_amdgcn_s_memtime() - tst; __builtin_amdgcn_sched_barrier(0); } } while (0)
    for (int nn = 0; nn < (SEQ / 64) * (1 + (PROBE_MIX & 1)); ++nn) {
        const int n = nn & (SEQ / 64 - 1), cur = nn & 1;
        if (PROBE_MIX & 1) { if (nn == SEQ / 64) {
#pragma unroll
            for (int i = 0; i < 8; ++i) S[i] = (f32x4){0.f, 0.f, 0.f, 0.f}; } }
        TSTART(1); TSTART(2);
        LAS unsigned char* img = lds + CB_IMG + cur * IM_BYTES; LAS float* VEC = (LAS float*)(img + IM_VEC);
        u32x4 ogv[2];
        { const bf16* gp0 = OG + base + (size_t)(64 * n + orow) * D + oc8; const bf16* gp1 = gp0 + (size_t)32 * D;
          asm volatile("global_load_dwordx4 %0, %1, off" : "=v"(ogv[0]) : "v"(gp0) : "memory");
          asm volatile("global_load_dwordx4 %0, %1, off" : "=v"(ogv[1]) : "v"(gp1) : "memory"); }
        asm volatile("s_waitcnt vmcnt(6)" ::: "memory");
        WG_BAR();
        if ((PROBE_MIX & 1) || n + 1 < SEQ / 64) HG_DMA_IMG((n + 1) & (SEQ / 64 - 1), cur ^ 1);
        TSTOP(2); TSTART(3);
        { f32x4 er[8];
#pragma unroll
          for (int kt8 = 0; kt8 < 8; ++kt8) er[kt8] = *(const LAS f32x4*)(VEC + 16 * kt8 + 4 * fq);
          u32x2 pw[8];
#pragma unroll
          for (int kt8 = 0; kt8 < 8; ++kt8) { pw[kt8].x = pk2(S[kt8][0] * er[kt8][0], S[kt8][1] * er[kt8][1]); pw[kt8].y = pk2(S[kt8][2] * er[kt8][2], S[kt8][3] * er[kt8][3]); }
#pragma unroll
          for (int kt8 = 0; kt8 < 8; ++kt8) *(LAS u32x2*)(STw + fr * HS_Q + (16 * kt8 + 4 * fq) * 2) = pw[kt8]; }
        f32x4 o[4];
#pragma unroll
        for (int tt = 0; tt < 4; ++tt) o[tt] = (f32x4){0.f, 0.f, 0.f, 0.f};
#pragma unroll
        for (int ks = 0; ks < 4; ++ks) { const bf16x8 bfr = *(const LAS bf16x8*)(STw + fr * HS_Q + (32 * ks + 8 * fq) * 2);
#pragma unroll
            for (int tt = 0; tt < 4; ++tt) o[tt] = __builtin_amdgcn_mfma_f32_16x16x32_bf16(*(const LAS bf16x8*)(img + IM_Q0 + (16 * tt + fr) * HS_Q + (32 * ks + 8 * fq) * 2), bfr, o[tt], 0, 0, 0); }
        if ((PROBE_MIX & 1) || n + 1 < SEQ / 64) asm volatile("s_waitcnt vmcnt(10)" ::: "memory");
        else asm volatile("s_waitcnt vmcnt(4)" ::: "memory");
        WG_BAR();
        TSTOP(3); TSTART(4);
        const LAS unsigned char* vrow = lds + CB_VT + (16 * w + fr) * 128; const int vsw = (16 * w + fr) & 7;
#pragma unroll
        for (int tt = 0; tt < 4; ++tt)
#pragma unroll
            for (int ks = 0; ks < 2; ++ks) if (ks == 0 || tt >= 2)
                o[tt] = __builtin_amdgcn_mfma_f32_16x16x32_bf16(*(const LAS bf16x8*)(img + IM_AS + (16 * tt + fr) * HS_AS + (32 * ks + 8 * fq) * 2), *(const LAS bf16x8*)(vrow + (((4 * ks + fq) ^ vsw) * 16)), o[tt], 0, 0, 0);
        { f32x4 eL[8]; bf16x8 ka[8];
#pragma unroll
          for (int kt8 = 0; kt8 < 8; ++kt8) { eL[kt8] = *(const LAS f32x4*)(VEC + 128 + 16 * kt8 + 4 * fq); ka[kt8] = *(const LAS bf16x8*)(img + IM_KT0 + (16 * kt8 + fr) * HS_KT + 8 * fq * 2); }
          const bf16x8 vb0 = *(const LAS bf16x8*)(vrow + ((fq ^ vsw) * 16)), vb1 = *(const LAS bf16x8*)(vrow + (((4 + fq) ^ vsw) * 16));
#pragma unroll
          for (int kt8 = 0; kt8 < 8; ++kt8) S[kt8] = __builtin_amdgcn_mfma_f32_16x16x32_bf16(ka[kt8], vb0, eL[kt8] * S[kt8], 0, 0, 0);
#pragma unroll
          for (int kt8 = 0; kt8 < 8; ++kt8) ka[kt8] = *(const LAS bf16x8*)(img + IM_KT1 + (16 * kt8 + fr) * HS_KT + 8 * fq * 2);
#pragma unroll
          for (int kt8 = 0; kt8 < 8; ++kt8) S[kt8] = __builtin_amdgcn_mfma_f32_16x16x32_bf16(ka[kt8], vb1, S[kt8], 0, 0, 0); }
        { float pq[16];
#pragma unroll
          for (int tt = 0; tt < 4; ++tt)
#pragma unroll
              for (int j = 0; j < 4; ++j) pq[tt * 4 + j] = o[tt][j] * o[tt][j];
#pragma unroll
          for (int i = 0; i < 16; ++i) pq[i] += dpp_f<0xB1>(pq[i]);
#pragma unroll
          for (int i = 0; i < 16; ++i) pq[i] += dpp_f<0x4E>(pq[i]);
#pragma unroll
          for (int i = 0; i < 16; ++i) pq[i] += dpp_f<0x141>(pq[i]);
#pragma unroll
          for (int i = 0; i < 16; ++i) pq[i] += dpp_f<0x140>(pq[i]);
          if (fr == 0) {
#pragma unroll
              for (int tt = 0; tt < 4; ++tt) *(LAS f32x4*)(SSQ + w * 64 + 16 * tt + 4 * fq) = (f32x4){pq[tt * 4], pq[tt * 4 + 1], pq[tt * 4 + 2], pq[tt * 4 + 3]}; } }
        WG_BAR();
        if ((PROBE_MIX & 1) || n + 1 < SEQ / 64) HG_DMA_VT((n + 1) & (SEQ / 64 - 1));
        TSTOP(4); TSTART(5);
        { LAS float* OUT = (LAS float*)(lds + CB_ST);
#pragma unroll
          for (int tt = 0; tt < 4; ++tt)
#pragma unroll
              for (int j = 0; j < 4; ++j) OUT[(16 * tt + 4 * fq + j) * 132 + 16 * w + fr] = o[tt][j] * gv;
          WG_BAR();
          if ((PROBE_MIX & 1) || n + 1 < SEQ / 64) asm volatile("s_waitcnt vmcnt(8)" : "+v"(ogv[0]), "+v"(ogv[1]) :: "memory");
          else asm volatile("s_waitcnt vmcnt(0)" : "+v"(ogv[0]), "+v"(ogv[1]) :: "memory");
          u32x4 ow[2];
#pragma unroll
          for (int i = 0; i < 2; ++i) { const int t = orow + 32 * i;
              float ss = SSQ[t];
#pragma unroll
              for (int ww = 1; ww < 8; ++ww) ss += SSQ[ww * 64 + t];
              const float rstd = __builtin_amdgcn_rsqf(ss * (1.0f / DKV) + EPS);
              const f32x4 x0 = *(const LAS f32x4*)(OUT + t * 132 + oc8) * rstd, x1 = *(const LAS f32x4*)(OUT + t * 132 + oc8 + 4) * rstd;
              const u32x4 g_ = ogv[i];
              const f32x4 g0 = (f32x4){bf2f(g_.x & 0xffffu), bf2f(g_.x >> 16), bf2f(g_.y & 0xffffu), bf2f(g_.y >> 16)}, g1 = (f32x4){bf2f(g_.z & 0xffffu), bf2f(g_.z >> 16), bf2f(g_.w & 0xffffu), bf2f(g_.w >> 16)};
              const f32x4 y0 = x0 * g0, y1 = x1 * g1;
              ow[i].x = pk2(y0[0], y0[1]); ow[i].y = pk2(y0[2], y0[3]); ow[i].z = pk2(y1[0], y1[1]); ow[i].w = pk2(y1[2], y1[3]); }
          *(u32x4*)(OA + base + (size_t)(64 * n + orow) * D + oc8) = ow[0]; *(u32x4*)(OA + base + (size_t)(64 * n + 32 + orow) * D + oc8) = ow[1]; }
        TSTOP(5); TSTOP(1);
    }
    asm volatile("s_waitcnt vmcnt(0)" ::: "memory");
    if (PROBE_T && PROBE_T < 10 && l == 0 && c.wg == 0 && tid == 0) *(float*)(a.ws + WS_DBG) = (float)(tacc >> 5) * 1e-4f;
#undef HG_DMA_IMG
#undef HG_DMA_VT
    { float* Sout = a.out + O_HGP + (((size_t)l * NBATCH + b) * NH + h) * DKV * DKV;
#pragma unroll
      for (int kt8 = 0; kt8 < 8; ++kt8)
#pragma unroll
          for (int j = 0; j < 4; ++j) Sout[(size_t)(16 * kt8 + 4 * fq + j) * DKV + 16 * w + fr] = S[kt8][j]; }
    __syncthreads();
}

constexpr int LXS = 132;
constexpr int L_XBS = 0, L_XC = 67 * LXS, L_AS = L_XC + 64 * LXS, L_BS = L_AS + 8192, L_SEG = L_BS + 8192, L_CARRY = L_SEG + 1024;
constexpr int LB_XCB = (L_CARRY + 256) * 4, XCB_STRIDE = 272;
static_assert(LB_XCB + 64 * XCB_STRIDE <= MISC_OFF && LB_XCB % 16 == 0, "lru lds");
__device__ __forceinline__ void lru_gates_naive(CArgs& a, Ctx& c, int l, int n) {
    LAS float* XC = (LAS float*)c.lds + L_XC; LAS float* As = (LAS float*)c.lds + L_AS; LAS float* Bs = (LAS float*)c.lds + L_BS;
    const bf16* wl = (const bf16*)(a.ws + WS_W + (size_t)l * WL_STRIDE);
    const int e = c.tid & 127, tg = c.tid >> 7;
    const bf16* wa = wl + OFF_LWA / 2 + (size_t)(n * 128 + e) * 128; const bf16* wx = wl + OFF_LWX / 2 + (size_t)(n * 128 + e) * 128;
    const int ch = n * 128 + e;
    const float ba = a.in[17][(size_t)l * D + ch], bx = a.in[19][(size_t)l * D + ch], sp = ((const float*)(a.ws + WS_TAB + 32768))[l * D + ch];
#pragma unroll 1
    for (int tq = 0; tq < 4; ++tq) {
        float ra[4], ia[4];
#pragma unroll
        for (int i = 0; i < 4; ++i) { ra[i] = 0.f; ia[i] = 0.f; }
        const LAS float* xc = XC + (tg * 16 + tq * 4) * LXS;
#pragma unroll 1
        for (int d0 = 0; d0 < 128; d0 += 8) {
            const f32x4 wa0 = ld_bf4(wa + d0), wa1 = ld_bf4(wa + d0 + 4), wx0 = ld_bf4(wx + d0), wx1 = ld_bf4(wx + d0 + 4);
#pragma unroll
            for (int tt = 0; tt < 4; ++tt) {
                const f32x4 x0 = *(const LAS f32x4*)(xc + tt * LXS + d0), x1 = *(const LAS f32x4*)(xc + tt * LXS + d0 + 4);
                ra[tt] += (x0[0] * wa0[0] + x0[1] * wa0[1]) + (x0[2] * wa0[2] + x0[3] * wa0[3]) + (x1[0] * wa1[0] + x1[1] * wa1[1]) + (x1[2] * wa1[2] + x1[3] * wa1[3]);
                ia[tt] += (x0[0] * wx0[0] + x0[1] * wx0[1]) + (x0[2] * wx0[2] + x0[3] * wx0[3]) + (x1[0] * wx1[0] + x1[1] * wx1[1]) + (x1[2] * wx1[2] + x1[3] * wx1[3]);
            }
        }
#pragma unroll
        for (int tt = 0; tt < 4; ++tt) {
            const int t = tg * 16 + tq * 4 + tt;
            const float r = sigmoidf_(ra[tt] + ba), ig = sigmoidf_(ia[tt] + bx);
            const float la = -8.0f * r * sp, aa = expf(la), mult = sqrtf(-expm1f(2.0f * la));
            As[t * 128 + e] = aa; Bs[t * 128 + e] = mult * ig * XC[t * LXS + e];
        }
    }
}
__device__ __forceinline__ void lru_gates_mfma(CArgs& a, Ctx& c, int l, int n) {
    LAS float* XC = (LAS float*)c.lds + L_XC; LAS float* As = (LAS float*)c.lds + L_AS; LAS float* Bs = (LAS float*)c.lds + L_BS;
    const bf16* wl = (const bf16*)(a.ws + WS_W + (size_t)l * WL_STRIDE);
    const int lane = c.tid & 63, w = __builtin_amdgcn_readfirstlane(c.tid >> 6), fr = lane & 15, fq = lane >> 4;
    const int e = 16 * w + fr, ch = n * 128 + e;
    const bf16* wa = wl + OFF_LWA / 2 + (size_t)(n * 128 + e) * 128 + 8 * fq; const bf16* wx = wl + OFF_LWX / 2 + (size_t)(n * 128 + e) * 128 + 8 * fq;
    bf16x8 Ba[4], Bx[4];
#pragma unroll
    for (int ks = 0; ks < 4; ++ks) { Ba[ks] = *(const bf16x8*)(wa + 32 * ks); Bx[ks] = *(const bf16x8*)(wx + 32 * ks); }
    const float ba = a.in[17][(size_t)l * D + ch], bx = a.in[19][(size_t)l * D + ch], sp = ((const float*)(a.ws + WS_TAB + 32768))[l * D + ch];
#pragma unroll
    for (int m = 0; m < 4; ++m) {
        f32x4 ar = (f32x4){0.f, 0.f, 0.f, 0.f}, ai = (f32x4){0.f, 0.f, 0.f, 0.f};
#pragma unroll
        for (int ks = 0; ks < 4; ++ks) {
            const bf16x8 af = *(const LAS bf16x8*)(c.lds + LB_XCB + (16 * m + fr) * XCB_STRIDE + (32 * ks + 8 * fq) * 2);
            ar = __builtin_amdgcn_mfma_f32_16x16x32_bf16(af, Ba[ks], ar, 0, 0, 0);
            ai = __builtin_amdgcn_mfma_f32_16x16x32_bf16(af, Bx[ks], ai, 0, 0, 0);
        }
#pragma unroll
        for (int j = 0; j < 4; ++j) {
            const int t = 16 * m + 4 * fq + j;
            const float r = sigmoidf_(ar[j] + ba), ig = sigmoidf_(ai[j] + bx);
            const float la = -8.0f * r * sp, aa = expf(la), mult = sqrtf(-expm1f(2.0f * la));
            As[t * 128 + e] = aa; Bs[t * 128 + e] = mult * ig * XC[t * LXS + e];
        }
    }
}
#if FAST_GATES
#define lru_gates lru_gates_mfma
#else
#define lru_gates lru_gates_naive
#endif

constexpr int LB_CW = LB_XCB + 64 * XCB_STRIDE;
static_assert(LB_CW + 2560 <= MISC_OFF, "lru lds");
__device__ __forceinline__ void lru_prompt_item(CArgs& a, Ctx& c, int l, int b, int n, int hc) {
    LAS float* L = (LAS float*)c.lds;
    LAS float* As = L + L_AS; LAS float* Bs = L + L_BS; LAS float* SEG = L + L_SEG; LAS float* CAR = L + L_CARRY;
    const bf16* XB = (const bf16*)(a.ws + WS_XB); const bf16* YG = (const bf16*)(a.ws + WS_YG); bf16* OB = (bf16*)(a.ws + WS_OB);
    const int t_ld = c.tid >> 3, c0 = (c.tid & 7) * 16;
    const int cch = c.tid & 63, sg = c.tid >> 6;
    const int lane = c.tid & 63, w = __builtin_amdgcn_readfirstlane(c.tid >> 6), fr = lane & 15, fq = lane >> 4;
    const int ec = 16 * (w & 3) + fr, e = 64 * hc + ec, ch = n * 128 + e, m0 = 2 * (w >> 2);
    const int chs = n * 128 + 64 * hc + cch;
    __syncthreads();
    if (c.tid < 128) CAR[c.tid] = 0.f;
    if (c.tid < 384) L[L_XBS + (c.tid >> 7) * LXS + (c.tid & 127)] = 0.f;
    f32x4 cwr[4][4], cbr[4];
#pragma unroll
    for (int j4 = 0; j4 < 4; ++j4) { cbr[j4] = *(const f32x4*)(a.in[15] + (size_t)l * D + n * 128 + c0 + 4 * j4);
#pragma unroll
        for (int j = 0; j < 4; ++j) cwr[j][j4] = *(const f32x4*)(a.in[14] + (size_t)l * 4 * D + j * D + n * 128 + c0 + 4 * j4); }
    bf16x8 Ba[4], Bx[4];
    { const bf16* wl = (const bf16*)(a.ws + WS_W + (size_t)l * WL_STRIDE);
      const bf16* wa = wl + OFF_LWA / 2 + (size_t)(n * 128 + e) * 128 + 8 * fq; const bf16* wx = wl + OFF_LWX / 2 + (size_t)(n * 128 + e) * 128 + 8 * fq;
#pragma unroll
      for (int ks = 0; ks < 4; ++ks) { Ba[ks] = *(const bf16x8*)(wa + 32 * ks); Bx[ks] = *(const bf16x8*)(wx + 32 * ks); } }
    const float ba = a.in[17][(size_t)l * D + ch], bx = a.in[19][(size_t)l * D + ch], sp8 = -8.0f * ((const float*)(a.ws + WS_TAB + 32768))[l * D + ch];
    const bf16* xsrc = XB + (size_t)(b * SEQ + t_ld) * D + n * 128 + c0;
    u32x4 xr0 = *(const u32x4*)xsrc, xr1 = *(const u32x4*)(xsrc + 8);
    unsigned long long tacc = 0ull, tst = 0ull;
#define LT0(id) do { if (PROBE_T == (id)) { __builtin_amdgcn_sched_barrier(0); tst = __builtin_amdgcn_s_memtime(); __builtin_amdgcn_sched_barrier(0); } } while (0)
#define LT1(id) do { if (PROBE_T == (id)) { __builtin_amdgcn_sched_barrier(0); tacc += __builtin_amdgcn_s_memtime() - tst; __builtin_amdgcn_sched_barrier(0); } } while (0)
    for (int t0 = 0; t0 < SEQ; t0 += 64) {
        const int par = (t0 >> 6) & 1;
        LT0(10); LT0(11);
        unsigned ygr[8];
        { const bf16* yp = YG + (size_t)(b * SEQ + t0 + sg * 8) * D + chs;
#pragma unroll
          for (int tt = 0; tt < 8; ++tt) ygr[tt] = yp[(size_t)tt * D]; }
        WG_BAR();
        { LAS float* dst = L + L_XBS + (3 + t_ld) * LXS + c0;
          *(LAS f32x4*)dst        = (f32x4){bf2f(xr0.x & 0xffffu), bf2f(xr0.x >> 16), bf2f(xr0.y & 0xffffu), bf2f(xr0.y >> 16)};
          *(LAS f32x4*)(dst + 4)  = (f32x4){bf2f(xr0.z & 0xffffu), bf2f(xr0.z >> 16), bf2f(xr0.w & 0xffffu), bf2f(xr0.w >> 16)};
          *(LAS f32x4*)(dst + 8)  = (f32x4){bf2f(xr1.x & 0xffffu), bf2f(xr1.x >> 16), bf2f(xr1.y & 0xffffu), bf2f(xr1.y >> 16)};
          *(LAS f32x4*)(dst + 12) = (f32x4){bf2f(xr1.z & 0xffffu), bf2f(xr1.z >> 16), bf2f(xr1.w & 0xffffu), bf2f(xr1.w >> 16)}; }
        if (t0 + 64 < SEQ) { xr0 = *(const u32x4*)(xsrc + (size_t)(t0 + 64) * D); xr1 = *(const u32x4*)(xsrc + (size_t)(t0 + 64) * D + 8); }
        WG_BAR();
        LT1(11); LT0(12);
#pragma unroll
        for (int hh = 0; hh < 2; ++hh) { f32x4 xv[4][2];
#pragma unroll
          for (int jj = 0; jj < 2; ++jj)
#pragma unroll
              for (int j = 0; j < 4; ++j) xv[j][jj] = *(const LAS f32x4*)(L + L_XBS + (t_ld + j) * LXS + c0 + 4 * (2 * hh + jj));
          f32x4 acc[2];
#pragma unroll
          for (int jj = 0; jj < 2; ++jj) { acc[jj] = cbr[2 * hh + jj];
#pragma unroll
              for (int j = 0; j < 4; ++j) acc[jj] += cwr[j][2 * hh + jj] * xv[j][jj]; }
#pragma unroll
          for (int jj = 0; jj < 2; ++jj) { const int cc = c0 + 4 * (2 * hh + jj);
              *(LAS f32x4*)(L + L_XC + t_ld * LXS + cc) = acc[jj];
              u32x2 pw; pw.x = pk2(acc[jj][0], acc[jj][1]); pw.y = pk2(acc[jj][2], acc[jj][3]); *(LAS u32x2*)(c.lds + LB_XCB + t_ld * XCB_STRIDE + cc * 2) = pw; } }
        WG_BAR();
        LT1(12); LT0(13);
        { bf16x8 af[2][4]; float xcv[2][4];
#pragma unroll
          for (int mm = 0; mm < 2; ++mm) {
#pragma unroll
              for (int ks = 0; ks < 4; ++ks) af[mm][ks] = *(const LAS bf16x8*)(c.lds + LB_XCB + (16 * (m0 + mm) + fr) * XCB_STRIDE + (32 * ks + 8 * fq) * 2);
#pragma unroll
              for (int j = 0; j < 4; ++j) xcv[mm][j] = L[L_XC + (16 * (m0 + mm) + 4 * fq + j) * LXS + e]; }
          f32x4 ar[2], ai[2];
#pragma unroll
          for (int mm = 0; mm < 2; ++mm) { ar[mm] = (f32x4){0.f, 0.f, 0.f, 0.f}; ai[mm] = (f32x4){0.f, 0.f, 0.f, 0.f}; }
#pragma unroll
          for (int ks = 0; ks < 4; ++ks)
#pragma unroll
              for (int mm = 0; mm < 2; ++mm) { ar[mm] = __builtin_amdgcn_mfma_f32_16x16x32_bf16(af[mm][ks], Ba[ks], ar[mm], 0, 0, 0); ai[mm] = __builtin_amdgcn_mfma_f32_16x16x32_bf16(af[mm][ks], Bx[ks], ai[mm], 0, 0, 0); }
          float av[2][4], bv[2][4];
#pragma unroll
          for (int mm = 0; mm < 2; ++mm)
#pragma unroll
              for (int j = 0; j < 4; ++j) {
                  const float r = sig_fast(ar[mm][j] + ba), ig = sig_fast(ai[mm][j] + bx);
                  const float la = sp8 * r, x2 = 2.0f * la;
                  const float em = x2 > -0.5f ? x2 * (1.0f + x2 * (0.5f + x2 * (0.16666667f + x2 * (0.041666668f + x2 * 0.0083333338f)))) : __expf(x2) - 1.0f;
                  av[mm][j] = __expf(la); bv[mm][j] = __builtin_amdgcn_sqrtf(-em) * ig * xcv[mm][j]; }
#pragma unroll
          for (int mm = 0; mm < 2; ++mm)
#pragma unroll
              for (int j = 0; j < 4; ++j) { const int t = 16 * (m0 + mm) + 4 * fq + j; As[t * 68 + ec] = av[mm][j]; Bs[t * 68 + ec] = bv[mm][j]; } }
        WG_BAR();
        LT1(13); LT0(14);
        float aa8[8], bb8[8];
#pragma unroll
        for (int tt = 0; tt < 8; ++tt) { aa8[tt] = As[(sg * 8 + tt) * 68 + cch]; bb8[tt] = Bs[(sg * 8 + tt) * 68 + cch]; }
        float P = 1.f, Bv = 0.f;
#pragma unroll
        for (int tt = 0; tt < 8; ++tt) { Bv = aa8[tt] * Bv + bb8[tt]; P *= aa8[tt]; }
        SEG[(sg * 64 + cch) * 2] = P; SEG[(sg * 64 + cch) * 2 + 1] = Bv;
        WG_BAR();
        LT1(14); LT0(15);
        float h = CAR[par * 64 + cch];
        { float sp_[7], sb_[7];
#pragma unroll
          for (int s2 = 0; s2 < 7; ++s2) { sp_[s2] = SEG[(s2 * 64 + cch) * 2]; sb_[s2] = SEG[(s2 * 64 + cch) * 2 + 1]; }
#pragma unroll
          for (int s2 = 0; s2 < 7; ++s2) if (s2 < sg) h = sp_[s2] * h + sb_[s2]; }
        { bf16* op = OB + (size_t)(b * SEQ + t0 + sg * 8) * D + chs;
#pragma unroll
          for (int tt = 0; tt < 8; ++tt) { h = aa8[tt] * h + bb8[tt];
              op[(size_t)tt * D] = (bf16)f2bf(h * bf2f(ygr[tt])); } }
        if (sg == 7) CAR[(par ^ 1) * 64 + cch] = h;
        if (c.tid < 384) L[L_XBS + (c.tid >> 7) * LXS + (c.tid & 127)] = L[L_XBS + (64 + (c.tid >> 7)) * LXS + (c.tid & 127)];
        LT1(15); LT1(10);
    }
    if (PROBE_T >= 10 && PROBE_T < 20 && l == 0 && c.wg == 64 && c.tid == 0) *(float*)(a.ws + WS_DBG) = (float)(tacc >> 5) * 1e-4f;
#undef LT0
#undef LT1
    __syncthreads();
    if (c.tid < 64) a.out[O_LRP + ((size_t)l * NBATCH + b) * D + n * 128 + 64 * hc + c.tid] = CAR[c.tid];
    if (hc == 0 && c.tid < 384) a.out[O_CVP + (((size_t)l * NBATCH + b) * 3 + (c.tid >> 7)) * D + n * 128 + (c.tid & 127)] = L[L_XBS + (c.tid >> 7) * LXS + (c.tid & 127)];
    __syncthreads();
}
__device__ __forceinline__ void lru_sample_item(CArgs& a, Ctx& c, int l, int n, int hf) {
    LAS float* L = (LAS float*)c.lds;
    const bf16* XB = (const bf16*)(a.ws + WS_XB); const bf16* YG = (const bf16*)(a.ws + WS_YG); bf16* OB = (bf16*)(a.ws + WS_OB);
    const int t_ld = c.tid >> 3, c0 = (c.tid & 7) * 16;
    const float* cw = a.in[14] + (size_t)l * 4 * D + n * 128; const float* cb = a.in[15] + (size_t)l * D + n * 128;
    const int bs = hf * 64 + t_ld, row = MP + bs;
    const float* sc = a.in[4] + ((size_t)l * NS + bs) * 3 * D + n * 128;
    float* nc = a.out + O_CVS + ((size_t)l * NS + bs) * 3 * D + n * 128;
    __syncthreads();
#pragma unroll
    for (int j4 = 0; j4 < 4; ++j4) { const int cc = c0 + 4 * j4;
        const f32x4 x = ld_bf4(XB + (size_t)row * D + n * 128 + cc);
        const f32x4 s0 = *(const f32x4*)(sc + cc), s1 = *(const f32x4*)(sc + D + cc), s2 = *(const f32x4*)(sc + 2 * D + cc);
        const f32x4 acc = *(const f32x4*)(cb + cc) + *(const f32x4*)(cw + cc) * s0 + *(const f32x4*)(cw + D + cc) * s1 + *(const f32x4*)(cw + 2 * D + cc) * s2 + *(const f32x4*)(cw + 3 * D + cc) * x;
        *(LAS f32x4*)(L + L_XC + t_ld * LXS + cc) = acc;
        { u32x2 w; w.x = pk2(acc[0], acc[1]); w.y = pk2(acc[2], acc[3]); *(LAS u32x2*)(c.lds + LB_XCB + t_ld * XCB_STRIDE + cc * 2) = w; }
        *(f32x4*)(nc + cc) = s1; *(f32x4*)(nc + D + cc) = s2; *(f32x4*)(nc + 2 * D + cc) = x; }
    __syncthreads();
    lru_gates(a, c, l, n);
    __syncthreads();
    { const int cch = c.tid & 127, tg = c.tid >> 7;
#pragma unroll 4
      for (int tt = 0; tt < 16; ++tt) { const int t = tg * 16 + tt, b2 = hf * 64 + t; const size_t off = (size_t)(MP + b2) * D + n * 128 + cch;
          const float h0 = a.in[3][((size_t)l * NS + b2) * D + n * 128 + cch];
          const float h = L[L_AS + t * 128 + cch] * h0 + L[L_BS + t * 128 + cch];
          a.out[O_LRS + ((size_t)l * NS + b2) * D + n * 128 + cch] = h;
          OB[off] = (bf16)f2bf(h * bf2f(YG[off])); } }
    __syncthreads();
}

__device__ __forceinline__ void mixer_phase(CArgs& a, Ctx& c, int l) {
    unsigned long long mt0 = 0ull; if (PROBE_T >= 20 && PROBE_T < 30) mt0 = __builtin_amdgcn_s_memrealtime();
    if (c.wg < 64) {
        hgrn_fast_prompt(a, c, l, c.wg >> 3, c.wg & 7);
    } else if (c.wg < 192) {
        const int i = c.wg - 64;
        for (int rep = 0; rep < 1 + ((PROBE_MIX >> 1) & 1); ++rep) lru_prompt_item(a, c, l, i >> 4, (i >> 1) & 7, i & 1);
    } else {
        for (int rep = 0; rep < 1 + ((PROBE_MIX >> 2) & 1); ++rep)
        for (int it = c.wg - 192; it < NS * NH; it += c.G - 192) {
            const int bs = it >> 3, h = it & 7; const size_t so = (((size_t)l * NS + bs) * NH + h) * DKV * DKV;
            hgrn_naive(a, c, l, MP + bs, 1, h, a.in[2] + so, a.out + O_HGS + so);
        }
        if (c.wg - 192 < 16) lru_sample_item(a, c, l, (c.wg - 192) >> 1, (c.wg - 192) & 1);
        else if (P0_DEFER && c.G > 208) { __syncthreads(); p0_work(a, c, c.wg, c.G, false, l == 0 ? 2 : 3, false); }
    }
    if (PROBE_T >= 20 && PROBE_T < 30 && l == 1) {
        const int pw = PROBE_T == 20 ? 0 : PROBE_T == 21 ? 64 : PROBE_T == 22 ? 255 : PROBE_T == 23 ? 192 : PROBE_T == 24 ? 63 : 191;
        asm volatile("s_waitcnt vmcnt(0)" ::: "memory"); __syncthreads();
        if (c.wg == pw && threadIdx.x == 0) *(float*)(a.ws + WS_DBG) = (float)(__builtin_amdgcn_s_memrealtime() - mt0) * 0.001f - 8.0f;
    }
}

__global__ void __launch_bounds__(512, 2) mega_fwd(Args a0) {
    extern __shared__ __attribute__((aligned(16))) unsigned char lds_raw[];
    Ctx c; c.lds = (LAS unsigned char*)lds_raw; c.tid = threadIdx.x; c.G = gridDim.x; c.wg = blockIdx.x;
    volatile LAS unsigned* MISC = (volatile LAS unsigned*)(c.lds + MISC_OFF);
    if (c.tid < 32) MISC[c.tid] = 0u;
    __syncthreads();
    XcdBarrier bar; bar.bar = (unsigned*)(a0.ws + WS_CTL) + 1024; bar.x = 0; bar.st = nullptr;
    const int nprog = a0.nprog;
    if (nprog > 1) bar = xcd_barrier_post((unsigned*)(a0.ws + WS_CTL) + 1024, MISC + 8);

    for (int pi = 0; pi < nprog; ++pi) {
        CArgs* ap = (CArgs*)__builtin_amdgcn_kernarg_segment_ptr(); asm volatile("" : "+s"(ap));
        CArgs& a = *ap;
        const int ph = a.prog[pi];
        unsigned long long pt0 = 0ull; if (PROBE_T >= 100 && ph == PROBE_T - 100) pt0 = __builtin_amdgcn_s_memrealtime();
        { int t_ = threadIdx.x, w_ = blockIdx.x, g_ = gridDim.x; asm volatile("" : "+v"(t_), "+s"(w_), "+s"(g_)); c.tid = t_; c.wg = w_; c.G = g_; }
        float* X = a.out;
        if (ph == 0) { }
        else if (ph == NPHASE - 1) final_norm_phase(a, c);
        else {
            const int l = (ph - 1) / 9, j = (ph - 1) % 9;
            const bf16* wl = (const bf16*)(a.ws + WS_W + (size_t)l * WL_STRIDE);
            const float* xp = l == 0 ? a.in[0] : nullptr; const float* xs = l == 0 ? a.in[1] : nullptr;
            const float* modl = (const float*)(a.ws + WS_MOD) + (size_t)l * NMOD * 6144;
            bf16* H = (bf16*)(a.ws + WS_H);
            if (j == 0) norm_phase(a, c, l, 0, xp, xs);
            else if (j == 1) {
                EpiIn e{a.ws + WS_PREP, (bf16*)(a.ws + WS_SQ), (bf16*)(a.ws + WS_SK), (float*)(a.ws + WS_SLOGF), (bf16*)(a.ws + WS_V), (bf16*)(a.ws + WS_OG), (bf16*)(a.ws + WS_XB), (bf16*)(a.ws + WS_YG), (bf16*)(a.ws + WS_SGA), (bf16*)(a.ws + WS_SGB),
                        (const float*)(a.ws + WS_TAB) + (size_t)l * 3 * D, l == 0 ? 1 : 0};
                gemm_phase_sel<0>(c, H, wl + OFF_WIN / 2, MT, NIN, D, e, nullptr, (float*)(a.ws + WS_DBG), NormJob{0, nullptr, nullptr, 0, nullptr, nullptr, nullptr, nullptr, nullptr}, ap);
                if (P0_DEFER && P0_UNDER && l == 0 && c.G > 208) { { int t_ = threadIdx.x; asm volatile("" : "+v"(t_)); c.tid = t_; } p0_work(a, c, c.wg, c.G, false, 4, false); }
            } else if (j == 2) hgrn_prep_items<false>(a, c, 0);
            else if (j == 3) mixer_phase(a, c, l);
            else if (j == 4) {
                EpiBrA ea{(const bf16*)(a.ws + WS_SGA), (float*)(a.ws + WS_T)};
                EpiBrB eb{(const bf16*)(a.ws + WS_SGB), (const float*)(a.ws + WS_T), (bf16*)(a.ws + WS_MG)};
                const int sfirst = STAGGER_BR ? ((c.wg >> 3) & 1) : 0;
#pragma nounroll
                for (int pass = 0; pass < 2; ++pass) {
                    if ((pass == 0) == (sfirst == 0)) {
                        { int t_ = threadIdx.x; asm volatile("" : "+v"(t_)); c.tid = t_; }
                        pg8::Gemm g{(const bf16*)(a.ws + WS_OA), wl + OFF_WA / 2, MP, D, D, (const bf16*)(a.ws + WS_OB), wl + OFF_WB / 2, 0};
                        PowOrder S; S.init(2, c.G, c.wg, 1);
                        EpiBranchUnit qe{(const bf16*)(a.ws + WS_SGA), (const bf16*)(a.ws + WS_SGB), (bf16*)(a.ws + WS_MG)};
                        pg8::gemm_phase<EpiBranchUnit, PowOrder, true, true>(c.lds, g, S, qe, c.tid);
                    } else {
                        { int t_ = threadIdx.x; asm volatile("" : "+v"(t_)); c.tid = t_; }
                        sample_gemm_phase(c, (const bf16*)(a.ws + WS_OA), wl + OFF_WA / 2, D, D, ea);
                        asm volatile("s_waitcnt vmcnt(0)" ::: "memory"); __syncthreads();
                        sample_gemm_phase(c, (const bf16*)(a.ws + WS_OB), wl + OFF_WB / 2, D, D, eb);
                    }
                }
            } else if (j == 5) {
                EpiRes e{xp, xs, (bf16*)X, modl, 2};
                unsigned* ctl = (unsigned*)(a.ws + WS_CTL);
                NormJob nj{FUSE_NORM ? 1 : 0, a.in[10] + (size_t)l * D, modl, 3 * 1024, ctl + 8192 + (2 * l) * 68 * 16, ctl + 1024, H, X, (const float*)(a.ws + WS_DBG)};
                gemm_phase_sel<3>(c, (const bf16*)(a.ws + WS_MG), wl + OFF_WO / 2, MT, D, D, e, nullptr, (float*)(a.ws + WS_DBG), nj);
            } else if (j == 6) norm_phase(a, c, l, 1, nullptr, nullptr);
            else if (j == 7) { EpiFF1 e{(bf16*)(a.ws + WS_HM), (bf16*)(a.ws + WS_HMS)}; gemm_phase_sel<4>(c, H, wl + OFF_W1 / 2, MT, FF, D, e); }
            else { EpiRes e{nullptr, nullptr, (bf16*)X, modl, 5};
                   unsigned* ctl = (unsigned*)(a.ws + WS_CTL);
                   NormJob nj{FUSE_NORM ? (l == 0 ? 1 : 2) : 0, l == 0 ? a.in[9] + D : a.in[26], modl + (size_t)NMOD * 6144, 0, ctl + 8192 + (2 * l + 1) * 68 * 16, ctl + 1024, H, X, (const float*)(a.ws + WS_DBG)};
                   gemm_phase_sel<5>(c, (const bf16*)(a.ws + WS_HM), wl + OFF_W2 / 2, MT, D, FF, e, nullptr, (float*)(a.ws + WS_DBG), nj); }
        }
        if (ph == 0) {
            { int t_ = threadIdx.x; asm volatile("" : "+v"(t_)); c.tid = t_; }
            p0_work(a, c, c.wg, c.G, true, 1, true);
        }
        if (pi + 1 < nprog) xcd_barrier(bar);
        if (PROBE_T >= 100 && ph == PROBE_T - 100 && c.wg == 0 && threadIdx.x == 0) *(float*)(a.ws + WS_DBG) = ((float)(__builtin_amdgcn_s_memrealtime() - pt0) * 0.01f - (float)PROBE_TOFS) * 0.1f;
    }
}

extern "C" void kernel_launch(void* const* d_in, const int* in_sizes, int n_in, void* d_out, int out_size, void* d_ws, size_t ws_size, hipStream_t stream) {
    static int grid = 0;
    if (grid == 0) {
        if (n_in != 27 || out_size != (int)O_END || ws_size < WS_END) { fprintf(stderr, "kernel_launch: unexpected shapes (n_in %d out %d ws %zu)\n", n_in, out_size, ws_size); grid = -1; return; }
        int dev = 0, cus = 0, per_cu = 0;
        if (hipGetDevice(&dev) != hipSuccess || hipDeviceGetAttribute(&cus, hipDeviceAttributeMultiprocessorCount, dev) != hipSuccess) { grid = -1; return; }
        if (hipFuncSetAttribute((const void*)mega_fwd, hipFuncAttributeMaxDynamicSharedMemorySize, LDS_BYTES) != hipSuccess) { fprintf(stderr, "kernel_launch: hipFuncSetAttribute failed\n"); grid = -1; return; }
        if (hipOccupancyMaxActiveBlocksPerMultiprocessor(&per_cu, (const void*)mega_fwd, 512, LDS_BYTES) != hipSuccess || per_cu < 1) { fprintf(stderr, "kernel_launch: occupancy query failed (%d)\n", per_cu); (void)hipGetLastError(); per_cu = 1; }
        grid = cus * (per_cu < 1 ? 1 : 1);
        fprintf(stderr, "kernel_launch: cus %d per_cu %d grid %d\n", cus, per_cu, grid);
    }
    if (grid < 0) return;
    (void)hipMemsetAsync((char*)d_ws + WS_CTL, 0, CTL_BYTES, stream);
    Args a{};
    for (int i = 0; i < 27; ++i) a.in[i] = (const float*)d_in[i];
    a.out = (float*)d_out; a.ws = (unsigned char*)d_ws;
    unsigned char prog[60]; int np = 0;
    for (int ph = 0; ph < NPHASE; ++ph) if (!(FUSE_NORM && (ph == 7 || ph == 10 || ph == 16 || ph == 19)) && !(FUSE_PREP && grid == 256 && (ph == 3 || ph == 12))) for (int rep = 0; rep < 1 + (int)(((unsigned)PROBE_REPEAT >> ph) & 1u); ++rep) prog[np++] = (unsigned char)ph;
#if ONE_LAUNCH
    a.nprog = np; for (int i = 0; i < np; ++i) a.prog[i] = prog[i];
    void* kargs[] = {&a};
    hipError_t e = hipLaunchCooperativeKernel((const void*)mega_fwd, dim3(grid), dim3(512), kargs, LDS_BYTES, stream);
    if (e != hipSuccess) fprintf(stderr, "kernel_launch: cooperative launch failed: %s (grid %d)\n", hipGetErrorString(e), grid);
#else
    for (int i = 0; i < np; ++i) { a.nprog = 1; a.prog[0] = prog[i]; hipLaunchKernelGGL(mega_fwd, dim3(grid), dim3(512), LDS_BYTES, stream, a); }
#endif
}
```
